# Optimizing an MI355X kernel written in HIP

```python
import jax
import jax.numpy as jnp
from jax import lax
import numpy as np

D_MODEL = 1024
BATCH = 2
SEQ = 8192
DEPTH = 2

GRID_W = 64
CTX_LEN = 256
EPS = 1e-6

LSTM_HEADS = 4
LSTM_DIM = 128
LSTM_WIDTH = LSTM_HEADS * LSTM_DIM
LSTM_CONV = 5
LSTM_CHUNK = 128

ATTN_HEADS = 8
ATTN_KV_HEADS = 2
ATTN_GROUP = ATTN_HEADS // ATTN_KV_HEADS
ATTN_DIM = 64
ATTN_WINDOW = 128
ATTN_BLOCK = 128
ROPE_BASE = 10000.0

AB_SPLITS = (LSTM_WIDTH, LSTM_WIDTH, LSTM_WIDTH, LSTM_WIDTH, 4 * LSTM_HEADS,
             ATTN_HEADS * ATTN_DIM, ATTN_KV_HEADS * ATTN_DIM, ATTN_KV_HEADS * ATTN_DIM)
AB_IN = sum(AB_SPLITS)
AB_OFFSETS = tuple(sum(AB_SPLITS[:i + 1]) for i in range(len(AB_SPLITS) - 1))
AB_MIX = LSTM_WIDTH + ATTN_HEADS * ATTN_DIM

GM_CHUNK = 128
GM_GROUPS = 8
GM_HALF = 2 * D_MODEL

N_EXPERTS = 16
EC_FACTOR = 2
D_EXPERT = D_MODEL

kernel_name = 'hybrid_mlstm_swa_gmlp_ec_dit'


def rmsnorm(x, g):
    xf = x.astype(jnp.float32)
    y = xf * lax.rsqrt(jnp.mean(xf * xf, axis=-1, keepdims=True) + EPS)
    return (y * g.astype(jnp.float32)).astype(x.dtype)


def layernorm(x, g, b):
    xf = x.astype(jnp.float32)
    mu = jnp.mean(xf, axis=-1, keepdims=True)
    var = jnp.mean(jnp.square(xf - mu), axis=-1, keepdims=True)
    return ((xf - mu) * lax.rsqrt(var + EPS) * g.astype(jnp.float32) + b.astype(jnp.float32)).astype(x.dtype)


def adaln(cond, w, b):
    m = jax.nn.silu(cond) @ w + b
    return jnp.split(m[..., None, :], 6, axis=-1)


def modulate(x, g, shift, scale):
    return rmsnorm(x, g) * (1 + scale) + shift


def axial_rope(n, dim):
    rows = n // GRID_W
    row = jnp.repeat(jnp.arange(rows), GRID_W).astype(jnp.float32)
    col = jnp.tile(jnp.arange(GRID_W), rows).astype(jnp.float32)
    nf = dim // 4
    inv = ROPE_BASE ** (-jnp.arange(nf, dtype=jnp.float32) / nf)
    ang = jnp.concatenate([row[:, None] * inv, col[:, None] * inv], axis=-1)
    return jnp.cos(ang), jnp.sin(ang)


def apply_rope(x, cos, sin):
    x1, x2 = jnp.split(x.astype(jnp.float32), 2, axis=-1)
    c = cos[None, :, None, :]
    s = sin[None, :, None, :]
    return jnp.concatenate([x1 * c - x2 * s, x2 * c + x1 * s], axis=-1).astype(x.dtype)


def centred_depthwise_conv(x, w):
    return lax.conv_general_dilated(
        x, w[:, None, :].astype(x.dtype), window_strides=(1,),
        padding=[(LSTM_CONV // 2, LSTM_CONV // 2)],
        dimension_numbers=('NWC', 'WIO', 'NWC'), feature_group_count=x.shape[-1])


def zero_state(batch):
    return (jnp.zeros((batch, LSTM_HEADS, LSTM_DIM, LSTM_DIM), jnp.float32),
            jnp.zeros((batch, LSTM_HEADS, LSTM_DIM), jnp.float32),
            jnp.zeros((batch, LSTM_HEADS), jnp.float32))


def mlstm_state_update(state, k, v, logi, logf):
    cm, nv, m = state
    b = jnp.cumsum(logf, axis=-1)
    g = b[..., -1]
    w = g[..., None] - b + logi
    m_new = jnp.maximum(g + m, jnp.max(w, axis=-1))
    decay = jnp.exp(g + m - m_new)
    wt = jnp.exp(w - m_new[..., None])
    c_new = decay[..., None, None] * cm + jnp.einsum('bhl,bhlv,bhlk->bhvk', wt, v, k)
    n_new = decay[..., None] * nv + jnp.einsum('bhl,bhlk->bhk', wt, k)
    return (c_new, n_new, m_new)


def mlstm_chunk(state, q, k, v, logi, logf):
    cm, nv, m = state
    length = q.shape[-2]
    b = jnp.cumsum(logf, axis=-1)
    order = jnp.tril(jnp.ones((length, length), bool))
    log_d = jnp.where(order, b[..., :, None] - b[..., None, :] + logi[..., None, :], -jnp.inf)
    log_inter = b + m[..., None]
    m_row = jnp.maximum(log_inter, jnp.max(log_d, axis=-1))
    s = jnp.einsum('bhqd,bhkd->bhqk', q, k) * jnp.exp(log_d - m_row[..., None])
    a = jnp.exp(log_inter - m_row)
    num = jnp.einsum('bhqk,bhkv->bhqv', s, v) + a[..., None] * jnp.einsum('bhvk,bhqk->bhqv', cm, q)
    den = jnp.sum(s, axis=-1) + a * jnp.einsum('bhk,bhqk->bhq', nv, q)
    h = num / jnp.maximum(jnp.abs(den), jnp.exp(-m_row))[..., None]
    return mlstm_state_update(state, k, v, logi, logf), h


def mlstm_scan(q, k, v, logi, logf, state0):
    bsz, heads, n, d = q.shape
    nc = n // LSTM_CHUNK

    def to_chunks(t):
        t = t.reshape(t.shape[:2] + (nc, LSTM_CHUNK) + t.shape[3:])
        return jnp.moveaxis(t, 2, 0)

    state, h = lax.scan(lambda st, xs: mlstm_chunk(st, *xs), state0,
                        tuple(to_chunks(t) for t in (q, k, v, logi, logf)))
    return jnp.moveaxis(h, 0, 2).reshape(bsz, heads, n, d), state


def mlstm_inputs(aq, ak, av, ag, conv_w, gate_b):
    bsz, n, _ = aq.shape
    qk = jax.nn.silu(centred_depthwise_conv(jnp.concatenate([aq, ak], axis=-1), conv_w))
    q, k = jnp.split(qk, 2, axis=-1)
    heads = lambda t: t.reshape(bsz, n, LSTM_HEADS, LSTM_DIM).transpose(0, 2, 1, 3).astype(jnp.float32)
    gates = (ag + gate_b).astype(jnp.float32).reshape(bsz, n, 4, LSTM_HEADS).transpose(2, 0, 3, 1)
    fwd = (gates[0], jax.nn.log_sigmoid(gates[1]))
    bwd = (gates[2], jax.nn.log_sigmoid(gates[3]))
    return heads(q), heads(k) * LSTM_DIM ** -0.5, heads(av), fwd, bwd


def mlstm_output(h, o, g):
    bsz, heads, n, d = h.shape
    h = h.transpose(0, 2, 1, 3)
    h = h * lax.rsqrt(jnp.mean(h * h, axis=-1, keepdims=True) + EPS)
    h = h.reshape(bsz, n, heads * d) * g.astype(jnp.float32)
    return (h * jax.nn.sigmoid(o.astype(jnp.float32))).astype(o.dtype)


def window_attn(q, k, v, kc, vc, sink):
    bsz, n = q.shape[0], q.shape[1]
    nb = n // ATTN_BLOCK
    nctx = kc.shape[1]
    qb = q.reshape(bsz, nb, ATTN_BLOCK, ATTN_KV_HEADS, ATTN_GROUP, ATTN_DIM)

    def windows(t):
        tp = jnp.pad(t, ((0, 0), (ATTN_BLOCK, ATTN_BLOCK), (0, 0), (0, 0)))
        tp = tp.reshape(bsz, nb + 2, ATTN_BLOCK, ATTN_KV_HEADS, ATTN_DIM)
        return jnp.concatenate([tp[:, :-2], tp[:, 1:-1], tp[:, 2:]], axis=2)

    kw, vw = windows(k), windows(v)
    qpos = jnp.arange(nb)[:, None] * ATTN_BLOCK + jnp.arange(ATTN_BLOCK)[None]
    kpos = jnp.arange(nb)[:, None] * ATTN_BLOCK - ATTN_BLOCK + jnp.arange(3 * ATTN_BLOCK)[None]
    valid = ((jnp.abs(qpos[:, :, None] - kpos[:, None, :]) <= ATTN_WINDOW)
             & (kpos[:, None, :] >= 0) & (kpos[:, None, :] < n))
    scale = ATTN_DIM ** -0.5
    s_loc = jnp.einsum('bnqgrd,bnkgd->bngrqk', qb, kw).astype(jnp.float32) * scale
    s_loc = jnp.where(valid[None, :, None, None], s_loc, -jnp.inf)
    s_ctx = jnp.einsum('bnqgrd,bcgd->bngrqc', qb, kc).astype(jnp.float32) * scale
    s_sink = jnp.broadcast_to(sink.reshape(ATTN_KV_HEADS, ATTN_GROUP).astype(jnp.float32)[None, None, :, :, None, None],
                              s_loc.shape[:-1] + (1,))
    p = jax.nn.softmax(jnp.concatenate([s_loc, s_ctx, s_sink], axis=-1), axis=-1).astype(v.dtype)
    w3 = 3 * ATTN_BLOCK
    out = (jnp.einsum('bngrqk,bnkgd->bnqgrd', p[..., :w3], vw)
           + jnp.einsum('bngrqc,bcgd->bnqgrd', p[..., w3:w3 + nctx], vc))
    return out.reshape(bsz, n, ATTN_HEADS * ATTN_DIM)


def context_attn(q, k, v, sink):
    bsz, nctx = q.shape[0], q.shape[1]
    qg = q.reshape(bsz, nctx, ATTN_KV_HEADS, ATTN_GROUP, ATTN_DIM)
    s = jnp.einsum('bqgrd,bkgd->bgrqk', qg, k).astype(jnp.float32) * ATTN_DIM ** -0.5
    s_sink = jnp.broadcast_to(sink.reshape(ATTN_KV_HEADS, ATTN_GROUP).astype(jnp.float32)[None, :, :, None, None],
                              s.shape[:-1] + (1,))
    p = jax.nn.softmax(jnp.concatenate([s, s_sink], axis=-1), axis=-1).astype(v.dtype)
    out = jnp.einsum('bgrqk,bkgd->bqgrd', p[..., :nctx], v)
    return out.reshape(bsz, nctx, ATTN_HEADS * ATTN_DIM)


def mixer_ab(hx, hc, ctx_needed, w_in, conv_w, gate_b, head_g, sink, w_out, cos, sin):
    bsz, n, _ = hx.shape
    nctx = hc.shape[1]
    aqx, akx, avx, aox, agx, bqx, bkx, bvx = jnp.split(hx @ w_in, AB_OFFSETS, axis=-1)
    aqc, akc, avc, aoc, agc, bqc, bkc, bvc = jnp.split(hc @ w_in, AB_OFFSETS, axis=-1)
    rev = lambda t: jnp.flip(t, axis=2)

    qx, kx, vx, fx, bx = mlstm_inputs(aqx, akx, avx, agx, conv_w, gate_b)
    qc, kc, vc, fc, bc = mlstm_inputs(aqc, akc, avc, agc, conv_w, gate_b)
    zero = zero_state(bsz)
    if ctx_needed:
        hcf, st_f = mlstm_scan(qc, kc, vc, fc[0], fc[1], zero)
        hcb, st_b = mlstm_scan(rev(qc), rev(kc), rev(vc), rev(bc[0]), rev(bc[1]), zero)
    else:
        st_f = mlstm_state_update(zero, kc, vc, fc[0], fc[1])
        st_b = mlstm_state_update(zero, rev(kc), rev(vc), rev(bc[0]), rev(bc[1]))
    hxf, _ = mlstm_scan(qx, kx, vx, fx[0], fx[1], st_f)
    hxb, _ = mlstm_scan(rev(qx), rev(kx), rev(vx), rev(bx[0]), rev(bx[1]), st_b)
    a_x = mlstm_output(hxf + rev(hxb), aox, head_g)

    q_lat = apply_rope(bqx.reshape(bsz, n, ATTN_HEADS, ATTN_DIM), cos, sin)
    k_lat = apply_rope(bkx.reshape(bsz, n, ATTN_KV_HEADS, ATTN_DIM), cos, sin)
    v_lat = bvx.reshape(bsz, n, ATTN_KV_HEADS, ATTN_DIM)
    k_ctx = bkc.reshape(bsz, nctx, ATTN_KV_HEADS, ATTN_DIM)
    v_ctx = bvc.reshape(bsz, nctx, ATTN_KV_HEADS, ATTN_DIM)
    b_x = window_attn(q_lat, k_lat, v_lat, k_ctx, v_ctx, sink)

    y_x = jnp.concatenate([a_x, b_x], axis=-1) @ w_out
    y_c = None
    if ctx_needed:
        a_c = mlstm_output(hcf + rev(hcb), aoc, head_g)
        b_c = context_attn(bqc.reshape(bsz, nctx, ATTN_HEADS, ATTN_DIM), k_ctx, v_ctx, sink)
        y_c = jnp.concatenate([a_c, b_c], axis=-1) @ w_out
    return y_x, y_c


def mixer_chunk_gmlp(h, w_in, ln_g, ln_b, w_s, b_s, w_out):
    bsz, n, _ = h.shape
    u, v = jnp.split(jax.nn.gelu(h @ w_in), 2, axis=-1)
    v = layernorm(v, ln_g, ln_b).reshape(bsz, n // GM_CHUNK, GM_CHUNK, GM_GROUPS, GM_HALF // GM_GROUPS)
    v = jnp.einsum('gpq,bnqgc->bnpgc', w_s, v) + b_s.T[None, None, :, :, None]
    return (u * v.reshape(bsz, n, GM_HALF)) @ w_out


def ec_moe(h, w_router, w_gate, w_up, w_down):
    n, d = h.shape[1], h.shape[2]
    cap = max(1, EC_FACTOR * n // N_EXPERTS)
    aff = jax.nn.softmax((h @ w_router).astype(jnp.float32), axis=-1)
    gate, idx = lax.top_k(jnp.swapaxes(aff, 1, 2), cap)
    xe = jax.vmap(lambda hb, ib: hb[ib])(h, idx)
    hid = jax.nn.silu(jnp.einsum('becd,edf->becf', xe, w_gate)) * jnp.einsum('becd,edf->becf', xe, w_up)
    ye = jnp.einsum('becf,efd->becd', hid, w_down) * gate[..., None].astype(h.dtype)
    return jax.vmap(lambda yb, ib: jnp.zeros((n, d), yb.dtype).at[ib.reshape(-1)].add(yb.reshape(-1, d)))(ye, idx)


def setup_inputs(seed: int = 0) -> dict:
    key = jax.random.key(seed)
    ks = iter(jax.random.split(key, 32))
    nrm = lambda shape, scale: jax.random.normal(next(ks), shape, jnp.float32) * scale
    d = D_MODEL
    ne, no = (DEPTH + 1) // 2, DEPTH // 2
    f_bias = jnp.linspace(3.0, 6.0, LSTM_HEADS)
    zh = jnp.zeros((LSTM_HEADS,), jnp.float32)
    gate_base = jnp.concatenate([zh, f_bias, zh, f_bias])
    return {
        'x': nrm((BATCH, SEQ, d), 1.0),
        'c': nrm((BATCH, d), 1.0),
        'ctx': nrm((BATCH, CTX_LEN, d), 1.0),
        'c_ctx': nrm((d,), 1.0),
        'w_mod': nrm((DEPTH, d, 6 * d), 0.25 * d ** -0.5),
        'b_mod': nrm((DEPTH, 6 * d), 0.01),
        'norm_mix_g': 1.0 + nrm((DEPTH, d), 0.01),
        'norm_ffn_g': 1.0 + nrm((DEPTH, d), 0.01),
        'final_norm_g': 1.0 + nrm((d,), 0.01),
        'ab_w_in': nrm((ne, d, AB_IN), d ** -0.5),
        'ab_conv_w': nrm((ne, LSTM_CONV, 2 * LSTM_WIDTH), LSTM_CONV ** -0.5),
        'ab_gate_b': gate_base + nrm((ne, 4 * LSTM_HEADS), 0.1),
        'ab_head_g': 1.0 + nrm((ne, LSTM_WIDTH), 0.01),
        'ab_sink': nrm((ne, ATTN_HEADS), 0.5),
        'ab_w_out': nrm((ne, AB_MIX, d), AB_MIX ** -0.5),
        'gm_w_in': nrm((no, d, 2 * GM_HALF), d ** -0.5),
        'gm_ln_g': 1.0 + nrm((no, GM_HALF), 0.01),
        'gm_ln_b': nrm((no, GM_HALF), 0.01),
        'gm_w_s': nrm((no, GM_GROUPS, GM_CHUNK, GM_CHUNK), GM_CHUNK ** -0.5),
        'gm_b_s': 1.0 + nrm((no, GM_GROUPS, GM_CHUNK), 0.01),
        'gm_w_out': nrm((no, GM_HALF, d), GM_HALF ** -0.5),
        'moe_w_router': nrm((DEPTH, d, N_EXPERTS), d ** -0.5),
        'moe_w_gate': nrm((DEPTH, N_EXPERTS, d, D_EXPERT), d ** -0.5),
        'moe_w_up': nrm((DEPTH, N_EXPERTS, d, D_EXPERT), d ** -0.5),
        'moe_w_down': nrm((DEPTH, N_EXPERTS, D_EXPERT, d), D_EXPERT ** -0.5),
    }


def reference(x, c, ctx, c_ctx, w_mod, b_mod, norm_mix_g, norm_ffn_g, final_norm_g,
              ab_w_in, ab_conv_w, ab_gate_b, ab_head_g, ab_sink, ab_w_out,
              gm_w_in, gm_ln_g, gm_ln_b, gm_w_s, gm_b_s, gm_w_out,
              moe_w_router, moe_w_gate, moe_w_up, moe_w_down):
    n = x.shape[1]
    cos, sin = axial_rope(n, ATTN_DIM)
    for layer in range(DEPTH):
        ctx_needed = any(j % 2 == 0 for j in range(layer + 1, DEPTH))
        even = layer % 2 == 0
        sh1, sc1, gt1, sh2, sc2, gt2 = adaln(c, w_mod[layer], b_mod[layer])
        if even or ctx_needed:
            csh1, csc1, cgt1, csh2, csc2, cgt2 = adaln(c_ctx, w_mod[layer], b_mod[layer])
        hx = modulate(x, norm_mix_g[layer], sh1, sc1)
        if even:
            e = layer // 2
            hc = modulate(ctx, norm_mix_g[layer], csh1, csc1)
            yx, yc = mixer_ab(hx, hc, ctx_needed, ab_w_in[e], ab_conv_w[e], ab_gate_b[e],
                              ab_head_g[e], ab_sink[e], ab_w_out[e], cos, sin)
        else:
            o = layer // 2
            gm = (gm_w_in[o], gm_ln_g[o], gm_ln_b[o], gm_w_s[o], gm_b_s[o], gm_w_out[o])
            yx = mixer_chunk_gmlp(hx, *gm)
            yc = mixer_chunk_gmlp(modulate(ctx, norm_mix_g[layer], csh1, csc1), *gm) if ctx_needed else None
        moe = (moe_w_router[layer], moe_w_gate[layer], moe_w_up[layer], moe_w_down[layer])
        x = x + gt1 * yx
        x = x + gt2 * ec_moe(modulate(x, norm_ffn_g[layer], sh2, sc2), *moe)
        if ctx_needed:
            ctx = ctx + cgt1 * yc
            ctx = ctx + cgt2 * ec_moe(modulate(ctx, norm_ffn_g[layer], csh2, csc2), *moe)
    return rmsnorm(x, final_norm_g)
```

```cpp
#include <hip/hip_runtime.h>
#include <hip/hip_cooperative_groups.h>
#include <cstdio>
namespace cg = cooperative_groups;

#define DI __device__ __forceinline__
typedef unsigned short bf16_t;
using bf16x8 = __attribute__((ext_vector_type(8))) short;
using s16x4 = __attribute__((ext_vector_type(4))) short;
using f32x16 = __attribute__((ext_vector_type(16))) float;
#define MFMA(a, b, c) __builtin_amdgcn_mfma_f32_32x32x16_bf16((a), (b), (c), 0, 0, 0)

#ifndef COOP
#define COOP 1
#endif

constexpr int DM = 1024, NBAT = 2, SEQ = 8192, NTOK = NBAT * SEQ, CTXL = 256, NROW = NTOK + NBAT * CTXL;
constexpr int PLD = 2816;
constexpr int NSTEP = 66;
constexpr float EPS = 1e-6f;

constexpr size_t al256(size_t x) { return (x + 255) & ~(size_t)255; }
constexpr size_t O_WIN = 0;
constexpr size_t O_WOUT = O_WIN + al256((size_t)PLD * 1024 * 2);
constexpr size_t O_GMIN = O_WOUT + al256((size_t)1024 * 1024 * 2);
constexpr size_t O_GMOUT = O_GMIN + al256((size_t)4096 * 1024 * 2);
constexpr size_t O_MGU = O_GMOUT + al256((size_t)1024 * 2048 * 2);
constexpr size_t O_MD = O_MGU + al256((size_t)16 * 2048 * 1024 * 2);
constexpr size_t O_MODV = O_MD + al256((size_t)16 * 1024 * 1024 * 2);
constexpr size_t O_HA = O_MODV + al256((size_t)2 * 3 * 6144 * 4);
constexpr size_t O_GL = O_HA + al256((size_t)NROW * 1024 * 2);
constexpr size_t O_AFF = O_GL + al256((size_t)NROW * 16 * 4);
constexpr size_t O_IDX = O_AFF + al256((size_t)32 * 8192 * 4);
constexpr size_t O_GATE = O_IDX + al256((size_t)32 * 1024 * 4);
constexpr size_t O_STATS = O_GATE + al256((size_t)32 * 1024 * 4);
constexpr size_t O_GSC = O_STATS + al256((size_t)NTOK * 2 * 4);
constexpr size_t O_MLOC = O_GSC + al256((size_t)16 * NSTEP * 4);
constexpr size_t O_DN = O_MLOC + al256((size_t)16 * NSTEP * 4);
constexpr size_t O_NST = O_DN + al256((size_t)16 * NSTEP * 128 * 4);
constexpr size_t O_MST = O_NST + al256((size_t)16 * 64 * 128 * 4);
constexpr size_t O_R12 = O_MST + al256((size_t)16 * 64 * 4);
constexpr size_t O_P = O_R12;
constexpr size_t O_QC = O_P + al256((size_t)NROW * PLD * 2);
constexpr size_t O_KC = O_QC + al256((size_t)NTOK * 512 * 2);
constexpr size_t O_KT = O_KC + al256((size_t)NTOK * 512 * 2);
constexpr size_t O_VT = O_KT + al256((size_t)132 * 4 * 128 * 128 * 2);
constexpr size_t O_RQ = O_VT + al256((size_t)132 * 4 * 128 * 128 * 2);
constexpr size_t O_RK = O_RQ + al256((size_t)NTOK * 512 * 2);
constexpr size_t O_AVTX = O_RK + al256((size_t)NROW * 128 * 2);
constexpr size_t O_AVTC = O_AVTX + al256((size_t)4 * 64 * 8192 * 2);
constexpr size_t O_R12_END = O_AVTC + al256((size_t)4 * 64 * 256 * 2);
constexpr size_t O_HID = O_R12;
constexpr size_t O_U = O_R12;
constexpr size_t O_GVT = O_U + al256((size_t)NTOK * 2048 * 2);
static_assert(O_GVT + (size_t)NTOK * 2048 * 2 <= O_R12_END, "R12 too small");
constexpr size_t O_DC = O_R12_END;
constexpr size_t O_CST = O_DC + al256((size_t)16 * NSTEP * 16384 * 4);
constexpr size_t O_UV = O_DC;
constexpr size_t WS_NEED = O_CST + al256((size_t)16 * 64 * 16384 * 2);

struct Params {
  const float *x, *c, *ctx, *c_ctx, *w_mod, *b_mod, *norm_mix_g, *norm_ffn_g, *final_norm_g;
  const float *ab_w_in, *ab_conv_w, *ab_gate_b, *ab_head_g, *ab_sink, *ab_w_out;
  const float *gm_w_in, *gm_ln_g, *gm_ln_b, *gm_w_s, *gm_b_s, *gm_w_out;
  const float *moe_w_router, *moe_w_gate, *moe_w_up, *moe_w_down;
  float* out;
  char* ws;
};

DI bf16_t f2bf(float x) { unsigned u = __float_as_uint(x); u += 0x7fffu + ((u >> 16) & 1u); return (bf16_t)(u >> 16); }
DI float bf2f(bf16_t b) { return __uint_as_float(((unsigned)b) << 16); }
DI unsigned pack2(float a, float b) { return (unsigned)f2bf(a) | ((unsigned)f2bf(b) << 16); }
DI bf16x8 pack8(float a0, float a1, float a2, float a3, float a4, float a5, float a6, float a7) {
  uint4 u; u.x = pack2(a0, a1); u.y = pack2(a2, a3); u.z = pack2(a4, a5); u.w = pack2(a6, a7);
  return __builtin_bit_cast(bf16x8, u);
}
DI bf16x8 ldfrag(const bf16_t* p) { return *(const bf16x8*)p; }
DI bf16x8 ldfrag2(const bf16_t* p0, const bf16_t* p1) {
  s16x4 lo = *(const s16x4*)p0, hi = *(const s16x4*)p1;
  return __builtin_shufflevector(lo, hi, 0, 1, 2, 3, 4, 5, 6, 7);
}
DI int crow(int i, int hh) { return (i & 3) + 8 * (i >> 2) + 4 * hh; }
DI float siluf(float x) { return x / (1.f + __expf(-x)); }
DI float sigmf(float x) { return 1.f / (1.f + __expf(-x)); }
DI float logsigf(float x) { return fminf(x, 0.f) - log1pf(expf(-fabsf(x))); }
DI float geluf(float x) { float u = 0.7978845608028654f * (x + 0.044715f * x * x * x); return 0.5f * x * (1.f + tanhf(u)); }
DI float wsum(float v) {
#pragma unroll
  for (int o = 32; o > 0; o >>= 1) v += __shfl_xor(v, o);
  return v;
}
DI f32x16 fzero() { f32x16 z; for (int i = 0; i < 16; ++i) z[i] = 0.f; return z; }

DI int tmap(int kind, int n) {
  if (kind == 0) return n;
  if (kind == 1) return n < 2048 ? n : (n < 2064 ? -1 : n - 16);
  int r = (n >> 6) * 128 + ((n >> 5) & 1) * 64 + (n & 31);
  return kind == 2 ? r : r + 32;
}
DI void tconv(const float* __restrict__ src, int ldn, int ncols, int K, int nmat, size_t sstride,
              bf16_t* __restrict__ dst, size_t dstride, int kind, char* smem) {
  float* sm = (float*)smem;
  const int t = threadIdx.x;
  const int ntn = (ncols + 63) >> 6, ntk = K >> 6, per = ntn * ntk;
  for (int tile = blockIdx.x; tile < per * nmat; tile += gridDim.x) {
    const int mat = tile / per, tt = tile % per;
    const int k0 = (tt / ntn) * 64, n0 = (tt % ntn) * 64;
    const float* s = src + (size_t)mat * sstride;
    bf16_t* d = dst + (size_t)mat * dstride;
    const int c4 = t & 15, rr = t >> 4;
#pragma unroll
    for (int i = 0; i < 4; ++i) {
      const int kr = rr + 16 * i, n = n0 + c4 * 4;
      float4 v = make_float4(0.f, 0.f, 0.f, 0.f);
      if (n < ncols) v = *(const float4*)(s + (size_t)(k0 + kr) * ldn + n);
      sm[kr * 65 + c4 * 4 + 0] = v.x; sm[kr * 65 + c4 * 4 + 1] = v.y; sm[kr * 65 + c4 * 4 + 2] = v.z; sm[kr * 65 + c4 * 4 + 3] = v.w;
    }
    __syncthreads();
    const int nl = t >> 2, kq = t & 3, n = n0 + nl;
    if (n < ncols) {
      const int row = tmap(kind, n);
      if (row >= 0) {
        uint4 o0, o1;
        const float* q = sm + (kq * 16) * 65 + nl;
        o0.x = pack2(q[0 * 65], q[1 * 65]); o0.y = pack2(q[2 * 65], q[3 * 65]); o0.z = pack2(q[4 * 65], q[5 * 65]); o0.w = pack2(q[6 * 65], q[7 * 65]);
        o1.x = pack2(q[8 * 65], q[9 * 65]); o1.y = pack2(q[10 * 65], q[11 * 65]); o1.z = pack2(q[12 * 65], q[13 * 65]); o1.w = pack2(q[14 * 65], q[15 * 65]);
        uint4* dp = (uint4*)(d + (size_t)row * K + k0 + kq * 16);
        dp[0] = o0; dp[1] = o1;
      }
    }
    __syncthreads();
  }
}
DI void tconv_moe(const Params& p, int layer, char* smem) {
  const size_t wo = (size_t)layer * 16 * 1024 * 1024;
  tconv(p.moe_w_gate + wo, 1024, 1024, 1024, 16, (size_t)1024 * 1024, (bf16_t*)(p.ws + O_MGU), (size_t)2048 * 1024, 2, smem);
  tconv(p.moe_w_up + wo, 1024, 1024, 1024, 16, (size_t)1024 * 1024, (bf16_t*)(p.ws + O_MGU), (size_t)2048 * 1024, 3, smem);
  tconv(p.moe_w_down + wo, 1024, 1024, 1024, 16, (size_t)1024 * 1024, (bf16_t*)(p.ws + O_MD), (size_t)1024 * 1024, 0, smem);
}

DI void phase_adaln(const Params& p, char* smem) {
  float* sv = (float*)smem;
  float* red = sv + 3 * 1024;
  float* modv = (float*)(p.ws + O_MODV);
  const int t = threadIdx.x;
  if (blockIdx.x >= 192) return;
  for (int i = t; i < 3 * 1024; i += 256) {
    const int v = i >> 10, k = i & 1023;
    const float cv = v < 2 ? p.c[v * 1024 + k] : p.c_ctx[k];
    sv[i] = siluf(cv);
  }
  __syncthreads();
  for (int item = blockIdx.x; item < 192; item += gridDim.x) {
    const int l = item / 96, cb = item % 96;
    const int cq = t & 15, kg = t >> 4;
    const float* w = p.w_mod + (size_t)l * 1024 * 6144 + cb * 64 + cq * 4;
    float a0[4] = {0.f, 0.f, 0.f, 0.f}, a1[4] = {0.f, 0.f, 0.f, 0.f}, a2[4] = {0.f, 0.f, 0.f, 0.f};
    for (int i = 0; i < 64; ++i) {
      const int k = kg + 16 * i;
      const float4 wv = *(const float4*)(w + (size_t)k * 6144);
      const float s0 = sv[k], s1 = sv[1024 + k], s2 = sv[2048 + k];
      a0[0] += s0 * wv.x; a0[1] += s0 * wv.y; a0[2] += s0 * wv.z; a0[3] += s0 * wv.w;
      a1[0] += s1 * wv.x; a1[1] += s1 * wv.y; a1[2] += s1 * wv.z; a1[3] += s1 * wv.w;
      a2[0] += s2 * wv.x; a2[1] += s2 * wv.y; a2[2] += s2 * wv.z; a2[3] += s2 * wv.w;
    }
#pragma unroll
    for (int j = 0; j < 4; ++j) {
      red[(kg * 3 + 0) * 64 + cq * 4 + j] = a0[j];
      red[(kg * 3 + 1) * 64 + cq * 4 + j] = a1[j];
      red[(kg * 3 + 2) * 64 + cq * 4 + j] = a2[j];
    }
    __syncthreads();
    if (t < 192) {
      const int v = t >> 6, col = t & 63;
      float s = 0.f;
      for (int g = 0; g < 16; ++g) s += red[(g * 3 + v) * 64 + col];
      const int cc = cb * 64 + col;
      modv[(l * 3 + v) * 6144 + cc] = s + p.b_mod[l * 6144 + cc];
    }
    __syncthreads();
  }
}

template <int MODE>
DI void phase_modulate(const Params& p, int layer, int which, char* smem) {
  float* wt = (float*)smem;
  const int t = threadIdx.x, lane = t & 63, w = t >> 6;
  const float* modv = (const float*)(p.ws + O_MODV);
  bf16_t* HA = (bf16_t*)(p.ws + O_HA);
  if (MODE != 0) {
    const float* W = MODE == 1 ? p.ab_w_in + 2048 : p.moe_w_router + (size_t)layer * 1024 * 16;
    const int ld = MODE == 1 ? 2832 : 16;
    for (int i = t; i < 4096; i += 256) {
      const int k = i >> 2, e4 = i & 3;
      const float4 v = *(const float4*)(W + (size_t)k * ld + e4 * 4);
      wt[(e4 * 4 + 0) * 1024 + k] = v.x; wt[(e4 * 4 + 1) * 1024 + k] = v.y; wt[(e4 * 4 + 2) * 1024 + k] = v.z; wt[(e4 * 4 + 3) * 1024 + k] = v.w;
    }
    __syncthreads();
  }
  const float* gn = (which == 0 ? p.norm_mix_g : p.norm_ffn_g) + layer * 1024;
  const int nrows = MODE == 1 ? NROW : NTOK;
  for (int row = blockIdx.x * 4 + w; row < nrows; row += gridDim.x * 4) {
    const float* src; int v;
    if (MODE == 1) {
      if (row < NTOK) { src = p.x + (size_t)row * 1024; v = row >> 13; }
      else { src = p.ctx + (size_t)(row - NTOK) * 1024; v = 2; }
    } else { src = p.out + (size_t)row * 1024; v = row >> 13; }
    const float* sh = modv + (layer * 3 + v) * 6144 + (which ? 3 : 0) * 1024;
    const float* sc = sh + 1024;
    float4 xv[4];
    float ss = 0.f;
#pragma unroll
    for (int i = 0; i < 4; ++i) {
      xv[i] = *(const float4*)(src + (i * 64 + lane) * 4);
      ss += xv[i].x * xv[i].x + xv[i].y * xv[i].y + xv[i].z * xv[i].z + xv[i].w * xv[i].w;
    }
    ss = wsum(ss);
    const float rstd = rsqrtf(ss * (1.f / 1024.f) + EPS);
    float4 yv[4];
#pragma unroll
    for (int i = 0; i < 4; ++i) {
      const int col = (i * 64 + lane) * 4;
      const float4 g4 = *(const float4*)(gn + col), s4 = *(const float4*)(sh + col), c4 = *(const float4*)(sc + col);
      float4 y;
      y.x = xv[i].x * rstd * g4.x * (1.f + c4.x) + s4.x;
      y.y = xv[i].y * rstd * g4.y * (1.f + c4.y) + s4.y;
      y.z = xv[i].z * rstd * g4.z * (1.f + c4.z) + s4.z;
      y.w = xv[i].w * rstd * g4.w * (1.f + c4.w) + s4.w;
      yv[i] = y;
      uint2 o; o.x = pack2(y.x, y.y); o.y = pack2(y.z, y.w);
      *(uint2*)(HA + (size_t)row * 1024 + col) = o;
    }
    if (MODE != 0) {
      float mine = 0.f;
#pragma unroll 1
      for (int e = 0; e < 16; ++e) {
        float pe = 0.f;
#pragma unroll
        for (int i = 0; i < 4; ++i) {
          const float4 w4 = *(const float4*)(wt + e * 1024 + (i * 64 + lane) * 4);
          pe += yv[i].x * w4.x + yv[i].y * w4.y + yv[i].z * w4.z + yv[i].w * w4.w;
        }
        pe = wsum(pe);
        if ((lane & 15) == e) mine = pe;
      }
      const int e = lane & 15;
      if (MODE == 1) {
        float val = mine + p.ab_gate_b[e];
        if (((e >> 2) & 1) == 1) val = logsigf(val);
        if (lane < 16) ((float*)(p.ws + O_GL))[(size_t)row * 16 + lane] = val;
      } else {
        float mx = mine;
#pragma unroll
        for (int o = 8; o > 0; o >>= 1) mx = fmaxf(mx, __shfl_xor(mx, o));
        const float ex = expf(mine - mx);
        float sum = ex;
#pragma unroll
        for (int o = 8; o > 0; o >>= 1) sum += __shfl_xor(sum, o);
        if (lane < 16) ((float*)(p.ws + O_AFF))[((size_t)(row >> 13) * 16 + lane) * 8192 + (row & 8191)] = ex / sum;
      }
    }
  }
}

template <class Epi>
DI void gemm_tile(const bf16_t* (&ap)[4], const bf16_t* (&bp)[4], int K, char* smem, Epi&& epi) {
  bf16_t* sA = (bf16_t*)smem;
  bf16_t* sB = sA + 2 * 128 * 72;
  const int t = threadIdx.x, lane = t & 63, w = t >> 6, wm = w >> 1, wn = w & 1, r = lane & 31, hh = lane >> 5;
  const int lrow = t >> 3, lcol = (t & 7) * 8;
  f32x16 acc[2][2];
#pragma unroll
  for (int i = 0; i < 2; ++i)
#pragma unroll
    for (int j = 0; j < 2; ++j) acc[i][j] = fzero();
  uint4 ra[4], rb[4];
#pragma unroll
  for (int i = 0; i < 4; ++i) { ra[i] = *(const uint4*)(ap[i]); rb[i] = *(const uint4*)(bp[i]); }
#pragma unroll
  for (int i = 0; i < 4; ++i) {
    *(uint4*)(sA + (lrow + 32 * i) * 72 + lcol) = ra[i];
    *(uint4*)(sB + (lrow + 32 * i) * 72 + lcol) = rb[i];
  }
  __syncthreads();
  const int KT = K >> 6;
  for (int kt = 0; kt < KT; ++kt) {
    const int cur = kt & 1;
    if (kt + 1 < KT) {
#pragma unroll
      for (int i = 0; i < 4; ++i) { ra[i] = *(const uint4*)(ap[i] + (kt + 1) * 64); rb[i] = *(const uint4*)(bp[i] + (kt + 1) * 64); }
    }
    const bf16_t* cA = sA + cur * 128 * 72 + (wm * 64 + r) * 72 + hh * 8;
    const bf16_t* cB = sB + cur * 128 * 72 + (wn * 64 + r) * 72 + hh * 8;
#pragma unroll
    for (int ks = 0; ks < 4; ++ks) {
      const bf16x8 a0 = *(const bf16x8*)(cA + ks * 16), a1 = *(const bf16x8*)(cA + 32 * 72 + ks * 16);
      const bf16x8 b0 = *(const bf16x8*)(cB + ks * 16), b1 = *(const bf16x8*)(cB + 32 * 72 + ks * 16);
      acc[0][0] = MFMA(a0, b0, acc[0][0]);
      acc[0][1] = MFMA(a0, b1, acc[0][1]);
      acc[1][0] = MFMA(a1, b0, acc[1][0]);
      acc[1][1] = MFMA(a1, b1, acc[1][1]);
    }
    if (kt + 1 < KT) {
      bf16_t* nA = sA + (cur ^ 1) * 128 * 72;
      bf16_t* nB = sB + (cur ^ 1) * 128 * 72;
#pragma unroll
      for (int i = 0; i < 4; ++i) {
        *(uint4*)(nA + (lrow + 32 * i) * 72 + lcol) = ra[i];
        *(uint4*)(nB + (lrow + 32 * i) * 72 + lcol) = rb[i];
      }
    }
    __syncthreads();
  }
  epi(acc, wm * 64, wn * 64, r, hh);
}

template <class MakeEpi>
DI void gemm_dense(const bf16_t* A, const bf16_t* Bt, int M, int N, int K, char* smem, MakeEpi&& mk) {
  const int t = threadIdx.x, lrow = t >> 3, lcol = (t & 7) * 8;
  const int ntn = N >> 7, ntm = M >> 7;
  for (int tile = blockIdx.x; tile < ntn * ntm; tile += gridDim.x) {
    const int mt = tile / ntn, nt = tile % ntn;
    const bf16_t* ap[4]; const bf16_t* bp[4];
#pragma unroll
    for (int i = 0; i < 4; ++i) {
      ap[i] = A + (size_t)(mt * 128 + lrow + 32 * i) * K + lcol;
      bp[i] = Bt + (size_t)(nt * 128 + lrow + 32 * i) * K + lcol;
    }
    gemm_tile(ap, bp, K, smem, mk(mt * 128, nt * 128));
  }
}

DI void phase_prep2(const Params& p, char* smem) {
  bf16_t* T = (bf16_t*)smem;
  const bf16_t* P = (const bf16_t*)(p.ws + O_P);
  bf16_t* Qc = (bf16_t*)(p.ws + O_QC); bf16_t* Kc = (bf16_t*)(p.ws + O_KC);
  bf16_t* KT = (bf16_t*)(p.ws + O_KT); bf16_t* VT = (bf16_t*)(p.ws + O_VT);
  bf16_t* RQ = (bf16_t*)(p.ws + O_RQ); bf16_t* RK = (bf16_t*)(p.ws + O_RK);
  bf16_t* AVTX = (bf16_t*)(p.ws + O_AVTX); bf16_t* AVTC = (bf16_t*)(p.ws + O_AVTC);
  const int t = threadIdx.x;
  for (int item = blockIdx.x; item < 132 * 6; item += gridDim.x) {
    const int sc = item / 6, part = item % 6;
    const bool isx = sc < 128;
    const int row0 = sc * 128;
    const int seq_lo = isx ? (sc >> 6) * 8192 : NTOK + ((sc - 128) >> 1) * 256;
    const int seq_hi = seq_lo + (isx ? 8192 : 256);
    if (part < 4) {
      const int h = part;
      const int col8 = t & 15, rsub = t >> 4;
      for (int pass = 0; pass < 3; ++pass) {
        if (pass == 2 && !isx) break;
        const int pcol = (pass == 0 ? 512 : (pass == 1 ? 1024 : 0)) + h * 128 + col8 * 8;
        float cw[5][8];
        if (pass != 1) {
#pragma unroll
          for (int j = 0; j < 5; ++j)
#pragma unroll
            for (int e = 0; e < 8; ++e) cw[j][e] = p.ab_conv_w[j * 1024 + (pass == 0 ? 512 : 0) + h * 128 + col8 * 8 + e];
        }
        for (int i = 0; i < 8; ++i) {
          const int rl = rsub + 16 * i, row = row0 + rl;
          uint4 o;
          if (pass == 1) {
            o = *(const uint4*)(P + (size_t)row * PLD + pcol);
          } else {
            float a[8];
#pragma unroll
            for (int e = 0; e < 8; ++e) a[e] = 0.f;
#pragma unroll
            for (int j = 0; j < 5; ++j) {
              const int rr = row + j - 2;
              if (rr >= seq_lo && rr < seq_hi) {
                const bf16x8 v = *(const bf16x8*)(P + (size_t)rr * PLD + pcol);
#pragma unroll
                for (int e = 0; e < 8; ++e) a[e] += cw[j][e] * bf2f((bf16_t)v[e]);
              }
            }
            const float scl = pass == 0 ? 0.08838834764831845f : 1.f;
#pragma unroll
            for (int e = 0; e < 8; ++e) a[e] = siluf(a[e]) * scl;
            o.x = pack2(a[0], a[1]); o.y = pack2(a[2], a[3]); o.z = pack2(a[4], a[5]); o.w = pack2(a[6], a[7]);
            if (isx) *(uint4*)((pass == 0 ? Kc : Qc) + (size_t)row * 512 + h * 128 + col8 * 8) = o;
          }
          if (pass < 2) *(uint4*)(T + rl * 136 + col8 * 8) = o;
        }
        if (pass < 2) {
          __syncthreads();
          bf16_t* dstT = (pass == 0 ? KT : VT) + (size_t)(sc * 4 + h) * 16384;
          const int d = t & 127, shf = t >> 7;
#pragma unroll
          for (int s8 = 0; s8 < 8; ++s8) {
            const bf16_t* q = T + (shf * 64 + s8 * 8) * 136 + d;
            uint4 o;
            o.x = (unsigned)q[0] | ((unsigned)q[136] << 16); o.y = (unsigned)q[2 * 136] | ((unsigned)q[3 * 136] << 16);
            o.z = (unsigned)q[4 * 136] | ((unsigned)q[5 * 136] << 16); o.w = (unsigned)q[6 * 136] | ((unsigned)q[7 * 136] << 16);
            *(uint4*)(dstT + d * 128 + shf * 64 + s8 * 8) = o;
          }
          __syncthreads();
        }
      }
    } else if (part == 4) {
      if (!isx) continue;
      for (int idx = t; idx < 512; idx += 256) {
        const int rl = idx >> 2, dc = idx & 3, row = row0 + rl, pos = row - seq_lo;
        const float rp = (float)(pos >> 6), cp = (float)(pos & 63);
        float cs[8], sn[8];
#pragma unroll
        for (int e = 0; e < 8; ++e) {
          const int a = dc * 8 + e;
          const float inv = powf(10000.f, -(float)(a & 15) / 16.f);
          const float ang = (a < 16 ? rp : cp) * inv;
          cs[e] = cosf(ang); sn[e] = sinf(ang);
        }
        for (int hq = 0; hq < 8; ++hq) {
          const bf16x8 x1 = *(const bf16x8*)(P + (size_t)row * PLD + 2048 + hq * 64 + dc * 8);
          const bf16x8 x2 = *(const bf16x8*)(P + (size_t)row * PLD + 2048 + hq * 64 + 32 + dc * 8);
          float o1[8], o2[8];
#pragma unroll
          for (int e = 0; e < 8; ++e) {
            const float a = bf2f((bf16_t)x1[e]), b = bf2f((bf16_t)x2[e]);
            o1[e] = (a * cs[e] - b * sn[e]) * 0.125f; o2[e] = (b * cs[e] + a * sn[e]) * 0.125f;
          }
          uint4 u1, u2;
          u1.x = pack2(o1[0], o1[1]); u1.y = pack2(o1[2], o1[3]); u1.z = pack2(o1[4], o1[5]); u1.w = pack2(o1[6], o1[7]);
          u2.x = pack2(o2[0], o2[1]); u2.y = pack2(o2[2], o2[3]); u2.z = pack2(o2[4], o2[5]); u2.w = pack2(o2[6], o2[7]);
          *(uint4*)(RQ + (size_t)row * 512 + hq * 64 + dc * 8) = u1;
          *(uint4*)(RQ + (size_t)row * 512 + hq * 64 + 32 + dc * 8) = u2;
        }
      }
    } else {
      for (int idx = t; idx < 512; idx += 256) {
        const int rl = idx >> 2, dc = idx & 3, row = row0 + rl, pos = row - seq_lo;
        const float rp = (float)(pos >> 6), cp = (float)(pos & 63);
        float cs[8], sn[8];
#pragma unroll
        for (int e = 0; e < 8; ++e) {
          const int a = dc * 8 + e;
          const float inv = powf(10000.f, -(float)(a & 15) / 16.f);
          const float ang = (a < 16 ? rp : cp) * inv;
          cs[e] = isx ? cosf(ang) : 1.f; sn[e] = isx ? sinf(ang) : 0.f;
        }
        for (int g = 0; g < 2; ++g) {
          const bf16x8 x1 = *(const bf16x8*)(P + (size_t)row * PLD + 2560 + g * 64 + dc * 8);
          const bf16x8 x2 = *(const bf16x8*)(P + (size_t)row * PLD + 2560 + g * 64 + 32 + dc * 8);
          float o1[8], o2[8];
#pragma unroll
          for (int e = 0; e < 8; ++e) {
            const float a = bf2f((bf16_t)x1[e]), b = bf2f((bf16_t)x2[e]);
            o1[e] = a * cs[e] - b * sn[e]; o2[e] = b * cs[e] + a * sn[e];
          }
          uint4 u1, u2;
          u1.x = pack2(o1[0], o1[1]); u1.y = pack2(o1[2], o1[3]); u1.z = pack2(o1[4], o1[5]); u1.w = pack2(o1[6], o1[7]);
          u2.x = pack2(o2[0], o2[1]); u2.y = pack2(o2[2], o2[3]); u2.z = pack2(o2[4], o2[5]); u2.w = pack2(o2[6], o2[7]);
          *(uint4*)(RK + (size_t)row * 128 + g * 64 + dc * 8) = u1;
          *(uint4*)(RK + (size_t)row * 128 + g * 64 + 32 + dc * 8) = u2;
        }
      }
      {
        const int col8 = t & 15, rsub = t >> 4;
        for (int i = 0; i < 8; ++i) {
          const int rl = rsub + 16 * i;
          *(uint4*)(T + rl * 136 + col8 * 8) = *(const uint4*)(P + (size_t)(row0 + rl) * PLD + 2688 + col8 * 8);
        }
        __syncthreads();
        const int d = t & 127, shf = t >> 7;
        const int b = isx ? (sc >> 6) : ((sc - 128) >> 1);
        const int pos0 = row0 - seq_lo;
        bf16_t* dst = isx ? AVTX + ((size_t)(b * 2 + (d >> 6)) * 64 + (d & 63)) * 8192 + pos0
                          : AVTC + ((size_t)(b * 2 + (d >> 6)) * 64 + (d & 63)) * 256 + pos0;
#pragma unroll
        for (int s8 = 0; s8 < 8; ++s8) {
          const bf16_t* q = T + (shf * 64 + s8 * 8) * 136 + d;
          uint4 o;
          o.x = (unsigned)q[0] | ((unsigned)q[136] << 16); o.y = (unsigned)q[2 * 136] | ((unsigned)q[3 * 136] << 16);
          o.z = (unsigned)q[4 * 136] | ((unsigned)q[5 * 136] << 16); o.w = (unsigned)q[6 * 136] | ((unsigned)q[7 * 136] << 16);
          *(uint4*)(dst + shf * 64 + s8 * 8) = o;
        }
        __syncthreads();
      }
    }
  }
}

DI void attn_item(const Params& p, int item) {
  const int g = item & 1, qb = (item >> 1) & 255, b = item >> 9;
  const int t = threadIdx.x, lane = t & 63, w = t >> 6, r = lane & 31, hh = lane >> 5;
  const int hq = g * 4 + w, q0 = qb * 32;
  const bf16_t* RQ = (const bf16_t*)(p.ws + O_RQ); const bf16_t* RK = (const bf16_t*)(p.ws + O_RK);
  const bf16_t* AVTX = (const bf16_t*)(p.ws + O_AVTX); const bf16_t* AVTC = (const bf16_t*)(p.ws + O_AVTC);
  bf16_t* MIX = (bf16_t*)(p.ws + O_HA);
  const size_t qrow = (size_t)b * 8192 + q0 + r;
  bf16x8 qf[4];
#pragma unroll
  for (int ks = 0; ks < 4; ++ks) qf[ks] = ldfrag(RQ + qrow * 512 + hq * 64 + ks * 16 + hh * 8);
  float m = p.ab_sink[hq], l = hh == 0 ? 1.f : 0.f;
  f32x16 o0 = fzero(), o1 = fzero();
  const int ipos = q0 + r;
  for (int tile = 0; tile < 17; ++tile) {
    const bf16_t* kbase; const bf16_t* vbase; int vld, k0; bool local;
    if (tile < 9) {
      k0 = q0 - 128 + tile * 32;
      if (k0 < 0 || k0 >= 8192) continue;
      kbase = RK + (size_t)(b * 8192 + k0) * 128 + g * 64;
      vbase = AVTX + (size_t)((b * 2 + g) * 64) * 8192 + k0; vld = 8192; local = true;
    } else {
      k0 = (tile - 9) * 32;
      kbase = RK + (size_t)(NTOK + b * 256 + k0) * 128 + g * 64;
      vbase = AVTC + (size_t)((b * 2 + g) * 64) * 256 + k0; vld = 256; local = false;
    }
    f32x16 s = fzero();
#pragma unroll
    for (int ks = 0; ks < 4; ++ks) s = MFMA(ldfrag(kbase + r * 128 + ks * 16 + hh * 8), qf[ks], s);
    float tmax = -INFINITY;
#pragma unroll
    for (int i = 0; i < 16; ++i) {
      const int dj = ipos - (k0 + crow(i, hh));
      const bool ok = !local || (dj <= 128 && dj >= -128);
      s[i] = ok ? s[i] : -INFINITY;
      tmax = fmaxf(tmax, s[i]);
    }
    tmax = fmaxf(tmax, __shfl_xor(tmax, 32));
    const float mn = fmaxf(m, tmax), corr = __expf(m - mn);
    m = mn; l *= corr;
#pragma unroll
    for (int i = 0; i < 16; ++i) { o0[i] *= corr; o1[i] *= corr; }
#pragma unroll
    for (int i = 0; i < 16; ++i) { s[i] = __expf(s[i] - mn); l += s[i]; }
#pragma unroll
    for (int s2 = 0; s2 < 2; ++s2) {
      const bf16x8 pf = pack8(s[8 * s2], s[8 * s2 + 1], s[8 * s2 + 2], s[8 * s2 + 3], s[8 * s2 + 4], s[8 * s2 + 5], s[8 * s2 + 6], s[8 * s2 + 7]);
      const bf16_t* v0 = vbase + (size_t)r * vld + 16 * s2 + 4 * hh;
      o0 = MFMA(ldfrag2(v0, v0 + 8), pf, o0);
      const bf16_t* v1 = v0 + (size_t)32 * vld;
      o1 = MFMA(ldfrag2(v1, v1 + 8), pf, o1);
    }
  }
  l += __shfl_xor(l, 32);
  const float inv = 1.f / l;
  bf16_t* dst = MIX + qrow * 1024 + 512 + hq * 64;
#pragma unroll
  for (int q4 = 0; q4 < 4; ++q4) {
    const int d = 8 * q4 + 4 * hh;
    uint2 u;
    u.x = pack2(o0[4 * q4] * inv, o0[4 * q4 + 1] * inv); u.y = pack2(o0[4 * q4 + 2] * inv, o0[4 * q4 + 3] * inv);
    *(uint2*)(dst + d) = u;
    u.x = pack2(o1[4 * q4] * inv, o1[4 * q4 + 1] * inv); u.y = pack2(o1[4 * q4 + 2] * inv, o1[4 * q4 + 3] * inv);
    *(uint2*)(dst + 32 + d) = u;
  }
}

DI void mlstm_local_item(const Params& p, int item, char* smem) {
  float* gs = (float*)smem;
  float* wv = gs + 512;
  float* msc = wv + 256;
  const int t = threadIdx.x, lane = t & 63, w = t >> 6, wm = w >> 1, wn = w & 1, r = lane & 31, hh = lane >> 5;
  const int bh = item / NSTEP, nc = item % NSTEP, b = bh >> 2, h = bh & 3;
  const int sc = nc < 2 ? 128 + b * 2 + nc : b * 64 + (nc - 2);
  const int row0 = sc * 128;
  const float* GL = (const float*)(p.ws + O_GL);
  const bf16_t* KT = (const bf16_t*)(p.ws + O_KT) + (size_t)(sc * 4 + h) * 16384;
  const bf16_t* VT = (const bf16_t*)(p.ws + O_VT) + (size_t)(sc * 4 + h) * 16384;
  for (int i = t; i < 512; i += 256) { const int ty = i >> 7, s = i & 127; gs[i] = GL[(size_t)(row0 + s) * 16 + ty * 4 + h]; }
  __syncthreads();
  {
    const int dir = t >> 7, s = t & 127;
    float wval, tot = 0.f;
    if (dir == 0) {
      float bsum = 0.f;
      for (int j = 0; j < 128; ++j) { const float f = gs[128 + j]; tot += f; if (j <= s) bsum += f; }
      wval = tot - bsum + gs[s];
    } else {
      float pre = 0.f;
      for (int j = 0; j < 128; ++j) { const float f = gs[384 + j]; tot += f; if (j < s) pre += f; }
      wval = pre + gs[256 + s];
    }
    wv[dir * 128 + s] = wval;
    if (s == 0) msc[dir] = tot;
  }
  __syncthreads();
  {
    const int dir = t >> 7, s = t & 127;
    float mx = -INFINITY;
    for (int j = 0; j < 128; ++j) mx = fmaxf(mx, wv[dir * 128 + j]);
    const float wval = wv[dir * 128 + s];
    __syncthreads();
    wv[dir * 128 + s] = expf(wval - mx);
    if (s == 0) msc[2 + dir] = mx;
  }
  __syncthreads();
  float* DC = (float*)(p.ws + O_DC);
#pragma unroll 1
  for (int d = 0; d < 2; ++d) {
    f32x16 acc[2][2];
#pragma unroll
    for (int i = 0; i < 2; ++i)
#pragma unroll
      for (int j = 0; j < 2; ++j) acc[i][j] = fzero();
#pragma unroll 2
    for (int ks = 0; ks < 8; ++ks) {
      const bf16x8 ra0 = ldfrag(VT + (wm * 64 + r) * 128 + ks * 16 + hh * 8);
      const bf16x8 ra1 = ldfrag(VT + (wm * 64 + 32 + r) * 128 + ks * 16 + hh * 8);
      const bf16x8 b0 = ldfrag(KT + (wn * 64 + r) * 128 + ks * 16 + hh * 8);
      const bf16x8 b1 = ldfrag(KT + (wn * 64 + 32 + r) * 128 + ks * 16 + hh * 8);
      const float* ww = wv + d * 128 + ks * 16 + hh * 8;
      const bf16x8 a0 = pack8(bf2f((bf16_t)ra0[0]) * ww[0], bf2f((bf16_t)ra0[1]) * ww[1], bf2f((bf16_t)ra0[2]) * ww[2], bf2f((bf16_t)ra0[3]) * ww[3],
                              bf2f((bf16_t)ra0[4]) * ww[4], bf2f((bf16_t)ra0[5]) * ww[5], bf2f((bf16_t)ra0[6]) * ww[6], bf2f((bf16_t)ra0[7]) * ww[7]);
      const bf16x8 a1 = pack8(bf2f((bf16_t)ra1[0]) * ww[0], bf2f((bf16_t)ra1[1]) * ww[1], bf2f((bf16_t)ra1[2]) * ww[2], bf2f((bf16_t)ra1[3]) * ww[3],
                              bf2f((bf16_t)ra1[4]) * ww[4], bf2f((bf16_t)ra1[5]) * ww[5], bf2f((bf16_t)ra1[6]) * ww[6], bf2f((bf16_t)ra1[7]) * ww[7]);
      acc[0][0] = MFMA(a0, b0, acc[0][0]);
      acc[0][1] = MFMA(a0, b1, acc[0][1]);
      acc[1][0] = MFMA(a1, b0, acc[1][0]);
      acc[1][1] = MFMA(a1, b1, acc[1][1]);
    }
    float* dst = DC + ((size_t)(bh * 2 + d) * NSTEP + nc) * 16384;
#pragma unroll
    for (int mi = 0; mi < 2; ++mi)
#pragma unroll
      for (int ni = 0; ni < 2; ++ni)
#pragma unroll
        for (int i = 0; i < 16; ++i)
          dst[(wm * 64 + mi * 32 + crow(i, hh)) * 128 + wn * 64 + ni * 32 + r] = acc[mi][ni][i];
  }
  {
    const int dir = t >> 7, k = t & 127;
    float s = 0.f;
    for (int s8 = 0; s8 < 16; ++s8) {
      const bf16x8 v = ldfrag(KT + k * 128 + s8 * 8);
#pragma unroll
      for (int e = 0; e < 8; ++e) s += wv[dir * 128 + s8 * 8 + e] * bf2f((bf16_t)v[e]);
    }
    ((float*)(p.ws + O_DN))[((size_t)(bh * 2 + dir) * NSTEP + nc) * 128 + k] = s;
    if (k == 0) {
      ((float*)(p.ws + O_GSC))[(bh * 2 + dir) * NSTEP + nc] = msc[dir];
      ((float*)(p.ws + O_MLOC))[(bh * 2 + dir) * NSTEP + nc] = msc[2 + dir];
    }
  }
  __syncthreads();
}

DI int chain_nc(int dir, int i) { return dir == 0 ? i : (i < 2 ? 1 - i : 67 - i); }
DI void phase_scan(const Params& p) {
  const float* GSC = (const float*)(p.ws + O_GSC); const float* MLOC = (const float*)(p.ws + O_MLOC);
  const float* DC = (const float*)(p.ws + O_DC); const float* DN = (const float*)(p.ws + O_DN);
  bf16_t* CST = (bf16_t*)(p.ws + O_CST); float* NST = (float*)(p.ws + O_NST); float* MST = (float*)(p.ws + O_MST);
  const int t = threadIdx.x;
  for (int item = blockIdx.x; item < 16 * 64 + 8; item += gridDim.x) {
    if (item < 1024) {
      const int chain = item >> 6, e = (item & 63) * 256 + t, dir = chain & 1;
      float m = 0.f, C = 0.f;
      for (int i = 0; i < NSTEP; ++i) {
        const int nc = chain_nc(dir, i);
        if (i >= 2) {
          CST[((size_t)chain * 64 + (nc - 2)) * 16384 + e] = f2bf(C);
          if (e == 0) MST[chain * 64 + nc - 2] = m;
        }
        const float g = GSC[chain * NSTEP + nc], ml = MLOC[chain * NSTEP + nc];
        const float mn = fmaxf(g + m, ml);
        C = expf(g + m - mn) * C + expf(ml - mn) * DC[((size_t)chain * NSTEP + nc) * 16384 + e];
        m = mn;
      }
    } else {
      const int idx = (item - 1024) * 256 + t;
      const int chain = idx >> 7, k = idx & 127, dir = chain & 1;
      float m = 0.f, n = 0.f;
      for (int i = 0; i < NSTEP; ++i) {
        const int nc = chain_nc(dir, i);
        if (i >= 2) NST[((size_t)chain * 64 + (nc - 2)) * 128 + k] = n;
        const float g = GSC[chain * NSTEP + nc], ml = MLOC[chain * NSTEP + nc];
        const float mn = fmaxf(g + m, ml);
        n = expf(g + m - mn) * n + expf(ml - mn) * DN[((size_t)chain * NSTEP + nc) * 128 + k];
        m = mn;
      }
    }
  }
}

DI void mlstm_out_item(const Params& p, int item, char* smem) {
  float* gs = (float*)smem;
  float* bb = gs + 512;
  float* lib = bb + 256;
  float* mrow = lib + 256;
  float* aT = mrow + 256;
  float* nq = aT + 256;
  float* nst = nq + 256;
  float* Hs = nst + 256;
  const int t = threadIdx.x, lane = t & 63, w = t >> 6, r = lane & 31, hh = lane >> 5;
  const int bh = item >> 6, c = item & 63, b = bh >> 2, h = bh & 3;
  const int sc = b * 64 + c, row0 = sc * 128;
  const float* GL = (const float*)(p.ws + O_GL);
  const bf16_t* Qc = (const bf16_t*)(p.ws + O_QC); const bf16_t* Kc = (const bf16_t*)(p.ws + O_KC);
  const bf16_t* VT = (const bf16_t*)(p.ws + O_VT) + (size_t)(sc * 4 + h) * 16384;
  const bf16_t* P = (const bf16_t*)(p.ws + O_P);
  const float* MST = (const float*)(p.ws + O_MST);
  bf16_t* MIX = (bf16_t*)(p.ws + O_HA);
  for (int i = t; i < 512; i += 256) { const int ty = i >> 7, s = i & 127; gs[i] = GL[(size_t)(row0 + s) * 16 + ty * 4 + h]; }
  {
    const int dir = t >> 7, k = t & 127;
    nst[t] = ((const float*)(p.ws + O_NST))[((size_t)(bh * 2 + dir) * 64 + c) * 128 + k];
  }
  __syncthreads();
  {
    const int dir = t >> 7, s = t & 127;
    float bsum = 0.f;
    if (dir == 0) { for (int j = 0; j <= s; ++j) bsum += gs[128 + j]; }
    else { for (int j = s; j < 128; ++j) bsum += gs[384 + j]; }
    bb[t] = bsum;
    lib[t] = gs[dir * 256 + s] - bsum;
    const bf16_t* qr = Qc + (size_t)(row0 + s) * 512 + h * 128;
    float acc = 0.f;
    for (int k8 = 0; k8 < 16; ++k8) {
      const bf16x8 v = ldfrag(qr + k8 * 8);
#pragma unroll
      for (int e = 0; e < 8; ++e) acc += nst[dir * 128 + k8 * 8 + e] * bf2f((bf16_t)v[e]);
    }
    nq[t] = acc;
  }
  __syncthreads();
  {
    const int dir = t >> 7, s = t & 127;
    float pm = -INFINITY;
    if (dir == 0) { for (int j = 0; j <= s; ++j) pm = fmaxf(pm, lib[j]); }
    else { for (int j = s; j < 128; ++j) pm = fmaxf(pm, lib[128 + j]); }
    const float m_in = MST[(bh * 2 + dir) * 64 + c];
    const float mr = bb[t] + fmaxf(m_in, pm);
    mrow[t] = mr;
    aT[t] = expf(bb[t] + m_in - mr);
  }
  __syncthreads();
  const int tl = w * 32 + r;
  const bf16_t* qrow = Qc + (size_t)(row0 + tl) * 512 + h * 128 + hh * 8;
#pragma unroll 1
  for (int dir = 0; dir < 2; ++dir) {
    const bf16_t* CST = (const bf16_t*)(p.ws + O_CST) + ((size_t)(bh * 2 + dir) * 64 + c) * 16384;
    const float bbt = bb[dir * 128 + tl], mrt = mrow[dir * 128 + tl], at = aT[dir * 128 + tl];
    float dsum = 0.f;
    const int sgn = dir == 0 ? 1 : -1;
    bf16x8 pf[8];
#pragma unroll
    for (int half = 0; half < 2; ++half) {
      f32x16 st[2];
      st[0] = fzero(); st[1] = fzero();
#pragma unroll 2
      for (int ks = 0; ks < 8; ++ks) {
        const bf16x8 qf = ldfrag(qrow + ks * 16);
#pragma unroll
        for (int r2 = 0; r2 < 2; ++r2)
          st[r2] = MFMA(ldfrag(Kc + (size_t)(row0 + (half * 2 + r2) * 32 + r) * 512 + h * 128 + ks * 16 + hh * 8), qf, st[r2]);
      }
#pragma unroll
      for (int r2 = 0; r2 < 2; ++r2) {
        const int rb = half * 2 + r2;
#pragma unroll
        for (int i = 0; i < 16; ++i) {
          const int s = rb * 32 + crow(i, hh);
          const int diff = (tl - s) * sgn;
          const float msk = (float)((unsigned)(~diff) >> 31);
          const float v = st[r2][i] * __expf(fminf(bbt + lib[dir * 128 + s] - mrt, 0.f)) * msk;
          st[r2][i] = v; dsum += v;
        }
        pf[rb * 2] = pack8(st[r2][0], st[r2][1], st[r2][2], st[r2][3], st[r2][4], st[r2][5], st[r2][6], st[r2][7]);
        pf[rb * 2 + 1] = pack8(st[r2][8], st[r2][9], st[r2][10], st[r2][11], st[r2][12], st[r2][13], st[r2][14], st[r2][15]);
      }
      __builtin_amdgcn_sched_barrier(0);
    }
    dsum += __shfl_xor(dsum, 32);
    const float den = dsum + at * nq[dir * 128 + tl];
    const float dinv = 1.f / fmaxf(fabsf(den), expf(-mrt));
#pragma unroll
    for (int half = 0; half < 2; ++half) {
      f32x16 ha[2];
      ha[0] = fzero(); ha[1] = fzero();
#pragma unroll 2
      for (int ks = 0; ks < 8; ++ks) {
        const bf16x8 qf = ldfrag(qrow + ks * 16);
#pragma unroll
        for (int r2 = 0; r2 < 2; ++r2)
          ha[r2] = MFMA(ldfrag(CST + ((half * 2 + r2) * 32 + r) * 128 + ks * 16 + hh * 8), qf, ha[r2]);
      }
#pragma unroll
      for (int r2 = 0; r2 < 2; ++r2)
#pragma unroll
        for (int i = 0; i < 16; ++i) ha[r2][i] *= at;
      __builtin_amdgcn_sched_barrier(0);
#pragma unroll
      for (int kk = 0; kk < 8; ++kk) {
#pragma unroll
        for (int r2 = 0; r2 < 2; ++r2) {
          const bf16_t* vp = VT + ((half * 2 + r2) * 32 + r) * 128 + kk * 16 + 4 * hh;
          ha[r2] = MFMA(ldfrag2(vp, vp + 8), pf[kk], ha[r2]);
        }
        if (kk == 3) __builtin_amdgcn_sched_barrier(0);
      }
#pragma unroll
      for (int r2 = 0; r2 < 2; ++r2)
#pragma unroll
        for (int i = 0; i < 16; ++i) {
          float* hp = Hs + ((half * 2 + r2) * 32 + crow(i, hh)) * 128 + tl;
          const float prev = dir == 0 ? 0.f : *hp;
          *hp = prev + ha[r2][i] * dinv;
        }
      __builtin_amdgcn_sched_barrier(0);
    }
  }
  float ss = 0.f;
#pragma unroll
  for (int rb = 0; rb < 4; ++rb)
#pragma unroll
    for (int i = 0; i < 16; ++i) { const float hv = Hs[(rb * 32 + crow(i, hh)) * 128 + tl]; ss += hv * hv; }
  ss += __shfl_xor(ss, 32);
  const float rn = rsqrtf(ss * (1.f / 128.f) + EPS);
  const size_t row = (size_t)row0 + tl;
#pragma unroll 1
  for (int rb = 0; rb < 4; ++rb)
#pragma unroll
    for (int q4 = 0; q4 < 4; ++q4) {
      const int v = rb * 32 + 8 * q4 + 4 * hh;
      const s16x4 ov = *(const s16x4*)(P + row * PLD + 1536 + h * 128 + v);
      const float4 hg = *(const float4*)(p.ab_head_g + h * 128 + v);
      const float y0 = Hs[(v + 0) * 128 + tl] * rn * hg.x * sigmf(bf2f((bf16_t)ov[0]));
      const float y1 = Hs[(v + 1) * 128 + tl] * rn * hg.y * sigmf(bf2f((bf16_t)ov[1]));
      const float y2 = Hs[(v + 2) * 128 + tl] * rn * hg.z * sigmf(bf2f((bf16_t)ov[2]));
      const float y3 = Hs[(v + 3) * 128 + tl] * rn * hg.w * sigmf(bf2f((bf16_t)ov[3]));
      uint2 u; u.x = pack2(y0, y1); u.y = pack2(y2, y3);
      *(uint2*)(MIX + row * 1024 + h * 128 + v) = u;
    }
  __syncthreads();
}

DI void phase_topk(const Params& p, char* smem) {
  unsigned* vals = (unsigned*)smem;
  unsigned* hist = vals + 8448;
  unsigned* cntg = hist + 256;
  unsigned* cnte = cntg + 256;
  unsigned* misc = cnte + 256;
  const float* AFF = (const float*)(p.ws + O_AFF);
  int* IDX = (int*)(p.ws + O_IDX); float* GATE = (float*)(p.ws + O_GATE);
  const int t = threadIdx.x;
  for (int item = blockIdx.x; item < 32; item += gridDim.x) {
    const float* a = AFF + (size_t)item * 8192;
    for (int i = t; i < 8192; i += 256) vals[i + (i >> 5)] = __float_as_uint(a[i]);
    unsigned prefix = 0, remaining = 1024;
    for (int pass = 0; pass < 4; ++pass) {
      const int shift = 24 - 8 * pass;
      hist[t] = 0;
      __syncthreads();
      const unsigned mask = pass == 0 ? 0u : (0xFFFFFFFFu << (shift + 8));
      for (int i = t; i < 8192; i += 256) {
        const unsigned u = vals[i + (i >> 5)];
        if ((u & mask) == (prefix & mask)) atomicAdd(&hist[(u >> shift) & 255], 1u);
      }
      __syncthreads();
      if (t == 0) {
        unsigned cum = 0; int sel = 0;
        for (int bin = 255; bin >= 0; --bin) {
          const unsigned cc = hist[bin];
          if (cum + cc >= remaining) { sel = bin; break; }
          cum += cc;
        }
        misc[0] = prefix | ((unsigned)sel << shift);
        misc[1] = remaining - cum;
      }
      __syncthreads();
      prefix = misc[0]; remaining = misc[1];
      __syncthreads();
    }
    const unsigned T = prefix, need_eq = remaining;
    unsigned cg_ = 0, ce = 0;
    for (int j = 0; j < 32; ++j) {
      const int n = t * 32 + j;
      const unsigned u = vals[n + (n >> 5)];
      cg_ += u > T; ce += u == T;
    }
    cntg[t] = cg_; cnte[t] = ce;
    __syncthreads();
    unsigned pg = 0, pe = 0;
    for (int j = 0; j < t; ++j) { pg += cntg[j]; pe += cnte[j]; }
    for (int j = 0; j < 32; ++j) {
      const int n = t * 32 + j;
      const unsigned u = vals[n + (n >> 5)];
      if (u > T) { IDX[item * 1024 + pg] = n; GATE[item * 1024 + pg] = __uint_as_float(u); ++pg; }
      else if (u == T) {
        if (pe < need_eq) { const unsigned slot = 1024 - need_eq + pe; IDX[item * 1024 + slot] = n; GATE[item * 1024 + slot] = __uint_as_float(u); }
        ++pe;
      }
    }
    __syncthreads();
  }
}

DI void phase_stats(const Params& p, char* smem) {
  float* red = (float*)smem;
  const bf16_t* GVT = (const bf16_t*)(p.ws + O_GVT);
  float* STATS = (float*)(p.ws + O_STATS);
  const int t = threadIdx.x, qq = t & 31, cg_ = t >> 5;
  for (int chunk = blockIdx.x; chunk < 128; chunk += gridDim.x) {
    const bf16_t* base = GVT + (size_t)chunk * 2048 * 128 + qq * 4;
    float s[4] = {0.f, 0.f, 0.f, 0.f}, s2[4] = {0.f, 0.f, 0.f, 0.f};
    for (int c = cg_; c < 2048; c += 8) {
      const s16x4 v = *(const s16x4*)(base + (size_t)c * 128);
#pragma unroll
      for (int e = 0; e < 4; ++e) { const float f = bf2f((bf16_t)v[e]); s[e] += f; s2[e] += f * f; }
    }
#pragma unroll
    for (int e = 0; e < 4; ++e) { red[(cg_ * 128 + qq * 4 + e) * 2] = s[e]; red[(cg_ * 128 + qq * 4 + e) * 2 + 1] = s2[e]; }
    __syncthreads();
    if (t < 128) {
      float a = 0.f, b2 = 0.f;
      for (int g = 0; g < 8; ++g) { a += red[(g * 128 + t) * 2]; b2 += red[(g * 128 + t) * 2 + 1]; }
      const float mu = a * (1.f / 2048.f);
      const float var = fmaxf(b2 * (1.f / 2048.f) - mu * mu, 0.f);
      STATS[(size_t)(chunk * 128 + t) * 2] = mu;
      STATS[(size_t)(chunk * 128 + t) * 2 + 1] = rsqrtf(var + EPS);
    }
    __syncthreads();
  }
}
DI void phase_spatial(const Params& p, char* smem) {
  float* smu = (float*)smem;
  float* srs = smu + 128;
  const bf16_t* GVT = (const bf16_t*)(p.ws + O_GVT); const bf16_t* U = (const bf16_t*)(p.ws + O_U);
  const float* STATS = (const float*)(p.ws + O_STATS);
  bf16_t* UV = (bf16_t*)(p.ws + O_UV);
  const int t = threadIdx.x, lane = t & 63, w = t >> 6, r = lane & 31, hh = lane >> 5;
  for (int item = blockIdx.x; item < 1024; item += gridDim.x) {
    const int chunk = item >> 3, g = item & 7;
    if (t < 128) { smu[t] = STATS[(size_t)(chunk * 128 + t) * 2]; srs[t] = STATS[(size_t)(chunk * 128 + t) * 2 + 1]; }
    __syncthreads();
    const float* Ws = p.gm_w_s + (size_t)g * 16384;
    f32x16 acc[4][2];
#pragma unroll
    for (int i = 0; i < 4; ++i) { acc[i][0] = fzero(); acc[i][1] = fzero(); }
    const int cA = g * 256 + w * 64 + r, cB = cA + 32;
    const float lgA = p.gm_ln_g[cA], lbA = p.gm_ln_b[cA], lgB = p.gm_ln_g[cB], lbB = p.gm_ln_b[cB];
    const bf16_t* vA = GVT + ((size_t)chunk * 2048 + cA) * 128 + hh * 8;
    const bf16_t* vB = GVT + ((size_t)chunk * 2048 + cB) * 128 + hh * 8;
    for (int ks = 0; ks < 8; ++ks) {
      const bf16x8 ra = ldfrag(vA + ks * 16), rbv = ldfrag(vB + ks * 16);
      const float* mu = smu + ks * 16 + hh * 8; const float* rs = srs + ks * 16 + hh * 8;
      const bf16x8 bA = pack8((bf2f((bf16_t)ra[0]) - mu[0]) * rs[0] * lgA + lbA, (bf2f((bf16_t)ra[1]) - mu[1]) * rs[1] * lgA + lbA,
                              (bf2f((bf16_t)ra[2]) - mu[2]) * rs[2] * lgA + lbA, (bf2f((bf16_t)ra[3]) - mu[3]) * rs[3] * lgA + lbA,
                              (bf2f((bf16_t)ra[4]) - mu[4]) * rs[4] * lgA + lbA, (bf2f((bf16_t)ra[5]) - mu[5]) * rs[5] * lgA + lbA,
                              (bf2f((bf16_t)ra[6]) - mu[6]) * rs[6] * lgA + lbA, (bf2f((bf16_t)ra[7]) - mu[7]) * rs[7] * lgA + lbA);
      const bf16x8 bB = pack8((bf2f((bf16_t)rbv[0]) - mu[0]) * rs[0] * lgB + lbB, (bf2f((bf16_t)rbv[1]) - mu[1]) * rs[1] * lgB + lbB,
                              (bf2f((bf16_t)rbv[2]) - mu[2]) * rs[2] * lgB + lbB, (bf2f((bf16_t)rbv[3]) - mu[3]) * rs[3] * lgB + lbB,
                              (bf2f((bf16_t)rbv[4]) - mu[4]) * rs[4] * lgB + lbB, (bf2f((bf16_t)rbv[5]) - mu[5]) * rs[5] * lgB + lbB,
                              (bf2f((bf16_t)rbv[6]) - mu[6]) * rs[6] * lgB + lbB, (bf2f((bf16_t)rbv[7]) - mu[7]) * rs[7] * lgB + lbB);
#pragma unroll
      for (int rb = 0; rb < 4; ++rb) {
        const float* wp = Ws + (rb * 32 + r) * 128 + ks * 16 + hh * 8;
        const float4 w0 = *(const float4*)wp, w1 = *(const float4*)(wp + 4);
        const bf16x8 a = pack8(w0.x, w0.y, w0.z, w0.w, w1.x, w1.y, w1.z, w1.w);
        acc[rb][0] = MFMA(a, bA, acc[rb][0]);
        acc[rb][1] = MFMA(a, bB, acc[rb][1]);
      }
    }
#pragma unroll
    for (int rb = 0; rb < 4; ++rb)
#pragma unroll
      for (int i = 0; i < 16; ++i) {
        const int pp = rb * 32 + crow(i, hh);
        const float bs = p.gm_b_s[g * 128 + pp];
        const size_t row = (size_t)chunk * 128 + pp;
        UV[row * 2048 + cA] = f2bf(bf2f(U[row * 2048 + cA]) * (acc[rb][0][i] + bs));
        UV[row * 2048 + cB] = f2bf(bf2f(U[row * 2048 + cB]) * (acc[rb][1][i] + bs));
      }
    __syncthreads();
  }
}

struct EpiBf16 {
  bf16_t* dst; int ld;
  DI void operator()(f32x16 (&acc)[2][2], int mb, int nb, int r, int hh) const {
#pragma unroll
    for (int mi = 0; mi < 2; ++mi)
#pragma unroll
      for (int ni = 0; ni < 2; ++ni)
#pragma unroll
        for (int i = 0; i < 16; ++i)
          dst[(size_t)(mb + mi * 32 + crow(i, hh)) * ld + nb + ni * 32 + r] = f2bf(acc[mi][ni][i]);
  }
};
struct EpiRes {
  float* out; const float* base; const float* gate;
  DI void operator()(f32x16 (&acc)[2][2], int mb, int nb, int r, int hh) const {
#pragma unroll
    for (int ni = 0; ni < 2; ++ni) {
      const int n = nb + ni * 32 + r;
      const float gt = gate[n];
#pragma unroll
      for (int mi = 0; mi < 2; ++mi) {
        const size_t o0 = (size_t)(mb + mi * 32 + 4 * hh) * 1024 + n;
        float* op = out + o0; const float* bp = base + o0;
#pragma unroll
        for (int i = 0; i < 16; ++i) {
          const int off = ((i & 3) + 8 * (i >> 2)) * 1024;
          op[off] = bp[off] + gt * acc[mi][ni][i];
        }
        __builtin_amdgcn_sched_barrier(0);
      }
    }
  }
};
struct EpiGelu {
  bf16_t* U; bf16_t* GVT; int m0, n0;
  DI void operator()(f32x16 (&acc)[2][2], int mb, int nb, int r, int hh) const {
    if (n0 < 2048) {
#pragma unroll
      for (int mi = 0; mi < 2; ++mi)
#pragma unroll
        for (int ni = 0; ni < 2; ++ni)
#pragma unroll
          for (int i = 0; i < 16; ++i)
            U[(size_t)(m0 + mb + mi * 32 + crow(i, hh)) * 2048 + n0 + nb + ni * 32 + r] = f2bf(geluf(acc[mi][ni][i]));
    } else {
      const int chunk = m0 >> 7;
#pragma unroll
      for (int mi = 0; mi < 2; ++mi)
#pragma unroll
        for (int ni = 0; ni < 2; ++ni) {
          const int cc = n0 - 2048 + nb + ni * 32 + r;
          bf16_t* d = GVT + ((size_t)chunk * 2048 + cc) * 128 + mb + mi * 32 + 4 * hh;
#pragma unroll
          for (int q4 = 0; q4 < 4; ++q4) {
            uint2 u;
            u.x = pack2(geluf(acc[mi][ni][4 * q4]), geluf(acc[mi][ni][4 * q4 + 1]));
            u.y = pack2(geluf(acc[mi][ni][4 * q4 + 2]), geluf(acc[mi][ni][4 * q4 + 3]));
            *(uint2*)(d + 8 * q4) = u;
          }
        }
    }
  }
};
struct EpiSwiglu {
  bf16_t* hid;
  DI void operator()(f32x16 (&acc)[2][2], int mb, int nb, int r, int hh) const {
    const int f = (nb >> 1) + r;
#pragma unroll
    for (int mi = 0; mi < 2; ++mi)
#pragma unroll
      for (int i = 0; i < 16; ++i) {
        const float gv = acc[mi][0][i], uv = acc[mi][1][i];
        hid[(size_t)(mb + mi * 32 + crow(i, hh)) * 1024 + f] = f2bf(siluf(gv) * uv);
      }
  }
};
struct EpiMoeOut {
  float* out; const int* idx; const float* gate; const float* gt2;
  int n0;
  DI void operator()(f32x16 (&acc)[2][2], int mb, int nb, int r, int hh) const {
#pragma unroll
    for (int mi = 0; mi < 2; ++mi)
#pragma unroll
      for (int i = 0; i < 16; ++i) {
        const int slot = mb + mi * 32 + crow(i, hh);
        const int tok = idx[slot];
        const float gs = gate[slot];
#pragma unroll
        for (int ni = 0; ni < 2; ++ni) {
          const int n = nb + ni * 32 + r;
          unsafeAtomicAdd(out + (size_t)tok * 1024 + n0 + n, gt2[n] * gs * acc[mi][ni][i]);
        }
      }
  }
};

DI void phase_moe1(const Params& p, char* smem) {
  const bf16_t* HA = (const bf16_t*)(p.ws + O_HA); const bf16_t* WGU = (const bf16_t*)(p.ws + O_MGU);
  const int* IDX = (const int*)(p.ws + O_IDX); bf16_t* HID = (bf16_t*)(p.ws + O_HID);
  const int t = threadIdx.x, lrow = t >> 3, lcol = (t & 7) * 8;
  for (int tile = blockIdx.x; tile < 32 * 8 * 16; tile += gridDim.x) {
    const int be = tile >> 7, mt = (tile >> 4) & 7, nt = tile & 15, b = be >> 4, e = be & 15;
    const bf16_t* ap[4]; const bf16_t* bp[4];
#pragma unroll
    for (int i = 0; i < 4; ++i) {
      const int tok = IDX[be * 1024 + mt * 128 + lrow + 32 * i];
      ap[i] = HA + ((size_t)b * 8192 + tok) * 1024 + lcol;
      bp[i] = WGU + ((size_t)e * 2048 + nt * 128 + lrow + 32 * i) * 1024 + lcol;
    }
    gemm_tile(ap, bp, 1024, smem, EpiSwiglu{HID + ((size_t)be * 1024 + mt * 128) * 1024 + nt * 64});
  }
}
DI void phase_moe2(const Params& p, int layer, char* smem) {
  const bf16_t* HID = (const bf16_t*)(p.ws + O_HID); const bf16_t* WD = (const bf16_t*)(p.ws + O_MD);
  const int* IDX = (const int*)(p.ws + O_IDX); const float* GATE = (const float*)(p.ws + O_GATE);
  const float* modv = (const float*)(p.ws + O_MODV);
  const int t = threadIdx.x, lrow = t >> 3, lcol = (t & 7) * 8;
  for (int tile = blockIdx.x; tile < 32 * 8 * 8; tile += gridDim.x) {
    const int be = tile >> 6, mt = (tile >> 3) & 7, nt = tile & 7, b = be >> 4, e = be & 15;
    const bf16_t* ap[4]; const bf16_t* bp[4];
#pragma unroll
    for (int i = 0; i < 4; ++i) {
      ap[i] = HID + ((size_t)be * 1024 + mt * 128 + lrow + 32 * i) * 1024 + lcol;
      bp[i] = WD + ((size_t)e * 1024 + nt * 128 + lrow + 32 * i) * 1024 + lcol;
    }
    gemm_tile(ap, bp, 1024, smem,
              EpiMoeOut{p.out + (size_t)b * 8192 * 1024, IDX + be * 1024 + mt * 128, GATE + be * 1024 + mt * 128,
                        modv + (layer * 3 + b) * 6144 + 5 * 1024 + nt * 128, nt * 128});
  }
}

DI void phase_final(const Params& p) {
  const int t = threadIdx.x, lane = t & 63, w = t >> 6;
  for (int row = blockIdx.x * 4 + w; row < NTOK; row += gridDim.x * 4) {
    float* src = p.out + (size_t)row * 1024;
    float4 xv[4]; float ss = 0.f;
#pragma unroll
    for (int i = 0; i < 4; ++i) {
      xv[i] = *(const float4*)(src + (i * 64 + lane) * 4);
      ss += xv[i].x * xv[i].x + xv[i].y * xv[i].y + xv[i].z * xv[i].z + xv[i].w * xv[i].w;
    }
    ss = wsum(ss);
    const float rstd = rsqrtf(ss * (1.f / 1024.f) + EPS);
#pragma unroll
    for (int i = 0; i < 4; ++i) {
      const int col = (i * 64 + lane) * 4;
      const float4 g4 = *(const float4*)(p.final_norm_g + col);
      float4 y; y.x = xv[i].x * rstd * g4.x; y.y = xv[i].y * rstd * g4.y; y.z = xv[i].z * rstd * g4.z; y.w = xv[i].w * rstd * g4.w;
      *(float4*)(src + col) = y;
    }
  }
}

constexpr int NPHASE = 22;
DI void run_phase(const Params& p, int ph, char* smem) {
  const float* modv = (const float*)(p.ws + O_MODV);
  switch (ph) {
#if !defined(ONLY) || ONLY == 0
    case 0:
      phase_adaln(p, smem);
      __syncthreads();
      tconv(p.ab_w_in, 2832, 2832, 1024, 1, 0, (bf16_t*)(p.ws + O_WIN), 0, 1, smem);
      tconv(p.ab_w_out, 1024, 1024, 1024, 1, 0, (bf16_t*)(p.ws + O_WOUT), 0, 0, smem);
      tconv(p.gm_w_in, 4096, 4096, 1024, 1, 0, (bf16_t*)(p.ws + O_GMIN), 0, 0, smem);
      tconv(p.gm_w_out, 1024, 1024, 2048, 1, 0, (bf16_t*)(p.ws + O_GMOUT), 0, 0, smem);
      tconv_moe(p, 0, smem);
      break;
#endif
#if !defined(ONLY) || ONLY == 1
    case 1: phase_modulate<1>(p, 0, 0, smem); break;
#endif
#if !defined(ONLY) || ONLY == 2
    case 2:
      gemm_dense((const bf16_t*)(p.ws + O_HA), (const bf16_t*)(p.ws + O_WIN), NROW, PLD, 1024, smem,
                 [&](int m0, int n0) { return EpiBf16{(bf16_t*)(p.ws + O_P) + (size_t)m0 * PLD + n0, PLD}; });
      break;
#endif
#if !defined(ONLY) || ONLY == 3
    case 3: phase_prep2(p, smem); break;
#endif
#if !defined(ONLY) || ONLY == 4
    case 4:
      for (int item = blockIdx.x; item < 1024 + 8 * NSTEP; item += gridDim.x) {
        if (item < 1024) attn_item(p, item); else mlstm_local_item(p, item - 1024, smem);
      }
      break;
#endif
#if !defined(ONLY) || ONLY == 5
    case 5: phase_scan(p); break;
#endif
#if !defined(ONLY) || ONLY == 6
    case 6:
      for (int item = blockIdx.x; item < 512; item += gridDim.x) mlstm_out_item(p, item, smem);
      break;
#endif
#if !defined(ONLY) || ONLY == 7
    case 7:
      gemm_dense((const bf16_t*)(p.ws + O_HA), (const bf16_t*)(p.ws + O_WOUT), NTOK, 1024, 1024, smem,
                 [&](int m0, int n0) {
                   return EpiRes{p.out + (size_t)m0 * 1024 + n0, p.x + (size_t)m0 * 1024 + n0, modv + (0 * 3 + (m0 >> 13)) * 6144 + 2 * 1024 + n0};
                 });
      break;
#endif
#if !defined(ONLY) || ONLY == 8
    case 8: phase_modulate<2>(p, 0, 1, smem); break;
#endif
#if !defined(ONLY) || ONLY == 9
    case 9: phase_topk(p, smem); break;
#endif
#if !defined(ONLY) || ONLY == 10
    case 10: phase_moe1(p, smem); break;
#endif
#if !defined(ONLY) || ONLY == 11
    case 11: phase_moe2(p, 0, smem); break;
#endif
#if !defined(ONLY) || ONLY == 12
    case 12:
      phase_modulate<0>(p, 1, 0, smem);
      __syncthreads();
      tconv_moe(p, 1, smem);
      break;
#endif
#if !defined(ONLY) || ONLY == 13
    case 13:
      gemm_dense((const bf16_t*)(p.ws + O_HA), (const bf16_t*)(p.ws + O_GMIN), NTOK, 4096, 1024, smem,
                 [&](int m0, int n0) { return EpiGelu{(bf16_t*)(p.ws + O_U), (bf16_t*)(p.ws + O_GVT), m0, n0}; });
      break;
#endif
#if !defined(ONLY) || ONLY == 14
    case 14: phase_stats(p, smem); break;
#endif
#if !defined(ONLY) || ONLY == 15
    case 15: phase_spatial(p, smem); break;
#endif
#if !defined(ONLY) || ONLY == 16
    case 16:
      gemm_dense((const bf16_t*)(p.ws + O_UV), (const bf16_t*)(p.ws + O_GMOUT), NTOK, 1024, 2048, smem,
                 [&](int m0, int n0) {
                   return EpiRes{p.out + (size_t)m0 * 1024 + n0, p.out + (size_t)m0 * 1024 + n0, modv + (1 * 3 + (m0 >> 13)) * 6144 + 2 * 1024 + n0};
                 });
      break;
#endif
#if !defined(ONLY) || ONLY == 17
    case 17: phase_modulate<2>(p, 1, 1, smem); break;
#endif
#if !defined(ONLY) || ONLY == 18
    case 18: phase_topk(p, smem); break;
#endif
#if !defined(ONLY) || ONLY == 19
    case 19: phase_moe1(p, smem); break;
#endif
#if !defined(ONLY) || ONLY == 20
    case 20: phase_moe2(p, 1, smem); break;
#endif
#if !defined(ONLY) || ONLY == 21
    case 21: phase_final(p); break;
#endif
    default: break;
  }
}

#if COOP
__global__ void __launch_bounds__(256, 1) mega(Params p) {
  __shared__ __attribute__((aligned(16))) char smem[73728];
  cg::grid_group grid = cg::this_grid();
#define PHX(n) run_phase(p, n, smem); grid.sync();
  PHX(0) PHX(1) PHX(2) PHX(3) PHX(4) PHX(5) PHX(6) PHX(7) PHX(8) PHX(9) PHX(10)
  PHX(11) PHX(12) PHX(13) PHX(14) PHX(15) PHX(16) PHX(17) PHX(18) PHX(19) PHX(20)
  run_phase(p, 21, smem);
}
#else
__global__ void __launch_bounds__(256, 1) mega(Params p, int ph) {
  __shared__ __attribute__((aligned(16))) char smem[73728];
  run_phase(p, ph, smem);
}
#endif

extern "C" void kernel_launch(void* const* d_in, const int* in_sizes, int n_in, void* d_out, int out_size, void* d_ws,
                              size_t ws_size, hipStream_t stream) {
  (void)in_sizes; (void)n_in; (void)out_size;
  if (ws_size < WS_NEED) { fprintf(stderr, "workspace too small: %zu < %zu\n", ws_size, (size_t)WS_NEED); return; }
  static int grid_blocks = 0;
  if (!grid_blocks) {
    int dev = 0, cus = 0, per_cu = 0;
    hipGetDevice(&dev);
    hipDeviceGetAttribute(&cus, hipDeviceAttributeMultiprocessorCount, dev);
    hipOccupancyMaxActiveBlocksPerMultiprocessor(&per_cu, mega, 256, 0);
    if (per_cu < 1) per_cu = 1;
    if (per_cu > 2) per_cu = 2;
    grid_blocks = cus * per_cu;
  }
  Params p{};
  const float** f = (const float**)&p;
  for (int i = 0; i < 25; ++i) f[i] = (const float*)d_in[i];
  p.out = (float*)d_out;
  p.ws = (char*)d_ws;
#if COOP
  void* args[] = {&p};
  hipError_t e = hipLaunchCooperativeKernel((void*)mega, dim3(grid_blocks), dim3(256), args, 0, stream);
  if (e != hipSuccess) fprintf(stderr, "cooperative launch failed: %s (grid %d)\n", hipGetErrorString(e), grid_blocks);
#else
  for (int ph = 0; ph < NPHASE; ++ph) hipLaunchKernelGGL(mega, dim3(grid_blocks), dim3(256), 0, stream, p, ph);
#endif
}
```

```cpp
#include <hip/hip_runtime.h>
#include <hip/hip_cooperative_groups.h>
#include <cstdio>
namespace cg = cooperative_groups;

#define DI __device__ __forceinline__
typedef unsigned short bf16_t;
using bf16x8 = __attribute__((ext_vector_type(8))) short;
using s16x4 = __attribute__((ext_vector_type(4))) short;
using f32x16 = __attribute__((ext_vector_type(16))) float;
#define MFMA(a, b, c) __builtin_amdgcn_mfma_f32_32x32x16_bf16((a), (b), (c), 0, 0, 0)

#ifndef COOP
#define COOP 1
#endif

constexpr int DM = 1024, NBAT = 2, SEQ = 8192, NTOK = NBAT * SEQ, CTXL = 256, NROW = NTOK + NBAT * CTXL;
constexpr int PLD = 2816;
constexpr int NSTEP = 66;
constexpr float EPS = 1e-6f;

constexpr size_t al256(size_t x) { return (x + 255) & ~(size_t)255; }
constexpr size_t O_WIN = 0;
constexpr size_t O_WOUT = O_WIN + al256((size_t)PLD * 1024 * 2);
constexpr size_t O_GMIN = O_WOUT + al256((size_t)1024 * 1024 * 2);
constexpr size_t O_GMOUT = O_GMIN + al256((size_t)4096 * 1024 * 2);
constexpr size_t O_MGU = O_GMOUT + al256((size_t)1024 * 2048 * 2);
constexpr size_t O_MD = O_MGU + al256((size_t)16 * 2048 * 1024 * 2);
constexpr size_t O_MODV = O_MD + al256((size_t)16 * 1024 * 1024 * 2);
constexpr size_t O_HA = O_MODV + al256((size_t)2 * 3 * 6144 * 4);
constexpr size_t O_GL = O_HA + al256((size_t)NROW * 1024 * 2);
constexpr size_t O_AFF = O_GL + al256((size_t)NROW * 16 * 4);
constexpr size_t O_IDX = O_AFF + al256((size_t)32 * 8192 * 4);
constexpr size_t O_GATE = O_IDX + al256((size_t)32 * 1024 * 4);
constexpr size_t O_STATS = O_GATE + al256((size_t)32 * 1024 * 4);
constexpr size_t O_GSC = O_STATS + al256((size_t)NTOK * 2 * 4);
constexpr size_t O_MLOC = O_GSC + al256((size_t)16 * NSTEP * 4);
constexpr size_t O_DN = O_MLOC + al256((size_t)16 * NSTEP * 4);
constexpr size_t O_NST = O_DN + al256((size_t)16 * NSTEP * 128 * 4);
constexpr size_t O_MST = O_NST + al256((size_t)16 * 64 * 128 * 4);
constexpr size_t O_R12 = O_MST + al256((size_t)16 * 64 * 4);
constexpr size_t O_P = O_R12;
constexpr size_t O_QC = O_P + al256((size_t)NROW * PLD * 2);
constexpr size_t O_KC = O_QC + al256((size_t)NTOK * 512 * 2);
constexpr size_t O_KT = O_KC + al256((size_t)NTOK * 512 * 2);
constexpr size_t O_VT = O_KT + al256((size_t)132 * 4 * 128 * 128 * 2);
constexpr size_t O_RQ = O_VT + al256((size_t)132 * 4 * 128 * 128 * 2);
constexpr size_t O_RK = O_RQ + al256((size_t)NTOK * 512 * 2);
constexpr size_t O_AVTX = O_RK + al256((size_t)NROW * 128 * 2);
constexpr size_t O_AVTC = O_AVTX + al256((size_t)4 * 64 * 8192 * 2);
constexpr size_t O_R12_END = O_AVTC + al256((size_t)4 * 64 * 256 * 2);
constexpr size_t O_HID = O_R12;
constexpr size_t O_U = O_R12;
constexpr size_t O_GVT = O_U + al256((size_t)NTOK * 2048 * 2);
static_assert(O_GVT + (size_t)NTOK * 2048 * 2 <= O_R12_END, "R12 too small");
constexpr size_t O_DC = O_R12_END;
constexpr size_t O_CST = O_DC + al256((size_t)16 * NSTEP * 16384 * 4);
constexpr size_t O_UV = O_DC;
constexpr size_t WS_NEED = O_CST + al256((size_t)16 * 64 * 16384 * 2);

struct Params {
  const float *x, *c, *ctx, *c_ctx, *w_mod, *b_mod, *norm_mix_g, *norm_ffn_g, *final_norm_g;
  const float *ab_w_in, *ab_conv_w, *ab_gate_b, *ab_head_g, *ab_sink, *ab_w_out;
  const float *gm_w_in, *gm_ln_g, *gm_ln_b, *gm_w_s, *gm_b_s, *gm_w_out;
  const float *moe_w_router, *moe_w_gate, *moe_w_up, *moe_w_down;
  float* out;
  char* ws;
};

DI bf16_t f2bf(float x) { unsigned u = __float_as_uint(x); u += 0x7fffu + ((u >> 16) & 1u); return (bf16_t)(u >> 16); }
DI float bf2f(bf16_t b) { return __uint_as_float(((unsigned)b) << 16); }
DI unsigned pack2(float a, float b) { return (unsigned)f2bf(a) | ((unsigned)f2bf(b) << 16); }
DI bf16x8 pack8(float a0, float a1, float a2, float a3, float a4, float a5, float a6, float a7) {
  uint4 u; u.x = pack2(a0, a1); u.y = pack2(a2, a3); u.z = pack2(a4, a5); u.w = pack2(a6, a7);
  return __builtin_bit_cast(bf16x8, u);
}
DI bf16x8 ldfrag(const bf16_t* p) { return *(const bf16x8*)p; }
DI bf16x8 ldfrag2(const bf16_t* p0, const bf16_t* p1) {
  s16x4 lo = *(const s16x4*)p0, hi = *(const s16x4*)p1;
  return __builtin_shufflevector(lo, hi, 0, 1, 2, 3, 4, 5, 6, 7);
}
DI int crow(int i, int hh) { return (i & 3) + 8 * (i >> 2) + 4 * hh; }
DI float siluf(float x) { return x / (1.f + __expf(-x)); }
DI float sigmf(float x) { return 1.f / (1.f + __expf(-x)); }
DI float logsigf(float x) { return fminf(x, 0.f) - log1pf(expf(-fabsf(x))); }
DI float geluf(float x) { float u = 0.7978845608028654f * (x + 0.044715f * x * x * x); return 0.5f * x * (1.f + tanhf(u)); }
DI float wsum(float v) {
#pragma unroll
  for (int o = 32; o > 0; o >>= 1) v += __shfl_xor(v, o);
  return v;
}
DI f32x16 fzero() { f32x16 z; for (int i = 0; i < 16; ++i) z[i] = 0.f; return z; }

DI int tmap(int kind, int n) {
  if (kind == 0) return n;
  if (kind == 1) return n < 2048 ? n : (n < 2064 ? -1 : n - 16);
  int r = (n >> 6) * 128 + ((n >> 5) & 1) * 64 + (n & 31);
  return kind == 2 ? r : r + 32;
}
DI void tconv(const float* __restrict__ src, int ldn, int ncols, int K, int nmat, size_t sstride,
              bf16_t* __restrict__ dst, size_t dstride, int kind, char* smem) {
  float* sm = (float*)smem;
  const int t = threadIdx.x;
  const int ntn = (ncols + 63) >> 6, ntk = K >> 6, per = ntn * ntk;
  for (int tile = blockIdx.x; tile < per * nmat; tile += gridDim.x) {
    const int mat = tile / per, tt = tile % per;
    const int k0 = (tt / ntn) * 64, n0 = (tt % ntn) * 64;
    const float* s = src + (size_t)mat * sstride;
    bf16_t* d = dst + (size_t)mat * dstride;
    const int c4 = t & 15, rr = t >> 4;
#pragma unroll
    for (int i = 0; i < 4; ++i) {
      const int kr = rr + 16 * i, n = n0 + c4 * 4;
      float4 v = make_float4(0.f, 0.f, 0.f, 0.f);
      if (n < ncols) v = *(const float4*)(s + (size_t)(k0 + kr) * ldn + n);
      sm[kr * 65 + c4 * 4 + 0] = v.x; sm[kr * 65 + c4 * 4 + 1] = v.y; sm[kr * 65 + c4 * 4 + 2] = v.z; sm[kr * 65 + c4 * 4 + 3] = v.w;
    }
    __syncthreads();
    const int nl = t >> 2, kq = t & 3, n = n0 + nl;
    if (n < ncols) {
      const int row = tmap(kind, n);
      if (row >= 0) {
        uint4 o0, o1;
        const float* q = sm + (kq * 16) * 65 + nl;
        o0.x = pack2(q[0 * 65], q[1 * 65]); o0.y = pack2(q[2 * 65], q[3 * 65]); o0.z = pack2(q[4 * 65], q[5 * 65]); o0.w = pack2(q[6 * 65], q[7 * 65]);
        o1.x = pack2(q[8 * 65], q[9 * 65]); o1.y = pack2(q[10 * 65], q[11 * 65]); o1.z = pack2(q[12 * 65], q[13 * 65]); o1.w = pack2(q[14 * 65], q[15 * 65]);
        uint4* dp = (uint4*)(d + (size_t)row * K + k0 + kq * 16);
        dp[0] = o0; dp[1] = o1;
      }
    }
    __syncthreads();
  }
}
DI void tconv_moe(const Params& p, int layer, char* smem) {
  const size_t wo = (size_t)layer * 16 * 1024 * 1024;
  tconv(p.moe_w_gate + wo, 1024, 1024, 1024, 16, (size_t)1024 * 1024, (bf16_t*)(p.ws + O_MGU), (size_t)2048 * 1024, 2, smem);
  tconv(p.moe_w_up + wo, 1024, 1024, 1024, 16, (size_t)1024 * 1024, (bf16_t*)(p.ws + O_MGU), (size_t)2048 * 1024, 3, smem);
  tconv(p.moe_w_down + wo, 1024, 1024, 1024, 16, (size_t)1024 * 1024, (bf16_t*)(p.ws + O_MD), (size_t)1024 * 1024, 0, smem);
}

DI void phase_adaln(const Params& p, char* smem) {
  float* sv = (float*)smem;
  float* red = sv + 3 * 1024;
  float* modv = (float*)(p.ws + O_MODV);
  const int t = threadIdx.x;
  if (blockIdx.x >= 192) return;
  for (int i = t; i < 3 * 1024; i += 256) {
    const int v = i >> 10, k = i & 1023;
    const float cv = v < 2 ? p.c[v * 1024 + k] : p.c_ctx[k];
    sv[i] = siluf(cv);
  }
  __syncthreads();
  for (int item = blockIdx.x; item < 192; item += gridDim.x) {
    const int l = item / 96, cb = item % 96;
    const int cq = t & 15, kg = t >> 4;
    const float* w = p.w_mod + (size_t)l * 1024 * 6144 + cb * 64 + cq * 4;
    float a0[4] = {0.f, 0.f, 0.f, 0.f}, a1[4] = {0.f, 0.f, 0.f, 0.f}, a2[4] = {0.f, 0.f, 0.f, 0.f};
    for (int i = 0; i < 64; ++i) {
      const int k = kg + 16 * i;
      const float4 wv = *(const float4*)(w + (size_t)k * 6144);
      const float s0 = sv[k], s1 = sv[1024 + k], s2 = sv[2048 + k];
      a0[0] += s0 * wv.x; a0[1] += s0 * wv.y; a0[2] += s0 * wv.z; a0[3] += s0 * wv.w;
      a1[0] += s1 * wv.x; a1[1] += s1 * wv.y; a1[2] += s1 * wv.z; a1[3] += s1 * wv.w;
      a2[0] += s2 * wv.x; a2[1] += s2 * wv.y; a2[2] += s2 * wv.z; a2[3] += s2 * wv.w;
    }
#pragma unroll
    for (int j = 0; j < 4; ++j) {
      red[(kg * 3 + 0) * 64 + cq * 4 + j] = a0[j];
      red[(kg * 3 + 1) * 64 + cq * 4 + j] = a1[j];
      red[(kg * 3 + 2) * 64 + cq * 4 + j] = a2[j];
    }
    __syncthreads();
    if (t < 192) {
      const int v = t >> 6, col = t & 63;
      float s = 0.f;
      for (int g = 0; g < 16; ++g) s += red[(g * 3 + v) * 64 + col];
      const int cc = cb * 64 + col;
      modv[(l * 3 + v) * 6144 + cc] = s + p.b_mod[l * 6144 + cc];
    }
    __syncthreads();
  }
}

template <int MODE>
DI void phase_modulate(const Params& p, int layer, int which, char* smem) {
  float* wt = (float*)smem;
  const int t = threadIdx.x, lane = t & 63, w = t >> 6;
  const float* modv = (const float*)(p.ws + O_MODV);
  bf16_t* HA = (bf16_t*)(p.ws + O_HA);
  if (MODE != 0) {
    const float* W = MODE == 1 ? p.ab_w_in + 2048 : p.moe_w_router + (size_t)layer * 1024 * 16;
    const int ld = MODE == 1 ? 2832 : 16;
    for (int i = t; i < 4096; i += 256) {
      const int k = i >> 2, e4 = i & 3;
      const float4 v = *(const float4*)(W + (size_t)k * ld + e4 * 4);
      wt[(e4 * 4 + 0) * 1024 + k] = v.x; wt[(e4 * 4 + 1) * 1024 + k] = v.y; wt[(e4 * 4 + 2) * 1024 + k] = v.z; wt[(e4 * 4 + 3) * 1024 + k] = v.w;
    }
    __syncthreads();
  }
  const float* gn = (which == 0 ? p.norm_mix_g : p.norm_ffn_g) + layer * 1024;
  const int nrows = MODE == 1 ? NROW : NTOK;
  for (int row = blockIdx.x * 4 + w; row < nrows; row += gridDim.x * 4) {
    const float* src; int v;
    if (MODE == 1) {
      if (row < NTOK) { src = p.x + (size_t)row * 1024; v = row >> 13; }
      else { src = p.ctx + (size_t)(row - NTOK) * 1024; v = 2; }
    } else { src = p.out + (size_t)row * 1024; v = row >> 13; }
    const float* sh = modv + (layer * 3 + v) * 6144 + (which ? 3 : 0) * 1024;
    const float* sc = sh + 1024;
    float4 xv[4];
    float ss = 0.f;
#pragma unroll
    for (int i = 0; i < 4; ++i) {
      xv[i] = *(const float4*)(src + (i * 64 + lane) * 4);
      ss += xv[i].x * xv[i].x + xv[i].y * xv[i].y + xv[i].z * xv[i].z + xv[i].w * xv[i].w;
    }
    ss = wsum(ss);
    const float rstd = rsqrtf(ss * (1.f / 1024.f) + EPS);
    float4 yv[4];
#pragma unroll
    for (int i = 0; i < 4; ++i) {
      const int col = (i * 64 + lane) * 4;
      const float4 g4 = *(const float4*)(gn + col), s4 = *(const float4*)(sh + col), c4 = *(const float4*)(sc + col);
      float4 y;
      y.x = xv[i].x * rstd * g4.x * (1.f + c4.x) + s4.x;
      y.y = xv[i].y * rstd * g4.y * (1.f + c4.y) + s4.y;
      y.z = xv[i].z * rstd * g4.z * (1.f + c4.z) + s4.z;
      y.w = xv[i].w * rstd * g4.w * (1.f + c4.w) + s4.w;
      yv[i] = y;
      uint2 o; o.x = pack2(y.x, y.y); o.y = pack2(y.z, y.w);
      *(uint2*)(HA + (size_t)row * 1024 + col) = o;
    }
    if (MODE != 0) {
      float mine = 0.f;
#pragma unroll 1
      for (int e = 0; e < 16; ++e) {
        float pe = 0.f;
#pragma unroll
        for (int i = 0; i < 4; ++i) {
          const float4 w4 = *(const float4*)(wt + e * 1024 + (i * 64 + lane) * 4);
          pe += yv[i].x * w4.x + yv[i].y * w4.y + yv[i].z * w4.z + yv[i].w * w4.w;
        }
        pe = wsum(pe);
        if ((lane & 15) == e) mine = pe;
      }
      const int e = lane & 15;
      if (MODE == 1) {
        float val = mine + p.ab_gate_b[e];
        if (((e >> 2) & 1) == 1) val = logsigf(val);
        if (lane < 16) ((float*)(p.ws + O_GL))[(size_t)row * 16 + lane] = val;
      } else {
        float mx = mine;
#pragma unroll
        for (int o = 8; o > 0; o >>= 1) mx = fmaxf(mx, __shfl_xor(mx, o));
        const float ex = expf(mine - mx);
        float sum = ex;
#pragma unroll
        for (int o = 8; o > 0; o >>= 1) sum += __shfl_xor(sum, o);
        if (lane < 16) ((float*)(p.ws + O_AFF))[((size_t)(row >> 13) * 16 + lane) * 8192 + (row & 8191)] = ex / sum;
      }
    }
  }
}

template <class Epi>
DI void gemm_tile(const bf16_t* (&ap)[4], const bf16_t* (&bp)[4], int K, char* smem, Epi&& epi) {
  bf16_t* sA = (bf16_t*)smem;
  bf16_t* sB = sA + 2 * 128 * 72;
  const int t = threadIdx.x, lane = t & 63, w = t >> 6, wm = w >> 1, wn = w & 1, r = lane & 31, hh = lane >> 5;
  const int lrow = t >> 3, lcol = (t & 7) * 8;
  f32x16 acc[2][2];
#pragma unroll
  for (int i = 0; i < 2; ++i)
#pragma unroll
    for (int j = 0; j < 2; ++j) acc[i][j] = fzero();
  uint4 ra[4], rb[4];
#pragma unroll
  for (int i = 0; i < 4; ++i) { ra[i] = *(const uint4*)(ap[i]); rb[i] = *(const uint4*)(bp[i]); }
#pragma unroll
  for (int i = 0; i < 4; ++i) {
    *(uint4*)(sA + (lrow + 32 * i) * 72 + lcol) = ra[i];
    *(uint4*)(sB + (lrow + 32 * i) * 72 + lcol) = rb[i];
  }
  __syncthreads();
  const int KT = K >> 6;
  for (int kt = 0; kt < KT; ++kt) {
    const int cur = kt & 1;
    if (kt + 1 < KT) {
#pragma unroll
      for (int i = 0; i < 4; ++i) { ra[i] = *(const uint4*)(ap[i] + (kt + 1) * 64); rb[i] = *(const uint4*)(bp[i] + (kt + 1) * 64); }
    }
    const bf16_t* cA = sA + cur * 128 * 72 + (wm * 64 + r) * 72 + hh * 8;
    const bf16_t* cB = sB + cur * 128 * 72 + (wn * 64 + r) * 72 + hh * 8;
#pragma unroll
    for (int ks = 0; ks < 4; ++ks) {
      const bf16x8 a0 = *(const bf16x8*)(cA + ks * 16), a1 = *(const bf16x8*)(cA + 32 * 72 + ks * 16);
      const bf16x8 b0 = *(const bf16x8*)(cB + ks * 16), b1 = *(const bf16x8*)(cB + 32 * 72 + ks * 16);
      acc[0][0] = MFMA(a0, b0, acc[0][0]);
      acc[0][1] = MFMA(a0, b1, acc[0][1]);
      acc[1][0] = MFMA(a1, b0, acc[1][0]);
      acc[1][1] = MFMA(a1, b1, acc[1][1]);
    }
    if (kt + 1 < KT) {
      bf16_t* nA = sA + (cur ^ 1) * 128 * 72;
      bf16_t* nB = sB + (cur ^ 1) * 128 * 72;
#pragma unroll
      for (int i = 0; i < 4; ++i) {
        *(uint4*)(nA + (lrow + 32 * i) * 72 + lcol) = ra[i];
        *(uint4*)(nB + (lrow + 32 * i) * 72 + lcol) = rb[i];
      }
    }
    __syncthreads();
  }
  epi(acc, wm * 64, wn * 64, r, hh);
}

template <class MakeEpi>
DI void gemm_dense(const bf16_t* A, const bf16_t* Bt, int M, int N, int K, char* smem, MakeEpi&& mk) {
  const int t = threadIdx.x, lrow = t >> 3, lcol = (t & 7) * 8;
  const int ntn = N >> 7, ntm = M >> 7;
  for (int tile = blockIdx.x; tile < ntn * ntm; tile += gridDim.x) {
    const int mt = tile / ntn, nt = tile % ntn;
    const bf16_t* ap[4]; const bf16_t* bp[4];
#pragma unroll
    for (int i = 0; i < 4; ++i) {
      ap[i] = A + (size_t)(mt * 128 + lrow + 32 * i) * K + lcol;
      bp[i] = Bt + (size_t)(nt * 128 + lrow + 32 * i) * K + lcol;
    }
    gemm_tile(ap, bp, K, smem, mk(mt * 128, nt * 128));
  }
}

DI void phase_prep2(const Params& p, char* smem) {
  bf16_t* T = (bf16_t*)smem;
  const bf16_t* P = (const bf16_t*)(p.ws + O_P);
  bf16_t* Qc = (bf16_t*)(p.ws + O_QC); bf16_t* Kc = (bf16_t*)(p.ws + O_KC);
  bf16_t* KT = (bf16_t*)(p.ws + O_KT); bf16_t* VT = (bf16_t*)(p.ws + O_VT);
  bf16_t* RQ = (bf16_t*)(p.ws + O_RQ); bf16_t* RK = (bf16_t*)(p.ws + O_RK);
  bf16_t* AVTX = (bf16_t*)(p.ws + O_AVTX); bf16_t* AVTC = (bf16_t*)(p.ws + O_AVTC);
  const int t = threadIdx.x;
  for (int item = blockIdx.x; item < 132 * 6; item += gridDim.x) {
    const int sc = item / 6, part = item % 6;
    const bool isx = sc < 128;
    const int row0 = sc * 128;
    const int seq_lo = isx ? (sc >> 6) * 8192 : NTOK + ((sc - 128) >> 1) * 256;
    const int seq_hi = seq_lo + (isx ? 8192 : 256);
    if (part < 4) {
      const int h = part;
      const int col8 = t & 15, rsub = t >> 4;
      for (int pass = 0; pass < 3; ++pass) {
        if (pass == 2 && !isx) break;
        const int pcol = (pass == 0 ? 512 : (pass == 1 ? 1024 : 0)) + h * 128 + col8 * 8;
        float cw[5][8];
        if (pass != 1) {
#pragma unroll
          for (int j = 0; j < 5; ++j)
#pragma unroll
            for (int e = 0; e < 8; ++e) cw[j][e] = p.ab_conv_w[j * 1024 + (pass == 0 ? 512 : 0) + h * 128 + col8 * 8 + e];
        }
        for (int i = 0; i < 8; ++i) {
          const int rl = rsub + 16 * i, row = row0 + rl;
          uint4 o;
          if (pass == 1) {
            o = *(const uint4*)(P + (size_t)row * PLD + pcol);
          } else {
            float a[8];
#pragma unroll
            for (int e = 0; e < 8; ++e) a[e] = 0.f;
#pragma unroll
            for (int j = 0; j < 5; ++j) {
              const int rr = row + j - 2;
              if (rr >= seq_lo && rr < seq_hi) {
                const bf16x8 v = *(const bf16x8*)(P + (size_t)rr * PLD + pcol);
#pragma unroll
                for (int e = 0; e < 8; ++e) a[e] += cw[j][e] * bf2f((bf16_t)v[e]);
              }
            }
            const float scl = pass == 0 ? 0.08838834764831845f : 1.f;
#pragma unroll
            for (int e = 0; e < 8; ++e) a[e] = siluf(a[e]) * scl;
            o.x = pack2(a[0], a[1]); o.y = pack2(a[2], a[3]); o.z = pack2(a[4], a[5]); o.w = pack2(a[6], a[7]);
            if (isx) *(uint4*)((pass == 0 ? Kc : Qc) + (size_t)row * 512 + h * 128 + col8 * 8) = o;
          }
          if (pass < 2) *(uint4*)(T + rl * 136 + col8 * 8) = o;
        }
        if (pass < 2) {
          __syncthreads();
          bf16_t* dstT = (pass == 0 ? KT : VT) + (size_t)(sc * 4 + h) * 16384;
          const int d = t & 127, shf = t >> 7;
#pragma unroll
          for (int s8 = 0; s8 < 8; ++s8) {
            const bf16_t* q = T + (shf * 64 + s8 * 8) * 136 + d;
            uint4 o;
            o.x = (unsigned)q[0] | ((unsigned)q[136] << 16); o.y = (unsigned)q[2 * 136] | ((unsigned)q[3 * 136] << 16);
            o.z = (unsigned)q[4 * 136] | ((unsigned)q[5 * 136] << 16); o.w = (unsigned)q[6 * 136] | ((unsigned)q[7 * 136] << 16);
            *(uint4*)(dstT + d * 128 + shf * 64 + s8 * 8) = o;
          }
          __syncthreads();
        }
      }
    } else if (part == 4) {
      if (!isx) continue;
      for (int idx = t; idx < 512; idx += 256) {
        const int rl = idx >> 2, dc = idx & 3, row = row0 + rl, pos = row - seq_lo;
        const float rp = (float)(pos >> 6), cp = (float)(pos & 63);
        float cs[8], sn[8];
#pragma unroll
        for (int e = 0; e < 8; ++e) {
          const int a = dc * 8 + e;
          const float inv = powf(10000.f, -(float)(a & 15) / 16.f);
          const float ang = (a < 16 ? rp : cp) * inv;
          cs[e] = cosf(ang); sn[e] = sinf(ang);
        }
        for (int hq = 0; hq < 8; ++hq) {
          const bf16x8 x1 = *(const bf16x8*)(P + (size_t)row * PLD + 2048 + hq * 64 + dc * 8);
          const bf16x8 x2 = *(const bf16x8*)(P + (size_t)row * PLD + 2048 + hq * 64 + 32 + dc * 8);
          float o1[8], o2[8];
#pragma unroll
          for (int e = 0; e < 8; ++e) {
            const float a = bf2f((bf16_t)x1[e]), b = bf2f((bf16_t)x2[e]);
            o1[e] = (a * cs[e] - b * sn[e]) * 0.125f; o2[e] = (b * cs[e] + a * sn[e]) * 0.125f;
          }
          uint4 u1, u2;
          u1.x = pack2(o1[0], o1[1]); u1.y = pack2(o1[2], o1[3]); u1.z = pack2(o1[4], o1[5]); u1.w = pack2(o1[6], o1[7]);
          u2.x = pack2(o2[0], o2[1]); u2.y = pack2(o2[2], o2[3]); u2.z = pack2(o2[4], o2[5]); u2.w = pack2(o2[6], o2[7]);
          *(uint4*)(RQ + (size_t)row * 512 + hq * 64 + dc * 8) = u1;
          *(uint4*)(RQ + (size_t)row * 512 + hq * 64 + 32 + dc * 8) = u2;
        }
      }
    } else {
      for (int idx = t; idx < 512; idx += 256) {
        const int rl = idx >> 2, dc = idx & 3, row = row0 + rl, pos = row - seq_lo;
        const float rp = (float)(pos >> 6), cp = (float)(pos & 63);
        float cs[8], sn[8];
#pragma unroll
        for (int e = 0; e < 8; ++e) {
          const int a = dc * 8 + e;
          const float inv = powf(10000.f, -(float)(a & 15) / 16.f);
          const float ang = (a < 16 ? rp : cp) * inv;
          cs[e] = isx ? cosf(ang) : 1.f; sn[e] = isx ? sinf(ang) : 0.f;
        }
        for (int g = 0; g < 2; ++g) {
          const bf16x8 x1 = *(const bf16x8*)(P + (size_t)row * PLD + 2560 + g * 64 + dc * 8);
          const bf16x8 x2 = *(const bf16x8*)(P + (size_t)row * PLD + 2560 + g * 64 + 32 + dc * 8);
          float o1[8], o2[8];
#pragma unroll
          for (int e = 0; e < 8; ++e) {
            const float a = bf2f((bf16_t)x1[e]), b = bf2f((bf16_t)x2[e]);
            o1[e] = a * cs[e] - b * sn[e]; o2[e] = b * cs[e] + a * sn[e];
          }
          uint4 u1, u2;
          u1.x = pack2(o1[0], o1[1]); u1.y = pack2(o1[2], o1[3]); u1.z = pack2(o1[4], o1[5]); u1.w = pack2(o1[6], o1[7]);
          u2.x = pack2(o2[0], o2[1]); u2.y = pack2(o2[2], o2[3]); u2.z = pack2(o2[4], o2[5]); u2.w = pack2(o2[6], o2[7]);
          *(uint4*)(RK + (size_t)row * 128 + g * 64 + dc * 8) = u1;
          *(uint4*)(RK + (size_t)row * 128 + g * 64 + 32 + dc * 8) = u2;
        }
      }
      {
        const int col8 = t & 15, rsub = t >> 4;
        for (int i = 0; i < 8; ++i) {
          const int rl = rsub + 16 * i;
          *(uint4*)(T + rl * 136 + col8 * 8) = *(const uint4*)(P + (size_t)(row0 + rl) * PLD + 2688 + col8 * 8);
        }
        __syncthreads();
        const int d = t & 127, shf = t >> 7;
        const int b = isx ? (sc >> 6) : ((sc - 128) >> 1);
        const int pos0 = row0 - seq_lo;
        bf16_t* dst = isx ? AVTX + ((size_t)(b * 2 + (d >> 6)) * 64 + (d & 63)) * 8192 + pos0
                          : AVTC + ((size_t)(b * 2 + (d >> 6)) * 64 + (d & 63)) * 256 + pos0;
#pragma unroll
        for (int s8 = 0; s8 < 8; ++s8) {
          const bf16_t* q = T + (shf * 64 + s8 * 8) * 136 + d;
          uint4 o;
          o.x = (unsigned)q[0] | ((unsigned)q[136] << 16); o.y = (unsigned)q[2 * 136] | ((unsigned)q[3 * 136] << 16);
          o.z = (unsigned)q[4 * 136] | ((unsigned)q[5 * 136] << 16); o.w = (unsigned)q[6 * 136] | ((unsigned)q[7 * 136] << 16);
          *(uint4*)(dst + shf * 64 + s8 * 8) = o;
        }
        __syncthreads();
      }
    }
  }
}

DI void attn_item(const Params& p, int item) {
  const int g = item & 1, qb = (item >> 1) & 255, b = item >> 9;
  int t_ = threadIdx.x;
  asm volatile("" : "+v"(t_));
  const int t = t_, lane = t & 63, w = t >> 6, r = lane & 31, hh = lane >> 5;
  const int hq = g * 4 + w, q0 = qb * 32;
  const bf16_t* RQ = (const bf16_t*)(p.ws + O_RQ); const bf16_t* RK = (const bf16_t*)(p.ws + O_RK);
  const bf16_t* AVTX = (const bf16_t*)(p.ws + O_AVTX); const bf16_t* AVTC = (const bf16_t*)(p.ws + O_AVTC);
  bf16_t* MIX = (bf16_t*)(p.ws + O_HA);
  const size_t qrow = (size_t)b * 8192 + q0 + r;
  bf16x8 qf[4];
#pragma unroll
  for (int ks = 0; ks < 4; ++ks) qf[ks] = ldfrag(RQ + qrow * 512 + hq * 64 + ks * 16 + hh * 8);
  float m = p.ab_sink[hq], l = hh == 0 ? 1.f : 0.f;
  f32x16 o0 = fzero(), o1 = fzero();
  const int ipos = q0 + r;
  for (int tile = 0; tile < 17; ++tile) {
    const bf16_t* kbase; const bf16_t* vbase; int vld, k0; bool local;
    if (tile < 9) {
      k0 = q0 - 128 + tile * 32;
      if (k0 < 0 || k0 >= 8192) continue;
      kbase = RK + (size_t)(b * 8192 + k0) * 128 + g * 64;
      vbase = AVTX + (size_t)((b * 2 + g) * 64) * 8192 + k0; vld = 8192; local = true;
    } else {
      k0 = (tile - 9) * 32;
      kbase = RK + (size_t)(NTOK + b * 256 + k0) * 128 + g * 64;
      vbase = AVTC + (size_t)((b * 2 + g) * 64) * 256 + k0; vld = 256; local = false;
    }
    f32x16 s = fzero();
#pragma unroll
    for (int ks = 0; ks < 4; ++ks) s = MFMA(ldfrag(kbase + r * 128 + ks * 16 + hh * 8), qf[ks], s);
    float tmax = -INFINITY;
#pragma unroll
    for (int i = 0; i < 16; ++i) {
      const int dj = ipos - (k0 + crow(i, hh));
      const bool ok = !local || (dj <= 128 && dj >= -128);
      s[i] = ok ? s[i] : -INFINITY;
      tmax = fmaxf(tmax, s[i]);
    }
    tmax = fmaxf(tmax, __shfl_xor(tmax, 32));
    const float mn = fmaxf(m, tmax), corr = __expf(m - mn);
    m = mn; l *= corr;
#pragma unroll
    for (int i = 0; i < 16; ++i) { o0[i] *= corr; o1[i] *= corr; }
#pragma unroll
    for (int i = 0; i < 16; ++i) { s[i] = __expf(s[i] - mn); l += s[i]; }
#pragma unroll
    for (int s2 = 0; s2 < 2; ++s2) {
      const bf16x8 pf = pack8(s[8 * s2], s[8 * s2 + 1], s[8 * s2 + 2], s[8 * s2 + 3], s[8 * s2 + 4], s[8 * s2 + 5], s[8 * s2 + 6], s[8 * s2 + 7]);
      const bf16_t* v0 = vbase + (size_t)r * vld + 16 * s2 + 4 * hh;
      o0 = MFMA(ldfrag2(v0, v0 + 8), pf, o0);
      const bf16_t* v1 = v0 + (size_t)32 * vld;
      o1 = MFMA(ldfrag2(v1, v1 + 8), pf, o1);
    }
  }
  l += __shfl_xor(l, 32);
  const float inv = 1.f / l;
  bf16_t* dst = MIX + qrow * 1024 + 512 + hq * 64;
#pragma unroll
  for (int q4 = 0; q4 < 4; ++q4) {
    const int d = 8 * q4 + 4 * hh;
    uint2 u;
    u.x = pack2(o0[4 * q4] * inv, o0[4 * q4 + 1] * inv); u.y = pack2(o0[4 * q4 + 2] * inv, o0[4 * q4 + 3] * inv);
    *(uint2*)(dst + d) = u;
    u.x = pack2(o1[4 * q4] * inv, o1[4 * q4 + 1] * inv); u.y = pack2(o1[4 * q4 + 2] * inv, o1[4 * q4 + 3] * inv);
    *(uint2*)(dst + 32 + d) = u;
  }
}

DI void mlstm_local_item(const Params& p, int item, char* smem) {
  float* gs = (float*)smem;
  float* wv = gs + 512;
  float* msc = wv + 256;
  int t_ = threadIdx.x;
  asm volatile("" : "+v"(t_));
  const int t = t_, lane = t & 63, w = t >> 6, wm = w >> 1, wn = w & 1, r = lane & 31, hh = lane >> 5;
  const int bh = item / NSTEP, nc = item % NSTEP, b = bh >> 2, h = bh & 3;
  const int sc = nc < 2 ? 128 + b * 2 + nc : b * 64 + (nc - 2);
  const int row0 = sc * 128;
  const float* GL = (const float*)(p.ws + O_GL);
  const bf16_t* KT = (const bf16_t*)(p.ws + O_KT) + (size_t)(sc * 4 + h) * 16384;
  const bf16_t* VT = (const bf16_t*)(p.ws + O_VT) + (size_t)(sc * 4 + h) * 16384;
  for (int i = t; i < 512; i += 256) { const int ty = i >> 7, s = i & 127; gs[i] = GL[(size_t)(row0 + s) * 16 + ty * 4 + h]; }
  __syncthreads();
  {
    const int dir = t >> 7, s = t & 127;
    float wval, tot = 0.f;
    if (dir == 0) {
      float bsum = 0.f;
      for (int j = 0; j < 128; ++j) { const float f = gs[128 + j]; tot += f; if (j <= s) bsum += f; }
      wval = tot - bsum + gs[s];
    } else {
      float pre = 0.f;
      for (int j = 0; j < 128; ++j) { const float f = gs[384 + j]; tot += f; if (j < s) pre += f; }
      wval = pre + gs[256 + s];
    }
    wv[dir * 128 + s] = wval;
    if (s == 0) msc[dir] = tot;
  }
  __syncthreads();
  {
    const int dir = t >> 7, s = t & 127;
    float mx = -INFINITY;
    for (int j = 0; j < 128; ++j) mx = fmaxf(mx, wv[dir * 128 + j]);
    const float wval = wv[dir * 128 + s];
    __syncthreads();
    wv[dir * 128 + s] = expf(wval - mx);
    if (s == 0) msc[2 + dir] = mx;
  }
  __syncthreads();
  float* DC = (float*)(p.ws + O_DC);
#pragma unroll 1
  for (int d = 0; d < 2; ++d) {
    f32x16 acc[2][2];
#pragma unroll
    for (int i = 0; i < 2; ++i)
#pragma unroll
      for (int j = 0; j < 2; ++j) acc[i][j] = fzero();
#pragma unroll 2
    for (int ks = 0; ks < 8; ++ks) {
      const bf16x8 ra0 = ldfrag(VT + (wm * 64 + r) * 128 + ks * 16 + hh * 8);
      const bf16x8 ra1 = ldfrag(VT + (wm * 64 + 32 + r) * 128 + ks * 16 + hh * 8);
      const bf16x8 b0 = ldfrag(KT + (wn * 64 + r) * 128 + ks * 16 + hh * 8);
      const bf16x8 b1 = ldfrag(KT + (wn * 64 + 32 + r) * 128 + ks * 16 + hh * 8);
      const float* ww = wv + d * 128 + ks * 16 + hh * 8;
      const bf16x8 a0 = pack8(bf2f((bf16_t)ra0[0]) * ww[0], bf2f((bf16_t)ra0[1]) * ww[1], bf2f((bf16_t)ra0[2]) * ww[2], bf2f((bf16_t)ra0[3]) * ww[3],
                              bf2f((bf16_t)ra0[4]) * ww[4], bf2f((bf16_t)ra0[5]) * ww[5], bf2f((bf16_t)ra0[6]) * ww[6], bf2f((bf16_t)ra0[7]) * ww[7]);
      const bf16x8 a1 = pack8(bf2f((bf16_t)ra1[0]) * ww[0], bf2f((bf16_t)ra1[1]) * ww[1], bf2f((bf16_t)ra1[2]) * ww[2], bf2f((bf16_t)ra1[3]) * ww[3],
                              bf2f((bf16_t)ra1[4]) * ww[4], bf2f((bf16_t)ra1[5]) * ww[5], bf2f((bf16_t)ra1[6]) * ww[6], bf2f((bf16_t)ra1[7]) * ww[7]);
      acc[0][0] = MFMA(a0, b0, acc[0][0]);
      acc[0][1] = MFMA(a0, b1, acc[0][1]);
      acc[1][0] = MFMA(a1, b0, acc[1][0]);
      acc[1][1] = MFMA(a1, b1, acc[1][1]);
    }
    float* dst = DC + ((size_t)(bh * 2 + d) * NSTEP + nc) * 16384;
#pragma unroll
    for (int mi = 0; mi < 2; ++mi)
#pragma unroll
      for (int ni = 0; ni < 2; ++ni)
#pragma unroll
        for (int i = 0; i < 16; ++i)
          dst[(wm * 64 + mi * 32 + crow(i, hh)) * 128 + wn * 64 + ni * 32 + r] = acc[mi][ni][i];
  }
  {
    const int dir = t >> 7, k = t & 127;
    float s = 0.f;
    for (int s8 = 0; s8 < 16; ++s8) {
      const bf16x8 v = ldfrag(KT + k * 128 + s8 * 8);
#pragma unroll
      for (int e = 0; e < 8; ++e) s += wv[dir * 128 + s8 * 8 + e] * bf2f((bf16_t)v[e]);
    }
    ((float*)(p.ws + O_DN))[((size_t)(bh * 2 + dir) * NSTEP + nc) * 128 + k] = s;
    if (k == 0) {
      ((float*)(p.ws + O_GSC))[(bh * 2 + dir) * NSTEP + nc] = msc[dir];
      ((float*)(p.ws + O_MLOC))[(bh * 2 + dir) * NSTEP + nc] = msc[2 + dir];
    }
  }
  __syncthreads();
}

DI int chain_nc(int dir, int i) { return dir == 0 ? i : (i < 2 ? 1 - i : 67 - i); }
DI void phase_scan(const Params& p) {
  const float* GSC = (const float*)(p.ws + O_GSC); const float* MLOC = (const float*)(p.ws + O_MLOC);
  const float* DC = (const float*)(p.ws + O_DC); const float* DN = (const float*)(p.ws + O_DN);
  bf16_t* CST = (bf16_t*)(p.ws + O_CST); float* NST = (float*)(p.ws + O_NST); float* MST = (float*)(p.ws + O_MST);
  const int t = threadIdx.x;
  for (int item = blockIdx.x; item < 16 * 64 + 8; item += gridDim.x) {
    if (item < 1024) {
      const int chain = item >> 6, e = (item & 63) * 256 + t, dir = chain & 1;
      const int ev = e >> 7, ek = e & 127;
      const int epos = ((((ev >> 5) * 8 + (ek >> 4)) * 64) + ((ek >> 3) & 1) * 32 + (ev & 31)) * 8 + (ek & 7);
      float m = 0.f, C = 0.f;
      for (int i = 0; i < NSTEP; ++i) {
        const int nc = chain_nc(dir, i);
        if (i >= 2) {
          CST[((size_t)chain * 64 + (nc - 2)) * 16384 + epos] = f2bf(C);
          if (e == 0) MST[chain * 64 + nc - 2] = m;
        }
        const float g = GSC[chain * NSTEP + nc], ml = MLOC[chain * NSTEP + nc];
        const float mn = fmaxf(g + m, ml);
        C = expf(g + m - mn) * C + expf(ml - mn) * DC[((size_t)chain * NSTEP + nc) * 16384 + e];
        m = mn;
      }
    } else {
      const int idx = (item - 1024) * 256 + t;
      const int chain = idx >> 7, k = idx & 127, dir = chain & 1;
      float m = 0.f, n = 0.f;
      for (int i = 0; i < NSTEP; ++i) {
        const int nc = chain_nc(dir, i);
        if (i >= 2) NST[((size_t)chain * 64 + (nc - 2)) * 128 + k] = n;
        const float g = GSC[chain * NSTEP + nc], ml = MLOC[chain * NSTEP + nc];
        const float mn = fmaxf(g + m, ml);
        n = expf(g + m - mn) * n + expf(ml - mn) * DN[((size_t)chain * NSTEP + nc) * 128 + k];
        m = mn;
      }
    }
  }
}

DI void mlstm_out_item(const Params& p, int item, char* smem) {
  float* gs = (float*)smem;
  float* bb = gs + 512;
  float* lib = bb + 256;
  float* mrow = lib + 256;
  float* aT = mrow + 256;
  float* nq = aT + 256;
  float* nst = nq + 256;
  char* sK = smem + 8192;
  char* sV = sK + 32768;
  int t_ = threadIdx.x;
  asm volatile("" : "+v"(t_));
  const int t = t_, lane = t & 63, w = t >> 6, r = lane & 31, hh = lane >> 5;
  const int bh = item >> 6, c = item & 63, b = bh >> 2, h = bh & 3;
  const int sc = b * 64 + c, row0 = sc * 128;
  const float* GL = (const float*)(p.ws + O_GL);
  const bf16_t* Qc = (const bf16_t*)(p.ws + O_QC); const bf16_t* Kc = (const bf16_t*)(p.ws + O_KC);
  const bf16_t* VT = (const bf16_t*)(p.ws + O_VT) + (size_t)(sc * 4 + h) * 16384;
  const bf16_t* P = (const bf16_t*)(p.ws + O_P);
  const float* MST = (const float*)(p.ws + O_MST);
  bf16_t* MIX = (bf16_t*)(p.ws + O_HA);
#pragma unroll
  for (int i = 0; i < 8; ++i) {
    const int q = t + 256 * i, row = q >> 4, cc = q & 15;
    const int so = row * 256 + ((cc ^ (row & 15)) << 4);
    *(uint4*)(sK + so) = *(const uint4*)(Kc + (size_t)(row0 + row) * 512 + h * 128 + cc * 8);
    *(uint4*)(sV + so) = *(const uint4*)(VT + row * 128 + cc * 8);
  }
  for (int i = t; i < 512; i += 256) { const int ty = i >> 7, s = i & 127; gs[i] = GL[(size_t)(row0 + s) * 16 + ty * 4 + h]; }
  {
    const int dir = t >> 7, k = t & 127;
    nst[t] = ((const float*)(p.ws + O_NST))[((size_t)(bh * 2 + dir) * 64 + c) * 128 + k];
  }
  __syncthreads();
  {
    const int dir = t >> 7, s = t & 127;
    float bsum = 0.f;
    if (dir == 0) { for (int j = 0; j <= s; ++j) bsum += gs[128 + j]; }
    else { for (int j = s; j < 128; ++j) bsum += gs[384 + j]; }
    bb[t] = bsum;
    lib[t] = gs[dir * 256 + s] - bsum;
    const bf16_t* qr = Qc + (size_t)(row0 + s) * 512 + h * 128;
    float acc = 0.f;
    for (int k8 = 0; k8 < 16; ++k8) {
      const bf16x8 v = ldfrag(qr + k8 * 8);
#pragma unroll
      for (int e = 0; e < 8; ++e) acc += nst[dir * 128 + k8 * 8 + e] * bf2f((bf16_t)v[e]);
    }
    nq[t] = acc;
  }
  __syncthreads();
  {
    const int dir = t >> 7, s = t & 127;
    float pm = -INFINITY;
    if (dir == 0) { for (int j = 0; j <= s; ++j) pm = fmaxf(pm, lib[j]); }
    else { for (int j = s; j < 128; ++j) pm = fmaxf(pm, lib[128 + j]); }
    const float m_in = MST[(bh * 2 + dir) * 64 + c];
    const float mr = bb[t] + fmaxf(m_in, pm);
    mrow[t] = mr;
    aT[t] = expf(bb[t] + m_in - mr);
  }
  __syncthreads();
  const int tl = w * 32 + r;
  const bf16_t* qrow = Qc + (size_t)(row0 + tl) * 512 + h * 128 + hh * 8;
  bf16x8 qf[8];
#pragma unroll
  for (int ks = 0; ks < 8; ++ks) qf[ks] = ldfrag(qrow + ks * 16);
  const int swz = r & 15;
  const char* kp[8]; const char* vp[16];
#pragma unroll
  for (int ks = 0; ks < 8; ++ks) kp[ks] = sK + r * 256 + (((ks * 2 + hh) ^ swz) << 4);
#pragma unroll
  for (int cc = 0; cc < 16; ++cc) vp[cc] = sV + r * 256 + 8 * hh + ((cc ^ swz) << 4);
  float* Hb = (float*)(p.ws + O_DC) + (size_t)item * 16384 + tl;
  float* Hbh = Hb + 4 * hh * 128;
  f32x16 outa[4];
#define MLSTM_DIR(DIR)                                                                                                   \
  {                                                                                                                      \
    const bf16_t* CSTl = (const bf16_t*)(p.ws + O_CST) + ((size_t)(bh * 2 + DIR) * 64 + c) * 16384 + lane * 8;           \
    const float bbt = bb[DIR * 128 + tl], mrt = mrow[DIR * 128 + tl], at = aT[DIR * 128 + tl];                            \
    float dsum = 0.f;                                                                                                    \
    const float* libp = lib + DIR * 128 + 4 * hh;                                                                        \
    const int tb = tl - 4 * hh;                                                                                          \
    bf16x8 pf[8];                                                                                                        \
    _Pragma("unroll") for (int half = 0; half < 2; ++half) {                                                             \
      f32x16 st[2];                                                                                                      \
      st[0] = fzero(); st[1] = fzero();                                                                                  \
      _Pragma("unroll") for (int ks = 0; ks < 8; ++ks) {                                                                 \
        _Pragma("unroll") for (int r2 = 0; r2 < 2; ++r2)                                                                 \
          st[r2] = MFMA(*(const bf16x8*)(kp[ks] + (half * 2 + r2) * 8192), qf[ks], st[r2]);                              \
      }                                                                                                                  \
      _Pragma("unroll") for (int r2 = 0; r2 < 2; ++r2) {                                                                 \
        const int rb = half * 2 + r2;                                                                                    \
        _Pragma("unroll") for (int i = 0; i < 16; ++i) {                                                                 \
          const int sc_ = rb * 32 + (i & 3) + 8 * (i >> 2);                                           \
          const int diff = DIR == 0 ? (tb - sc_) : (sc_ - tb);                                                           \
          const float msk = (float)((unsigned)(~diff) >> 31);                                                            \
          const float v = st[r2][i] * __expf(fminf(bbt + libp[sc_] - mrt, 0.f)) * msk;                                    \
          st[r2][i] = v; dsum += v;                                                                                      \
        }                                                                                                                \
        pf[rb * 2] = pack8(st[r2][0], st[r2][1], st[r2][2], st[r2][3], st[r2][4], st[r2][5], st[r2][6], st[r2][7]);      \
        pf[rb * 2 + 1] = pack8(st[r2][8], st[r2][9], st[r2][10], st[r2][11], st[r2][12], st[r2][13], st[r2][14], st[r2][15]); \
      }                                                                                                                  \
      __builtin_amdgcn_sched_barrier(0);                                                                                 \
    }                                                                                                                    \
    dsum += __shfl_xor(dsum, 32);                                                                                        \
    const float den = dsum + at * nq[DIR * 128 + tl];                                                                    \
    const float dinv = 1.f / fmaxf(fabsf(den), expf(-mrt));                                                              \
    _Pragma("unroll") for (int half = 0; half < 2; ++half) {                                                             \
      f32x16 ha[2];                                                                                                      \
      ha[0] = fzero(); ha[1] = fzero();                                                                                  \
      _Pragma("unroll") for (int ks = 0; ks < 8; ++ks) {                                                                 \
        _Pragma("unroll") for (int r2 = 0; r2 < 2; ++r2)                                                                 \
          ha[r2] = MFMA(ldfrag(CSTl + ((half * 2 + r2) * 8 + ks) * 512), qf[ks], ha[r2]);                                \
        if (ks == 3) __builtin_amdgcn_sched_barrier(0);                                                                  \
      }                                                                                                                  \
      _Pragma("unroll") for (int r2 = 0; r2 < 2; ++r2)                                                                   \
        _Pragma("unroll") for (int i = 0; i < 16; ++i) ha[r2][i] *= at;                                                  \
      __builtin_amdgcn_sched_barrier(0);                                                                                 \
      _Pragma("unroll") for (int kk = 0; kk < 8; ++kk) {                                                                 \
        _Pragma("unroll") for (int r2 = 0; r2 < 2; ++r2) {                                                               \
          const s16x4 lo = *(const s16x4*)(vp[2 * kk] + (half * 2 + r2) * 8192);                                         \
          const s16x4 hi = *(const s16x4*)(vp[2 * kk + 1] + (half * 2 + r2) * 8192);                                     \
          ha[r2] = MFMA(__builtin_shufflevector(lo, hi, 0, 1, 2, 3, 4, 5, 6, 7), pf[kk], ha[r2]);                        \
        }                                                                                                                \
      }                                                                                                                  \
      _Pragma("unroll") for (int r2 = 0; r2 < 2; ++r2)                                                                   \
        _Pragma("unroll") for (int i = 0; i < 16; ++i) {                                                                 \
          float* hp = Hbh + ((half * 2 + r2) * 32 + (i & 3) + 8 * (i >> 2)) * 128;                                       \
          if (DIR == 0) *hp = ha[r2][i] * dinv;                                                                          \
          else outa[half * 2 + r2][i] = *hp + ha[r2][i] * dinv;                                                          \
        }                                                                                                                \
      __builtin_amdgcn_sched_barrier(0);                                                                                 \
    }                                                                                                                    \
  }
  MLSTM_DIR(0)
  MLSTM_DIR(1)
#undef MLSTM_DIR
  float ss = 0.f;
#pragma unroll
  for (int rb = 0; rb < 4; ++rb)
#pragma unroll
    for (int i = 0; i < 16; ++i) ss += outa[rb][i] * outa[rb][i];
  ss += __shfl_xor(ss, 32);
  const float rn = rsqrtf(ss * (1.f / 128.f) + EPS);
  const size_t row = (size_t)row0 + tl;
#pragma unroll
  for (int rb = 0; rb < 4; ++rb)
#pragma unroll
    for (int q4 = 0; q4 < 4; ++q4) {
      const int v = rb * 32 + 8 * q4 + 4 * hh;
      const s16x4 ov = *(const s16x4*)(P + row * PLD + 1536 + h * 128 + v);
      const float4 hg = *(const float4*)(p.ab_head_g + h * 128 + v);
      const float y0 = outa[rb][4 * q4] * rn * hg.x * sigmf(bf2f((bf16_t)ov[0]));
      const float y1 = outa[rb][4 * q4 + 1] * rn * hg.y * sigmf(bf2f((bf16_t)ov[1]));
      const float y2 = outa[rb][4 * q4 + 2] * rn * hg.z * sigmf(bf2f((bf16_t)ov[2]));
      const float y3 = outa[rb][4 * q4 + 3] * rn * hg.w * sigmf(bf2f((bf16_t)ov[3]));
      uint2 u; u.x = pack2(y0, y1); u.y = pack2(y2, y3);
      *(uint2*)(MIX + row * 1024 + h * 128 + v) = u;
    }
  __syncthreads();
}

DI void phase_topk(const Params& p, char* smem) {
  unsigned* vals = (unsigned*)smem;
  unsigned* hist = vals + 8448;
  unsigned* cntg = hist + 256;
  unsigned* cnte = cntg + 256;
  unsigned* misc = cnte + 256;
  const float* AFF = (const float*)(p.ws + O_AFF);
  int* IDX = (int*)(p.ws + O_IDX); float* GATE = (float*)(p.ws + O_GATE);
  const int t = threadIdx.x;
  for (int item = blockIdx.x; item < 32; item += gridDim.x) {
    const float* a = AFF + (size_t)item * 8192;
    for (int i = t; i < 8192; i += 256) vals[i + (i >> 5)] = __float_as_uint(a[i]);
    unsigned prefix = 0, remaining = 1024;
    for (int pass = 0; pass < 4; ++pass) {
      const int shift = 24 - 8 * pass;
      hist[t] = 0;
      __syncthreads();
      const unsigned mask = pass == 0 ? 0u : (0xFFFFFFFFu << (shift + 8));
      for (int i = t; i < 8192; i += 256) {
        const unsigned u = vals[i + (i >> 5)];
        if ((u & mask) == (prefix & mask)) atomicAdd(&hist[(u >> shift) & 255], 1u);
      }
      __syncthreads();
      if (t == 0) {
        unsigned cum = 0; int sel = 0;
        for (int bin = 255; bin >= 0; --bin) {
          const unsigned cc = hist[bin];
          if (cum + cc >= remaining) { sel = bin; break; }
          cum += cc;
        }
        misc[0] = prefix | ((unsigned)sel << shift);
        misc[1] = remaining - cum;
      }
      __syncthreads();
      prefix = misc[0]; remaining = misc[1];
      __syncthreads();
    }
    const unsigned T = prefix, need_eq = remaining;
    unsigned cg_ = 0, ce = 0;
    for (int j = 0; j < 32; ++j) {
      const int n = t * 32 + j;
      const unsigned u = vals[n + (n >> 5)];
      cg_ += u > T; ce += u == T;
    }
    cntg[t] = cg_; cnte[t] = ce;
    __syncthreads();
    unsigned pg = 0, pe = 0;
    for (int j = 0; j < t; ++j) { pg += cntg[j]; pe += cnte[j]; }
    for (int j = 0; j < 32; ++j) {
      const int n = t * 32 + j;
      const unsigned u = vals[n + (n >> 5)];
      if (u > T) { IDX[item * 1024 + pg] = n; GATE[item * 1024 + pg] = __uint_as_float(u); ++pg; }
      else if (u == T) {
        if (pe < need_eq) { const unsigned slot = 1024 - need_eq + pe; IDX[item * 1024 + slot] = n; GATE[item * 1024 + slot] = __uint_as_float(u); }
        ++pe;
      }
    }
    __syncthreads();
  }
}

DI void phase_stats(const Params& p, char* smem) {
  float* red = (float*)smem;
  const bf16_t* GVT = (const bf16_t*)(p.ws + O_GVT);
  float* STATS = (float*)(p.ws + O_STATS);
  const int t = threadIdx.x, qq = t & 31, cg_ = t >> 5;
  for (int chunk = blockIdx.x; chunk < 128; chunk += gridDim.x) {
    const bf16_t* base = GVT + (size_t)chunk * 2048 * 128 + qq * 4;
    float s[4] = {0.f, 0.f, 0.f, 0.f}, s2[4] = {0.f, 0.f, 0.f, 0.f};
    for (int c = cg_; c < 2048; c += 8) {
      const s16x4 v = *(const s16x4*)(base + (size_t)c * 128);
#pragma unroll
      for (int e = 0; e < 4; ++e) { const float f = bf2f((bf16_t)v[e]); s[e] += f; s2[e] += f * f; }
    }
#pragma unroll
    for (int e = 0; e < 4; ++e) { red[(cg_ * 128 + qq * 4 + e) * 2] = s[e]; red[(cg_ * 128 + qq * 4 + e) * 2 + 1] = s2[e]; }
    __syncthreads();
    if (t < 128) {
      float a = 0.f, b2 = 0.f;
      for (int g = 0; g < 8; ++g) { a += red[(g * 128 + t) * 2]; b2 += red[(g * 128 + t) * 2 + 1]; }
      const float mu = a * (1.f / 2048.f);
      const float var = fmaxf(b2 * (1.f / 2048.f) - mu * mu, 0.f);
      STATS[(size_t)(chunk * 128 + t) * 2] = mu;
      STATS[(size_t)(chunk * 128 + t) * 2 + 1] = rsqrtf(var + EPS);
    }
    __syncthreads();
  }
}
DI void phase_spatial(const Params& p, char* smem) {
  float* smu = (float*)smem;
  float* srs = smu + 128;
  const bf16_t* GVT = (const bf16_t*)(p.ws + O_GVT); const bf16_t* U = (const bf16_t*)(p.ws + O_U);
  const float* STATS = (const float*)(p.ws + O_STATS);
  bf16_t* UV = (bf16_t*)(p.ws + O_UV);
  for (int item = blockIdx.x; item < 1024; item += gridDim.x) {
    int t_ = threadIdx.x;
    asm volatile("" : "+v"(t_));
    const int t = t_, lane = t & 63, w = t >> 6, r = lane & 31, hh = lane >> 5;
    const int chunk = item >> 3, g = item & 7;
    if (t < 128) { smu[t] = STATS[(size_t)(chunk * 128 + t) * 2]; srs[t] = STATS[(size_t)(chunk * 128 + t) * 2 + 1]; }
    __syncthreads();
    const float* Ws = p.gm_w_s + (size_t)g * 16384;
    f32x16 acc[4][2];
#pragma unroll
    for (int i = 0; i < 4; ++i) { acc[i][0] = fzero(); acc[i][1] = fzero(); }
    const int cA = g * 256 + w * 64 + r, cB = cA + 32;
    const float lgA = p.gm_ln_g[cA], lbA = p.gm_ln_b[cA], lgB = p.gm_ln_g[cB], lbB = p.gm_ln_b[cB];
    const bf16_t* vA = GVT + ((size_t)chunk * 2048 + cA) * 128 + hh * 8;
    const bf16_t* vB = GVT + ((size_t)chunk * 2048 + cB) * 128 + hh * 8;
    for (int ks = 0; ks < 8; ++ks) {
      const bf16x8 ra = ldfrag(vA + ks * 16), rbv = ldfrag(vB + ks * 16);
      const float* mu = smu + ks * 16 + hh * 8; const float* rs = srs + ks * 16 + hh * 8;
      const bf16x8 bA = pack8((bf2f((bf16_t)ra[0]) - mu[0]) * rs[0] * lgA + lbA, (bf2f((bf16_t)ra[1]) - mu[1]) * rs[1] * lgA + lbA,
                              (bf2f((bf16_t)ra[2]) - mu[2]) * rs[2] * lgA + lbA, (bf2f((bf16_t)ra[3]) - mu[3]) * rs[3] * lgA + lbA,
                              (bf2f((bf16_t)ra[4]) - mu[4]) * rs[4] * lgA + lbA, (bf2f((bf16_t)ra[5]) - mu[5]) * rs[5] * lgA + lbA,
                              (bf2f((bf16_t)ra[6]) - mu[6]) * rs[6] * lgA + lbA, (bf2f((bf16_t)ra[7]) - mu[7]) * rs[7] * lgA + lbA);
      const bf16x8 bB = pack8((bf2f((bf16_t)rbv[0]) - mu[0]) * rs[0] * lgB + lbB, (bf2f((bf16_t)rbv[1]) - mu[1]) * rs[1] * lgB + lbB,
                              (bf2f((bf16_t)rbv[2]) - mu[2]) * rs[2] * lgB + lbB, (bf2f((bf16_t)rbv[3]) - mu[3]) * rs[3] * lgB + lbB,
                              (bf2f((bf16_t)rbv[4]) - mu[4]) * rs[4] * lgB + lbB, (bf2f((bf16_t)rbv[5]) - mu[5]) * rs[5] * lgB + lbB,
                              (bf2f((bf16_t)rbv[6]) - mu[6]) * rs[6] * lgB + lbB, (bf2f((bf16_t)rbv[7]) - mu[7]) * rs[7] * lgB + lbB);
#pragma unroll
      for (int rb = 0; rb < 4; ++rb) {
        const float* wp = Ws + (rb * 32 + r) * 128 + ks * 16 + hh * 8;
        const float4 w0 = *(const float4*)wp, w1 = *(const float4*)(wp + 4);
        const bf16x8 a = pack8(w0.x, w0.y, w0.z, w0.w, w1.x, w1.y, w1.z, w1.w);
        acc[rb][0] = MFMA(a, bA, acc[rb][0]);
        acc[rb][1] = MFMA(a, bB, acc[rb][1]);
      }
    }
#pragma unroll
    for (int rb = 0; rb < 4; ++rb)
#pragma unroll
      for (int i = 0; i < 16; ++i) {
        const int pp = rb * 32 + crow(i, hh);
        const float bs = p.gm_b_s[g * 128 + pp];
        const size_t row = (size_t)chunk * 128 + pp;
        UV[row * 2048 + cA] = f2bf(bf2f(U[row * 2048 + cA]) * (acc[rb][0][i] + bs));
        UV[row * 2048 + cB] = f2bf(bf2f(U[row * 2048 + cB]) * (acc[rb][1][i] + bs));
      }
    __syncthreads();
  }
}

struct EpiBf16 {
  bf16_t* dst; int ld;
  DI void operator()(f32x16 (&acc)[2][2], int mb, int nb, int r, int hh) const {
#pragma unroll
    for (int mi = 0; mi < 2; ++mi)
#pragma unroll
      for (int ni = 0; ni < 2; ++ni)
#pragma unroll
        for (int i = 0; i < 16; ++i)
          dst[(size_t)(mb + mi * 32 + crow(i, hh)) * ld + nb + ni * 32 + r] = f2bf(acc[mi][ni][i]);
  }
};
struct EpiRes {
  float* out; const float* base; const float* gate;
  DI void operator()(f32x16 (&acc)[2][2], int mb, int nb, int r, int hh) const {
#pragma unroll
    for (int ni = 0; ni < 2; ++ni) {
      const int n = nb + ni * 32 + r;
      const float gt = gate[n];
#pragma unroll
      for (int mi = 0; mi < 2; ++mi) {
        const size_t o0 = (size_t)(mb + mi * 32 + 4 * hh) * 1024 + n;
        float* op = out + o0; const float* bp = base + o0;
#pragma unroll
        for (int i = 0; i < 16; ++i) {
          const int off = ((i & 3) + 8 * (i >> 2)) * 1024;
          op[off] = bp[off] + gt * acc[mi][ni][i];
        }
        __builtin_amdgcn_sched_barrier(0);
      }
    }
  }
};
struct EpiGelu {
  bf16_t* U; bf16_t* GVT; int m0, n0;
  DI void operator()(f32x16 (&acc)[2][2], int mb, int nb, int r, int hh) const {
    if (n0 < 2048) {
#pragma unroll
      for (int mi = 0; mi < 2; ++mi)
#pragma unroll
        for (int ni = 0; ni < 2; ++ni)
#pragma unroll
          for (int i = 0; i < 16; ++i)
            U[(size_t)(m0 + mb + mi * 32 + crow(i, hh)) * 2048 + n0 + nb + ni * 32 + r] = f2bf(geluf(acc[mi][ni][i]));
    } else {
      const int chunk = m0 >> 7;
#pragma unroll
      for (int mi = 0; mi < 2; ++mi)
#pragma unroll
        for (int ni = 0; ni < 2; ++ni) {
          const int cc = n0 - 2048 + nb + ni * 32 + r;
          bf16_t* d = GVT + ((size_t)chunk * 2048 + cc) * 128 + mb + mi * 32 + 4 * hh;
#pragma unroll
          for (int q4 = 0; q4 < 4; ++q4) {
            uint2 u;
            u.x = pack2(geluf(acc[mi][ni][4 * q4]), geluf(acc[mi][ni][4 * q4 + 1]));
            u.y = pack2(geluf(acc[mi][ni][4 * q4 + 2]), geluf(acc[mi][ni][4 * q4 + 3]));
            *(uint2*)(d + 8 * q4) = u;
          }
        }
    }
  }
};
struct EpiSwiglu {
  bf16_t* hid;
  DI void operator()(f32x16 (&acc)[2][2], int mb, int nb, int r, int hh) const {
    const int f = (nb >> 1) + r;
#pragma unroll
    for (int mi = 0; mi < 2; ++mi)
#pragma unroll
      for (int i = 0; i < 16; ++i) {
        const float gv = acc[mi][0][i], uv = acc[mi][1][i];
        hid[(size_t)(mb + mi * 32 + crow(i, hh)) * 1024 + f] = f2bf(siluf(gv) * uv);
      }
  }
};
struct EpiMoeOut {
  float* out; const int* idx; const float* gate; const float* gt2;
  int n0;
  DI void operator()(f32x16 (&acc)[2][2], int mb, int nb, int r, int hh) const {
#pragma unroll
    for (int mi = 0; mi < 2; ++mi)
#pragma unroll
      for (int i = 0; i < 16; ++i) {
        const int slot = mb + mi * 32 + crow(i, hh);
        const int tok = idx[slot];
        const float gs = gate[slot];
#pragma unroll
        for (int ni = 0; ni < 2; ++ni) {
          const int n = nb + ni * 32 + r;
          unsafeAtomicAdd(out + (size_t)tok * 1024 + n0 + n, gt2[n] * gs * acc[mi][ni][i]);
        }
      }
  }
};

DI void phase_moe1(const Params& p, char* smem) {
  const bf16_t* HA = (const bf16_t*)(p.ws + O_HA); const bf16_t* WGU = (const bf16_t*)(p.ws + O_MGU);
  const int* IDX = (const int*)(p.ws + O_IDX); bf16_t* HID = (bf16_t*)(p.ws + O_HID);
  const int t = threadIdx.x, lrow = t >> 3, lcol = (t & 7) * 8;
  for (int tile = blockIdx.x; tile < 32 * 8 * 16; tile += gridDim.x) {
    const int be = tile >> 7, mt = (tile >> 4) & 7, nt = tile & 15, b = be >> 4, e = be & 15;
    const bf16_t* ap[4]; const bf16_t* bp[4];
#pragma unroll
    for (int i = 0; i < 4; ++i) {
      const int tok = IDX[be * 1024 + mt * 128 + lrow + 32 * i];
      ap[i] = HA + ((size_t)b * 8192 + tok) * 1024 + lcol;
      bp[i] = WGU + ((size_t)e * 2048 + nt * 128 + lrow + 32 * i) * 1024 + lcol;
    }
    gemm_tile(ap, bp, 1024, smem, EpiSwiglu{HID + ((size_t)be * 1024 + mt * 128) * 1024 + nt * 64});
  }
}
DI void phase_moe2(const Params& p, int layer, char* smem) {
  const bf16_t* HID = (const bf16_t*)(p.ws + O_HID); const bf16_t* WD = (const bf16_t*)(p.ws + O_MD);
  const int* IDX = (const int*)(p.ws + O_IDX); const float* GATE = (const float*)(p.ws + O_GATE);
  const float* modv = (const float*)(p.ws + O_MODV);
  const int t = threadIdx.x, lrow = t >> 3, lcol = (t & 7) * 8;
  for (int tile = blockIdx.x; tile < 32 * 8 * 8; tile += gridDim.x) {
    const int be = tile >> 6, mt = (tile >> 3) & 7, nt = tile & 7, b = be >> 4, e = be & 15;
    const bf16_t* ap[4]; const bf16_t* bp[4];
#pragma unroll
    for (int i = 0; i < 4; ++i) {
      ap[i] = HID + ((size_t)be * 1024 + mt * 128 + lrow + 32 * i) * 1024 + lcol;
      bp[i] = WD + ((size_t)e * 1024 + nt * 128 + lrow + 32 * i) * 1024 + lcol;
    }
    gemm_tile(ap, bp, 1024, smem,
              EpiMoeOut{p.out + (size_t)b * 8192 * 1024, IDX + be * 1024 + mt * 128, GATE + be * 1024 + mt * 128,
                        modv + (layer * 3 + b) * 6144 + 5 * 1024 + nt * 128, nt * 128});
  }
}

DI void phase_final(const Params& p) {
  const int t = threadIdx.x, lane = t & 63, w = t >> 6;
  for (int row = blockIdx.x * 4 + w; row < NTOK; row += gridDim.x * 4) {
    float* src = p.out + (size_t)row * 1024;
    float4 xv[4]; float ss = 0.f;
#pragma unroll
    for (int i = 0; i < 4; ++i) {
      xv[i] = *(const float4*)(src + (i * 64 + lane) * 4);
      ss += xv[i].x * xv[i].x + xv[i].y * xv[i].y + xv[i].z * xv[i].z + xv[i].w * xv[i].w;
    }
    ss = wsum(ss);
    const float rstd = rsqrtf(ss * (1.f / 1024.f) + EPS);
#pragma unroll
    for (int i = 0; i < 4; ++i) {
      const int col = (i * 64 + lane) * 4;
      const float4 g4 = *(const float4*)(p.final_norm_g + col);
      float4 y; y.x = xv[i].x * rstd * g4.x; y.y = xv[i].y * rstd * g4.y; y.z = xv[i].z * rstd * g4.z; y.w = xv[i].w * rstd * g4.w;
      *(float4*)(src + col) = y;
    }
  }
}

constexpr int NPHASE = 22;
DI void run_phase(const Params& p, int ph, char* smem) {
  const float* modv = (const float*)(p.ws + O_MODV);
  switch (ph) {
#if !defined(ONLY) || ONLY == 0
    case 0:
      phase_adaln(p, smem);
      __syncthreads();
      tconv(p.ab_w_in, 2832, 2832, 1024, 1, 0, (bf16_t*)(p.ws + O_WIN), 0, 1, smem);
      tconv(p.ab_w_out, 1024, 1024, 1024, 1, 0, (bf16_t*)(p.ws + O_WOUT), 0, 0, smem);
      tconv(p.gm_w_in, 4096, 4096, 1024, 1, 0, (bf16_t*)(p.ws + O_GMIN), 0, 0, smem);
      tconv(p.gm_w_out, 1024, 1024, 2048, 1, 0, (bf16_t*)(p.ws + O_GMOUT), 0, 0, smem);
      tconv_moe(p, 0, smem);
      break;
#endif
#if !defined(ONLY) || ONLY == 1
    case 1: phase_modulate<1>(p, 0, 0, smem); break;
#endif
#if !defined(ONLY) || ONLY == 2
    case 2:
      gemm_dense((const bf16_t*)(p.ws + O_HA), (const bf16_t*)(p.ws + O_WIN), NROW, PLD, 1024, smem,
                 [&](int m0, int n0) { return EpiBf16{(bf16_t*)(p.ws + O_P) + (size_t)m0 * PLD + n0, PLD}; });
      break;
#endif
#if !defined(ONLY) || ONLY == 3
    case 3: phase_prep2(p, smem); break;
#endif
#if !defined(ONLY) || ONLY == 4
    case 4:
      for (int item = blockIdx.x; item < 1024 + 8 * NSTEP; item += gridDim.x) {
        if (item < 1024) attn_item(p, item); else mlstm_local_item(p, item - 1024, smem);
      }
      break;
#endif
#if !defined(ONLY) || ONLY == 5
    case 5: phase_scan(p); break;
#endif
#if !defined(ONLY) || ONLY == 6
    case 6:
      for (int item = blockIdx.x; item < 512; item += gridDim.x) mlstm_out_item(p, item, smem);
      break;
#endif
#if !defined(ONLY) || ONLY == 7
    case 7:
      gemm_dense((const bf16_t*)(p.ws + O_HA), (const bf16_t*)(p.ws + O_WOUT), NTOK, 1024, 1024, smem,
                 [&](int m0, int n0) {
                   return EpiRes{p.out + (size_t)m0 * 1024 + n0, p.x + (size_t)m0 * 1024 + n0, modv + (0 * 3 + (m0 >> 13)) * 6144 + 2 * 1024 + n0};
                 });
      break;
#endif
#if !defined(ONLY) || ONLY == 8
    case 8: phase_modulate<2>(p, 0, 1, smem); break;
#endif
#if !defined(ONLY) || ONLY == 9
    case 9: phase_topk(p, smem); break;
#endif
#if !defined(ONLY) || ONLY == 10
    case 10: phase_moe1(p, smem); break;
#endif
#if !defined(ONLY) || ONLY == 11
    case 11: phase_moe2(p, 0, smem); break;
#endif
#if !defined(ONLY) || ONLY == 12
    case 12:
      phase_modulate<0>(p, 1, 0, smem);
      __syncthreads();
      tconv_moe(p, 1, smem);
      break;
#endif
#if !defined(ONLY) || ONLY == 13
    case 13:
      gemm_dense((const bf16_t*)(p.ws + O_HA), (const bf16_t*)(p.ws + O_GMIN), NTOK, 4096, 1024, smem,
                 [&](int m0, int n0) { return EpiGelu{(bf16_t*)(p.ws + O_U), (bf16_t*)(p.ws + O_GVT), m0, n0}; });
      break;
#endif
#if !defined(ONLY) || ONLY == 14
    case 14: phase_stats(p, smem); break;
#endif
#if !defined(ONLY) || ONLY == 15
    case 15: phase_spatial(p, smem); break;
#endif
#if !defined(ONLY) || ONLY == 16
    case 16:
      gemm_dense((const bf16_t*)(p.ws + O_UV), (const bf16_t*)(p.ws + O_GMOUT), NTOK, 1024, 2048, smem,
                 [&](int m0, int n0) {
                   return EpiRes{p.out + (size_t)m0 * 1024 + n0, p.out + (size_t)m0 * 1024 + n0, modv + (1 * 3 + (m0 >> 13)) * 6144 + 2 * 1024 + n0};
                 });
      break;
#endif
#if !defined(ONLY) || ONLY == 17
    case 17: phase_modulate<2>(p, 1, 1, smem); break;
#endif
#if !defined(ONLY) || ONLY == 18
    case 18: phase_topk(p, smem); break;
#endif
#if !defined(ONLY) || ONLY == 19
    case 19: phase_moe1(p, smem); break;
#endif
#if !defined(ONLY) || ONLY == 20
    case 20: phase_moe2(p, 1, smem); break;
#endif
#if !defined(ONLY) || ONLY == 21
    case 21: phase_final(p); break;
#endif
    default: break;
  }
}

#if COOP
__global__ void __launch_bounds__(256, 2) mega(Params p) {
  __shared__ __attribute__((aligned(16))) char smem[73728];
  cg::grid_group grid = cg::this_grid();
#define PHX(n) run_phase(p, n, smem); grid.sync();
  PHX(0) PHX(1) PHX(2) PHX(3) PHX(4) PHX(5) PHX(6) PHX(7) PHX(8) PHX(9) PHX(10)
  PHX(11) PHX(12) PHX(13) PHX(14) PHX(15) PHX(16) PHX(17) PHX(18) PHX(19) PHX(20)
  run_phase(p, 21, smem);
}
#else
__global__ void __launch_bounds__(256, 2) mega(Params p, int ph) {
  __shared__ __attribute__((aligned(16))) char smem[73728];
  run_phase(p, ph, smem);
}
#endif

extern "C" void kernel_launch(void* const* d_in, const int* in_sizes, int n_in, void* d_out, int out_size, void* d_ws,
                              size_t ws_size, hipStream_t stream) {
  (void)in_sizes; (void)n_in; (void)out_size;
  if (ws_size < WS_NEED) { fprintf(stderr, "workspace too small: %zu < %zu\n", ws_size, (size_t)WS_NEED); return; }
  static int grid_blocks = 0;
  if (!grid_blocks) {
    int dev = 0, cus = 0, per_cu = 0;
    hipGetDevice(&dev);
    hipDeviceGetAttribute(&cus, hipDeviceAttributeMultiprocessorCount, dev);
    hipOccupancyMaxActiveBlocksPerMultiprocessor(&per_cu, mega, 256, 0);
    if (per_cu < 1) per_cu = 1;
    if (per_cu > 2) per_cu = 2;
    grid_blocks = cus * per_cu;
  }
  Params p{};
  const float** f = (const float**)&p;
  for (int i = 0; i < 25; ++i) f[i] = (const float*)d_in[i];
  p.out = (float*)d_out;
  p.ws = (char*)d_ws;
#if COOP
  void* args[] = {&p};
  hipError_t e = hipLaunchCooperativeKernel((void*)mega, dim3(grid_blocks), dim3(256), args, 0, stream);
  if (e != hipSuccess) fprintf(stderr, "cooperative launch failed: %s (grid %d)\n", hipGetErrorString(e), grid_blocks);
#else
  for (int ph = 0; ph < NPHASE; ++ph) hipLaunchKernelGGL(mega, dim3(grid_blocks), dim3(256), 0, stream, p, ph);
#endif
}
```

```cpp
#include <hip/hip_runtime.h>
#include <hip/hip_cooperative_groups.h>
#include <cstdio>
namespace cg = cooperative_groups;

#define DI __device__ __forceinline__
typedef unsigned short bf16_t;
using bf16x8 = __attribute__((ext_vector_type(8))) short;
using s16x4 = __attribute__((ext_vector_type(4))) short;
using f32x16 = __attribute__((ext_vector_type(16))) float;
#define MFMA(a, b, c) __builtin_amdgcn_mfma_f32_32x32x16_bf16((a), (b), (c), 0, 0, 0)

#ifndef COOP
#define COOP 1
#endif

constexpr int DM = 1024, NBAT = 2, SEQ = 8192, NTOK = NBAT * SEQ, CTXL = 256, NROW = NTOK + NBAT * CTXL;
constexpr int PLD = 2816;
constexpr int NSTEP = 66;
constexpr float EPS = 1e-6f;

constexpr size_t al256(size_t x) { return (x + 255) & ~(size_t)255; }
constexpr size_t O_BAR = 0;
constexpr size_t O_WIN = 16384;
constexpr size_t O_WOUT = O_WIN + al256((size_t)PLD * 1024 * 2);
constexpr size_t O_GMIN = O_WOUT + al256((size_t)1024 * 1024 * 2);
constexpr size_t O_GMOUT = O_GMIN + al256((size_t)4096 * 1024 * 2);
constexpr size_t O_MGU = O_GMOUT + al256((size_t)1024 * 2048 * 2);
constexpr size_t O_MD = O_MGU + al256((size_t)16 * 2048 * 1024 * 2);
constexpr size_t O_MODV = O_MD + al256((size_t)16 * 1024 * 1024 * 2);
constexpr size_t O_HA = O_MODV + al256((size_t)2 * 3 * 6144 * 4);
constexpr size_t O_GL = O_HA + al256((size_t)NROW * 1024 * 2);
constexpr size_t O_AFF = O_GL + al256((size_t)NROW * 16 * 4);
constexpr size_t O_IDX = O_AFF + al256((size_t)32 * 8192 * 4);
constexpr size_t O_GATE = O_IDX + al256((size_t)32 * 1024 * 4);
constexpr size_t O_STATS = O_GATE + al256((size_t)32 * 1024 * 4);
constexpr size_t O_GSC = O_STATS + al256((size_t)NTOK * 2 * 4);
constexpr size_t O_MLOC = O_GSC + al256((size_t)16 * NSTEP * 4);
constexpr size_t O_DN = O_MLOC + al256((size_t)16 * NSTEP * 4);
constexpr size_t O_NST = O_DN + al256((size_t)16 * NSTEP * 128 * 4);
constexpr size_t O_MST = O_NST + al256((size_t)16 * 64 * 128 * 4);
constexpr size_t O_R12 = O_MST + al256((size_t)16 * 64 * 4);
constexpr size_t O_P = O_R12;
constexpr size_t O_QC = O_P + al256((size_t)NROW * PLD * 2);
constexpr size_t O_KC = O_QC + al256((size_t)NTOK * 512 * 2);
constexpr size_t O_KT = O_KC + al256((size_t)NTOK * 512 * 2);
constexpr size_t O_VT = O_KT + al256((size_t)132 * 4 * 128 * 128 * 2);
constexpr size_t O_RQ = O_VT + al256((size_t)132 * 4 * 128 * 128 * 2);
constexpr size_t O_RK = O_RQ + al256((size_t)NTOK * 512 * 2);
constexpr size_t O_AVTX = O_RK + al256((size_t)NROW * 128 * 2);
constexpr size_t O_AVTC = O_AVTX + al256((size_t)4 * 64 * 8192 * 2);
constexpr size_t O_R12_END = O_AVTC + al256((size_t)4 * 64 * 256 * 2);
constexpr size_t O_HID = O_R12;
constexpr size_t O_U = O_R12;
constexpr size_t O_GVT = O_U + al256((size_t)NTOK * 2048 * 2);
static_assert(O_GVT + (size_t)NTOK * 2048 * 2 <= O_R12_END, "R12 too small");
constexpr size_t O_DC = O_R12_END;
constexpr size_t O_CST = O_DC + al256((size_t)16 * NSTEP * 16384 * 4);
constexpr size_t O_UV = O_DC;
constexpr size_t WS_NEED = O_CST + al256((size_t)16 * 64 * 16384 * 2);

struct Params {
  const float *x, *c, *ctx, *c_ctx, *w_mod, *b_mod, *norm_mix_g, *norm_ffn_g, *final_norm_g;
  const float *ab_w_in, *ab_conv_w, *ab_gate_b, *ab_head_g, *ab_sink, *ab_w_out;
  const float *gm_w_in, *gm_ln_g, *gm_ln_b, *gm_w_s, *gm_b_s, *gm_w_out;
  const float *moe_w_router, *moe_w_gate, *moe_w_up, *moe_w_down;
  float* out;
  char* ws;
};

DI bf16_t f2bf(float x) { unsigned u = __float_as_uint(x); u += 0x7fffu + ((u >> 16) & 1u); return (bf16_t)(u >> 16); }
DI float bf2f(bf16_t b) { return __uint_as_float(((unsigned)b) << 16); }
DI unsigned pack2(float a, float b) { return (unsigned)f2bf(a) | ((unsigned)f2bf(b) << 16); }
DI bf16x8 pack8(float a0, float a1, float a2, float a3, float a4, float a5, float a6, float a7) {
  uint4 u; u.x = pack2(a0, a1); u.y = pack2(a2, a3); u.z = pack2(a4, a5); u.w = pack2(a6, a7);
  return __builtin_bit_cast(bf16x8, u);
}
DI bf16x8 ldfrag(const bf16_t* p) { return *(const bf16x8*)p; }
DI bf16x8 ldfrag2(const bf16_t* p0, const bf16_t* p1) {
  s16x4 lo = *(const s16x4*)p0, hi = *(const s16x4*)p1;
  return __builtin_shufflevector(lo, hi, 0, 1, 2, 3, 4, 5, 6, 7);
}
DI int crow(int i, int hh) { return (i & 3) + 8 * (i >> 2) + 4 * hh; }
DI float siluf(float x) { return x / (1.f + __expf(-x)); }
DI float sigmf(float x) { return 1.f / (1.f + __expf(-x)); }
DI float logsigf(float x) { return fminf(x, 0.f) - log1pf(expf(-fabsf(x))); }
DI float geluf(float x) { float u = 0.7978845608028654f * (x + 0.044715f * x * x * x); return 0.5f * x * (1.f + tanhf(u)); }
DI float wsum(float v) {
#pragma unroll
  for (int o = 32; o > 0; o >>= 1) v += __shfl_xor(v, o);
  return v;
}
DI int tid() { int t = threadIdx.x; asm volatile("" : "+v"(t)); return t; }
DI f32x16 fzero() { f32x16 z; for (int i = 0; i < 16; ++i) z[i] = 0.f; return z; }

DI int tmap(int kind, int n) {
  if (kind == 0) return n;
  if (kind == 1) return n < 2048 ? n : (n < 2064 ? -1 : n - 16);
  int r = (n >> 6) * 128 + ((n >> 5) & 1) * 64 + (n & 31);
  return kind == 2 ? r : r + 32;
}
DI void tconv(const float* __restrict__ src, int ldn, int ncols, int K, int nmat, size_t sstride,
              bf16_t* __restrict__ dst, size_t dstride, int kind, char* smem) {
  float* sm = (float*)smem;
  const int t = tid();
  const int ntn = (ncols + 63) >> 6, ntk = K >> 6, per = ntn * ntk;
  for (int tile = blockIdx.x; tile < per * nmat; tile += gridDim.x) {
    const int mat = tile / per, tt = tile % per;
    const int k0 = (tt / ntn) * 64, n0 = (tt % ntn) * 64;
    const float* s = src + (size_t)mat * sstride;
    bf16_t* d = dst + (size_t)mat * dstride;
    const int c4 = t & 15, rr = t >> 4;
#pragma unroll
    for (int i = 0; i < 4; ++i) {
      const int kr = rr + 16 * i, n = n0 + c4 * 4;
      float4 v = make_float4(0.f, 0.f, 0.f, 0.f);
      if (n < ncols) v = *(const float4*)(s + (size_t)(k0 + kr) * ldn + n);
      sm[kr * 65 + c4 * 4 + 0] = v.x; sm[kr * 65 + c4 * 4 + 1] = v.y; sm[kr * 65 + c4 * 4 + 2] = v.z; sm[kr * 65 + c4 * 4 + 3] = v.w;
    }
    __syncthreads();
    const int nl = t >> 2, kq = t & 3, n = n0 + nl;
    if (n < ncols) {
      const int row = tmap(kind, n);
      if (row >= 0) {
        uint4 o0, o1;
        const float* q = sm + (kq * 16) * 65 + nl;
        o0.x = pack2(q[0 * 65], q[1 * 65]); o0.y = pack2(q[2 * 65], q[3 * 65]); o0.z = pack2(q[4 * 65], q[5 * 65]); o0.w = pack2(q[6 * 65], q[7 * 65]);
        o1.x = pack2(q[8 * 65], q[9 * 65]); o1.y = pack2(q[10 * 65], q[11 * 65]); o1.z = pack2(q[12 * 65], q[13 * 65]); o1.w = pack2(q[14 * 65], q[15 * 65]);
        uint4* dp = (uint4*)(d + (size_t)row * K + k0 + kq * 16);
        dp[0] = o0; dp[1] = o1;
      }
    }
    __syncthreads();
  }
}
DI void tconv_moe(const Params& p, int layer, char* smem) {
  const size_t wo = (size_t)layer * 16 * 1024 * 1024;
  tconv(p.moe_w_gate + wo, 1024, 1024, 1024, 16, (size_t)1024 * 1024, (bf16_t*)(p.ws + O_MGU), (size_t)2048 * 1024, 2, smem);
  tconv(p.moe_w_up + wo, 1024, 1024, 1024, 16, (size_t)1024 * 1024, (bf16_t*)(p.ws + O_MGU), (size_t)2048 * 1024, 3, smem);
  tconv(p.moe_w_down + wo, 1024, 1024, 1024, 16, (size_t)1024 * 1024, (bf16_t*)(p.ws + O_MD), (size_t)1024 * 1024, 0, smem);
}

DI void phase_adaln(const Params& p, char* smem) {
  float* sv = (float*)smem;
  float* red = sv + 3 * 1024;
  float* modv = (float*)(p.ws + O_MODV);
  const int t = tid();
  if (blockIdx.x >= 192) return;
  for (int i = t; i < 3 * 1024; i += 256) {
    const int v = i >> 10, k = i & 1023;
    const float cv = v < 2 ? p.c[v * 1024 + k] : p.c_ctx[k];
    sv[i] = siluf(cv);
  }
  __syncthreads();
  for (int item = blockIdx.x; item < 192; item += gridDim.x) {
    const int l = item / 96, cb = item % 96;
    const int cq = t & 15, kg = t >> 4;
    const float* w = p.w_mod + (size_t)l * 1024 * 6144 + cb * 64 + cq * 4;
    float a0[4] = {0.f, 0.f, 0.f, 0.f}, a1[4] = {0.f, 0.f, 0.f, 0.f}, a2[4] = {0.f, 0.f, 0.f, 0.f};
    for (int i = 0; i < 64; ++i) {
      const int k = kg + 16 * i;
      const float4 wv = *(const float4*)(w + (size_t)k * 6144);
      const float s0 = sv[k], s1 = sv[1024 + k], s2 = sv[2048 + k];
      a0[0] += s0 * wv.x; a0[1] += s0 * wv.y; a0[2] += s0 * wv.z; a0[3] += s0 * wv.w;
      a1[0] += s1 * wv.x; a1[1] += s1 * wv.y; a1[2] += s1 * wv.z; a1[3] += s1 * wv.w;
      a2[0] += s2 * wv.x; a2[1] += s2 * wv.y; a2[2] += s2 * wv.z; a2[3] += s2 * wv.w;
    }
#pragma unroll
    for (int j = 0; j < 4; ++j) {
      red[(kg * 3 + 0) * 64 + cq * 4 + j] = a0[j];
      red[(kg * 3 + 1) * 64 + cq * 4 + j] = a1[j];
      red[(kg * 3 + 2) * 64 + cq * 4 + j] = a2[j];
    }
    __syncthreads();
    if (t < 192) {
      const int v = t >> 6, col = t & 63;
      float s = 0.f;
      for (int g = 0; g < 16; ++g) s += red[(g * 3 + v) * 64 + col];
      const int cc = cb * 64 + col;
      modv[(l * 3 + v) * 6144 + cc] = s + p.b_mod[l * 6144 + cc];
    }
    __syncthreads();
  }
}

template <int MODE>
DI void phase_modulate(const Params& p, int layer, int which, char* smem) {
  float* wt = (float*)smem;
  const int t = tid(), lane = t & 63, w = t >> 6;
  const float* modv = (const float*)(p.ws + O_MODV);
  bf16_t* HA = (bf16_t*)(p.ws + O_HA);
  if (MODE != 0) {
    const float* W = MODE == 1 ? p.ab_w_in + 2048 : p.moe_w_router + (size_t)layer * 1024 * 16;
    const int ld = MODE == 1 ? 2832 : 16;
    for (int i = t; i < 4096; i += 256) {
      const int k = i >> 2, e4 = i & 3;
      const float4 v = *(const float4*)(W + (size_t)k * ld + e4 * 4);
      wt[(e4 * 4 + 0) * 1024 + k] = v.x; wt[(e4 * 4 + 1) * 1024 + k] = v.y; wt[(e4 * 4 + 2) * 1024 + k] = v.z; wt[(e4 * 4 + 3) * 1024 + k] = v.w;
    }
    __syncthreads();
  }
  const float* gn = (which == 0 ? p.norm_mix_g : p.norm_ffn_g) + layer * 1024;
  const int nrows = MODE == 1 ? NROW : NTOK;
  for (int row = blockIdx.x * 4 + w; row < nrows; row += gridDim.x * 4) {
    const float* src; int v;
    if (MODE == 1) {
      if (row < NTOK) { src = p.x + (size_t)row * 1024; v = row >> 13; }
      else { src = p.ctx + (size_t)(row - NTOK) * 1024; v = 2; }
    } else { src = p.out + (size_t)row * 1024; v = row >> 13; }
    const float* sh = modv + (layer * 3 + v) * 6144 + (which ? 3 : 0) * 1024;
    const float* sc = sh + 1024;
    float4 xv[4];
    float ss = 0.f;
#pragma unroll
    for (int i = 0; i < 4; ++i) {
      xv[i] = *(const float4*)(src + (i * 64 + lane) * 4);
      ss += xv[i].x * xv[i].x + xv[i].y * xv[i].y + xv[i].z * xv[i].z + xv[i].w * xv[i].w;
    }
    ss = wsum(ss);
    const float rstd = rsqrtf(ss * (1.f / 1024.f) + EPS);
    float4 yv[4];
#pragma unroll
    for (int i = 0; i < 4; ++i) {
      const int col = (i * 64 + lane) * 4;
      const float4 g4 = *(const float4*)(gn + col), s4 = *(const float4*)(sh + col), c4 = *(const float4*)(sc + col);
      float4 y;
      y.x = xv[i].x * rstd * g4.x * (1.f + c4.x) + s4.x;
      y.y = xv[i].y * rstd * g4.y * (1.f + c4.y) + s4.y;
      y.z = xv[i].z * rstd * g4.z * (1.f + c4.z) + s4.z;
      y.w = xv[i].w * rstd * g4.w * (1.f + c4.w) + s4.w;
      yv[i] = y;
      uint2 o; o.x = pack2(y.x, y.y); o.y = pack2(y.z, y.w);
      *(uint2*)(HA + (size_t)row * 1024 + col) = o;
    }
    if (MODE != 0) {
      float mine = 0.f;
#pragma unroll 1
      for (int e = 0; e < 16; ++e) {
        float pe = 0.f;
#pragma unroll
        for (int i = 0; i < 4; ++i) {
          const float4 w4 = *(const float4*)(wt + e * 1024 + (i * 64 + lane) * 4);
          pe += yv[i].x * w4.x + yv[i].y * w4.y + yv[i].z * w4.z + yv[i].w * w4.w;
        }
        pe = wsum(pe);
        if ((lane & 15) == e) mine = pe;
      }
      const int e = lane & 15;
      if (MODE == 1) {
        float val = mine + p.ab_gate_b[e];
        if (((e >> 2) & 1) == 1) val = logsigf(val);
        if (lane < 16) ((float*)(p.ws + O_GL))[(size_t)row * 16 + lane] = val;
      } else {
        float mx = mine;
#pragma unroll
        for (int o = 8; o > 0; o >>= 1) mx = fmaxf(mx, __shfl_xor(mx, o));
        const float ex = expf(mine - mx);
        float sum = ex;
#pragma unroll
        for (int o = 8; o > 0; o >>= 1) sum += __shfl_xor(sum, o);
        if (lane < 16) ((float*)(p.ws + O_AFF))[((size_t)(row >> 13) * 16 + lane) * 8192 + (row & 8191)] = ex / sum;
      }
    }
  }
}

template <class Epi>
DI void gemm_tile(const bf16_t* (&ap)[4], const bf16_t* (&bp)[4], int K, char* smem, Epi&& epi) {
  bf16_t* sA = (bf16_t*)smem;
  bf16_t* sB = sA + 2 * 128 * 72;
  const int t = tid(), lane = t & 63, w = t >> 6, wm = w >> 1, wn = w & 1, r = lane & 31, hh = lane >> 5;
  const int lrow = t >> 3, lcol = (t & 7) * 8;
  const bf16_t* a0p = ap[0]; const bf16_t* a1p = ap[1]; const bf16_t* a2p = ap[2]; const bf16_t* a3p = ap[3];
  const bf16_t* b0p = bp[0]; const bf16_t* b1p = bp[1]; const bf16_t* b2p = bp[2]; const bf16_t* b3p = bp[3];
  f32x16 acc00 = fzero(), acc01 = fzero(), acc10 = fzero(), acc11 = fzero();
  uint4 ra0 = *(const uint4*)a0p, ra1 = *(const uint4*)a1p, ra2 = *(const uint4*)a2p, ra3 = *(const uint4*)a3p;
  uint4 rb0 = *(const uint4*)b0p, rb1 = *(const uint4*)b1p, rb2 = *(const uint4*)b2p, rb3 = *(const uint4*)b3p;
  const int so = lrow * 72 + lcol;
  *(uint4*)(sA + so) = ra0; *(uint4*)(sA + so + 32 * 72) = ra1; *(uint4*)(sA + so + 64 * 72) = ra2; *(uint4*)(sA + so + 96 * 72) = ra3;
  *(uint4*)(sB + so) = rb0; *(uint4*)(sB + so + 32 * 72) = rb1; *(uint4*)(sB + so + 64 * 72) = rb2; *(uint4*)(sB + so + 96 * 72) = rb3;
  __syncthreads();
  const int KT = K >> 6;
  for (int kt = 0; kt < KT; ++kt) {
    const int cur = kt & 1;
    const int kn = (kt + 1 < KT ? kt + 1 : kt) * 64;
    ra0 = *(const uint4*)(a0p + kn); ra1 = *(const uint4*)(a1p + kn); ra2 = *(const uint4*)(a2p + kn); ra3 = *(const uint4*)(a3p + kn);
    rb0 = *(const uint4*)(b0p + kn); rb1 = *(const uint4*)(b1p + kn); rb2 = *(const uint4*)(b2p + kn); rb3 = *(const uint4*)(b3p + kn);
    __builtin_amdgcn_sched_barrier(0);
    const bf16_t* cA = sA + cur * 128 * 72 + (wm * 64 + r) * 72 + hh * 8;
    const bf16_t* cB = sB + cur * 128 * 72 + (wn * 64 + r) * 72 + hh * 8;
#pragma unroll
    for (int ks = 0; ks < 4; ++ks) {
      const bf16x8 a0 = *(const bf16x8*)(cA + ks * 16), a1 = *(const bf16x8*)(cA + 32 * 72 + ks * 16);
      const bf16x8 b0 = *(const bf16x8*)(cB + ks * 16), b1 = *(const bf16x8*)(cB + 32 * 72 + ks * 16);
      acc00 = MFMA(a0, b0, acc00);
      acc01 = MFMA(a0, b1, acc01);
      acc10 = MFMA(a1, b0, acc10);
      acc11 = MFMA(a1, b1, acc11);
    }
    __builtin_amdgcn_sched_barrier(0);
    {
      bf16_t* nA = sA + (cur ^ 1) * 128 * 72 + so;
      bf16_t* nB = sB + (cur ^ 1) * 128 * 72 + so;
      *(uint4*)(nA) = ra0; *(uint4*)(nA + 32 * 72) = ra1; *(uint4*)(nA + 64 * 72) = ra2; *(uint4*)(nA + 96 * 72) = ra3;
      *(uint4*)(nB) = rb0; *(uint4*)(nB + 32 * 72) = rb1; *(uint4*)(nB + 64 * 72) = rb2; *(uint4*)(nB + 96 * 72) = rb3;
    }
    __syncthreads();
  }
  f32x16 acc[2][2];
  acc[0][0] = acc00; acc[0][1] = acc01; acc[1][0] = acc10; acc[1][1] = acc11;
  epi(acc, wm * 64, wn * 64, r, hh);
}

struct TileWalk {
  int L, Lend, nl;
  DI TileWalk(int T) {
    const int xcd = blockIdx.x & 7, li = blockIdx.x >> 3;
    nl = gridDim.x >> 3;
    const int tx = T >> 3;
    L = xcd * tx + li; Lend = (xcd + 1) * tx;
  }
  DI bool valid() const { return L < Lend; }
  DI void next() { L += nl; }
  DI void get(int SM, int SN, int nsn, int& mt, int& nt) const {
    const int s = L / (SM * SN), wi = L % (SM * SN);
    mt = (s / nsn) * SM + wi / SN; nt = (s % nsn) * SN + wi % SN;
  }
};

template <class MakeEpi>
DI void gemm_dense(const bf16_t* A, const bf16_t* Bt, int M, int N, int K, int SM, int SN, char* smem, MakeEpi&& mk) {
  const int t = tid(), lrow = t >> 3, lcol = (t & 7) * 8;
  const int ntn = N >> 7, ntm = M >> 7;
  for (TileWalk tw(ntn * ntm); tw.valid(); tw.next()) {
    int mt, nt; tw.get(SM, SN, ntn / SN, mt, nt);
    const bf16_t* ap[4]; const bf16_t* bp[4];
#pragma unroll
    for (int i = 0; i < 4; ++i) {
      ap[i] = A + (size_t)(mt * 128 + lrow + 32 * i) * K + lcol;
      bp[i] = Bt + (size_t)(nt * 128 + lrow + 32 * i) * K + lcol;
    }
    gemm_tile(ap, bp, K, smem, mk(mt * 128, nt * 128));
  }
}

DI void phase_prep2(const Params& p, char* smem) {
  bf16_t* T = (bf16_t*)smem;
  const bf16_t* P = (const bf16_t*)(p.ws + O_P);
  bf16_t* Qc = (bf16_t*)(p.ws + O_QC); bf16_t* Kc = (bf16_t*)(p.ws + O_KC);
  bf16_t* KT = (bf16_t*)(p.ws + O_KT); bf16_t* VT = (bf16_t*)(p.ws + O_VT);
  bf16_t* RQ = (bf16_t*)(p.ws + O_RQ); bf16_t* RK = (bf16_t*)(p.ws + O_RK);
  bf16_t* AVTX = (bf16_t*)(p.ws + O_AVTX); bf16_t* AVTC = (bf16_t*)(p.ws + O_AVTC);
  const int t = tid();
  for (int item = blockIdx.x; item < 132 * 6; item += gridDim.x) {
    const int sc = item / 6, part = item % 6;
    const bool isx = sc < 128;
    const int row0 = sc * 128;
    const int seq_lo = isx ? (sc >> 6) * 8192 : NTOK + ((sc - 128) >> 1) * 256;
    const int seq_hi = seq_lo + (isx ? 8192 : 256);
    if (part < 4) {
      const int h = part;
      const int col8 = t & 15, rsub = t >> 4;
      for (int pass = 0; pass < 3; ++pass) {
        if (pass == 2 && !isx) break;
        const int pcol = (pass == 0 ? 512 : (pass == 1 ? 1024 : 0)) + h * 128 + col8 * 8;
        float cw[5][8];
        if (pass != 1) {
#pragma unroll
          for (int j = 0; j < 5; ++j)
#pragma unroll
            for (int e = 0; e < 8; ++e) cw[j][e] = p.ab_conv_w[j * 1024 + (pass == 0 ? 512 : 0) + h * 128 + col8 * 8 + e];
        }
        for (int i = 0; i < 8; ++i) {
          const int rl = rsub + 16 * i, row = row0 + rl;
          uint4 o;
          if (pass == 1) {
            o = *(const uint4*)(P + (size_t)row * PLD + pcol);
          } else {
            float a[8];
#pragma unroll
            for (int e = 0; e < 8; ++e) a[e] = 0.f;
#pragma unroll
            for (int j = 0; j < 5; ++j) {
              const int rr = row + j - 2;
              if (rr >= seq_lo && rr < seq_hi) {
                const bf16x8 v = *(const bf16x8*)(P + (size_t)rr * PLD + pcol);
#pragma unroll
                for (int e = 0; e < 8; ++e) a[e] += cw[j][e] * bf2f((bf16_t)v[e]);
              }
            }
            const float scl = pass == 0 ? 0.08838834764831845f : 1.f;
#pragma unroll
            for (int e = 0; e < 8; ++e) a[e] = siluf(a[e]) * scl;
            o.x = pack2(a[0], a[1]); o.y = pack2(a[2], a[3]); o.z = pack2(a[4], a[5]); o.w = pack2(a[6], a[7]);
            if (isx) *(uint4*)((pass == 0 ? Kc : Qc) + (size_t)row * 512 + h * 128 + col8 * 8) = o;
          }
          if (pass < 2) *(uint4*)(T + rl * 136 + col8 * 8) = o;
        }
        if (pass < 2) {
          __syncthreads();
          bf16_t* dstT = (pass == 0 ? KT : VT) + (size_t)(sc * 4 + h) * 16384;
          const int d = t & 127, shf = t >> 7;
#pragma unroll
          for (int s8 = 0; s8 < 8; ++s8) {
            const bf16_t* q = T + (shf * 64 + s8 * 8) * 136 + d;
            uint4 o;
            o.x = (unsigned)q[0] | ((unsigned)q[136] << 16); o.y = (unsigned)q[2 * 136] | ((unsigned)q[3 * 136] << 16);
            o.z = (unsigned)q[4 * 136] | ((unsigned)q[5 * 136] << 16); o.w = (unsigned)q[6 * 136] | ((unsigned)q[7 * 136] << 16);
            *(uint4*)(dstT + d * 128 + shf * 64 + s8 * 8) = o;
          }
          __syncthreads();
        }
      }
    } else if (part == 4) {
      if (!isx) continue;
      for (int idx = t; idx < 512; idx += 256) {
        const int rl = idx >> 2, dc = idx & 3, row = row0 + rl, pos = row - seq_lo;
        const float rp = (float)(pos >> 6), cp = (float)(pos & 63);
        float cs[8], sn[8];
#pragma unroll
        for (int e = 0; e < 8; ++e) {
          const int a = dc * 8 + e;
          const float inv = powf(10000.f, -(float)(a & 15) / 16.f);
          const float ang = (a < 16 ? rp : cp) * inv;
          cs[e] = cosf(ang); sn[e] = sinf(ang);
        }
        for (int hq = 0; hq < 8; ++hq) {
          const bf16x8 x1 = *(const bf16x8*)(P + (size_t)row * PLD + 2048 + hq * 64 + dc * 8);
          const bf16x8 x2 = *(const bf16x8*)(P + (size_t)row * PLD + 2048 + hq * 64 + 32 + dc * 8);
          float o1[8], o2[8];
#pragma unroll
          for (int e = 0; e < 8; ++e) {
            const float a = bf2f((bf16_t)x1[e]), b = bf2f((bf16_t)x2[e]);
            o1[e] = (a * cs[e] - b * sn[e]) * 0.125f; o2[e] = (b * cs[e] + a * sn[e]) * 0.125f;
          }
          uint4 u1, u2;
          u1.x = pack2(o1[0], o1[1]); u1.y = pack2(o1[2], o1[3]); u1.z = pack2(o1[4], o1[5]); u1.w = pack2(o1[6], o1[7]);
          u2.x = pack2(o2[0], o2[1]); u2.y = pack2(o2[2], o2[3]); u2.z = pack2(o2[4], o2[5]); u2.w = pack2(o2[6], o2[7]);
          *(uint4*)(RQ + (size_t)row * 512 + hq * 64 + dc * 8) = u1;
          *(uint4*)(RQ + (size_t)row * 512 + hq * 64 + 32 + dc * 8) = u2;
        }
      }
    } else {
      for (int idx = t; idx < 512; idx += 256) {
        const int rl = idx >> 2, dc = idx & 3, row = row0 + rl, pos = row - seq_lo;
        const float rp = (float)(pos >> 6), cp = (float)(pos & 63);
        float cs[8], sn[8];
#pragma unroll
        for (int e = 0; e < 8; ++e) {
          const int a = dc * 8 + e;
          const float inv = powf(10000.f, -(float)(a & 15) / 16.f);
          const float ang = (a < 16 ? rp : cp) * inv;
          cs[e] = isx ? cosf(ang) : 1.f; sn[e] = isx ? sinf(ang) : 0.f;
        }
        for (int g = 0; g < 2; ++g) {
          const bf16x8 x1 = *(const bf16x8*)(P + (size_t)row * PLD + 2560 + g * 64 + dc * 8);
          const bf16x8 x2 = *(const bf16x8*)(P + (size_t)row * PLD + 2560 + g * 64 + 32 + dc * 8);
          float o1[8], o2[8];
#pragma unroll
          for (int e = 0; e < 8; ++e) {
            const float a = bf2f((bf16_t)x1[e]), b = bf2f((bf16_t)x2[e]);
            o1[e] = a * cs[e] - b * sn[e]; o2[e] = b * cs[e] + a * sn[e];
          }
          uint4 u1, u2;
          u1.x = pack2(o1[0], o1[1]); u1.y = pack2(o1[2], o1[3]); u1.z = pack2(o1[4], o1[5]); u1.w = pack2(o1[6], o1[7]);
          u2.x = pack2(o2[0], o2[1]); u2.y = pack2(o2[2], o2[3]); u2.z = pack2(o2[4], o2[5]); u2.w = pack2(o2[6], o2[7]);
          *(uint4*)(RK + (size_t)row * 128 + g * 64 + dc * 8) = u1;
          *(uint4*)(RK + (size_t)row * 128 + g * 64 + 32 + dc * 8) = u2;
        }
      }
      {
        const int col8 = t & 15, rsub = t >> 4;
        for (int i = 0; i < 8; ++i) {
          const int rl = rsub + 16 * i;
          *(uint4*)(T + rl * 136 + col8 * 8) = *(const uint4*)(P + (size_t)(row0 + rl) * PLD + 2688 + col8 * 8);
        }
        __syncthreads();
        const int d = t & 127, shf = t >> 7;
        const int b = isx ? (sc >> 6) : ((sc - 128) >> 1);
        const int pos0 = row0 - seq_lo;
        bf16_t* dst = isx ? AVTX + ((size_t)(b * 2 + (d >> 6)) * 64 + (d & 63)) * 8192 + pos0
                          : AVTC + ((size_t)(b * 2 + (d >> 6)) * 64 + (d & 63)) * 256 + pos0;
#pragma unroll
        for (int s8 = 0; s8 < 8; ++s8) {
          const bf16_t* q = T + (shf * 64 + s8 * 8) * 136 + d;
          uint4 o;
          o.x = (unsigned)q[0] | ((unsigned)q[136] << 16); o.y = (unsigned)q[2 * 136] | ((unsigned)q[3 * 136] << 16);
          o.z = (unsigned)q[4 * 136] | ((unsigned)q[5 * 136] << 16); o.w = (unsigned)q[6 * 136] | ((unsigned)q[7 * 136] << 16);
          *(uint4*)(dst + shf * 64 + s8 * 8) = o;
        }
        __syncthreads();
      }
    }
  }
}

DI void attn_item(const Params& p, int item) {
  const int g = item & 1, qb = (item >> 1) & 255, b = item >> 9;
  int t_ = tid();
  asm volatile("" : "+v"(t_));
  const int t = t_, lane = t & 63, w = t >> 6, r = lane & 31, hh = lane >> 5;
  const int hq = g * 4 + w, q0 = qb * 32;
  const bf16_t* RQ = (const bf16_t*)(p.ws + O_RQ); const bf16_t* RK = (const bf16_t*)(p.ws + O_RK);
  const bf16_t* AVTX = (const bf16_t*)(p.ws + O_AVTX); const bf16_t* AVTC = (const bf16_t*)(p.ws + O_AVTC);
  bf16_t* MIX = (bf16_t*)(p.ws + O_HA);
  const size_t qrow = (size_t)b * 8192 + q0 + r;
  bf16x8 qf[4];
#pragma unroll
  for (int ks = 0; ks < 4; ++ks) qf[ks] = ldfrag(RQ + qrow * 512 + hq * 64 + ks * 16 + hh * 8);
  float m = p.ab_sink[hq], l = hh == 0 ? 1.f : 0.f;
  f32x16 o0 = fzero(), o1 = fzero();
  const int ipos = q0 + r;
  for (int tile = 0; tile < 17; ++tile) {
    const bf16_t* kbase; const bf16_t* vbase; int vld, k0; bool local;
    if (tile < 9) {
      k0 = q0 - 128 + tile * 32;
      if (k0 < 0 || k0 >= 8192) continue;
      kbase = RK + (size_t)(b * 8192 + k0) * 128 + g * 64;
      vbase = AVTX + (size_t)((b * 2 + g) * 64) * 8192 + k0; vld = 8192; local = true;
    } else {
      k0 = (tile - 9) * 32;
      kbase = RK + (size_t)(NTOK + b * 256 + k0) * 128 + g * 64;
      vbase = AVTC + (size_t)((b * 2 + g) * 64) * 256 + k0; vld = 256; local = false;
    }
    f32x16 s = fzero();
#pragma unroll
    for (int ks = 0; ks < 4; ++ks) s = MFMA(ldfrag(kbase + r * 128 + ks * 16 + hh * 8), qf[ks], s);
    float tmax = -INFINITY;
#pragma unroll
    for (int i = 0; i < 16; ++i) {
      const int dj = ipos - (k0 + crow(i, hh));
      const bool ok = !local || (dj <= 128 && dj >= -128);
      s[i] = ok ? s[i] : -INFINITY;
      tmax = fmaxf(tmax, s[i]);
    }
    tmax = fmaxf(tmax, __shfl_xor(tmax, 32));
    const float mn = fmaxf(m, tmax), corr = __expf(m - mn);
    m = mn; l *= corr;
#pragma unroll
    for (int i = 0; i < 16; ++i) { o0[i] *= corr; o1[i] *= corr; }
#pragma unroll
    for (int i = 0; i < 16; ++i) { s[i] = __expf(s[i] - mn); l += s[i]; }
#pragma unroll
    for (int s2 = 0; s2 < 2; ++s2) {
      const bf16x8 pf = pack8(s[8 * s2], s[8 * s2 + 1], s[8 * s2 + 2], s[8 * s2 + 3], s[8 * s2 + 4], s[8 * s2 + 5], s[8 * s2 + 6], s[8 * s2 + 7]);
      const bf16_t* v0 = vbase + (size_t)r * vld + 16 * s2 + 4 * hh;
      o0 = MFMA(ldfrag2(v0, v0 + 8), pf, o0);
      const bf16_t* v1 = v0 + (size_t)32 * vld;
      o1 = MFMA(ldfrag2(v1, v1 + 8), pf, o1);
    }
  }
  l += __shfl_xor(l, 32);
  const float inv = 1.f / l;
  bf16_t* dst = MIX + qrow * 1024 + 512 + hq * 64;
#pragma unroll
  for (int q4 = 0; q4 < 4; ++q4) {
    const int d = 8 * q4 + 4 * hh;
    uint2 u;
    u.x = pack2(o0[4 * q4] * inv, o0[4 * q4 + 1] * inv); u.y = pack2(o0[4 * q4 + 2] * inv, o0[4 * q4 + 3] * inv);
    *(uint2*)(dst + d) = u;
    u.x = pack2(o1[4 * q4] * inv, o1[4 * q4 + 1] * inv); u.y = pack2(o1[4 * q4 + 2] * inv, o1[4 * q4 + 3] * inv);
    *(uint2*)(dst + 32 + d) = u;
  }
}

DI void mlstm_local_item(const Params& p, int item, char* smem) {
  float* gs = (float*)smem;
  float* wv = gs + 512;
  float* msc = wv + 256;
  int t_ = tid();
  asm volatile("" : "+v"(t_));
  const int t = t_, lane = t & 63, w = t >> 6, wm = w >> 1, wn = w & 1, r = lane & 31, hh = lane >> 5;
  const int bh = item / NSTEP, nc = item % NSTEP, b = bh >> 2, h = bh & 3;
  const int sc = nc < 2 ? 128 + b * 2 + nc : b * 64 + (nc - 2);
  const int row0 = sc * 128;
  const float* GL = (const float*)(p.ws + O_GL);
  const bf16_t* KT = (const bf16_t*)(p.ws + O_KT) + (size_t)(sc * 4 + h) * 16384;
  const bf16_t* VT = (const bf16_t*)(p.ws + O_VT) + (size_t)(sc * 4 + h) * 16384;
  for (int i = t; i < 512; i += 256) { const int ty = i >> 7, s = i & 127; gs[i] = GL[(size_t)(row0 + s) * 16 + ty * 4 + h]; }
  __syncthreads();
  {
    const int dir = t >> 7, s = t & 127;
    float wval, tot = 0.f;
    if (dir == 0) {
      float bsum = 0.f;
      for (int j = 0; j < 128; ++j) { const float f = gs[128 + j]; tot += f; if (j <= s) bsum += f; }
      wval = tot - bsum + gs[s];
    } else {
      float pre = 0.f;
      for (int j = 0; j < 128; ++j) { const float f = gs[384 + j]; tot += f; if (j < s) pre += f; }
      wval = pre + gs[256 + s];
    }
    wv[dir * 128 + s] = wval;
    if (s == 0) msc[dir] = tot;
  }
  __syncthreads();
  {
    const int dir = t >> 7, s = t & 127;
    float mx = -INFINITY;
    for (int j = 0; j < 128; ++j) mx = fmaxf(mx, wv[dir * 128 + j]);
    const float wval = wv[dir * 128 + s];
    __syncthreads();
    wv[dir * 128 + s] = expf(wval - mx);
    if (s == 0) msc[2 + dir] = mx;
  }
  __syncthreads();
  float* DC = (float*)(p.ws + O_DC);
#pragma unroll 1
  for (int d = 0; d < 2; ++d) {
    f32x16 acc[2][2];
#pragma unroll
    for (int i = 0; i < 2; ++i)
#pragma unroll
      for (int j = 0; j < 2; ++j) acc[i][j] = fzero();
#pragma unroll 2
    for (int ks = 0; ks < 8; ++ks) {
      const bf16x8 ra0 = ldfrag(VT + (wm * 64 + r) * 128 + ks * 16 + hh * 8);
      const bf16x8 ra1 = ldfrag(VT + (wm * 64 + 32 + r) * 128 + ks * 16 + hh * 8);
      const bf16x8 b0 = ldfrag(KT + (wn * 64 + r) * 128 + ks * 16 + hh * 8);
      const bf16x8 b1 = ldfrag(KT + (wn * 64 + 32 + r) * 128 + ks * 16 + hh * 8);
      const float* ww = wv + d * 128 + ks * 16 + hh * 8;
      const bf16x8 a0 = pack8(bf2f((bf16_t)ra0[0]) * ww[0], bf2f((bf16_t)ra0[1]) * ww[1], bf2f((bf16_t)ra0[2]) * ww[2], bf2f((bf16_t)ra0[3]) * ww[3],
                              bf2f((bf16_t)ra0[4]) * ww[4], bf2f((bf16_t)ra0[5]) * ww[5], bf2f((bf16_t)ra0[6]) * ww[6], bf2f((bf16_t)ra0[7]) * ww[7]);
      const bf16x8 a1 = pack8(bf2f((bf16_t)ra1[0]) * ww[0], bf2f((bf16_t)ra1[1]) * ww[1], bf2f((bf16_t)ra1[2]) * ww[2], bf2f((bf16_t)ra1[3]) * ww[3],
                              bf2f((bf16_t)ra1[4]) * ww[4], bf2f((bf16_t)ra1[5]) * ww[5], bf2f((bf16_t)ra1[6]) * ww[6], bf2f((bf16_t)ra1[7]) * ww[7]);
      acc[0][0] = MFMA(a0, b0, acc[0][0]);
      acc[0][1] = MFMA(a0, b1, acc[0][1]);
      acc[1][0] = MFMA(a1, b0, acc[1][0]);
      acc[1][1] = MFMA(a1, b1, acc[1][1]);
    }
    float* dst = DC + ((size_t)(bh * 2 + d) * NSTEP + nc) * 16384;
#pragma unroll
    for (int mi = 0; mi < 2; ++mi)
#pragma unroll
      for (int ni = 0; ni < 2; ++ni)
#pragma unroll
        for (int i = 0; i < 16; ++i)
          dst[(wm * 64 + mi * 32 + crow(i, hh)) * 128 + wn * 64 + ni * 32 + r] = acc[mi][ni][i];
  }
  {
    const int dir = t >> 7, k = t & 127;
    float s = 0.f;
    for (int s8 = 0; s8 < 16; ++s8) {
      const bf16x8 v = ldfrag(KT + k * 128 + s8 * 8);
#pragma unroll
      for (int e = 0; e < 8; ++e) s += wv[dir * 128 + s8 * 8 + e] * bf2f((bf16_t)v[e]);
    }
    ((float*)(p.ws + O_DN))[((size_t)(bh * 2 + dir) * NSTEP + nc) * 128 + k] = s;
    if (k == 0) {
      ((float*)(p.ws + O_GSC))[(bh * 2 + dir) * NSTEP + nc] = msc[dir];
      ((float*)(p.ws + O_MLOC))[(bh * 2 + dir) * NSTEP + nc] = msc[2 + dir];
    }
  }
  __syncthreads();
}

DI int chain_nc(int dir, int i) { return dir == 0 ? i : (i < 2 ? 1 - i : 67 - i); }
DI void phase_scan(const Params& p) {
  const float* GSC = (const float*)(p.ws + O_GSC); const float* MLOC = (const float*)(p.ws + O_MLOC);
  const float* DC = (const float*)(p.ws + O_DC); const float* DN = (const float*)(p.ws + O_DN);
  bf16_t* CST = (bf16_t*)(p.ws + O_CST); float* NST = (float*)(p.ws + O_NST); float* MST = (float*)(p.ws + O_MST);
  const int t = tid();
  for (int item = blockIdx.x; item < 16 * 64 + 8; item += gridDim.x) {
    if (item < 1024) {
      const int chain = item >> 6, e = (item & 63) * 256 + t, dir = chain & 1;
      const int ev = e >> 7, ek = e & 127;
      const int epos = ((((ev >> 5) * 8 + (ek >> 4)) * 64) + ((ek >> 3) & 1) * 32 + (ev & 31)) * 8 + (ek & 7);
      float m = 0.f, C = 0.f;
      for (int i = 0; i < NSTEP; ++i) {
        const int nc = chain_nc(dir, i);
        if (i >= 2) {
          CST[((size_t)chain * 64 + (nc - 2)) * 16384 + epos] = f2bf(C);
          if (e == 0) MST[chain * 64 + nc - 2] = m;
        }
        const float g = GSC[chain * NSTEP + nc], ml = MLOC[chain * NSTEP + nc];
        const float mn = fmaxf(g + m, ml);
        C = expf(g + m - mn) * C + expf(ml - mn) * DC[((size_t)chain * NSTEP + nc) * 16384 + e];
        m = mn;
      }
    } else {
      const int idx = (item - 1024) * 256 + t;
      const int chain = idx >> 7, k = idx & 127, dir = chain & 1;
      float m = 0.f, n = 0.f;
      for (int i = 0; i < NSTEP; ++i) {
        const int nc = chain_nc(dir, i);
        if (i >= 2) NST[((size_t)chain * 64 + (nc - 2)) * 128 + k] = n;
        const float g = GSC[chain * NSTEP + nc], ml = MLOC[chain * NSTEP + nc];
        const float mn = fmaxf(g + m, ml);
        n = expf(g + m - mn) * n + expf(ml - mn) * DN[((size_t)chain * NSTEP + nc) * 128 + k];
        m = mn;
      }
    }
  }
}

DI void mlstm_out_item(const Params& p, int item, char* smem) {
  float* gs = (float*)smem;
  float* bb = gs + 512;
  float* lib = bb + 256;
  float* mrow = lib + 256;
  float* aT = mrow + 256;
  float* nq = aT + 256;
  float* nst = nq + 256;
  char* sK = smem + 8192;
  char* sV = sK + 32768;
  int t_ = tid();
  asm volatile("" : "+v"(t_));
  const int t = t_, lane = t & 63, w = t >> 6, r = lane & 31, hh = lane >> 5;
  const int bh = item >> 6, c = item & 63, b = bh >> 2, h = bh & 3;
  const int sc = b * 64 + c, row0 = sc * 128;
  const float* GL = (const float*)(p.ws + O_GL);
  const bf16_t* Qc = (const bf16_t*)(p.ws + O_QC); const bf16_t* Kc = (const bf16_t*)(p.ws + O_KC);
  const bf16_t* VT = (const bf16_t*)(p.ws + O_VT) + (size_t)(sc * 4 + h) * 16384;
  const bf16_t* P = (const bf16_t*)(p.ws + O_P);
  const float* MST = (const float*)(p.ws + O_MST);
  bf16_t* MIX = (bf16_t*)(p.ws + O_HA);
#pragma unroll
  for (int i = 0; i < 8; ++i) {
    const int q = t + 256 * i, row = q >> 4, cc = q & 15;
    const int so = row * 256 + ((cc ^ (row & 15)) << 4);
    *(uint4*)(sK + so) = *(const uint4*)(Kc + (size_t)(row0 + row) * 512 + h * 128 + cc * 8);
    *(uint4*)(sV + so) = *(const uint4*)(VT + row * 128 + cc * 8);
  }
  for (int i = t; i < 512; i += 256) { const int ty = i >> 7, s = i & 127; gs[i] = GL[(size_t)(row0 + s) * 16 + ty * 4 + h]; }
  {
    const int dir = t >> 7, k = t & 127;
    nst[t] = ((const float*)(p.ws + O_NST))[((size_t)(bh * 2 + dir) * 64 + c) * 128 + k];
  }
  __syncthreads();
  {
    const int dir = t >> 7, s = t & 127;
    float bsum = 0.f;
    if (dir == 0) { for (int j = 0; j <= s; ++j) bsum += gs[128 + j]; }
    else { for (int j = s; j < 128; ++j) bsum += gs[384 + j]; }
    bb[t] = bsum;
    lib[t] = gs[dir * 256 + s] - bsum;
    const bf16_t* qr = Qc + (size_t)(row0 + s) * 512 + h * 128;
    float acc = 0.f;
    for (int k8 = 0; k8 < 16; ++k8) {
      const bf16x8 v = ldfrag(qr + k8 * 8);
#pragma unroll
      for (int e = 0; e < 8; ++e) acc += nst[dir * 128 + k8 * 8 + e] * bf2f((bf16_t)v[e]);
    }
    nq[t] = acc;
  }
  __syncthreads();
  {
    const int dir = t >> 7, s = t & 127;
    float pm = -INFINITY;
    if (dir == 0) { for (int j = 0; j <= s; ++j) pm = fmaxf(pm, lib[j]); }
    else { for (int j = s; j < 128; ++j) pm = fmaxf(pm, lib[128 + j]); }
    const float m_in = MST[(bh * 2 + dir) * 64 + c];
    const float mr = bb[t] + fmaxf(m_in, pm);
    mrow[t] = mr;
    aT[t] = expf(bb[t] + m_in - mr);
  }
  __syncthreads();
  const int tl = w * 32 + r;
  const bf16_t* qrow = Qc + (size_t)(row0 + tl) * 512 + h * 128 + hh * 8;
  bf16x8 qf[8];
#pragma unroll
  for (int ks = 0; ks < 8; ++ks) qf[ks] = ldfrag(qrow + ks * 16);
  const int swz = r & 15;
  const char* kp[8]; const char* vp[16];
#pragma unroll
  for (int ks = 0; ks < 8; ++ks) kp[ks] = sK + r * 256 + (((ks * 2 + hh) ^ swz) << 4);
#pragma unroll
  for (int cc = 0; cc < 16; ++cc) vp[cc] = sV + r * 256 + 8 * hh + ((cc ^ swz) << 4);
  float* Hb = (float*)(p.ws + O_DC) + (size_t)item * 16384 + tl;
  float* Hbh = Hb + 4 * hh * 128;
  f32x16 outa[4];
#define MLSTM_DIR(DIR)                                                                                                   \
  {                                                                                                                      \
    const bf16_t* CSTl = (const bf16_t*)(p.ws + O_CST) + ((size_t)(bh * 2 + DIR) * 64 + c) * 16384 + lane * 8;           \
    const float bbt = bb[DIR * 128 + tl], mrt = mrow[DIR * 128 + tl], at = aT[DIR * 128 + tl];                            \
    float dsum = 0.f;                                                                                                    \
    const float* libp = lib + DIR * 128 + 4 * hh;                                                                        \
    const int tb = tl - 4 * hh;                                                                                          \
    bf16x8 pf[8];                                                                                                        \
    _Pragma("unroll") for (int half = 0; half < 2; ++half) {                                                             \
      f32x16 st[2];                                                                                                      \
      st[0] = fzero(); st[1] = fzero();                                                                                  \
      _Pragma("unroll") for (int ks = 0; ks < 8; ++ks) {                                                                 \
        _Pragma("unroll") for (int r2 = 0; r2 < 2; ++r2)                                                                 \
          st[r2] = MFMA(*(const bf16x8*)(kp[ks] + (half * 2 + r2) * 8192), qf[ks], st[r2]);                              \
      }                                                                                                                  \
      _Pragma("unroll") for (int r2 = 0; r2 < 2; ++r2) {                                                                 \
        const int rb = half * 2 + r2;                                                                                    \
        _Pragma("unroll") for (int i = 0; i < 16; ++i) {                                                                 \
          const int sc_ = rb * 32 + (i & 3) + 8 * (i >> 2);                                           \
          const int diff = DIR == 0 ? (tb - sc_) : (sc_ - tb);                                                           \
          const float msk = (float)((unsigned)(~diff) >> 31);                                                            \
          const float v = st[r2][i] * __expf(fminf(bbt + libp[sc_] - mrt, 0.f)) * msk;                                    \
          st[r2][i] = v; dsum += v;                                                                                      \
        }                                                                                                                \
        pf[rb * 2] = pack8(st[r2][0], st[r2][1], st[r2][2], st[r2][3], st[r2][4], st[r2][5], st[r2][6], st[r2][7]);      \
        pf[rb * 2 + 1] = pack8(st[r2][8], st[r2][9], st[r2][10], st[r2][11], st[r2][12], st[r2][13], st[r2][14], st[r2][15]); \
      }                                                                                                                  \
      __builtin_amdgcn_sched_barrier(0);                                                                                 \
    }                                                                                                                    \
    dsum += __shfl_xor(dsum, 32);                                                                                        \
    const float den = dsum + at * nq[DIR * 128 + tl];                                                                    \
    const float dinv = 1.f / fmaxf(fabsf(den), expf(-mrt));                                                              \
    _Pragma("unroll") for (int half = 0; half < 2; ++half) {                                                             \
      f32x16 ha[2];                                                                                                      \
      ha[0] = fzero(); ha[1] = fzero();                                                                                  \
      _Pragma("unroll") for (int ks = 0; ks < 8; ++ks) {                                                                 \
        _Pragma("unroll") for (int r2 = 0; r2 < 2; ++r2)                                                                 \
          ha[r2] = MFMA(ldfrag(CSTl + ((half * 2 + r2) * 8 + ks) * 512), qf[ks], ha[r2]);                                \
        if (ks == 3) __builtin_amdgcn_sched_barrier(0);                                                                  \
      }                                                                                                                  \
      _Pragma("unroll") for (int r2 = 0; r2 < 2; ++r2)                                                                   \
        _Pragma("unroll") for (int i = 0; i < 16; ++i) ha[r2][i] *= at;                                                  \
      __builtin_amdgcn_sched_barrier(0);                                                                                 \
      _Pragma("unroll") for (int kk = 0; kk < 8; ++kk) {                                                                 \
        _Pragma("unroll") for (int r2 = 0; r2 < 2; ++r2) {                                                               \
          const s16x4 lo = *(const s16x4*)(vp[2 * kk] + (half * 2 + r2) * 8192);                                         \
          const s16x4 hi = *(const s16x4*)(vp[2 * kk + 1] + (half * 2 + r2) * 8192);                                     \
          ha[r2] = MFMA(__builtin_shufflevector(lo, hi, 0, 1, 2, 3, 4, 5, 6, 7), pf[kk], ha[r2]);                        \
        }                                                                                                                \
      }                                                                                                                  \
      _Pragma("unroll") for (int r2 = 0; r2 < 2; ++r2)                                                                   \
        _Pragma("unroll") for (int i = 0; i < 16; ++i) {                                                                 \
          float* hp = Hbh + ((half * 2 + r2) * 32 + (i & 3) + 8 * (i >> 2)) * 128;                                       \
          if (DIR == 0) *hp = ha[r2][i] * dinv;                                                                          \
          else outa[half * 2 + r2][i] = *hp + ha[r2][i] * dinv;                                                          \
        }                                                                                                                \
      __builtin_amdgcn_sched_barrier(0);                                                                                 \
    }                                                                                                                    \
  }
  MLSTM_DIR(0)
  MLSTM_DIR(1)
#undef MLSTM_DIR
  float ss = 0.f;
#pragma unroll
  for (int rb = 0; rb < 4; ++rb)
#pragma unroll
    for (int i = 0; i < 16; ++i) ss += outa[rb][i] * outa[rb][i];
  ss += __shfl_xor(ss, 32);
  const float rn = rsqrtf(ss * (1.f / 128.f) + EPS);
  const size_t row = (size_t)row0 + tl;
#pragma unroll
  for (int rb = 0; rb < 4; ++rb)
#pragma unroll
    for (int q4 = 0; q4 < 4; ++q4) {
      const int v = rb * 32 + 8 * q4 + 4 * hh;
      const s16x4 ov = *(const s16x4*)(P + row * PLD + 1536 + h * 128 + v);
      const float4 hg = *(const float4*)(p.ab_head_g + h * 128 + v);
      const float y0 = outa[rb][4 * q4] * rn * hg.x * sigmf(bf2f((bf16_t)ov[0]));
      const float y1 = outa[rb][4 * q4 + 1] * rn * hg.y * sigmf(bf2f((bf16_t)ov[1]));
      const float y2 = outa[rb][4 * q4 + 2] * rn * hg.z * sigmf(bf2f((bf16_t)ov[2]));
      const float y3 = outa[rb][4 * q4 + 3] * rn * hg.w * sigmf(bf2f((bf16_t)ov[3]));
      uint2 u; u.x = pack2(y0, y1); u.y = pack2(y2, y3);
      *(uint2*)(MIX + row * 1024 + h * 128 + v) = u;
    }
  __syncthreads();
}

DI void phase_topk(const Params& p, char* smem) {
  unsigned* vals = (unsigned*)smem;
  unsigned* hist = vals + 8448;
  unsigned* cntg = hist + 256;
  unsigned* cnte = cntg + 256;
  unsigned* misc = cnte + 256;
  const float* AFF = (const float*)(p.ws + O_AFF);
  int* IDX = (int*)(p.ws + O_IDX); float* GATE = (float*)(p.ws + O_GATE);
  const int t = tid();
  for (int item = blockIdx.x; item < 32; item += gridDim.x) {
    const float* a = AFF + (size_t)item * 8192;
    for (int i = t; i < 8192; i += 256) vals[i + (i >> 5)] = __float_as_uint(a[i]);
    unsigned prefix = 0, remaining = 1024;
    for (int pass = 0; pass < 4; ++pass) {
      const int shift = 24 - 8 * pass;
      hist[t] = 0;
      __syncthreads();
      const unsigned mask = pass == 0 ? 0u : (0xFFFFFFFFu << (shift + 8));
      for (int i = t; i < 8192; i += 256) {
        const unsigned u = vals[i + (i >> 5)];
        if ((u & mask) == (prefix & mask)) atomicAdd(&hist[(u >> shift) & 255], 1u);
      }
      __syncthreads();
      if (t == 0) {
        unsigned cum = 0; int sel = 0;
        for (int bin = 255; bin >= 0; --bin) {
          const unsigned cc = hist[bin];
          if (cum + cc >= remaining) { sel = bin; break; }
          cum += cc;
        }
        misc[0] = prefix | ((unsigned)sel << shift);
        misc[1] = remaining - cum;
      }
      __syncthreads();
      prefix = misc[0]; remaining = misc[1];
      __syncthreads();
    }
    const unsigned T = prefix, need_eq = remaining;
    unsigned cg_ = 0, ce = 0;
    for (int j = 0; j < 32; ++j) {
      const int n = t * 32 + j;
      const unsigned u = vals[n + (n >> 5)];
      cg_ += u > T; ce += u == T;
    }
    cntg[t] = cg_; cnte[t] = ce;
    __syncthreads();
    unsigned pg = 0, pe = 0;
    for (int j = 0; j < t; ++j) { pg += cntg[j]; pe += cnte[j]; }
    for (int j = 0; j < 32; ++j) {
      const int n = t * 32 + j;
      const unsigned u = vals[n + (n >> 5)];
      if (u > T) { IDX[item * 1024 + pg] = n; GATE[item * 1024 + pg] = __uint_as_float(u); ++pg; }
      else if (u == T) {
        if (pe < need_eq) { const unsigned slot = 1024 - need_eq + pe; IDX[item * 1024 + slot] = n; GATE[item * 1024 + slot] = __uint_as_float(u); }
        ++pe;
      }
    }
    __syncthreads();
  }
}

DI void phase_stats(const Params& p, char* smem) {
  float* red = (float*)smem;
  const bf16_t* GVT = (const bf16_t*)(p.ws + O_GVT);
  float* STATS = (float*)(p.ws + O_STATS);
  const int t = tid(), qq = t & 31, cg_ = t >> 5;
  for (int chunk = blockIdx.x; chunk < 128; chunk += gridDim.x) {
    const bf16_t* base = GVT + (size_t)chunk * 2048 * 128 + qq * 4;
    float s[4] = {0.f, 0.f, 0.f, 0.f}, s2[4] = {0.f, 0.f, 0.f, 0.f};
    for (int c = cg_; c < 2048; c += 8) {
      const s16x4 v = *(const s16x4*)(base + (size_t)c * 128);
#pragma unroll
      for (int e = 0; e < 4; ++e) { const float f = bf2f((bf16_t)v[e]); s[e] += f; s2[e] += f * f; }
    }
#pragma unroll
    for (int e = 0; e < 4; ++e) { red[(cg_ * 128 + qq * 4 + e) * 2] = s[e]; red[(cg_ * 128 + qq * 4 + e) * 2 + 1] = s2[e]; }
    __syncthreads();
    if (t < 128) {
      float a = 0.f, b2 = 0.f;
      for (int g = 0; g < 8; ++g) { a += red[(g * 128 + t) * 2]; b2 += red[(g * 128 + t) * 2 + 1]; }
      const float mu = a * (1.f / 2048.f);
      const float var = fmaxf(b2 * (1.f / 2048.f) - mu * mu, 0.f);
      STATS[(size_t)(chunk * 128 + t) * 2] = mu;
      STATS[(size_t)(chunk * 128 + t) * 2 + 1] = rsqrtf(var + EPS);
    }
    __syncthreads();
  }
}
DI void phase_spatial(const Params& p, char* smem) {
  float* smu = (float*)smem;
  float* srs = smu + 128;
  const bf16_t* GVT = (const bf16_t*)(p.ws + O_GVT); const bf16_t* U = (const bf16_t*)(p.ws + O_U);
  const float* STATS = (const float*)(p.ws + O_STATS);
  bf16_t* UV = (bf16_t*)(p.ws + O_UV);
  for (int item = blockIdx.x; item < 1024; item += gridDim.x) {
    int t_ = tid();
    asm volatile("" : "+v"(t_));
    const int t = t_, lane = t & 63, w = t >> 6, r = lane & 31, hh = lane >> 5;
    const int chunk = item >> 3, g = item & 7;
    if (t < 128) { smu[t] = STATS[(size_t)(chunk * 128 + t) * 2]; srs[t] = STATS[(size_t)(chunk * 128 + t) * 2 + 1]; }
    __syncthreads();
    const float* Ws = p.gm_w_s + (size_t)g * 16384;
    f32x16 acc[4][2];
#pragma unroll
    for (int i = 0; i < 4; ++i) { acc[i][0] = fzero(); acc[i][1] = fzero(); }
    const int cA = g * 256 + w * 64 + r, cB = cA + 32;
    const float lgA = p.gm_ln_g[cA], lbA = p.gm_ln_b[cA], lgB = p.gm_ln_g[cB], lbB = p.gm_ln_b[cB];
    const bf16_t* vA = GVT + ((size_t)chunk * 2048 + cA) * 128 + hh * 8;
    const bf16_t* vB = GVT + ((size_t)chunk * 2048 + cB) * 128 + hh * 8;
    for (int ks = 0; ks < 8; ++ks) {
      const bf16x8 ra = ldfrag(vA + ks * 16), rbv = ldfrag(vB + ks * 16);
      const float* mu = smu + ks * 16 + hh * 8; const float* rs = srs + ks * 16 + hh * 8;
      const bf16x8 bA = pack8((bf2f((bf16_t)ra[0]) - mu[0]) * rs[0] * lgA + lbA, (bf2f((bf16_t)ra[1]) - mu[1]) * rs[1] * lgA + lbA,
                              (bf2f((bf16_t)ra[2]) - mu[2]) * rs[2] * lgA + lbA, (bf2f((bf16_t)ra[3]) - mu[3]) * rs[3] * lgA + lbA,
                              (bf2f((bf16_t)ra[4]) - mu[4]) * rs[4] * lgA + lbA, (bf2f((bf16_t)ra[5]) - mu[5]) * rs[5] * lgA + lbA,
                              (bf2f((bf16_t)ra[6]) - mu[6]) * rs[6] * lgA + lbA, (bf2f((bf16_t)ra[7]) - mu[7]) * rs[7] * lgA + lbA);
      const bf16x8 bB = pack8((bf2f((bf16_t)rbv[0]) - mu[0]) * rs[0] * lgB + lbB, (bf2f((bf16_t)rbv[1]) - mu[1]) * rs[1] * lgB + lbB,
                              (bf2f((bf16_t)rbv[2]) - mu[2]) * rs[2] * lgB + lbB, (bf2f((bf16_t)rbv[3]) - mu[3]) * rs[3] * lgB + lbB,
                              (bf2f((bf16_t)rbv[4]) - mu[4]) * rs[4] * lgB + lbB, (bf2f((bf16_t)rbv[5]) - mu[5]) * rs[5] * lgB + lbB,
                              (bf2f((bf16_t)rbv[6]) - mu[6]) * rs[6] * lgB + lbB, (bf2f((bf16_t)rbv[7]) - mu[7]) * rs[7] * lgB + lbB);
#pragma unroll
      for (int rb = 0; rb < 4; ++rb) {
        const float* wp = Ws + (rb * 32 + r) * 128 + ks * 16 + hh * 8;
        const float4 w0 = *(const float4*)wp, w1 = *(const float4*)(wp + 4);
        const bf16x8 a = pack8(w0.x, w0.y, w0.z, w0.w, w1.x, w1.y, w1.z, w1.w);
        acc[rb][0] = MFMA(a, bA, acc[rb][0]);
        acc[rb][1] = MFMA(a, bB, acc[rb][1]);
      }
    }
#pragma unroll
    for (int rb = 0; rb < 4; ++rb)
#pragma unroll
      for (int i = 0; i < 16; ++i) {
        const int pp = rb * 32 + crow(i, hh);
        const float bs = p.gm_b_s[g * 128 + pp];
        const size_t row = (size_t)chunk * 128 + pp;
        UV[row * 2048 + cA] = f2bf(bf2f(U[row * 2048 + cA]) * (acc[rb][0][i] + bs));
        UV[row * 2048 + cB] = f2bf(bf2f(U[row * 2048 + cB]) * (acc[rb][1][i] + bs));
      }
    __syncthreads();
  }
}

struct EpiBf16 {
  bf16_t* dst; int ld;
  DI void operator()(f32x16 (&acc)[2][2], int mb, int nb, int r, int hh) const {
#pragma unroll
    for (int mi = 0; mi < 2; ++mi)
#pragma unroll
      for (int ni = 0; ni < 2; ++ni)
#pragma unroll
        for (int i = 0; i < 16; ++i)
          dst[(size_t)(mb + mi * 32 + crow(i, hh)) * ld + nb + ni * 32 + r] = f2bf(acc[mi][ni][i]);
  }
};
struct EpiRes {
  float* out; const float* base; const float* gate;
  DI void operator()(f32x16 (&acc)[2][2], int mb, int nb, int r, int hh) const {
#pragma unroll
    for (int ni = 0; ni < 2; ++ni) {
      const int n = nb + ni * 32 + r;
      const float gt = gate[n];
#pragma unroll
      for (int mi = 0; mi < 2; ++mi) {
        const size_t o0 = (size_t)(mb + mi * 32 + 4 * hh) * 1024 + n;
        float* op = out + o0; const float* bp = base + o0;
#pragma unroll
        for (int i = 0; i < 16; ++i) {
          const int off = ((i & 3) + 8 * (i >> 2)) * 1024;
          op[off] = bp[off] + gt * acc[mi][ni][i];
        }
        __builtin_amdgcn_sched_barrier(0);
      }
    }
  }
};
struct EpiGelu {
  bf16_t* U; bf16_t* GVT; int m0, n0;
  DI void operator()(f32x16 (&acc)[2][2], int mb, int nb, int r, int hh) const {
    if (n0 < 2048) {
#pragma unroll
      for (int mi = 0; mi < 2; ++mi)
#pragma unroll
        for (int ni = 0; ni < 2; ++ni)
#pragma unroll
          for (int i = 0; i < 16; ++i)
            U[(size_t)(m0 + mb + mi * 32 + crow(i, hh)) * 2048 + n0 + nb + ni * 32 + r] = f2bf(geluf(acc[mi][ni][i]));
    } else {
      const int chunk = m0 >> 7;
#pragma unroll
      for (int mi = 0; mi < 2; ++mi)
#pragma unroll
        for (int ni = 0; ni < 2; ++ni) {
          const int cc = n0 - 2048 + nb + ni * 32 + r;
          bf16_t* d = GVT + ((size_t)chunk * 2048 + cc) * 128 + mb + mi * 32 + 4 * hh;
#pragma unroll
          for (int q4 = 0; q4 < 4; ++q4) {
            uint2 u;
            u.x = pack2(geluf(acc[mi][ni][4 * q4]), geluf(acc[mi][ni][4 * q4 + 1]));
            u.y = pack2(geluf(acc[mi][ni][4 * q4 + 2]), geluf(acc[mi][ni][4 * q4 + 3]));
            *(uint2*)(d + 8 * q4) = u;
          }
        }
    }
  }
};
struct EpiSwiglu {
  bf16_t* hid;
  DI void operator()(f32x16 (&acc)[2][2], int mb, int nb, int r, int hh) const {
    const int f = (nb >> 1) + r;
#pragma unroll
    for (int mi = 0; mi < 2; ++mi)
#pragma unroll
      for (int i = 0; i < 16; ++i) {
        const float gv = acc[mi][0][i], uv = acc[mi][1][i];
        hid[(size_t)(mb + mi * 32 + crow(i, hh)) * 1024 + f] = f2bf(siluf(gv) * uv);
      }
  }
};
struct EpiMoeOut {
  float* out; const int* idx; const float* gate; const float* gt2;
  int n0;
  DI void operator()(f32x16 (&acc)[2][2], int mb, int nb, int r, int hh) const {
#pragma unroll
    for (int mi = 0; mi < 2; ++mi)
#pragma unroll
      for (int i = 0; i < 16; ++i) {
        const int slot = mb + mi * 32 + crow(i, hh);
        const int tok = idx[slot];
        const float gs = gate[slot];
#pragma unroll
        for (int ni = 0; ni < 2; ++ni) {
          const int n = nb + ni * 32 + r;
          unsafeAtomicAdd(out + (size_t)tok * 1024 + n0 + n, gt2[n] * gs * acc[mi][ni][i]);
        }
      }
  }
};

DI void phase_moe1(const Params& p, char* smem) {
  const bf16_t* HA = (const bf16_t*)(p.ws + O_HA); const bf16_t* WGU = (const bf16_t*)(p.ws + O_MGU);
  const int* IDX = (const int*)(p.ws + O_IDX); bf16_t* HID = (bf16_t*)(p.ws + O_HID);
  const int t = tid(), lrow = t >> 3, lcol = (t & 7) * 8;
  for (TileWalk tw(256 * 16); tw.valid(); tw.next()) {
    int mg, nt; tw.get(8, 8, 2, mg, nt);
    const int e = mg >> 4, b = (mg >> 3) & 1, mt = mg & 7, be = b * 16 + e;
    const bf16_t* ap[4]; const bf16_t* bp[4];
#pragma unroll
    for (int i = 0; i < 4; ++i) {
      const int tok = IDX[be * 1024 + mt * 128 + lrow + 32 * i];
      ap[i] = HA + ((size_t)b * 8192 + tok) * 1024 + lcol;
      bp[i] = WGU + ((size_t)e * 2048 + nt * 128 + lrow + 32 * i) * 1024 + lcol;
    }
    gemm_tile(ap, bp, 1024, smem, EpiSwiglu{HID + ((size_t)be * 1024 + mt * 128) * 1024 + nt * 64});
  }
}
DI void phase_moe2(const Params& p, int layer, char* smem) {
  const bf16_t* HID = (const bf16_t*)(p.ws + O_HID); const bf16_t* WD = (const bf16_t*)(p.ws + O_MD);
  const int* IDX = (const int*)(p.ws + O_IDX); const float* GATE = (const float*)(p.ws + O_GATE);
  const float* modv = (const float*)(p.ws + O_MODV);
  const int t = tid(), lrow = t >> 3, lcol = (t & 7) * 8;
  for (TileWalk tw(256 * 8); tw.valid(); tw.next()) {
    int mg, nt; tw.get(8, 8, 1, mg, nt);
    const int e = mg >> 4, b = (mg >> 3) & 1, mt = mg & 7, be = b * 16 + e;
    const bf16_t* ap[4]; const bf16_t* bp[4];
#pragma unroll
    for (int i = 0; i < 4; ++i) {
      ap[i] = HID + ((size_t)be * 1024 + mt * 128 + lrow + 32 * i) * 1024 + lcol;
      bp[i] = WD + ((size_t)e * 1024 + nt * 128 + lrow + 32 * i) * 1024 + lcol;
    }
    gemm_tile(ap, bp, 1024, smem,
              EpiMoeOut{p.out + (size_t)b * 8192 * 1024, IDX + be * 1024 + mt * 128, GATE + be * 1024 + mt * 128,
                        modv + (layer * 3 + b) * 6144 + 5 * 1024 + nt * 128, nt * 128});
  }
}

DI void phase_final(const Params& p) {
  const int t = tid(), lane = t & 63, w = t >> 6;
  for (int row = blockIdx.x * 4 + w; row < NTOK; row += gridDim.x * 4) {
    float* src = p.out + (size_t)row * 1024;
    float4 xv[4]; float ss = 0.f;
#pragma unroll
    for (int i = 0; i < 4; ++i) {
      xv[i] = *(const float4*)(src + (i * 64 + lane) * 4);
      ss += xv[i].x * xv[i].x + xv[i].y * xv[i].y + xv[i].z * xv[i].z + xv[i].w * xv[i].w;
    }
    ss = wsum(ss);
    const float rstd = rsqrtf(ss * (1.f / 1024.f) + EPS);
#pragma unroll
    for (int i = 0; i < 4; ++i) {
      const int col = (i * 64 + lane) * 4;
      const float4 g4 = *(const float4*)(p.final_norm_g + col);
      float4 y; y.x = xv[i].x * rstd * g4.x; y.y = xv[i].y * rstd * g4.y; y.z = xv[i].z * rstd * g4.z; y.w = xv[i].w * rstd * g4.w;
      *(float4*)(src + col) = y;
    }
  }
}

constexpr int NPHASE = 22;
DI void run_phase(const Params& p, int ph, char* smem) {
  const float* modv = (const float*)(p.ws + O_MODV);
  switch (ph) {
#if !defined(ONLY) || ONLY == 0
    case 0:
      phase_adaln(p, smem);
      __syncthreads();
      tconv(p.ab_w_in, 2832, 2832, 1024, 1, 0, (bf16_t*)(p.ws + O_WIN), 0, 1, smem);
      tconv(p.ab_w_out, 1024, 1024, 1024, 1, 0, (bf16_t*)(p.ws + O_WOUT), 0, 0, smem);
      tconv(p.gm_w_in, 4096, 4096, 1024, 1, 0, (bf16_t*)(p.ws + O_GMIN), 0, 0, smem);
      tconv(p.gm_w_out, 1024, 1024, 2048, 1, 0, (bf16_t*)(p.ws + O_GMOUT), 0, 0, smem);
      tconv_moe(p, 0, smem);
      break;
#endif
#if !defined(ONLY) || ONLY == 1
    case 1: phase_modulate<1>(p, 0, 0, smem); break;
#endif
#if !defined(ONLY) || ONLY == 2
    case 2:
      gemm_dense((const bf16_t*)(p.ws + O_HA), (const bf16_t*)(p.ws + O_WIN), NROW, PLD, 1024, 6, 11, smem,
                 [&](int m0, int n0) { return EpiBf16{(bf16_t*)(p.ws + O_P) + (size_t)m0 * PLD + n0, PLD}; });
      break;
#endif
#if !defined(ONLY) || ONLY == 3
    case 3: phase_prep2(p, smem); break;
#endif
#if !defined(ONLY) || ONLY == 4
    case 4:
      for (int item = blockIdx.x; item < 1024 + 8 * NSTEP; item += gridDim.x) {
        if (item < 1024) attn_item(p, item); else mlstm_local_item(p, item - 1024, smem);
      }
      break;
#endif
#if !defined(ONLY) || ONLY == 5
    case 5: phase_scan(p); break;
#endif
#if !defined(ONLY) || ONLY == 6
    case 6:
      for (int item = blockIdx.x; item < 512; item += gridDim.x) mlstm_out_item(p, item, smem);
      break;
#endif
#if !defined(ONLY) || ONLY == 7
    case 7:
      gemm_dense((const bf16_t*)(p.ws + O_HA), (const bf16_t*)(p.ws + O_WOUT), NTOK, 1024, 1024, 8, 8, smem,
                 [&](int m0, int n0) {
                   return EpiRes{p.out + (size_t)m0 * 1024 + n0, p.x + (size_t)m0 * 1024 + n0, modv + (0 * 3 + (m0 >> 13)) * 6144 + 2 * 1024 + n0};
                 });
      break;
#endif
#if !defined(ONLY) || ONLY == 8
    case 8: phase_modulate<2>(p, 0, 1, smem); break;
#endif
#if !defined(ONLY) || ONLY == 9
    case 9: phase_topk(p, smem); break;
#endif
#if !defined(ONLY) || ONLY == 10
    case 10: phase_moe1(p, smem); break;
#endif
#if !defined(ONLY) || ONLY == 11
    case 11: phase_moe2(p, 0, smem); break;
#endif
#if !defined(ONLY) || ONLY == 12
    case 12:
      phase_modulate<0>(p, 1, 0, smem);
      __syncthreads();
      tconv_moe(p, 1, smem);
      break;
#endif
#if !defined(ONLY) || ONLY == 13
    case 13:
      gemm_dense((const bf16_t*)(p.ws + O_HA), (const bf16_t*)(p.ws + O_GMIN), NTOK, 4096, 1024, 8, 8, smem,
                 [&](int m0, int n0) { return EpiGelu{(bf16_t*)(p.ws + O_U), (bf16_t*)(p.ws + O_GVT), m0, n0}; });
      break;
#endif
#if !defined(ONLY) || ONLY == 14
    case 14: phase_stats(p, smem); break;
#endif
#if !defined(ONLY) || ONLY == 15
    case 15: phase_spatial(p, smem); break;
#endif
#if !defined(ONLY) || ONLY == 16
    case 16:
      gemm_dense((const bf16_t*)(p.ws + O_UV), (const bf16_t*)(p.ws + O_GMOUT), NTOK, 1024, 2048, 8, 8, smem,
                 [&](int m0, int n0) {
                   return EpiRes{p.out + (size_t)m0 * 1024 + n0, p.out + (size_t)m0 * 1024 + n0, modv + (1 * 3 + (m0 >> 13)) * 6144 + 2 * 1024 + n0};
                 });
      break;
#endif
#if !defined(ONLY) || ONLY == 17
    case 17: phase_modulate<2>(p, 1, 1, smem); break;
#endif
#if !defined(ONLY) || ONLY == 18
    case 18: phase_topk(p, smem); break;
#endif
#if !defined(ONLY) || ONLY == 19
    case 19: phase_moe1(p, smem); break;
#endif
#if !defined(ONLY) || ONLY == 20
    case 20: phase_moe2(p, 1, smem); break;
#endif
#if !defined(ONLY) || ONLY == 21
    case 21: phase_final(p); break;
#endif
    default: break;
  }
}

#define XB_TMO      128
#define XB_XCNT(j)  (256  + 64 * (j))
#define XB_XSUB(j)  (1280 + 64 * (j))
#define XB_XGEN(j)  (2304 + 64 * (j))
#define XB_TOP      3328
#define XB_TOPGEN   3392
#define XCD_BAR_WORDS 3456
#define XB_SPIN_CAP (1u << 18)
#define LAS __attribute__((address_space(3)))
DI unsigned xb_ld(unsigned* p) { return __hip_atomic_load(p, __ATOMIC_RELAXED, __HIP_MEMORY_SCOPE_AGENT); }
DI unsigned xb_add(unsigned* p, unsigned v) { return __hip_atomic_fetch_add(p, v, __ATOMIC_RELAXED, __HIP_MEMORY_SCOPE_AGENT); }
DI unsigned xb_xcc_id() { return (unsigned)__builtin_amdgcn_s_getreg((3 << 11) | 20) & 0xFu; }
#define XB_SPIN(cond, bar) do { unsigned _sp = 0; while (cond) { __builtin_amdgcn_s_sleep(1); \
    if ((++_sp & 255u) == 0u) { if (xb_ld(&(bar)[XB_TMO])) break; if (_sp > XB_SPIN_CAP) { atomicAdd(&(bar)[XB_TMO], 1u); break; } } } } while (0)
struct XcdBarrier { unsigned* bar; unsigned x; volatile LAS unsigned* st; };
DI XcdBarrier xcd_barrier_post(unsigned* bar, volatile LAS unsigned* st) {
  XcdBarrier b; b.bar = bar; b.x = xb_xcc_id(); b.st = st;
  if (threadIdx.x == 0) (void)xb_add(&bar[XB_XCNT(b.x)], 1u);
  return b;
}
DI void xcd_barrier_complete(unsigned* bar, unsigned x, unsigned& nloc, unsigned& nx) {
  const unsigned G = gridDim.x * gridDim.y * gridDim.z;
  unsigned sum, cnt, mine, sp = 0u;
  for (;;) {
    sum = 0u; cnt = 0u; mine = 0u;
#pragma unroll
    for (unsigned j = 0; j < 16; ++j) { const unsigned c = xb_ld(&bar[XB_XCNT(j)]); sum += c; cnt += (c > 0u) ? 1u : 0u; mine = (j == x) ? c : mine; }
    if (sum == G) break;
    __builtin_amdgcn_s_sleep(1);
    if ((++sp & 255u) == 0u) { if (xb_ld(&bar[XB_TMO])) break; if (sp > XB_SPIN_CAP) { atomicAdd(&bar[XB_TMO], 1u); break; } }
  }
  nloc = mine > 0u ? mine : 1u; nx = cnt > 0u ? cnt : 1u;
}
DI void xcd_barrier(const XcdBarrier& b) {
  asm volatile("s_waitcnt vmcnt(0)" ::: "memory");
  __syncthreads();
  if (threadIdx.x == 0) {
    unsigned* bar = b.bar;
    __builtin_amdgcn_s_waitcnt(0);
    unsigned nloc = b.st[0], nx = b.st[1];
    if (nloc == 0u) { xcd_barrier_complete(bar, b.x, nloc, nx); b.st[0] = nloc; b.st[1] = nx; }
    const unsigned old = xb_add(&bar[XB_XSUB(b.x)], 1u);
    const unsigned gen = old / nloc;
    if (old + 1u == (gen + 1u) * nloc) {
      __builtin_amdgcn_fence(__ATOMIC_RELEASE, "agent");
      asm volatile("s_waitcnt vmcnt(0)" ::: "memory");
      const unsigned og = xb_add(&bar[XB_TOP], 1u);
      const unsigned tg = og / nx;
      if (og + 1u == (tg + 1u) * nx) xb_add(&bar[XB_TOPGEN], 1u);
      else XB_SPIN(xb_ld(&bar[XB_TOPGEN]) == tg, bar);
      __builtin_amdgcn_fence(__ATOMIC_ACQUIRE, "agent");
      xb_add(&bar[XB_XGEN(b.x)], 1u);
      asm volatile("s_waitcnt vmcnt(0)" ::: "memory");
    } else {
      XB_SPIN(xb_ld(&bar[XB_XGEN(b.x)]) == gen, bar);
      __builtin_amdgcn_fence(__ATOMIC_ACQUIRE, "agent");
      asm volatile("s_waitcnt vmcnt(0)" ::: "memory");
    }
  }
  __syncthreads();
}

DI Params kargs() {
  struct Raw { unsigned long long v[27]; } raw;
  static_assert(sizeof(Raw) == sizeof(Params), "Params must be 27 pointers");
#if defined(__HIP_DEVICE_COMPILE__)
  typedef const unsigned long long __attribute__((address_space(4))) CU;
  CU* q = (CU*)__builtin_amdgcn_kernarg_segment_ptr();
  asm volatile("" : "+s"(q));
#pragma unroll
  for (int i = 0; i < 27; ++i) raw.v[i] = q[i];
#else
  for (int i = 0; i < 27; ++i) raw.v[i] = 0;
#endif
  return __builtin_bit_cast(Params, raw);
}
#if COOP
#ifndef REPEAT_MASK
#define REPEAT_MASK 0
#endif
__global__ void __launch_bounds__(256, 2) mega(Params p_unused) {
  __shared__ __attribute__((aligned(16))) char smem[73728];
  __shared__ __attribute__((aligned(16))) unsigned xbw[4];
  cg::grid_group grid = cg::this_grid();
  if (threadIdx.x < 4) xbw[threadIdx.x] = 0u;
  __syncthreads();
  XcdBarrier xb;
  { const Params pp = kargs(); xb = xcd_barrier_post((unsigned*)(pp.ws + O_BAR), (volatile LAS unsigned*)xbw); }
#define PHX(n) { const Params pp = kargs(); run_phase(pp, n, smem); } xcd_barrier(xb); \
  if ((REPEAT_MASK >> n) & 1) { { const Params pp = kargs(); run_phase(pp, n, smem); } xcd_barrier(xb); }
  { const Params pp = kargs(); run_phase(pp, 0, smem); }
  grid.sync();
  PHX(1) PHX(2) PHX(3) PHX(4) PHX(5) PHX(6) PHX(7) PHX(8) PHX(9) PHX(10)
  PHX(11) PHX(12) PHX(13) PHX(14) PHX(15) PHX(16) PHX(17) PHX(18) PHX(19) PHX(20)
  { const Params pp = kargs(); run_phase(pp, 21, smem); }
}
#else
__global__ void __launch_bounds__(256, 2) mega(Params p, int ph) {
  __shared__ __attribute__((aligned(16))) char smem[73728];
  run_phase(p, ph, smem);
}
#endif

extern "C" void kernel_launch(void* const* d_in, const int* in_sizes, int n_in, void* d_out, int out_size, void* d_ws,
                              size_t ws_size, hipStream_t stream) {
  (void)in_sizes; (void)n_in; (void)out_size;
  if (ws_size < WS_NEED) { fprintf(stderr, "workspace too small: %zu < %zu\n", ws_size, (size_t)WS_NEED); return; }
  static int grid_blocks = 0;
  if (!grid_blocks) {
    int dev = 0, cus = 0, per_cu = 0;
    hipGetDevice(&dev);
    hipDeviceGetAttribute(&cus, hipDeviceAttributeMultiprocessorCount, dev);
    hipOccupancyMaxActiveBlocksPerMultiprocessor(&per_cu, mega, 256, 0);
    if (per_cu < 1) per_cu = 1;
    if (per_cu > 2) per_cu = 2;
    grid_blocks = cus * per_cu;
  }
  Params p{};
  const float** f = (const float**)&p;
  for (int i = 0; i < 25; ++i) f[i] = (const float*)d_in[i];
  p.out = (float*)d_out;
  p.ws = (char*)d_ws;
#if COOP
  hipMemsetAsync((char*)d_ws + O_BAR, 0, XCD_BAR_WORDS * 4, stream);
  void* args[] = {&p};
  hipError_t e = hipLaunchCooperativeKernel((void*)mega, dim3(grid_blocks), dim3(256), args, 0, stream);
  if (e != hipSuccess) fprintf(stderr, "cooperative launch failed: %s (grid %d)\n", hipGetErrorString(e), grid_blocks);
#else
  for (int ph = 0; ph < NPHASE; ++ph) hipLaunchKernelGGL(mega, dim3(grid_blocks), dim3(256), 0, stream, p, ph);
#endif
}
```

```cpp
#include <hip/hip_runtime.h>
#include <hip/hip_cooperative_groups.h>
#include <cstdio>
namespace cg = cooperative_groups;

#define DI __device__ __forceinline__
typedef unsigned short bf16_t;
using bf16x8 = __attribute__((ext_vector_type(8))) short;
using s16x4 = __attribute__((ext_vector_type(4))) short;
using f32x16 = __attribute__((ext_vector_type(16))) float;
#define MFMA(a, b, c) __builtin_amdgcn_mfma_f32_32x32x16_bf16((a), (b), (c), 0, 0, 0)

#ifndef COOP
#define COOP 1
#endif

constexpr int DM = 1024, NBAT = 2, SEQ = 8192, NTOK = NBAT * SEQ, CTXL = 256, NROW = NTOK + NBAT * CTXL;
constexpr int PLD = 2816;
constexpr int NSTEP = 66;
constexpr float EPS = 1e-6f;

constexpr size_t al256(size_t x) { return (x + 255) & ~(size_t)255; }
constexpr size_t O_BAR = 0;
constexpr size_t O_WIN = 16384;
constexpr size_t O_WOUT = O_WIN + al256((size_t)PLD * 1024 * 2);
constexpr size_t O_GMIN = O_WOUT + al256((size_t)1024 * 1024 * 2);
constexpr size_t O_GMOUT = O_GMIN + al256((size_t)4096 * 1024 * 2);
constexpr size_t O_MGU = O_GMOUT + al256((size_t)1024 * 2048 * 2);
constexpr size_t O_MD = O_MGU + al256((size_t)16 * 2048 * 1024 * 2);
constexpr size_t O_MODV = O_MD + al256((size_t)16 * 1024 * 1024 * 2);
constexpr size_t O_HA = O_MODV + al256((size_t)2 * 3 * 6144 * 4);
constexpr size_t O_GL = O_HA + al256((size_t)NROW * 1024 * 2);
constexpr size_t O_AFF = O_GL + al256((size_t)NROW * 16 * 4);
constexpr size_t O_IDX = O_AFF + al256((size_t)32 * 8192 * 4);
constexpr size_t O_GATE = O_IDX + al256((size_t)32 * 1024 * 4);
constexpr size_t O_STATS = O_GATE + al256((size_t)32 * 1024 * 4);
constexpr size_t O_GSC = O_STATS + al256((size_t)NTOK * 2 * 4);
constexpr size_t O_MLOC = O_GSC + al256((size_t)16 * NSTEP * 4);
constexpr size_t O_DN = O_MLOC + al256((size_t)16 * NSTEP * 4);
constexpr size_t O_NST = O_DN + al256((size_t)16 * NSTEP * 128 * 4);
constexpr size_t O_MST = O_NST + al256((size_t)16 * 64 * 128 * 4);
constexpr size_t O_INV = O_MST + al256((size_t)16 * 64 * 4);
constexpr size_t O_R12 = O_INV + al256((size_t)NTOK * 16 * 4);
constexpr size_t O_P = O_R12;
constexpr size_t O_QC = O_P + al256((size_t)NROW * PLD * 2);
constexpr size_t O_KC = O_QC + al256((size_t)NTOK * 512 * 2);
constexpr size_t O_KT = O_KC + al256((size_t)NTOK * 512 * 2);
constexpr size_t O_VT = O_KT + al256((size_t)132 * 4 * 128 * 128 * 2);
constexpr size_t O_RQ = O_VT + al256((size_t)132 * 4 * 128 * 128 * 2);
constexpr size_t O_RK = O_RQ + al256((size_t)NTOK * 512 * 2);
constexpr size_t O_AVTX = O_RK + al256((size_t)NROW * 128 * 2);
constexpr size_t O_AVTC = O_AVTX + al256((size_t)4 * 64 * 8192 * 2);
constexpr size_t O_R12_END = O_AVTC + al256((size_t)4 * 64 * 256 * 2);
constexpr size_t O_HID = O_R12;
constexpr size_t O_U = O_R12;
constexpr size_t O_GVT = O_U + al256((size_t)NTOK * 2048 * 2);
static_assert(O_GVT + (size_t)NTOK * 2048 * 2 <= O_R12_END, "R12 too small");
constexpr size_t O_DC = O_R12_END;
constexpr size_t O_CST = O_DC + al256((size_t)16 * NSTEP * 16384 * 4);
constexpr size_t O_UV = O_DC;
constexpr size_t O_YE = O_DC;
constexpr size_t WS_NEED = O_CST + al256((size_t)16 * 64 * 16384 * 2);

struct Params {
  const float *x, *c, *ctx, *c_ctx, *w_mod, *b_mod, *norm_mix_g, *norm_ffn_g, *final_norm_g;
  const float *ab_w_in, *ab_conv_w, *ab_gate_b, *ab_head_g, *ab_sink, *ab_w_out;
  const float *gm_w_in, *gm_ln_g, *gm_ln_b, *gm_w_s, *gm_b_s, *gm_w_out;
  const float *moe_w_router, *moe_w_gate, *moe_w_up, *moe_w_down;
  float* out;
  char* ws;
};

DI bf16_t f2bf(float x) { unsigned u = __float_as_uint(x); u += 0x7fffu + ((u >> 16) & 1u); return (bf16_t)(u >> 16); }
DI float bf2f(bf16_t b) { return __uint_as_float(((unsigned)b) << 16); }
DI unsigned pack2(float a, float b) { return (unsigned)f2bf(a) | ((unsigned)f2bf(b) << 16); }
DI bf16x8 pack8(float a0, float a1, float a2, float a3, float a4, float a5, float a6, float a7) {
  uint4 u; u.x = pack2(a0, a1); u.y = pack2(a2, a3); u.z = pack2(a4, a5); u.w = pack2(a6, a7);
  return __builtin_bit_cast(bf16x8, u);
}
DI bf16x8 ldfrag(const bf16_t* p) { return *(const bf16x8*)p; }
DI bf16x8 ldfrag2(const bf16_t* p0, const bf16_t* p1) {
  s16x4 lo = *(const s16x4*)p0, hi = *(const s16x4*)p1;
  return __builtin_shufflevector(lo, hi, 0, 1, 2, 3, 4, 5, 6, 7);
}
DI int crow(int i, int hh) { return (i & 3) + 8 * (i >> 2) + 4 * hh; }
DI float siluf(float x) { return x / (1.f + __expf(-x)); }
DI float sigmf(float x) { return 1.f / (1.f + __expf(-x)); }
DI float logsigf(float x) { return fminf(x, 0.f) - log1pf(expf(-fabsf(x))); }
DI float geluf(float x) {
  const float u2 = 1.5957691216057308f * (x + 0.044715f * x * x * x);
  return x / (1.f + __expf(-u2));
}
DI float wsum(float v) {
#pragma unroll
  for (int o = 32; o > 0; o >>= 1) v += __shfl_xor(v, o);
  return v;
}
DI int tid() { int t = threadIdx.x; asm volatile("" : "+v"(t)); return t; }
DI f32x16 fzero() { f32x16 z; for (int i = 0; i < 16; ++i) z[i] = 0.f; return z; }

DI int tmap(int kind, int n) {
  if (kind == 0) return n;
  if (kind == 1) return n < 2048 ? n : (n < 2064 ? -1 : n - 16);
  int r = (n >> 6) * 128 + ((n >> 5) & 1) * 64 + (n & 31);
  return kind == 2 ? r : r + 32;
}
DI void tconv(const float* __restrict__ src, int ldn, int ncols, int K, int nmat, size_t sstride,
              bf16_t* __restrict__ dst, size_t dstride, int kind, char* smem) {
  float* sm = (float*)smem;
  const int t = tid();
  const int ntn = (ncols + 63) >> 6, ntk = K >> 6, per = ntn * ntk;
  for (int tile = blockIdx.x; tile < per * nmat; tile += gridDim.x) {
    const int mat = tile / per, tt = tile % per;
    const int k0 = (tt / ntn) * 64, n0 = (tt % ntn) * 64;
    const float* s = src + (size_t)mat * sstride;
    bf16_t* d = dst + (size_t)mat * dstride;
    const int c4 = t & 15, rr = t >> 4;
#pragma unroll
    for (int i = 0; i < 4; ++i) {
      const int kr = rr + 16 * i, n = n0 + c4 * 4;
      float4 v = make_float4(0.f, 0.f, 0.f, 0.f);
      if (n < ncols) v = *(const float4*)(s + (size_t)(k0 + kr) * ldn + n);
      sm[kr * 65 + c4 * 4 + 0] = v.x; sm[kr * 65 + c4 * 4 + 1] = v.y; sm[kr * 65 + c4 * 4 + 2] = v.z; sm[kr * 65 + c4 * 4 + 3] = v.w;
    }
    __syncthreads();
    const int nl = t >> 2, kq = t & 3, n = n0 + nl;
    if (n < ncols) {
      const int row = tmap(kind, n);
      if (row >= 0) {
        uint4 o0, o1;
        const float* q = sm + (kq * 16) * 65 + nl;
        o0.x = pack2(q[0 * 65], q[1 * 65]); o0.y = pack2(q[2 * 65], q[3 * 65]); o0.z = pack2(q[4 * 65], q[5 * 65]); o0.w = pack2(q[6 * 65], q[7 * 65]);
        o1.x = pack2(q[8 * 65], q[9 * 65]); o1.y = pack2(q[10 * 65], q[11 * 65]); o1.z = pack2(q[12 * 65], q[13 * 65]); o1.w = pack2(q[14 * 65], q[15 * 65]);
        uint4* dp = (uint4*)(d + (size_t)row * K + k0 + kq * 16);
        dp[0] = o0; dp[1] = o1;
      }
    }
    __syncthreads();
  }
}
DI void tconv_moe(const Params& p, int layer, char* smem) {
  const size_t wo = (size_t)layer * 16 * 1024 * 1024;
  tconv(p.moe_w_gate + wo, 1024, 1024, 1024, 16, (size_t)1024 * 1024, (bf16_t*)(p.ws + O_MGU), (size_t)2048 * 1024, 2, smem);
  tconv(p.moe_w_up + wo, 1024, 1024, 1024, 16, (size_t)1024 * 1024, (bf16_t*)(p.ws + O_MGU), (size_t)2048 * 1024, 3, smem);
  tconv(p.moe_w_down + wo, 1024, 1024, 1024, 16, (size_t)1024 * 1024, (bf16_t*)(p.ws + O_MD), (size_t)1024 * 1024, 0, smem);
}

DI void phase_adaln(const Params& p, char* smem) {
  float* sv = (float*)smem;
  float* red = sv + 3 * 1024;
  float* modv = (float*)(p.ws + O_MODV);
  const int t = tid();
  if (blockIdx.x >= 192) return;
  for (int i = t; i < 3 * 1024; i += 256) {
    const int v = i >> 10, k = i & 1023;
    const float cv = v < 2 ? p.c[v * 1024 + k] : p.c_ctx[k];
    sv[i] = siluf(cv);
  }
  __syncthreads();
  for (int item = blockIdx.x; item < 192; item += gridDim.x) {
    const int l = item / 96, cb = item % 96;
    const int cq = t & 15, kg = t >> 4;
    const float* w = p.w_mod + (size_t)l * 1024 * 6144 + cb * 64 + cq * 4;
    float a0[4] = {0.f, 0.f, 0.f, 0.f}, a1[4] = {0.f, 0.f, 0.f, 0.f}, a2[4] = {0.f, 0.f, 0.f, 0.f};
    for (int i = 0; i < 64; ++i) {
      const int k = kg + 16 * i;
      const float4 wv = *(const float4*)(w + (size_t)k * 6144);
      const float s0 = sv[k], s1 = sv[1024 + k], s2 = sv[2048 + k];
      a0[0] += s0 * wv.x; a0[1] += s0 * wv.y; a0[2] += s0 * wv.z; a0[3] += s0 * wv.w;
      a1[0] += s1 * wv.x; a1[1] += s1 * wv.y; a1[2] += s1 * wv.z; a1[3] += s1 * wv.w;
      a2[0] += s2 * wv.x; a2[1] += s2 * wv.y; a2[2] += s2 * wv.z; a2[3] += s2 * wv.w;
    }
#pragma unroll
    for (int j = 0; j < 4; ++j) {
      red[(kg * 3 + 0) * 64 + cq * 4 + j] = a0[j];
      red[(kg * 3 + 1) * 64 + cq * 4 + j] = a1[j];
      red[(kg * 3 + 2) * 64 + cq * 4 + j] = a2[j];
    }
    __syncthreads();
    if (t < 192) {
      const int v = t >> 6, col = t & 63;
      float s = 0.f;
      for (int g = 0; g < 16; ++g) s += red[(g * 3 + v) * 64 + col];
      const int cc = cb * 64 + col;
      modv[(l * 3 + v) * 6144 + cc] = s + p.b_mod[l * 6144 + cc];
    }
    __syncthreads();
  }
}

DI void moe_combine_row(const Params& p, int row, int lane, float4 (&acc)[4]) {
  const int* INV = (const int*)(p.ws + O_INV); const float* GATE = (const float*)(p.ws + O_GATE);
  const bf16_t* YE = (const bf16_t*)(p.ws + O_YE);
  const int b = row >> 13;
  const int myslot = INV[(size_t)row * 16 + (lane & 15)];
#pragma unroll
  for (int i = 0; i < 4; ++i) acc[i] = make_float4(0.f, 0.f, 0.f, 0.f);
#pragma unroll 1
  for (int e = 0; e < 16; ++e) {
    const int slot = __builtin_amdgcn_readlane(myslot, e);
    if (slot != 0) {
      const int be = b * 16 + e;
      const float g = GATE[be * 1024 + slot - 1];
      const bf16_t* yr = YE + ((size_t)be * 1024 + slot - 1) * 1024;
#pragma unroll
      for (int i = 0; i < 4; ++i) {
        const s16x4 v = *(const s16x4*)(yr + (i * 64 + lane) * 4);
        acc[i].x += g * bf2f((bf16_t)v[0]); acc[i].y += g * bf2f((bf16_t)v[1]); acc[i].z += g * bf2f((bf16_t)v[2]); acc[i].w += g * bf2f((bf16_t)v[3]);
      }
    }
  }
}

template <int MODE, bool COMB>
DI void phase_modulate(const Params& p, int layer, int which, char* smem) {
  float* wt = (float*)smem;
  const int t = tid(), lane = t & 63, w = t >> 6;
  const float* modv = (const float*)(p.ws + O_MODV);
  bf16_t* HA = (bf16_t*)(p.ws + O_HA);
  if (MODE != 0) {
    const float* W = MODE == 1 ? p.ab_w_in + 2048 : p.moe_w_router + (size_t)layer * 1024 * 16;
    const int ld = MODE == 1 ? 2832 : 16;
    for (int i = t; i < 4096; i += 256) {
      const int k = i >> 2, e4 = i & 3;
      const float4 v = *(const float4*)(W + (size_t)k * ld + e4 * 4);
      wt[(e4 * 4 + 0) * 1024 + k] = v.x; wt[(e4 * 4 + 1) * 1024 + k] = v.y; wt[(e4 * 4 + 2) * 1024 + k] = v.z; wt[(e4 * 4 + 3) * 1024 + k] = v.w;
    }
    __syncthreads();
  }
  const float* gn = (which == 0 ? p.norm_mix_g : p.norm_ffn_g) + layer * 1024;
  const int nrows = MODE == 1 ? NROW : NTOK;
  for (int row = blockIdx.x * 4 + w; row < nrows; row += gridDim.x * 4) {
    const float* src; int v;
    if (MODE == 1) {
      if (row < NTOK) { src = p.x + (size_t)row * 1024; v = row >> 13; }
      else { src = p.ctx + (size_t)(row - NTOK) * 1024; v = 2; }
    } else { src = p.out + (size_t)row * 1024; v = row >> 13; }
    const float* sh = modv + (layer * 3 + v) * 6144 + (which ? 3 : 0) * 1024;
    const float* sc = sh + 1024;
    float4 xv[4];
    float ss = 0.f;
#pragma unroll
    for (int i = 0; i < 4; ++i) xv[i] = *(const float4*)(src + (i * 64 + lane) * 4);
    if (COMB) {
      float4 ca[4];
      moe_combine_row(p, row, lane, ca);
      const float* g2 = modv + ((layer - 1) * 3 + v) * 6144 + 5 * 1024;
#pragma unroll
      for (int i = 0; i < 4; ++i) {
        const float4 gg = *(const float4*)(g2 + (i * 64 + lane) * 4);
        xv[i].x += gg.x * ca[i].x; xv[i].y += gg.y * ca[i].y; xv[i].z += gg.z * ca[i].z; xv[i].w += gg.w * ca[i].w;
        *(float4*)(p.out + (size_t)row * 1024 + (i * 64 + lane) * 4) = xv[i];
      }
    }
#pragma unroll
    for (int i = 0; i < 4; ++i) ss += xv[i].x * xv[i].x + xv[i].y * xv[i].y + xv[i].z * xv[i].z + xv[i].w * xv[i].w;
    ss = wsum(ss);
    const float rstd = rsqrtf(ss * (1.f / 1024.f) + EPS);
    float4 yv[4];
#pragma unroll
    for (int i = 0; i < 4; ++i) {
      const int col = (i * 64 + lane) * 4;
      const float4 g4 = *(const float4*)(gn + col), s4 = *(const float4*)(sh + col), c4 = *(const float4*)(sc + col);
      float4 y;
      y.x = xv[i].x * rstd * g4.x * (1.f + c4.x) + s4.x;
      y.y = xv[i].y * rstd * g4.y * (1.f + c4.y) + s4.y;
      y.z = xv[i].z * rstd * g4.z * (1.f + c4.z) + s4.z;
      y.w = xv[i].w * rstd * g4.w * (1.f + c4.w) + s4.w;
      yv[i] = y;
      uint2 o; o.x = pack2(y.x, y.y); o.y = pack2(y.z, y.w);
      *(uint2*)(HA + (size_t)row * 1024 + col) = o;
    }
    if (MODE != 0) {
      float mine = 0.f;
#pragma unroll 1
      for (int e = 0; e < 16; ++e) {
        float pe = 0.f;
#pragma unroll
        for (int i = 0; i < 4; ++i) {
          const float4 w4 = *(const float4*)(wt + e * 1024 + (i * 64 + lane) * 4);
          pe += yv[i].x * w4.x + yv[i].y * w4.y + yv[i].z * w4.z + yv[i].w * w4.w;
        }
        pe = wsum(pe);
        if ((lane & 15) == e) mine = pe;
      }
      const int e = lane & 15;
      if (MODE == 1) {
        float val = mine + p.ab_gate_b[e];
        if (((e >> 2) & 1) == 1) val = logsigf(val);
        if (lane < 16) ((float*)(p.ws + O_GL))[(size_t)row * 16 + lane] = val;
      } else {
        float mx = mine;
#pragma unroll
        for (int o = 8; o > 0; o >>= 1) mx = fmaxf(mx, __shfl_xor(mx, o));
        const float ex = expf(mine - mx);
        float sum = ex;
#pragma unroll
        for (int o = 8; o > 0; o >>= 1) sum += __shfl_xor(sum, o);
        if (lane < 16) ((float*)(p.ws + O_AFF))[((size_t)(row >> 13) * 16 + lane) * 8192 + (row & 8191)] = ex / sum;
        if (lane < 16) ((int*)(p.ws + O_INV))[(size_t)row * 16 + lane] = 0;
      }
    }
  }
}

template <class Epi>
DI void gemm_tile(const bf16_t* (&ap)[4], const bf16_t* (&bp)[4], int K, char* smem, Epi&& epi) {
  bf16_t* sA = (bf16_t*)smem;
  bf16_t* sB = sA + 2 * 128 * 72;
  const int t = tid(), lane = t & 63, w = t >> 6, wm = w >> 1, wn = w & 1, r = lane & 31, hh = lane >> 5;
  const int lrow = t >> 3, lcol = (t & 7) * 8;
  const bf16_t* a0p = ap[0]; const bf16_t* a1p = ap[1]; const bf16_t* a2p = ap[2]; const bf16_t* a3p = ap[3];
  const bf16_t* b0p = bp[0]; const bf16_t* b1p = bp[1]; const bf16_t* b2p = bp[2]; const bf16_t* b3p = bp[3];
  f32x16 acc00 = fzero(), acc01 = fzero(), acc10 = fzero(), acc11 = fzero();
  uint4 ra0 = *(const uint4*)a0p, ra1 = *(const uint4*)a1p, ra2 = *(const uint4*)a2p, ra3 = *(const uint4*)a3p;
  uint4 rb0 = *(const uint4*)b0p, rb1 = *(const uint4*)b1p, rb2 = *(const uint4*)b2p, rb3 = *(const uint4*)b3p;
  const int so = lrow * 72 + lcol;
  *(uint4*)(sA + so) = ra0; *(uint4*)(sA + so + 32 * 72) = ra1; *(uint4*)(sA + so + 64 * 72) = ra2; *(uint4*)(sA + so + 96 * 72) = ra3;
  *(uint4*)(sB + so) = rb0; *(uint4*)(sB + so + 32 * 72) = rb1; *(uint4*)(sB + so + 64 * 72) = rb2; *(uint4*)(sB + so + 96 * 72) = rb3;
  __syncthreads();
  const int KT = K >> 6;
  for (int kt = 0; kt < KT; ++kt) {
    const int cur = kt & 1;
    const int kn = (kt + 1 < KT ? kt + 1 : kt) * 64;
    ra0 = *(const uint4*)(a0p + kn); ra1 = *(const uint4*)(a1p + kn); ra2 = *(const uint4*)(a2p + kn); ra3 = *(const uint4*)(a3p + kn);
    rb0 = *(const uint4*)(b0p + kn); rb1 = *(const uint4*)(b1p + kn); rb2 = *(const uint4*)(b2p + kn); rb3 = *(const uint4*)(b3p + kn);
    __builtin_amdgcn_sched_barrier(0);
    const bf16_t* cA = sA + cur * 128 * 72 + (wm * 64 + r) * 72 + hh * 8;
    const bf16_t* cB = sB + cur * 128 * 72 + (wn * 64 + r) * 72 + hh * 8;
#pragma unroll
    for (int ks = 0; ks < 4; ++ks) {
      const bf16x8 a0 = *(const bf16x8*)(cA + ks * 16), a1 = *(const bf16x8*)(cA + 32 * 72 + ks * 16);
      const bf16x8 b0 = *(const bf16x8*)(cB + ks * 16), b1 = *(const bf16x8*)(cB + 32 * 72 + ks * 16);
      acc00 = MFMA(a0, b0, acc00);
      acc01 = MFMA(a0, b1, acc01);
      acc10 = MFMA(a1, b0, acc10);
      acc11 = MFMA(a1, b1, acc11);
    }
    __builtin_amdgcn_sched_barrier(0);
    {
      bf16_t* nA = sA + (cur ^ 1) * 128 * 72 + so;
      bf16_t* nB = sB + (cur ^ 1) * 128 * 72 + so;
      *(uint4*)(nA) = ra0; *(uint4*)(nA + 32 * 72) = ra1; *(uint4*)(nA + 64 * 72) = ra2; *(uint4*)(nA + 96 * 72) = ra3;
      *(uint4*)(nB) = rb0; *(uint4*)(nB + 32 * 72) = rb1; *(uint4*)(nB + 64 * 72) = rb2; *(uint4*)(nB + 96 * 72) = rb3;
    }
    __syncthreads();
  }
  f32x16 acc[2][2];
  acc[0][0] = acc00; acc[0][1] = acc01; acc[1][0] = acc10; acc[1][1] = acc11;
  epi(acc, wm * 64, wn * 64, r, hh);
}

struct TileWalk {
  int L, Lend, nl;
  DI TileWalk(int T, const char* smem) {
    const volatile unsigned* xw = (const volatile unsigned*)(smem + 73728);
    const int nloc = (int)xw[0], sb = (int)xw[2], rk = (int)xw[3], G = (int)gridDim.x;
    nl = nloc;
    L = (T * sb) / G + rk; Lend = (T * (sb + nloc)) / G;
  }
  DI bool valid() const { return L < Lend; }
  DI void next() { L += nl; }
  DI void get(int SM, int SN, int nsn, int& mt, int& nt) const {
    const int s = L / (SM * SN), wi = L % (SM * SN);
    mt = (s / nsn) * SM + wi / SN; nt = (s % nsn) * SN + wi % SN;
  }
};

template <class MakeEpi>
DI void gemm_dense(const bf16_t* A, const bf16_t* Bt, int M, int N, int K, int SM, int SN, char* smem, MakeEpi&& mk) {
  const int t = tid(), lrow = t >> 3, lcol = (t & 7) * 8;
  const int ntn = N >> 7, ntm = M >> 7;
  for (TileWalk tw(ntn * ntm, smem); tw.valid(); tw.next()) {
    int mt, nt; tw.get(SM, SN, ntn / SN, mt, nt);
    const bf16_t* ap[4]; const bf16_t* bp[4];
#pragma unroll
    for (int i = 0; i < 4; ++i) {
      ap[i] = A + (size_t)(mt * 128 + lrow + 32 * i) * K + lcol;
      bp[i] = Bt + (size_t)(nt * 128 + lrow + 32 * i) * K + lcol;
    }
    gemm_tile(ap, bp, K, smem, mk(mt * 128, nt * 128));
  }
}

DI void phase_prep2(const Params& p, char* smem) {
  bf16_t* T = (bf16_t*)smem;
  const bf16_t* P = (const bf16_t*)(p.ws + O_P);
  bf16_t* Qc = (bf16_t*)(p.ws + O_QC); bf16_t* Kc = (bf16_t*)(p.ws + O_KC);
  bf16_t* KT = (bf16_t*)(p.ws + O_KT); bf16_t* VT = (bf16_t*)(p.ws + O_VT);
  bf16_t* RQ = (bf16_t*)(p.ws + O_RQ); bf16_t* RK = (bf16_t*)(p.ws + O_RK);
  bf16_t* AVTX = (bf16_t*)(p.ws + O_AVTX); bf16_t* AVTC = (bf16_t*)(p.ws + O_AVTC);
  const int t = tid();
  for (int item = blockIdx.x; item < 132 * 6; item += gridDim.x) {
    const int sc = item / 6, part = item % 6;
    const bool isx = sc < 128;
    const int row0 = sc * 128;
    const int seq_lo = isx ? (sc >> 6) * 8192 : NTOK + ((sc - 128) >> 1) * 256;
    const int seq_hi = seq_lo + (isx ? 8192 : 256);
    if (part < 4) {
      const int h = part;
      const int col8 = t & 15, rsub = t >> 4;
      for (int pass = 0; pass < 3; ++pass) {
        if (pass == 2 && !isx) break;
        const int pcol = (pass == 0 ? 512 : (pass == 1 ? 1024 : 0)) + h * 128 + col8 * 8;
        float cw[5][8];
        if (pass != 1) {
#pragma unroll
          for (int j = 0; j < 5; ++j)
#pragma unroll
            for (int e = 0; e < 8; ++e) cw[j][e] = p.ab_conv_w[j * 1024 + (pass == 0 ? 512 : 0) + h * 128 + col8 * 8 + e];
        }
        for (int i = 0; i < 8; ++i) {
          const int rl = rsub + 16 * i, row = row0 + rl;
          uint4 o;
          if (pass == 1) {
            o = *(const uint4*)(P + (size_t)row * PLD + pcol);
          } else {
            float a[8];
#pragma unroll
            for (int e = 0; e < 8; ++e) a[e] = 0.f;
#pragma unroll
            for (int j = 0; j < 5; ++j) {
              const int rr = row + j - 2;
              if (rr >= seq_lo && rr < seq_hi) {
                const bf16x8 v = *(const bf16x8*)(P + (size_t)rr * PLD + pcol);
#pragma unroll
                for (int e = 0; e < 8; ++e) a[e] += cw[j][e] * bf2f((bf16_t)v[e]);
              }
            }
            const float scl = pass == 0 ? 0.08838834764831845f : 1.f;
#pragma unroll
            for (int e = 0; e < 8; ++e) a[e] = siluf(a[e]) * scl;
            o.x = pack2(a[0], a[1]); o.y = pack2(a[2], a[3]); o.z = pack2(a[4], a[5]); o.w = pack2(a[6], a[7]);
            if (isx) *(uint4*)((pass == 0 ? Kc : Qc) + (size_t)row * 512 + h * 128 + col8 * 8) = o;
          }
          if (pass < 2) *(uint4*)(T + rl * 136 + col8 * 8) = o;
        }
        if (pass < 2) {
          __syncthreads();
          bf16_t* dstT = (pass == 0 ? KT : VT) + (size_t)(sc * 4 + h) * 16384;
          const int d = t & 127, shf = t >> 7;
#pragma unroll
          for (int s8 = 0; s8 < 8; ++s8) {
            const bf16_t* q = T + (shf * 64 + s8 * 8) * 136 + d;
            uint4 o;
            o.x = (unsigned)q[0] | ((unsigned)q[136] << 16); o.y = (unsigned)q[2 * 136] | ((unsigned)q[3 * 136] << 16);
            o.z = (unsigned)q[4 * 136] | ((unsigned)q[5 * 136] << 16); o.w = (unsigned)q[6 * 136] | ((unsigned)q[7 * 136] << 16);
            *(uint4*)(dstT + d * 128 + shf * 64 + s8 * 8) = o;
          }
          __syncthreads();
        }
      }
    } else if (part == 4) {
      if (!isx) continue;
      for (int idx = t; idx < 512; idx += 256) {
        const int rl = idx >> 2, dc = idx & 3, row = row0 + rl, pos = row - seq_lo;
        const float rp = (float)(pos >> 6), cp = (float)(pos & 63);
        float cs[8], sn[8];
#pragma unroll
        for (int e = 0; e < 8; ++e) {
          const int a = dc * 8 + e;
          const float inv = powf(10000.f, -(float)(a & 15) / 16.f);
          const float ang = (a < 16 ? rp : cp) * inv;
          cs[e] = cosf(ang); sn[e] = sinf(ang);
        }
        for (int hq = 0; hq < 8; ++hq) {
          const bf16x8 x1 = *(const bf16x8*)(P + (size_t)row * PLD + 2048 + hq * 64 + dc * 8);
          const bf16x8 x2 = *(const bf16x8*)(P + (size_t)row * PLD + 2048 + hq * 64 + 32 + dc * 8);
          float o1[8], o2[8];
#pragma unroll
          for (int e = 0; e < 8; ++e) {
            const float a = bf2f((bf16_t)x1[e]), b = bf2f((bf16_t)x2[e]);
            o1[e] = (a * cs[e] - b * sn[e]) * 0.125f; o2[e] = (b * cs[e] + a * sn[e]) * 0.125f;
          }
          uint4 u1, u2;
          u1.x = pack2(o1[0], o1[1]); u1.y = pack2(o1[2], o1[3]); u1.z = pack2(o1[4], o1[5]); u1.w = pack2(o1[6], o1[7]);
          u2.x = pack2(o2[0], o2[1]); u2.y = pack2(o2[2], o2[3]); u2.z = pack2(o2[4], o2[5]); u2.w = pack2(o2[6], o2[7]);
          *(uint4*)(RQ + (size_t)row * 512 + hq * 64 + dc * 8) = u1;
          *(uint4*)(RQ + (size_t)row * 512 + hq * 64 + 32 + dc * 8) = u2;
        }
      }
    } else {
      for (int idx = t; idx < 512; idx += 256) {
        const int rl = idx >> 2, dc = idx & 3, row = row0 + rl, pos = row - seq_lo;
        const float rp = (float)(pos >> 6), cp = (float)(pos & 63);
        float cs[8], sn[8];
#pragma unroll
        for (int e = 0; e < 8; ++e) {
          const int a = dc * 8 + e;
          const float inv = powf(10000.f, -(float)(a & 15) / 16.f);
          const float ang = (a < 16 ? rp : cp) * inv;
          cs[e] = isx ? cosf(ang) : 1.f; sn[e] = isx ? sinf(ang) : 0.f;
        }
        for (int g = 0; g < 2; ++g) {
          const bf16x8 x1 = *(const bf16x8*)(P + (size_t)row * PLD + 2560 + g * 64 + dc * 8);
          const bf16x8 x2 = *(const bf16x8*)(P + (size_t)row * PLD + 2560 + g * 64 + 32 + dc * 8);
          float o1[8], o2[8];
#pragma unroll
          for (int e = 0; e < 8; ++e) {
            const float a = bf2f((bf16_t)x1[e]), b = bf2f((bf16_t)x2[e]);
            o1[e] = a * cs[e] - b * sn[e]; o2[e] = b * cs[e] + a * sn[e];
          }
          uint4 u1, u2;
          u1.x = pack2(o1[0], o1[1]); u1.y = pack2(o1[2], o1[3]); u1.z = pack2(o1[4], o1[5]); u1.w = pack2(o1[6], o1[7]);
          u2.x = pack2(o2[0], o2[1]); u2.y = pack2(o2[2], o2[3]); u2.z = pack2(o2[4], o2[5]); u2.w = pack2(o2[6], o2[7]);
          *(uint4*)(RK + (size_t)row * 128 + g * 64 + dc * 8) = u1;
          *(uint4*)(RK + (size_t)row * 128 + g * 64 + 32 + dc * 8) = u2;
        }
      }
      {
        const int col8 = t & 15, rsub = t >> 4;
        for (int i = 0; i < 8; ++i) {
          const int rl = rsub + 16 * i;
          *(uint4*)(T + rl * 136 + col8 * 8) = *(const uint4*)(P + (size_t)(row0 + rl) * PLD + 2688 + col8 * 8);
        }
        __syncthreads();
        const int d = t & 127, shf = t >> 7;
        const int b = isx ? (sc >> 6) : ((sc - 128) >> 1);
        const int pos0 = row0 - seq_lo;
        bf16_t* dst = isx ? AVTX + ((size_t)(b * 2 + (d >> 6)) * 64 + (d & 63)) * 8192 + pos0
                          : AVTC + ((size_t)(b * 2 + (d >> 6)) * 64 + (d & 63)) * 256 + pos0;
#pragma unroll
        for (int s8 = 0; s8 < 8; ++s8) {
          const bf16_t* q = T + (shf * 64 + s8 * 8) * 136 + d;
          uint4 o;
          o.x = (unsigned)q[0] | ((unsigned)q[136] << 16); o.y = (unsigned)q[2 * 136] | ((unsigned)q[3 * 136] << 16);
          o.z = (unsigned)q[4 * 136] | ((unsigned)q[5 * 136] << 16); o.w = (unsigned)q[6 * 136] | ((unsigned)q[7 * 136] << 16);
          *(uint4*)(dst + shf * 64 + s8 * 8) = o;
        }
        __syncthreads();
      }
    }
  }
}

DI void attn_item(const Params& p, int item) {
  const int g = item & 1, qb = (item >> 1) & 255, b = item >> 9;
  int t_ = tid();
  asm volatile("" : "+v"(t_));
  const int t = t_, lane = t & 63, w = t >> 6, r = lane & 31, hh = lane >> 5;
  const int hq = g * 4 + w, q0 = qb * 32;
  const bf16_t* RQ = (const bf16_t*)(p.ws + O_RQ); const bf16_t* RK = (const bf16_t*)(p.ws + O_RK);
  const bf16_t* AVTX = (const bf16_t*)(p.ws + O_AVTX); const bf16_t* AVTC = (const bf16_t*)(p.ws + O_AVTC);
  bf16_t* MIX = (bf16_t*)(p.ws + O_HA);
  const size_t qrow = (size_t)b * 8192 + q0 + r;
  bf16x8 qf[4];
#pragma unroll
  for (int ks = 0; ks < 4; ++ks) qf[ks] = ldfrag(RQ + qrow * 512 + hq * 64 + ks * 16 + hh * 8);
  float m = p.ab_sink[hq], l = hh == 0 ? 1.f : 0.f;
  f32x16 o0 = fzero(), o1 = fzero();
  const int ipos = q0 + r;
  for (int tile = 0; tile < 17; ++tile) {
    const bf16_t* kbase; const bf16_t* vbase; int vld, k0; bool local;
    if (tile < 9) {
      k0 = q0 - 128 + tile * 32;
      if (k0 < 0 || k0 >= 8192) continue;
      kbase = RK + (size_t)(b * 8192 + k0) * 128 + g * 64;
      vbase = AVTX + (size_t)((b * 2 + g) * 64) * 8192 + k0; vld = 8192; local = true;
    } else {
      k0 = (tile - 9) * 32;
      kbase = RK + (size_t)(NTOK + b * 256 + k0) * 128 + g * 64;
      vbase = AVTC + (size_t)((b * 2 + g) * 64) * 256 + k0; vld = 256; local = false;
    }
    f32x16 s = fzero();
#pragma unroll
    for (int ks = 0; ks < 4; ++ks) s = MFMA(ldfrag(kbase + r * 128 + ks * 16 + hh * 8), qf[ks], s);
    float tmax = -INFINITY;
#pragma unroll
    for (int i = 0; i < 16; ++i) {
      const int dj = ipos - (k0 + crow(i, hh));
      const bool ok = !local || (dj <= 128 && dj >= -128);
      s[i] = ok ? s[i] : -INFINITY;
      tmax = fmaxf(tmax, s[i]);
    }
    tmax = fmaxf(tmax, __shfl_xor(tmax, 32));
    const float mn = fmaxf(m, tmax), corr = __expf(m - mn);
    m = mn; l *= corr;
#pragma unroll
    for (int i = 0; i < 16; ++i) { o0[i] *= corr; o1[i] *= corr; }
#pragma unroll
    for (int i = 0; i < 16; ++i) { s[i] = __expf(s[i] - mn); l += s[i]; }
#pragma unroll
    for (int s2 = 0; s2 < 2; ++s2) {
      const bf16x8 pf = pack8(s[8 * s2], s[8 * s2 + 1], s[8 * s2 + 2], s[8 * s2 + 3], s[8 * s2 + 4], s[8 * s2 + 5], s[8 * s2 + 6], s[8 * s2 + 7]);
      const bf16_t* v0 = vbase + (size_t)r * vld + 16 * s2 + 4 * hh;
      o0 = MFMA(ldfrag2(v0, v0 + 8), pf, o0);
      const bf16_t* v1 = v0 + (size_t)32 * vld;
      o1 = MFMA(ldfrag2(v1, v1 + 8), pf, o1);
    }
  }
  l += __shfl_xor(l, 32);
  const float inv = 1.f / l;
  bf16_t* dst = MIX + qrow * 1024 + 512 + hq * 64;
#pragma unroll
  for (int q4 = 0; q4 < 4; ++q4) {
    const int d = 8 * q4 + 4 * hh;
    uint2 u;
    u.x = pack2(o0[4 * q4] * inv, o0[4 * q4 + 1] * inv); u.y = pack2(o0[4 * q4 + 2] * inv, o0[4 * q4 + 3] * inv);
    *(uint2*)(dst + d) = u;
    u.x = pack2(o1[4 * q4] * inv, o1[4 * q4 + 1] * inv); u.y = pack2(o1[4 * q4 + 2] * inv, o1[4 * q4 + 3] * inv);
    *(uint2*)(dst + 32 + d) = u;
  }
}

DI void mlstm_local_item(const Params& p, int item, char* smem) {
  float* gs = (float*)smem;
  float* wv = gs + 512;
  float* msc = wv + 256;
  int t_ = tid();
  asm volatile("" : "+v"(t_));
  const int t = t_, lane = t & 63, w = t >> 6, wm = w >> 1, wn = w & 1, r = lane & 31, hh = lane >> 5;
  const int bh = item / NSTEP, nc = item % NSTEP, b = bh >> 2, h = bh & 3;
  const int sc = nc < 2 ? 128 + b * 2 + nc : b * 64 + (nc - 2);
  const int row0 = sc * 128;
  const float* GL = (const float*)(p.ws + O_GL);
  const bf16_t* KT = (const bf16_t*)(p.ws + O_KT) + (size_t)(sc * 4 + h) * 16384;
  const bf16_t* VT = (const bf16_t*)(p.ws + O_VT) + (size_t)(sc * 4 + h) * 16384;
  for (int i = t; i < 512; i += 256) { const int ty = i >> 7, s = i & 127; gs[i] = GL[(size_t)(row0 + s) * 16 + ty * 4 + h]; }
  __syncthreads();
  {
    const int dir = t >> 7, s = t & 127;
    float wval, tot = 0.f;
    if (dir == 0) {
      float bsum = 0.f;
      for (int j = 0; j < 128; ++j) { const float f = gs[128 + j]; tot += f; if (j <= s) bsum += f; }
      wval = tot - bsum + gs[s];
    } else {
      float pre = 0.f;
      for (int j = 0; j < 128; ++j) { const float f = gs[384 + j]; tot += f; if (j < s) pre += f; }
      wval = pre + gs[256 + s];
    }
    wv[dir * 128 + s] = wval;
    if (s == 0) msc[dir] = tot;
  }
  __syncthreads();
  {
    const int dir = t >> 7, s = t & 127;
    float mx = -INFINITY;
    for (int j = 0; j < 128; ++j) mx = fmaxf(mx, wv[dir * 128 + j]);
    const float wval = wv[dir * 128 + s];
    __syncthreads();
    wv[dir * 128 + s] = expf(wval - mx);
    if (s == 0) msc[2 + dir] = mx;
  }
  __syncthreads();
  float* DC = (float*)(p.ws + O_DC);
#pragma unroll 1
  for (int d = 0; d < 2; ++d) {
    f32x16 acc[2][2];
#pragma unroll
    for (int i = 0; i < 2; ++i)
#pragma unroll
      for (int j = 0; j < 2; ++j) acc[i][j] = fzero();
#pragma unroll 2
    for (int ks = 0; ks < 8; ++ks) {
      const bf16x8 ra0 = ldfrag(VT + (wm * 64 + r) * 128 + ks * 16 + hh * 8);
      const bf16x8 ra1 = ldfrag(VT + (wm * 64 + 32 + r) * 128 + ks * 16 + hh * 8);
      const bf16x8 b0 = ldfrag(KT + (wn * 64 + r) * 128 + ks * 16 + hh * 8);
      const bf16x8 b1 = ldfrag(KT + (wn * 64 + 32 + r) * 128 + ks * 16 + hh * 8);
      const float* ww = wv + d * 128 + ks * 16 + hh * 8;
      const bf16x8 a0 = pack8(bf2f((bf16_t)ra0[0]) * ww[0], bf2f((bf16_t)ra0[1]) * ww[1], bf2f((bf16_t)ra0[2]) * ww[2], bf2f((bf16_t)ra0[3]) * ww[3],
                              bf2f((bf16_t)ra0[4]) * ww[4], bf2f((bf16_t)ra0[5]) * ww[5], bf2f((bf16_t)ra0[6]) * ww[6], bf2f((bf16_t)ra0[7]) * ww[7]);
      const bf16x8 a1 = pack8(bf2f((bf16_t)ra1[0]) * ww[0], bf2f((bf16_t)ra1[1]) * ww[1], bf2f((bf16_t)ra1[2]) * ww[2], bf2f((bf16_t)ra1[3]) * ww[3],
                              bf2f((bf16_t)ra1[4]) * ww[4], bf2f((bf16_t)ra1[5]) * ww[5], bf2f((bf16_t)ra1[6]) * ww[6], bf2f((bf16_t)ra1[7]) * ww[7]);
      acc[0][0] = MFMA(a0, b0, acc[0][0]);
      acc[0][1] = MFMA(a0, b1, acc[0][1]);
      acc[1][0] = MFMA(a1, b0, acc[1][0]);
      acc[1][1] = MFMA(a1, b1, acc[1][1]);
    }
    float* dst = DC + ((size_t)(bh * 2 + d) * NSTEP + nc) * 16384;
#pragma unroll
    for (int mi = 0; mi < 2; ++mi)
#pragma unroll
      for (int ni = 0; ni < 2; ++ni)
#pragma unroll
        for (int i = 0; i < 16; ++i)
          dst[(wm * 64 + mi * 32 + crow(i, hh)) * 128 + wn * 64 + ni * 32 + r] = acc[mi][ni][i];
  }
  {
    const int dir = t >> 7, k = t & 127;
    float s = 0.f;
    for (int s8 = 0; s8 < 16; ++s8) {
      const bf16x8 v = ldfrag(KT + k * 128 + s8 * 8);
#pragma unroll
      for (int e = 0; e < 8; ++e) s += wv[dir * 128 + s8 * 8 + e] * bf2f((bf16_t)v[e]);
    }
    ((float*)(p.ws + O_DN))[((size_t)(bh * 2 + dir) * NSTEP + nc) * 128 + k] = s;
    if (k == 0) {
      ((float*)(p.ws + O_GSC))[(bh * 2 + dir) * NSTEP + nc] = msc[dir];
      ((float*)(p.ws + O_MLOC))[(bh * 2 + dir) * NSTEP + nc] = msc[2 + dir];
    }
  }
  __syncthreads();
}

DI int chain_nc(int dir, int i) { return dir == 0 ? i : (i < 2 ? 1 - i : 67 - i); }
DI void phase_scan(const Params& p) {
  const float* GSC = (const float*)(p.ws + O_GSC); const float* MLOC = (const float*)(p.ws + O_MLOC);
  const float* DC = (const float*)(p.ws + O_DC); const float* DN = (const float*)(p.ws + O_DN);
  bf16_t* CST = (bf16_t*)(p.ws + O_CST); float* NST = (float*)(p.ws + O_NST); float* MST = (float*)(p.ws + O_MST);
  const int t = tid();
  for (int item = blockIdx.x; item < 16 * 64 + 8; item += gridDim.x) {
    if (item < 1024) {
      const int chain = item >> 6, e = (item & 63) * 256 + t, dir = chain & 1;
      const int ev = e >> 7, ek = e & 127;
      const int epos = ((((ev >> 5) * 8 + (ek >> 4)) * 64) + ((ek >> 3) & 1) * 32 + (ev & 31)) * 8 + (ek & 7);
      float m = 0.f, C = 0.f;
      for (int i = 0; i < NSTEP; ++i) {
        const int nc = chain_nc(dir, i);
        if (i >= 2) {
          CST[((size_t)chain * 64 + (nc - 2)) * 16384 + epos] = f2bf(C);
          if (e == 0) MST[chain * 64 + nc - 2] = m;
        }
        const float g = GSC[chain * NSTEP + nc], ml = MLOC[chain * NSTEP + nc];
        const float mn = fmaxf(g + m, ml);
        C = expf(g + m - mn) * C + expf(ml - mn) * DC[((size_t)chain * NSTEP + nc) * 16384 + e];
        m = mn;
      }
    } else {
      const int idx = (item - 1024) * 256 + t;
      const int chain = idx >> 7, k = idx & 127, dir = chain & 1;
      float m = 0.f, n = 0.f;
      for (int i = 0; i < NSTEP; ++i) {
        const int nc = chain_nc(dir, i);
        if (i >= 2) NST[((size_t)chain * 64 + (nc - 2)) * 128 + k] = n;
        const float g = GSC[chain * NSTEP + nc], ml = MLOC[chain * NSTEP + nc];
        const float mn = fmaxf(g + m, ml);
        n = expf(g + m - mn) * n + expf(ml - mn) * DN[((size_t)chain * NSTEP + nc) * 128 + k];
        m = mn;
      }
    }
  }
}

DI void mlstm_out_item(const Params& p, int item, char* smem) {
  float* gs = (float*)smem;
  float* bb = gs + 512;
  float* lib = bb + 256;
  float* mrow = lib + 256;
  float* aT = mrow + 256;
  float* nq = aT + 256;
  float* nst = nq + 256;
  char* sK = smem + 8192;
  char* sV = sK + 32768;
  int t_ = tid();
  asm volatile("" : "+v"(t_));
  const int t = t_, lane = t & 63, w = t >> 6, r = lane & 31, hh = lane >> 5;
  const int bh = item >> 6, c = item & 63, b = bh >> 2, h = bh & 3;
  const int sc = b * 64 + c, row0 = sc * 128;
  const float* GL = (const float*)(p.ws + O_GL);
  const bf16_t* Qc = (const bf16_t*)(p.ws + O_QC); const bf16_t* Kc = (const bf16_t*)(p.ws + O_KC);
  const bf16_t* VT = (const bf16_t*)(p.ws + O_VT) + (size_t)(sc * 4 + h) * 16384;
  const bf16_t* P = (const bf16_t*)(p.ws + O_P);
  const float* MST = (const float*)(p.ws + O_MST);
  bf16_t* MIX = (bf16_t*)(p.ws + O_HA);
#pragma unroll
  for (int i = 0; i < 8; ++i) {
    const int q = t + 256 * i, row = q >> 4, cc = q & 15;
    const int so = row * 256 + ((cc ^ (row & 15)) << 4);
    *(uint4*)(sK + so) = *(const uint4*)(Kc + (size_t)(row0 + row) * 512 + h * 128 + cc * 8);
    *(uint4*)(sV + so) = *(const uint4*)(VT + row * 128 + cc * 8);
  }
  for (int i = t; i < 512; i += 256) { const int ty = i >> 7, s = i & 127; gs[i] = GL[(size_t)(row0 + s) * 16 + ty * 4 + h]; }
  {
    const int dir = t >> 7, k = t & 127;
    nst[t] = ((const float*)(p.ws + O_NST))[((size_t)(bh * 2 + dir) * 64 + c) * 128 + k];
  }
  __syncthreads();
  {
    const int dir = t >> 7, s = t & 127;
    float bsum = 0.f;
    if (dir == 0) { for (int j = 0; j <= s; ++j) bsum += gs[128 + j]; }
    else { for (int j = s; j < 128; ++j) bsum += gs[384 + j]; }
    bb[t] = bsum;
    lib[t] = gs[dir * 256 + s] - bsum;
    const bf16_t* qr = Qc + (size_t)(row0 + s) * 512 + h * 128;
    float acc = 0.f;
    for (int k8 = 0; k8 < 16; ++k8) {
      const bf16x8 v = ldfrag(qr + k8 * 8);
#pragma unroll
      for (int e = 0; e < 8; ++e) acc += nst[dir * 128 + k8 * 8 + e] * bf2f((bf16_t)v[e]);
    }
    nq[t] = acc;
  }
  __syncthreads();
  {
    const int dir = t >> 7, s = t & 127;
    float pm = -INFINITY;
    if (dir == 0) { for (int j = 0; j <= s; ++j) pm = fmaxf(pm, lib[j]); }
    else { for (int j = s; j < 128; ++j) pm = fmaxf(pm, lib[128 + j]); }
    const float m_in = MST[(bh * 2 + dir) * 64 + c];
    const float mr = bb[t] + fmaxf(m_in, pm);
    mrow[t] = mr;
    aT[t] = expf(bb[t] + m_in - mr);
  }
  __syncthreads();
  const int tl = w * 32 + r;
  const bf16_t* qrow = Qc + (size_t)(row0 + tl) * 512 + h * 128 + hh * 8;
  bf16x8 qf[8];
#pragma unroll
  for (int ks = 0; ks < 8; ++ks) qf[ks] = ldfrag(qrow + ks * 16);
  const int swz = r & 15;
  const char* kp[8]; const char* vp[16];
#pragma unroll
  for (int ks = 0; ks < 8; ++ks) kp[ks] = sK + r * 256 + (((ks * 2 + hh) ^ swz) << 4);
#pragma unroll
  for (int cc = 0; cc < 16; ++cc) vp[cc] = sV + r * 256 + 8 * hh + ((cc ^ swz) << 4);
  float* Hb = (float*)(p.ws + O_DC) + (size_t)item * 16384 + tl;
  float* Hbh = Hb + 4 * hh * 128;
  f32x16 outa[4];
#define MLSTM_DIR(DIR)                                                                                                   \
  {                                                                                                                      \
    const bf16_t* CSTl = (const bf16_t*)(p.ws + O_CST) + ((size_t)(bh * 2 + DIR) * 64 + c) * 16384 + lane * 8;           \
    const float bbt = bb[DIR * 128 + tl], mrt = mrow[DIR * 128 + tl], at = aT[DIR * 128 + tl];                            \
    float dsum = 0.f;                                                                                                    \
    const float* libp = lib + DIR * 128 + 4 * hh;                                                                        \
    const int tb = tl - 4 * hh;                                                                                          \
    bf16x8 pf[8];                                                                                                        \
    _Pragma("unroll") for (int half = 0; half < 2; ++half) {                                                             \
      f32x16 st[2];                                                                                                      \
      st[0] = fzero(); st[1] = fzero();                                                                                  \
      _Pragma("unroll") for (int ks = 0; ks < 8; ++ks) {                                                                 \
        _Pragma("unroll") for (int r2 = 0; r2 < 2; ++r2)                                                                 \
          st[r2] = MFMA(*(const bf16x8*)(kp[ks] + (half * 2 + r2) * 8192), qf[ks], st[r2]);                              \
      }                                                                                                                  \
      _Pragma("unroll") for (int r2 = 0; r2 < 2; ++r2) {                                                                 \
        const int rb = half * 2 + r2;                                                                                    \
        _Pragma("unroll") for (int i = 0; i < 16; ++i) {                                                                 \
          const int sc_ = rb * 32 + (i & 3) + 8 * (i >> 2);                                           \
          const int diff = DIR == 0 ? (tb - sc_) : (sc_ - tb);                                                           \
          const float msk = (float)((unsigned)(~diff) >> 31);                                                            \
          const float v = st[r2][i] * __expf(fminf(bbt + libp[sc_] - mrt, 0.f)) * msk;                                    \
          st[r2][i] = v; dsum += v;                                                                                      \
        }                                                                                                                \
        pf[rb * 2] = pack8(st[r2][0], st[r2][1], st[r2][2], st[r2][3], st[r2][4], st[r2][5], st[r2][6], st[r2][7]);      \
        pf[rb * 2 + 1] = pack8(st[r2][8], st[r2][9], st[r2][10], st[r2][11], st[r2][12], st[r2][13], st[r2][14], st[r2][15]); \
      }                                                                                                                  \
      __builtin_amdgcn_sched_barrier(0);                                                                                 \
    }                                                                                                                    \
    dsum += __shfl_xor(dsum, 32);                                                                                        \
    const float den = dsum + at * nq[DIR * 128 + tl];                                                                    \
    const float dinv = 1.f / fmaxf(fabsf(den), expf(-mrt));                                                              \
    _Pragma("unroll") for (int half = 0; half < 2; ++half) {                                                             \
      f32x16 ha[2];                                                                                                      \
      ha[0] = fzero(); ha[1] = fzero();                                                                                  \
      _Pragma("unroll") for (int ks = 0; ks < 8; ++ks) {                                                                 \
        _Pragma("unroll") for (int r2 = 0; r2 < 2; ++r2)                                                                 \
          ha[r2] = MFMA(ldfrag(CSTl + ((half * 2 + r2) * 8 + ks) * 512), qf[ks], ha[r2]);                                \
        if (ks == 3) __builtin_amdgcn_sched_barrier(0);                                                                  \
      }                                                                                                                  \
      _Pragma("unroll") for (int r2 = 0; r2 < 2; ++r2)                                                                   \
        _Pragma("unroll") for (int i = 0; i < 16; ++i) ha[r2][i] *= at;                                                  \
      __builtin_amdgcn_sched_barrier(0);                                                                                 \
      _Pragma("unroll") for (int kk = 0; kk < 8; ++kk) {                                                                 \
        _Pragma("unroll") for (int r2 = 0; r2 < 2; ++r2) {                                                               \
          const s16x4 lo = *(const s16x4*)(vp[2 * kk] + (half * 2 + r2) * 8192);                                         \
          const s16x4 hi = *(const s16x4*)(vp[2 * kk + 1] + (half * 2 + r2) * 8192);                                     \
          ha[r2] = MFMA(__builtin_shufflevector(lo, hi, 0, 1, 2, 3, 4, 5, 6, 7), pf[kk], ha[r2]);                        \
        }                                                                                                                \
      }                                                                                                                  \
      _Pragma("unroll") for (int r2 = 0; r2 < 2; ++r2)                                                                   \
        _Pragma("unroll") for (int i = 0; i < 16; ++i) {                                                                 \
          float* hp = Hbh + ((half * 2 + r2) * 32 + (i & 3) + 8 * (i >> 2)) * 128;                                       \
          if (DIR == 0) *hp = ha[r2][i] * dinv;                                                                          \
          else outa[half * 2 + r2][i] = *hp + ha[r2][i] * dinv;                                                          \
        }                                                                                                                \
      __builtin_amdgcn_sched_barrier(0);                                                                                 \
    }                                                                                                                    \
  }
  MLSTM_DIR(0)
  MLSTM_DIR(1)
#undef MLSTM_DIR
  float ss = 0.f;
#pragma unroll
  for (int rb = 0; rb < 4; ++rb)
#pragma unroll
    for (int i = 0; i < 16; ++i) ss += outa[rb][i] * outa[rb][i];
  ss += __shfl_xor(ss, 32);
  const float rn = rsqrtf(ss * (1.f / 128.f) + EPS);
  const size_t row = (size_t)row0 + tl;
#pragma unroll
  for (int rb = 0; rb < 4; ++rb)
#pragma unroll
    for (int q4 = 0; q4 < 4; ++q4) {
      const int v = rb * 32 + 8 * q4 + 4 * hh;
      const s16x4 ov = *(const s16x4*)(P + row * PLD + 1536 + h * 128 + v);
      const float4 hg = *(const float4*)(p.ab_head_g + h * 128 + v);
      const float y0 = outa[rb][4 * q4] * rn * hg.x * sigmf(bf2f((bf16_t)ov[0]));
      const float y1 = outa[rb][4 * q4 + 1] * rn * hg.y * sigmf(bf2f((bf16_t)ov[1]));
      const float y2 = outa[rb][4 * q4 + 2] * rn * hg.z * sigmf(bf2f((bf16_t)ov[2]));
      const float y3 = outa[rb][4 * q4 + 3] * rn * hg.w * sigmf(bf2f((bf16_t)ov[3]));
      uint2 u; u.x = pack2(y0, y1); u.y = pack2(y2, y3);
      *(uint2*)(MIX + row * 1024 + h * 128 + v) = u;
    }
  __syncthreads();
}

DI void phase_topk(const Params& p, char* smem) {
  unsigned* vals = (unsigned*)smem;
  unsigned* hist = vals + 8448;
  unsigned* cntg = hist + 256;
  unsigned* cnte = cntg + 256;
  unsigned* misc = cnte + 256;
  const float* AFF = (const float*)(p.ws + O_AFF);
  int* IDX = (int*)(p.ws + O_IDX); float* GATE = (float*)(p.ws + O_GATE); int* INV = (int*)(p.ws + O_INV);
  const int t = tid();
  for (int item = blockIdx.x; item < 32; item += gridDim.x) {
    const float* a = AFF + (size_t)item * 8192;
    for (int i = t; i < 8192; i += 256) vals[i + (i >> 5)] = __float_as_uint(a[i]);
    unsigned prefix = 0, remaining = 1024;
    for (int pass = 0; pass < 4; ++pass) {
      const int shift = 24 - 8 * pass;
      hist[t] = 0;
      __syncthreads();
      const unsigned mask = pass == 0 ? 0u : (0xFFFFFFFFu << (shift + 8));
      for (int i = t; i < 8192; i += 256) {
        const unsigned u = vals[i + (i >> 5)];
        if ((u & mask) == (prefix & mask)) atomicAdd(&hist[(u >> shift) & 255], 1u);
      }
      __syncthreads();
      {
        unsigned above = 0;
        for (int bin = t + 1; bin < 256; ++bin) above += hist[bin];
        const unsigned mineh = hist[t];
        if (above < remaining && above + mineh >= remaining) {
          misc[0] = prefix | ((unsigned)t << shift);
          misc[1] = remaining - above;
        }
      }
      __syncthreads();
      prefix = misc[0]; remaining = misc[1];
      __syncthreads();
    }
    const unsigned T = prefix, need_eq = remaining;
    unsigned cg_ = 0, ce = 0;
    for (int j = 0; j < 32; ++j) {
      const int n = t * 32 + j;
      const unsigned u = vals[n + (n >> 5)];
      cg_ += u > T; ce += u == T;
    }
    cntg[t] = cg_; cnte[t] = ce;
    __syncthreads();
    unsigned pg = 0, pe = 0;
    for (int j = 0; j < t; ++j) { pg += cntg[j]; pe += cnte[j]; }
    for (int j = 0; j < 32; ++j) {
      const int n = t * 32 + j;
      const unsigned u = vals[n + (n >> 5)];
      if (u > T) { IDX[item * 1024 + pg] = n; GATE[item * 1024 + pg] = __uint_as_float(u); INV[((size_t)(item >> 4) * 8192 + n) * 16 + (item & 15)] = (int)pg + 1; ++pg; }
      else if (u == T) {
        if (pe < need_eq) { const unsigned slot = 1024 - need_eq + pe; IDX[item * 1024 + slot] = n; GATE[item * 1024 + slot] = __uint_as_float(u); INV[((size_t)(item >> 4) * 8192 + n) * 16 + (item & 15)] = (int)slot + 1; }
        ++pe;
      }
    }
    __syncthreads();
  }
}

DI void phase_stats(const Params& p, char* smem) {
  float* red = (float*)smem;
  const bf16_t* GVT = (const bf16_t*)(p.ws + O_GVT);
  float* STATS = (float*)(p.ws + O_STATS);
  const int t = tid(), qq = t & 31, cg_ = t >> 5;
  for (int chunk = blockIdx.x; chunk < 128; chunk += gridDim.x) {
    const bf16_t* base = GVT + (size_t)chunk * 2048 * 128 + qq * 4;
    float s[4] = {0.f, 0.f, 0.f, 0.f}, s2[4] = {0.f, 0.f, 0.f, 0.f};
    for (int c = cg_; c < 2048; c += 8) {
      const s16x4 v = *(const s16x4*)(base + (size_t)c * 128);
#pragma unroll
      for (int e = 0; e < 4; ++e) { const float f = bf2f((bf16_t)v[e]); s[e] += f; s2[e] += f * f; }
    }
#pragma unroll
    for (int e = 0; e < 4; ++e) { red[(cg_ * 128 + qq * 4 + e) * 2] = s[e]; red[(cg_ * 128 + qq * 4 + e) * 2 + 1] = s2[e]; }
    __syncthreads();
    if (t < 128) {
      float a = 0.f, b2 = 0.f;
      for (int g = 0; g < 8; ++g) { a += red[(g * 128 + t) * 2]; b2 += red[(g * 128 + t) * 2 + 1]; }
      const float mu = a * (1.f / 2048.f);
      const float var = fmaxf(b2 * (1.f / 2048.f) - mu * mu, 0.f);
      STATS[(size_t)(chunk * 128 + t) * 2] = mu;
      STATS[(size_t)(chunk * 128 + t) * 2 + 1] = rsqrtf(var + EPS);
    }
    __syncthreads();
  }
}
DI void phase_spatial(const Params& p, char* smem) {
  float* smu = (float*)smem;
  float* srs = smu + 128;
  const bf16_t* GVT = (const bf16_t*)(p.ws + O_GVT); const bf16_t* U = (const bf16_t*)(p.ws + O_U);
  const float* STATS = (const float*)(p.ws + O_STATS);
  bf16_t* UV = (bf16_t*)(p.ws + O_UV);
  for (int item = blockIdx.x; item < 1024; item += gridDim.x) {
    int t_ = tid();
    asm volatile("" : "+v"(t_));
    const int t = t_, lane = t & 63, w = t >> 6, r = lane & 31, hh = lane >> 5;
    const int chunk = item >> 3, g = item & 7;
    if (t < 128) { smu[t] = STATS[(size_t)(chunk * 128 + t) * 2]; srs[t] = STATS[(size_t)(chunk * 128 + t) * 2 + 1]; }
    __syncthreads();
    const float* Ws = p.gm_w_s + (size_t)g * 16384;
    f32x16 acc[4][2];
#pragma unroll
    for (int i = 0; i < 4; ++i) { acc[i][0] = fzero(); acc[i][1] = fzero(); }
    const int cA = g * 256 + w * 64 + r, cB = cA + 32;
    const float lgA = p.gm_ln_g[cA], lbA = p.gm_ln_b[cA], lgB = p.gm_ln_g[cB], lbB = p.gm_ln_b[cB];
    const bf16_t* vA = GVT + ((size_t)chunk * 2048 + cA) * 128 + hh * 8;
    const bf16_t* vB = GVT + ((size_t)chunk * 2048 + cB) * 128 + hh * 8;
    for (int ks = 0; ks < 8; ++ks) {
      const bf16x8 ra = ldfrag(vA + ks * 16), rbv = ldfrag(vB + ks * 16);
      const float* mu = smu + ks * 16 + hh * 8; const float* rs = srs + ks * 16 + hh * 8;
      const bf16x8 bA = pack8((bf2f((bf16_t)ra[0]) - mu[0]) * rs[0] * lgA + lbA, (bf2f((bf16_t)ra[1]) - mu[1]) * rs[1] * lgA + lbA,
                              (bf2f((bf16_t)ra[2]) - mu[2]) * rs[2] * lgA + lbA, (bf2f((bf16_t)ra[3]) - mu[3]) * rs[3] * lgA + lbA,
                              (bf2f((bf16_t)ra[4]) - mu[4]) * rs[4] * lgA + lbA, (bf2f((bf16_t)ra[5]) - mu[5]) * rs[5] * lgA + lbA,
                              (bf2f((bf16_t)ra[6]) - mu[6]) * rs[6] * lgA + lbA, (bf2f((bf16_t)ra[7]) - mu[7]) * rs[7] * lgA + lbA);
      const bf16x8 bB = pack8((bf2f((bf16_t)rbv[0]) - mu[0]) * rs[0] * lgB + lbB, (bf2f((bf16_t)rbv[1]) - mu[1]) * rs[1] * lgB + lbB,
                              (bf2f((bf16_t)rbv[2]) - mu[2]) * rs[2] * lgB + lbB, (bf2f((bf16_t)rbv[3]) - mu[3]) * rs[3] * lgB + lbB,
                              (bf2f((bf16_t)rbv[4]) - mu[4]) * rs[4] * lgB + lbB, (bf2f((bf16_t)rbv[5]) - mu[5]) * rs[5] * lgB + lbB,
                              (bf2f((bf16_t)rbv[6]) - mu[6]) * rs[6] * lgB + lbB, (bf2f((bf16_t)rbv[7]) - mu[7]) * rs[7] * lgB + lbB);
#pragma unroll
      for (int rb = 0; rb < 4; ++rb) {
        const float* wp = Ws + (rb * 32 + r) * 128 + ks * 16 + hh * 8;
        const float4 w0 = *(const float4*)wp, w1 = *(const float4*)(wp + 4);
        const bf16x8 a = pack8(w0.x, w0.y, w0.z, w0.w, w1.x, w1.y, w1.z, w1.w);
        acc[rb][0] = MFMA(a, bA, acc[rb][0]);
        acc[rb][1] = MFMA(a, bB, acc[rb][1]);
      }
    }
#pragma unroll
    for (int rb = 0; rb < 4; ++rb)
#pragma unroll
      for (int i = 0; i < 16; ++i) {
        const int pp = rb * 32 + crow(i, hh);
        const float bs = p.gm_b_s[g * 128 + pp];
        const size_t row = (size_t)chunk * 128 + pp;
        UV[row * 2048 + cA] = f2bf(bf2f(U[row * 2048 + cA]) * (acc[rb][0][i] + bs));
        UV[row * 2048 + cB] = f2bf(bf2f(U[row * 2048 + cB]) * (acc[rb][1][i] + bs));
      }
    __syncthreads();
  }
}

struct EpiBf16 {
  bf16_t* dst; int ld;
  DI void operator()(f32x16 (&acc)[2][2], int mb, int nb, int r, int hh) const {
#pragma unroll
    for (int mi = 0; mi < 2; ++mi)
#pragma unroll
      for (int ni = 0; ni < 2; ++ni)
#pragma unroll
        for (int i = 0; i < 16; ++i)
          dst[(size_t)(mb + mi * 32 + crow(i, hh)) * ld + nb + ni * 32 + r] = f2bf(acc[mi][ni][i]);
  }
};
struct EpiRes {
  float* out; const float* base; const float* gate;
  DI void operator()(f32x16 (&acc)[2][2], int mb, int nb, int r, int hh) const {
#pragma unroll
    for (int ni = 0; ni < 2; ++ni) {
      const int n = nb + ni * 32 + r;
      const float gt = gate[n];
#pragma unroll
      for (int mi = 0; mi < 2; ++mi) {
        const size_t o0 = (size_t)(mb + mi * 32 + 4 * hh) * 1024 + n;
        float* op = out + o0; const float* bp = base + o0;
#pragma unroll
        for (int i = 0; i < 16; ++i) {
          const int off = ((i & 3) + 8 * (i >> 2)) * 1024;
          op[off] = bp[off] + gt * acc[mi][ni][i];
        }
        __builtin_amdgcn_sched_barrier(0);
      }
    }
  }
};
struct EpiGelu {
  bf16_t* U; bf16_t* GVT; int m0, n0;
  DI void operator()(f32x16 (&acc)[2][2], int mb, int nb, int r, int hh) const {
    if (n0 < 2048) {
#pragma unroll
      for (int mi = 0; mi < 2; ++mi)
#pragma unroll
        for (int ni = 0; ni < 2; ++ni)
#pragma unroll
          for (int i = 0; i < 16; ++i)
            U[(size_t)(m0 + mb + mi * 32 + crow(i, hh)) * 2048 + n0 + nb + ni * 32 + r] = f2bf(geluf(acc[mi][ni][i]));
    } else {
      const int chunk = m0 >> 7;
#pragma unroll
      for (int mi = 0; mi < 2; ++mi)
#pragma unroll
        for (int ni = 0; ni < 2; ++ni) {
          const int cc = n0 - 2048 + nb + ni * 32 + r;
          bf16_t* d = GVT + ((size_t)chunk * 2048 + cc) * 128 + mb + mi * 32 + 4 * hh;
#pragma unroll
          for (int q4 = 0; q4 < 4; ++q4) {
            uint2 u;
            u.x = pack2(geluf(acc[mi][ni][4 * q4]), geluf(acc[mi][ni][4 * q4 + 1]));
            u.y = pack2(geluf(acc[mi][ni][4 * q4 + 2]), geluf(acc[mi][ni][4 * q4 + 3]));
            *(uint2*)(d + 8 * q4) = u;
          }
        }
    }
  }
};
struct EpiSwiglu {
  bf16_t* hid;
  DI void operator()(f32x16 (&acc)[2][2], int mb, int nb, int r, int hh) const {
    const int f = (nb >> 1) + r;
#pragma unroll
    for (int mi = 0; mi < 2; ++mi)
#pragma unroll
      for (int i = 0; i < 16; ++i) {
        const float gv = acc[mi][0][i], uv = acc[mi][1][i];
        hid[(size_t)(mb + mi * 32 + crow(i, hh)) * 1024 + f] = f2bf(siluf(gv) * uv);
      }
  }
};
struct EpiMoeOut {
  float* out; const int* idx; const float* gate; const float* gt2;
  int n0;
  DI void operator()(f32x16 (&acc)[2][2], int mb, int nb, int r, int hh) const {
#pragma unroll
    for (int mi = 0; mi < 2; ++mi)
#pragma unroll
      for (int i = 0; i < 16; ++i) {
        const int slot = mb + mi * 32 + crow(i, hh);
        const int tok = idx[slot];
        const float gs = gate[slot];
#pragma unroll
        for (int ni = 0; ni < 2; ++ni) {
          const int n = nb + ni * 32 + r;
          unsafeAtomicAdd(out + (size_t)tok * 1024 + n0 + n, gt2[n] * gs * acc[mi][ni][i]);
        }
      }
  }
};

DI void phase_moe1(const Params& p, char* smem) {
  const bf16_t* HA = (const bf16_t*)(p.ws + O_HA); const bf16_t* WGU = (const bf16_t*)(p.ws + O_MGU);
  const int* IDX = (const int*)(p.ws + O_IDX); bf16_t* HID = (bf16_t*)(p.ws + O_HID);
  const int t = tid(), lrow = t >> 3, lcol = (t & 7) * 8;
  for (TileWalk tw(256 * 16, smem); tw.valid(); tw.next()) {
    int mg, nt; tw.get(8, 8, 2, mg, nt);
    const int e = mg >> 4, b = (mg >> 3) & 1, mt = mg & 7, be = b * 16 + e;
    const bf16_t* ap[4]; const bf16_t* bp[4];
#pragma unroll
    for (int i = 0; i < 4; ++i) {
      const int tok = IDX[be * 1024 + mt * 128 + lrow + 32 * i];
      ap[i] = HA + ((size_t)b * 8192 + tok) * 1024 + lcol;
      bp[i] = WGU + ((size_t)e * 2048 + nt * 128 + lrow + 32 * i) * 1024 + lcol;
    }
    gemm_tile(ap, bp, 1024, smem, EpiSwiglu{HID + ((size_t)be * 1024 + mt * 128) * 1024 + nt * 64});
  }
}
DI void phase_moe2(const Params& p, int layer, char* smem) {
  const bf16_t* HID = (const bf16_t*)(p.ws + O_HID); const bf16_t* WD = (const bf16_t*)(p.ws + O_MD);
  const int* IDX = (const int*)(p.ws + O_IDX); const float* GATE = (const float*)(p.ws + O_GATE);
  const float* modv = (const float*)(p.ws + O_MODV);
  const int t = tid(), lrow = t >> 3, lcol = (t & 7) * 8;
  for (TileWalk tw(256 * 8, smem); tw.valid(); tw.next()) {
    int mg, nt; tw.get(8, 8, 1, mg, nt);
    const int e = mg >> 4, b = (mg >> 3) & 1, mt = mg & 7, be = b * 16 + e;
    const bf16_t* ap[4]; const bf16_t* bp[4];
#pragma unroll
    for (int i = 0; i < 4; ++i) {
      ap[i] = HID + ((size_t)be * 1024 + mt * 128 + lrow + 32 * i) * 1024 + lcol;
      bp[i] = WD + ((size_t)e * 1024 + nt * 128 + lrow + 32 * i) * 1024 + lcol;
    }
    gemm_tile(ap, bp, 1024, smem, EpiBf16{(bf16_t*)(p.ws + O_YE) + ((size_t)be * 1024 + mt * 128) * 1024 + nt * 128, 1024});
  }
}

DI void phase_final(const Params& p) {
  const int t = tid(), lane = t & 63, w = t >> 6;
  for (int row = blockIdx.x * 4 + w; row < NTOK; row += gridDim.x * 4) {
    float* src = p.out + (size_t)row * 1024;
    float4 xv[4]; float ss = 0.f;
#pragma unroll
    for (int i = 0; i < 4; ++i) xv[i] = *(const float4*)(src + (i * 64 + lane) * 4);
    {
      float4 ca[4];
      moe_combine_row(p, row, lane, ca);
      const float* g2 = (const float*)(p.ws + O_MODV) + (1 * 3 + (row >> 13)) * 6144 + 5 * 1024;
#pragma unroll
      for (int i = 0; i < 4; ++i) {
        const float4 gg = *(const float4*)(g2 + (i * 64 + lane) * 4);
        xv[i].x += gg.x * ca[i].x; xv[i].y += gg.y * ca[i].y; xv[i].z += gg.z * ca[i].z; xv[i].w += gg.w * ca[i].w;
      }
    }
#pragma unroll
    for (int i = 0; i < 4; ++i) ss += xv[i].x * xv[i].x + xv[i].y * xv[i].y + xv[i].z * xv[i].z + xv[i].w * xv[i].w;
    ss = wsum(ss);
    const float rstd = rsqrtf(ss * (1.f / 1024.f) + EPS);
#pragma unroll
    for (int i = 0; i < 4; ++i) {
      const int col = (i * 64 + lane) * 4;
      const float4 g4 = *(const float4*)(p.final_norm_g + col);
      float4 y; y.x = xv[i].x * rstd * g4.x; y.y = xv[i].y * rstd * g4.y; y.z = xv[i].z * rstd * g4.z; y.w = xv[i].w * rstd * g4.w;
      *(float4*)(src + col) = y;
    }
  }
}

constexpr int NPHASE = 22;
DI void run_phase(const Params& p, int ph, char* smem) {
  const float* modv = (const float*)(p.ws + O_MODV);
  switch (ph) {
#if !defined(ONLY) || ONLY == 0
    case 0:
      phase_adaln(p, smem);
      __syncthreads();
      tconv(p.ab_w_in, 2832, 2832, 1024, 1, 0, (bf16_t*)(p.ws + O_WIN), 0, 1, smem);
      tconv(p.ab_w_out, 1024, 1024, 1024, 1, 0, (bf16_t*)(p.ws + O_WOUT), 0, 0, smem);
      tconv(p.gm_w_in, 4096, 4096, 1024, 1, 0, (bf16_t*)(p.ws + O_GMIN), 0, 0, smem);
      tconv(p.gm_w_out, 1024, 1024, 2048, 1, 0, (bf16_t*)(p.ws + O_GMOUT), 0, 0, smem);
      tconv_moe(p, 0, smem);
      break;
#endif
#if !defined(ONLY) || ONLY == 1
    case 1: phase_modulate<1, false>(p, 0, 0, smem); break;
#endif
#if !defined(ONLY) || ONLY == 2
    case 2:
      gemm_dense((const bf16_t*)(p.ws + O_HA), (const bf16_t*)(p.ws + O_WIN), NROW, PLD, 1024, 6, 11, smem,
                 [&](int m0, int n0) { return EpiBf16{(bf16_t*)(p.ws + O_P) + (size_t)m0 * PLD + n0, PLD}; });
      break;
#endif
#if !defined(ONLY) || ONLY == 3
    case 3: phase_prep2(p, smem); break;
#endif
#if !defined(ONLY) || ONLY == 4
    case 4:
      for (int item = blockIdx.x; item < 1024 + 8 * NSTEP; item += gridDim.x) {
        if (item < 1024) attn_item(p, item); else mlstm_local_item(p, item - 1024, smem);
      }
      break;
#endif
#if !defined(ONLY) || ONLY == 5
    case 5: phase_scan(p); break;
#endif
#if !defined(ONLY) || ONLY == 6
    case 6:
      for (int item = blockIdx.x; item < 512; item += gridDim.x) mlstm_out_item(p, item, smem);
      break;
#endif
#if !defined(ONLY) || ONLY == 7
    case 7:
      gemm_dense((const bf16_t*)(p.ws + O_HA), (const bf16_t*)(p.ws + O_WOUT), NTOK, 1024, 1024, 8, 8, smem,
                 [&](int m0, int n0) {
                   return EpiRes{p.out + (size_t)m0 * 1024 + n0, p.x + (size_t)m0 * 1024 + n0, modv + (0 * 3 + (m0 >> 13)) * 6144 + 2 * 1024 + n0};
                 });
      break;
#endif
#if !defined(ONLY) || ONLY == 8
    case 8: phase_modulate<2, false>(p, 0, 1, smem); break;
#endif
#if !defined(ONLY) || ONLY == 9
    case 9: phase_topk(p, smem); break;
#endif
#if !defined(ONLY) || ONLY == 10
    case 10: phase_moe1(p, smem); break;
#endif
#if !defined(ONLY) || ONLY == 11
    case 11: phase_moe2(p, 0, smem); break;
#endif
#if !defined(ONLY) || ONLY == 12
    case 12:
      phase_modulate<0, true>(p, 1, 0, smem);
      __syncthreads();
      tconv_moe(p, 1, smem);
      break;
#endif
#if !defined(ONLY) || ONLY == 13
    case 13:
      gemm_dense((const bf16_t*)(p.ws + O_HA), (const bf16_t*)(p.ws + O_GMIN), NTOK, 4096, 1024, 8, 8, smem,
                 [&](int m0, int n0) { return EpiGelu{(bf16_t*)(p.ws + O_U), (bf16_t*)(p.ws + O_GVT), m0, n0}; });
      break;
#endif
#if !defined(ONLY) || ONLY == 14
    case 14: phase_stats(p, smem); break;
#endif
#if !defined(ONLY) || ONLY == 15
    case 15: phase_spatial(p, smem); break;
#endif
#if !defined(ONLY) || ONLY == 16
    case 16:
      gemm_dense((const bf16_t*)(p.ws + O_UV), (const bf16_t*)(p.ws + O_GMOUT), NTOK, 1024, 2048, 8, 8, smem,
                 [&](int m0, int n0) {
                   return EpiRes{p.out + (size_t)m0 * 1024 + n0, p.out + (size_t)m0 * 1024 + n0, modv + (1 * 3 + (m0 >> 13)) * 6144 + 2 * 1024 + n0};
                 });
      break;
#endif
#if !defined(ONLY) || ONLY == 17
    case 17: phase_modulate<2, false>(p, 1, 1, smem); break;
#endif
#if !defined(ONLY) || ONLY == 18
    case 18: phase_topk(p, smem); break;
#endif
#if !defined(ONLY) || ONLY == 19
    case 19: phase_moe1(p, smem); break;
#endif
#if !defined(ONLY) || ONLY == 20
    case 20: phase_moe2(p, 1, smem); break;
#endif
#if !defined(ONLY) || ONLY == 21
    case 21: phase_final(p); break;
#endif
    default: break;
  }
}

#define XB_TMO      128
#define XB_XCNT(j)  (256  + 64 * (j))
#define XB_XSUB(j)  (1280 + 64 * (j))
#define XB_XGEN(j)  (2304 + 64 * (j))
#define XB_TOP      3328
#define XB_TOPGEN   3392
#define XCD_BAR_WORDS 3456
#define XB_SPIN_CAP (1u << 18)
#define LAS __attribute__((address_space(3)))
DI unsigned xb_ld(unsigned* p) { return __hip_atomic_load(p, __ATOMIC_RELAXED, __HIP_MEMORY_SCOPE_AGENT); }
DI unsigned xb_add(unsigned* p, unsigned v) { return __hip_atomic_fetch_add(p, v, __ATOMIC_RELAXED, __HIP_MEMORY_SCOPE_AGENT); }
DI unsigned xb_xcc_id() { return (unsigned)__builtin_amdgcn_s_getreg((3 << 11) | 20) & 0xFu; }
#define XB_SPIN(cond, bar) do { unsigned _sp = 0; while (cond) { __builtin_amdgcn_s_sleep(1); \
    if ((++_sp & 255u) == 0u) { if (xb_ld(&(bar)[XB_TMO])) break; if (_sp > XB_SPIN_CAP) { atomicAdd(&(bar)[XB_TMO], 1u); break; } } } } while (0)
struct XcdBarrier { unsigned* bar; unsigned x; volatile LAS unsigned* st; };
DI XcdBarrier xcd_barrier_post(unsigned* bar, volatile LAS unsigned* st) {
  XcdBarrier b; b.bar = bar; b.x = xb_xcc_id(); b.st = st;
  if (threadIdx.x == 0) st[3] = xb_add(&bar[XB_XCNT(b.x)], 1u);
  return b;
}
DI void xcd_barrier_complete(unsigned* bar, unsigned x, unsigned& nloc, unsigned& nx, unsigned& sbefore) {
  const unsigned G = gridDim.x * gridDim.y * gridDim.z;
  unsigned sum, cnt, mine, sp = 0u, sb = 0u;
  for (;;) {
    sum = 0u; cnt = 0u; mine = 0u; sb = 0u;
#pragma unroll
    for (unsigned j = 0; j < 16; ++j) { const unsigned c = xb_ld(&bar[XB_XCNT(j)]); sum += c; cnt += (c > 0u) ? 1u : 0u; mine = (j == x) ? c : mine; sb += (j < x) ? c : 0u; }
    if (sum == G) break;
    __builtin_amdgcn_s_sleep(1);
    if ((++sp & 255u) == 0u) { if (xb_ld(&bar[XB_TMO])) break; if (sp > XB_SPIN_CAP) { atomicAdd(&bar[XB_TMO], 1u); break; } }
  }
  nloc = mine > 0u ? mine : 1u; nx = cnt > 0u ? cnt : 1u; sbefore = sb;
}
DI void xcd_barrier(const XcdBarrier& b) {
  asm volatile("s_waitcnt vmcnt(0)" ::: "memory");
  __syncthreads();
  if (threadIdx.x == 0) {
    unsigned* bar = b.bar;
    __builtin_amdgcn_s_waitcnt(0);
    unsigned nloc = b.st[0], nx = b.st[1];
    if (nloc == 0u) { unsigned sbf; xcd_barrier_complete(bar, b.x, nloc, nx, sbf); b.st[0] = nloc; b.st[1] = nx; b.st[2] = sbf; }
    const unsigned old = xb_add(&bar[XB_XSUB(b.x)], 1u);
    const unsigned gen = old / nloc;
    if (old + 1u == (gen + 1u) * nloc) {
      __builtin_amdgcn_fence(__ATOMIC_RELEASE, "agent");
      asm volatile("s_waitcnt vmcnt(0)" ::: "memory");
      const unsigned og = xb_add(&bar[XB_TOP], 1u);
      const unsigned tg = og / nx;
      if (og + 1u == (tg + 1u) * nx) xb_add(&bar[XB_TOPGEN], 1u);
      else XB_SPIN(xb_ld(&bar[XB_TOPGEN]) == tg, bar);
      __builtin_amdgcn_fence(__ATOMIC_ACQUIRE, "agent");
      xb_add(&bar[XB_XGEN(b.x)], 1u);
      asm volatile("s_waitcnt vmcnt(0)" ::: "memory");
    } else {
      XB_SPIN(xb_ld(&bar[XB_XGEN(b.x)]) == gen, bar);
      __builtin_amdgcn_fence(__ATOMIC_ACQUIRE, "agent");
      asm volatile("s_waitcnt vmcnt(0)" ::: "memory");
    }
  }
  __syncthreads();
}

DI Params kargs() {
  Params P{};
#if defined(__HIP_DEVICE_COMPILE__)
  typedef const unsigned long long __attribute__((address_space(4))) CU;
  CU* q = (CU*)__builtin_amdgcn_kernarg_segment_ptr();
  asm volatile("" : "+s"(q));
#define GP(T, i) ((T*)(T __attribute__((address_space(1)))*)(q[i]))
  P.x = GP(const float, 0);
  P.c = GP(const float, 1);
  P.ctx = GP(const float, 2);
  P.c_ctx = GP(const float, 3);
  P.w_mod = GP(const float, 4);
  P.b_mod = GP(const float, 5);
  P.norm_mix_g = GP(const float, 6);
  P.norm_ffn_g = GP(const float, 7);
  P.final_norm_g = GP(const float, 8);
  P.ab_w_in = GP(const float, 9);
  P.ab_conv_w = GP(const float, 10);
  P.ab_gate_b = GP(const float, 11);
  P.ab_head_g = GP(const float, 12);
  P.ab_sink = GP(const float, 13);
  P.ab_w_out = GP(const float, 14);
  P.gm_w_in = GP(const float, 15);
  P.gm_ln_g = GP(const float, 16);
  P.gm_ln_b = GP(const float, 17);
  P.gm_w_s = GP(const float, 18);
  P.gm_b_s = GP(const float, 19);
  P.gm_w_out = GP(const float, 20);
  P.moe_w_router = GP(const float, 21);
  P.moe_w_gate = GP(const float, 22);
  P.moe_w_up = GP(const float, 23);
  P.moe_w_down = GP(const float, 24);
  P.out = GP(float, 25);
  P.ws = GP(char, 26);
#undef GP
#endif
  return P;
}
#if COOP
#ifndef REPEAT_MASK
#define REPEAT_MASK 0
#endif
__global__ void __launch_bounds__(256, 2) mega(Params p_unused) {
  __shared__ __attribute__((aligned(16))) char smem[73728 + 16];
  unsigned* xbw = (unsigned*)(smem + 73728);
  cg::grid_group grid = cg::this_grid();
  if (threadIdx.x < 4) xbw[threadIdx.x] = 0u;
  __syncthreads();
  XcdBarrier xb;
  { const Params pp = kargs(); xb = xcd_barrier_post((unsigned*)(pp.ws + O_BAR), (volatile LAS unsigned*)xbw); }
#define PHX(n) { const Params pp = kargs(); run_phase(pp, n, smem); } xcd_barrier(xb); \
  if ((REPEAT_MASK >> n) & 1) { { const Params pp = kargs(); run_phase(pp, n, smem); } xcd_barrier(xb); }
  { const Params pp = kargs(); run_phase(pp, 0, smem); }
  grid.sync();
  PHX(1) PHX(2) PHX(3) PHX(4) PHX(5) PHX(6) PHX(7) PHX(8) PHX(9) PHX(10)
  PHX(11) PHX(12) PHX(13) PHX(14) PHX(15) PHX(16) PHX(17) PHX(18) PHX(19) PHX(20)
  { const Params pp = kargs(); run_phase(pp, 21, smem); }
}
#else
__global__ void __launch_bounds__(256, 2) mega(Params p, int ph) {
  __shared__ __attribute__((aligned(16))) char smem[73728];
  run_phase(p, ph, smem);
}
#endif

extern "C" void kernel_launch(void* const* d_in, const int* in_sizes, int n_in, void* d_out, int out_size, void* d_ws,
                              size_t ws_size, hipStream_t stream) {
  (void)in_sizes; (void)n_in; (void)out_size;
  if (ws_size < WS_NEED) { fprintf(stderr, "workspace too small: %zu < %zu\n", ws_size, (size_t)WS_NEED); return; }
  static int grid_blocks = 0;
  if (!grid_blocks) {
    int dev = 0, cus = 0, per_cu = 0;
    hipGetDevice(&dev);
    hipDeviceGetAttribute(&cus, hipDeviceAttributeMultiprocessorCount, dev);
    hipOccupancyMaxActiveBlocksPerMultiprocessor(&per_cu, mega, 256, 0);
    if (per_cu < 1) per_cu = 1;
    if (per_cu > 2) per_cu = 2;
    grid_blocks = cus * per_cu;
  }
  Params p{};
  const float** f = (const float**)&p;
  for (int i = 0; i < 25; ++i) f[i] = (const float*)d_in[i];
  p.out = (float*)d_out;
  p.ws = (char*)d_ws;
#if COOP
  hipMemsetAsync((char*)d_ws + O_BAR, 0, XCD_BAR_WORDS * 4, stream);
  void* args[] = {&p};
  hipError_t e = hipLaunchCooperativeKernel((void*)mega, dim3(grid_blocks), dim3(256), args, 0, stream);
  if (e != hipSuccess) fprintf(stderr, "cooperative launch failed: %s (grid %d)\n", hipGetErrorString(e), grid_blocks);
#else
  for (int ph = 0; ph < NPHASE; ++ph) hipLaunchKernelGGL(mega, dim3(grid_blocks), dim3(256), 0, stream, p, ph);
#endif
}
```

```cpp
#include <hip/hip_runtime.h>
#include <hip/hip_cooperative_groups.h>
#include <cstdio>
namespace cg = cooperative_groups;

#define DI __device__ __forceinline__
typedef unsigned short bf16_t;
using bf16x8 = __attribute__((ext_vector_type(8))) short;
using s16x4 = __attribute__((ext_vector_type(4))) short;
using f32x16 = __attribute__((ext_vector_type(16))) float;
#define MFMA(a, b, c) __builtin_amdgcn_mfma_f32_32x32x16_bf16((a), (b), (c), 0, 0, 0)

#ifndef COOP
#define COOP 1
#endif

constexpr int DM = 1024, NBAT = 2, SEQ = 8192, NTOK = NBAT * SEQ, CTXL = 256, NROW = NTOK + NBAT * CTXL;
constexpr int PLD = 2816;
constexpr int NSTEP = 66;
constexpr float EPS = 1e-6f;

constexpr size_t al256(size_t x) { return (x + 255) & ~(size_t)255; }
constexpr size_t O_BAR = 0;
constexpr size_t O_WIN = 16384;
constexpr size_t O_WOUT = O_WIN + al256((size_t)PLD * 1024 * 2);
constexpr size_t O_GMIN = O_WOUT + al256((size_t)1024 * 1024 * 2);
constexpr size_t O_GMOUT = O_GMIN + al256((size_t)4096 * 1024 * 2);
constexpr size_t O_MGU = O_GMOUT + al256((size_t)1024 * 2048 * 2);
constexpr size_t O_MD = O_MGU + al256((size_t)16 * 2048 * 1024 * 2);
constexpr size_t O_MODV = O_MD + al256((size_t)16 * 1024 * 1024 * 2);
constexpr size_t O_HA = O_MODV + al256((size_t)2 * 3 * 6144 * 4);
constexpr size_t O_GL = O_HA + al256((size_t)NROW * 1024 * 2);
constexpr size_t O_AFF = O_GL + al256((size_t)NROW * 16 * 4);
constexpr size_t O_IDX = O_AFF + al256((size_t)32 * 8192 * 4);
constexpr size_t O_GATE = O_IDX + al256((size_t)32 * 1024 * 4);
constexpr size_t O_STATS = O_GATE + al256((size_t)32 * 1024 * 4);
constexpr size_t O_GSC = O_STATS + al256((size_t)NTOK * 16 * 4);
constexpr size_t O_MLOC = O_GSC + al256((size_t)16 * NSTEP * 4);
constexpr size_t O_DN = O_MLOC + al256((size_t)16 * NSTEP * 4);
constexpr size_t O_NST = O_DN + al256((size_t)16 * NSTEP * 128 * 4);
constexpr size_t O_MST = O_NST + al256((size_t)16 * 64 * 128 * 4);
constexpr size_t O_INV = O_MST + al256((size_t)16 * 64 * 4);
constexpr size_t O_R12 = O_INV + al256((size_t)NTOK * 16 * 4);
constexpr size_t O_P = O_R12;
constexpr size_t O_QC = O_P + al256((size_t)NROW * PLD * 2);
constexpr size_t O_KC = O_QC + al256((size_t)NTOK * 512 * 2);
constexpr size_t O_KT = O_KC + al256((size_t)NTOK * 512 * 2);
constexpr size_t O_VT = O_KT + al256((size_t)132 * 4 * 128 * 128 * 2);
constexpr size_t O_RQ = O_VT + al256((size_t)132 * 4 * 128 * 128 * 2);
constexpr size_t O_RK = O_RQ + al256((size_t)NTOK * 512 * 2);
constexpr size_t O_AVTX = O_RK + al256((size_t)NROW * 128 * 2);
constexpr size_t O_AVTC = O_AVTX + al256((size_t)4 * 64 * 8192 * 2);
constexpr size_t O_R12_END = O_AVTC + al256((size_t)4 * 64 * 256 * 2);
constexpr size_t O_HID = O_R12;
constexpr size_t O_U = O_R12;
constexpr size_t O_GVT = O_U + al256((size_t)NTOK * 2048 * 2);
static_assert(O_GVT + (size_t)NTOK * 2048 * 2 <= O_R12_END, "R12 too small");
constexpr size_t O_DC = O_R12_END;
constexpr size_t O_CST = O_DC + al256((size_t)16 * NSTEP * 16384 * 4);
constexpr size_t O_UV = O_DC;
constexpr size_t O_YE = O_DC;
constexpr size_t WS_NEED = O_CST + al256((size_t)16 * 64 * 16384 * 2);

struct Params {
  const float *x, *c, *ctx, *c_ctx, *w_mod, *b_mod, *norm_mix_g, *norm_ffn_g, *final_norm_g;
  const float *ab_w_in, *ab_conv_w, *ab_gate_b, *ab_head_g, *ab_sink, *ab_w_out;
  const float *gm_w_in, *gm_ln_g, *gm_ln_b, *gm_w_s, *gm_b_s, *gm_w_out;
  const float *moe_w_router, *moe_w_gate, *moe_w_up, *moe_w_down;
  float* out;
  char* ws;
};

DI bf16_t f2bf(float x) { unsigned u = __float_as_uint(x); u += 0x7fffu + ((u >> 16) & 1u); return (bf16_t)(u >> 16); }
DI float bf2f(bf16_t b) { return __uint_as_float(((unsigned)b) << 16); }
DI unsigned pack2(float a, float b) { return (unsigned)f2bf(a) | ((unsigned)f2bf(b) << 16); }
DI bf16x8 pack8(float a0, float a1, float a2, float a3, float a4, float a5, float a6, float a7) {
  uint4 u; u.x = pack2(a0, a1); u.y = pack2(a2, a3); u.z = pack2(a4, a5); u.w = pack2(a6, a7);
  return __builtin_bit_cast(bf16x8, u);
}
DI bf16x8 ldfrag(const bf16_t* p) { return *(const bf16x8*)p; }
DI bf16x8 ldfrag2(const bf16_t* p0, const bf16_t* p1) {
  s16x4 lo = *(const s16x4*)p0, hi = *(const s16x4*)p1;
  return __builtin_shufflevector(lo, hi, 0, 1, 2, 3, 4, 5, 6, 7);
}
DI int crow(int i, int hh) { return (i & 3) + 8 * (i >> 2) + 4 * hh; }
DI float siluf(float x) { return x / (1.f + __expf(-x)); }
DI float sigmf(float x) { return 1.f / (1.f + __expf(-x)); }
DI float logsigf(float x) { return fminf(x, 0.f) - log1pf(expf(-fabsf(x))); }
DI float geluf(float x) {
  const float u2 = 1.5957691216057308f * (x + 0.044715f * x * x * x);
  return x / (1.f + __expf(-u2));
}
DI float wsum(float v) {
#pragma unroll
  for (int o = 32; o > 0; o >>= 1) v += __shfl_xor(v, o);
  return v;
}
DI int tid() { int t = threadIdx.x; asm volatile("" : "+v"(t)); return t; }
DI f32x16 fzero() { f32x16 z; for (int i = 0; i < 16; ++i) z[i] = 0.f; return z; }

DI int tmap(int kind, int n) {
  if (kind == 0) return n;
  if (kind == 1) return n < 2048 ? n : (n < 2064 ? -1 : n - 16);
  int r = (n >> 6) * 128 + ((n >> 5) & 1) * 64 + (n & 31);
  return kind == 2 ? r : r + 32;
}
DI void tconv(const float* __restrict__ src, int ldn, int ncols, int K, int nmat, size_t sstride,
              bf16_t* __restrict__ dst, size_t dstride, int kind, char* smem) {
  float* sm = (float*)smem;
  const int t = tid();
  const int ntn = (ncols + 63) >> 6, ntk = K >> 6, per = ntn * ntk, total = per * nmat;
  const int c4 = t & 15, rr = t >> 4;
  float4 v0, v1, v2, v3;
#define TC_LOAD(tile_) { const int mat_ = (tile_) / per, tt_ = (tile_) % per; const int k0_ = (tt_ / ntn) * 64, n_ = (tt_ % ntn) * 64 + c4 * 4; \
    const float* s_ = src + (size_t)mat_ * sstride + (size_t)(k0_ + rr) * ldn + n_; \
    if (n_ < ncols) { v0 = *(const float4*)(s_); v1 = *(const float4*)(s_ + (size_t)16 * ldn); v2 = *(const float4*)(s_ + (size_t)32 * ldn); v3 = *(const float4*)(s_ + (size_t)48 * ldn); } \
    else { v0 = v1 = v2 = v3 = make_float4(0.f, 0.f, 0.f, 0.f); } }
  int tile = blockIdx.x;
  if (tile < total) TC_LOAD(tile)
  for (; tile < total; tile += gridDim.x) {
    const int mat = tile / per, tt = tile % per;
    const int k0 = (tt / ntn) * 64, n0 = (tt % ntn) * 64;
    bf16_t* d = dst + (size_t)mat * dstride;
    {
      float* q = sm + rr * 65 + c4 * 4;
      q[0] = v0.x; q[1] = v0.y; q[2] = v0.z; q[3] = v0.w;
      q[16 * 65 + 0] = v1.x; q[16 * 65 + 1] = v1.y; q[16 * 65 + 2] = v1.z; q[16 * 65 + 3] = v1.w;
      q[32 * 65 + 0] = v2.x; q[32 * 65 + 1] = v2.y; q[32 * 65 + 2] = v2.z; q[32 * 65 + 3] = v2.w;
      q[48 * 65 + 0] = v3.x; q[48 * 65 + 1] = v3.y; q[48 * 65 + 2] = v3.z; q[48 * 65 + 3] = v3.w;
    }
    if (tile + (int)gridDim.x < total) TC_LOAD(tile + (int)gridDim.x)
    __syncthreads();
    const int nl = t >> 2, kq = t & 3, n = n0 + nl;
    if (n < ncols) {
      const int row = tmap(kind, n);
      if (row >= 0) {
        uint4 o0, o1;
        const float* q = sm + (kq * 16) * 65 + nl;
        o0.x = pack2(q[0 * 65], q[1 * 65]); o0.y = pack2(q[2 * 65], q[3 * 65]); o0.z = pack2(q[4 * 65], q[5 * 65]); o0.w = pack2(q[6 * 65], q[7 * 65]);
        o1.x = pack2(q[8 * 65], q[9 * 65]); o1.y = pack2(q[10 * 65], q[11 * 65]); o1.z = pack2(q[12 * 65], q[13 * 65]); o1.w = pack2(q[14 * 65], q[15 * 65]);
        uint4* dp = (uint4*)(d + (size_t)row * K + k0 + kq * 16);
        dp[0] = o0; dp[1] = o1;
      }
    }
    __syncthreads();
  }
#undef TC_LOAD
}
DI void tconv_moe(const Params& p, int layer, char* smem) {
  const size_t wo = (size_t)layer * 16 * 1024 * 1024;
  tconv(p.moe_w_gate + wo, 1024, 1024, 1024, 16, (size_t)1024 * 1024, (bf16_t*)(p.ws + O_MGU), (size_t)2048 * 1024, 2, smem);
  tconv(p.moe_w_up + wo, 1024, 1024, 1024, 16, (size_t)1024 * 1024, (bf16_t*)(p.ws + O_MGU), (size_t)2048 * 1024, 3, smem);
  tconv(p.moe_w_down + wo, 1024, 1024, 1024, 16, (size_t)1024 * 1024, (bf16_t*)(p.ws + O_MD), (size_t)1024 * 1024, 0, smem);
}

DI void phase_adaln(const Params& p, char* smem) {
  float* sv = (float*)smem;
  float* red = sv + 3 * 1024;
  float* modv = (float*)(p.ws + O_MODV);
  const int t = tid();
  if (blockIdx.x >= 192) return;
  for (int i = t; i < 3 * 1024; i += 256) {
    const int v = i >> 10, k = i & 1023;
    const float cv = v < 2 ? p.c[v * 1024 + k] : p.c_ctx[k];
    sv[i] = siluf(cv);
  }
  __syncthreads();
  for (int item = blockIdx.x; item < 192; item += gridDim.x) {
    const int l = item / 96, cb = item % 96;
    const int cq = t & 15, kg = t >> 4;
    const float* w = p.w_mod + (size_t)l * 1024 * 6144 + cb * 64 + cq * 4;
    float a0[4] = {0.f, 0.f, 0.f, 0.f}, a1[4] = {0.f, 0.f, 0.f, 0.f}, a2[4] = {0.f, 0.f, 0.f, 0.f};
    for (int i = 0; i < 64; ++i) {
      const int k = kg + 16 * i;
      const float4 wv = *(const float4*)(w + (size_t)k * 6144);
      const float s0 = sv[k], s1 = sv[1024 + k], s2 = sv[2048 + k];
      a0[0] += s0 * wv.x; a0[1] += s0 * wv.y; a0[2] += s0 * wv.z; a0[3] += s0 * wv.w;
      a1[0] += s1 * wv.x; a1[1] += s1 * wv.y; a1[2] += s1 * wv.z; a1[3] += s1 * wv.w;
      a2[0] += s2 * wv.x; a2[1] += s2 * wv.y; a2[2] += s2 * wv.z; a2[3] += s2 * wv.w;
    }
#pragma unroll
    for (int j = 0; j < 4; ++j) {
      red[(kg * 3 + 0) * 64 + cq * 4 + j] = a0[j];
      red[(kg * 3 + 1) * 64 + cq * 4 + j] = a1[j];
      red[(kg * 3 + 2) * 64 + cq * 4 + j] = a2[j];
    }
    __syncthreads();
    if (t < 192) {
      const int v = t >> 6, col = t & 63;
      float s = 0.f;
      for (int g = 0; g < 16; ++g) s += red[(g * 3 + v) * 64 + col];
      const int cc = cb * 64 + col;
      modv[(l * 3 + v) * 6144 + cc] = s + p.b_mod[l * 6144 + cc];
    }
    __syncthreads();
  }
}

DI void moe_combine_row(const Params& p, int row, int lane, float4 (&acc)[4]) {
  const int* INV = (const int*)(p.ws + O_INV); const float* GATE = (const float*)(p.ws + O_GATE);
  const bf16_t* YE = (const bf16_t*)(p.ws + O_YE);
  const int b = row >> 13;
  const int myslot = INV[(size_t)row * 16 + (lane & 15)];
#pragma unroll
  for (int i = 0; i < 4; ++i) acc[i] = make_float4(0.f, 0.f, 0.f, 0.f);
#pragma unroll 1
  for (int e = 0; e < 16; ++e) {
    const int slot = __builtin_amdgcn_readlane(myslot, e);
    if (slot != 0) {
      const int be = b * 16 + e;
      const float g = GATE[be * 1024 + slot - 1];
      const bf16_t* yr = YE + ((size_t)be * 1024 + slot - 1) * 1024;
#pragma unroll
      for (int i = 0; i < 4; ++i) {
        const s16x4 v = *(const s16x4*)(yr + (i * 64 + lane) * 4);
        acc[i].x += g * bf2f((bf16_t)v[0]); acc[i].y += g * bf2f((bf16_t)v[1]); acc[i].z += g * bf2f((bf16_t)v[2]); acc[i].w += g * bf2f((bf16_t)v[3]);
      }
    }
  }
}

template <int MODE, bool COMB>
DI void phase_modulate(const Params& p, int layer, int which, char* smem) {
  float* wt = (float*)smem;
  const int t = tid(), lane = t & 63, w = t >> 6;
  const float* modv = (const float*)(p.ws + O_MODV);
  bf16_t* HA = (bf16_t*)(p.ws + O_HA);
  if (MODE != 0) {
    const float* W = MODE == 1 ? p.ab_w_in + 2048 : p.moe_w_router + (size_t)layer * 1024 * 16;
    const int ld = MODE == 1 ? 2832 : 16;
    for (int i = t; i < 4096; i += 256) {
      const int k = i >> 2, e4 = i & 3;
      const float4 v = *(const float4*)(W + (size_t)k * ld + e4 * 4);
      wt[(e4 * 4 + 0) * 1024 + k] = v.x; wt[(e4 * 4 + 1) * 1024 + k] = v.y; wt[(e4 * 4 + 2) * 1024 + k] = v.z; wt[(e4 * 4 + 3) * 1024 + k] = v.w;
    }
    __syncthreads();
  }
  const float* gn = (which == 0 ? p.norm_mix_g : p.norm_ffn_g) + layer * 1024;
  const int nrows = MODE == 1 ? NROW : NTOK;
  const int rstride = gridDim.x * 4;
  float4 nx[4];
#define MOD_SRC(row_) (MODE == 1 ? ((row_) < NTOK ? p.x + (size_t)(row_) * 1024 : p.ctx + (size_t)((row_) - NTOK) * 1024) : p.out + (size_t)(row_) * 1024)
  {
    const int row0_ = blockIdx.x * 4 + w;
    if (row0_ < nrows) {
      const float* s0_ = MOD_SRC(row0_);
#pragma unroll
      for (int i = 0; i < 4; ++i) nx[i] = *(const float4*)(s0_ + (i * 64 + lane) * 4);
    }
  }
  for (int row = blockIdx.x * 4 + w; row < nrows; row += rstride) {
    const int v = (MODE == 1 && row >= NTOK) ? 2 : (row >> 13);
    const float* sh = modv + (layer * 3 + v) * 6144 + (which ? 3 : 0) * 1024;
    const float* sc = sh + 1024;
    float4 xv[4];
    float ss = 0.f;
#pragma unroll
    for (int i = 0; i < 4; ++i) xv[i] = nx[i];
    if (row + rstride < nrows) {
      const float* s1_ = MOD_SRC(row + rstride);
#pragma unroll
      for (int i = 0; i < 4; ++i) nx[i] = *(const float4*)(s1_ + (i * 64 + lane) * 4);
    }
    if (COMB) {
      float4 ca[4];
      moe_combine_row(p, row, lane, ca);
      const float* g2 = modv + ((layer - 1) * 3 + v) * 6144 + 5 * 1024;
#pragma unroll
      for (int i = 0; i < 4; ++i) {
        const float4 gg = *(const float4*)(g2 + (i * 64 + lane) * 4);
        xv[i].x += gg.x * ca[i].x; xv[i].y += gg.y * ca[i].y; xv[i].z += gg.z * ca[i].z; xv[i].w += gg.w * ca[i].w;
        *(float4*)(p.out + (size_t)row * 1024 + (i * 64 + lane) * 4) = xv[i];
      }
    }
#pragma unroll
    for (int i = 0; i < 4; ++i) ss += xv[i].x * xv[i].x + xv[i].y * xv[i].y + xv[i].z * xv[i].z + xv[i].w * xv[i].w;
    ss = wsum(ss);
    const float rstd = rsqrtf(ss * (1.f / 1024.f) + EPS);
    float4 yv[4];
#pragma unroll
    for (int i = 0; i < 4; ++i) {
      const int col = (i * 64 + lane) * 4;
      const float4 g4 = *(const float4*)(gn + col), s4 = *(const float4*)(sh + col), c4 = *(const float4*)(sc + col);
      float4 y;
      y.x = xv[i].x * rstd * g4.x * (1.f + c4.x) + s4.x;
      y.y = xv[i].y * rstd * g4.y * (1.f + c4.y) + s4.y;
      y.z = xv[i].z * rstd * g4.z * (1.f + c4.z) + s4.z;
      y.w = xv[i].w * rstd * g4.w * (1.f + c4.w) + s4.w;
      yv[i] = y;
      uint2 o; o.x = pack2(y.x, y.y); o.y = pack2(y.z, y.w);
      *(uint2*)(HA + (size_t)row * 1024 + col) = o;
    }
    if (MODE != 0) {
      float mine = 0.f;
#pragma unroll 1
      for (int e4 = 0; e4 < 16; e4 += 4) {
        float pe0 = 0.f, pe1 = 0.f, pe2 = 0.f, pe3 = 0.f;
#pragma unroll
        for (int i = 0; i < 4; ++i) {
          const float* wp = wt + e4 * 1024 + (i * 64 + lane) * 4;
          const float4 wa = *(const float4*)(wp), wb = *(const float4*)(wp + 1024), wc = *(const float4*)(wp + 2048), wd = *(const float4*)(wp + 3072);
          pe0 += yv[i].x * wa.x + yv[i].y * wa.y + yv[i].z * wa.z + yv[i].w * wa.w;
          pe1 += yv[i].x * wb.x + yv[i].y * wb.y + yv[i].z * wb.z + yv[i].w * wb.w;
          pe2 += yv[i].x * wc.x + yv[i].y * wc.y + yv[i].z * wc.z + yv[i].w * wc.w;
          pe3 += yv[i].x * wd.x + yv[i].y * wd.y + yv[i].z * wd.z + yv[i].w * wd.w;
        }
#pragma unroll
        for (int o = 32; o > 0; o >>= 1) {
          const float q0 = __shfl_xor(pe0, o), q1 = __shfl_xor(pe1, o), q2 = __shfl_xor(pe2, o), q3 = __shfl_xor(pe3, o);
          pe0 += q0; pe1 += q1; pe2 += q2; pe3 += q3;
        }
        const int el = (lane & 15) - e4;
        mine = el == 0 ? pe0 : (el == 1 ? pe1 : (el == 2 ? pe2 : (el == 3 ? pe3 : mine)));
      }
      const int e = lane & 15;
      if (MODE == 1) {
        float val = mine + p.ab_gate_b[e];
        if (((e >> 2) & 1) == 1) val = logsigf(val);
        if (lane < 16) ((float*)(p.ws + O_GL))[(size_t)row * 16 + lane] = val;
      } else {
        float mx = mine;
#pragma unroll
        for (int o = 8; o > 0; o >>= 1) mx = fmaxf(mx, __shfl_xor(mx, o));
        const float ex = expf(mine - mx);
        float sum = ex;
#pragma unroll
        for (int o = 8; o > 0; o >>= 1) sum += __shfl_xor(sum, o);
        if (lane < 16) ((float*)(p.ws + O_AFF))[((size_t)(row >> 13) * 16 + lane) * 8192 + (row & 8191)] = ex / sum;
        if (lane < 16) ((int*)(p.ws + O_INV))[(size_t)row * 16 + lane] = 0;
      }
    }
  }
}

template <class Epi>
DI void gemm_tile(const bf16_t* (&ap)[4], const bf16_t* (&bp)[4], int K, char* smem, Epi&& epi) {
  bf16_t* sA = (bf16_t*)smem;
  bf16_t* sB = sA + 2 * 128 * 72;
  const int t = tid(), lane = t & 63, w = t >> 6, wm = w >> 1, wn = w & 1, r = lane & 31, hh = lane >> 5;
  const int lrow = t >> 3, lcol = (t & 7) * 8;
  const bf16_t* a0p = ap[0]; const bf16_t* a1p = ap[1]; const bf16_t* a2p = ap[2]; const bf16_t* a3p = ap[3];
  const bf16_t* b0p = bp[0]; const bf16_t* b1p = bp[1]; const bf16_t* b2p = bp[2]; const bf16_t* b3p = bp[3];
  f32x16 acc00 = fzero(), acc01 = fzero(), acc10 = fzero(), acc11 = fzero();
  uint4 ra0 = *(const uint4*)a0p, ra1 = *(const uint4*)a1p, ra2 = *(const uint4*)a2p, ra3 = *(const uint4*)a3p;
  uint4 rb0 = *(const uint4*)b0p, rb1 = *(const uint4*)b1p, rb2 = *(const uint4*)b2p, rb3 = *(const uint4*)b3p;
  const int so = lrow * 72 + lcol;
  *(uint4*)(sA + so) = ra0; *(uint4*)(sA + so + 32 * 72) = ra1; *(uint4*)(sA + so + 64 * 72) = ra2; *(uint4*)(sA + so + 96 * 72) = ra3;
  *(uint4*)(sB + so) = rb0; *(uint4*)(sB + so + 32 * 72) = rb1; *(uint4*)(sB + so + 64 * 72) = rb2; *(uint4*)(sB + so + 96 * 72) = rb3;
  __syncthreads();
  const int KT = K >> 6;
  for (int kt = 0; kt < KT; ++kt) {
    const int cur = kt & 1;
    const int kn = (kt + 1 < KT ? kt + 1 : kt) * 64;
    ra0 = *(const uint4*)(a0p + kn); ra1 = *(const uint4*)(a1p + kn); ra2 = *(const uint4*)(a2p + kn); ra3 = *(const uint4*)(a3p + kn);
    rb0 = *(const uint4*)(b0p + kn); rb1 = *(const uint4*)(b1p + kn); rb2 = *(const uint4*)(b2p + kn); rb3 = *(const uint4*)(b3p + kn);
    __builtin_amdgcn_sched_barrier(0);
    const bf16_t* cA = sA + cur * 128 * 72 + (wm * 64 + r) * 72 + hh * 8;
    const bf16_t* cB = sB + cur * 128 * 72 + (wn * 64 + r) * 72 + hh * 8;
    {
      bf16x8 a0 = *(const bf16x8*)(cA), a1 = *(const bf16x8*)(cA + 32 * 72);
      bf16x8 b0 = *(const bf16x8*)(cB), b1 = *(const bf16x8*)(cB + 32 * 72);
#pragma unroll
      for (int ks = 0; ks < 4; ++ks) {
        bf16x8 na0 = a0, na1 = a1, nb0 = b0, nb1 = b1;
        if (ks < 3) {
          na0 = *(const bf16x8*)(cA + (ks + 1) * 16); na1 = *(const bf16x8*)(cA + 32 * 72 + (ks + 1) * 16);
          nb0 = *(const bf16x8*)(cB + (ks + 1) * 16); nb1 = *(const bf16x8*)(cB + 32 * 72 + (ks + 1) * 16);
        }
        acc00 = MFMA(a0, b0, acc00);
        acc01 = MFMA(a0, b1, acc01);
        acc10 = MFMA(a1, b0, acc10);
        acc11 = MFMA(a1, b1, acc11);
        __builtin_amdgcn_sched_barrier(0);
        a0 = na0; a1 = na1; b0 = nb0; b1 = nb1;
      }
    }
    __builtin_amdgcn_sched_barrier(0);
    {
      bf16_t* nA = sA + (cur ^ 1) * 128 * 72 + so;
      bf16_t* nB = sB + (cur ^ 1) * 128 * 72 + so;
      *(uint4*)(nA) = ra0; *(uint4*)(nA + 32 * 72) = ra1; *(uint4*)(nA + 64 * 72) = ra2; *(uint4*)(nA + 96 * 72) = ra3;
      *(uint4*)(nB) = rb0; *(uint4*)(nB + 32 * 72) = rb1; *(uint4*)(nB + 64 * 72) = rb2; *(uint4*)(nB + 96 * 72) = rb3;
    }
    __syncthreads();
  }
  f32x16 acc[2][2];
  acc[0][0] = acc00; acc[0][1] = acc01; acc[1][0] = acc10; acc[1][1] = acc11;
  epi(acc, wm * 64, wn * 64, r, hh);
}

struct TileWalk {
  int L, Lend, nl;
  DI TileWalk(int T, const char* smem) {
    const volatile unsigned* xw = (const volatile unsigned*)(smem + 73728);
    const int nloc = (int)xw[0], sb = (int)xw[2], rk = (int)xw[3], G = (int)gridDim.x;
    nl = nloc;
    L = (T * sb) / G + rk; Lend = (T * (sb + nloc)) / G;
  }
  DI bool valid() const { return L < Lend; }
  DI void next() { L += nl; }
  DI void get(int SM, int SN, int nsn, int& mt, int& nt) const {
    const int s = L / (SM * SN), wi = L % (SM * SN);
    mt = (s / nsn) * SM + wi / SN; nt = (s % nsn) * SN + wi % SN;
  }
};

template <class MakeEpi>
DI void gemm_dense(const bf16_t* A, const bf16_t* Bt, int M, int N, int K, int SM, int SN, char* smem, MakeEpi&& mk) {
  const int t = tid(), lrow = t >> 3, lcol = (t & 7) * 8;
  const int ntn = N >> 7, ntm = M >> 7;
  for (TileWalk tw(ntn * ntm, smem); tw.valid(); tw.next()) {
    int mt, nt; tw.get(SM, SN, ntn / SN, mt, nt);
    const bf16_t* ap[4]; const bf16_t* bp[4];
#pragma unroll
    for (int i = 0; i < 4; ++i) {
      ap[i] = A + (size_t)(mt * 128 + lrow + 32 * i) * K + lcol;
      bp[i] = Bt + (size_t)(nt * 128 + lrow + 32 * i) * K + lcol;
    }
    gemm_tile(ap, bp, K, smem, mk(mt * 128, nt * 128));
  }
}

DI void phase_prep2(const Params& p, char* smem) {
  bf16_t* T = (bf16_t*)smem;
  const bf16_t* P = (const bf16_t*)(p.ws + O_P);
  bf16_t* Qc = (bf16_t*)(p.ws + O_QC); bf16_t* Kc = (bf16_t*)(p.ws + O_KC);
  bf16_t* KT = (bf16_t*)(p.ws + O_KT); bf16_t* VT = (bf16_t*)(p.ws + O_VT);
  bf16_t* RQ = (bf16_t*)(p.ws + O_RQ); bf16_t* RK = (bf16_t*)(p.ws + O_RK);
  bf16_t* AVTX = (bf16_t*)(p.ws + O_AVTX); bf16_t* AVTC = (bf16_t*)(p.ws + O_AVTC);
  const int t = tid();
  for (int item = blockIdx.x; item < 132 * 6; item += gridDim.x) {
    const int sc = item / 6, part = item % 6;
    const bool isx = sc < 128;
    const int row0 = sc * 128;
    const int seq_lo = isx ? (sc >> 6) * 8192 : NTOK + ((sc - 128) >> 1) * 256;
    const int seq_hi = seq_lo + (isx ? 8192 : 256);
    if (part < 4) {
      const int h = part;
      const int col8 = t & 15, rsub = t >> 4;
      for (int pass = 0; pass < 3; ++pass) {
        if (pass == 2 && !isx) break;
        const int pcol = (pass == 0 ? 512 : (pass == 1 ? 1024 : 0)) + h * 128 + col8 * 8;
        float cw[5][8];
        if (pass != 1) {
#pragma unroll
          for (int j = 0; j < 5; ++j)
#pragma unroll
            for (int e = 0; e < 8; ++e) cw[j][e] = p.ab_conv_w[j * 1024 + (pass == 0 ? 512 : 0) + h * 128 + col8 * 8 + e];
        }
        for (int i = 0; i < 8; ++i) {
          const int rl = rsub + 16 * i, row = row0 + rl;
          uint4 o;
          if (pass == 1) {
            o = *(const uint4*)(P + (size_t)row * PLD + pcol);
          } else {
            float a[8];
#pragma unroll
            for (int e = 0; e < 8; ++e) a[e] = 0.f;
#pragma unroll
            for (int j = 0; j < 5; ++j) {
              const int rr = row + j - 2;
              if (rr >= seq_lo && rr < seq_hi) {
                const bf16x8 v = *(const bf16x8*)(P + (size_t)rr * PLD + pcol);
#pragma unroll
                for (int e = 0; e < 8; ++e) a[e] += cw[j][e] * bf2f((bf16_t)v[e]);
              }
            }
            const float scl = pass == 0 ? 0.08838834764831845f : 1.f;
#pragma unroll
            for (int e = 0; e < 8; ++e) a[e] = siluf(a[e]) * scl;
            o.x = pack2(a[0], a[1]); o.y = pack2(a[2], a[3]); o.z = pack2(a[4], a[5]); o.w = pack2(a[6], a[7]);
            if (isx) *(uint4*)((pass == 0 ? Kc : Qc) + (size_t)row * 512 + h * 128 + col8 * 8) = o;
          }
          if (pass < 2) *(uint4*)(T + rl * 136 + col8 * 8) = o;
        }
        if (pass < 2) {
          __syncthreads();
          bf16_t* dstT = (pass == 0 ? KT : VT) + (size_t)(sc * 4 + h) * 16384;
          const int d = t & 127, shf = t >> 7;
#pragma unroll
          for (int s8 = 0; s8 < 8; ++s8) {
            const bf16_t* q = T + (shf * 64 + s8 * 8) * 136 + d;
            uint4 o;
            o.x = (unsigned)q[0] | ((unsigned)q[136] << 16); o.y = (unsigned)q[2 * 136] | ((unsigned)q[3 * 136] << 16);
            o.z = (unsigned)q[4 * 136] | ((unsigned)q[5 * 136] << 16); o.w = (unsigned)q[6 * 136] | ((unsigned)q[7 * 136] << 16);
            *(uint4*)(dstT + d * 128 + shf * 64 + s8 * 8) = o;
          }
          __syncthreads();
        }
      }
    } else if (part == 4) {
      if (!isx) continue;
      for (int idx = t; idx < 512; idx += 256) {
        const int rl = idx >> 2, dc = idx & 3, row = row0 + rl, pos = row - seq_lo;
        const float rp = (float)(pos >> 6), cp = (float)(pos & 63);
        float cs[8], sn[8];
#pragma unroll
        for (int e = 0; e < 8; ++e) {
          const int a = dc * 8 + e;
          const float inv = powf(10000.f, -(float)(a & 15) / 16.f);
          const float ang = (a < 16 ? rp : cp) * inv;
          cs[e] = cosf(ang); sn[e] = sinf(ang);
        }
        for (int hq = 0; hq < 8; ++hq) {
          const bf16x8 x1 = *(const bf16x8*)(P + (size_t)row * PLD + 2048 + hq * 64 + dc * 8);
          const bf16x8 x2 = *(const bf16x8*)(P + (size_t)row * PLD + 2048 + hq * 64 + 32 + dc * 8);
          float o1[8], o2[8];
#pragma unroll
          for (int e = 0; e < 8; ++e) {
            const float a = bf2f((bf16_t)x1[e]), b = bf2f((bf16_t)x2[e]);
            o1[e] = (a * cs[e] - b * sn[e]) * 0.125f; o2[e] = (b * cs[e] + a * sn[e]) * 0.125f;
          }
          uint4 u1, u2;
          u1.x = pack2(o1[0], o1[1]); u1.y = pack2(o1[2], o1[3]); u1.z = pack2(o1[4], o1[5]); u1.w = pack2(o1[6], o1[7]);
          u2.x = pack2(o2[0], o2[1]); u2.y = pack2(o2[2], o2[3]); u2.z = pack2(o2[4], o2[5]); u2.w = pack2(o2[6], o2[7]);
          *(uint4*)(RQ + (size_t)row * 512 + hq * 64 + dc * 8) = u1;
          *(uint4*)(RQ + (size_t)row * 512 + hq * 64 + 32 + dc * 8) = u2;
        }
      }
    } else {
      for (int idx = t; idx < 512; idx += 256) {
        const int rl = idx >> 2, dc = idx & 3, row = row0 + rl, pos = row - seq_lo;
        const float rp = (float)(pos >> 6), cp = (float)(pos & 63);
        float cs[8], sn[8];
#pragma unroll
        for (int e = 0; e < 8; ++e) {
          const int a = dc * 8 + e;
          const float inv = powf(10000.f, -(float)(a & 15) / 16.f);
          const float ang = (a < 16 ? rp : cp) * inv;
          cs[e] = isx ? cosf(ang) : 1.f; sn[e] = isx ? sinf(ang) : 0.f;
        }
        for (int g = 0; g < 2; ++g) {
          const bf16x8 x1 = *(const bf16x8*)(P + (size_t)row * PLD + 2560 + g * 64 + dc * 8);
          const bf16x8 x2 = *(const bf16x8*)(P + (size_t)row * PLD + 2560 + g * 64 + 32 + dc * 8);
          float o1[8], o2[8];
#pragma unroll
          for (int e = 0; e < 8; ++e) {
            const float a = bf2f((bf16_t)x1[e]), b = bf2f((bf16_t)x2[e]);
            o1[e] = a * cs[e] - b * sn[e]; o2[e] = b * cs[e] + a * sn[e];
          }
          uint4 u1, u2;
          u1.x = pack2(o1[0], o1[1]); u1.y = pack2(o1[2], o1[3]); u1.z = pack2(o1[4], o1[5]); u1.w = pack2(o1[6], o1[7]);
          u2.x = pack2(o2[0], o2[1]); u2.y = pack2(o2[2], o2[3]); u2.z = pack2(o2[4], o2[5]); u2.w = pack2(o2[6], o2[7]);
          *(uint4*)(RK + (size_t)row * 128 + g * 64 + dc * 8) = u1;
          *(uint4*)(RK + (size_t)row * 128 + g * 64 + 32 + dc * 8) = u2;
        }
      }
      {
        const int col8 = t & 15, rsub = t >> 4;
        for (int i = 0; i < 8; ++i) {
          const int rl = rsub + 16 * i;
          *(uint4*)(T + rl * 136 + col8 * 8) = *(const uint4*)(P + (size_t)(row0 + rl) * PLD + 2688 + col8 * 8);
        }
        __syncthreads();
        const int d = t & 127, shf = t >> 7;
        const int b = isx ? (sc >> 6) : ((sc - 128) >> 1);
        const int pos0 = row0 - seq_lo;
        bf16_t* dst = isx ? AVTX + ((size_t)(b * 2 + (d >> 6)) * 64 + (d & 63)) * 8192 + pos0
                          : AVTC + ((size_t)(b * 2 + (d >> 6)) * 64 + (d & 63)) * 256 + pos0;
#pragma unroll
        for (int s8 = 0; s8 < 8; ++s8) {
          const bf16_t* q = T + (shf * 64 + s8 * 8) * 136 + d;
          uint4 o;
          o.x = (unsigned)q[0] | ((unsigned)q[136] << 16); o.y = (unsigned)q[2 * 136] | ((unsigned)q[3 * 136] << 16);
          o.z = (unsigned)q[4 * 136] | ((unsigned)q[5 * 136] << 16); o.w = (unsigned)q[6 * 136] | ((unsigned)q[7 * 136] << 16);
          *(uint4*)(dst + shf * 64 + s8 * 8) = o;
        }
        __syncthreads();
      }
    }
  }
}

DI void attn_item(const Params& p, int item) {
  const int g = item & 1, qb = (item >> 1) & 255, b = item >> 9;
  int t_ = tid();
  asm volatile("" : "+v"(t_));
  const int t = t_, lane = t & 63, w = t >> 6, r = lane & 31, hh = lane >> 5;
  const int hq = g * 4 + w, q0 = qb * 32;
  const bf16_t* RQ = (const bf16_t*)(p.ws + O_RQ); const bf16_t* RK = (const bf16_t*)(p.ws + O_RK);
  const bf16_t* AVTX = (const bf16_t*)(p.ws + O_AVTX); const bf16_t* AVTC = (const bf16_t*)(p.ws + O_AVTC);
  bf16_t* MIX = (bf16_t*)(p.ws + O_HA);
  const size_t qrow = (size_t)b * 8192 + q0 + r;
  bf16x8 qf[4];
#pragma unroll
  for (int ks = 0; ks < 4; ++ks) qf[ks] = ldfrag(RQ + qrow * 512 + hq * 64 + ks * 16 + hh * 8);
  float m = p.ab_sink[hq], l = hh == 0 ? 1.f : 0.f;
  f32x16 o0 = fzero(), o1 = fzero();
  const int ipos = q0 + r;
  const int lo = q0 - 128 < 0 ? 0 : q0 - 128, hi = q0 + 128 > 8192 - 32 ? 8192 - 32 : q0 + 128;
  const int nloc = ((hi - lo) >> 5) + 1, ntile = nloc + 8;
  const bf16_t* kloc = RK + (size_t)(b * 8192) * 128 + g * 64 + r * 128 + hh * 8;
  const bf16_t* kctx = RK + (size_t)(NTOK + b * 256) * 128 + g * 64 + r * 128 + hh * 8;
  const bf16_t* vloc = AVTX + (size_t)((b * 2 + g) * 64 + r) * 8192 + 4 * hh;
  const bf16_t* vctx = AVTC + (size_t)((b * 2 + g) * 64 + r) * 256 + 4 * hh;
  bf16x8 kf0, kf1, kf2, kf3, vf00, vf01, vf10, vf11;
#define ATT_LOAD(j_, K0, K1, K2, K3, V00, V01, V10, V11) { \
    const bool loc_ = (j_) < nloc; const int k0_ = loc_ ? lo + (j_) * 32 : ((j_) - nloc) * 32; \
    const bf16_t* kb_ = (loc_ ? kloc : kctx) + (size_t)k0_ * 128; \
    const bf16_t* vb_ = (loc_ ? vloc : vctx) + k0_; const int vs_ = (loc_ ? 8192 : 256) * 32; \
    K0 = ldfrag(kb_); K1 = ldfrag(kb_ + 16); K2 = ldfrag(kb_ + 32); K3 = ldfrag(kb_ + 48); \
    V00 = ldfrag2(vb_, vb_ + 8); V01 = ldfrag2(vb_ + 16, vb_ + 24); V10 = ldfrag2(vb_ + vs_, vb_ + vs_ + 8); V11 = ldfrag2(vb_ + vs_ + 16, vb_ + vs_ + 24); }
  ATT_LOAD(0, kf0, kf1, kf2, kf3, vf00, vf01, vf10, vf11)
#pragma unroll 1
  for (int tile = 0; tile < ntile; ++tile) {
    bf16x8 nk0 = kf0, nk1 = kf1, nk2 = kf2, nk3 = kf3, nv00 = vf00, nv01 = vf01, nv10 = vf10, nv11 = vf11;
    if (tile + 1 < ntile) ATT_LOAD(tile + 1, nk0, nk1, nk2, nk3, nv00, nv01, nv10, nv11)
    const bool local = tile < nloc;
    const int k0 = local ? lo + tile * 32 : (tile - nloc) * 32;
    f32x16 s = fzero();
    s = MFMA(kf0, qf[0], s); s = MFMA(kf1, qf[1], s); s = MFMA(kf2, qf[2], s); s = MFMA(kf3, qf[3], s);
    float tmax = -INFINITY;
#pragma unroll
    for (int i = 0; i < 16; ++i) {
      const int dj = ipos - (k0 + crow(i, hh));
      const bool ok = !local || (dj <= 128 && dj >= -128);
      s[i] = ok ? s[i] : -INFINITY;
      tmax = fmaxf(tmax, s[i]);
    }
    tmax = fmaxf(tmax, __shfl_xor(tmax, 32));
    const float mn = fmaxf(m, tmax), corr = __expf(m - mn);
    m = mn; l *= corr;
#pragma unroll
    for (int i = 0; i < 16; ++i) { o0[i] *= corr; o1[i] *= corr; }
#pragma unroll
    for (int i = 0; i < 16; ++i) { s[i] = __expf(s[i] - mn); l += s[i]; }
    const bf16x8 pf0 = pack8(s[0], s[1], s[2], s[3], s[4], s[5], s[6], s[7]);
    const bf16x8 pf1 = pack8(s[8], s[9], s[10], s[11], s[12], s[13], s[14], s[15]);
    o0 = MFMA(vf00, pf0, o0); o1 = MFMA(vf10, pf0, o1);
    o0 = MFMA(vf01, pf1, o0); o1 = MFMA(vf11, pf1, o1);
    kf0 = nk0; kf1 = nk1; kf2 = nk2; kf3 = nk3; vf00 = nv00; vf01 = nv01; vf10 = nv10; vf11 = nv11;
  }
#undef ATT_LOAD
  l += __shfl_xor(l, 32);
  const float inv = 1.f / l;
  bf16_t* dst = MIX + qrow * 1024 + 512 + hq * 64;
#pragma unroll
  for (int q4 = 0; q4 < 4; ++q4) {
    const int d = 8 * q4 + 4 * hh;
    uint2 u;
    u.x = pack2(o0[4 * q4] * inv, o0[4 * q4 + 1] * inv); u.y = pack2(o0[4 * q4 + 2] * inv, o0[4 * q4 + 3] * inv);
    *(uint2*)(dst + d) = u;
    u.x = pack2(o1[4 * q4] * inv, o1[4 * q4 + 1] * inv); u.y = pack2(o1[4 * q4 + 2] * inv, o1[4 * q4 + 3] * inv);
    *(uint2*)(dst + 32 + d) = u;
  }
}

DI void mlstm_local_item(const Params& p, int item, char* smem) {
  float* gs = (float*)smem;
  float* wv = gs + 512;
  float* msc = wv + 256;
  int t_ = tid();
  asm volatile("" : "+v"(t_));
  const int t = t_, lane = t & 63, w = t >> 6, wm = w >> 1, wn = w & 1, r = lane & 31, hh = lane >> 5;
  const int bh = item / NSTEP, nc = item % NSTEP, b = bh >> 2, h = bh & 3;
  const int sc = nc < 2 ? 128 + b * 2 + nc : b * 64 + (nc - 2);
  const int row0 = sc * 128;
  const float* GL = (const float*)(p.ws + O_GL);
  const bf16_t* KT = (const bf16_t*)(p.ws + O_KT) + (size_t)(sc * 4 + h) * 16384;
  const bf16_t* VT = (const bf16_t*)(p.ws + O_VT) + (size_t)(sc * 4 + h) * 16384;
  for (int i = t; i < 512; i += 256) { const int ty = i >> 7, s = i & 127; gs[i] = GL[(size_t)(row0 + s) * 16 + ty * 4 + h]; }
  __syncthreads();
  {
    const int dir = t >> 7, s = t & 127;
    float wval, tot = 0.f;
    if (dir == 0) {
      float bsum = 0.f;
      for (int j = 0; j < 128; ++j) { const float f = gs[128 + j]; tot += f; if (j <= s) bsum += f; }
      wval = tot - bsum + gs[s];
    } else {
      float pre = 0.f;
      for (int j = 0; j < 128; ++j) { const float f = gs[384 + j]; tot += f; if (j < s) pre += f; }
      wval = pre + gs[256 + s];
    }
    wv[dir * 128 + s] = wval;
    if (s == 0) msc[dir] = tot;
  }
  __syncthreads();
  {
    const int dir = t >> 7, s = t & 127;
    float mx = -INFINITY;
    for (int j = 0; j < 128; ++j) mx = fmaxf(mx, wv[dir * 128 + j]);
    const float wval = wv[dir * 128 + s];
    __syncthreads();
    wv[dir * 128 + s] = expf(wval - mx);
    if (s == 0) msc[2 + dir] = mx;
  }
  __syncthreads();
  float* DC = (float*)(p.ws + O_DC);
#pragma unroll 1
  for (int d = 0; d < 2; ++d) {
    f32x16 acc[2][2];
#pragma unroll
    for (int i = 0; i < 2; ++i)
#pragma unroll
      for (int j = 0; j < 2; ++j) acc[i][j] = fzero();
#pragma unroll 2
    for (int ks = 0; ks < 8; ++ks) {
      const bf16x8 ra0 = ldfrag(VT + (wm * 64 + r) * 128 + ks * 16 + hh * 8);
      const bf16x8 ra1 = ldfrag(VT + (wm * 64 + 32 + r) * 128 + ks * 16 + hh * 8);
      const bf16x8 b0 = ldfrag(KT + (wn * 64 + r) * 128 + ks * 16 + hh * 8);
      const bf16x8 b1 = ldfrag(KT + (wn * 64 + 32 + r) * 128 + ks * 16 + hh * 8);
      const float* ww = wv + d * 128 + ks * 16 + hh * 8;
      const bf16x8 a0 = pack8(bf2f((bf16_t)ra0[0]) * ww[0], bf2f((bf16_t)ra0[1]) * ww[1], bf2f((bf16_t)ra0[2]) * ww[2], bf2f((bf16_t)ra0[3]) * ww[3],
                              bf2f((bf16_t)ra0[4]) * ww[4], bf2f((bf16_t)ra0[5]) * ww[5], bf2f((bf16_t)ra0[6]) * ww[6], bf2f((bf16_t)ra0[7]) * ww[7]);
      const bf16x8 a1 = pack8(bf2f((bf16_t)ra1[0]) * ww[0], bf2f((bf16_t)ra1[1]) * ww[1], bf2f((bf16_t)ra1[2]) * ww[2], bf2f((bf16_t)ra1[3]) * ww[3],
                              bf2f((bf16_t)ra1[4]) * ww[4], bf2f((bf16_t)ra1[5]) * ww[5], bf2f((bf16_t)ra1[6]) * ww[6], bf2f((bf16_t)ra1[7]) * ww[7]);
      acc[0][0] = MFMA(a0, b0, acc[0][0]);
      acc[0][1] = MFMA(a0, b1, acc[0][1]);
      acc[1][0] = MFMA(a1, b0, acc[1][0]);
      acc[1][1] = MFMA(a1, b1, acc[1][1]);
    }
    float* dst = DC + ((size_t)(bh * 2 + d) * NSTEP + nc) * 16384;
#pragma unroll
    for (int mi = 0; mi < 2; ++mi)
#pragma unroll
      for (int ni = 0; ni < 2; ++ni)
#pragma unroll
        for (int i = 0; i < 16; ++i)
          dst[(wm * 64 + mi * 32 + crow(i, hh)) * 128 + wn * 64 + ni * 32 + r] = acc[mi][ni][i];
  }
  {
    const int dir = t >> 7, k = t & 127;
    float s = 0.f;
    for (int s8 = 0; s8 < 16; ++s8) {
      const bf16x8 v = ldfrag(KT + k * 128 + s8 * 8);
#pragma unroll
      for (int e = 0; e < 8; ++e) s += wv[dir * 128 + s8 * 8 + e] * bf2f((bf16_t)v[e]);
    }
    ((float*)(p.ws + O_DN))[((size_t)(bh * 2 + dir) * NSTEP + nc) * 128 + k] = s;
    if (k == 0) {
      ((float*)(p.ws + O_GSC))[(bh * 2 + dir) * NSTEP + nc] = msc[dir];
      ((float*)(p.ws + O_MLOC))[(bh * 2 + dir) * NSTEP + nc] = msc[2 + dir];
    }
  }
  __syncthreads();
}

DI int chain_nc(int dir, int i) { return dir == 0 ? i : (i < 2 ? 1 - i : 67 - i); }
template <int DIR>
DI void scan_chain_elems(const float* __restrict__ DCc, bf16_t* __restrict__ CSTc, const float* fa, const float* fb, int e, int epos) {
  float C = 0.f;
#pragma unroll
  for (int blk = 0; blk < 3; ++blk) {
    float v[22];
#pragma unroll
    for (int j = 0; j < 22; ++j) {
      const int i = blk * 22 + j;
      const int nc = DIR == 0 ? i : (i < 2 ? 1 - i : 67 - i);
      v[j] = DCc[(size_t)nc * 16384 + e];
    }
#pragma unroll
    for (int j = 0; j < 22; ++j) {
      const int i = blk * 22 + j;
      const int nc = DIR == 0 ? i : (i < 2 ? 1 - i : 67 - i);
      if (i >= 2) CSTc[(size_t)(nc - 2) * 16384 + epos] = f2bf(C);
      C = fa[i] * C + fb[i] * v[j];
    }
  }
}
DI void phase_scan(const Params& p, char* smem) {
  float* fa = (float*)smem;
  float* fb = fa + 66;
  const float* GSC = (const float*)(p.ws + O_GSC); const float* MLOC = (const float*)(p.ws + O_MLOC);
  const float* DC = (const float*)(p.ws + O_DC); const float* DN = (const float*)(p.ws + O_DN);
  bf16_t* CST = (bf16_t*)(p.ws + O_CST); float* NST = (float*)(p.ws + O_NST); float* MST = (float*)(p.ws + O_MST);
  const int t = tid();
  for (int item = blockIdx.x; item < 16 * 64 + 16; item += gridDim.x) {
    const int chain = item < 1024 ? (item >> 6) : (item - 1024), dir = chain & 1;
    __syncthreads();
    if (t < NSTEP) { const int nc = chain_nc(dir, t); fa[t] = GSC[chain * NSTEP + nc]; fb[t] = MLOC[chain * NSTEP + nc]; }
    __syncthreads();
    if (t == 0) {
      float m = 0.f;
      for (int i = 0; i < NSTEP; ++i) {
        if (i >= 2 && item >= 1024) MST[chain * 64 + chain_nc(dir, i) - 2] = m;
        const float g = fa[i], ml = fb[i];
        const float mn = fmaxf(g + m, ml);
        fa[i] = __expf(g + m - mn); fb[i] = __expf(ml - mn);
        m = mn;
      }
    }
    __syncthreads();
    if (item < 1024) {
      const int e = (item & 63) * 256 + t;
      const int ev = e >> 7, ek = e & 127;
      const int epos = ((((ev >> 5) * 8 + (ek >> 4)) * 64) + ((ek >> 3) & 1) * 32 + (ev & 31)) * 8 + (ek & 7);
      const float* DCc = DC + (size_t)chain * NSTEP * 16384;
      bf16_t* CSTc = CST + (size_t)chain * 64 * 16384;
      if (dir == 0) scan_chain_elems<0>(DCc, CSTc, fa, fb, e, epos);
      else scan_chain_elems<1>(DCc, CSTc, fa, fb, e, epos);
    } else if (t < 128) {
      const int k = t;
      float n = 0.f;
      for (int i = 0; i < NSTEP; ++i) {
        const int nc = chain_nc(dir, i);
        if (i >= 2) NST[((size_t)chain * 64 + (nc - 2)) * 128 + k] = n;
        n = fa[i] * n + fb[i] * DN[((size_t)chain * NSTEP + nc) * 128 + k];
      }
    }
  }
}

DI void mlstm_out_item(const Params& p, int item, char* smem) {
  float* gs = (float*)smem;
  float* bb = gs + 512;
  float* lib = bb + 256;
  float* mrow = lib + 256;
  float* aT = mrow + 256;
  float* nq = aT + 256;
  float* nst = nq + 256;
  char* sK = smem + 8192;
  char* sV = sK + 32768;
  int t_ = tid();
  asm volatile("" : "+v"(t_));
  const int t = t_, lane = t & 63, w = t >> 6, r = lane & 31, hh = lane >> 5;
  const int bh = item >> 6, c = item & 63, b = bh >> 2, h = bh & 3;
  const int sc = b * 64 + c, row0 = sc * 128;
  const float* GL = (const float*)(p.ws + O_GL);
  const bf16_t* Qc = (const bf16_t*)(p.ws + O_QC); const bf16_t* Kc = (const bf16_t*)(p.ws + O_KC);
  const bf16_t* VT = (const bf16_t*)(p.ws + O_VT) + (size_t)(sc * 4 + h) * 16384;
  const bf16_t* P = (const bf16_t*)(p.ws + O_P);
  const float* MST = (const float*)(p.ws + O_MST);
  bf16_t* MIX = (bf16_t*)(p.ws + O_HA);
#pragma unroll
  for (int i = 0; i < 8; ++i) {
    const int q = t + 256 * i, row = q >> 4, cc = q & 15;
    const int so = row * 256 + ((cc ^ (row & 15)) << 4);
    *(uint4*)(sK + so) = *(const uint4*)(Kc + (size_t)(row0 + row) * 512 + h * 128 + cc * 8);
    *(uint4*)(sV + so) = *(const uint4*)(VT + row * 128 + cc * 8);
  }
  for (int i = t; i < 512; i += 256) { const int ty = i >> 7, s = i & 127; gs[i] = GL[(size_t)(row0 + s) * 16 + ty * 4 + h]; }
  {
    const int dir = t >> 7, k = t & 127;
    nst[t] = ((const float*)(p.ws + O_NST))[((size_t)(bh * 2 + dir) * 64 + c) * 128 + k];
  }
  __syncthreads();
  {
    const int dir = t >> 7, s = t & 127;
    float bsum = 0.f;
    if (dir == 0) { for (int j = 0; j <= s; ++j) bsum += gs[128 + j]; }
    else { for (int j = s; j < 128; ++j) bsum += gs[384 + j]; }
    bb[t] = bsum;
    lib[t] = gs[dir * 256 + s] - bsum;
    const bf16_t* qr = Qc + (size_t)(row0 + s) * 512 + h * 128;
    float acc = 0.f;
    for (int k8 = 0; k8 < 16; ++k8) {
      const bf16x8 v = ldfrag(qr + k8 * 8);
#pragma unroll
      for (int e = 0; e < 8; ++e) acc += nst[dir * 128 + k8 * 8 + e] * bf2f((bf16_t)v[e]);
    }
    nq[t] = acc;
  }
  __syncthreads();
  {
    const int dir = t >> 7, s = t & 127;
    float pm = -INFINITY;
    if (dir == 0) { for (int j = 0; j <= s; ++j) pm = fmaxf(pm, lib[j]); }
    else { for (int j = s; j < 128; ++j) pm = fmaxf(pm, lib[128 + j]); }
    const float m_in = MST[(bh * 2 + dir) * 64 + c];
    const float mr = bb[t] + fmaxf(m_in, pm);
    mrow[t] = mr;
    aT[t] = expf(bb[t] + m_in - mr);
  }
  __syncthreads();
  const int tl = w * 32 + r;
  const bf16_t* qrow = Qc + (size_t)(row0 + tl) * 512 + h * 128 + hh * 8;
  bf16x8 qf[8];
#pragma unroll
  for (int ks = 0; ks < 8; ++ks) qf[ks] = ldfrag(qrow + ks * 16);
  const int swz = r & 15;
  const char* kp[8]; const char* vp[16];
#pragma unroll
  for (int ks = 0; ks < 8; ++ks) kp[ks] = sK + r * 256 + (((ks * 2 + hh) ^ swz) << 4);
#pragma unroll
  for (int cc = 0; cc < 16; ++cc) vp[cc] = sV + r * 256 + 8 * hh + ((cc ^ swz) << 4);
  float* Hb = (float*)(p.ws + O_DC) + (size_t)item * 16384 + tl;
  float* Hbh = Hb + 4 * hh * 128;
  f32x16 outa[4];
#define MLSTM_DIR(DIR)                                                                                                   \
  {                                                                                                                      \
    const bf16_t* CSTl = (const bf16_t*)(p.ws + O_CST) + ((size_t)(bh * 2 + DIR) * 64 + c) * 16384 + lane * 8;           \
    const float bbt = bb[DIR * 128 + tl], mrt = mrow[DIR * 128 + tl], at = aT[DIR * 128 + tl];                            \
    float dsum = 0.f;                                                                                                    \
    const float* libp = lib + DIR * 128 + 4 * hh;                                                                        \
    const int tb = tl - 4 * hh;                                                                                          \
    bf16x8 pf[8];                                                                                                        \
    _Pragma("unroll") for (int half = 0; half < 2; ++half) {                                                             \
      f32x16 st[2];                                                                                                      \
      st[0] = fzero(); st[1] = fzero();                                                                                  \
      _Pragma("unroll") for (int ks = 0; ks < 8; ++ks) {                                                                 \
        _Pragma("unroll") for (int r2 = 0; r2 < 2; ++r2)                                                                 \
          st[r2] = MFMA(*(const bf16x8*)(kp[ks] + (half * 2 + r2) * 8192), qf[ks], st[r2]);                              \
      }                                                                                                                  \
      _Pragma("unroll") for (int r2 = 0; r2 < 2; ++r2) {                                                                 \
        const int rb = half * 2 + r2;                                                                                    \
        _Pragma("unroll") for (int i = 0; i < 16; ++i) {                                                                 \
          const int sc_ = rb * 32 + (i & 3) + 8 * (i >> 2);                                           \
          const int diff = DIR == 0 ? (tb - sc_) : (sc_ - tb);                                                           \
          const float msk = (float)((unsigned)(~diff) >> 31);                                                            \
          const float v = st[r2][i] * __expf(fminf(bbt + libp[sc_] - mrt, 0.f)) * msk;                                    \
          st[r2][i] = v; dsum += v;                                                                                      \
        }                                                                                                                \
        pf[rb * 2] = pack8(st[r2][0], st[r2][1], st[r2][2], st[r2][3], st[r2][4], st[r2][5], st[r2][6], st[r2][7]);      \
        pf[rb * 2 + 1] = pack8(st[r2][8], st[r2][9], st[r2][10], st[r2][11], st[r2][12], st[r2][13], st[r2][14], st[r2][15]); \
      }                                                                                                                  \
      __builtin_amdgcn_sched_barrier(0);                                                                                 \
    }                                                                                                                    \
    dsum += __shfl_xor(dsum, 32);                                                                                        \
    const float den = dsum + at * nq[DIR * 128 + tl];                                                                    \
    const float dinv = 1.f / fmaxf(fabsf(den), expf(-mrt));                                                              \
    _Pragma("unroll") for (int half = 0; half < 2; ++half) {                                                             \
      f32x16 ha[2];                                                                                                      \
      ha[0] = fzero(); ha[1] = fzero();                                                                                  \
      _Pragma("unroll") for (int ks = 0; ks < 8; ++ks) {                                                                 \
        _Pragma("unroll") for (int r2 = 0; r2 < 2; ++r2)                                                                 \
          ha[r2] = MFMA(ldfrag(CSTl + ((half * 2 + r2) * 8 + ks) * 512), qf[ks], ha[r2]);                                \
        if (ks == 3) __builtin_amdgcn_sched_barrier(0);                                                                  \
      }                                                                                                                  \
      _Pragma("unroll") for (int r2 = 0; r2 < 2; ++r2)                                                                   \
        _Pragma("unroll") for (int i = 0; i < 16; ++i) ha[r2][i] *= at;                                                  \
      __builtin_amdgcn_sched_barrier(0);                                                                                 \
      _Pragma("unroll") for (int kk = 0; kk < 8; ++kk) {                                                                 \
        _Pragma("unroll") for (int r2 = 0; r2 < 2; ++r2) {                                                               \
          const s16x4 lo = *(const s16x4*)(vp[2 * kk] + (half * 2 + r2) * 8192);                                         \
          const s16x4 hi = *(const s16x4*)(vp[2 * kk + 1] + (half * 2 + r2) * 8192);                                     \
          ha[r2] = MFMA(__builtin_shufflevector(lo, hi, 0, 1, 2, 3, 4, 5, 6, 7), pf[kk], ha[r2]);                        \
        }                                                                                                                \
      }                                                                                                                  \
      _Pragma("unroll") for (int r2 = 0; r2 < 2; ++r2)                                                                   \
        _Pragma("unroll") for (int i = 0; i < 16; ++i) {                                                                 \
          float* hp = Hbh + ((half * 2 + r2) * 32 + (i & 3) + 8 * (i >> 2)) * 128;                                       \
          if (DIR == 0) *hp = ha[r2][i] * dinv;                                                                          \
          else outa[half * 2 + r2][i] = *hp + ha[r2][i] * dinv;                                                          \
        }                                                                                                                \
      __builtin_amdgcn_sched_barrier(0);                                                                                 \
    }                                                                                                                    \
  }
  MLSTM_DIR(0)
  MLSTM_DIR(1)
#undef MLSTM_DIR
  float ss = 0.f;
#pragma unroll
  for (int rb = 0; rb < 4; ++rb)
#pragma unroll
    for (int i = 0; i < 16; ++i) ss += outa[rb][i] * outa[rb][i];
  ss += __shfl_xor(ss, 32);
  const float rn = rsqrtf(ss * (1.f / 128.f) + EPS);
  const size_t row = (size_t)row0 + tl;
#pragma unroll
  for (int rb = 0; rb < 4; ++rb)
#pragma unroll
    for (int q4 = 0; q4 < 4; ++q4) {
      const int v = rb * 32 + 8 * q4 + 4 * hh;
      const s16x4 ov = *(const s16x4*)(P + row * PLD + 1536 + h * 128 + v);
      const float4 hg = *(const float4*)(p.ab_head_g + h * 128 + v);
      const float y0 = outa[rb][4 * q4] * rn * hg.x * sigmf(bf2f((bf16_t)ov[0]));
      const float y1 = outa[rb][4 * q4 + 1] * rn * hg.y * sigmf(bf2f((bf16_t)ov[1]));
      const float y2 = outa[rb][4 * q4 + 2] * rn * hg.z * sigmf(bf2f((bf16_t)ov[2]));
      const float y3 = outa[rb][4 * q4 + 3] * rn * hg.w * sigmf(bf2f((bf16_t)ov[3]));
      uint2 u; u.x = pack2(y0, y1); u.y = pack2(y2, y3);
      *(uint2*)(MIX + row * 1024 + h * 128 + v) = u;
    }
  __syncthreads();
}

DI void phase_topk(const Params& p, char* smem) {
  unsigned* vals = (unsigned*)smem;
  unsigned* hist = vals + 8448;
  unsigned* cntg = hist + 256;
  unsigned* cnte = cntg + 256;
  unsigned* misc = cnte + 256;
  const float* AFF = (const float*)(p.ws + O_AFF);
  int* IDX = (int*)(p.ws + O_IDX); float* GATE = (float*)(p.ws + O_GATE); int* INV = (int*)(p.ws + O_INV);
  const int t = tid();
  for (int item = blockIdx.x; item < 32; item += gridDim.x) {
    const float* a = AFF + (size_t)item * 8192;
    for (int i = t; i < 8192; i += 256) vals[i + (i >> 5)] = __float_as_uint(a[i]);
    unsigned prefix = 0, remaining = 1024;
    for (int pass = 0; pass < 4; ++pass) {
      const int shift = 24 - 8 * pass;
      hist[t] = 0;
      __syncthreads();
      const unsigned mask = pass == 0 ? 0u : (0xFFFFFFFFu << (shift + 8));
      for (int i = t; i < 8192; i += 256) {
        const unsigned u = vals[i + (i >> 5)];
        if ((u & mask) == (prefix & mask)) atomicAdd(&hist[(u >> shift) & 255], 1u);
      }
      __syncthreads();
      {
        unsigned above = 0;
        for (int bin = t + 1; bin < 256; ++bin) above += hist[bin];
        const unsigned mineh = hist[t];
        if (above < remaining && above + mineh >= remaining) {
          misc[0] = prefix | ((unsigned)t << shift);
          misc[1] = remaining - above;
        }
      }
      __syncthreads();
      prefix = misc[0]; remaining = misc[1];
      __syncthreads();
    }
    const unsigned T = prefix, need_eq = remaining;
    unsigned cg_ = 0, ce = 0;
    for (int j = 0; j < 32; ++j) {
      const int n = t * 32 + j;
      const unsigned u = vals[n + (n >> 5)];
      cg_ += u > T; ce += u == T;
    }
    cntg[t] = cg_; cnte[t] = ce;
    __syncthreads();
    unsigned pg = 0, pe = 0;
    for (int j = 0; j < t; ++j) { pg += cntg[j]; pe += cnte[j]; }
    for (int j = 0; j < 32; ++j) {
      const int n = t * 32 + j;
      const unsigned u = vals[n + (n >> 5)];
      if (u > T) { IDX[item * 1024 + pg] = n; GATE[item * 1024 + pg] = __uint_as_float(u); INV[((size_t)(item >> 4) * 8192 + n) * 16 + (item & 15)] = (int)pg + 1; ++pg; }
      else if (u == T) {
        if (pe < need_eq) { const unsigned slot = 1024 - need_eq + pe; IDX[item * 1024 + slot] = n; GATE[item * 1024 + slot] = __uint_as_float(u); INV[((size_t)(item >> 4) * 8192 + n) * 16 + (item & 15)] = (int)slot + 1; }
        ++pe;
      }
    }
    __syncthreads();
  }
}

DI void phase_stats(const Params& p, char* smem) {
  float* red = (float*)smem;
  const bf16_t* GVT = (const bf16_t*)(p.ws + O_GVT);
  float* PART = (float*)(p.ws + O_STATS);
  const int t = tid(), qq = t & 31, cg_ = t >> 5;
  for (int item = blockIdx.x; item < 1024; item += gridDim.x) {
    const int chunk = item >> 3, cgrp = item & 7;
    const bf16_t* base = GVT + ((size_t)chunk * 2048 + cgrp * 256) * 128 + qq * 4;
    float s[4] = {0.f, 0.f, 0.f, 0.f}, s2[4] = {0.f, 0.f, 0.f, 0.f};
#pragma unroll 8
    for (int c = cg_; c < 256; c += 8) {
      const s16x4 v = *(const s16x4*)(base + (size_t)c * 128);
#pragma unroll
      for (int e = 0; e < 4; ++e) { const float f = bf2f((bf16_t)v[e]); s[e] += f; s2[e] += f * f; }
    }
#pragma unroll
    for (int e = 0; e < 4; ++e) { red[(cg_ * 128 + qq * 4 + e) * 2] = s[e]; red[(cg_ * 128 + qq * 4 + e) * 2 + 1] = s2[e]; }
    __syncthreads();
    if (t < 128) {
      float a = 0.f, b2 = 0.f;
      for (int g = 0; g < 8; ++g) { a += red[(g * 128 + t) * 2]; b2 += red[(g * 128 + t) * 2 + 1]; }
      PART[((size_t)item * 128 + t) * 2] = a;
      PART[((size_t)item * 128 + t) * 2 + 1] = b2;
    }
    __syncthreads();
  }
}
DI void phase_spatial(const Params& p, char* smem) {
  float* smu = (float*)smem;
  float* srs = smu + 128;
  const bf16_t* GVT = (const bf16_t*)(p.ws + O_GVT); const bf16_t* U = (const bf16_t*)(p.ws + O_U);
  const float* PART = (const float*)(p.ws + O_STATS);
  bf16_t* UV = (bf16_t*)(p.ws + O_UV);
  for (int item = blockIdx.x; item < 1024; item += gridDim.x) {
    int t_ = tid();
    const int t = t_, lane = t & 63, w = t >> 6, r = lane & 31, hh = lane >> 5;
    const int chunk = item >> 3, g = item & 7;
    if (t < 128) {
      float a = 0.f, b2 = 0.f;
#pragma unroll
      for (int j = 0; j < 8; ++j) { a += PART[((size_t)(chunk * 8 + j) * 128 + t) * 2]; b2 += PART[((size_t)(chunk * 8 + j) * 128 + t) * 2 + 1]; }
      const float mu = a * (1.f / 2048.f);
      const float var = fmaxf(b2 * (1.f / 2048.f) - mu * mu, 0.f);
      smu[t] = mu; srs[t] = rsqrtf(var + EPS);
    }
    __syncthreads();
    const float* Ws = p.gm_w_s + (size_t)g * 16384;
    f32x16 acc[2][4];
#pragma unroll
    for (int i = 0; i < 4; ++i) { acc[0][i] = fzero(); acc[1][i] = fzero(); }
    const int cA = g * 256 + w * 64 + r, cB = cA + 32;
    const float lgA = p.gm_ln_g[cA], lbA = p.gm_ln_b[cA], lgB = p.gm_ln_g[cB], lbB = p.gm_ln_b[cB];
    const bf16_t* vA = GVT + ((size_t)chunk * 2048 + cA) * 128 + hh * 8;
    const bf16_t* vB = GVT + ((size_t)chunk * 2048 + cB) * 128 + hh * 8;
    for (int ks = 0; ks < 8; ++ks) {
      const bf16x8 ra = ldfrag(vA + ks * 16), rbv = ldfrag(vB + ks * 16);
      const float* mu = smu + ks * 16 + hh * 8; const float* rs = srs + ks * 16 + hh * 8;
      const bf16x8 aA = pack8((bf2f((bf16_t)ra[0]) - mu[0]) * rs[0] * lgA + lbA, (bf2f((bf16_t)ra[1]) - mu[1]) * rs[1] * lgA + lbA,
                              (bf2f((bf16_t)ra[2]) - mu[2]) * rs[2] * lgA + lbA, (bf2f((bf16_t)ra[3]) - mu[3]) * rs[3] * lgA + lbA,
                              (bf2f((bf16_t)ra[4]) - mu[4]) * rs[4] * lgA + lbA, (bf2f((bf16_t)ra[5]) - mu[5]) * rs[5] * lgA + lbA,
                              (bf2f((bf16_t)ra[6]) - mu[6]) * rs[6] * lgA + lbA, (bf2f((bf16_t)ra[7]) - mu[7]) * rs[7] * lgA + lbA);
      const bf16x8 aB = pack8((bf2f((bf16_t)rbv[0]) - mu[0]) * rs[0] * lgB + lbB, (bf2f((bf16_t)rbv[1]) - mu[1]) * rs[1] * lgB + lbB,
                              (bf2f((bf16_t)rbv[2]) - mu[2]) * rs[2] * lgB + lbB, (bf2f((bf16_t)rbv[3]) - mu[3]) * rs[3] * lgB + lbB,
                              (bf2f((bf16_t)rbv[4]) - mu[4]) * rs[4] * lgB + lbB, (bf2f((bf16_t)rbv[5]) - mu[5]) * rs[5] * lgB + lbB,
                              (bf2f((bf16_t)rbv[6]) - mu[6]) * rs[6] * lgB + lbB, (bf2f((bf16_t)rbv[7]) - mu[7]) * rs[7] * lgB + lbB);
#pragma unroll
      for (int pb = 0; pb < 4; ++pb) {
        const float* wp = Ws + (pb * 32 + r) * 128 + ks * 16 + hh * 8;
        const float4 w0 = *(const float4*)wp, w1 = *(const float4*)(wp + 4);
        const bf16x8 bw = pack8(w0.x, w0.y, w0.z, w0.w, w1.x, w1.y, w1.z, w1.w);
        acc[0][pb] = MFMA(aA, bw, acc[0][pb]);
        acc[1][pb] = MFMA(aB, bw, acc[1][pb]);
      }
    }
#pragma unroll
    for (int pb = 0; pb < 4; ++pb) {
      const int pp = pb * 32 + r;
      const float bs = p.gm_b_s[g * 128 + pp];
      const size_t rowo = ((size_t)chunk * 128 + pp) * 2048 + g * 256 + w * 64 + 4 * hh;
#pragma unroll
      for (int cb = 0; cb < 2; ++cb)
#pragma unroll
        for (int q4 = 0; q4 < 4; ++q4) {
          const size_t o = rowo + cb * 32 + 8 * q4;
          const s16x4 uu = *(const s16x4*)(U + o);
          uint2 st;
          st.x = pack2(bf2f((bf16_t)uu[0]) * (acc[cb][pb][4 * q4] + bs), bf2f((bf16_t)uu[1]) * (acc[cb][pb][4 * q4 + 1] + bs));
          st.y = pack2(bf2f((bf16_t)uu[2]) * (acc[cb][pb][4 * q4 + 2] + bs), bf2f((bf16_t)uu[3]) * (acc[cb][pb][4 * q4 + 3] + bs));
          *(uint2*)(UV + o) = st;
        }
    }
    __syncthreads();
  }
}

struct EpiBf16 {
  bf16_t* dst; int ld;
  DI void operator()(f32x16 (&acc)[2][2], int mb, int nb, int r, int hh) const {
#pragma unroll
    for (int mi = 0; mi < 2; ++mi)
#pragma unroll
      for (int ni = 0; ni < 2; ++ni)
#pragma unroll
        for (int i = 0; i < 16; ++i)
          dst[(size_t)(mb + mi * 32 + crow(i, hh)) * ld + nb + ni * 32 + r] = f2bf(acc[mi][ni][i]);
  }
};
struct EpiRes {
  float* out; const float* base; const float* gate;
  DI void operator()(f32x16 (&acc)[2][2], int mb, int nb, int r, int hh) const {
#pragma unroll
    for (int ni = 0; ni < 2; ++ni) {
      const int n = nb + ni * 32 + r;
      const float gt = gate[n];
#pragma unroll
      for (int mi = 0; mi < 2; ++mi) {
        const size_t o0 = (size_t)(mb + mi * 32 + 4 * hh) * 1024 + n;
        float* op = out + o0; const float* bp = base + o0;
#pragma unroll
        for (int i = 0; i < 16; ++i) {
          const int off = ((i & 3) + 8 * (i >> 2)) * 1024;
          op[off] = bp[off] + gt * acc[mi][ni][i];
        }
        __builtin_amdgcn_sched_barrier(0);
      }
    }
  }
};
struct EpiGelu {
  bf16_t* U; bf16_t* GVT; int m0, n0;
  DI void operator()(f32x16 (&acc)[2][2], int mb, int nb, int r, int hh) const {
    if (n0 < 2048) {
#pragma unroll
      for (int mi = 0; mi < 2; ++mi)
#pragma unroll
        for (int ni = 0; ni < 2; ++ni)
#pragma unroll
          for (int i = 0; i < 16; ++i)
            U[(size_t)(m0 + mb + mi * 32 + crow(i, hh)) * 2048 + n0 + nb + ni * 32 + r] = f2bf(geluf(acc[mi][ni][i]));
    } else {
      const int chunk = m0 >> 7;
#pragma unroll
      for (int mi = 0; mi < 2; ++mi)
#pragma unroll
        for (int ni = 0; ni < 2; ++ni) {
          const int cc = n0 - 2048 + nb + ni * 32 + r;
          bf16_t* d = GVT + ((size_t)chunk * 2048 + cc) * 128 + mb + mi * 32 + 4 * hh;
#pragma unroll
          for (int q4 = 0; q4 < 4; ++q4) {
            uint2 u;
            u.x = pack2(geluf(acc[mi][ni][4 * q4]), geluf(acc[mi][ni][4 * q4 + 1]));
            u.y = pack2(geluf(acc[mi][ni][4 * q4 + 2]), geluf(acc[mi][ni][4 * q4 + 3]));
            *(uint2*)(d + 8 * q4) = u;
          }
        }
    }
  }
};
struct EpiSwiglu {
  bf16_t* hid;
  DI void operator()(f32x16 (&acc)[2][2], int mb, int nb, int r, int hh) const {
    const int f = (nb >> 1) + r;
#pragma unroll
    for (int mi = 0; mi < 2; ++mi)
#pragma unroll
      for (int i = 0; i < 16; ++i) {
        const float gv = acc[mi][0][i], uv = acc[mi][1][i];
        hid[(size_t)(mb + mi * 32 + crow(i, hh)) * 1024 + f] = f2bf(siluf(gv) * uv);
      }
  }
};
struct EpiMoeOut {
  float* out; const int* idx; const float* gate; const float* gt2;
  int n0;
  DI void operator()(f32x16 (&acc)[2][2], int mb, int nb, int r, int hh) const {
#pragma unroll
    for (int mi = 0; mi < 2; ++mi)
#pragma unroll
      for (int i = 0; i < 16; ++i) {
        const int slot = mb + mi * 32 + crow(i, hh);
        const int tok = idx[slot];
        const float gs = gate[slot];
#pragma unroll
        for (int ni = 0; ni < 2; ++ni) {
          const int n = nb + ni * 32 + r;
          unsafeAtomicAdd(out + (size_t)tok * 1024 + n0 + n, gt2[n] * gs * acc[mi][ni][i]);
        }
      }
  }
};

DI void phase_moe1(const Params& p, char* smem) {
  const bf16_t* HA = (const bf16_t*)(p.ws + O_HA); const bf16_t* WGU = (const bf16_t*)(p.ws + O_MGU);
  const int* IDX = (const int*)(p.ws + O_IDX); bf16_t* HID = (bf16_t*)(p.ws + O_HID);
  const int t = tid(), lrow = t >> 3, lcol = (t & 7) * 8;
  for (TileWalk tw(256 * 16, smem); tw.valid(); tw.next()) {
    int mg, nt; tw.get(8, 8, 2, mg, nt);
    const int e = mg >> 4, b = (mg >> 3) & 1, mt = mg & 7, be = b * 16 + e;
    const bf16_t* ap[4]; const bf16_t* bp[4];
#pragma unroll
    for (int i = 0; i < 4; ++i) {
      const int tok = IDX[be * 1024 + mt * 128 + lrow + 32 * i];
      ap[i] = HA + ((size_t)b * 8192 + tok) * 1024 + lcol;
      bp[i] = WGU + ((size_t)e * 2048 + nt * 128 + lrow + 32 * i) * 1024 + lcol;
    }
    gemm_tile(ap, bp, 1024, smem, EpiSwiglu{HID + ((size_t)be * 1024 + mt * 128) * 1024 + nt * 64});
  }
}
DI void phase_moe2(const Params& p, int layer, char* smem) {
  const bf16_t* HID = (const bf16_t*)(p.ws + O_HID); const bf16_t* WD = (const bf16_t*)(p.ws + O_MD);
  const int* IDX = (const int*)(p.ws + O_IDX); const float* GATE = (const float*)(p.ws + O_GATE);
  const float* modv = (const float*)(p.ws + O_MODV);
  const int t = tid(), lrow = t >> 3, lcol = (t & 7) * 8;
  for (TileWalk tw(256 * 8, smem); tw.valid(); tw.next()) {
    int mg, nt; tw.get(8, 8, 1, mg, nt);
    const int e = mg >> 4, b = (mg >> 3) & 1, mt = mg & 7, be = b * 16 + e;
    const bf16_t* ap[4]; const bf16_t* bp[4];
#pragma unroll
    for (int i = 0; i < 4; ++i) {
      ap[i] = HID + ((size_t)be * 1024 + mt * 128 + lrow + 32 * i) * 1024 + lcol;
      bp[i] = WD + ((size_t)e * 1024 + nt * 128 + lrow + 32 * i) * 1024 + lcol;
    }
    gemm_tile(ap, bp, 1024, smem, EpiBf16{(bf16_t*)(p.ws + O_YE) + ((size_t)be * 1024 + mt * 128) * 1024 + nt * 128, 1024});
  }
}

DI void phase_final(const Params& p) {
  const int t = tid(), lane = t & 63, w = t >> 6;
  for (int row = blockIdx.x * 4 + w; row < NTOK; row += gridDim.x * 4) {
    float* src = p.out + (size_t)row * 1024;
    float4 xv[4]; float ss = 0.f;
#pragma unroll
    for (int i = 0; i < 4; ++i) xv[i] = *(const float4*)(src + (i * 64 + lane) * 4);
    {
      float4 ca[4];
      moe_combine_row(p, row, lane, ca);
      const float* g2 = (const float*)(p.ws + O_MODV) + (1 * 3 + (row >> 13)) * 6144 + 5 * 1024;
#pragma unroll
      for (int i = 0; i < 4; ++i) {
        const float4 gg = *(const float4*)(g2 + (i * 64 + lane) * 4);
        xv[i].x += gg.x * ca[i].x; xv[i].y += gg.y * ca[i].y; xv[i].z += gg.z * ca[i].z; xv[i].w += gg.w * ca[i].w;
      }
    }
#pragma unroll
    for (int i = 0; i < 4; ++i) ss += xv[i].x * xv[i].x + xv[i].y * xv[i].y + xv[i].z * xv[i].z + xv[i].w * xv[i].w;
    ss = wsum(ss);
    const float rstd = rsqrtf(ss * (1.f / 1024.f) + EPS);
#pragma unroll
    for (int i = 0; i < 4; ++i) {
      const int col = (i * 64 + lane) * 4;
      const float4 g4 = *(const float4*)(p.final_norm_g + col);
      float4 y; y.x = xv[i].x * rstd * g4.x; y.y = xv[i].y * rstd * g4.y; y.z = xv[i].z * rstd * g4.z; y.w = xv[i].w * rstd * g4.w;
      *(float4*)(src + col) = y;
    }
  }
}

constexpr int NPHASE = 22;
DI void run_phase(const Params& p, int ph, char* smem) {
  const float* modv = (const float*)(p.ws + O_MODV);
  switch (ph) {
#if !defined(ONLY) || ONLY == 0
    case 0:
      phase_adaln(p, smem);
      __syncthreads();
      tconv(p.ab_w_in, 2832, 2832, 1024, 1, 0, (bf16_t*)(p.ws + O_WIN), 0, 1, smem);
      tconv(p.ab_w_out, 1024, 1024, 1024, 1, 0, (bf16_t*)(p.ws + O_WOUT), 0, 0, smem);
      tconv(p.gm_w_in, 4096, 4096, 1024, 1, 0, (bf16_t*)(p.ws + O_GMIN), 0, 0, smem);
      tconv(p.gm_w_out, 1024, 1024, 2048, 1, 0, (bf16_t*)(p.ws + O_GMOUT), 0, 0, smem);
      tconv_moe(p, 0, smem);
      break;
#endif
#if !defined(ONLY) || ONLY == 1
    case 1: phase_modulate<1, false>(p, 0, 0, smem); break;
#endif
#if !defined(ONLY) || ONLY == 2
    case 2:
      gemm_dense((const bf16_t*)(p.ws + O_HA), (const bf16_t*)(p.ws + O_WIN), NROW, PLD, 1024, 6, 11, smem,
                 [&](int m0, int n0) { return EpiBf16{(bf16_t*)(p.ws + O_P) + (size_t)m0 * PLD + n0, PLD}; });
      break;
#endif
#if !defined(ONLY) || ONLY == 3
    case 3: phase_prep2(p, smem); break;
#endif
#if !defined(ONLY) || ONLY == 4
    case 4:
      for (int item = blockIdx.x; item < 1024 + 8 * NSTEP; item += gridDim.x) {
        if (item < 1024) attn_item(p, item); else mlstm_local_item(p, item - 1024, smem);
      }
      break;
#endif
#if !defined(ONLY) || ONLY == 5
    case 5: phase_scan(p, smem); break;
#endif
#if !defined(ONLY) || ONLY == 6
    case 6:
      for (int item = blockIdx.x; item < 512; item += gridDim.x) mlstm_out_item(p, item, smem);
      break;
#endif
#if !defined(ONLY) || ONLY == 7
    case 7:
      gemm_dense((const bf16_t*)(p.ws + O_HA), (const bf16_t*)(p.ws + O_WOUT), NTOK, 1024, 1024, 8, 8, smem,
                 [&](int m0, int n0) {
                   return EpiRes{p.out + (size_t)m0 * 1024 + n0, p.x + (size_t)m0 * 1024 + n0, modv + (0 * 3 + (m0 >> 13)) * 6144 + 2 * 1024 + n0};
                 });
      break;
#endif
#if !defined(ONLY) || ONLY == 8
    case 8: phase_modulate<2, false>(p, 0, 1, smem); break;
#endif
#if !defined(ONLY) || ONLY == 9
    case 9: phase_topk(p, smem); break;
#endif
#if !defined(ONLY) || ONLY == 10
    case 10: phase_moe1(p, smem); break;
#endif
#if !defined(ONLY) || ONLY == 11
    case 11: phase_moe2(p, 0, smem); break;
#endif
#if !defined(ONLY) || ONLY == 12
    case 12:
      phase_modulate<0, true>(p, 1, 0, smem);
      __syncthreads();
      tconv_moe(p, 1, smem);
      break;
#endif
#if !defined(ONLY) || ONLY == 13
    case 13:
      gemm_dense((const bf16_t*)(p.ws + O_HA), (const bf16_t*)(p.ws + O_GMIN), NTOK, 4096, 1024, 8, 8, smem,
                 [&](int m0, int n0) { return EpiGelu{(bf16_t*)(p.ws + O_U), (bf16_t*)(p.ws + O_GVT), m0, n0}; });
      break;
#endif
#if !defined(ONLY) || ONLY == 14
    case 14: phase_stats(p, smem); break;
#endif
#if !defined(ONLY) || ONLY == 15
    case 15: phase_spatial(p, smem); break;
#endif
#if !defined(ONLY) || ONLY == 16
    case 16:
      gemm_dense((const bf16_t*)(p.ws + O_UV), (const bf16_t*)(p.ws + O_GMOUT), NTOK, 1024, 2048, 8, 8, smem,
                 [&](int m0, int n0) {
                   return EpiRes{p.out + (size_t)m0 * 1024 + n0, p.out + (size_t)m0 * 1024 + n0, modv + (1 * 3 + (m0 >> 13)) * 6144 + 2 * 1024 + n0};
                 });
      break;
#endif
#if !defined(ONLY) || ONLY == 17
    case 17: phase_modulate<2, false>(p, 1, 1, smem); break;
#endif
#if !defined(ONLY) || ONLY == 18
    case 18: phase_topk(p, smem); break;
#endif
#if !defined(ONLY) || ONLY == 19
    case 19: phase_moe1(p, smem); break;
#endif
#if !defined(ONLY) || ONLY == 20
    case 20: phase_moe2(p, 1, smem); break;
#endif
#if !defined(ONLY) || ONLY == 21
    case 21: phase_final(p); break;
#endif
    default: break;
  }
}

#define XB_TMO      128
#define XB_XCNT(j)  (256  + 64 * (j))
#define XB_XSUB(j)  (1280 + 64 * (j))
#define XB_XGEN(j)  (2304 + 64 * (j))
#define XB_TOP      3328
#define XB_TOPGEN   3392
#define XCD_BAR_WORDS 3456
#define XB_SPIN_CAP (1u << 18)
#define LAS __attribute__((address_space(3)))
DI unsigned xb_ld(unsigned* p) { return __hip_atomic_load(p, __ATOMIC_RELAXED, __HIP_MEMORY_SCOPE_AGENT); }
DI unsigned xb_add(unsigned* p, unsigned v) { return __hip_atomic_fetch_add(p, v, __ATOMIC_RELAXED, __HIP_MEMORY_SCOPE_AGENT); }
DI unsigned xb_xcc_id() { return (unsigned)__builtin_amdgcn_s_getreg((3 << 11) | 20) & 0xFu; }
#define XB_SPIN(cond, bar) do { unsigned _sp = 0; while (cond) { __builtin_amdgcn_s_sleep(1); \
    if ((++_sp & 255u) == 0u) { if (xb_ld(&(bar)[XB_TMO])) break; if (_sp > XB_SPIN_CAP) { atomicAdd(&(bar)[XB_TMO], 1u); break; } } } } while (0)
struct XcdBarrier { unsigned* bar; unsigned x; volatile LAS unsigned* st; };
DI XcdBarrier xcd_barrier_post(unsigned* bar, volatile LAS unsigned* st) {
  XcdBarrier b; b.bar = bar; b.x = xb_xcc_id(); b.st = st;
  if (threadIdx.x == 0) st[3] = xb_add(&bar[XB_XCNT(b.x)], 1u);
  return b;
}
DI void xcd_barrier_complete(unsigned* bar, unsigned x, unsigned& nloc, unsigned& nx, unsigned& sbefore) {
  const unsigned G = gridDim.x * gridDim.y * gridDim.z;
  unsigned sum, cnt, mine, sp = 0u, sb = 0u;
  for (;;) {
    sum = 0u; cnt = 0u; mine = 0u; sb = 0u;
#pragma unroll
    for (unsigned j = 0; j < 16; ++j) { const unsigned c = xb_ld(&bar[XB_XCNT(j)]); sum += c; cnt += (c > 0u) ? 1u : 0u; mine = (j == x) ? c : mine; sb += (j < x) ? c : 0u; }
    if (sum == G) break;
    __builtin_amdgcn_s_sleep(1);
    if ((++sp & 255u) == 0u) { if (xb_ld(&bar[XB_TMO])) break; if (sp > XB_SPIN_CAP) { atomicAdd(&bar[XB_TMO], 1u); break; } }
  }
  nloc = mine > 0u ? mine : 1u; nx = cnt > 0u ? cnt : 1u; sbefore = sb;
}
DI void xcd_barrier(const XcdBarrier& b) {
  asm volatile("s_waitcnt vmcnt(0)" ::: "memory");
  __syncthreads();
  if (threadIdx.x == 0) {
    unsigned* bar = b.bar;
    __builtin_amdgcn_s_waitcnt(0);
    unsigned nloc = b.st[0], nx = b.st[1];
    if (nloc == 0u) { unsigned sbf; xcd_barrier_complete(bar, b.x, nloc, nx, sbf); b.st[0] = nloc; b.st[1] = nx; b.st[2] = sbf; }
    const unsigned old = xb_add(&bar[XB_XSUB(b.x)], 1u);
    const unsigned gen = old / nloc;
    if (old + 1u == (gen + 1u) * nloc) {
      __builtin_amdgcn_fence(__ATOMIC_RELEASE, "agent");
      asm volatile("s_waitcnt vmcnt(0)" ::: "memory");
      const unsigned og = xb_add(&bar[XB_TOP], 1u);
      const unsigned tg = og / nx;
      if (og + 1u == (tg + 1u) * nx) xb_add(&bar[XB_TOPGEN], 1u);
      else XB_SPIN(xb_ld(&bar[XB_TOPGEN]) == tg, bar);
      __builtin_amdgcn_fence(__ATOMIC_ACQUIRE, "agent");
      xb_add(&bar[XB_XGEN(b.x)], 1u);
      asm volatile("s_waitcnt vmcnt(0)" ::: "memory");
    } else {
      XB_SPIN(xb_ld(&bar[XB_XGEN(b.x)]) == gen, bar);
      __builtin_amdgcn_fence(__ATOMIC_ACQUIRE, "agent");
      asm volatile("s_waitcnt vmcnt(0)" ::: "memory");
    }
  }
  __syncthreads();
}

DI Params kargs() {
  Params P{};
#if defined(__HIP_DEVICE_COMPILE__)
  typedef const unsigned long long __attribute__((address_space(4))) CU;
  CU* q = (CU*)__builtin_amdgcn_kernarg_segment_ptr();
  asm volatile("" : "+s"(q));
#define GP(T, i) ((T*)(T __attribute__((address_space(1)))*)(q[i]))
  P.x = GP(const float, 0);
  P.c = GP(const float, 1);
  P.ctx = GP(const float, 2);
  P.c_ctx = GP(const float, 3);
  P.w_mod = GP(const float, 4);
  P.b_mod = GP(const float, 5);
  P.norm_mix_g = GP(const float, 6);
  P.norm_ffn_g = GP(const float, 7);
  P.final_norm_g = GP(const float, 8);
  P.ab_w_in = GP(const float, 9);
  P.ab_conv_w = GP(const float, 10);
  P.ab_gate_b = GP(const float, 11);
  P.ab_head_g = GP(const float, 12);
  P.ab_sink = GP(const float, 13);
  P.ab_w_out = GP(const float, 14);
  P.gm_w_in = GP(const float, 15);
  P.gm_ln_g = GP(const float, 16);
  P.gm_ln_b = GP(const float, 17);
  P.gm_w_s = GP(const float, 18);
  P.gm_b_s = GP(const float, 19);
  P.gm_w_out = GP(const float, 20);
  P.moe_w_router = GP(const float, 21);
  P.moe_w_gate = GP(const float, 22);
  P.moe_w_up = GP(const float, 23);
  P.moe_w_down = GP(const float, 24);
  P.out = GP(float, 25);
  P.ws = GP(char, 26);
#undef GP
#endif
  return P;
}
#if COOP
#ifndef REPEAT_MASK
#define REPEAT_MASK 0
#endif
__global__ void __launch_bounds__(256, 2) mega(Params p_unused) {
  __shared__ __attribute__((aligned(16))) char smem[73728 + 16];
  unsigned* xbw = (unsigned*)(smem + 73728);
  cg::grid_group grid = cg::this_grid();
  if (threadIdx.x < 4) xbw[threadIdx.x] = 0u;
  __syncthreads();
  XcdBarrier xb;
  { const Params pp = kargs(); xb = xcd_barrier_post((unsigned*)(pp.ws + O_BAR), (volatile LAS unsigned*)xbw); }
#define PHX(n) { const Params pp = kargs(); run_phase(pp, n, smem); } xcd_barrier(xb); \
  if ((REPEAT_MASK >> n) & 1) { { const Params pp = kargs(); run_phase(pp, n, smem); } xcd_barrier(xb); }
  { const Params pp = kargs(); run_phase(pp, 0, smem); }
  grid.sync();
  PHX(1) PHX(2) PHX(3) PHX(4) PHX(5) PHX(6) PHX(7) PHX(8) PHX(9) PHX(10)
  PHX(11) PHX(12) PHX(13) PHX(14) PHX(15) PHX(16) PHX(17) PHX(18) PHX(19) PHX(20)
  { const Params pp = kargs(); run_phase(pp, 21, smem); }
}
#else
__global__ void __launch_bounds__(256, 2) mega(Params p, int ph) {
  __shared__ __attribute__((aligned(16))) char smem[73728];
  run_phase(p, ph, smem);
}
#endif

extern "C" void kernel_launch(void* const* d_in, const int* in_sizes, int n_in, void* d_out, int out_size, void* d_ws,
                              size_t ws_size, hipStream_t stream) {
  (void)in_sizes; (void)n_in; (void)out_size;
  if (ws_size < WS_NEED) { fprintf(stderr, "workspace too small: %zu < %zu\n", ws_size, (size_t)WS_NEED); return; }
  static int grid_blocks = 0;
  if (!grid_blocks) {
    int dev = 0, cus = 0, per_cu = 0;
    hipGetDevice(&dev);
    hipDeviceGetAttribute(&cus, hipDeviceAttributeMultiprocessorCount, dev);
    hipOccupancyMaxActiveBlocksPerMultiprocessor(&per_cu, mega, 256, 0);
    if (per_cu < 1) per_cu = 1;
    if (per_cu > 2) per_cu = 2;
    grid_blocks = cus * per_cu;
  }
  Params p{};
  const float** f = (const float**)&p;
  for (int i = 0; i < 25; ++i) f[i] = (const float*)d_in[i];
  p.out = (float*)d_out;
  p.ws = (char*)d_ws;
#if COOP
  hipMemsetAsync((char*)d_ws + O_BAR, 0, XCD_BAR_WORDS * 4, stream);
  void* args[] = {&p};
  hipError_t e = hipLaunchCooperativeKernel((void*)mega, dim3(grid_blocks), dim3(256), args, 0, stream);
  if (e != hipSuccess) fprintf(stderr, "cooperative launch failed: %s (grid %d)\n", hipGetErrorString(e), grid_blocks);
#else
  for (int ph = 0; ph < NPHASE; ++ph) hipLaunchKernelGGL(mega, dim3(grid_blocks), dim3(256), 0, stream, p, ph);
#endif
}
```

```cpp
#include <hip/hip_runtime.h>
#include <hip/hip_cooperative_groups.h>
#include <cstdio>
namespace cg = cooperative_groups;

#define DI __device__ __forceinline__
typedef unsigned short bf16_t;
using bf16x8 = __attribute__((ext_vector_type(8))) short;
using s16x4 = __attribute__((ext_vector_type(4))) short;
using f32x16 = __attribute__((ext_vector_type(16))) float;
#define MFMA(a, b, c) __builtin_amdgcn_mfma_f32_32x32x16_bf16((a), (b), (c), 0, 0, 0)

#ifndef COOP
#define COOP 1
#endif

constexpr int DM = 1024, NBAT = 2, SEQ = 8192, NTOK = NBAT * SEQ, CTXL = 256, NROW = NTOK + NBAT * CTXL;
constexpr int PLD = 2816;
constexpr int NSTEP = 66;
constexpr float EPS = 1e-6f;

constexpr size_t al256(size_t x) { return (x + 255) & ~(size_t)255; }
constexpr size_t O_BAR = 0;
constexpr size_t O_WIN = 16384;
constexpr size_t O_WOUT = O_WIN + al256((size_t)PLD * 1024 * 2);
constexpr size_t O_GMIN = O_WOUT + al256((size_t)1024 * 1024 * 2);
constexpr size_t O_GMOUT = O_GMIN + al256((size_t)4096 * 1024 * 2);
constexpr size_t O_MGU = O_GMOUT + al256((size_t)1024 * 2048 * 2);
constexpr size_t O_MD = O_MGU + al256((size_t)16 * 2048 * 1024 * 2);
constexpr size_t O_MODV = O_MD + al256((size_t)16 * 1024 * 1024 * 2);
constexpr size_t O_HA = O_MODV + al256((size_t)2 * 3 * 6144 * 4);
constexpr size_t O_GL = O_HA + al256((size_t)NROW * 1024 * 2);
constexpr size_t O_AFF = O_GL + al256((size_t)NROW * 16 * 4);
constexpr size_t O_IDX = O_AFF + al256((size_t)32 * 8192 * 4);
constexpr size_t O_GATE = O_IDX + al256((size_t)32 * 1024 * 4);
constexpr size_t O_STATS = O_GATE + al256((size_t)32 * 1024 * 4);
constexpr size_t O_GSC = O_STATS + al256((size_t)NTOK * 16 * 4);
constexpr size_t O_MLOC = O_GSC + al256((size_t)16 * NSTEP * 4);
constexpr size_t O_DN = O_MLOC + al256((size_t)16 * NSTEP * 4);
constexpr size_t O_NST = O_DN + al256((size_t)16 * NSTEP * 128 * 4);
constexpr size_t O_MST = O_NST + al256((size_t)16 * 64 * 128 * 4);
constexpr size_t O_INV = O_MST + al256((size_t)16 * 64 * 4);
constexpr size_t O_R12 = O_INV + al256((size_t)NTOK * 16 * 4);
constexpr size_t O_P = O_R12;
constexpr size_t O_QC = O_P + al256((size_t)NROW * PLD * 2);
constexpr size_t O_KC = O_QC + al256((size_t)NTOK * 512 * 2);
constexpr size_t O_KT = O_KC + al256((size_t)NTOK * 512 * 2);
constexpr size_t O_VT = O_KT + al256((size_t)132 * 4 * 128 * 128 * 2);
constexpr size_t O_RQ = O_VT + al256((size_t)132 * 4 * 128 * 128 * 2);
constexpr size_t O_RK = O_RQ + al256((size_t)NTOK * 512 * 2);
constexpr size_t O_AVTX = O_RK + al256((size_t)NROW * 128 * 2);
constexpr size_t O_AVTC = O_AVTX + al256((size_t)4 * 64 * 8192 * 2);
constexpr size_t O_R12_END = O_AVTC + al256((size_t)4 * 64 * 256 * 2);
constexpr size_t O_HID = O_R12;
constexpr size_t O_U = O_R12;
constexpr size_t O_GVT = O_U + al256((size_t)NTOK * 2048 * 2);
static_assert(O_GVT + (size_t)NTOK * 2048 * 2 <= O_R12_END, "R12 too small");
constexpr size_t O_DC = O_R12_END;
constexpr size_t O_CST = O_DC + al256((size_t)16 * NSTEP * 16384 * 4);
constexpr size_t O_UV = O_DC;
constexpr size_t O_YE = O_DC;
constexpr size_t WS_NEED = O_CST + al256((size_t)16 * 64 * 16384 * 2);

struct Params {
  const float *x, *c, *ctx, *c_ctx, *w_mod, *b_mod, *norm_mix_g, *norm_ffn_g, *final_norm_g;
  const float *ab_w_in, *ab_conv_w, *ab_gate_b, *ab_head_g, *ab_sink, *ab_w_out;
  const float *gm_w_in, *gm_ln_g, *gm_ln_b, *gm_w_s, *gm_b_s, *gm_w_out;
  const float *moe_w_router, *moe_w_gate, *moe_w_up, *moe_w_down;
  float* out;
  char* ws;
};

DI bf16_t f2bf(float x) { unsigned u = __float_as_uint(x); u += 0x7fffu + ((u >> 16) & 1u); return (bf16_t)(u >> 16); }
DI float bf2f(bf16_t b) { return __uint_as_float(((unsigned)b) << 16); }
DI unsigned pack2(float a, float b) { return (unsigned)f2bf(a) | ((unsigned)f2bf(b) << 16); }
DI bf16x8 pack8(float a0, float a1, float a2, float a3, float a4, float a5, float a6, float a7) {
  uint4 u; u.x = pack2(a0, a1); u.y = pack2(a2, a3); u.z = pack2(a4, a5); u.w = pack2(a6, a7);
  return __builtin_bit_cast(bf16x8, u);
}
DI bf16x8 ldfrag(const bf16_t* p) { return *(const bf16x8*)p; }
DI bf16x8 ldfrag2(const bf16_t* p0, const bf16_t* p1) {
  s16x4 lo = *(const s16x4*)p0, hi = *(const s16x4*)p1;
  return __builtin_shufflevector(lo, hi, 0, 1, 2, 3, 4, 5, 6, 7);
}
DI int crow(int i, int hh) { return (i & 3) + 8 * (i >> 2) + 4 * hh; }
DI float siluf(float x) { return x / (1.f + __expf(-x)); }
DI float sigmf(float x) { return 1.f / (1.f + __expf(-x)); }
DI float logsigf(float x) { return fminf(x, 0.f) - log1pf(expf(-fabsf(x))); }
DI float geluf(float x) {
  const float u2 = 1.5957691216057308f * (x + 0.044715f * x * x * x);
  return x / (1.f + __expf(-u2));
}
DI float wsum(float v) {
#pragma unroll
  for (int o = 32; o > 0; o >>= 1) v += __shfl_xor(v, o);
  return v;
}
DI int tid() { int t = threadIdx.x; asm volatile("" : "+v"(t)); return t; }
DI f32x16 fzero() { f32x16 z; for (int i = 0; i < 16; ++i) z[i] = 0.f; return z; }

DI int tmap(int kind, int n) {
  if (kind == 0) return n;
  if (kind == 1) return n < 2048 ? n : (n < 2064 ? -1 : n - 16);
  int r = (n >> 6) * 128 + ((n >> 5) & 1) * 64 + (n & 31);
  return kind == 2 ? r : r + 32;
}
DI void tconv(const float* __restrict__ src, int ldn, int ncols, int K, int nmat, size_t sstride,
              bf16_t* __restrict__ dst, size_t dstride, int kind, char* smem) {
  float* sm = (float*)smem;
  const int t = tid();
  const int ntn = (ncols + 63) >> 6, ntk = K >> 6, per = ntn * ntk, total = per * nmat;
  const int c4 = t & 15, rr = t >> 4;
  float4 v0, v1, v2, v3;
#define TC_LOAD(tile_) { const int mat_ = (tile_) / per, tt_ = (tile_) % per; const int k0_ = (tt_ / ntn) * 64, n_ = (tt_ % ntn) * 64 + c4 * 4; \
    const float* s_ = src + (size_t)mat_ * sstride + (size_t)(k0_ + rr) * ldn + n_; \
    if (n_ < ncols) { v0 = *(const float4*)(s_); v1 = *(const float4*)(s_ + (size_t)16 * ldn); v2 = *(const float4*)(s_ + (size_t)32 * ldn); v3 = *(const float4*)(s_ + (size_t)48 * ldn); } \
    else { v0 = v1 = v2 = v3 = make_float4(0.f, 0.f, 0.f, 0.f); } }
  int tile = blockIdx.x;
  if (tile < total) TC_LOAD(tile)
  for (; tile < total; tile += gridDim.x) {
    const int mat = tile / per, tt = tile % per;
    const int k0 = (tt / ntn) * 64, n0 = (tt % ntn) * 64;
    bf16_t* d = dst + (size_t)mat * dstride;
    {
      float* q = sm + rr * 65 + c4 * 4;
      q[0] = v0.x; q[1] = v0.y; q[2] = v0.z; q[3] = v0.w;
      q[16 * 65 + 0] = v1.x; q[16 * 65 + 1] = v1.y; q[16 * 65 + 2] = v1.z; q[16 * 65 + 3] = v1.w;
      q[32 * 65 + 0] = v2.x; q[32 * 65 + 1] = v2.y; q[32 * 65 + 2] = v2.z; q[32 * 65 + 3] = v2.w;
      q[48 * 65 + 0] = v3.x; q[48 * 65 + 1] = v3.y; q[48 * 65 + 2] = v3.z; q[48 * 65 + 3] = v3.w;
    }
    if (tile + (int)gridDim.x < total) TC_LOAD(tile + (int)gridDim.x)
    __syncthreads();
    const int nl = t >> 2, kq = t & 3, n = n0 + nl;
    if (n < ncols) {
      const int row = tmap(kind, n);
      if (row >= 0) {
        uint4 o0, o1;
        const float* q = sm + (kq * 16) * 65 + nl;
        o0.x = pack2(q[0 * 65], q[1 * 65]); o0.y = pack2(q[2 * 65], q[3 * 65]); o0.z = pack2(q[4 * 65], q[5 * 65]); o0.w = pack2(q[6 * 65], q[7 * 65]);
        o1.x = pack2(q[8 * 65], q[9 * 65]); o1.y = pack2(q[10 * 65], q[11 * 65]); o1.z = pack2(q[12 * 65], q[13 * 65]); o1.w = pack2(q[14 * 65], q[15 * 65]);
        uint4* dp = (uint4*)(d + (size_t)row * K + k0 + kq * 16);
        dp[0] = o0; dp[1] = o1;
      }
    }
    __syncthreads();
  }
#undef TC_LOAD
}
DI void tconv_moe(const Params& p, int layer, char* smem) {
  const size_t wo = (size_t)layer * 16 * 1024 * 1024;
  tconv(p.moe_w_gate + wo, 1024, 1024, 1024, 16, (size_t)1024 * 1024, (bf16_t*)(p.ws + O_MGU), (size_t)2048 * 1024, 2, smem);
  tconv(p.moe_w_up + wo, 1024, 1024, 1024, 16, (size_t)1024 * 1024, (bf16_t*)(p.ws + O_MGU), (size_t)2048 * 1024, 3, smem);
  tconv(p.moe_w_down + wo, 1024, 1024, 1024, 16, (size_t)1024 * 1024, (bf16_t*)(p.ws + O_MD), (size_t)1024 * 1024, 0, smem);
}

DI void phase_adaln(const Params& p, char* smem) {
  float* sv = (float*)smem;
  float* red = sv + 3 * 1024;
  float* modv = (float*)(p.ws + O_MODV);
  const int t = tid();
  if (blockIdx.x >= 192) return;
  for (int i = t; i < 3 * 1024; i += 256) {
    const int v = i >> 10, k = i & 1023;
    const float cv = v < 2 ? p.c[v * 1024 + k] : p.c_ctx[k];
    sv[i] = siluf(cv);
  }
  __syncthreads();
  for (int item = blockIdx.x; item < 192; item += gridDim.x) {
    const int l = item / 96, cb = item % 96;
    const int cq = t & 15, kg = t >> 4;
    const float* w = p.w_mod + (size_t)l * 1024 * 6144 + cb * 64 + cq * 4;
    float a0[4] = {0.f, 0.f, 0.f, 0.f}, a1[4] = {0.f, 0.f, 0.f, 0.f}, a2[4] = {0.f, 0.f, 0.f, 0.f};
    for (int i = 0; i < 64; ++i) {
      const int k = kg + 16 * i;
      const float4 wv = *(const float4*)(w + (size_t)k * 6144);
      const float s0 = sv[k], s1 = sv[1024 + k], s2 = sv[2048 + k];
      a0[0] += s0 * wv.x; a0[1] += s0 * wv.y; a0[2] += s0 * wv.z; a0[3] += s0 * wv.w;
      a1[0] += s1 * wv.x; a1[1] += s1 * wv.y; a1[2] += s1 * wv.z; a1[3] += s1 * wv.w;
      a2[0] += s2 * wv.x; a2[1] += s2 * wv.y; a2[2] += s2 * wv.z; a2[3] += s2 * wv.w;
    }
#pragma unroll
    for (int j = 0; j < 4; ++j) {
      red[(kg * 3 + 0) * 64 + cq * 4 + j] = a0[j];
      red[(kg * 3 + 1) * 64 + cq * 4 + j] = a1[j];
      red[(kg * 3 + 2) * 64 + cq * 4 + j] = a2[j];
    }
    __syncthreads();
    if (t < 192) {
      const int v = t >> 6, col = t & 63;
      float s = 0.f;
      for (int g = 0; g < 16; ++g) s += red[(g * 3 + v) * 64 + col];
      const int cc = cb * 64 + col;
      modv[(l * 3 + v) * 6144 + cc] = s + p.b_mod[l * 6144 + cc];
    }
    __syncthreads();
  }
}

DI void moe_combine_row(const Params& p, int row, int lane, float4 (&acc)[4]) {
  const int* INV = (const int*)(p.ws + O_INV); const float* GATE = (const float*)(p.ws + O_GATE);
  const bf16_t* YE = (const bf16_t*)(p.ws + O_YE);
  const int b = row >> 13;
  const int myslot = INV[(size_t)row * 16 + (lane & 15)];
#pragma unroll
  for (int i = 0; i < 4; ++i) acc[i] = make_float4(0.f, 0.f, 0.f, 0.f);
#pragma unroll 1
  for (int e = 0; e < 16; ++e) {
    const int slot = __builtin_amdgcn_readlane(myslot, e);
    if (slot != 0) {
      const int be = b * 16 + e;
      const float g = GATE[be * 1024 + slot - 1];
      const bf16_t* yr = YE + ((size_t)be * 1024 + slot - 1) * 1024;
#pragma unroll
      for (int i = 0; i < 4; ++i) {
        const s16x4 v = *(const s16x4*)(yr + (i * 64 + lane) * 4);
        acc[i].x += g * bf2f((bf16_t)v[0]); acc[i].y += g * bf2f((bf16_t)v[1]); acc[i].z += g * bf2f((bf16_t)v[2]); acc[i].w += g * bf2f((bf16_t)v[3]);
      }
    }
  }
}

template <int MODE, bool COMB>
DI void phase_modulate(const Params& p, int layer, int which, char* smem) {
  float* wt = (float*)smem;
  const int t = tid(), lane = t & 63, w = t >> 6;
  const float* modv = (const float*)(p.ws + O_MODV);
  bf16_t* HA = (bf16_t*)(p.ws + O_HA);
  if (MODE != 0) {
    const float* W = MODE == 1 ? p.ab_w_in + 2048 : p.moe_w_router + (size_t)layer * 1024 * 16;
    const int ld = MODE == 1 ? 2832 : 16;
    for (int i = t; i < 4096; i += 256) {
      const int k = i >> 2, e4 = i & 3;
      const float4 v = *(const float4*)(W + (size_t)k * ld + e4 * 4);
      wt[(e4 * 4 + 0) * 1024 + k] = v.x; wt[(e4 * 4 + 1) * 1024 + k] = v.y; wt[(e4 * 4 + 2) * 1024 + k] = v.z; wt[(e4 * 4 + 3) * 1024 + k] = v.w;
    }
    __syncthreads();
  }
  const float* gn = (which == 0 ? p.norm_mix_g : p.norm_ffn_g) + layer * 1024;
  const int nrows = MODE == 1 ? NROW : NTOK;
  const int rstride = gridDim.x * 4;
  float4 nx[4];
#define MOD_SRC(row_) (MODE == 1 ? ((row_) < NTOK ? p.x + (size_t)(row_) * 1024 : p.ctx + (size_t)((row_) - NTOK) * 1024) : p.out + (size_t)(row_) * 1024)
  {
    const int row0_ = blockIdx.x * 4 + w;
    if (row0_ < nrows) {
      const float* s0_ = MOD_SRC(row0_);
#pragma unroll
      for (int i = 0; i < 4; ++i) nx[i] = *(const float4*)(s0_ + (i * 64 + lane) * 4);
    }
  }
  for (int row = blockIdx.x * 4 + w; row < nrows; row += rstride) {
    const int v = (MODE == 1 && row >= NTOK) ? 2 : (row >> 13);
    const float* sh = modv + (layer * 3 + v) * 6144 + (which ? 3 : 0) * 1024;
    const float* sc = sh + 1024;
    float4 xv[4];
    float ss = 0.f;
#pragma unroll
    for (int i = 0; i < 4; ++i) xv[i] = nx[i];
    if (row + rstride < nrows) {
      const float* s1_ = MOD_SRC(row + rstride);
#pragma unroll
      for (int i = 0; i < 4; ++i) nx[i] = *(const float4*)(s1_ + (i * 64 + lane) * 4);
    }
    if (COMB) {
      float4 ca[4];
      moe_combine_row(p, row, lane, ca);
      const float* g2 = modv + ((layer - 1) * 3 + v) * 6144 + 5 * 1024;
#pragma unroll
      for (int i = 0; i < 4; ++i) {
        const float4 gg = *(const float4*)(g2 + (i * 64 + lane) * 4);
        xv[i].x += gg.x * ca[i].x; xv[i].y += gg.y * ca[i].y; xv[i].z += gg.z * ca[i].z; xv[i].w += gg.w * ca[i].w;
        *(float4*)(p.out + (size_t)row * 1024 + (i * 64 + lane) * 4) = xv[i];
      }
    }
#pragma unroll
    for (int i = 0; i < 4; ++i) ss += xv[i].x * xv[i].x + xv[i].y * xv[i].y + xv[i].z * xv[i].z + xv[i].w * xv[i].w;
    ss = wsum(ss);
    const float rstd = rsqrtf(ss * (1.f / 1024.f) + EPS);
    float4 yv[4];
#pragma unroll
    for (int i = 0; i < 4; ++i) {
      const int col = (i * 64 + lane) * 4;
      const float4 g4 = *(const float4*)(gn + col), s4 = *(const float4*)(sh + col), c4 = *(const float4*)(sc + col);
      float4 y;
      y.x = xv[i].x * rstd * g4.x * (1.f + c4.x) + s4.x;
      y.y = xv[i].y * rstd * g4.y * (1.f + c4.y) + s4.y;
      y.z = xv[i].z * rstd * g4.z * (1.f + c4.z) + s4.z;
      y.w = xv[i].w * rstd * g4.w * (1.f + c4.w) + s4.w;
      yv[i] = y;
      uint2 o; o.x = pack2(y.x, y.y); o.y = pack2(y.z, y.w);
      *(uint2*)(HA + (size_t)row * 1024 + col) = o;
    }
    if (MODE != 0) {
      float mine = 0.f;
#pragma unroll 1
      for (int e4 = 0; e4 < 16; e4 += 4) {
        float pe0 = 0.f, pe1 = 0.f, pe2 = 0.f, pe3 = 0.f;
#pragma unroll
        for (int i = 0; i < 4; ++i) {
          const float* wp = wt + e4 * 1024 + (i * 64 + lane) * 4;
          const float4 wa = *(const float4*)(wp), wb = *(const float4*)(wp + 1024), wc = *(const float4*)(wp + 2048), wd = *(const float4*)(wp + 3072);
          pe0 += yv[i].x * wa.x + yv[i].y * wa.y + yv[i].z * wa.z + yv[i].w * wa.w;
          pe1 += yv[i].x * wb.x + yv[i].y * wb.y + yv[i].z * wb.z + yv[i].w * wb.w;
          pe2 += yv[i].x * wc.x + yv[i].y * wc.y + yv[i].z * wc.z + yv[i].w * wc.w;
          pe3 += yv[i].x * wd.x + yv[i].y * wd.y + yv[i].z * wd.z + yv[i].w * wd.w;
        }
#pragma unroll
        for (int o = 32; o > 0; o >>= 1) {
          const float q0 = __shfl_xor(pe0, o), q1 = __shfl_xor(pe1, o), q2 = __shfl_xor(pe2, o), q3 = __shfl_xor(pe3, o);
          pe0 += q0; pe1 += q1; pe2 += q2; pe3 += q3;
        }
        const int el = (lane & 15) - e4;
        mine = el == 0 ? pe0 : (el == 1 ? pe1 : (el == 2 ? pe2 : (el == 3 ? pe3 : mine)));
      }
      const int e = lane & 15;
      if (MODE == 1) {
        float val = mine + p.ab_gate_b[e];
        if (((e >> 2) & 1) == 1) val = logsigf(val);
        if (lane < 16) ((float*)(p.ws + O_GL))[(size_t)row * 16 + lane] = val;
      } else {
        float mx = mine;
#pragma unroll
        for (int o = 8; o > 0; o >>= 1) mx = fmaxf(mx, __shfl_xor(mx, o));
        const float ex = expf(mine - mx);
        float sum = ex;
#pragma unroll
        for (int o = 8; o > 0; o >>= 1) sum += __shfl_xor(sum, o);
        if (lane < 16) ((float*)(p.ws + O_AFF))[((size_t)(row >> 13) * 16 + lane) * 8192 + (row & 8191)] = ex / sum;
        if (lane < 16) ((int*)(p.ws + O_INV))[(size_t)row * 16 + lane] = 0;
      }
    }
  }
}

template <class Epi>
DI void gemm_tile(const bf16_t* (&ap)[4], const bf16_t* (&bp)[4], int K, char* smem, Epi&& epi) {
  bf16_t* sA = (bf16_t*)smem;
  bf16_t* sB = sA + 2 * 128 * 72;
  const int t = tid(), lane = t & 63, w = t >> 6, wm = w >> 1, wn = w & 1, r = lane & 31, hh = lane >> 5;
  const int lrow = t >> 3, lcol = (t & 7) * 8;
  const bf16_t* a0p = ap[0]; const bf16_t* a1p = ap[1]; const bf16_t* a2p = ap[2]; const bf16_t* a3p = ap[3];
  const bf16_t* b0p = bp[0]; const bf16_t* b1p = bp[1]; const bf16_t* b2p = bp[2]; const bf16_t* b3p = bp[3];
  f32x16 acc00 = fzero(), acc01 = fzero(), acc10 = fzero(), acc11 = fzero();
  uint4 ra0 = *(const uint4*)a0p, ra1 = *(const uint4*)a1p, ra2 = *(const uint4*)a2p, ra3 = *(const uint4*)a3p;
  uint4 rb0 = *(const uint4*)b0p, rb1 = *(const uint4*)b1p, rb2 = *(const uint4*)b2p, rb3 = *(const uint4*)b3p;
  const int so = lrow * 72 + lcol;
  *(uint4*)(sA + so) = ra0; *(uint4*)(sA + so + 32 * 72) = ra1; *(uint4*)(sA + so + 64 * 72) = ra2; *(uint4*)(sA + so + 96 * 72) = ra3;
  *(uint4*)(sB + so) = rb0; *(uint4*)(sB + so + 32 * 72) = rb1; *(uint4*)(sB + so + 64 * 72) = rb2; *(uint4*)(sB + so + 96 * 72) = rb3;
  __syncthreads();
  const int KT = K >> 6;
  for (int kt = 0; kt < KT; ++kt) {
    const int cur = kt & 1;
    const int kn = (kt + 1 < KT ? kt + 1 : kt) * 64;
    ra0 = *(const uint4*)(a0p + kn); ra1 = *(const uint4*)(a1p + kn); ra2 = *(const uint4*)(a2p + kn); ra3 = *(const uint4*)(a3p + kn);
    rb0 = *(const uint4*)(b0p + kn); rb1 = *(const uint4*)(b1p + kn); rb2 = *(const uint4*)(b2p + kn); rb3 = *(const uint4*)(b3p + kn);
    __builtin_amdgcn_sched_barrier(0);
    const bf16_t* cA = sA + cur * 128 * 72 + (wm * 64 + r) * 72 + hh * 8;
    const bf16_t* cB = sB + cur * 128 * 72 + (wn * 64 + r) * 72 + hh * 8;
    {
      bf16x8 a0 = *(const bf16x8*)(cA), a1 = *(const bf16x8*)(cA + 32 * 72);
      bf16x8 b0 = *(const bf16x8*)(cB), b1 = *(const bf16x8*)(cB + 32 * 72);
#pragma unroll
      for (int ks = 0; ks < 4; ++ks) {
        bf16x8 na0 = a0, na1 = a1, nb0 = b0, nb1 = b1;
        if (ks < 3) {
          na0 = *(const bf16x8*)(cA + (ks + 1) * 16); na1 = *(const bf16x8*)(cA + 32 * 72 + (ks + 1) * 16);
          nb0 = *(const bf16x8*)(cB + (ks + 1) * 16); nb1 = *(const bf16x8*)(cB + 32 * 72 + (ks + 1) * 16);
        }
        acc00 = MFMA(a0, b0, acc00);
        acc01 = MFMA(a0, b1, acc01);
        acc10 = MFMA(a1, b0, acc10);
        acc11 = MFMA(a1, b1, acc11);
        __builtin_amdgcn_sched_barrier(0);
        a0 = na0; a1 = na1; b0 = nb0; b1 = nb1;
      }
    }
    __builtin_amdgcn_sched_barrier(0);
    {
      bf16_t* nA = sA + (cur ^ 1) * 128 * 72 + so;
      bf16_t* nB = sB + (cur ^ 1) * 128 * 72 + so;
      *(uint4*)(nA) = ra0; *(uint4*)(nA + 32 * 72) = ra1; *(uint4*)(nA + 64 * 72) = ra2; *(uint4*)(nA + 96 * 72) = ra3;
      *(uint4*)(nB) = rb0; *(uint4*)(nB + 32 * 72) = rb1; *(uint4*)(nB + 64 * 72) = rb2; *(uint4*)(nB + 96 * 72) = rb3;
    }
    __syncthreads();
  }
  f32x16 acc[2][2];
  acc[0][0] = acc00; acc[0][1] = acc01; acc[1][0] = acc10; acc[1][1] = acc11;
  epi(acc, wm * 64, wn * 64, r, hh);
}

struct TileWalk {
  int L, Lend, nl;
  DI TileWalk(int T, const char* smem) {
    const volatile unsigned* xw = (const volatile unsigned*)(smem + 73728);
    const int nloc = (int)xw[0], sb = (int)xw[2], rk = (int)xw[3], G = (int)gridDim.x;
    nl = nloc;
    L = (T * sb) / G + rk; Lend = (T * (sb + nloc)) / G;
  }
  DI bool valid() const { return L < Lend; }
  DI void next() { L += nl; }
  DI void get(int SM, int SN, int nsn, int& mt, int& nt) const {
    const int s = L / (SM * SN), wi = L % (SM * SN);
    mt = (s / nsn) * SM + wi / SN; nt = (s % nsn) * SN + wi % SN;
  }
};

template <class MakeEpi>
DI void gemm_dense(const bf16_t* A, const bf16_t* Bt, int M, int N, int K, int SM, int SN, char* smem, MakeEpi&& mk) {
  const int t = tid(), lrow = t >> 3, lcol = (t & 7) * 8;
  const int ntn = N >> 7, ntm = M >> 7;
  for (TileWalk tw(ntn * ntm, smem); tw.valid(); tw.next()) {
    int mt, nt; tw.get(SM, SN, ntn / SN, mt, nt);
    const bf16_t* ap[4]; const bf16_t* bp[4];
#pragma unroll
    for (int i = 0; i < 4; ++i) {
      ap[i] = A + (size_t)(mt * 128 + lrow + 32 * i) * K + lcol;
      bp[i] = Bt + (size_t)(nt * 128 + lrow + 32 * i) * K + lcol;
    }
    gemm_tile(ap, bp, K, smem, mk(mt * 128, nt * 128));
  }
}

DI void phase_prep2(const Params& p, char* smem) {
  bf16_t* T = (bf16_t*)smem;
  const bf16_t* P = (const bf16_t*)(p.ws + O_P);
  bf16_t* Qc = (bf16_t*)(p.ws + O_QC); bf16_t* Kc = (bf16_t*)(p.ws + O_KC);
  bf16_t* KT = (bf16_t*)(p.ws + O_KT); bf16_t* VT = (bf16_t*)(p.ws + O_VT);
  bf16_t* RQ = (bf16_t*)(p.ws + O_RQ); bf16_t* RK = (bf16_t*)(p.ws + O_RK);
  bf16_t* AVTX = (bf16_t*)(p.ws + O_AVTX); bf16_t* AVTC = (bf16_t*)(p.ws + O_AVTC);
  const int t = tid();
  for (int item = blockIdx.x; item < 132 * 6; item += gridDim.x) {
    const int sc = item / 6, part = item % 6;
    const bool isx = sc < 128;
    const int row0 = sc * 128;
    const int seq_lo = isx ? (sc >> 6) * 8192 : NTOK + ((sc - 128) >> 1) * 256;
    const int seq_hi = seq_lo + (isx ? 8192 : 256);
    if (part < 4) {
      const int h = part;
      const int col8 = t & 15, rsub = t >> 4;
      for (int pass = 0; pass < 3; ++pass) {
        if (pass == 2 && !isx) break;
        const int pcol = (pass == 0 ? 512 : (pass == 1 ? 1024 : 0)) + h * 128 + col8 * 8;
        float cw[5][8];
        if (pass != 1) {
#pragma unroll
          for (int j = 0; j < 5; ++j)
#pragma unroll
            for (int e = 0; e < 8; ++e) cw[j][e] = p.ab_conv_w[j * 1024 + (pass == 0 ? 512 : 0) + h * 128 + col8 * 8 + e];
        }
        for (int i = 0; i < 8; ++i) {
          const int rl = rsub + 16 * i, row = row0 + rl;
          uint4 o;
          if (pass == 1) {
            o = *(const uint4*)(P + (size_t)row * PLD + pcol);
          } else {
            float a[8];
#pragma unroll
            for (int e = 0; e < 8; ++e) a[e] = 0.f;
#pragma unroll
            for (int j = 0; j < 5; ++j) {
              const int rr = row + j - 2;
              if (rr >= seq_lo && rr < seq_hi) {
                const bf16x8 v = *(const bf16x8*)(P + (size_t)rr * PLD + pcol);
#pragma unroll
                for (int e = 0; e < 8; ++e) a[e] += cw[j][e] * bf2f((bf16_t)v[e]);
              }
            }
            const float scl = pass == 0 ? 0.08838834764831845f : 1.f;
#pragma unroll
            for (int e = 0; e < 8; ++e) a[e] = siluf(a[e]) * scl;
            o.x = pack2(a[0], a[1]); o.y = pack2(a[2], a[3]); o.z = pack2(a[4], a[5]); o.w = pack2(a[6], a[7]);
            if (isx) *(uint4*)((pass == 0 ? Kc : Qc) + (size_t)row * 512 + h * 128 + col8 * 8) = o;
          }
          if (pass < 2) *(uint4*)(T + rl * 136 + col8 * 8) = o;
        }
        if (pass < 2) {
          __syncthreads();
          bf16_t* dstT = (pass == 0 ? KT : VT) + (size_t)(sc * 4 + h) * 16384;
          const int d = t & 127, shf = t >> 7;
#pragma unroll
          for (int s8 = 0; s8 < 8; ++s8) {
            const bf16_t* q = T + (shf * 64 + s8 * 8) * 136 + d;
            uint4 o;
            o.x = (unsigned)q[0] | ((unsigned)q[136] << 16); o.y = (unsigned)q[2 * 136] | ((unsigned)q[3 * 136] << 16);
            o.z = (unsigned)q[4 * 136] | ((unsigned)q[5 * 136] << 16); o.w = (unsigned)q[6 * 136] | ((unsigned)q[7 * 136] << 16);
            *(uint4*)(dstT + d * 128 + shf * 64 + s8 * 8) = o;
          }
          __syncthreads();
        }
      }
    } else if (part == 4) {
      if (!isx) continue;
      for (int idx = t; idx < 512; idx += 256) {
        const int rl = idx >> 2, dc = idx & 3, row = row0 + rl, pos = row - seq_lo;
        const float rp = (float)(pos >> 6), cp = (float)(pos & 63);
        float cs[8], sn[8];
#pragma unroll
        for (int e = 0; e < 8; ++e) {
          const int a = dc * 8 + e;
          const float inv = powf(10000.f, -(float)(a & 15) / 16.f);
          const float ang = (a < 16 ? rp : cp) * inv;
          cs[e] = cosf(ang); sn[e] = sinf(ang);
        }
        for (int hq = 0; hq < 8; ++hq) {
          const bf16x8 x1 = *(const bf16x8*)(P + (size_t)row * PLD + 2048 + hq * 64 + dc * 8);
          const bf16x8 x2 = *(const bf16x8*)(P + (size_t)row * PLD + 2048 + hq * 64 + 32 + dc * 8);
          float o1[8], o2[8];
#pragma unroll
          for (int e = 0; e < 8; ++e) {
            const float a = bf2f((bf16_t)x1[e]), b = bf2f((bf16_t)x2[e]);
            o1[e] = (a * cs[e] - b * sn[e]) * 0.125f; o2[e] = (b * cs[e] + a * sn[e]) * 0.125f;
          }
          uint4 u1, u2;
          u1.x = pack2(o1[0], o1[1]); u1.y = pack2(o1[2], o1[3]); u1.z = pack2(o1[4], o1[5]); u1.w = pack2(o1[6], o1[7]);
          u2.x = pack2(o2[0], o2[1]); u2.y = pack2(o2[2], o2[3]); u2.z = pack2(o2[4], o2[5]); u2.w = pack2(o2[6], o2[7]);
          *(uint4*)(RQ + (size_t)row * 512 + hq * 64 + dc * 8) = u1;
          *(uint4*)(RQ + (size_t)row * 512 + hq * 64 + 32 + dc * 8) = u2;
        }
      }
    } else {
      for (int idx = t; idx < 512; idx += 256) {
        const int rl = idx >> 2, dc = idx & 3, row = row0 + rl, pos = row - seq_lo;
        const float rp = (float)(pos >> 6), cp = (float)(pos & 63);
        float cs[8], sn[8];
#pragma unroll
        for (int e = 0; e < 8; ++e) {
          const int a = dc * 8 + e;
          const float inv = powf(10000.f, -(float)(a & 15) / 16.f);
          const float ang = (a < 16 ? rp : cp) * inv;
          cs[e] = isx ? cosf(ang) : 1.f; sn[e] = isx ? sinf(ang) : 0.f;
        }
        for (int g = 0; g < 2; ++g) {
          const bf16x8 x1 = *(const bf16x8*)(P + (size_t)row * PLD + 2560 + g * 64 + dc * 8);
          const bf16x8 x2 = *(const bf16x8*)(P + (size_t)row * PLD + 2560 + g * 64 + 32 + dc * 8);
          float o1[8], o2[8];
#pragma unroll
          for (int e = 0; e < 8; ++e) {
            const float a = bf2f((bf16_t)x1[e]), b = bf2f((bf16_t)x2[e]);
            o1[e] = a * cs[e] - b * sn[e]; o2[e] = b * cs[e] + a * sn[e];
          }
          uint4 u1, u2;
          u1.x = pack2(o1[0], o1[1]); u1.y = pack2(o1[2], o1[3]); u1.z = pack2(o1[4], o1[5]); u1.w = pack2(o1[6], o1[7]);
          u2.x = pack2(o2[0], o2[1]); u2.y = pack2(o2[2], o2[3]); u2.z = pack2(o2[4], o2[5]); u2.w = pack2(o2[6], o2[7]);
          *(uint4*)(RK + (size_t)row * 128 + g * 64 + dc * 8) = u1;
          *(uint4*)(RK + (size_t)row * 128 + g * 64 + 32 + dc * 8) = u2;
        }
      }
      {
        const int col8 = t & 15, rsub = t >> 4;
        for (int i = 0; i < 8; ++i) {
          const int rl = rsub + 16 * i;
          *(uint4*)(T + rl * 136 + col8 * 8) = *(const uint4*)(P + (size_t)(row0 + rl) * PLD + 2688 + col8 * 8);
        }
        __syncthreads();
        const int d = t & 127, shf = t >> 7;
        const int b = isx ? (sc >> 6) : ((sc - 128) >> 1);
        const int pos0 = row0 - seq_lo;
        bf16_t* dst = isx ? AVTX + ((size_t)(b * 2 + (d >> 6)) * 64 + (d & 63)) * 8192 + pos0
                          : AVTC + ((size_t)(b * 2 + (d >> 6)) * 64 + (d & 63)) * 256 + pos0;
#pragma unroll
        for (int s8 = 0; s8 < 8; ++s8) {
          const bf16_t* q = T + (shf * 64 + s8 * 8) * 136 + d;
          uint4 o;
          o.x = (unsigned)q[0] | ((unsigned)q[136] << 16); o.y = (unsigned)q[2 * 136] | ((unsigned)q[3 * 136] << 16);
          o.z = (unsigned)q[4 * 136] | ((unsigned)q[5 * 136] << 16); o.w = (unsigned)q[6 * 136] | ((unsigned)q[7 * 136] << 16);
          *(uint4*)(dst + shf * 64 + s8 * 8) = o;
        }
        __syncthreads();
      }
    }
  }
}

DI void attn_item(const Params& p, int item) {
  const int g = item & 1, qb = (item >> 1) & 255, b = item >> 9;
  int t_ = tid();
  asm volatile("" : "+v"(t_));
  const int t = t_, lane = t & 63, w = t >> 6, r = lane & 31, hh = lane >> 5;
  const int hq = g * 4 + w, q0 = qb * 32;
  const bf16_t* RQ = (const bf16_t*)(p.ws + O_RQ); const bf16_t* RK = (const bf16_t*)(p.ws + O_RK);
  const bf16_t* AVTX = (const bf16_t*)(p.ws + O_AVTX); const bf16_t* AVTC = (const bf16_t*)(p.ws + O_AVTC);
  bf16_t* MIX = (bf16_t*)(p.ws + O_HA);
  const size_t qrow = (size_t)b * 8192 + q0 + r;
  bf16x8 qf[4];
#pragma unroll
  for (int ks = 0; ks < 4; ++ks) qf[ks] = ldfrag(RQ + qrow * 512 + hq * 64 + ks * 16 + hh * 8);
  float m = p.ab_sink[hq], l = hh == 0 ? 1.f : 0.f;
  f32x16 o0 = fzero(), o1 = fzero();
  const int ipos = q0 + r;
  const int lo = q0 - 128 < 0 ? 0 : q0 - 128, hi = q0 + 128 > 8192 - 32 ? 8192 - 32 : q0 + 128;
  const int nloc = ((hi - lo) >> 5) + 1, ntile = nloc + 8;
  const bf16_t* kloc = RK + (size_t)(b * 8192) * 128 + g * 64 + r * 128 + hh * 8;
  const bf16_t* kctx = RK + (size_t)(NTOK + b * 256) * 128 + g * 64 + r * 128 + hh * 8;
  const bf16_t* vloc = AVTX + (size_t)((b * 2 + g) * 64 + r) * 8192 + 4 * hh;
  const bf16_t* vctx = AVTC + (size_t)((b * 2 + g) * 64 + r) * 256 + 4 * hh;
  bf16x8 kf0, kf1, kf2, kf3, vf00, vf01, vf10, vf11;
#define ATT_LOAD(j_, K0, K1, K2, K3, V00, V01, V10, V11) { \
    const bool loc_ = (j_) < nloc; const int k0_ = loc_ ? lo + (j_) * 32 : ((j_) - nloc) * 32; \
    const bf16_t* kb_ = (loc_ ? kloc : kctx) + (size_t)k0_ * 128; \
    const bf16_t* vb_ = (loc_ ? vloc : vctx) + k0_; const int vs_ = (loc_ ? 8192 : 256) * 32; \
    K0 = ldfrag(kb_); K1 = ldfrag(kb_ + 16); K2 = ldfrag(kb_ + 32); K3 = ldfrag(kb_ + 48); \
    V00 = ldfrag2(vb_, vb_ + 8); V01 = ldfrag2(vb_ + 16, vb_ + 24); V10 = ldfrag2(vb_ + vs_, vb_ + vs_ + 8); V11 = ldfrag2(vb_ + vs_ + 16, vb_ + vs_ + 24); }
  ATT_LOAD(0, kf0, kf1, kf2, kf3, vf00, vf01, vf10, vf11)
#pragma unroll 1
  for (int tile = 0; tile < ntile; ++tile) {
    bf16x8 nk0 = kf0, nk1 = kf1, nk2 = kf2, nk3 = kf3, nv00 = vf00, nv01 = vf01, nv10 = vf10, nv11 = vf11;
    if (tile + 1 < ntile) ATT_LOAD(tile + 1, nk0, nk1, nk2, nk3, nv00, nv01, nv10, nv11)
    const bool local = tile < nloc;
    const int k0 = local ? lo + tile * 32 : (tile - nloc) * 32;
    f32x16 s = fzero();
    s = MFMA(kf0, qf[0], s); s = MFMA(kf1, qf[1], s); s = MFMA(kf2, qf[2], s); s = MFMA(kf3, qf[3], s);
    float tmax = -INFINITY;
#pragma unroll
    for (int i = 0; i < 16; ++i) {
      const int dj = ipos - (k0 + crow(i, hh));
      const bool ok = !local || (dj <= 128 && dj >= -128);
      s[i] = ok ? s[i] : -INFINITY;
      tmax = fmaxf(tmax, s[i]);
    }
    tmax = fmaxf(tmax, __shfl_xor(tmax, 32));
    const float mn = fmaxf(m, tmax), corr = __expf(m - mn);
    m = mn; l *= corr;
#pragma unroll
    for (int i = 0; i < 16; ++i) { o0[i] *= corr; o1[i] *= corr; }
#pragma unroll
    for (int i = 0; i < 16; ++i) { s[i] = __expf(s[i] - mn); l += s[i]; }
    const bf16x8 pf0 = pack8(s[0], s[1], s[2], s[3], s[4], s[5], s[6], s[7]);
    const bf16x8 pf1 = pack8(s[8], s[9], s[10], s[11], s[12], s[13], s[14], s[15]);
    o0 = MFMA(vf00, pf0, o0); o1 = MFMA(vf10, pf0, o1);
    o0 = MFMA(vf01, pf1, o0); o1 = MFMA(vf11, pf1, o1);
    kf0 = nk0; kf1 = nk1; kf2 = nk2; kf3 = nk3; vf00 = nv00; vf01 = nv01; vf10 = nv10; vf11 = nv11;
  }
#undef ATT_LOAD
  l += __shfl_xor(l, 32);
  const float inv = 1.f / l;
  bf16_t* dst = MIX + qrow * 1024 + 512 + hq * 64;
#pragma unroll
  for (int q4 = 0; q4 < 4; ++q4) {
    const int d = 8 * q4 + 4 * hh;
    uint2 u;
    u.x = pack2(o0[4 * q4] * inv, o0[4 * q4 + 1] * inv); u.y = pack2(o0[4 * q4 + 2] * inv, o0[4 * q4 + 3] * inv);
    *(uint2*)(dst + d) = u;
    u.x = pack2(o1[4 * q4] * inv, o1[4 * q4 + 1] * inv); u.y = pack2(o1[4 * q4 + 2] * inv, o1[4 * q4 + 3] * inv);
    *(uint2*)(dst + 32 + d) = u;
  }
}

DI void mlstm_local_item(const Params& p, int item, char* smem) {
  float* gs = (float*)smem;
  float* wv = gs + 512;
  float* msc = wv + 256;
  int t_ = tid();
  asm volatile("" : "+v"(t_));
  const int t = t_, lane = t & 63, w = t >> 6, wm = w >> 1, wn = w & 1, r = lane & 31, hh = lane >> 5;
  const int bh = item / NSTEP, nc = item % NSTEP, b = bh >> 2, h = bh & 3;
  const int sc = nc < 2 ? 128 + b * 2 + nc : b * 64 + (nc - 2);
  const int row0 = sc * 128;
  const float* GL = (const float*)(p.ws + O_GL);
  const bf16_t* KT = (const bf16_t*)(p.ws + O_KT) + (size_t)(sc * 4 + h) * 16384;
  const bf16_t* VT = (const bf16_t*)(p.ws + O_VT) + (size_t)(sc * 4 + h) * 16384;
  for (int i = t; i < 512; i += 256) { const int ty = i >> 7, s = i & 127; gs[i] = GL[(size_t)(row0 + s) * 16 + ty * 4 + h]; }
  __syncthreads();
  {
    const int dir = t >> 7, s = t & 127;
    float wval, tot = 0.f;
    if (dir == 0) {
      float bsum = 0.f;
      for (int j = 0; j < 128; ++j) { const float f = gs[128 + j]; tot += f; if (j <= s) bsum += f; }
      wval = tot - bsum + gs[s];
    } else {
      float pre = 0.f;
      for (int j = 0; j < 128; ++j) { const float f = gs[384 + j]; tot += f; if (j < s) pre += f; }
      wval = pre + gs[256 + s];
    }
    wv[dir * 128 + s] = wval;
    if (s == 0) msc[dir] = tot;
  }
  __syncthreads();
  {
    const int dir = t >> 7, s = t & 127;
    float mx = -INFINITY;
    for (int j = 0; j < 128; ++j) mx = fmaxf(mx, wv[dir * 128 + j]);
    const float wval = wv[dir * 128 + s];
    __syncthreads();
    wv[dir * 128 + s] = expf(wval - mx);
    if (s == 0) msc[2 + dir] = mx;
  }
  __syncthreads();
  float* DC = (float*)(p.ws + O_DC);
#pragma unroll 1
  for (int d = 0; d < 2; ++d) {
    f32x16 acc[2][2];
#pragma unroll
    for (int i = 0; i < 2; ++i)
#pragma unroll
      for (int j = 0; j < 2; ++j) acc[i][j] = fzero();
#pragma unroll 2
    for (int ks = 0; ks < 8; ++ks) {
      const bf16x8 ra0 = ldfrag(VT + (wm * 64 + r) * 128 + ks * 16 + hh * 8);
      const bf16x8 ra1 = ldfrag(VT + (wm * 64 + 32 + r) * 128 + ks * 16 + hh * 8);
      const bf16x8 b0 = ldfrag(KT + (wn * 64 + r) * 128 + ks * 16 + hh * 8);
      const bf16x8 b1 = ldfrag(KT + (wn * 64 + 32 + r) * 128 + ks * 16 + hh * 8);
      const float* ww = wv + d * 128 + ks * 16 + hh * 8;
      const bf16x8 a0 = pack8(bf2f((bf16_t)ra0[0]) * ww[0], bf2f((bf16_t)ra0[1]) * ww[1], bf2f((bf16_t)ra0[2]) * ww[2], bf2f((bf16_t)ra0[3]) * ww[3],
                              bf2f((bf16_t)ra0[4]) * ww[4], bf2f((bf16_t)ra0[5]) * ww[5], bf2f((bf16_t)ra0[6]) * ww[6], bf2f((bf16_t)ra0[7]) * ww[7]);
      const bf16x8 a1 = pack8(bf2f((bf16_t)ra1[0]) * ww[0], bf2f((bf16_t)ra1[1]) * ww[1], bf2f((bf16_t)ra1[2]) * ww[2], bf2f((bf16_t)ra1[3]) * ww[3],
                              bf2f((bf16_t)ra1[4]) * ww[4], bf2f((bf16_t)ra1[5]) * ww[5], bf2f((bf16_t)ra1[6]) * ww[6], bf2f((bf16_t)ra1[7]) * ww[7]);
      acc[0][0] = MFMA(a0, b0, acc[0][0]);
      acc[0][1] = MFMA(a0, b1, acc[0][1]);
      acc[1][0] = MFMA(a1, b0, acc[1][0]);
      acc[1][1] = MFMA(a1, b1, acc[1][1]);
    }
    float* dst = DC + ((size_t)(bh * 2 + d) * NSTEP + nc) * 16384;
#pragma unroll
    for (int mi = 0; mi < 2; ++mi)
#pragma unroll
      for (int ni = 0; ni < 2; ++ni)
#pragma unroll
        for (int i = 0; i < 16; ++i)
          dst[(wm * 64 + mi * 32 + crow(i, hh)) * 128 + wn * 64 + ni * 32 + r] = acc[mi][ni][i];
  }
  {
    const int dir = t >> 7, k = t & 127;
    float s = 0.f;
    for (int s8 = 0; s8 < 16; ++s8) {
      const bf16x8 v = ldfrag(KT + k * 128 + s8 * 8);
#pragma unroll
      for (int e = 0; e < 8; ++e) s += wv[dir * 128 + s8 * 8 + e] * bf2f((bf16_t)v[e]);
    }
    ((float*)(p.ws + O_DN))[((size_t)(bh * 2 + dir) * NSTEP + nc) * 128 + k] = s;
    if (k == 0) {
      ((float*)(p.ws + O_GSC))[(bh * 2 + dir) * NSTEP + nc] = msc[dir];
      ((float*)(p.ws + O_MLOC))[(bh * 2 + dir) * NSTEP + nc] = msc[2 + dir];
    }
  }
  __syncthreads();
}

DI int chain_nc(int dir, int i) { return dir == 0 ? i : (i < 2 ? 1 - i : 67 - i); }
template <int DIR>
DI void scan_chain_elems(const float* __restrict__ DCc, bf16_t* __restrict__ CSTc, const float* fa, const float* fb, int e, int epos) {
  float C = 0.f;
#pragma unroll
  for (int blk = 0; blk < 3; ++blk) {
    float v[22];
#pragma unroll
    for (int j = 0; j < 22; ++j) {
      const int i = blk * 22 + j;
      const int nc = DIR == 0 ? i : (i < 2 ? 1 - i : 67 - i);
      v[j] = DCc[(size_t)nc * 16384 + e];
    }
#pragma unroll
    for (int j = 0; j < 22; ++j) {
      const int i = blk * 22 + j;
      const int nc = DIR == 0 ? i : (i < 2 ? 1 - i : 67 - i);
      if (i >= 2) CSTc[(size_t)(nc - 2) * 16384 + epos] = f2bf(C);
      C = fa[i] * C + fb[i] * v[j];
    }
  }
}
DI void phase_scan(const Params& p, char* smem) {
  float* fa = (float*)smem;
  float* fb = fa + 66;
  const float* GSC = (const float*)(p.ws + O_GSC); const float* MLOC = (const float*)(p.ws + O_MLOC);
  const float* DC = (const float*)(p.ws + O_DC); const float* DN = (const float*)(p.ws + O_DN);
  bf16_t* CST = (bf16_t*)(p.ws + O_CST); float* NST = (float*)(p.ws + O_NST); float* MST = (float*)(p.ws + O_MST);
  const int t = tid();
  for (int item = blockIdx.x; item < 16 * 64 + 16; item += gridDim.x) {
    const int chain = item < 1024 ? (item >> 6) : (item - 1024), dir = chain & 1;
    __syncthreads();
    if (t < NSTEP) { const int nc = chain_nc(dir, t); fa[t] = GSC[chain * NSTEP + nc]; fb[t] = MLOC[chain * NSTEP + nc]; }
    __syncthreads();
    if (t == 0) {
      float m = 0.f;
      for (int i = 0; i < NSTEP; ++i) {
        if (i >= 2 && item >= 1024) MST[chain * 64 + chain_nc(dir, i) - 2] = m;
        const float g = fa[i], ml = fb[i];
        const float mn = fmaxf(g + m, ml);
        fa[i] = __expf(g + m - mn); fb[i] = __expf(ml - mn);
        m = mn;
      }
    }
    __syncthreads();
    if (item < 1024) {
      const int e = (item & 63) * 256 + t;
      const int ev = e >> 7, ek = e & 127;
      const int epos = ((((ev >> 5) * 8 + (ek >> 4)) * 64) + ((ek >> 3) & 1) * 32 + (ev & 31)) * 8 + (ek & 7);
      const float* DCc = DC + (size_t)chain * NSTEP * 16384;
      bf16_t* CSTc = CST + (size_t)chain * 64 * 16384;
      if (dir == 0) scan_chain_elems<0>(DCc, CSTc, fa, fb, e, epos);
      else scan_chain_elems<1>(DCc, CSTc, fa, fb, e, epos);
    } else if (t < 128) {
      const int k = t;
      float n = 0.f;
      for (int i = 0; i < NSTEP; ++i) {
        const int nc = chain_nc(dir, i);
        if (i >= 2) NST[((size_t)chain * 64 + (nc - 2)) * 128 + k] = n;
        n = fa[i] * n + fb[i] * DN[((size_t)chain * NSTEP + nc) * 128 + k];
      }
    }
  }
}

DI void mlstm_out_item(const Params& p, int item, char* smem) {
  float* gs = (float*)smem;
  float* bb = gs + 512;
  float* lib = bb + 256;
  float* mrow = lib + 256;
  float* aT = mrow + 256;
  float* nq = aT + 256;
  float* nst = nq + 256;
  char* sK = smem + 8192;
  char* sV = sK + 32768;
  int t_ = tid();
  asm volatile("" : "+v"(t_));
  const int t = t_, lane = t & 63, w = t >> 6, r = lane & 31, hh = lane >> 5;
  const int bh = item >> 6, c = item & 63, b = bh >> 2, h = bh & 3;
  const int sc = b * 64 + c, row0 = sc * 128;
  const float* GL = (const float*)(p.ws + O_GL);
  const bf16_t* Qc = (const bf16_t*)(p.ws + O_QC); const bf16_t* Kc = (const bf16_t*)(p.ws + O_KC);
  const bf16_t* VT = (const bf16_t*)(p.ws + O_VT) + (size_t)(sc * 4 + h) * 16384;
  const bf16_t* P = (const bf16_t*)(p.ws + O_P);
  const float* MST = (const float*)(p.ws + O_MST);
  bf16_t* MIX = (bf16_t*)(p.ws + O_HA);
#pragma unroll
  for (int i = 0; i < 8; ++i) {
    const int q = t + 256 * i, row = q >> 4, cc = q & 15;
    const int so = row * 256 + ((cc ^ (row & 15)) << 4);
    *(uint4*)(sK + so) = *(const uint4*)(Kc + (size_t)(row0 + row) * 512 + h * 128 + cc * 8);
    *(uint4*)(sV + so) = *(const uint4*)(VT + row * 128 + cc * 8);
  }
  for (int i = t; i < 512; i += 256) { const int ty = i >> 7, s = i & 127; gs[i] = GL[(size_t)(row0 + s) * 16 + ty * 4 + h]; }
  {
    const int dir = t >> 7, k = t & 127;
    nst[t] = ((const float*)(p.ws + O_NST))[((size_t)(bh * 2 + dir) * 64 + c) * 128 + k];
  }
  __syncthreads();
  {
    const int dir = t >> 7, s = t & 127;
    float bsum = 0.f;
    if (dir == 0) { for (int j = 0; j <= s; ++j) bsum += gs[128 + j]; }
    else { for (int j = s; j < 128; ++j) bsum += gs[384 + j]; }
    bb[t] = bsum;
    lib[t] = gs[dir * 256 + s] - bsum;
    const bf16_t* qr = Qc + (size_t)(row0 + s) * 512 + h * 128;
    float acc = 0.f;
    for (int k8 = 0; k8 < 16; ++k8) {
      const bf16x8 v = ldfrag(qr + k8 * 8);
#pragma unroll
      for (int e = 0; e < 8; ++e) acc += nst[dir * 128 + k8 * 8 + e] * bf2f((bf16_t)v[e]);
    }
    nq[t] = acc;
  }
  __syncthreads();
  {
    const int dir = t >> 7, s = t & 127;
    float pm = -INFINITY;
    if (dir == 0) { for (int j = 0; j <= s; ++j) pm = fmaxf(pm, lib[j]); }
    else { for (int j = s; j < 128; ++j) pm = fmaxf(pm, lib[128 + j]); }
    const float m_in = MST[(bh * 2 + dir) * 64 + c];
    const float mr = bb[t] + fmaxf(m_in, pm);
    mrow[t] = mr;
    aT[t] = expf(bb[t] + m_in - mr);
  }
  __syncthreads();
  const int tl = w * 32 + r;
  const bf16_t* qrow = Qc + (size_t)(row0 + tl) * 512 + h * 128 + hh * 8;
  bf16x8 qf[8];
#pragma unroll
  for (int ks = 0; ks < 8; ++ks) qf[ks] = ldfrag(qrow + ks * 16);
  const int swz = r & 15;
  const char* kp[8]; const char* vp[16];
#pragma unroll
  for (int ks = 0; ks < 8; ++ks) kp[ks] = sK + r * 256 + (((ks * 2 + hh) ^ swz) << 4);
#pragma unroll
  for (int cc = 0; cc < 16; ++cc) vp[cc] = sV + r * 256 + 8 * hh + ((cc ^ swz) << 4);
  float* Hb = (float*)(p.ws + O_DC) + (size_t)item * 16384 + tl;
  float* Hbh = Hb + 4 * hh * 128;
  f32x16 outa[4];
#define MLSTM_DIR(DIR)                                                                                                   \
  {                                                                                                                      \
    const bf16_t* CSTl = (const bf16_t*)(p.ws + O_CST) + ((size_t)(bh * 2 + DIR) * 64 + c) * 16384 + lane * 8;           \
    const float bbt = bb[DIR * 128 + tl], mrt = mrow[DIR * 128 + tl], at = aT[DIR * 128 + tl];                            \
    float dsum = 0.f;                                                                                                    \
    const float* libp = lib + DIR * 128 + 4 * hh;                                                                        \
    const int tb = tl - 4 * hh;                                                                                          \
    bf16x8 pf[8];                                                                                                        \
    _Pragma("unroll") for (int half = 0; half < 2; ++half) {                                                             \
      f32x16 st[2];                                                                                                      \
      st[0] = fzero(); st[1] = fzero();                                                                                  \
      _Pragma("unroll") for (int ks = 0; ks < 8; ++ks) {                                                                 \
        _Pragma("unroll") for (int r2 = 0; r2 < 2; ++r2)                                                                 \
          st[r2] = MFMA(*(const bf16x8*)(kp[ks] + (half * 2 + r2) * 8192), qf[ks], st[r2]);                              \
      }                                                                                                                  \
      _Pragma("unroll") for (int r2 = 0; r2 < 2; ++r2) {                                                                 \
        const int rb = half * 2 + r2;                                                                                    \
        _Pragma("unroll") for (int i = 0; i < 16; ++i) {                                                                 \
          const int sc_ = rb * 32 + (i & 3) + 8 * (i >> 2);                                           \
          const int diff = DIR == 0 ? (tb - sc_) : (sc_ - tb);                                                           \
          const float msk = (float)((unsigned)(~diff) >> 31);                                                            \
          const float v = st[r2][i] * __expf(fminf(bbt + libp[sc_] - mrt, 0.f)) * msk;                                    \
          st[r2][i] = v; dsum += v;                                                                                      \
        }                                                                                                                \
        pf[rb * 2] = pack8(st[r2][0], st[r2][1], st[r2][2], st[r2][3], st[r2][4], st[r2][5], st[r2][6], st[r2][7]);      \
        pf[rb * 2 + 1] = pack8(st[r2][8], st[r2][9], st[r2][10], st[r2][11], st[r2][12], st[r2][13], st[r2][14], st[r2][15]); \
      }                                                                                                                  \
      __builtin_amdgcn_sched_barrier(0);                                                                                 \
    }                                                                                                                    \
    dsum += __shfl_xor(dsum, 32);                                                                                        \
    const float den = dsum + at * nq[DIR * 128 + tl];                                                                    \
    const float dinv = 1.f / fmaxf(fabsf(den), expf(-mrt));                                                              \
    _Pragma("unroll") for (int half = 0; half < 2; ++half) {                                                             \
      f32x16 ha[2];                                                                                                      \
      ha[0] = fzero(); ha[1] = fzero();                                                                                  \
      _Pragma("unroll") for (int ks = 0; ks < 8; ++ks) {                                                                 \
        _Pragma("unroll") for (int r2 = 0; r2 < 2; ++r2)                                                                 \
          ha[r2] = MFMA(ldfrag(CSTl + ((half * 2 + r2) * 8 + ks) * 512), qf[ks], ha[r2]);                                \
        if (ks == 3) __builtin_amdgcn_sched_barrier(0);                                                                  \
      }                                                                                                                  \
      _Pragma("unroll") for (int r2 = 0; r2 < 2; ++r2)                                                                   \
        _Pragma("unroll") for (int i = 0; i < 16; ++i) ha[r2][i] *= at;                                                  \
      __builtin_amdgcn_sched_barrier(0);                                                                                 \
      _Pragma("unroll") for (int kk = 0; kk < 8; ++kk) {                                                                 \
        _Pragma("unroll") for (int r2 = 0; r2 < 2; ++r2) {                                                               \
          const s16x4 lo = *(const s16x4*)(vp[2 * kk] + (half * 2 + r2) * 8192);                                         \
          const s16x4 hi = *(const s16x4*)(vp[2 * kk + 1] + (half * 2 + r2) * 8192);                                     \
          ha[r2] = MFMA(__builtin_shufflevector(lo, hi, 0, 1, 2, 3, 4, 5, 6, 7), pf[kk], ha[r2]);                        \
        }                                                                                                                \
      }                                                                                                                  \
      _Pragma("unroll") for (int r2 = 0; r2 < 2; ++r2)                                                                   \
        _Pragma("unroll") for (int i = 0; i < 16; ++i) {                                                                 \
          float* hp = Hbh + ((half * 2 + r2) * 32 + (i & 3) + 8 * (i >> 2)) * 128;                                       \
          if (DIR == 0) *hp = ha[r2][i] * dinv;                                                                          \
          else outa[half * 2 + r2][i] = *hp + ha[r2][i] * dinv;                                                          \
        }                                                                                                                \
      __builtin_amdgcn_sched_barrier(0);                                                                                 \
    }                                                                                                                    \
  }
  MLSTM_DIR(0)
  MLSTM_DIR(1)
#undef MLSTM_DIR
  float ss = 0.f;
#pragma unroll
  for (int rb = 0; rb < 4; ++rb)
#pragma unroll
    for (int i = 0; i < 16; ++i) ss += outa[rb][i] * outa[rb][i];
  ss += __shfl_xor(ss, 32);
  const float rn = rsqrtf(ss * (1.f / 128.f) + EPS);
  const size_t row = (size_t)row0 + tl;
#pragma unroll
  for (int rb = 0; rb < 4; ++rb)
#pragma unroll
    for (int q4 = 0; q4 < 4; ++q4) {
      const int v = rb * 32 + 8 * q4 + 4 * hh;
      const s16x4 ov = *(const s16x4*)(P + row * PLD + 1536 + h * 128 + v);
      const float4 hg = *(const float4*)(p.ab_head_g + h * 128 + v);
      const float y0 = outa[rb][4 * q4] * rn * hg.x * sigmf(bf2f((bf16_t)ov[0]));
      const float y1 = outa[rb][4 * q4 + 1] * rn * hg.y * sigmf(bf2f((bf16_t)ov[1]));
      const float y2 = outa[rb][4 * q4 + 2] * rn * hg.z * sigmf(bf2f((bf16_t)ov[2]));
      const float y3 = outa[rb][4 * q4 + 3] * rn * hg.w * sigmf(bf2f((bf16_t)ov[3]));
      uint2 u; u.x = pack2(y0, y1); u.y = pack2(y2, y3);
      *(uint2*)(MIX + row * 1024 + h * 128 + v) = u;
    }
  __syncthreads();
}

DI void phase_topk(const Params& p, char* smem) {
  unsigned* vals = (unsigned*)smem;
  unsigned* hist = vals + 8448;
  unsigned* cntg = hist + 256;
  unsigned* cnte = cntg + 256;
  unsigned* misc = cnte + 256;
  const float* AFF = (const float*)(p.ws + O_AFF);
  int* IDX = (int*)(p.ws + O_IDX); float* GATE = (float*)(p.ws + O_GATE); int* INV = (int*)(p.ws + O_INV);
  const int t = tid();
  for (int item = blockIdx.x; item < 32; item += gridDim.x) {
    const float* a = AFF + (size_t)item * 8192;
    for (int i = t; i < 8192; i += 256) vals[i + (i >> 5)] = __float_as_uint(a[i]);
    unsigned prefix = 0, remaining = 1024;
    for (int pass = 0; pass < 4; ++pass) {
      const int shift = 24 - 8 * pass;
      hist[t] = 0;
      __syncthreads();
      const unsigned mask = pass == 0 ? 0u : (0xFFFFFFFFu << (shift + 8));
      for (int i = t; i < 8192; i += 256) {
        const unsigned u = vals[i + (i >> 5)];
        if ((u & mask) == (prefix & mask)) atomicAdd(&hist[(u >> shift) & 255], 1u);
      }
      __syncthreads();
      {
        unsigned above = 0;
        for (int bin = t + 1; bin < 256; ++bin) above += hist[bin];
        const unsigned mineh = hist[t];
        if (above < remaining && above + mineh >= remaining) {
          misc[0] = prefix | ((unsigned)t << shift);
          misc[1] = remaining - above;
        }
      }
      __syncthreads();
      prefix = misc[0]; remaining = misc[1];
      __syncthreads();
    }
    const unsigned T = prefix, need_eq = remaining;
    unsigned cg_ = 0, ce = 0;
    for (int j = 0; j < 32; ++j) {
      const int n = t * 32 + j;
      const unsigned u = vals[n + (n >> 5)];
      cg_ += u > T; ce += u == T;
    }
    cntg[t] = cg_; cnte[t] = ce;
    __syncthreads();
    unsigned pg = 0, pe = 0;
    for (int j = 0; j < t; ++j) { pg += cntg[j]; pe += cnte[j]; }
    for (int j = 0; j < 32; ++j) {
      const int n = t * 32 + j;
      const unsigned u = vals[n + (n >> 5)];
      if (u > T) { IDX[item * 1024 + pg] = n; GATE[item * 1024 + pg] = __uint_as_float(u); INV[((size_t)(item >> 4) * 8192 + n) * 16 + (item & 15)] = (int)pg + 1; ++pg; }
      else if (u == T) {
        if (pe < need_eq) { const unsigned slot = 1024 - need_eq + pe; IDX[item * 1024 + slot] = n; GATE[item * 1024 + slot] = __uint_as_float(u); INV[((size_t)(item >> 4) * 8192 + n) * 16 + (item & 15)] = (int)slot + 1; }
        ++pe;
      }
    }
    __syncthreads();
  }
}

DI void phase_stats(const Params& p, char* smem) {
  float* red = (float*)smem;
  const bf16_t* GVT = (const bf16_t*)(p.ws + O_GVT);
  float* PART = (float*)(p.ws + O_STATS);
  const int t = tid(), qq = t & 31, cg_ = t >> 5;
  for (int item = blockIdx.x; item < 1024; item += gridDim.x) {
    const int chunk = item >> 3, cgrp = item & 7;
    const bf16_t* base = GVT + ((size_t)chunk * 2048 + cgrp * 256) * 128 + qq * 4;
    float s[4] = {0.f, 0.f, 0.f, 0.f}, s2[4] = {0.f, 0.f, 0.f, 0.f};
#pragma unroll 8
    for (int c = cg_; c < 256; c += 8) {
      const s16x4 v = *(const s16x4*)(base + (size_t)c * 128);
#pragma unroll
      for (int e = 0; e < 4; ++e) { const float f = bf2f((bf16_t)v[e]); s[e] += f; s2[e] += f * f; }
    }
#pragma unroll
    for (int e = 0; e < 4; ++e) { red[(cg_ * 128 + qq * 4 + e) * 2] = s[e]; red[(cg_ * 128 + qq * 4 + e) * 2 + 1] = s2[e]; }
    __syncthreads();
    if (t < 128) {
      float a = 0.f, b2 = 0.f;
      for (int g = 0; g < 8; ++g) { a += red[(g * 128 + t) * 2]; b2 += red[(g * 128 + t) * 2 + 1]; }
      PART[((size_t)item * 128 + t) * 2] = a;
      PART[((size_t)item * 128 + t) * 2 + 1] = b2;
    }
    __syncthreads();
  }
}
DI void phase_spatial(const Params& p, char* smem) {
  float* smu = (float*)smem;
  float* srs = smu + 128;
  const bf16_t* GVT = (const bf16_t*)(p.ws + O_GVT); const bf16_t* U = (const bf16_t*)(p.ws + O_U);
  const float* PART = (const float*)(p.ws + O_STATS);
  bf16_t* UV = (bf16_t*)(p.ws + O_UV);
  for (int item = blockIdx.x; item < 1024; item += gridDim.x) {
    int t_ = tid();
    const int t = t_, lane = t & 63, w = t >> 6, r = lane & 31, hh = lane >> 5;
    const int chunk = item >> 3, g = item & 7;
    if (t < 128) {
      float a = 0.f, b2 = 0.f;
#pragma unroll
      for (int j = 0; j < 8; ++j) { a += PART[((size_t)(chunk * 8 + j) * 128 + t) * 2]; b2 += PART[((size_t)(chunk * 8 + j) * 128 + t) * 2 + 1]; }
      const float mu = a * (1.f / 2048.f);
      const float var = fmaxf(b2 * (1.f / 2048.f) - mu * mu, 0.f);
      smu[t] = mu; srs[t] = rsqrtf(var + EPS);
    }
    __syncthreads();
    const float* Ws = p.gm_w_s + (size_t)g * 16384;
    f32x16 acc[2][4];
#pragma unroll
    for (int i = 0; i < 4; ++i) { acc[0][i] = fzero(); acc[1][i] = fzero(); }
    const int cA = g * 256 + w * 64 + r, cB = cA + 32;
    const float lgA = p.gm_ln_g[cA], lbA = p.gm_ln_b[cA], lgB = p.gm_ln_g[cB], lbB = p.gm_ln_b[cB];
    const bf16_t* vA = GVT + ((size_t)chunk * 2048 + cA) * 128 + hh * 8;
    const bf16_t* vB = GVT + ((size_t)chunk * 2048 + cB) * 128 + hh * 8;
    for (int ks = 0; ks < 8; ++ks) {
      const bf16x8 ra = ldfrag(vA + ks * 16), rbv = ldfrag(vB + ks * 16);
      const float* mu = smu + ks * 16 + hh * 8; const float* rs = srs + ks * 16 + hh * 8;
      const bf16x8 aA = pack8((bf2f((bf16_t)ra[0]) - mu[0]) * rs[0] * lgA + lbA, (bf2f((bf16_t)ra[1]) - mu[1]) * rs[1] * lgA + lbA,
                              (bf2f((bf16_t)ra[2]) - mu[2]) * rs[2] * lgA + lbA, (bf2f((bf16_t)ra[3]) - mu[3]) * rs[3] * lgA + lbA,
                              (bf2f((bf16_t)ra[4]) - mu[4]) * rs[4] * lgA + lbA, (bf2f((bf16_t)ra[5]) - mu[5]) * rs[5] * lgA + lbA,
                              (bf2f((bf16_t)ra[6]) - mu[6]) * rs[6] * lgA + lbA, (bf2f((bf16_t)ra[7]) - mu[7]) * rs[7] * lgA + lbA);
      const bf16x8 aB = pack8((bf2f((bf16_t)rbv[0]) - mu[0]) * rs[0] * lgB + lbB, (bf2f((bf16_t)rbv[1]) - mu[1]) * rs[1] * lgB + lbB,
                              (bf2f((bf16_t)rbv[2]) - mu[2]) * rs[2] * lgB + lbB, (bf2f((bf16_t)rbv[3]) - mu[3]) * rs[3] * lgB + lbB,
                              (bf2f((bf16_t)rbv[4]) - mu[4]) * rs[4] * lgB + lbB, (bf2f((bf16_t)rbv[5]) - mu[5]) * rs[5] * lgB + lbB,
                              (bf2f((bf16_t)rbv[6]) - mu[6]) * rs[6] * lgB + lbB, (bf2f((bf16_t)rbv[7]) - mu[7]) * rs[7] * lgB + lbB);
#pragma unroll
      for (int pb = 0; pb < 4; ++pb) {
        const float* wp = Ws + (pb * 32 + r) * 128 + ks * 16 + hh * 8;
        const float4 w0 = *(const float4*)wp, w1 = *(const float4*)(wp + 4);
        const bf16x8 bw = pack8(w0.x, w0.y, w0.z, w0.w, w1.x, w1.y, w1.z, w1.w);
        acc[0][pb] = MFMA(aA, bw, acc[0][pb]);
        acc[1][pb] = MFMA(aB, bw, acc[1][pb]);
      }
    }
#pragma unroll
    for (int pb = 0; pb < 4; ++pb) {
      const int pp = pb * 32 + r;
      const float bs = p.gm_b_s[g * 128 + pp];
      const size_t rowo = ((size_t)chunk * 128 + pp) * 2048 + g * 256 + w * 64 + 4 * hh;
#pragma unroll
      for (int cb = 0; cb < 2; ++cb)
#pragma unroll
        for (int q4 = 0; q4 < 4; ++q4) {
          const size_t o = rowo + cb * 32 + 8 * q4;
          const s16x4 uu = *(const s16x4*)(U + o);
          uint2 st;
          st.x = pack2(bf2f((bf16_t)uu[0]) * (acc[cb][pb][4 * q4] + bs), bf2f((bf16_t)uu[1]) * (acc[cb][pb][4 * q4 + 1] + bs));
          st.y = pack2(bf2f((bf16_t)uu[2]) * (acc[cb][pb][4 * q4 + 2] + bs), bf2f((bf16_t)uu[3]) * (acc[cb][pb][4 * q4 + 3] + bs));
          *(uint2*)(UV + o) = st;
        }
    }
    __syncthreads();
  }
}

struct EpiBf16 {
  bf16_t* dst; int ld;
  DI void operator()(f32x16 (&acc)[2][2], int mb, int nb, int r, int hh) const {
#pragma unroll
    for (int mi = 0; mi < 2; ++mi)
#pragma unroll
      for (int ni = 0; ni < 2; ++ni)
#pragma unroll
        for (int i = 0; i < 16; ++i)
          dst[(size_t)(mb + mi * 32 + crow(i, hh)) * ld + nb + ni * 32 + r] = f2bf(acc[mi][ni][i]);
  }
};
struct EpiRes {
  float* out; const float* base; const float* gate;
  DI void operator()(f32x16 (&acc)[2][2], int mb, int nb, int r, int hh) const {
#pragma unroll
    for (int ni = 0; ni < 2; ++ni) {
      const int n = nb + ni * 32 + r;
      const float gt = gate[n];
#pragma unroll
      for (int mi = 0; mi < 2; ++mi) {
        const size_t o0 = (size_t)(mb + mi * 32 + 4 * hh) * 1024 + n;
        float* op = out + o0; const float* bp = base + o0;
#pragma unroll
        for (int i = 0; i < 16; ++i) {
          const int off = ((i & 3) + 8 * (i >> 2)) * 1024;
          op[off] = bp[off] + gt * acc[mi][ni][i];
        }
        __builtin_amdgcn_sched_barrier(0);
      }
    }
  }
};
struct EpiGelu {
  bf16_t* U; bf16_t* GVT; int m0, n0;
  DI void operator()(f32x16 (&acc)[2][2], int mb, int nb, int r, int hh) const {
    if (n0 < 2048) {
#pragma unroll
      for (int mi = 0; mi < 2; ++mi)
#pragma unroll
        for (int ni = 0; ni < 2; ++ni)
#pragma unroll
          for (int i = 0; i < 16; ++i)
            U[(size_t)(m0 + mb + mi * 32 + crow(i, hh)) * 2048 + n0 + nb + ni * 32 + r] = f2bf(geluf(acc[mi][ni][i]));
    } else {
      const int chunk = m0 >> 7;
#pragma unroll
      for (int mi = 0; mi < 2; ++mi)
#pragma unroll
        for (int ni = 0; ni < 2; ++ni) {
          const int cc = n0 - 2048 + nb + ni * 32 + r;
          bf16_t* d = GVT + ((size_t)chunk * 2048 + cc) * 128 + mb + mi * 32 + 4 * hh;
#pragma unroll
          for (int q4 = 0; q4 < 4; ++q4) {
            uint2 u;
            u.x = pack2(geluf(acc[mi][ni][4 * q4]), geluf(acc[mi][ni][4 * q4 + 1]));
            u.y = pack2(geluf(acc[mi][ni][4 * q4 + 2]), geluf(acc[mi][ni][4 * q4 + 3]));
            *(uint2*)(d + 8 * q4) = u;
          }
        }
    }
  }
};
struct EpiSwiglu {
  bf16_t* hid;
  DI void operator()(f32x16 (&acc)[2][2], int mb, int nb, int r, int hh) const {
    const int f = (nb >> 1) + r;
#pragma unroll
    for (int mi = 0; mi < 2; ++mi)
#pragma unroll
      for (int i = 0; i < 16; ++i) {
        const float gv = acc[mi][0][i], uv = acc[mi][1][i];
        hid[(size_t)(mb + mi * 32 + crow(i, hh)) * 1024 + f] = f2bf(siluf(gv) * uv);
      }
  }
};
struct EpiMoeOut {
  float* out; const int* idx; const float* gate; const float* gt2;
  int n0;
  DI void operator()(f32x16 (&acc)[2][2], int mb, int nb, int r, int hh) const {
#pragma unroll
    for (int mi = 0; mi < 2; ++mi)
#pragma unroll
      for (int i = 0; i < 16; ++i) {
        const int slot = mb + mi * 32 + crow(i, hh);
        const int tok = idx[slot];
        const float gs = gate[slot];
#pragma unroll
        for (int ni = 0; ni < 2; ++ni) {
          const int n = nb + ni * 32 + r;
          unsafeAtomicAdd(out + (size_t)tok * 1024 + n0 + n, gt2[n] * gs * acc[mi][ni][i]);
        }
      }
  }
};

DI void phase_moe1(const Params& p, char* smem) {
  const bf16_t* HA = (const bf16_t*)(p.ws + O_HA); const bf16_t* WGU = (const bf16_t*)(p.ws + O_MGU);
  const int* IDX = (const int*)(p.ws + O_IDX); bf16_t* HID = (bf16_t*)(p.ws + O_HID);
  const int t = tid(), lrow = t >> 3, lcol = (t & 7) * 8;
  for (TileWalk tw(256 * 16, smem); tw.valid(); tw.next()) {
    int mg, nt; tw.get(8, 8, 2, mg, nt);
    const int e = mg >> 4, b = (mg >> 3) & 1, mt = mg & 7, be = b * 16 + e;
    const bf16_t* ap[4]; const bf16_t* bp[4];
#pragma unroll
    for (int i = 0; i < 4; ++i) {
      const int tok = IDX[be * 1024 + mt * 128 + lrow + 32 * i];
      ap[i] = HA + ((size_t)b * 8192 + tok) * 1024 + lcol;
      bp[i] = WGU + ((size_t)e * 2048 + nt * 128 + lrow + 32 * i) * 1024 + lcol;
    }
    gemm_tile(ap, bp, 1024, smem, EpiSwiglu{HID + ((size_t)be * 1024 + mt * 128) * 1024 + nt * 64});
  }
}
DI void phase_moe2(const Params& p, int layer, char* smem) {
  const bf16_t* HID = (const bf16_t*)(p.ws + O_HID); const bf16_t* WD = (const bf16_t*)(p.ws + O_MD);
  const int* IDX = (const int*)(p.ws + O_IDX); const float* GATE = (const float*)(p.ws + O_GATE);
  const float* modv = (const float*)(p.ws + O_MODV);
  const int t = tid(), lrow = t >> 3, lcol = (t & 7) * 8;
  for (TileWalk tw(256 * 8, smem); tw.valid(); tw.next()) {
    int mg, nt; tw.get(8, 8, 1, mg, nt);
    const int e = mg >> 4, b = (mg >> 3) & 1, mt = mg & 7, be = b * 16 + e;
    const bf16_t* ap[4]; const bf16_t* bp[4];
#pragma unroll
    for (int i = 0; i < 4; ++i) {
      ap[i] = HID + ((size_t)be * 1024 + mt * 128 + lrow + 32 * i) * 1024 + lcol;
      bp[i] = WD + ((size_t)e * 1024 + nt * 128 + lrow + 32 * i) * 1024 + lcol;
    }
    gemm_tile(ap, bp, 1024, smem, EpiBf16{(bf16_t*)(p.ws + O_YE) + ((size_t)be * 1024 + mt * 128) * 1024 + nt * 128, 1024});
  }
}

DI void phase_final(const Params& p) {
  const int t = tid(), lane = t & 63, w = t >> 6;
  for (int row = blockIdx.x * 4 + w; row < NTOK; row += gridDim.x * 4) {
    float* src = p.out + (size_t)row * 1024;
    float4 xv[4]; float ss = 0.f;
#pragma unroll
    for (int i = 0; i < 4; ++i) xv[i] = *(const float4*)(src + (i * 64 + lane) * 4);
    {
      float4 ca[4];
      moe_combine_row(p, row, lane, ca);
      const float* g2 = (const float*)(p.ws + O_MODV) + (1 * 3 + (row >> 13)) * 6144 + 5 * 1024;
#pragma unroll
      for (int i = 0; i < 4; ++i) {
        const float4 gg = *(const float4*)(g2 + (i * 64 + lane) * 4);
        xv[i].x += gg.x * ca[i].x; xv[i].y += gg.y * ca[i].y; xv[i].z += gg.z * ca[i].z; xv[i].w += gg.w * ca[i].w;
      }
    }
#pragma unroll
    for (int i = 0; i < 4; ++i) ss += xv[i].x * xv[i].x + xv[i].y * xv[i].y + xv[i].z * xv[i].z + xv[i].w * xv[i].w;
    ss = wsum(ss);
    const float rstd = rsqrtf(ss * (1.f / 1024.f) + EPS);
#pragma unroll
    for (int i = 0; i < 4; ++i) {
      const int col = (i * 64 + lane) * 4;
      const float4 g4 = *(const float4*)(p.final_norm_g + col);
      float4 y; y.x = xv[i].x * rstd * g4.x; y.y = xv[i].y * rstd * g4.y; y.z = xv[i].z * rstd * g4.z; y.w = xv[i].w * rstd * g4.w;
      *(float4*)(src + col) = y;
    }
  }
}

constexpr int NPHASE = 22;
DI void run_phase(const Params& p, int ph, char* smem) {
  const float* modv = (const float*)(p.ws + O_MODV);
  switch (ph) {
#if !defined(ONLY) || ONLY == 0
    case 0:
      phase_adaln(p, smem);
      __syncthreads();
      tconv(p.ab_w_in, 2832, 2832, 1024, 1, 0, (bf16_t*)(p.ws + O_WIN), 0, 1, smem);
      tconv(p.ab_w_out, 1024, 1024, 1024, 1, 0, (bf16_t*)(p.ws + O_WOUT), 0, 0, smem);
      tconv(p.gm_w_in, 4096, 4096, 1024, 1, 0, (bf16_t*)(p.ws + O_GMIN), 0, 0, smem);
      tconv(p.gm_w_out, 1024, 1024, 2048, 1, 0, (bf16_t*)(p.ws + O_GMOUT), 0, 0, smem);
      tconv_moe(p, 0, smem);
      break;
#endif
#if !defined(ONLY) || ONLY == 1
    case 1: phase_modulate<1, false>(p, 0, 0, smem); break;
#endif
#if !defined(ONLY) || ONLY == 2
    case 2:
      gemm_dense((const bf16_t*)(p.ws + O_HA), (const bf16_t*)(p.ws + O_WIN), NROW, PLD, 1024, 6, 11, smem,
                 [&](int m0, int n0) { return EpiBf16{(bf16_t*)(p.ws + O_P) + (size_t)m0 * PLD + n0, PLD}; });
      break;
#endif
#if !defined(ONLY) || ONLY == 3
    case 3: phase_prep2(p, smem); break;
#endif
#if !defined(ONLY) || ONLY == 4
    case 4:
      for (int item = blockIdx.x; item < 1024 + 8 * NSTEP; item += gridDim.x) {
        if (item < 1024) attn_item(p, item); else mlstm_local_item(p, item - 1024, smem);
      }
      break;
#endif
#if !defined(ONLY) || ONLY == 5
    case 5: phase_scan(p, smem); break;
#endif
#if !defined(ONLY) || ONLY == 6
    case 6:
      for (int item = blockIdx.x; item < 512; item += gridDim.x) mlstm_out_item(p, item, smem);
      break;
#endif
#if !defined(ONLY) || ONLY == 7
    case 7:
      gemm_dense((const bf16_t*)(p.ws + O_HA), (const bf16_t*)(p.ws + O_WOUT), NTOK, 1024, 1024, 8, 8, smem,
                 [&](int m0, int n0) {
                   return EpiRes{p.out + (size_t)m0 * 1024 + n0, p.x + (size_t)m0 * 1024 + n0, modv + (0 * 3 + (m0 >> 13)) * 6144 + 2 * 1024 + n0};
                 });
      break;
#endif
#if !defined(ONLY) || ONLY == 8
    case 8: phase_modulate<2, false>(p, 0, 1, smem); break;
#endif
#if !defined(ONLY) || ONLY == 9
    case 9: phase_topk(p, smem); break;
#endif
#if !defined(ONLY) || ONLY == 10
    case 10: phase_moe1(p, smem); break;
#endif
#if !defined(ONLY) || ONLY == 11
    case 11: phase_moe2(p, 0, smem); break;
#endif
#if !defined(ONLY) || ONLY == 12
    case 12:
      phase_modulate<0, true>(p, 1, 0, smem);
      __syncthreads();
      tconv_moe(p, 1, smem);
      break;
#endif
#if !defined(ONLY) || ONLY == 13
    case 13:
      gemm_dense((const bf16_t*)(p.ws + O_HA), (const bf16_t*)(p.ws + O_GMIN), NTOK, 4096, 1024, 8, 8, smem,
                 [&](int m0, int n0) { return EpiGelu{(bf16_t*)(p.ws + O_U), (bf16_t*)(p.ws + O_GVT), m0, n0}; });
      break;
#endif
#if !defined(ONLY) || ONLY == 14
    case 14: phase_stats(p, smem); break;
#endif
#if !defined(ONLY) || ONLY == 15
    case 15: phase_spatial(p, smem); break;
#endif
#if !defined(ONLY) || ONLY == 16
    case 16:
      gemm_dense((const bf16_t*)(p.ws + O_UV), (const bf16_t*)(p.ws + O_GMOUT), NTOK, 1024, 2048, 8, 8, smem,
                 [&](int m0, int n0) {
                   return EpiRes{p.out + (size_t)m0 * 1024 + n0, p.out + (size_t)m0 * 1024 + n0, modv + (1 * 3 + (m0 >> 13)) * 6144 + 2 * 1024 + n0};
                 });
      break;
#endif
#if !defined(ONLY) || ONLY == 17
    case 17: phase_modulate<2, false>(p, 1, 1, smem); break;
#endif
#if !defined(ONLY) || ONLY == 18
    case 18: phase_topk(p, smem); break;
#endif
#if !defined(ONLY) || ONLY == 19
    case 19: phase_moe1(p, smem); break;
#endif
#if !defined(ONLY) || ONLY == 20
    case 20: phase_moe2(p, 1, smem); break;
#endif
#if !defined(ONLY) || ONLY == 21
    case 21: phase_final(p); break;
#endif
    default: break;
  }
}

#define XB_TMO      128
#define XB_XCNT(j)  (256  + 64 * (j))
#define XB_XSUB(j)  (1280 + 64 * (j))
#define XB_XGEN(j)  (2304 + 64 * (j))
#define XB_TOP      3328
#define XB_TOPGEN   3392
#define XCD_BAR_WORDS 3456
#define XB_SPIN_CAP (1u << 18)
#define LAS __attribute__((address_space(3)))
DI unsigned xb_ld(unsigned* p) { return __hip_atomic_load(p, __ATOMIC_RELAXED, __HIP_MEMORY_SCOPE_AGENT); }
DI unsigned xb_add(unsigned* p, unsigned v) { return __hip_atomic_fetch_add(p, v, __ATOMIC_RELAXED, __HIP_MEMORY_SCOPE_AGENT); }
DI unsigned xb_xcc_id() { return (unsigned)__builtin_amdgcn_s_getreg((3 << 11) | 20) & 0xFu; }
#define XB_SPIN(cond, bar) do { unsigned _sp = 0; while (cond) { __builtin_amdgcn_s_sleep(1); \
    if ((++_sp & 255u) == 0u) { if (xb_ld(&(bar)[XB_TMO])) break; if (_sp > XB_SPIN_CAP) { atomicAdd(&(bar)[XB_TMO], 1u); break; } } } } while (0)
struct XcdBarrier { unsigned* bar; unsigned x; volatile LAS unsigned* st; };
DI XcdBarrier xcd_barrier_post(unsigned* bar, volatile LAS unsigned* st) {
  XcdBarrier b; b.bar = bar; b.x = xb_xcc_id(); b.st = st;
  if (threadIdx.x == 0) st[3] = xb_add(&bar[XB_XCNT(b.x)], 1u);
  return b;
}
DI void xcd_barrier_complete(unsigned* bar, unsigned x, unsigned& nloc, unsigned& nx, unsigned& sbefore) {
  const unsigned G = gridDim.x * gridDim.y * gridDim.z;
  unsigned sum, cnt, mine, sp = 0u, sb = 0u;
  for (;;) {
    sum = 0u; cnt = 0u; mine = 0u; sb = 0u;
#pragma unroll
    for (unsigned j = 0; j < 16; ++j) { const unsigned c = xb_ld(&bar[XB_XCNT(j)]); sum += c; cnt += (c > 0u) ? 1u : 0u; mine = (j == x) ? c : mine; sb += (j < x) ? c : 0u; }
    if (sum == G) break;
    __builtin_amdgcn_s_sleep(1);
    if ((++sp & 255u) == 0u) { if (xb_ld(&bar[XB_TMO])) break; if (sp > XB_SPIN_CAP) { atomicAdd(&bar[XB_TMO], 1u); break; } }
  }
  nloc = mine > 0u ? mine : 1u; nx = cnt > 0u ? cnt : 1u; sbefore = sb;
}
DI void xcd_barrier(const XcdBarrier& b) {
  asm volatile("s_waitcnt vmcnt(0)" ::: "memory");
  __syncthreads();
  if (threadIdx.x == 0) {
    unsigned* bar = b.bar;
    __builtin_amdgcn_s_waitcnt(0);
    unsigned nloc = b.st[0], nx = b.st[1];
    if (nloc == 0u) { unsigned sbf; xcd_barrier_complete(bar, b.x, nloc, nx, sbf); b.st[0] = nloc; b.st[1] = nx; b.st[2] = sbf; }
    const unsigned old = xb_add(&bar[XB_XSUB(b.x)], 1u);
    const unsigned gen = old / nloc;
    if (old + 1u == (gen + 1u) * nloc) {
      __builtin_amdgcn_fence(__ATOMIC_RELEASE, "agent");
      asm volatile("s_waitcnt vmcnt(0)" ::: "memory");
      const unsigned og = xb_add(&bar[XB_TOP], 1u);
      const unsigned tg = og / nx;
      if (og + 1u == (tg + 1u) * nx) xb_add(&bar[XB_TOPGEN], 1u);
      else XB_SPIN(xb_ld(&bar[XB_TOPGEN]) == tg, bar);
      __builtin_amdgcn_fence(__ATOMIC_ACQUIRE, "agent");
      xb_add(&bar[XB_XGEN(b.x)], 1u);
      asm volatile("s_waitcnt vmcnt(0)" ::: "memory");
    } else {
      XB_SPIN(xb_ld(&bar[XB_XGEN(b.x)]) == gen, bar);
      __builtin_amdgcn_fence(__ATOMIC_ACQUIRE, "agent");
      asm volatile("s_waitcnt vmcnt(0)" ::: "memory");
    }
  }
  __syncthreads();
}

DI Params kargs() {
  Params P{};
#if defined(__HIP_DEVICE_COMPILE__)
  typedef const unsigned long long __attribute__((address_space(4))) CU;
  CU* q = (CU*)__builtin_amdgcn_kernarg_segment_ptr();
  asm volatile("" : "+s"(q));
#define GP(T, i) ((T*)(T __attribute__((address_space(1)))*)(q[i]))
  P.x = GP(const float, 0);
  P.c = GP(const float, 1);
  P.ctx = GP(const float, 2);
  P.c_ctx = GP(const float, 3);
  P.w_mod = GP(const float, 4);
  P.b_mod = GP(const float, 5);
  P.norm_mix_g = GP(const float, 6);
  P.norm_ffn_g = GP(const float, 7);
  P.final_norm_g = GP(const float, 8);
  P.ab_w_in = GP(const float, 9);
  P.ab_conv_w = GP(const float, 10);
  P.ab_gate_b = GP(const float, 11);
  P.ab_head_g = GP(const float, 12);
  P.ab_sink = GP(const float, 13);
  P.ab_w_out = GP(const float, 14);
  P.gm_w_in = GP(const float, 15);
  P.gm_ln_g = GP(const float, 16);
  P.gm_ln_b = GP(const float, 17);
  P.gm_w_s = GP(const float, 18);
  P.gm_b_s = GP(const float, 19);
  P.gm_w_out = GP(const float, 20);
  P.moe_w_router = GP(const float, 21);
  P.moe_w_gate = GP(const float, 22);
  P.moe_w_up = GP(const float, 23);
  P.moe_w_down = GP(const float, 24);
  P.out = GP(float, 25);
  P.ws = GP(char, 26);
#undef GP
#endif
  return P;
}
#if COOP
#ifndef REPEAT_MASK
#define REPEAT_MASK 0
#endif
__global__ void __launch_bounds__(256, 2) mega(Params p_unused) {
  __shared__ __attribute__((aligned(16))) char smem[73728 + 16];
  unsigned* xbw = (unsigned*)(smem + 73728);
  cg::grid_group grid = cg::this_grid();
  if (threadIdx.x < 4) xbw[threadIdx.x] = 0u;
  __syncthreads();
  XcdBarrier xb;
  { const Params pp = kargs(); xb = xcd_barrier_post((unsigned*)(pp.ws + O_BAR), (volatile LAS unsigned*)xbw); }
#define PHX(n) { const Params pp = kargs(); run_phase(pp, n, smem); } xcd_barrier(xb); \
  if ((REPEAT_MASK >> n) & 1) { { const Params pp = kargs(); run_phase(pp, n, smem); } xcd_barrier(xb); }
  { const Params pp = kargs(); run_phase(pp, 0, smem); }
  if (p_unused.ws == nullptr) grid.sync();
  xcd_barrier(xb);
  PHX(1) PHX(2) PHX(3) PHX(4) PHX(5) PHX(6) PHX(7) PHX(8) PHX(9) PHX(10)
  PHX(11) PHX(12) PHX(13) PHX(14) PHX(15) PHX(16) PHX(17) PHX(18) PHX(19) PHX(20)
  { const Params pp = kargs(); run_phase(pp, 21, smem); }
}
#else
__global__ void __launch_bounds__(256, 2) mega(Params p, int ph) {
  __shared__ __attribute__((aligned(16))) char smem[73728];
  run_phase(p, ph, smem);
}
#endif

extern "C" void kernel_launch(void* const* d_in, const int* in_sizes, int n_in, void* d_out, int out_size, void* d_ws,
                              size_t ws_size, hipStream_t stream) {
  (void)in_sizes; (void)n_in; (void)out_size;
  if (ws_size < WS_NEED) { fprintf(stderr, "workspace too small: %zu < %zu\n", ws_size, (size_t)WS_NEED); return; }
  static int grid_blocks = 0;
  if (!grid_blocks) {
    int dev = 0, cus = 0, per_cu = 0;
    hipGetDevice(&dev);
    hipDeviceGetAttribute(&cus, hipDeviceAttributeMultiprocessorCount, dev);
    hipOccupancyMaxActiveBlocksPerMultiprocessor(&per_cu, mega, 256, 0);
    if (per_cu < 1) per_cu = 1;
    if (per_cu > 2) per_cu = 2;
    grid_blocks = cus * per_cu;
  }
  Params p{};
  const float** f = (const float**)&p;
  for (int i = 0; i < 25; ++i) f[i] = (const float*)d_in[i];
  p.out = (float*)d_out;
  p.ws = (char*)d_ws;
#if COOP
  hipMemsetAsync((char*)d_ws + O_BAR, 0, XCD_BAR_WORDS * 4, stream);
  void* args[] = {&p};
  hipError_t e = hipLaunchCooperativeKernel((void*)mega, dim3(grid_blocks), dim3(256), args, 0, stream);
  if (e != hipSuccess) fprintf(stderr, "cooperative launch failed: %s (grid %d)\n", hipGetErrorString(e), grid_blocks);
#else
  for (int ph = 0; ph < NPHASE; ++ph) hipLaunchKernelGGL(mega, dim3(grid_blocks), dim3(256), 0, stream, p, ph);
#endif
}
```

```cpp
#include <hip/hip_runtime.h>
#include <hip/hip_cooperative_groups.h>
#include <cstdio>
namespace cg = cooperative_groups;

#define DI __device__ __forceinline__
typedef unsigned short bf16_t;
using bf16x8 = __attribute__((ext_vector_type(8))) short;
using s16x4 = __attribute__((ext_vector_type(4))) short;
using f32x16 = __attribute__((ext_vector_type(16))) float;
#define MFMA(a, b, c) __builtin_amdgcn_mfma_f32_32x32x16_bf16((a), (b), (c), 0, 0, 0)

#ifndef COOP
#define COOP 1
#endif

constexpr int DM = 1024, NBAT = 2, SEQ = 8192, NTOK = NBAT * SEQ, CTXL = 256, NROW = NTOK + NBAT * CTXL;
constexpr int PLD = 2816;
constexpr int NSTEP = 66;
constexpr float EPS = 1e-6f;

constexpr size_t al256(size_t x) { return (x + 255) & ~(size_t)255; }
constexpr size_t O_BAR = 0;
constexpr size_t O_WIN = 16384;
constexpr size_t O_WOUT = O_WIN + al256((size_t)PLD * 1024 * 2);
constexpr size_t O_GMIN = O_WOUT + al256((size_t)1024 * 1024 * 2);
constexpr size_t O_GMOUT = O_GMIN + al256((size_t)4096 * 1024 * 2);
constexpr size_t O_MGU = O_GMOUT + al256((size_t)1024 * 2048 * 2);
constexpr size_t O_MD = O_MGU + al256((size_t)16 * 2048 * 1024 * 2);
constexpr size_t O_MODV = O_MD + al256((size_t)16 * 1024 * 1024 * 2);
constexpr size_t O_HA = O_MODV + al256((size_t)2 * 3 * 6144 * 4);
constexpr size_t O_GL = O_HA + al256((size_t)NROW * 1024 * 2);
constexpr size_t O_AFF = O_GL + al256((size_t)NROW * 16 * 4);
constexpr size_t O_IDX = O_AFF + al256((size_t)32 * 8192 * 4);
constexpr size_t O_GATE = O_IDX + al256((size_t)32 * 1024 * 4);
constexpr size_t O_STATS = O_GATE + al256((size_t)32 * 1024 * 4);
constexpr size_t O_GSC = O_STATS + al256((size_t)NTOK * 16 * 4);
constexpr size_t O_MLOC = O_GSC + al256((size_t)16 * NSTEP * 4);
constexpr size_t O_DN = O_MLOC + al256((size_t)16 * NSTEP * 4);
constexpr size_t O_NST = O_DN + al256((size_t)16 * NSTEP * 128 * 4);
constexpr size_t O_MST = O_NST + al256((size_t)16 * 64 * 128 * 4);
constexpr size_t O_INV = O_MST + al256((size_t)16 * 64 * 4);
constexpr size_t O_R12 = O_INV + al256((size_t)NTOK * 16 * 4);
constexpr size_t O_P = O_R12;
constexpr size_t O_QC = O_P + al256((size_t)NROW * PLD * 2);
constexpr size_t O_KC = O_QC + al256((size_t)NTOK * 512 * 2);
constexpr size_t O_KT = O_KC + al256((size_t)NTOK * 512 * 2);
constexpr size_t O_VT = O_KT + al256((size_t)132 * 4 * 128 * 128 * 2);
constexpr size_t O_RQ = O_VT + al256((size_t)132 * 4 * 128 * 128 * 2);
constexpr size_t O_RK = O_RQ + al256((size_t)NTOK * 512 * 2);
constexpr size_t O_AVTX = O_RK + al256((size_t)NROW * 128 * 2);
constexpr size_t O_AVTC = O_AVTX + al256((size_t)4 * 64 * 8192 * 2);
constexpr size_t O_R12_END = O_AVTC + al256((size_t)4 * 64 * 256 * 2);
constexpr size_t O_HID = O_R12;
constexpr size_t O_U = O_R12;
constexpr size_t O_GVT = O_U + al256((size_t)NTOK * 2048 * 2);
static_assert(O_GVT + (size_t)NTOK * 2048 * 2 <= O_R12_END, "R12 too small");
constexpr size_t O_DC = O_R12_END;
constexpr size_t O_CST = O_DC + al256((size_t)16 * NSTEP * 16384 * 4);
constexpr size_t O_UV = O_DC;
constexpr size_t O_YE = O_DC;
constexpr size_t WS_NEED = O_CST + al256((size_t)16 * 64 * 16384 * 2);

struct Params {
  const float *x, *c, *ctx, *c_ctx, *w_mod, *b_mod, *norm_mix_g, *norm_ffn_g, *final_norm_g;
  const float *ab_w_in, *ab_conv_w, *ab_gate_b, *ab_head_g, *ab_sink, *ab_w_out;
  const float *gm_w_in, *gm_ln_g, *gm_ln_b, *gm_w_s, *gm_b_s, *gm_w_out;
  const float *moe_w_router, *moe_w_gate, *moe_w_up, *moe_w_down;
  float* out;
  char* ws;
};

DI bf16_t f2bf(float x) { unsigned u = __float_as_uint(x); u += 0x7fffu + ((u >> 16) & 1u); return (bf16_t)(u >> 16); }
DI float bf2f(bf16_t b) { return __uint_as_float(((unsigned)b) << 16); }
DI unsigned pack2(float a, float b) { return (unsigned)f2bf(a) | ((unsigned)f2bf(b) << 16); }
DI bf16x8 pack8(float a0, float a1, float a2, float a3, float a4, float a5, float a6, float a7) {
  uint4 u; u.x = pack2(a0, a1); u.y = pack2(a2, a3); u.z = pack2(a4, a5); u.w = pack2(a6, a7);
  return __builtin_bit_cast(bf16x8, u);
}
DI bf16x8 ldfrag(const bf16_t* p) { return *(const bf16x8*)p; }
DI bf16x8 ldfrag2(const bf16_t* p0, const bf16_t* p1) {
  s16x4 lo = *(const s16x4*)p0, hi = *(const s16x4*)p1;
  return __builtin_shufflevector(lo, hi, 0, 1, 2, 3, 4, 5, 6, 7);
}
DI int crow(int i, int hh) { return (i & 3) + 8 * (i >> 2) + 4 * hh; }
DI float siluf(float x) { return x / (1.f + __expf(-x)); }
DI float sigmf(float x) { return 1.f / (1.f + __expf(-x)); }
DI float logsigf(float x) { return fminf(x, 0.f) - log1pf(expf(-fabsf(x))); }
DI float geluf(float x) {
  const float u2 = 1.5957691216057308f * (x + 0.044715f * x * x * x);
  return x / (1.f + __expf(-u2));
}
DI float wsum(float v) {
#pragma unroll
  for (int o = 32; o > 0; o >>= 1) v += __shfl_xor(v, o);
  return v;
}
DI int tid() { int t = threadIdx.x; asm volatile("" : "+v"(t)); return t; }
DI f32x16 fzero() { f32x16 z; for (int i = 0; i < 16; ++i) z[i] = 0.f; return z; }

DI int tmap(int kind, int n) {
  if (kind == 0) return n;
  if (kind == 1) return n < 2048 ? n : (n < 2064 ? -1 : n - 16);
  int r = (n >> 6) * 128 + ((n >> 5) & 1) * 64 + (n & 31);
  return kind == 2 ? r : r + 32;
}
DI void tconv(const float* __restrict__ src, int ldn, int ncols, int K, int nmat, size_t sstride,
              bf16_t* __restrict__ dst, size_t dstride, int kind, char* smem) {
  float* sm = (float*)smem;
  const int t = tid();
  const int ntn = (ncols + 63) >> 6, ntk = K >> 6, per = ntn * ntk, total = per * nmat;
  const int c4 = t & 15, rr = t >> 4;
  float4 v0, v1, v2, v3;
#define TC_LOAD(tile_) { const int mat_ = (tile_) / per, tt_ = (tile_) % per; const int k0_ = (tt_ / ntn) * 64, n_ = (tt_ % ntn) * 64 + c4 * 4; \
    const float* s_ = src + (size_t)mat_ * sstride + (size_t)(k0_ + rr) * ldn + n_; \
    if (n_ < ncols) { v0 = *(const float4*)(s_); v1 = *(const float4*)(s_ + (size_t)16 * ldn); v2 = *(const float4*)(s_ + (size_t)32 * ldn); v3 = *(const float4*)(s_ + (size_t)48 * ldn); } \
    else { v0 = v1 = v2 = v3 = make_float4(0.f, 0.f, 0.f, 0.f); } }
  int tile = blockIdx.x;
  if (tile < total) TC_LOAD(tile)
  for (; tile < total; tile += gridDim.x) {
    const int mat = tile / per, tt = tile % per;
    const int k0 = (tt / ntn) * 64, n0 = (tt % ntn) * 64;
    bf16_t* d = dst + (size_t)mat * dstride;
    {
      float* q = sm + rr * 65 + c4 * 4;
      q[0] = v0.x; q[1] = v0.y; q[2] = v0.z; q[3] = v0.w;
      q[16 * 65 + 0] = v1.x; q[16 * 65 + 1] = v1.y; q[16 * 65 + 2] = v1.z; q[16 * 65 + 3] = v1.w;
      q[32 * 65 + 0] = v2.x; q[32 * 65 + 1] = v2.y; q[32 * 65 + 2] = v2.z; q[32 * 65 + 3] = v2.w;
      q[48 * 65 + 0] = v3.x; q[48 * 65 + 1] = v3.y; q[48 * 65 + 2] = v3.z; q[48 * 65 + 3] = v3.w;
    }
    if (tile + (int)gridDim.x < total) TC_LOAD(tile + (int)gridDim.x)
    __syncthreads();
    const int nl = t >> 2, kq = t & 3, n = n0 + nl;
    if (n < ncols) {
      const int row = tmap(kind, n);
      if (row >= 0) {
        uint4 o0, o1;
        const float* q = sm + (kq * 16) * 65 + nl;
        o0.x = pack2(q[0 * 65], q[1 * 65]); o0.y = pack2(q[2 * 65], q[3 * 65]); o0.z = pack2(q[4 * 65], q[5 * 65]); o0.w = pack2(q[6 * 65], q[7 * 65]);
        o1.x = pack2(q[8 * 65], q[9 * 65]); o1.y = pack2(q[10 * 65], q[11 * 65]); o1.z = pack2(q[12 * 65], q[13 * 65]); o1.w = pack2(q[14 * 65], q[15 * 65]);
        uint4* dp = (uint4*)(d + (size_t)row * K + k0 + kq * 16);
        dp[0] = o0; dp[1] = o1;
      }
    }
    __syncthreads();
  }
#undef TC_LOAD
}
DI void tconv_moe(const Params& p, int layer, char* smem) {
  const size_t wo = (size_t)layer * 16 * 1024 * 1024;
  tconv(p.moe_w_gate + wo, 1024, 1024, 1024, 16, (size_t)1024 * 1024, (bf16_t*)(p.ws + O_MGU), (size_t)2048 * 1024, 2, smem);
  tconv(p.moe_w_up + wo, 1024, 1024, 1024, 16, (size_t)1024 * 1024, (bf16_t*)(p.ws + O_MGU), (size_t)2048 * 1024, 3, smem);
  tconv(p.moe_w_down + wo, 1024, 1024, 1024, 16, (size_t)1024 * 1024, (bf16_t*)(p.ws + O_MD), (size_t)1024 * 1024, 0, smem);
}

DI void phase_adaln(const Params& p, char* smem) {
  float* sv = (float*)smem;
  float* red = sv + 3 * 1024;
  float* modv = (float*)(p.ws + O_MODV);
  const int t = tid();
  if (blockIdx.x >= 192) return;
  for (int i = t; i < 3 * 1024; i += 256) {
    const int v = i >> 10, k = i & 1023;
    const float cv = v < 2 ? p.c[v * 1024 + k] : p.c_ctx[k];
    sv[i] = siluf(cv);
  }
  __syncthreads();
  for (int item = blockIdx.x; item < 192; item += gridDim.x) {
    const int l = item / 96, cb = item % 96;
    const int cq = t & 15, kg = t >> 4;
    const float* w = p.w_mod + (size_t)l * 1024 * 6144 + cb * 64 + cq * 4;
    float a0[4] = {0.f, 0.f, 0.f, 0.f}, a1[4] = {0.f, 0.f, 0.f, 0.f}, a2[4] = {0.f, 0.f, 0.f, 0.f};
    for (int i = 0; i < 64; ++i) {
      const int k = kg + 16 * i;
      const float4 wv = *(const float4*)(w + (size_t)k * 6144);
      const float s0 = sv[k], s1 = sv[1024 + k], s2 = sv[2048 + k];
      a0[0] += s0 * wv.x; a0[1] += s0 * wv.y; a0[2] += s0 * wv.z; a0[3] += s0 * wv.w;
      a1[0] += s1 * wv.x; a1[1] += s1 * wv.y; a1[2] += s1 * wv.z; a1[3] += s1 * wv.w;
      a2[0] += s2 * wv.x; a2[1] += s2 * wv.y; a2[2] += s2 * wv.z; a2[3] += s2 * wv.w;
    }
#pragma unroll
    for (int j = 0; j < 4; ++j) {
      red[(kg * 3 + 0) * 64 + cq * 4 + j] = a0[j];
      red[(kg * 3 + 1) * 64 + cq * 4 + j] = a1[j];
      red[(kg * 3 + 2) * 64 + cq * 4 + j] = a2[j];
    }
    __syncthreads();
    if (t < 192) {
      const int v = t >> 6, col = t & 63;
      float s = 0.f;
      for (int g = 0; g < 16; ++g) s += red[(g * 3 + v) * 64 + col];
      const int cc = cb * 64 + col;
      modv[(l * 3 + v) * 6144 + cc] = s + p.b_mod[l * 6144 + cc];
    }
    __syncthreads();
  }
}

DI void moe_combine_row(const Params& p, int row, int lane, float4 (&acc)[4]) {
  const int* INV = (const int*)(p.ws + O_INV); const float* GATE = (const float*)(p.ws + O_GATE);
  const bf16_t* YE = (const bf16_t*)(p.ws + O_YE);
  const int b = row >> 13;
  const int myslot = INV[(size_t)row * 16 + (lane & 15)];
#pragma unroll
  for (int i = 0; i < 4; ++i) acc[i] = make_float4(0.f, 0.f, 0.f, 0.f);
#pragma unroll 1
  for (int e = 0; e < 16; ++e) {
    const int slot = __builtin_amdgcn_readlane(myslot, e);
    if (slot != 0) {
      const int be = b * 16 + e;
      const float g = GATE[be * 1024 + slot - 1];
      const bf16_t* yr = YE + ((size_t)be * 1024 + slot - 1) * 1024;
#pragma unroll
      for (int i = 0; i < 4; ++i) {
        const s16x4 v = *(const s16x4*)(yr + (i * 64 + lane) * 4);
        acc[i].x += g * bf2f((bf16_t)v[0]); acc[i].y += g * bf2f((bf16_t)v[1]); acc[i].z += g * bf2f((bf16_t)v[2]); acc[i].w += g * bf2f((bf16_t)v[3]);
      }
    }
  }
}

template <int MODE, bool COMB>
DI void phase_modulate(const Params& p, int layer, int which, char* smem) {
  float* wt = (float*)smem;
  const int t = tid(), lane = t & 63, w = t >> 6;
  const float* modv = (const float*)(p.ws + O_MODV);
  bf16_t* HA = (bf16_t*)(p.ws + O_HA);
  if (MODE != 0) {
    const float* W = MODE == 1 ? p.ab_w_in + 2048 : p.moe_w_router + (size_t)layer * 1024 * 16;
    const int ld = MODE == 1 ? 2832 : 16;
    for (int i = t; i < 4096; i += 256) {
      const int k = i >> 2, e4 = i & 3;
      const float4 v = *(const float4*)(W + (size_t)k * ld + e4 * 4);
      wt[(e4 * 4 + 0) * 1024 + k] = v.x; wt[(e4 * 4 + 1) * 1024 + k] = v.y; wt[(e4 * 4 + 2) * 1024 + k] = v.z; wt[(e4 * 4 + 3) * 1024 + k] = v.w;
    }
    __syncthreads();
  }
  const float* gn = (which == 0 ? p.norm_mix_g : p.norm_ffn_g) + layer * 1024;
  const int nrows = MODE == 1 ? NROW : NTOK;
  const int rstride = gridDim.x * 4;
  float4 nx[4];
#define MOD_SRC(row_) (MODE == 1 ? ((row_) < NTOK ? p.x + (size_t)(row_) * 1024 : p.ctx + (size_t)((row_) - NTOK) * 1024) : p.out + (size_t)(row_) * 1024)
  {
    const int row0_ = blockIdx.x * 4 + w;
    if (row0_ < nrows) {
      const float* s0_ = MOD_SRC(row0_);
#pragma unroll
      for (int i = 0; i < 4; ++i) nx[i] = *(const float4*)(s0_ + (i * 64 + lane) * 4);
    }
  }
  for (int row = blockIdx.x * 4 + w; row < nrows; row += rstride) {
    const int v = (MODE == 1 && row >= NTOK) ? 2 : (row >> 13);
    const float* sh = modv + (layer * 3 + v) * 6144 + (which ? 3 : 0) * 1024;
    const float* sc = sh + 1024;
    float4 xv[4];
    float ss = 0.f;
#pragma unroll
    for (int i = 0; i < 4; ++i) xv[i] = nx[i];
    if (row + rstride < nrows) {
      const float* s1_ = MOD_SRC(row + rstride);
#pragma unroll
      for (int i = 0; i < 4; ++i) nx[i] = *(const float4*)(s1_ + (i * 64 + lane) * 4);
    }
    if (COMB) {
      float4 ca[4];
      moe_combine_row(p, row, lane, ca);
      const float* g2 = modv + ((layer - 1) * 3 + v) * 6144 + 5 * 1024;
#pragma unroll
      for (int i = 0; i < 4; ++i) {
        const float4 gg = *(const float4*)(g2 + (i * 64 + lane) * 4);
        xv[i].x += gg.x * ca[i].x; xv[i].y += gg.y * ca[i].y; xv[i].z += gg.z * ca[i].z; xv[i].w += gg.w * ca[i].w;
        *(float4*)(p.out + (size_t)row * 1024 + (i * 64 + lane) * 4) = xv[i];
      }
    }
#pragma unroll
    for (int i = 0; i < 4; ++i) ss += xv[i].x * xv[i].x + xv[i].y * xv[i].y + xv[i].z * xv[i].z + xv[i].w * xv[i].w;
    ss = wsum(ss);
    const float rstd = rsqrtf(ss * (1.f / 1024.f) + EPS);
    float4 yv[4];
#pragma unroll
    for (int i = 0; i < 4; ++i) {
      const int col = (i * 64 + lane) * 4;
      const float4 g4 = *(const float4*)(gn + col), s4 = *(const float4*)(sh + col), c4 = *(const float4*)(sc + col);
      float4 y;
      y.x = xv[i].x * rstd * g4.x * (1.f + c4.x) + s4.x;
      y.y = xv[i].y * rstd * g4.y * (1.f + c4.y) + s4.y;
      y.z = xv[i].z * rstd * g4.z * (1.f + c4.z) + s4.z;
      y.w = xv[i].w * rstd * g4.w * (1.f + c4.w) + s4.w;
      yv[i] = y;
      uint2 o; o.x = pack2(y.x, y.y); o.y = pack2(y.z, y.w);
      *(uint2*)(HA + (size_t)row * 1024 + col) = o;
    }
    if (MODE != 0) {
      float mine = 0.f;
#pragma unroll 1
      for (int e4 = 0; e4 < 16; e4 += 4) {
        float pe0 = 0.f, pe1 = 0.f, pe2 = 0.f, pe3 = 0.f;
#pragma unroll
        for (int i = 0; i < 4; ++i) {
          const float* wp = wt + e4 * 1024 + (i * 64 + lane) * 4;
          const float4 wa = *(const float4*)(wp), wb = *(const float4*)(wp + 1024), wc = *(const float4*)(wp + 2048), wd = *(const float4*)(wp + 3072);
          pe0 += yv[i].x * wa.x + yv[i].y * wa.y + yv[i].z * wa.z + yv[i].w * wa.w;
          pe1 += yv[i].x * wb.x + yv[i].y * wb.y + yv[i].z * wb.z + yv[i].w * wb.w;
          pe2 += yv[i].x * wc.x + yv[i].y * wc.y + yv[i].z * wc.z + yv[i].w * wc.w;
          pe3 += yv[i].x * wd.x + yv[i].y * wd.y + yv[i].z * wd.z + yv[i].w * wd.w;
        }
#pragma unroll
        for (int o = 32; o > 0; o >>= 1) {
          const float q0 = __shfl_xor(pe0, o), q1 = __shfl_xor(pe1, o), q2 = __shfl_xor(pe2, o), q3 = __shfl_xor(pe3, o);
          pe0 += q0; pe1 += q1; pe2 += q2; pe3 += q3;
        }
        const int el = (lane & 15) - e4;
        mine = el == 0 ? pe0 : (el == 1 ? pe1 : (el == 2 ? pe2 : (el == 3 ? pe3 : mine)));
      }
      const int e = lane & 15;
      if (MODE == 1) {
        float val = mine + p.ab_gate_b[e];
        if (((e >> 2) & 1) == 1) val = logsigf(val);
        if (lane < 16) ((float*)(p.ws + O_GL))[(size_t)row * 16 + lane] = val;
      } else {
        float mx = mine;
#pragma unroll
        for (int o = 8; o > 0; o >>= 1) mx = fmaxf(mx, __shfl_xor(mx, o));
        const float ex = expf(mine - mx);
        float sum = ex;
#pragma unroll
        for (int o = 8; o > 0; o >>= 1) sum += __shfl_xor(sum, o);
        if (lane < 16) ((float*)(p.ws + O_AFF))[((size_t)(row >> 13) * 16 + lane) * 8192 + (row & 8191)] = ex / sum;
        if (lane < 16) ((int*)(p.ws + O_INV))[(size_t)row * 16 + lane] = 0;
      }
    }
  }
}

template <bool DENSEA, class Epi>
DI void gemm_tile(const bf16_t* Abase, const unsigned (&aoff)[8], const bf16_t* Bbase, unsigned boff, int K, char* smem, Epi&& epi) {
  bf16_t* sA = (bf16_t*)smem;
  bf16_t* sB = sA + 256 * 72;
  const int t = tid(), lane = t & 63, w = t >> 6, wm = w >> 1, wn = w & 1, r = lane & 31, hh = lane >> 5;
  const int lrow = t >> 3, lcol = (t & 7) * 8;
  const unsigned bst = 32u * (unsigned)K;
  f32x16 acc[4][2];
#pragma unroll
  for (int i = 0; i < 4; ++i) { acc[i][0] = fzero(); acc[i][1] = fzero(); }
  uint4 A0, A1, A2, A3, A4, A5, A6, A7, B0, B1, B2, B3;
#define GLOADT(kn_) { \
    const bf16_t* Ak_ = Abase + (kn_); const bf16_t* Bk_ = Bbase + (kn_);     \
    if (DENSEA) { \
      A0 = *(const uint4*)(Ak_ + aoff[0]); A1 = *(const uint4*)((Ak_ + bst) + aoff[0]); A2 = *(const uint4*)((Ak_ + 2 * bst) + aoff[0]); A3 = *(const uint4*)((Ak_ + 3 * bst) + aoff[0]); \
      A4 = *(const uint4*)((Ak_ + 4 * bst) + aoff[0]); A5 = *(const uint4*)((Ak_ + 5 * bst) + aoff[0]); A6 = *(const uint4*)((Ak_ + 6 * bst) + aoff[0]); A7 = *(const uint4*)((Ak_ + 7 * bst) + aoff[0]); \
    } else { \
      A0 = *(const uint4*)(Ak_ + aoff[0]); A1 = *(const uint4*)(Ak_ + aoff[1]); A2 = *(const uint4*)(Ak_ + aoff[2]); A3 = *(const uint4*)(Ak_ + aoff[3]); \
      A4 = *(const uint4*)(Ak_ + aoff[4]); A5 = *(const uint4*)(Ak_ + aoff[5]); A6 = *(const uint4*)(Ak_ + aoff[6]); A7 = *(const uint4*)(Ak_ + aoff[7]); \
    } \
    B0 = *(const uint4*)(Bk_ + boff); B1 = *(const uint4*)((Bk_ + bst) + boff); B2 = *(const uint4*)((Bk_ + 2 * bst) + boff); B3 = *(const uint4*)((Bk_ + 3 * bst) + boff); }
  GLOADT(0)
  const int so = lrow * 72 + lcol;
  const bf16_t* cA = sA + (wm * 128 + r) * 72 + hh * 8;
  const bf16_t* cB = sB + (wn * 64 + r) * 72 + hh * 8;
  const int KT = K >> 6;
  for (int kt = 0; kt < KT; ++kt) {
    __syncthreads();
    *(uint4*)(sA + so) = A0; *(uint4*)(sA + so + 32 * 72) = A1; *(uint4*)(sA + so + 64 * 72) = A2; *(uint4*)(sA + so + 96 * 72) = A3;
    *(uint4*)(sA + so + 128 * 72) = A4; *(uint4*)(sA + so + 160 * 72) = A5; *(uint4*)(sA + so + 192 * 72) = A6; *(uint4*)(sA + so + 224 * 72) = A7;
    *(uint4*)(sB + so) = B0; *(uint4*)(sB + so + 32 * 72) = B1; *(uint4*)(sB + so + 64 * 72) = B2; *(uint4*)(sB + so + 96 * 72) = B3;
    __syncthreads();
    { const int kn = (kt + 1 < KT ? kt + 1 : kt) * 64; GLOADT(kn) }
    __builtin_amdgcn_sched_barrier(0);
#pragma unroll
    for (int ks = 0; ks < 4; ++ks) {
      const bf16x8 b0 = *(const bf16x8*)(cB + ks * 16), b1 = *(const bf16x8*)(cB + 32 * 72 + ks * 16);
#pragma unroll
      for (int mi = 0; mi < 4; ++mi) {
        const bf16x8 a = *(const bf16x8*)(cA + mi * 32 * 72 + ks * 16);
        acc[mi][0] = MFMA(a, b0, acc[mi][0]);
        acc[mi][1] = MFMA(a, b1, acc[mi][1]);
      }
      if (ks == 1) __builtin_amdgcn_sched_barrier(0);
    }
    __builtin_amdgcn_sched_barrier(0);
  }
#undef GLOADT
  epi(acc, wm * 128, wn * 64, r, hh);
}

struct TileWalk {
  int L, Lend, nl;
  DI TileWalk(int T, const char* smem) {
    const volatile unsigned* xw = (const volatile unsigned*)(smem + 73728);
    const int nloc = (int)xw[0], sb = (int)xw[2], rk = (int)xw[3];
    int G = (int)gridDim.x;
    asm volatile("" : "+s"(G));
    nl = nloc;
    L = (T * sb) / G + rk; Lend = (T * (sb + nloc)) / G;
  }
  DI bool valid() const { return L < Lend; }
  DI void next() { L += nl; }
  DI void get(int SM, int SN, int nsn, int& mt, int& nt) const {
    const int s = L / (SM * SN), wi = L % (SM * SN);
    mt = (s / nsn) * SM + wi / SN; nt = (s % nsn) * SN + wi % SN;
  }
};

template <class MakeEpi>
DI void gemm_dense(const bf16_t* A, const bf16_t* Bt, int M, int N, int K, int SM, int SN, char* smem, MakeEpi&& mk) {
  const int t = tid(), lrow = t >> 3, lcol = (t & 7) * 8;
  const int ntn = N >> 7, ntm = M >> 8;
  for (TileWalk tw(ntn * ntm, smem); tw.valid(); tw.next()) {
    int mt, nt; tw.get(SM, SN, ntn / SN, mt, nt);
    unsigned aoff[8];
#pragma unroll
    for (int i = 0; i < 8; ++i) aoff[i] = (unsigned)(lrow + 32 * i) * (unsigned)K + (unsigned)lcol;
    gemm_tile<true>(A + (size_t)mt * 256 * K, aoff, Bt + (size_t)(nt * 128) * K, (unsigned)lrow * (unsigned)K + (unsigned)lcol, K, smem, mk(mt * 256, nt * 128));
  }
}

DI void phase_prep2(const Params& p, char* smem) {
  bf16_t* T = (bf16_t*)smem;
  const bf16_t* P = (const bf16_t*)(p.ws + O_P);
  bf16_t* Qc = (bf16_t*)(p.ws + O_QC); bf16_t* Kc = (bf16_t*)(p.ws + O_KC);
  bf16_t* KT = (bf16_t*)(p.ws + O_KT); bf16_t* VT = (bf16_t*)(p.ws + O_VT);
  bf16_t* RQ = (bf16_t*)(p.ws + O_RQ); bf16_t* RK = (bf16_t*)(p.ws + O_RK);
  bf16_t* AVTX = (bf16_t*)(p.ws + O_AVTX); bf16_t* AVTC = (bf16_t*)(p.ws + O_AVTC);
  const int t = tid();
  for (int item = blockIdx.x; item < 132 * 6; item += gridDim.x) {
    const int sc = item / 6, part = item % 6;
    const bool isx = sc < 128;
    const int row0 = sc * 128;
    const int seq_lo = isx ? (sc >> 6) * 8192 : NTOK + ((sc - 128) >> 1) * 256;
    const int seq_hi = seq_lo + (isx ? 8192 : 256);
    if (part < 4) {
      const int h = part;
      const int col8 = t & 15, rsub = t >> 4;
      for (int pass = 0; pass < 3; ++pass) {
        if (pass == 2 && !isx) break;
        const int pcol = (pass == 0 ? 512 : (pass == 1 ? 1024 : 0)) + h * 128 + col8 * 8;
        float cw[5][8];
        if (pass != 1) {
#pragma unroll
          for (int j = 0; j < 5; ++j)
#pragma unroll
            for (int e = 0; e < 8; ++e) cw[j][e] = p.ab_conv_w[j * 1024 + (pass == 0 ? 512 : 0) + h * 128 + col8 * 8 + e];
        }
        for (int i = 0; i < 8; ++i) {
          const int rl = rsub + 16 * i, row = row0 + rl;
          uint4 o;
          if (pass == 1) {
            o = *(const uint4*)(P + (size_t)row * PLD + pcol);
          } else {
            float a[8];
#pragma unroll
            for (int e = 0; e < 8; ++e) a[e] = 0.f;
#pragma unroll
            for (int j = 0; j < 5; ++j) {
              const int rr = row + j - 2;
              if (rr >= seq_lo && rr < seq_hi) {
                const bf16x8 v = *(const bf16x8*)(P + (size_t)rr * PLD + pcol);
#pragma unroll
                for (int e = 0; e < 8; ++e) a[e] += cw[j][e] * bf2f((bf16_t)v[e]);
              }
            }
            const float scl = pass == 0 ? 0.08838834764831845f : 1.f;
#pragma unroll
            for (int e = 0; e < 8; ++e) a[e] = siluf(a[e]) * scl;
            o.x = pack2(a[0], a[1]); o.y = pack2(a[2], a[3]); o.z = pack2(a[4], a[5]); o.w = pack2(a[6], a[7]);
            if (isx) *(uint4*)((pass == 0 ? Kc : Qc) + (size_t)row * 512 + h * 128 + col8 * 8) = o;
          }
          if (pass < 2) *(uint4*)(T + rl * 136 + col8 * 8) = o;
        }
        if (pass < 2) {
          __syncthreads();
          bf16_t* dstT = (pass == 0 ? KT : VT) + (size_t)(sc * 4 + h) * 16384;
          const int d = t & 127, shf = t >> 7;
#pragma unroll
          for (int s8 = 0; s8 < 8; ++s8) {
            const bf16_t* q = T + (shf * 64 + s8 * 8) * 136 + d;
            uint4 o;
            o.x = (unsigned)q[0] | ((unsigned)q[136] << 16); o.y = (unsigned)q[2 * 136] | ((unsigned)q[3 * 136] << 16);
            o.z = (unsigned)q[4 * 136] | ((unsigned)q[5 * 136] << 16); o.w = (unsigned)q[6 * 136] | ((unsigned)q[7 * 136] << 16);
            *(uint4*)(dstT + d * 128 + shf * 64 + s8 * 8) = o;
          }
          __syncthreads();
        }
      }
    } else if (part == 4) {
      if (!isx) continue;
      for (int idx = t; idx < 512; idx += 256) {
        const int rl = idx >> 2, dc = idx & 3, row = row0 + rl, pos = row - seq_lo;
        const float rp = (float)(pos >> 6), cp = (float)(pos & 63);
        float cs[8], sn[8];
#pragma unroll
        for (int e = 0; e < 8; ++e) {
          const int a = dc * 8 + e;
          const float inv = powf(10000.f, -(float)(a & 15) / 16.f);
          const float ang = (a < 16 ? rp : cp) * inv;
          cs[e] = cosf(ang); sn[e] = sinf(ang);
        }
        for (int hq = 0; hq < 8; ++hq) {
          const bf16x8 x1 = *(const bf16x8*)(P + (size_t)row * PLD + 2048 + hq * 64 + dc * 8);
          const bf16x8 x2 = *(const bf16x8*)(P + (size_t)row * PLD + 2048 + hq * 64 + 32 + dc * 8);
          float o1[8], o2[8];
#pragma unroll
          for (int e = 0; e < 8; ++e) {
            const float a = bf2f((bf16_t)x1[e]), b = bf2f((bf16_t)x2[e]);
            o1[e] = (a * cs[e] - b * sn[e]) * 0.125f; o2[e] = (b * cs[e] + a * sn[e]) * 0.125f;
          }
          uint4 u1, u2;
          u1.x = pack2(o1[0], o1[1]); u1.y = pack2(o1[2], o1[3]); u1.z = pack2(o1[4], o1[5]); u1.w = pack2(o1[6], o1[7]);
          u2.x = pack2(o2[0], o2[1]); u2.y = pack2(o2[2], o2[3]); u2.z = pack2(o2[4], o2[5]); u2.w = pack2(o2[6], o2[7]);
          *(uint4*)(RQ + (size_t)row * 512 + hq * 64 + dc * 8) = u1;
          *(uint4*)(RQ + (size_t)row * 512 + hq * 64 + 32 + dc * 8) = u2;
        }
      }
    } else {
      for (int idx = t; idx < 512; idx += 256) {
        const int rl = idx >> 2, dc = idx & 3, row = row0 + rl, pos = row - seq_lo;
        const float rp = (float)(pos >> 6), cp = (float)(pos & 63);
        float cs[8], sn[8];
#pragma unroll
        for (int e = 0; e < 8; ++e) {
          const int a = dc * 8 + e;
          const float inv = powf(10000.f, -(float)(a & 15) / 16.f);
          const float ang = (a < 16 ? rp : cp) * inv;
          cs[e] = isx ? cosf(ang) : 1.f; sn[e] = isx ? sinf(ang) : 0.f;
        }
        for (int g = 0; g < 2; ++g) {
          const bf16x8 x1 = *(const bf16x8*)(P + (size_t)row * PLD + 2560 + g * 64 + dc * 8);
          const bf16x8 x2 = *(const bf16x8*)(P + (size_t)row * PLD + 2560 + g * 64 + 32 + dc * 8);
          float o1[8], o2[8];
#pragma unroll
          for (int e = 0; e < 8; ++e) {
            const float a = bf2f((bf16_t)x1[e]), b = bf2f((bf16_t)x2[e]);
            o1[e] = a * cs[e] - b * sn[e]; o2[e] = b * cs[e] + a * sn[e];
          }
          uint4 u1, u2;
          u1.x = pack2(o1[0], o1[1]); u1.y = pack2(o1[2], o1[3]); u1.z = pack2(o1[4], o1[5]); u1.w = pack2(o1[6], o1[7]);
          u2.x = pack2(o2[0], o2[1]); u2.y = pack2(o2[2], o2[3]); u2.z = pack2(o2[4], o2[5]); u2.w = pack2(o2[6], o2[7]);
          *(uint4*)(RK + (size_t)row * 128 + g * 64 + dc * 8) = u1;
          *(uint4*)(RK + (size_t)row * 128 + g * 64 + 32 + dc * 8) = u2;
        }
      }
      {
        const int col8 = t & 15, rsub = t >> 4;
        for (int i = 0; i < 8; ++i) {
          const int rl = rsub + 16 * i;
          *(uint4*)(T + rl * 136 + col8 * 8) = *(const uint4*)(P + (size_t)(row0 + rl) * PLD + 2688 + col8 * 8);
        }
        __syncthreads();
        const int d = t & 127, shf = t >> 7;
        const int b = isx ? (sc >> 6) : ((sc - 128) >> 1);
        const int pos0 = row0 - seq_lo;
        bf16_t* dst = isx ? AVTX + ((size_t)(b * 2 + (d >> 6)) * 64 + (d & 63)) * 8192 + pos0
                          : AVTC + ((size_t)(b * 2 + (d >> 6)) * 64 + (d & 63)) * 256 + pos0;
#pragma unroll
        for (int s8 = 0; s8 < 8; ++s8) {
          const bf16_t* q = T + (shf * 64 + s8 * 8) * 136 + d;
          uint4 o;
          o.x = (unsigned)q[0] | ((unsigned)q[136] << 16); o.y = (unsigned)q[2 * 136] | ((unsigned)q[3 * 136] << 16);
          o.z = (unsigned)q[4 * 136] | ((unsigned)q[5 * 136] << 16); o.w = (unsigned)q[6 * 136] | ((unsigned)q[7 * 136] << 16);
          *(uint4*)(dst + shf * 64 + s8 * 8) = o;
        }
        __syncthreads();
      }
    }
  }
}

DI void attn_item(const Params& p, int item) {
  const int g = item & 1, qb = (item >> 1) & 255, b = item >> 9;
  int t_ = tid();
  asm volatile("" : "+v"(t_));
  const int t = t_, lane = t & 63, w = t >> 6, r = lane & 31, hh = lane >> 5;
  const int hq = g * 4 + w, q0 = qb * 32;
  const bf16_t* RQ = (const bf16_t*)(p.ws + O_RQ); const bf16_t* RK = (const bf16_t*)(p.ws + O_RK);
  const bf16_t* AVTX = (const bf16_t*)(p.ws + O_AVTX); const bf16_t* AVTC = (const bf16_t*)(p.ws + O_AVTC);
  bf16_t* MIX = (bf16_t*)(p.ws + O_HA);
  const size_t qrow = (size_t)b * 8192 + q0 + r;
  bf16x8 qf[4];
#pragma unroll
  for (int ks = 0; ks < 4; ++ks) qf[ks] = ldfrag(RQ + qrow * 512 + hq * 64 + ks * 16 + hh * 8);
  float m = p.ab_sink[hq], l = hh == 0 ? 1.f : 0.f;
  f32x16 o0 = fzero(), o1 = fzero();
  const int ipos = q0 + r;
  const int lo = q0 - 128 < 0 ? 0 : q0 - 128, hi = q0 + 128 > 8192 - 32 ? 8192 - 32 : q0 + 128;
  const int nloc = ((hi - lo) >> 5) + 1, ntile = nloc + 8;
  const bf16_t* kloc = RK + (size_t)(b * 8192) * 128 + g * 64 + r * 128 + hh * 8;
  const bf16_t* kctx = RK + (size_t)(NTOK + b * 256) * 128 + g * 64 + r * 128 + hh * 8;
  const bf16_t* vloc = AVTX + (size_t)((b * 2 + g) * 64 + r) * 8192 + 4 * hh;
  const bf16_t* vctx = AVTC + (size_t)((b * 2 + g) * 64 + r) * 256 + 4 * hh;
  bf16x8 kf0, kf1, kf2, kf3, vf00, vf01, vf10, vf11;
#define ATT_LOAD(j_, K0, K1, K2, K3, V00, V01, V10, V11) { \
    const bool loc_ = (j_) < nloc; const int k0_ = loc_ ? lo + (j_) * 32 : ((j_) - nloc) * 32; \
    const bf16_t* kb_ = (loc_ ? kloc : kctx) + (size_t)k0_ * 128; \
    const bf16_t* vb_ = (loc_ ? vloc : vctx) + k0_; const int vs_ = (loc_ ? 8192 : 256) * 32; \
    K0 = ldfrag(kb_); K1 = ldfrag(kb_ + 16); K2 = ldfrag(kb_ + 32); K3 = ldfrag(kb_ + 48); \
    V00 = ldfrag2(vb_, vb_ + 8); V01 = ldfrag2(vb_ + 16, vb_ + 24); V10 = ldfrag2(vb_ + vs_, vb_ + vs_ + 8); V11 = ldfrag2(vb_ + vs_ + 16, vb_ + vs_ + 24); }
  ATT_LOAD(0, kf0, kf1, kf2, kf3, vf00, vf01, vf10, vf11)
#pragma unroll 1
  for (int tile = 0; tile < ntile; ++tile) {
    bf16x8 nk0 = kf0, nk1 = kf1, nk2 = kf2, nk3 = kf3, nv00 = vf00, nv01 = vf01, nv10 = vf10, nv11 = vf11;
    if (tile + 1 < ntile) ATT_LOAD(tile + 1, nk0, nk1, nk2, nk3, nv00, nv01, nv10, nv11)
    const bool local = tile < nloc;
    const int k0 = local ? lo + tile * 32 : (tile - nloc) * 32;
    f32x16 s = fzero();
    s = MFMA(kf0, qf[0], s); s = MFMA(kf1, qf[1], s); s = MFMA(kf2, qf[2], s); s = MFMA(kf3, qf[3], s);
    float tmax = -INFINITY;
#pragma unroll
    for (int i = 0; i < 16; ++i) {
      const int dj = ipos - (k0 + crow(i, hh));
      const bool ok = !local || (dj <= 128 && dj >= -128);
      s[i] = ok ? s[i] : -INFINITY;
      tmax = fmaxf(tmax, s[i]);
    }
    tmax = fmaxf(tmax, __shfl_xor(tmax, 32));
    const float mn = fmaxf(m, tmax), corr = __expf(m - mn);
    m = mn; l *= corr;
#pragma unroll
    for (int i = 0; i < 16; ++i) { o0[i] *= corr; o1[i] *= corr; }
#pragma unroll
    for (int i = 0; i < 16; ++i) { s[i] = __expf(s[i] - mn); l += s[i]; }
    const bf16x8 pf0 = pack8(s[0], s[1], s[2], s[3], s[4], s[5], s[6], s[7]);
    const bf16x8 pf1 = pack8(s[8], s[9], s[10], s[11], s[12], s[13], s[14], s[15]);
    o0 = MFMA(vf00, pf0, o0); o1 = MFMA(vf10, pf0, o1);
    o0 = MFMA(vf01, pf1, o0); o1 = MFMA(vf11, pf1, o1);
    kf0 = nk0; kf1 = nk1; kf2 = nk2; kf3 = nk3; vf00 = nv00; vf01 = nv01; vf10 = nv10; vf11 = nv11;
  }
#undef ATT_LOAD
  l += __shfl_xor(l, 32);
  const float inv = 1.f / l;
  bf16_t* dst = MIX + qrow * 1024 + 512 + hq * 64;
#pragma unroll
  for (int q4 = 0; q4 < 4; ++q4) {
    const int d = 8 * q4 + 4 * hh;
    uint2 u;
    u.x = pack2(o0[4 * q4] * inv, o0[4 * q4 + 1] * inv); u.y = pack2(o0[4 * q4 + 2] * inv, o0[4 * q4 + 3] * inv);
    *(uint2*)(dst + d) = u;
    u.x = pack2(o1[4 * q4] * inv, o1[4 * q4 + 1] * inv); u.y = pack2(o1[4 * q4 + 2] * inv, o1[4 * q4 + 3] * inv);
    *(uint2*)(dst + 32 + d) = u;
  }
}

DI void mlstm_local_item(const Params& p, int item, char* smem) {
  float* gs = (float*)smem;
  float* wv = gs + 512;
  float* msc = wv + 256;
  int t_ = tid();
  asm volatile("" : "+v"(t_));
  const int t = t_, lane = t & 63, w = t >> 6, wm = w >> 1, wn = w & 1, r = lane & 31, hh = lane >> 5;
  const int bh = item / NSTEP, nc = item % NSTEP, b = bh >> 2, h = bh & 3;
  const int sc = nc < 2 ? 128 + b * 2 + nc : b * 64 + (nc - 2);
  const int row0 = sc * 128;
  const float* GL = (const float*)(p.ws + O_GL);
  const bf16_t* KT = (const bf16_t*)(p.ws + O_KT) + (size_t)(sc * 4 + h) * 16384;
  const bf16_t* VT = (const bf16_t*)(p.ws + O_VT) + (size_t)(sc * 4 + h) * 16384;
  for (int i = t; i < 512; i += 256) { const int ty = i >> 7, s = i & 127; gs[i] = GL[(size_t)(row0 + s) * 16 + ty * 4 + h]; }
  __syncthreads();
  {
    const int dir = t >> 7, s = t & 127;
    float wval, tot = 0.f;
    if (dir == 0) {
      float bsum = 0.f;
      for (int j = 0; j < 128; ++j) { const float f = gs[128 + j]; tot += f; if (j <= s) bsum += f; }
      wval = tot - bsum + gs[s];
    } else {
      float pre = 0.f;
      for (int j = 0; j < 128; ++j) { const float f = gs[384 + j]; tot += f; if (j < s) pre += f; }
      wval = pre + gs[256 + s];
    }
    wv[dir * 128 + s] = wval;
    if (s == 0) msc[dir] = tot;
  }
  __syncthreads();
  {
    const int dir = t >> 7, s = t & 127;
    float mx = -INFINITY;
    for (int j = 0; j < 128; ++j) mx = fmaxf(mx, wv[dir * 128 + j]);
    const float wval = wv[dir * 128 + s];
    __syncthreads();
    wv[dir * 128 + s] = expf(wval - mx);
    if (s == 0) msc[2 + dir] = mx;
  }
  __syncthreads();
  float* DC = (float*)(p.ws + O_DC);
#pragma unroll 1
  for (int d = 0; d < 2; ++d) {
    f32x16 acc[2][2];
#pragma unroll
    for (int i = 0; i < 2; ++i)
#pragma unroll
      for (int j = 0; j < 2; ++j) acc[i][j] = fzero();
#pragma unroll 2
    for (int ks = 0; ks < 8; ++ks) {
      const bf16x8 ra0 = ldfrag(VT + (wm * 64 + r) * 128 + ks * 16 + hh * 8);
      const bf16x8 ra1 = ldfrag(VT + (wm * 64 + 32 + r) * 128 + ks * 16 + hh * 8);
      const bf16x8 b0 = ldfrag(KT + (wn * 64 + r) * 128 + ks * 16 + hh * 8);
      const bf16x8 b1 = ldfrag(KT + (wn * 64 + 32 + r) * 128 + ks * 16 + hh * 8);
      const float* ww = wv + d * 128 + ks * 16 + hh * 8;
      const bf16x8 a0 = pack8(bf2f((bf16_t)ra0[0]) * ww[0], bf2f((bf16_t)ra0[1]) * ww[1], bf2f((bf16_t)ra0[2]) * ww[2], bf2f((bf16_t)ra0[3]) * ww[3],
                              bf2f((bf16_t)ra0[4]) * ww[4], bf2f((bf16_t)ra0[5]) * ww[5], bf2f((bf16_t)ra0[6]) * ww[6], bf2f((bf16_t)ra0[7]) * ww[7]);
      const bf16x8 a1 = pack8(bf2f((bf16_t)ra1[0]) * ww[0], bf2f((bf16_t)ra1[1]) * ww[1], bf2f((bf16_t)ra1[2]) * ww[2], bf2f((bf16_t)ra1[3]) * ww[3],
                              bf2f((bf16_t)ra1[4]) * ww[4], bf2f((bf16_t)ra1[5]) * ww[5], bf2f((bf16_t)ra1[6]) * ww[6], bf2f((bf16_t)ra1[7]) * ww[7]);
      acc[0][0] = MFMA(a0, b0, acc[0][0]);
      acc[0][1] = MFMA(a0, b1, acc[0][1]);
      acc[1][0] = MFMA(a1, b0, acc[1][0]);
      acc[1][1] = MFMA(a1, b1, acc[1][1]);
    }
    float* dst = DC + ((size_t)(bh * 2 + d) * NSTEP + nc) * 16384;
#pragma unroll
    for (int mi = 0; mi < 2; ++mi)
#pragma unroll
      for (int ni = 0; ni < 2; ++ni)
#pragma unroll
        for (int i = 0; i < 16; ++i)
          dst[(wm * 64 + mi * 32 + crow(i, hh)) * 128 + wn * 64 + ni * 32 + r] = acc[mi][ni][i];
  }
  {
    const int dir = t >> 7, k = t & 127;
    float s = 0.f;
    for (int s8 = 0; s8 < 16; ++s8) {
      const bf16x8 v = ldfrag(KT + k * 128 + s8 * 8);
#pragma unroll
      for (int e = 0; e < 8; ++e) s += wv[dir * 128 + s8 * 8 + e] * bf2f((bf16_t)v[e]);
    }
    ((float*)(p.ws + O_DN))[((size_t)(bh * 2 + dir) * NSTEP + nc) * 128 + k] = s;
    if (k == 0) {
      ((float*)(p.ws + O_GSC))[(bh * 2 + dir) * NSTEP + nc] = msc[dir];
      ((float*)(p.ws + O_MLOC))[(bh * 2 + dir) * NSTEP + nc] = msc[2 + dir];
    }
  }
  __syncthreads();
}

DI int chain_nc(int dir, int i) { return dir == 0 ? i : (i < 2 ? 1 - i : 67 - i); }
template <int DIR>
DI void scan_chain_elems(const float* __restrict__ DCc, bf16_t* __restrict__ CSTc, const float* fa, const float* fb, int e, int epos) {
  float C = 0.f;
#pragma unroll
  for (int blk = 0; blk < 3; ++blk) {
    float v[22];
#pragma unroll
    for (int j = 0; j < 22; ++j) {
      const int i = blk * 22 + j;
      const int nc = DIR == 0 ? i : (i < 2 ? 1 - i : 67 - i);
      v[j] = DCc[(size_t)nc * 16384 + e];
    }
#pragma unroll
    for (int j = 0; j < 22; ++j) {
      const int i = blk * 22 + j;
      const int nc = DIR == 0 ? i : (i < 2 ? 1 - i : 67 - i);
      if (i >= 2) CSTc[(size_t)(nc - 2) * 16384 + epos] = f2bf(C);
      C = fa[i] * C + fb[i] * v[j];
    }
  }
}
DI void phase_scan(const Params& p, char* smem) {
  float* fa = (float*)smem;
  float* fb = fa + 66;
  const float* GSC = (const float*)(p.ws + O_GSC); const float* MLOC = (const float*)(p.ws + O_MLOC);
  const float* DC = (const float*)(p.ws + O_DC); const float* DN = (const float*)(p.ws + O_DN);
  bf16_t* CST = (bf16_t*)(p.ws + O_CST); float* NST = (float*)(p.ws + O_NST); float* MST = (float*)(p.ws + O_MST);
  const int t = tid();
  for (int item = blockIdx.x; item < 16 * 64 + 16; item += gridDim.x) {
    const int chain = item < 1024 ? (item >> 6) : (item - 1024), dir = chain & 1;
    __syncthreads();
    if (t < NSTEP) { const int nc = chain_nc(dir, t); fa[t] = GSC[chain * NSTEP + nc]; fb[t] = MLOC[chain * NSTEP + nc]; }
    __syncthreads();
    if (t == 0) {
      float m = 0.f;
      for (int i = 0; i < NSTEP; ++i) {
        if (i >= 2 && item >= 1024) MST[chain * 64 + chain_nc(dir, i) - 2] = m;
        const float g = fa[i], ml = fb[i];
        const float mn = fmaxf(g + m, ml);
        fa[i] = __expf(g + m - mn); fb[i] = __expf(ml - mn);
        m = mn;
      }
    }
    __syncthreads();
    if (item < 1024) {
      const int e = (item & 63) * 256 + t;
      const int ev = e >> 7, ek = e & 127;
      const int epos = ((((ev >> 5) * 8 + (ek >> 4)) * 64) + ((ek >> 3) & 1) * 32 + (ev & 31)) * 8 + (ek & 7);
      const float* DCc = DC + (size_t)chain * NSTEP * 16384;
      bf16_t* CSTc = CST + (size_t)chain * 64 * 16384;
      if (dir == 0) scan_chain_elems<0>(DCc, CSTc, fa, fb, e, epos);
      else scan_chain_elems<1>(DCc, CSTc, fa, fb, e, epos);
    } else if (t < 128) {
      const int k = t;
      float n = 0.f;
      for (int i = 0; i < NSTEP; ++i) {
        const int nc = chain_nc(dir, i);
        if (i >= 2) NST[((size_t)chain * 64 + (nc - 2)) * 128 + k] = n;
        n = fa[i] * n + fb[i] * DN[((size_t)chain * NSTEP + nc) * 128 + k];
      }
    }
  }
}

DI void mlstm_out_item(const Params& p, int item, char* smem) {
  float* gs = (float*)smem;
  float* bb = gs + 512;
  float* lib = bb + 256;
  float* mrow = lib + 256;
  float* aT = mrow + 256;
  float* nq = aT + 256;
  float* nst = nq + 256;
  char* sK = smem + 8192;
  char* sV = sK + 32768;
  int t_ = tid();
  asm volatile("" : "+v"(t_));
  const int t = t_, lane = t & 63, w = t >> 6, r = lane & 31, hh = lane >> 5;
  const int bh = item >> 6, c = item & 63, b = bh >> 2, h = bh & 3;
  const int sc = b * 64 + c, row0 = sc * 128;
  const float* GL = (const float*)(p.ws + O_GL);
  const bf16_t* Qc = (const bf16_t*)(p.ws + O_QC); const bf16_t* Kc = (const bf16_t*)(p.ws + O_KC);
  const bf16_t* VT = (const bf16_t*)(p.ws + O_VT) + (size_t)(sc * 4 + h) * 16384;
  const bf16_t* P = (const bf16_t*)(p.ws + O_P);
  const float* MST = (const float*)(p.ws + O_MST);
  bf16_t* MIX = (bf16_t*)(p.ws + O_HA);
#pragma unroll
  for (int i = 0; i < 8; ++i) {
    const int q = t + 256 * i, row = q >> 4, cc = q & 15;
    const int so = row * 256 + ((cc ^ (row & 15)) << 4);
    *(uint4*)(sK + so) = *(const uint4*)(Kc + (size_t)(row0 + row) * 512 + h * 128 + cc * 8);
    *(uint4*)(sV + so) = *(const uint4*)(VT + row * 128 + cc * 8);
  }
  for (int i = t; i < 512; i += 256) { const int ty = i >> 7, s = i & 127; gs[i] = GL[(size_t)(row0 + s) * 16 + ty * 4 + h]; }
  {
    const int dir = t >> 7, k = t & 127;
    nst[t] = ((const float*)(p.ws + O_NST))[((size_t)(bh * 2 + dir) * 64 + c) * 128 + k];
  }
  __syncthreads();
  {
    const int dir = t >> 7, s = t & 127;
    float bsum = 0.f;
    if (dir == 0) { for (int j = 0; j <= s; ++j) bsum += gs[128 + j]; }
    else { for (int j = s; j < 128; ++j) bsum += gs[384 + j]; }
    bb[t] = bsum;
    lib[t] = gs[dir * 256 + s] - bsum;
    const bf16_t* qr = Qc + (size_t)(row0 + s) * 512 + h * 128;
    float acc = 0.f;
    for (int k8 = 0; k8 < 16; ++k8) {
      const bf16x8 v = ldfrag(qr + k8 * 8);
#pragma unroll
      for (int e = 0; e < 8; ++e) acc += nst[dir * 128 + k8 * 8 + e] * bf2f((bf16_t)v[e]);
    }
    nq[t] = acc;
  }
  __syncthreads();
  {
    const int dir = t >> 7, s = t & 127;
    float pm = -INFINITY;
    if (dir == 0) { for (int j = 0; j <= s; ++j) pm = fmaxf(pm, lib[j]); }
    else { for (int j = s; j < 128; ++j) pm = fmaxf(pm, lib[128 + j]); }
    const float m_in = MST[(bh * 2 + dir) * 64 + c];
    const float mr = bb[t] + fmaxf(m_in, pm);
    mrow[t] = mr;
    aT[t] = expf(bb[t] + m_in - mr);
  }
  __syncthreads();
  const int tl = w * 32 + r;
  const bf16_t* qrow = Qc + (size_t)(row0 + tl) * 512 + h * 128 + hh * 8;
  bf16x8 qf[8];
#pragma unroll
  for (int ks = 0; ks < 8; ++ks) qf[ks] = ldfrag(qrow + ks * 16);
  const int swz = r & 15;
  const char* kp[8]; const char* vp[16];
#pragma unroll
  for (int ks = 0; ks < 8; ++ks) kp[ks] = sK + r * 256 + (((ks * 2 + hh) ^ swz) << 4);
#pragma unroll
  for (int cc = 0; cc < 16; ++cc) vp[cc] = sV + r * 256 + 8 * hh + ((cc ^ swz) << 4);
  float* Hb = (float*)(p.ws + O_DC) + (size_t)item * 16384 + tl;
  float* Hbh = Hb + 4 * hh * 128;
  f32x16 outa[4];
#define MLSTM_DIR(DIR)                                                                                                   \
  {                                                                                                                      \
    const bf16_t* CSTl = (const bf16_t*)(p.ws + O_CST) + ((size_t)(bh * 2 + DIR) * 64 + c) * 16384 + lane * 8;           \
    const float bbt = bb[DIR * 128 + tl], mrt = mrow[DIR * 128 + tl], at = aT[DIR * 128 + tl];                            \
    float dsum = 0.f;                                                                                                    \
    const float* libp = lib + DIR * 128 + 4 * hh;                                                                        \
    const int tb = tl - 4 * hh;                                                                                          \
    bf16x8 pf[8];                                                                                                        \
    _Pragma("unroll") for (int half = 0; half < 2; ++half) {                                                             \
      f32x16 st[2];                                                                                                      \
      st[0] = fzero(); st[1] = fzero();                                                                                  \
      _Pragma("unroll") for (int ks = 0; ks < 8; ++ks) {                                                                 \
        _Pragma("unroll") for (int r2 = 0; r2 < 2; ++r2)                                                                 \
          st[r2] = MFMA(*(const bf16x8*)(kp[ks] + (half * 2 + r2) * 8192), qf[ks], st[r2]);                              \
      }                                                                                                                  \
      _Pragma("unroll") for (int r2 = 0; r2 < 2; ++r2) {                                                                 \
        const int rb = half * 2 + r2;                                                                                    \
        _Pragma("unroll") for (int i = 0; i < 16; ++i) {                                                                 \
          const int sc_ = rb * 32 + (i & 3) + 8 * (i >> 2);                                           \
          const int diff = DIR == 0 ? (tb - sc_) : (sc_ - tb);                                                           \
          const float msk = (float)((unsigned)(~diff) >> 31);                                                            \
          const float v = st[r2][i] * __expf(fminf(bbt + libp[sc_] - mrt, 0.f)) * msk;                                    \
          st[r2][i] = v; dsum += v;                                                                                      \
        }                                                                                                                \
        pf[rb * 2] = pack8(st[r2][0], st[r2][1], st[r2][2], st[r2][3], st[r2][4], st[r2][5], st[r2][6], st[r2][7]);      \
        pf[rb * 2 + 1] = pack8(st[r2][8], st[r2][9], st[r2][10], st[r2][11], st[r2][12], st[r2][13], st[r2][14], st[r2][15]); \
      }                                                                                                                  \
      __builtin_amdgcn_sched_barrier(0);                                                                                 \
    }                                                                                                                    \
    dsum += __shfl_xor(dsum, 32);                                                                                        \
    const float den = dsum + at * nq[DIR * 128 + tl];                                                                    \
    const float dinv = 1.f / fmaxf(fabsf(den), expf(-mrt));                                                              \
    _Pragma("unroll") for (int half = 0; half < 2; ++half) {                                                             \
      f32x16 ha[2];                                                                                                      \
      ha[0] = fzero(); ha[1] = fzero();                                                                                  \
      _Pragma("unroll") for (int ks = 0; ks < 8; ++ks) {                                                                 \
        _Pragma("unroll") for (int r2 = 0; r2 < 2; ++r2)                                                                 \
          ha[r2] = MFMA(ldfrag(CSTl + ((half * 2 + r2) * 8 + ks) * 512), qf[ks], ha[r2]);                                \
        if (ks == 3) __builtin_amdgcn_sched_barrier(0);                                                                  \
      }                                                                                                                  \
      _Pragma("unroll") for (int r2 = 0; r2 < 2; ++r2)                                                                   \
        _Pragma("unroll") for (int i = 0; i < 16; ++i) ha[r2][i] *= at;                                                  \
      __builtin_amdgcn_sched_barrier(0);                                                                                 \
      _Pragma("unroll") for (int kk = 0; kk < 8; ++kk) {                                                                 \
        _Pragma("unroll") for (int r2 = 0; r2 < 2; ++r2) {                                                               \
          const s16x4 lo = *(const s16x4*)(vp[2 * kk] + (half * 2 + r2) * 8192);                                         \
          const s16x4 hi = *(const s16x4*)(vp[2 * kk + 1] + (half * 2 + r2) * 8192);                                     \
          ha[r2] = MFMA(__builtin_shufflevector(lo, hi, 0, 1, 2, 3, 4, 5, 6, 7), pf[kk], ha[r2]);                        \
        }                                                                                                                \
      }                                                                                                                  \
      _Pragma("unroll") for (int r2 = 0; r2 < 2; ++r2)                                                                   \
        _Pragma("unroll") for (int i = 0; i < 16; ++i) {                                                                 \
          float* hp = Hbh + ((half * 2 + r2) * 32 + (i & 3) + 8 * (i >> 2)) * 128;                                       \
          if (DIR == 0) *hp = ha[r2][i] * dinv;                                                                          \
          else outa[half * 2 + r2][i] = *hp + ha[r2][i] * dinv;                                                          \
        }                                                                                                                \
      __builtin_amdgcn_sched_barrier(0);                                                                                 \
    }                                                                                                                    \
  }
  MLSTM_DIR(0)
  MLSTM_DIR(1)
#undef MLSTM_DIR
  float ss = 0.f;
#pragma unroll
  for (int rb = 0; rb < 4; ++rb)
#pragma unroll
    for (int i = 0; i < 16; ++i) ss += outa[rb][i] * outa[rb][i];
  ss += __shfl_xor(ss, 32);
  const float rn = rsqrtf(ss * (1.f / 128.f) + EPS);
  const size_t row = (size_t)row0 + tl;
#pragma unroll
  for (int rb = 0; rb < 4; ++rb)
#pragma unroll
    for (int q4 = 0; q4 < 4; ++q4) {
      const int v = rb * 32 + 8 * q4 + 4 * hh;
      const s16x4 ov = *(const s16x4*)(P + row * PLD + 1536 + h * 128 + v);
      const float4 hg = *(const float4*)(p.ab_head_g + h * 128 + v);
      const float y0 = outa[rb][4 * q4] * rn * hg.x * sigmf(bf2f((bf16_t)ov[0]));
      const float y1 = outa[rb][4 * q4 + 1] * rn * hg.y * sigmf(bf2f((bf16_t)ov[1]));
      const float y2 = outa[rb][4 * q4 + 2] * rn * hg.z * sigmf(bf2f((bf16_t)ov[2]));
      const float y3 = outa[rb][4 * q4 + 3] * rn * hg.w * sigmf(bf2f((bf16_t)ov[3]));
      uint2 u; u.x = pack2(y0, y1); u.y = pack2(y2, y3);
      *(uint2*)(MIX + row * 1024 + h * 128 + v) = u;
    }
  __syncthreads();
}

DI void phase_topk(const Params& p, char* smem) {
  unsigned* vals = (unsigned*)smem;
  unsigned* hist = vals + 8448;
  unsigned* cntg = hist + 256;
  unsigned* cnte = cntg + 256;
  unsigned* misc = cnte + 256;
  const float* AFF = (const float*)(p.ws + O_AFF);
  int* IDX = (int*)(p.ws + O_IDX); float* GATE = (float*)(p.ws + O_GATE); int* INV = (int*)(p.ws + O_INV);
  const int t = tid();
  for (int item = blockIdx.x; item < 32; item += gridDim.x) {
    const float* a = AFF + (size_t)item * 8192;
    for (int i = t; i < 8192; i += 256) vals[i + (i >> 5)] = __float_as_uint(a[i]);
    unsigned prefix = 0, remaining = 1024;
    for (int pass = 0; pass < 4; ++pass) {
      const int shift = 24 - 8 * pass;
      hist[t] = 0;
      __syncthreads();
      const unsigned mask = pass == 0 ? 0u : (0xFFFFFFFFu << (shift + 8));
      for (int i = t; i < 8192; i += 256) {
        const unsigned u = vals[i + (i >> 5)];
        if ((u & mask) == (prefix & mask)) atomicAdd(&hist[(u >> shift) & 255], 1u);
      }
      __syncthreads();
      {
        unsigned above = 0;
        for (int bin = t + 1; bin < 256; ++bin) above += hist[bin];
        const unsigned mineh = hist[t];
        if (above < remaining && above + mineh >= remaining) {
          misc[0] = prefix | ((unsigned)t << shift);
          misc[1] = remaining - above;
        }
      }
      __syncthreads();
      prefix = misc[0]; remaining = misc[1];
      __syncthreads();
    }
    const unsigned T = prefix, need_eq = remaining;
    unsigned cg_ = 0, ce = 0;
    for (int j = 0; j < 32; ++j) {
      const int n = t * 32 + j;
      const unsigned u = vals[n + (n >> 5)];
      cg_ += u > T; ce += u == T;
    }
    cntg[t] = cg_; cnte[t] = ce;
    __syncthreads();
    unsigned pg = 0, pe = 0;
    for (int j = 0; j < t; ++j) { pg += cntg[j]; pe += cnte[j]; }
    for (int j = 0; j < 32; ++j) {
      const int n = t * 32 + j;
      const unsigned u = vals[n + (n >> 5)];
      if (u > T) { IDX[item * 1024 + pg] = n; GATE[item * 1024 + pg] = __uint_as_float(u); INV[((size_t)(item >> 4) * 8192 + n) * 16 + (item & 15)] = (int)pg + 1; ++pg; }
      else if (u == T) {
        if (pe < need_eq) { const unsigned slot = 1024 - need_eq + pe; IDX[item * 1024 + slot] = n; GATE[item * 1024 + slot] = __uint_as_float(u); INV[((size_t)(item >> 4) * 8192 + n) * 16 + (item & 15)] = (int)slot + 1; }
        ++pe;
      }
    }
    __syncthreads();
  }
}

DI void phase_stats(const Params& p, char* smem) {
  float* red = (float*)smem;
  const bf16_t* GVT = (const bf16_t*)(p.ws + O_GVT);
  float* PART = (float*)(p.ws + O_STATS);
  const int t = tid(), qq = t & 31, cg_ = t >> 5;
  for (int item = blockIdx.x; item < 1024; item += gridDim.x) {
    const int chunk = item >> 3, cgrp = item & 7;
    const bf16_t* base = GVT + ((size_t)chunk * 2048 + cgrp * 256) * 128 + qq * 4;
    float s[4] = {0.f, 0.f, 0.f, 0.f}, s2[4] = {0.f, 0.f, 0.f, 0.f};
#pragma unroll 8
    for (int c = cg_; c < 256; c += 8) {
      const s16x4 v = *(const s16x4*)(base + (size_t)c * 128);
#pragma unroll
      for (int e = 0; e < 4; ++e) { const float f = bf2f((bf16_t)v[e]); s[e] += f; s2[e] += f * f; }
    }
#pragma unroll
    for (int e = 0; e < 4; ++e) { red[(cg_ * 128 + qq * 4 + e) * 2] = s[e]; red[(cg_ * 128 + qq * 4 + e) * 2 + 1] = s2[e]; }
    __syncthreads();
    if (t < 128) {
      float a = 0.f, b2 = 0.f;
      for (int g = 0; g < 8; ++g) { a += red[(g * 128 + t) * 2]; b2 += red[(g * 128 + t) * 2 + 1]; }
      PART[((size_t)item * 128 + t) * 2] = a;
      PART[((size_t)item * 128 + t) * 2 + 1] = b2;
    }
    __syncthreads();
  }
}
DI void phase_spatial(const Params& p, char* smem) {
  float* smu = (float*)smem;
  float* srs = smu + 128;
  const bf16_t* GVT = (const bf16_t*)(p.ws + O_GVT); const bf16_t* U = (const bf16_t*)(p.ws + O_U);
  const float* PART = (const float*)(p.ws + O_STATS);
  bf16_t* UV = (bf16_t*)(p.ws + O_UV);
  for (int item = blockIdx.x; item < 1024; item += gridDim.x) {
    int t_ = tid();
    const int t = t_, lane = t & 63, w = t >> 6, r = lane & 31, hh = lane >> 5;
    const int chunk = item >> 3, g = item & 7;
    if (t < 128) {
      float a = 0.f, b2 = 0.f;
#pragma unroll
      for (int j = 0; j < 8; ++j) { a += PART[((size_t)(chunk * 8 + j) * 128 + t) * 2]; b2 += PART[((size_t)(chunk * 8 + j) * 128 + t) * 2 + 1]; }
      const float mu = a * (1.f / 2048.f);
      const float var = fmaxf(b2 * (1.f / 2048.f) - mu * mu, 0.f);
      smu[t] = mu; srs[t] = rsqrtf(var + EPS);
    }
    __syncthreads();
    const float* Ws = p.gm_w_s + (size_t)g * 16384;
    f32x16 acc[2][4];
#pragma unroll
    for (int i = 0; i < 4; ++i) { acc[0][i] = fzero(); acc[1][i] = fzero(); }
    const int cA = g * 256 + w * 64 + r, cB = cA + 32;
    const float lgA = p.gm_ln_g[cA], lbA = p.gm_ln_b[cA], lgB = p.gm_ln_g[cB], lbB = p.gm_ln_b[cB];
    const bf16_t* vA = GVT + ((size_t)chunk * 2048 + cA) * 128 + hh * 8;
    const bf16_t* vB = GVT + ((size_t)chunk * 2048 + cB) * 128 + hh * 8;
    for (int ks = 0; ks < 8; ++ks) {
      const bf16x8 ra = ldfrag(vA + ks * 16), rbv = ldfrag(vB + ks * 16);
      const float* mu = smu + ks * 16 + hh * 8; const float* rs = srs + ks * 16 + hh * 8;
      const bf16x8 aA = pack8((bf2f((bf16_t)ra[0]) - mu[0]) * rs[0] * lgA + lbA, (bf2f((bf16_t)ra[1]) - mu[1]) * rs[1] * lgA + lbA,
                              (bf2f((bf16_t)ra[2]) - mu[2]) * rs[2] * lgA + lbA, (bf2f((bf16_t)ra[3]) - mu[3]) * rs[3] * lgA + lbA,
                              (bf2f((bf16_t)ra[4]) - mu[4]) * rs[4] * lgA + lbA, (bf2f((bf16_t)ra[5]) - mu[5]) * rs[5] * lgA + lbA,
                              (bf2f((bf16_t)ra[6]) - mu[6]) * rs[6] * lgA + lbA, (bf2f((bf16_t)ra[7]) - mu[7]) * rs[7] * lgA + lbA);
      const bf16x8 aB = pack8((bf2f((bf16_t)rbv[0]) - mu[0]) * rs[0] * lgB + lbB, (bf2f((bf16_t)rbv[1]) - mu[1]) * rs[1] * lgB + lbB,
                              (bf2f((bf16_t)rbv[2]) - mu[2]) * rs[2] * lgB + lbB, (bf2f((bf16_t)rbv[3]) - mu[3]) * rs[3] * lgB + lbB,
                              (bf2f((bf16_t)rbv[4]) - mu[4]) * rs[4] * lgB + lbB, (bf2f((bf16_t)rbv[5]) - mu[5]) * rs[5] * lgB + lbB,
                              (bf2f((bf16_t)rbv[6]) - mu[6]) * rs[6] * lgB + lbB, (bf2f((bf16_t)rbv[7]) - mu[7]) * rs[7] * lgB + lbB);
#pragma unroll
      for (int pb = 0; pb < 4; ++pb) {
        const float* wp = Ws + (pb * 32 + r) * 128 + ks * 16 + hh * 8;
        const float4 w0 = *(const float4*)wp, w1 = *(const float4*)(wp + 4);
        const bf16x8 bw = pack8(w0.x, w0.y, w0.z, w0.w, w1.x, w1.y, w1.z, w1.w);
        acc[0][pb] = MFMA(aA, bw, acc[0][pb]);
        acc[1][pb] = MFMA(aB, bw, acc[1][pb]);
      }
    }
#pragma unroll
    for (int pb = 0; pb < 4; ++pb) {
      const int pp = pb * 32 + r;
      const float bs = p.gm_b_s[g * 128 + pp];
      const size_t rowo = ((size_t)chunk * 128 + pp) * 2048 + g * 256 + w * 64 + 4 * hh;
#pragma unroll
      for (int cb = 0; cb < 2; ++cb)
#pragma unroll
        for (int q4 = 0; q4 < 4; ++q4) {
          const size_t o = rowo + cb * 32 + 8 * q4;
          const s16x4 uu = *(const s16x4*)(U + o);
          uint2 st;
          st.x = pack2(bf2f((bf16_t)uu[0]) * (acc[cb][pb][4 * q4] + bs), bf2f((bf16_t)uu[1]) * (acc[cb][pb][4 * q4 + 1] + bs));
          st.y = pack2(bf2f((bf16_t)uu[2]) * (acc[cb][pb][4 * q4 + 2] + bs), bf2f((bf16_t)uu[3]) * (acc[cb][pb][4 * q4 + 3] + bs));
          *(uint2*)(UV + o) = st;
        }
    }
    __syncthreads();
  }
}

struct EpiBf16 {
  bf16_t* dst; int ld;
  DI void operator()(f32x16 (&acc)[4][2], int mb, int nb, int r, int hh) const {
#pragma unroll
    for (int mi = 0; mi < 4; ++mi)
#pragma unroll
      for (int ni = 0; ni < 2; ++ni)
#pragma unroll
        for (int i = 0; i < 16; ++i)
          dst[(size_t)(mb + mi * 32 + crow(i, hh)) * ld + nb + ni * 32 + r] = f2bf(acc[mi][ni][i]);
  }
};
struct EpiRes {
  float* out; const float* base; const float* gate;
  DI void operator()(f32x16 (&acc)[4][2], int mb, int nb, int r, int hh) const {
#pragma unroll
    for (int ni = 0; ni < 2; ++ni) {
      const int n = nb + ni * 32 + r;
      const float gt = gate[n];
#pragma unroll
      for (int mi = 0; mi < 4; ++mi) {
        const unsigned o0 = (unsigned)(mb + mi * 32 + 4 * hh) * 1024u + (unsigned)n;
#pragma unroll
        for (int q4 = 0; q4 < 4; ++q4) {
          const float b0 = base[o0 + (8 * q4 + 0) * 1024], b1 = base[o0 + (8 * q4 + 1) * 1024], b2 = base[o0 + (8 * q4 + 2) * 1024], b3 = base[o0 + (8 * q4 + 3) * 1024];
          out[o0 + (8 * q4 + 0) * 1024] = b0 + gt * acc[mi][ni][4 * q4];
          out[o0 + (8 * q4 + 1) * 1024] = b1 + gt * acc[mi][ni][4 * q4 + 1];
          out[o0 + (8 * q4 + 2) * 1024] = b2 + gt * acc[mi][ni][4 * q4 + 2];
          out[o0 + (8 * q4 + 3) * 1024] = b3 + gt * acc[mi][ni][4 * q4 + 3];
          __builtin_amdgcn_sched_barrier(0);
        }
      }
    }
  }
};
struct EpiGelu {
  bf16_t* U; bf16_t* GVT; int m0, n0;
  DI void operator()(f32x16 (&acc)[4][2], int mb, int nb, int r, int hh) const {
    if (n0 < 2048) {
#pragma unroll
      for (int mi = 0; mi < 4; ++mi)
#pragma unroll
        for (int ni = 0; ni < 2; ++ni)
#pragma unroll
          for (int i = 0; i < 16; ++i)
            U[(size_t)(m0 + mb + mi * 32 + crow(i, hh)) * 2048 + n0 + nb + ni * 32 + r] = f2bf(geluf(acc[mi][ni][i]));
    } else {
#pragma unroll
      for (int mi = 0; mi < 4; ++mi) {
        const int mrow = m0 + mb + mi * 32;
        const int chunk = mrow >> 7, q0 = mrow & 127;
#pragma unroll
        for (int ni = 0; ni < 2; ++ni) {
          const int cc = n0 - 2048 + nb + ni * 32 + r;
          bf16_t* d = GVT + ((size_t)chunk * 2048 + cc) * 128 + q0 + 4 * hh;
#pragma unroll
          for (int q4 = 0; q4 < 4; ++q4) {
            uint2 u;
            u.x = pack2(geluf(acc[mi][ni][4 * q4]), geluf(acc[mi][ni][4 * q4 + 1]));
            u.y = pack2(geluf(acc[mi][ni][4 * q4 + 2]), geluf(acc[mi][ni][4 * q4 + 3]));
            *(uint2*)(d + 8 * q4) = u;
          }
        }
      }
    }
  }
};
struct EpiSwiglu {
  bf16_t* hid;
  DI void operator()(f32x16 (&acc)[4][2], int mb, int nb, int r, int hh) const {
    const int f = (nb >> 1) + r;
#pragma unroll
    for (int mi = 0; mi < 4; ++mi)
#pragma unroll
      for (int i = 0; i < 16; ++i) {
        const float gv = acc[mi][0][i], uv = acc[mi][1][i];
        hid[(size_t)(mb + mi * 32 + crow(i, hh)) * 1024 + f] = f2bf(siluf(gv) * uv);
      }
  }
};
DI void phase_moe1(const Params& p, char* smem) {
  const bf16_t* HA = (const bf16_t*)(p.ws + O_HA); const bf16_t* WGU = (const bf16_t*)(p.ws + O_MGU);
  const int* IDX = (const int*)(p.ws + O_IDX); bf16_t* HID = (bf16_t*)(p.ws + O_HID);
  const int t = tid(), lrow = t >> 3, lcol = (t & 7) * 8;
  for (TileWalk tw(128 * 16, smem); tw.valid(); tw.next()) {
    int mg, nt; tw.get(8, 8, 2, mg, nt);
    const int e = mg >> 3, b = (mg >> 2) & 1, mt = mg & 3, be = b * 16 + e;
    unsigned aoff[8];
#pragma unroll
    for (int i = 0; i < 8; ++i) aoff[i] = (unsigned)IDX[be * 1024 + mt * 256 + lrow + 32 * i] * 1024u + (unsigned)lcol;
    gemm_tile<false>(HA + (size_t)b * 8192 * 1024, aoff, WGU + ((size_t)e * 2048 + nt * 128) * 1024, (unsigned)lrow * 1024u + (unsigned)lcol, 1024, smem,
              EpiSwiglu{HID + ((size_t)be * 1024 + mt * 256) * 1024 + nt * 64});
  }
}
DI void phase_moe2(const Params& p, int layer, char* smem) {
  const bf16_t* HID = (const bf16_t*)(p.ws + O_HID); const bf16_t* WD = (const bf16_t*)(p.ws + O_MD);
  const int t = tid(), lrow = t >> 3, lcol = (t & 7) * 8;
  for (TileWalk tw(128 * 8, smem); tw.valid(); tw.next()) {
    int mg, nt; tw.get(8, 8, 1, mg, nt);
    const int e = mg >> 3, b = (mg >> 2) & 1, mt = mg & 3, be = b * 16 + e;
    unsigned aoff[8];
#pragma unroll
    for (int i = 0; i < 8; ++i) aoff[i] = (unsigned)(lrow + 32 * i) * 1024u + (unsigned)lcol;
    gemm_tile<true>(HID + ((size_t)be * 1024 + mt * 256) * 1024, aoff, WD + ((size_t)e * 1024 + nt * 128) * 1024, (unsigned)lrow * 1024u + (unsigned)lcol, 1024, smem,
              EpiBf16{(bf16_t*)(p.ws + O_YE) + ((size_t)be * 1024 + mt * 256) * 1024 + nt * 128, 1024});
  }
}

DI void phase_final(const Params& p) {
  const int t = tid(), lane = t & 63, w = t >> 6;
  for (int row = blockIdx.x * 4 + w; row < NTOK; row += gridDim.x * 4) {
    float* src = p.out + (size_t)row * 1024;
    float4 xv[4]; float ss = 0.f;
#pragma unroll
    for (int i = 0; i < 4; ++i) xv[i] = *(const float4*)(src + (i * 64 + lane) * 4);
    {
      float4 ca[4];
      moe_combine_row(p, row, lane, ca);
      const float* g2 = (const float*)(p.ws + O_MODV) + (1 * 3 + (row >> 13)) * 6144 + 5 * 1024;
#pragma unroll
      for (int i = 0; i < 4; ++i) {
        const float4 gg = *(const float4*)(g2 + (i * 64 + lane) * 4);
        xv[i].x += gg.x * ca[i].x; xv[i].y += gg.y * ca[i].y; xv[i].z += gg.z * ca[i].z; xv[i].w += gg.w * ca[i].w;
      }
    }
#pragma unroll
    for (int i = 0; i < 4; ++i) ss += xv[i].x * xv[i].x + xv[i].y * xv[i].y + xv[i].z * xv[i].z + xv[i].w * xv[i].w;
    ss = wsum(ss);
    const float rstd = rsqrtf(ss * (1.f / 1024.f) + EPS);
#pragma unroll
    for (int i = 0; i < 4; ++i) {
      const int col = (i * 64 + lane) * 4;
      const float4 g4 = *(const float4*)(p.final_norm_g + col);
      float4 y; y.x = xv[i].x * rstd * g4.x; y.y = xv[i].y * rstd * g4.y; y.z = xv[i].z * rstd * g4.z; y.w = xv[i].w * rstd * g4.w;
      *(float4*)(src + col) = y;
    }
  }
}

constexpr int NPHASE = 22;
DI void run_phase(const Params& p, int ph, char* smem) {
  const float* modv = (const float*)(p.ws + O_MODV);
  switch (ph) {
#if !defined(ONLY) || ONLY == 0
    case 0:
      phase_adaln(p, smem);
      __syncthreads();
      tconv(p.ab_w_in, 2832, 2832, 1024, 1, 0, (bf16_t*)(p.ws + O_WIN), 0, 1, smem);
      tconv(p.ab_w_out, 1024, 1024, 1024, 1, 0, (bf16_t*)(p.ws + O_WOUT), 0, 0, smem);
      tconv(p.gm_w_in, 4096, 4096, 1024, 1, 0, (bf16_t*)(p.ws + O_GMIN), 0, 0, smem);
      tconv(p.gm_w_out, 1024, 1024, 2048, 1, 0, (bf16_t*)(p.ws + O_GMOUT), 0, 0, smem);
      tconv_moe(p, 0, smem);
      break;
#endif
#if !defined(ONLY) || ONLY == 1
    case 1: phase_modulate<1, false>(p, 0, 0, smem); break;
#endif
#if !defined(ONLY) || ONLY == 2
    case 2:
      gemm_dense((const bf16_t*)(p.ws + O_HA), (const bf16_t*)(p.ws + O_WIN), NROW, PLD, 1024, 6, 11, smem,
                 [&](int m0, int n0) { return EpiBf16{(bf16_t*)(p.ws + O_P) + (size_t)m0 * PLD + n0, PLD}; });
      break;
#endif
#if !defined(ONLY) || ONLY == 3
    case 3: phase_prep2(p, smem); break;
#endif
#if !defined(ONLY) || ONLY == 4
    case 4:
      for (int item = blockIdx.x; item < 1024 + 8 * NSTEP; item += gridDim.x) {
        if (item < 1024) attn_item(p, item); else mlstm_local_item(p, item - 1024, smem);
      }
      break;
#endif
#if !defined(ONLY) || ONLY == 5
    case 5: phase_scan(p, smem); break;
#endif
#if !defined(ONLY) || ONLY == 6
    case 6:
      for (int item = blockIdx.x; item < 512; item += gridDim.x) mlstm_out_item(p, item, smem);
      break;
#endif
#if !defined(ONLY) || ONLY == 7
    case 7:
      gemm_dense((const bf16_t*)(p.ws + O_HA), (const bf16_t*)(p.ws + O_WOUT), NTOK, 1024, 1024, 8, 8, smem,
                 [&](int m0, int n0) {
                   return EpiRes{p.out + (size_t)m0 * 1024 + n0, p.x + (size_t)m0 * 1024 + n0, modv + (0 * 3 + (m0 >> 13)) * 6144 + 2 * 1024 + n0};
                 });
      break;
#endif
#if !defined(ONLY) || ONLY == 8
    case 8: phase_modulate<2, false>(p, 0, 1, smem); break;
#endif
#if !defined(ONLY) || ONLY == 9
    case 9: phase_topk(p, smem); break;
#endif
#if !defined(ONLY) || ONLY == 10
    case 10: phase_moe1(p, smem); break;
#endif
#if !defined(ONLY) || ONLY == 11
    case 11: phase_moe2(p, 0, smem); break;
#endif
#if !defined(ONLY) || ONLY == 12
    case 12:
      phase_modulate<0, true>(p, 1, 0, smem);
      __syncthreads();
      tconv_moe(p, 1, smem);
      break;
#endif
#if !defined(ONLY) || ONLY == 13
    case 13:
      gemm_dense((const bf16_t*)(p.ws + O_HA), (const bf16_t*)(p.ws + O_GMIN), NTOK, 4096, 1024, 8, 8, smem,
                 [&](int m0, int n0) { return EpiGelu{(bf16_t*)(p.ws + O_U), (bf16_t*)(p.ws + O_GVT), m0, n0}; });
      break;
#endif
#if !defined(ONLY) || ONLY == 14
    case 14: phase_stats(p, smem); break;
#endif
#if !defined(ONLY) || ONLY == 15
    case 15: phase_spatial(p, smem); break;
#endif
#if !defined(ONLY) || ONLY == 16
    case 16:
      gemm_dense((const bf16_t*)(p.ws + O_UV), (const bf16_t*)(p.ws + O_GMOUT), NTOK, 1024, 2048, 8, 8, smem,
                 [&](int m0, int n0) {
                   return EpiRes{p.out + (size_t)m0 * 1024 + n0, p.out + (size_t)m0 * 1024 + n0, modv + (1 * 3 + (m0 >> 13)) * 6144 + 2 * 1024 + n0};
                 });
      break;
#endif
#if !defined(ONLY) || ONLY == 17
    case 17: phase_modulate<2, false>(p, 1, 1, smem); break;
#endif
#if !defined(ONLY) || ONLY == 18
    case 18: phase_topk(p, smem); break;
#endif
#if !defined(ONLY) || ONLY == 19
    case 19: phase_moe1(p, smem); break;
#endif
#if !defined(ONLY) || ONLY == 20
    case 20: phase_moe2(p, 1, smem); break;
#endif
#if !defined(ONLY) || ONLY == 21
    case 21: phase_final(p); break;
#endif
    default: break;
  }
}

#define XB_TMO      128
#define XB_XCNT(j)  (256  + 64 * (j))
#define XB_XSUB(j)  (1280 + 64 * (j))
#define XB_XGEN(j)  (2304 + 64 * (j))
#define XB_TOP      3328
#define XB_TOPGEN   3392
#define XCD_BAR_WORDS 3456
#define XB_SPIN_CAP (1u << 18)
#define LAS __attribute__((address_space(3)))
DI unsigned xb_ld(unsigned* p) { return __hip_atomic_load(p, __ATOMIC_RELAXED, __HIP_MEMORY_SCOPE_AGENT); }
DI unsigned xb_add(unsigned* p, unsigned v) { return __hip_atomic_fetch_add(p, v, __ATOMIC_RELAXED, __HIP_MEMORY_SCOPE_AGENT); }
DI unsigned xb_xcc_id() { return (unsigned)__builtin_amdgcn_s_getreg((3 << 11) | 20) & 0xFu; }
#define XB_SPIN(cond, bar) do { unsigned _sp = 0; while (cond) { __builtin_amdgcn_s_sleep(1); \
    if ((++_sp & 255u) == 0u) { if (xb_ld(&(bar)[XB_TMO])) break; if (_sp > XB_SPIN_CAP) { atomicAdd(&(bar)[XB_TMO], 1u); break; } } } } while (0)
struct XcdBarrier { unsigned* bar; unsigned x; volatile LAS unsigned* st; };
DI XcdBarrier xcd_barrier_post(unsigned* bar, volatile LAS unsigned* st) {
  XcdBarrier b; b.bar = bar; b.x = xb_xcc_id(); b.st = st;
  if (threadIdx.x == 0) st[3] = xb_add(&bar[XB_XCNT(b.x)], 1u);
  return b;
}
DI void xcd_barrier_complete(unsigned* bar, unsigned x, unsigned& nloc, unsigned& nx, unsigned& sbefore) {
  const unsigned G = gridDim.x * gridDim.y * gridDim.z;
  unsigned sum, cnt, mine, sp = 0u, sb = 0u;
  for (;;) {
    sum = 0u; cnt = 0u; mine = 0u; sb = 0u;
#pragma unroll
    for (unsigned j = 0; j < 16; ++j) { const unsigned c = xb_ld(&bar[XB_XCNT(j)]); sum += c; cnt += (c > 0u) ? 1u : 0u; mine = (j == x) ? c : mine; sb += (j < x) ? c : 0u; }
    if (sum == G) break;
    __builtin_amdgcn_s_sleep(1);
    if ((++sp & 255u) == 0u) { if (xb_ld(&bar[XB_TMO])) break; if (sp > XB_SPIN_CAP) { atomicAdd(&bar[XB_TMO], 1u); break; } }
  }
  nloc = mine > 0u ? mine : 1u; nx = cnt > 0u ? cnt : 1u; sbefore = sb;
}
DI void xcd_barrier(const XcdBarrier& b) {
  asm volatile("s_waitcnt vmcnt(0)" ::: "memory");
  __syncthreads();
  if (threadIdx.x == 0) {
    unsigned* bar = b.bar;
    __builtin_amdgcn_s_waitcnt(0);
    unsigned nloc = b.st[0], nx = b.st[1];
    if (nloc == 0u) { unsigned sbf; xcd_barrier_complete(bar, b.x, nloc, nx, sbf); b.st[0] = nloc; b.st[1] = nx; b.st[2] = sbf; }
    const unsigned old = xb_add(&bar[XB_XSUB(b.x)], 1u);
    const unsigned gen = old / nloc;
    if (old + 1u == (gen + 1u) * nloc) {
      __builtin_amdgcn_fence(__ATOMIC_RELEASE, "agent");
      asm volatile("s_waitcnt vmcnt(0)" ::: "memory");
      const unsigned og = xb_add(&bar[XB_TOP], 1u);
      const unsigned tg = og / nx;
      if (og + 1u == (tg + 1u) * nx) xb_add(&bar[XB_TOPGEN], 1u);
      else XB_SPIN(xb_ld(&bar[XB_TOPGEN]) == tg, bar);
      __builtin_amdgcn_fence(__ATOMIC_ACQUIRE, "agent");
      xb_add(&bar[XB_XGEN(b.x)], 1u);
      asm volatile("s_waitcnt vmcnt(0)" ::: "memory");
    } else {
      XB_SPIN(xb_ld(&bar[XB_XGEN(b.x)]) == gen, bar);
      __builtin_amdgcn_fence(__ATOMIC_ACQUIRE, "agent");
      asm volatile("s_waitcnt vmcnt(0)" ::: "memory");
    }
  }
  __syncthreads();
}

DI Params kargs() {
  Params P{};
#if defined(__HIP_DEVICE_COMPILE__)
  typedef const unsigned long long __attribute__((address_space(4))) CU;
  CU* q = (CU*)__builtin_amdgcn_kernarg_segment_ptr();
  asm volatile("" : "+s"(q));
#define GP(T, i) ((T*)(T __attribute__((address_space(1)))*)(q[i]))
  P.x = GP(const float, 0);
  P.c = GP(const float, 1);
  P.ctx = GP(const float, 2);
  P.c_ctx = GP(const float, 3);
  P.w_mod = GP(const float, 4);
  P.b_mod = GP(const float, 5);
  P.norm_mix_g = GP(const float, 6);
  P.norm_ffn_g = GP(const float, 7);
  P.final_norm_g = GP(const float, 8);
  P.ab_w_in = GP(const float, 9);
  P.ab_conv_w = GP(const float, 10);
  P.ab_gate_b = GP(const float, 11);
  P.ab_head_g = GP(const float, 12);
  P.ab_sink = GP(const float, 13);
  P.ab_w_out = GP(const float, 14);
  P.gm_w_in = GP(const float, 15);
  P.gm_ln_g = GP(const float, 16);
  P.gm_ln_b = GP(const float, 17);
  P.gm_w_s = GP(const float, 18);
  P.gm_b_s = GP(const float, 19);
  P.gm_w_out = GP(const float, 20);
  P.moe_w_router = GP(const float, 21);
  P.moe_w_gate = GP(const float, 22);
  P.moe_w_up = GP(const float, 23);
  P.moe_w_down = GP(const float, 24);
  P.out = GP(float, 25);
  P.ws = GP(char, 26);
#undef GP
#endif
  return P;
}
#if COOP
#ifndef REPEAT_MASK
#define REPEAT_MASK 0
#endif
__global__ void __launch_bounds__(256, 2) mega(Params p_unused) {
  __shared__ __attribute__((aligned(16))) char smem[73728 + 16];
  unsigned* xbw = (unsigned*)(smem + 73728);
  cg::grid_group grid = cg::this_grid();
  if (threadIdx.x < 4) xbw[threadIdx.x] = 0u;
  __syncthreads();
  XcdBarrier xb;
  { const Params pp = kargs(); xb = xcd_barrier_post((unsigned*)(pp.ws + O_BAR), (volatile LAS unsigned*)xbw); }
#define PHX(n) { const Params pp = kargs(); run_phase(pp, n, smem); } xcd_barrier(xb); \
  if ((REPEAT_MASK >> n) & 1) { { const Params pp = kargs(); run_phase(pp, n, smem); } xcd_barrier(xb); }
  { const Params pp = kargs(); run_phase(pp, 0, smem); }
  if (p_unused.ws == nullptr) grid.sync();
  xcd_barrier(xb);
  PHX(1) PHX(2) PHX(3) PHX(4) PHX(5) PHX(6) PHX(7) PHX(8) PHX(9) PHX(10)
  PHX(11) PHX(12) PHX(13) PHX(14) PHX(15) PHX(16) PHX(17) PHX(18) PHX(19) PHX(20)
  { const Params pp = kargs(); run_phase(pp, 21, smem); }
}
#else
__global__ void __launch_bounds__(256, 2) mega(Params p, int ph) {
  __shared__ __attribute__((aligned(16))) char smem[73728];
  run_phase(p, ph, smem);
}
#endif

extern "C" void kernel_launch(void* const* d_in, const int* in_sizes, int n_in, void* d_out, int out_size, void* d_ws,
                              size_t ws_size, hipStream_t stream) {
  (void)in_sizes; (void)n_in; (void)out_size;
  if (ws_size < WS_NEED) { fprintf(stderr, "workspace too small: %zu < %zu\n", ws_size, (size_t)WS_NEED); return; }
  static int grid_blocks = 0;
  if (!grid_blocks) {
    int dev = 0, cus = 0, per_cu = 0;
    hipGetDevice(&dev);
    hipDeviceGetAttribute(&cus, hipDeviceAttributeMultiprocessorCount, dev);
    hipOccupancyMaxActiveBlocksPerMultiprocessor(&per_cu, mega, 256, 0);
    if (per_cu < 1) per_cu = 1;
    if (per_cu > 2) per_cu = 2;
    grid_blocks = cus * per_cu;
  }
  Params p{};
  const float** f = (const float**)&p;
  for (int i = 0; i < 25; ++i) f[i] = (const float*)d_in[i];
  p.out = (float*)d_out;
  p.ws = (char*)d_ws;
#if COOP
  hipMemsetAsync((char*)d_ws + O_BAR, 0, XCD_BAR_WORDS * 4, stream);
  void* args[] = {&p};
  hipError_t e = hipLaunchCooperativeKernel((void*)mega, dim3(grid_blocks), dim3(256), args, 0, stream);
  if (e != hipSuccess) fprintf(stderr, "cooperative launch failed: %s (grid %d)\n", hipGetErrorString(e), grid_blocks);
#else
  for (int ph = 0; ph < NPHASE; ++ph) hipLaunchKernelGGL(mega, dim3(grid_blocks), dim3(256), 0, stream, p, ph);
#endif
}
```

```cpp
#include <hip/hip_runtime.h>
#include <hip/hip_cooperative_groups.h>
#include <cstdio>
namespace cg = cooperative_groups;

#define DI __device__ __forceinline__
typedef unsigned short bf16_t;
using bf16x8 = __attribute__((ext_vector_type(8))) short;
using s16x4 = __attribute__((ext_vector_type(4))) short;
using f32x16 = __attribute__((ext_vector_type(16))) float;
#define MFMA(a, b, c) __builtin_amdgcn_mfma_f32_32x32x16_bf16((a), (b), (c), 0, 0, 0)

#ifndef COOP
#define COOP 1
#endif

constexpr int DM = 1024, NBAT = 2, SEQ = 8192, NTOK = NBAT * SEQ, CTXL = 256, NROW = NTOK + NBAT * CTXL;
constexpr int PLD = 2816;
constexpr int NSTEP = 66;
constexpr float EPS = 1e-6f;

constexpr size_t al256(size_t x) { return (x + 255) & ~(size_t)255; }
constexpr size_t O_BAR = 0;
constexpr size_t O_WIN = 16384;
constexpr size_t O_WOUT = O_WIN + al256((size_t)PLD * 1024 * 2);
constexpr size_t O_GMIN = O_WOUT + al256((size_t)1024 * 1024 * 2);
constexpr size_t O_GMOUT = O_GMIN + al256((size_t)4096 * 1024 * 2);
constexpr size_t O_MGU = O_GMOUT + al256((size_t)1024 * 2048 * 2);
constexpr size_t O_MD = O_MGU + al256((size_t)16 * 2048 * 1024 * 2);
constexpr size_t O_MODV = O_MD + al256((size_t)16 * 1024 * 1024 * 2);
constexpr size_t O_HA = O_MODV + al256((size_t)2 * 3 * 6144 * 4);
constexpr size_t O_GL = O_HA + al256((size_t)NROW * 1024 * 2);
constexpr size_t O_AFF = O_GL + al256((size_t)NROW * 16 * 4);
constexpr size_t O_IDX = O_AFF + al256((size_t)32 * 8192 * 4);
constexpr size_t O_GATE = O_IDX + al256((size_t)32 * 1024 * 4);
constexpr size_t O_STATS = O_GATE + al256((size_t)32 * 1024 * 4);
constexpr size_t O_GSC = O_STATS + al256((size_t)NTOK * 16 * 4);
constexpr size_t O_MLOC = O_GSC + al256((size_t)16 * NSTEP * 4);
constexpr size_t O_DN = O_MLOC + al256((size_t)16 * NSTEP * 4);
constexpr size_t O_NST = O_DN + al256((size_t)16 * NSTEP * 128 * 4);
constexpr size_t O_MST = O_NST + al256((size_t)16 * 64 * 128 * 4);
constexpr size_t O_INV = O_MST + al256((size_t)16 * 64 * 4);
constexpr size_t O_R12 = O_INV + al256((size_t)NTOK * 16 * 4);
constexpr size_t O_P = O_R12;
constexpr size_t O_QC = O_P + al256((size_t)NROW * PLD * 2);
constexpr size_t O_KC = O_QC + al256((size_t)NTOK * 512 * 2);
constexpr size_t O_KT = O_KC + al256((size_t)NTOK * 512 * 2);
constexpr size_t O_VT = O_KT + al256((size_t)132 * 4 * 128 * 128 * 2);
constexpr size_t O_RQ = O_VT + al256((size_t)132 * 4 * 128 * 128 * 2);
constexpr size_t O_RK = O_RQ + al256((size_t)NTOK * 512 * 2);
constexpr size_t O_AVTX = O_RK + al256((size_t)NROW * 128 * 2);
constexpr size_t O_AVTC = O_AVTX + al256((size_t)4 * 64 * 8192 * 2);
constexpr size_t O_R12_END = O_AVTC + al256((size_t)4 * 64 * 256 * 2);
constexpr size_t O_HID = O_R12;
constexpr size_t O_U = O_R12;
constexpr size_t O_GVT = O_U + al256((size_t)NTOK * 2048 * 2);
static_assert(O_GVT + (size_t)NTOK * 2048 * 2 <= O_R12_END, "R12 too small");
constexpr size_t O_DC = O_R12_END;
constexpr size_t O_CST = O_DC + al256((size_t)16 * NSTEP * 16384 * 4);
constexpr size_t O_UV = O_DC;
constexpr size_t O_YE = O_DC;
constexpr size_t WS_NEED = O_CST + al256((size_t)16 * 64 * 16384 * 2);

struct Params {
  const float *x, *c, *ctx, *c_ctx, *w_mod, *b_mod, *norm_mix_g, *norm_ffn_g, *final_norm_g;
  const float *ab_w_in, *ab_conv_w, *ab_gate_b, *ab_head_g, *ab_sink, *ab_w_out;
  const float *gm_w_in, *gm_ln_g, *gm_ln_b, *gm_w_s, *gm_b_s, *gm_w_out;
  const float *moe_w_router, *moe_w_gate, *moe_w_up, *moe_w_down;
  float* out;
  char* ws;
};

DI bf16_t f2bf(float x) { unsigned u = __float_as_uint(x); u += 0x7fffu + ((u >> 16) & 1u); return (bf16_t)(u >> 16); }
DI float bf2f(bf16_t b) { return __uint_as_float(((unsigned)b) << 16); }
DI unsigned pack2(float a, float b) { return (unsigned)f2bf(a) | ((unsigned)f2bf(b) << 16); }
DI bf16x8 pack8(float a0, float a1, float a2, float a3, float a4, float a5, float a6, float a7) {
  uint4 u; u.x = pack2(a0, a1); u.y = pack2(a2, a3); u.z = pack2(a4, a5); u.w = pack2(a6, a7);
  return __builtin_bit_cast(bf16x8, u);
}
DI bf16x8 ldfrag(const bf16_t* p) { return *(const bf16x8*)p; }
DI bf16x8 ldfrag2(const bf16_t* p0, const bf16_t* p1) {
  s16x4 lo = *(const s16x4*)p0, hi = *(const s16x4*)p1;
  return __builtin_shufflevector(lo, hi, 0, 1, 2, 3, 4, 5, 6, 7);
}
DI int crow(int i, int hh) { return (i & 3) + 8 * (i >> 2) + 4 * hh; }
DI float siluf(float x) { return x / (1.f + __expf(-x)); }
DI float sigmf(float x) { return 1.f / (1.f + __expf(-x)); }
DI float logsigf(float x) { return fminf(x, 0.f) - log1pf(expf(-fabsf(x))); }
DI float geluf(float x) {
  const float u2 = 1.5957691216057308f * (x + 0.044715f * x * x * x);
  return x / (1.f + __expf(-u2));
}
DI float wsum(float v) {
#pragma unroll
  for (int o = 32; o > 0; o >>= 1) v += __shfl_xor(v, o);
  return v;
}
DI int tid() { int t = threadIdx.x; asm volatile("" : "+v"(t)); return t; }
DI f32x16 fzero() { f32x16 z; for (int i = 0; i < 16; ++i) z[i] = 0.f; return z; }

DI int tmap(int kind, int n) {
  if (kind == 0) return n;
  if (kind == 1) return n < 2048 ? n : (n < 2064 ? -1 : n - 16);
  int r = (n >> 6) * 128 + ((n >> 5) & 1) * 64 + (n & 31);
  return kind == 2 ? r : r + 32;
}
DI void tconv(const float* __restrict__ src, int ldn, int ncols, int K, int nmat, size_t sstride,
              bf16_t* __restrict__ dst, size_t dstride, int kind, char* smem) {
  float* sm = (float*)smem;
  const int t = tid();
  const int ntn = (ncols + 63) >> 6, ntk = K >> 6, per = ntn * ntk, total = per * nmat;
  const int c4 = t & 15, rr = t >> 4;
  float4 v0, v1, v2, v3;
#define TC_LOAD(tile_) { const int mat_ = (tile_) / per, tt_ = (tile_) % per; const int k0_ = (tt_ / ntn) * 64, n_ = (tt_ % ntn) * 64 + c4 * 4; \
    const float* s_ = src + (size_t)mat_ * sstride + (size_t)(k0_ + rr) * ldn + n_; \
    if (n_ < ncols) { v0 = *(const float4*)(s_); v1 = *(const float4*)(s_ + (size_t)16 * ldn); v2 = *(const float4*)(s_ + (size_t)32 * ldn); v3 = *(const float4*)(s_ + (size_t)48 * ldn); } \
    else { v0 = v1 = v2 = v3 = make_float4(0.f, 0.f, 0.f, 0.f); } }
  int tile = blockIdx.x;
  if (tile < total) TC_LOAD(tile)
  for (; tile < total; tile += gridDim.x) {
    const int mat = tile / per, tt = tile % per;
    const int k0 = (tt / ntn) * 64, n0 = (tt % ntn) * 64;
    bf16_t* d = dst + (size_t)mat * dstride;
    {
      float* q = sm + rr * 65 + c4 * 4;
      q[0] = v0.x; q[1] = v0.y; q[2] = v0.z; q[3] = v0.w;
      q[16 * 65 + 0] = v1.x; q[16 * 65 + 1] = v1.y; q[16 * 65 + 2] = v1.z; q[16 * 65 + 3] = v1.w;
      q[32 * 65 + 0] = v2.x; q[32 * 65 + 1] = v2.y; q[32 * 65 + 2] = v2.z; q[32 * 65 + 3] = v2.w;
      q[48 * 65 + 0] = v3.x; q[48 * 65 + 1] = v3.y; q[48 * 65 + 2] = v3.z; q[48 * 65 + 3] = v3.w;
    }
    if (tile + (int)gridDim.x < total) TC_LOAD(tile + (int)gridDim.x)
    __syncthreads();
    const int nl = t >> 2, kq = t & 3, n = n0 + nl;
    if (n < ncols) {
      const int row = tmap(kind, n);
      if (row >= 0) {
        uint4 o0, o1;
        const float* q = sm + (kq * 16) * 65 + nl;
        o0.x = pack2(q[0 * 65], q[1 * 65]); o0.y = pack2(q[2 * 65], q[3 * 65]); o0.z = pack2(q[4 * 65], q[5 * 65]); o0.w = pack2(q[6 * 65], q[7 * 65]);
        o1.x = pack2(q[8 * 65], q[9 * 65]); o1.y = pack2(q[10 * 65], q[11 * 65]); o1.z = pack2(q[12 * 65], q[13 * 65]); o1.w = pack2(q[14 * 65], q[15 * 65]);
        uint4* dp = (uint4*)(d + (size_t)row * K + k0 + kq * 16);
        dp[0] = o0; dp[1] = o1;
      }
    }
    __syncthreads();
  }
#undef TC_LOAD
}
DI void tconv_moe(const Params& p, int layer, char* smem) {
  const size_t wo = (size_t)layer * 16 * 1024 * 1024;
  tconv(p.moe_w_gate + wo, 1024, 1024, 1024, 16, (size_t)1024 * 1024, (bf16_t*)(p.ws + O_MGU), (size_t)2048 * 1024, 2, smem);
  tconv(p.moe_w_up + wo, 1024, 1024, 1024, 16, (size_t)1024 * 1024, (bf16_t*)(p.ws + O_MGU), (size_t)2048 * 1024, 3, smem);
  tconv(p.moe_w_down + wo, 1024, 1024, 1024, 16, (size_t)1024 * 1024, (bf16_t*)(p.ws + O_MD), (size_t)1024 * 1024, 0, smem);
}

DI void phase_adaln(const Params& p, char* smem) {
  float* sv = (float*)smem;
  float* red = sv + 3 * 1024;
  float* modv = (float*)(p.ws + O_MODV);
  const int t = tid();
  if (blockIdx.x >= 192) return;
  for (int i = t; i < 3 * 1024; i += 256) {
    const int v = i >> 10, k = i & 1023;
    const float cv = v < 2 ? p.c[v * 1024 + k] : p.c_ctx[k];
    sv[i] = siluf(cv);
  }
  __syncthreads();
  for (int item = blockIdx.x; item < 192; item += gridDim.x) {
    const int l = item / 96, cb = item % 96;
    const int cq = t & 15, kg = t >> 4;
    const float* w = p.w_mod + (size_t)l * 1024 * 6144 + cb * 64 + cq * 4;
    float a0[4] = {0.f, 0.f, 0.f, 0.f}, a1[4] = {0.f, 0.f, 0.f, 0.f}, a2[4] = {0.f, 0.f, 0.f, 0.f};
    for (int i = 0; i < 64; ++i) {
      const int k = kg + 16 * i;
      const float4 wv = *(const float4*)(w + (size_t)k * 6144);
      const float s0 = sv[k], s1 = sv[1024 + k], s2 = sv[2048 + k];
      a0[0] += s0 * wv.x; a0[1] += s0 * wv.y; a0[2] += s0 * wv.z; a0[3] += s0 * wv.w;
      a1[0] += s1 * wv.x; a1[1] += s1 * wv.y; a1[2] += s1 * wv.z; a1[3] += s1 * wv.w;
      a2[0] += s2 * wv.x; a2[1] += s2 * wv.y; a2[2] += s2 * wv.z; a2[3] += s2 * wv.w;
    }
#pragma unroll
    for (int j = 0; j < 4; ++j) {
      red[(kg * 3 + 0) * 64 + cq * 4 + j] = a0[j];
      red[(kg * 3 + 1) * 64 + cq * 4 + j] = a1[j];
      red[(kg * 3 + 2) * 64 + cq * 4 + j] = a2[j];
    }
    __syncthreads();
    if (t < 192) {
      const int v = t >> 6, col = t & 63;
      float s = 0.f;
      for (int g = 0; g < 16; ++g) s += red[(g * 3 + v) * 64 + col];
      const int cc = cb * 64 + col;
      modv[(l * 3 + v) * 6144 + cc] = s + p.b_mod[l * 6144 + cc];
    }
    __syncthreads();
  }
}

DI void moe_combine_row(const Params& p, int row, int lane, float4 (&acc)[4]) {
  const int* INV = (const int*)(p.ws + O_INV); const float* GATE = (const float*)(p.ws + O_GATE);
  const bf16_t* YE = (const bf16_t*)(p.ws + O_YE);
  const int b = row >> 13;
  const int myslot = INV[(size_t)row * 16 + (lane & 15)];
#pragma unroll
  for (int i = 0; i < 4; ++i) acc[i] = make_float4(0.f, 0.f, 0.f, 0.f);
#pragma unroll 1
  for (int e = 0; e < 16; ++e) {
    const int slot = __builtin_amdgcn_readlane(myslot, e);
    if (slot != 0) {
      const int be = b * 16 + e;
      const float g = GATE[be * 1024 + slot - 1];
      const bf16_t* yr = YE + ((size_t)be * 1024 + slot - 1) * 1024;
#pragma unroll
      for (int i = 0; i < 4; ++i) {
        const s16x4 v = *(const s16x4*)(yr + (i * 64 + lane) * 4);
        acc[i].x += g * bf2f((bf16_t)v[0]); acc[i].y += g * bf2f((bf16_t)v[1]); acc[i].z += g * bf2f((bf16_t)v[2]); acc[i].w += g * bf2f((bf16_t)v[3]);
      }
    }
  }
}

template <int MODE, bool COMB>
DI void phase_modulate(const Params& p, int layer, int which, char* smem) {
  float* wt = (float*)smem;
  const int t = tid(), lane = t & 63, w = t >> 6;
  const float* modv = (const float*)(p.ws + O_MODV);
  bf16_t* HA = (bf16_t*)(p.ws + O_HA);
  if (MODE != 0) {
    const float* W = MODE == 1 ? p.ab_w_in + 2048 : p.moe_w_router + (size_t)layer * 1024 * 16;
    const int ld = MODE == 1 ? 2832 : 16;
    for (int i = t; i < 4096; i += 256) {
      const int k = i >> 2, e4 = i & 3;
      const float4 v = *(const float4*)(W + (size_t)k * ld + e4 * 4);
      wt[(e4 * 4 + 0) * 1024 + k] = v.x; wt[(e4 * 4 + 1) * 1024 + k] = v.y; wt[(e4 * 4 + 2) * 1024 + k] = v.z; wt[(e4 * 4 + 3) * 1024 + k] = v.w;
    }
    __syncthreads();
  }
  const float* gn = (which == 0 ? p.norm_mix_g : p.norm_ffn_g) + layer * 1024;
  const int nrows = MODE == 1 ? NROW : NTOK;
  const int rstride = gridDim.x * 4;
  float4 nx[4];
#define MOD_SRC(row_) (MODE == 1 ? ((row_) < NTOK ? p.x + (size_t)(row_) * 1024 : p.ctx + (size_t)((row_) - NTOK) * 1024) : p.out + (size_t)(row_) * 1024)
  {
    const int row0_ = blockIdx.x * 4 + w;
    if (row0_ < nrows) {
      const float* s0_ = MOD_SRC(row0_);
#pragma unroll
      for (int i = 0; i < 4; ++i) nx[i] = *(const float4*)(s0_ + (i * 64 + lane) * 4);
    }
  }
  for (int row = blockIdx.x * 4 + w; row < nrows; row += rstride) {
    const int v = (MODE == 1 && row >= NTOK) ? 2 : (row >> 13);
    const float* sh = modv + (layer * 3 + v) * 6144 + (which ? 3 : 0) * 1024;
    const float* sc = sh + 1024;
    float4 xv[4];
    float ss = 0.f;
#pragma unroll
    for (int i = 0; i < 4; ++i) xv[i] = nx[i];
    if (row + rstride < nrows) {
      const float* s1_ = MOD_SRC(row + rstride);
#pragma unroll
      for (int i = 0; i < 4; ++i) nx[i] = *(const float4*)(s1_ + (i * 64 + lane) * 4);
    }
    if (COMB) {
      float4 ca[4];
      moe_combine_row(p, row, lane, ca);
      const float* g2 = modv + ((layer - 1) * 3 + v) * 6144 + 5 * 1024;
#pragma unroll
      for (int i = 0; i < 4; ++i) {
        const float4 gg = *(const float4*)(g2 + (i * 64 + lane) * 4);
        xv[i].x += gg.x * ca[i].x; xv[i].y += gg.y * ca[i].y; xv[i].z += gg.z * ca[i].z; xv[i].w += gg.w * ca[i].w;
        *(float4*)(p.out + (size_t)row * 1024 + (i * 64 + lane) * 4) = xv[i];
      }
    }
#pragma unroll
    for (int i = 0; i < 4; ++i) ss += xv[i].x * xv[i].x + xv[i].y * xv[i].y + xv[i].z * xv[i].z + xv[i].w * xv[i].w;
    ss = wsum(ss);
    const float rstd = rsqrtf(ss * (1.f / 1024.f) + EPS);
    float4 yv[4];
#pragma unroll
    for (int i = 0; i < 4; ++i) {
      const int col = (i * 64 + lane) * 4;
      const float4 g4 = *(const float4*)(gn + col), s4 = *(const float4*)(sh + col), c4 = *(const float4*)(sc + col);
      float4 y;
      y.x = xv[i].x * rstd * g4.x * (1.f + c4.x) + s4.x;
      y.y = xv[i].y * rstd * g4.y * (1.f + c4.y) + s4.y;
      y.z = xv[i].z * rstd * g4.z * (1.f + c4.z) + s4.z;
      y.w = xv[i].w * rstd * g4.w * (1.f + c4.w) + s4.w;
      yv[i] = y;
      uint2 o; o.x = pack2(y.x, y.y); o.y = pack2(y.z, y.w);
      *(uint2*)(HA + (size_t)row * 1024 + col) = o;
    }
    if (MODE != 0) {
      float mine = 0.f;
#pragma unroll 1
      for (int e4 = 0; e4 < 16; e4 += 4) {
        float pe0 = 0.f, pe1 = 0.f, pe2 = 0.f, pe3 = 0.f;
#pragma unroll
        for (int i = 0; i < 4; ++i) {
          const float* wp = wt + e4 * 1024 + (i * 64 + lane) * 4;
          const float4 wa = *(const float4*)(wp), wb = *(const float4*)(wp + 1024), wc = *(const float4*)(wp + 2048), wd = *(const float4*)(wp + 3072);
          pe0 += yv[i].x * wa.x + yv[i].y * wa.y + yv[i].z * wa.z + yv[i].w * wa.w;
          pe1 += yv[i].x * wb.x + yv[i].y * wb.y + yv[i].z * wb.z + yv[i].w * wb.w;
          pe2 += yv[i].x * wc.x + yv[i].y * wc.y + yv[i].z * wc.z + yv[i].w * wc.w;
          pe3 += yv[i].x * wd.x + yv[i].y * wd.y + yv[i].z * wd.z + yv[i].w * wd.w;
        }
#pragma unroll
        for (int o = 32; o > 0; o >>= 1) {
          const float q0 = __shfl_xor(pe0, o), q1 = __shfl_xor(pe1, o), q2 = __shfl_xor(pe2, o), q3 = __shfl_xor(pe3, o);
          pe0 += q0; pe1 += q1; pe2 += q2; pe3 += q3;
        }
        const int el = (lane & 15) - e4;
        mine = el == 0 ? pe0 : (el == 1 ? pe1 : (el == 2 ? pe2 : (el == 3 ? pe3 : mine)));
      }
      const int e = lane & 15;
      if (MODE == 1) {
        float val = mine + p.ab_gate_b[e];
        if (((e >> 2) & 1) == 1) val = logsigf(val);
        if (lane < 16) ((float*)(p.ws + O_GL))[(size_t)row * 16 + lane] = val;
      } else {
        float mx = mine;
#pragma unroll
        for (int o = 8; o > 0; o >>= 1) mx = fmaxf(mx, __shfl_xor(mx, o));
        const float ex = expf(mine - mx);
        float sum = ex;
#pragma unroll
        for (int o = 8; o > 0; o >>= 1) sum += __shfl_xor(sum, o);
        if (lane < 16) ((float*)(p.ws + O_AFF))[((size_t)(row >> 13) * 16 + lane) * 8192 + (row & 8191)] = ex / sum;
        if (lane < 16) ((int*)(p.ws + O_INV))[(size_t)row * 16 + lane] = 0;
      }
    }
  }
}

template <bool DENSEA, class Epi>
DI void gemm_tile(const bf16_t* Abase, const unsigned (&aoff)[8], const bf16_t* Bbase, unsigned boff, int K, char* smem, Epi&& epi) {
  bf16_t* sA = (bf16_t*)smem;
  bf16_t* sB = sA + 256 * 72;
  const int t = tid(), lane = t & 63, w = t >> 6, wm = w >> 1, wn = w & 1, r = lane & 31, hh = lane >> 5;
  const int lrow = t >> 3, lcol = (t & 7) * 8;
  const unsigned bst = 32u * (unsigned)K;
  f32x16 acc[4][2];
#pragma unroll
  for (int i = 0; i < 4; ++i) { acc[i][0] = fzero(); acc[i][1] = fzero(); }
  uint4 A0, A1, A2, A3, A4, A5, A6, A7, B0, B1, B2, B3;
#define GLOADT(kn_) { \
    const bf16_t* Ak_ = Abase + (kn_); const bf16_t* Bk_ = Bbase + (kn_);     \
    if (DENSEA) { \
      A0 = *(const uint4*)(Ak_ + aoff[0]); A1 = *(const uint4*)((Ak_ + bst) + aoff[0]); A2 = *(const uint4*)((Ak_ + 2 * bst) + aoff[0]); A3 = *(const uint4*)((Ak_ + 3 * bst) + aoff[0]); \
      A4 = *(const uint4*)((Ak_ + 4 * bst) + aoff[0]); A5 = *(const uint4*)((Ak_ + 5 * bst) + aoff[0]); A6 = *(const uint4*)((Ak_ + 6 * bst) + aoff[0]); A7 = *(const uint4*)((Ak_ + 7 * bst) + aoff[0]); \
    } else { \
      A0 = *(const uint4*)(Ak_ + aoff[0]); A1 = *(const uint4*)(Ak_ + aoff[1]); A2 = *(const uint4*)(Ak_ + aoff[2]); A3 = *(const uint4*)(Ak_ + aoff[3]); \
      A4 = *(const uint4*)(Ak_ + aoff[4]); A5 = *(const uint4*)(Ak_ + aoff[5]); A6 = *(const uint4*)(Ak_ + aoff[6]); A7 = *(const uint4*)(Ak_ + aoff[7]); \
    } \
    B0 = *(const uint4*)(Bk_ + boff); B1 = *(const uint4*)((Bk_ + bst) + boff); B2 = *(const uint4*)((Bk_ + 2 * bst) + boff); B3 = *(const uint4*)((Bk_ + 3 * bst) + boff); }
  GLOADT(0)
  const int so = lrow * 72 + lcol;
  const bf16_t* cA = sA + (wm * 128 + r) * 72 + hh * 8;
  const bf16_t* cB = sB + (wn * 64 + r) * 72 + hh * 8;
  const int KT = K >> 6;
  for (int kt = 0; kt < KT; ++kt) {
    __syncthreads();
    *(uint4*)(sA + so) = A0; *(uint4*)(sA + so + 32 * 72) = A1; *(uint4*)(sA + so + 64 * 72) = A2; *(uint4*)(sA + so + 96 * 72) = A3;
    *(uint4*)(sA + so + 128 * 72) = A4; *(uint4*)(sA + so + 160 * 72) = A5; *(uint4*)(sA + so + 192 * 72) = A6; *(uint4*)(sA + so + 224 * 72) = A7;
    *(uint4*)(sB + so) = B0; *(uint4*)(sB + so + 32 * 72) = B1; *(uint4*)(sB + so + 64 * 72) = B2; *(uint4*)(sB + so + 96 * 72) = B3;
    __syncthreads();
    { const int kn = (kt + 1 < KT ? kt + 1 : kt) * 64; GLOADT(kn) }
    __builtin_amdgcn_sched_barrier(0);
#pragma unroll
    for (int ks = 0; ks < 4; ++ks) {
      const bf16x8 b0 = *(const bf16x8*)(cB + ks * 16), b1 = *(const bf16x8*)(cB + 32 * 72 + ks * 16);
#pragma unroll
      for (int mi = 0; mi < 4; ++mi) {
        const bf16x8 a = *(const bf16x8*)(cA + mi * 32 * 72 + ks * 16);
        acc[mi][0] = MFMA(a, b0, acc[mi][0]);
        acc[mi][1] = MFMA(a, b1, acc[mi][1]);
      }
      if (ks == 1) __builtin_amdgcn_sched_barrier(0);
    }
    __builtin_amdgcn_sched_barrier(0);
  }
#undef GLOADT
  epi(acc, wm * 128, wn * 64, r, hh);
}

struct TileWalk {
  int L, Lend, nl;
  DI TileWalk(int T, const char* smem) {
    const volatile unsigned* xw = (const volatile unsigned*)(smem + 73728);
    const int nloc = (int)xw[0], sb = (int)xw[2], rk = (int)xw[3];
    int G = (int)gridDim.x;
    asm volatile("" : "+s"(G));
    nl = nloc;
    L = (T * sb) / G + rk; Lend = (T * (sb + nloc)) / G;
  }
  DI bool valid() const { return L < Lend; }
  DI void next() { L += nl; }
  DI void get(int SM, int SN, int nsn, int& mt, int& nt) const {
    const int s = L / (SM * SN), wi = L % (SM * SN);
    mt = (s / nsn) * SM + wi / SN; nt = (s % nsn) * SN + wi % SN;
  }
};

template <class MakeEpi>
DI void gemm_dense(const bf16_t* A, const bf16_t* Bt, int M, int N, int K, int SM, int SN, char* smem, MakeEpi&& mk) {
  const int t = tid(), lrow = t >> 3, lcol = (t & 7) * 8;
  const int ntn = N >> 7, ntm = M >> 8;
  for (TileWalk tw(ntn * ntm, smem); tw.valid(); tw.next()) {
    int mt, nt; tw.get(SM, SN, ntn / SN, mt, nt);
    unsigned aoff[8];
#pragma unroll
    for (int i = 0; i < 8; ++i) aoff[i] = (unsigned)(lrow + 32 * i) * (unsigned)K + (unsigned)lcol;
    gemm_tile<true>(A + (size_t)mt * 256 * K, aoff, Bt + (size_t)(nt * 128) * K, (unsigned)lrow * (unsigned)K + (unsigned)lcol, K, smem, mk(mt * 256, nt * 128));
  }
}

DI void phase_prep2(const Params& p, char* smem) {
  bf16_t* T = (bf16_t*)smem;
  const bf16_t* P = (const bf16_t*)(p.ws + O_P);
  bf16_t* Qc = (bf16_t*)(p.ws + O_QC); bf16_t* Kc = (bf16_t*)(p.ws + O_KC);
  bf16_t* KT = (bf16_t*)(p.ws + O_KT); bf16_t* VT = (bf16_t*)(p.ws + O_VT);
  bf16_t* RQ = (bf16_t*)(p.ws + O_RQ); bf16_t* RK = (bf16_t*)(p.ws + O_RK);
  bf16_t* AVTX = (bf16_t*)(p.ws + O_AVTX); bf16_t* AVTC = (bf16_t*)(p.ws + O_AVTC);
  const int t = tid();
  for (int item = blockIdx.x; item < 132 * 6; item += gridDim.x) {
    const int sc = item / 6, part = item % 6;
    const bool isx = sc < 128;
    const int row0 = sc * 128;
    const int seq_lo = isx ? (sc >> 6) * 8192 : NTOK + ((sc - 128) >> 1) * 256;
    const int seq_hi = seq_lo + (isx ? 8192 : 256);
    if (part < 4) {
      const int h = part;
      const int col8 = t & 15, rsub = t >> 4;
      for (int pass = 0; pass < 3; ++pass) {
        if (pass == 2 && !isx) break;
        const int pcol = (pass == 0 ? 512 : (pass == 1 ? 1024 : 0)) + h * 128 + col8 * 8;
        float cw[5][8];
        if (pass != 1) {
#pragma unroll
          for (int j = 0; j < 5; ++j)
#pragma unroll
            for (int e = 0; e < 8; ++e) cw[j][e] = p.ab_conv_w[j * 1024 + (pass == 0 ? 512 : 0) + h * 128 + col8 * 8 + e];
        }
        for (int i = 0; i < 8; ++i) {
          const int rl = rsub + 16 * i, row = row0 + rl;
          uint4 o;
          if (pass == 1) {
            o = *(const uint4*)(P + (size_t)row * PLD + pcol);
          } else {
            float a[8];
#pragma unroll
            for (int e = 0; e < 8; ++e) a[e] = 0.f;
#pragma unroll
            for (int j = 0; j < 5; ++j) {
              const int rr = row + j - 2;
              if (rr >= seq_lo && rr < seq_hi) {
                const bf16x8 v = *(const bf16x8*)(P + (size_t)rr * PLD + pcol);
#pragma unroll
                for (int e = 0; e < 8; ++e) a[e] += cw[j][e] * bf2f((bf16_t)v[e]);
              }
            }
            const float scl = pass == 0 ? 0.08838834764831845f : 1.f;
#pragma unroll
            for (int e = 0; e < 8; ++e) a[e] = siluf(a[e]) * scl;
            o.x = pack2(a[0], a[1]); o.y = pack2(a[2], a[3]); o.z = pack2(a[4], a[5]); o.w = pack2(a[6], a[7]);
            if (isx) *(uint4*)((pass == 0 ? Kc : Qc) + (size_t)row * 512 + h * 128 + col8 * 8) = o;
          }
          if (pass < 2) *(uint4*)(T + rl * 136 + col8 * 8) = o;
        }
        if (pass < 2) {
          __syncthreads();
          bf16_t* dstT = (pass == 0 ? KT : VT) + (size_t)(sc * 4 + h) * 16384;
          const int d = t & 127, shf = t >> 7;
#pragma unroll
          for (int s8 = 0; s8 < 8; ++s8) {
            const bf16_t* q = T + (shf * 64 + s8 * 8) * 136 + d;
            uint4 o;
            o.x = (unsigned)q[0] | ((unsigned)q[136] << 16); o.y = (unsigned)q[2 * 136] | ((unsigned)q[3 * 136] << 16);
            o.z = (unsigned)q[4 * 136] | ((unsigned)q[5 * 136] << 16); o.w = (unsigned)q[6 * 136] | ((unsigned)q[7 * 136] << 16);
            *(uint4*)(dstT + d * 128 + shf * 64 + s8 * 8) = o;
          }
          __syncthreads();
        }
      }
    } else if (part == 4) {
      if (!isx) continue;
      for (int idx = t; idx < 512; idx += 256) {
        const int rl = idx >> 2, dc = idx & 3, row = row0 + rl, pos = row - seq_lo;
        const float rp = (float)(pos >> 6), cp = (float)(pos & 63);
        float cs[8], sn[8];
#pragma unroll
        for (int e = 0; e < 8; ++e) {
          const int a = dc * 8 + e;
          const float inv = powf(10000.f, -(float)(a & 15) / 16.f);
          const float ang = (a < 16 ? rp : cp) * inv;
          cs[e] = cosf(ang); sn[e] = sinf(ang);
        }
        for (int hq = 0; hq < 8; ++hq) {
          const bf16x8 x1 = *(const bf16x8*)(P + (size_t)row * PLD + 2048 + hq * 64 + dc * 8);
          const bf16x8 x2 = *(const bf16x8*)(P + (size_t)row * PLD + 2048 + hq * 64 + 32 + dc * 8);
          float o1[8], o2[8];
#pragma unroll
          for (int e = 0; e < 8; ++e) {
            const float a = bf2f((bf16_t)x1[e]), b = bf2f((bf16_t)x2[e]);
            o1[e] = (a * cs[e] - b * sn[e]) * 0.125f; o2[e] = (b * cs[e] + a * sn[e]) * 0.125f;
          }
          uint4 u1, u2;
          u1.x = pack2(o1[0], o1[1]); u1.y = pack2(o1[2], o1[3]); u1.z = pack2(o1[4], o1[5]); u1.w = pack2(o1[6], o1[7]);
          u2.x = pack2(o2[0], o2[1]); u2.y = pack2(o2[2], o2[3]); u2.z = pack2(o2[4], o2[5]); u2.w = pack2(o2[6], o2[7]);
          *(uint4*)(RQ + (size_t)row * 512 + hq * 64 + dc * 8) = u1;
          *(uint4*)(RQ + (size_t)row * 512 + hq * 64 + 32 + dc * 8) = u2;
        }
      }
    } else {
      for (int idx = t; idx < 512; idx += 256) {
        const int rl = idx >> 2, dc = idx & 3, row = row0 + rl, pos = row - seq_lo;
        const float rp = (float)(pos >> 6), cp = (float)(pos & 63);
        float cs[8], sn[8];
#pragma unroll
        for (int e = 0; e < 8; ++e) {
          const int a = dc * 8 + e;
          const float inv = powf(10000.f, -(float)(a & 15) / 16.f);
          const float ang = (a < 16 ? rp : cp) * inv;
          cs[e] = isx ? cosf(ang) : 1.f; sn[e] = isx ? sinf(ang) : 0.f;
        }
        for (int g = 0; g < 2; ++g) {
          const bf16x8 x1 = *(const bf16x8*)(P + (size_t)row * PLD + 2560 + g * 64 + dc * 8);
          const bf16x8 x2 = *(const bf16x8*)(P + (size_t)row * PLD + 2560 + g * 64 + 32 + dc * 8);
          float o1[8], o2[8];
#pragma unroll
          for (int e = 0; e < 8; ++e) {
            const float a = bf2f((bf16_t)x1[e]), b = bf2f((bf16_t)x2[e]);
            o1[e] = a * cs[e] - b * sn[e]; o2[e] = b * cs[e] + a * sn[e];
          }
          uint4 u1, u2;
          u1.x = pack2(o1[0], o1[1]); u1.y = pack2(o1[2], o1[3]); u1.z = pack2(o1[4], o1[5]); u1.w = pack2(o1[6], o1[7]);
          u2.x = pack2(o2[0], o2[1]); u2.y = pack2(o2[2], o2[3]); u2.z = pack2(o2[4], o2[5]); u2.w = pack2(o2[6], o2[7]);
          *(uint4*)(RK + (size_t)row * 128 + g * 64 + dc * 8) = u1;
          *(uint4*)(RK + (size_t)row * 128 + g * 64 + 32 + dc * 8) = u2;
        }
      }
      {
        const int col8 = t & 15, rsub = t >> 4;
        for (int i = 0; i < 8; ++i) {
          const int rl = rsub + 16 * i;
          *(uint4*)(T + rl * 136 + col8 * 8) = *(const uint4*)(P + (size_t)(row0 + rl) * PLD + 2688 + col8 * 8);
        }
        __syncthreads();
        const int d = t & 127, shf = t >> 7;
        const int b = isx ? (sc >> 6) : ((sc - 128) >> 1);
        const int pos0 = row0 - seq_lo;
        bf16_t* dst = isx ? AVTX + ((size_t)(b * 2 + (d >> 6)) * 64 + (d & 63)) * 8192 + pos0
                          : AVTC + ((size_t)(b * 2 + (d >> 6)) * 64 + (d & 63)) * 256 + pos0;
#pragma unroll
        for (int s8 = 0; s8 < 8; ++s8) {
          const bf16_t* q = T + (shf * 64 + s8 * 8) * 136 + d;
          uint4 o;
          o.x = (unsigned)q[0] | ((unsigned)q[136] << 16); o.y = (unsigned)q[2 * 136] | ((unsigned)q[3 * 136] << 16);
          o.z = (unsigned)q[4 * 136] | ((unsigned)q[5 * 136] << 16); o.w = (unsigned)q[6 * 136] | ((unsigned)q[7 * 136] << 16);
          *(uint4*)(dst + shf * 64 + s8 * 8) = o;
        }
        __syncthreads();
      }
    }
  }
}

DI void attn_item(const Params& p, int item, char* smem) {
  const int g = item & 1, qb = (item >> 1) & 255, b = item >> 9;
  int t_ = tid();
  asm volatile("" : "+v"(t_));
  const int t = t_, lane = t & 63, w = t >> 6, r = lane & 31, hh = lane >> 5;
  const int hq = g * 4 + w, q0 = qb * 32;
  const bf16_t* RQ = (const bf16_t*)(p.ws + O_RQ); const bf16_t* RK = (const bf16_t*)(p.ws + O_RK);
  const bf16_t* AVTX = (const bf16_t*)(p.ws + O_AVTX); const bf16_t* AVTC = (const bf16_t*)(p.ws + O_AVTC);
  bf16_t* MIX = (bf16_t*)(p.ws + O_HA);
  const size_t qrow = (size_t)b * 8192 + q0 + r;
  bf16x8 qf[4];
#pragma unroll
  for (int ks = 0; ks < 4; ++ks) qf[ks] = ldfrag(RQ + qrow * 512 + hq * 64 + ks * 16 + hh * 8);
  float m = p.ab_sink[hq], l = hh == 0 ? 1.f : 0.f;
  f32x16 o0 = fzero(), o1 = fzero();
  const int ipos = q0 + r;
  const int lo = q0 - 128 < 0 ? 0 : q0 - 128, hi = q0 + 128 > 8192 - 32 ? 8192 - 32 : q0 + 128;
  const int nloc = ((hi - lo) >> 5) + 1, ntile = nloc + 8;
  bf16_t* sKt = (bf16_t*)smem;
  bf16_t* sVt = sKt + 2 * 32 * 72;
  const bf16_t* kloc = RK + (size_t)(b * 8192) * 128 + g * 64 + (t >> 3) * 128 + (t & 7) * 8;
  const bf16_t* kctx = RK + (size_t)(NTOK + b * 256) * 128 + g * 64 + (t >> 3) * 128 + (t & 7) * 8;
  const bf16_t* vloc = AVTX + (size_t)((b * 2 + g) * 64 + (t >> 2)) * 8192 + (t & 3) * 8;
  const bf16_t* vctx = AVTC + (size_t)((b * 2 + g) * 64 + (t >> 2)) * 256 + (t & 3) * 8;
  const int skoff = (t >> 3) * 72 + (t & 7) * 8, svoff = (t >> 2) * 40 + (t & 3) * 8;
  uint4 gk, gv;
#define ATT_LOAD(j_) { const bool loc_ = (j_) < nloc; const int k0_ = loc_ ? lo + (j_) * 32 : ((j_) - nloc) * 32; \
    gk = *(const uint4*)((loc_ ? kloc : kctx) + (size_t)k0_ * 128); gv = *(const uint4*)((loc_ ? vloc : vctx) + k0_); }
  ATT_LOAD(0)
  __syncthreads();
  *(uint4*)(sKt + skoff) = gk; *(uint4*)(sVt + svoff) = gv;
  __syncthreads();
#pragma unroll 1
  for (int tile = 0; tile < ntile; ++tile) {
    const int cur = tile & 1;
    if (tile + 1 < ntile) ATT_LOAD(tile + 1)
    const bool local = tile < nloc;
    const int k0 = local ? lo + tile * 32 : (tile - nloc) * 32;
    const bf16_t* kt = sKt + cur * 32 * 72 + r * 72 + hh * 8;
    const bf16_t* vt = sVt + cur * 64 * 40 + r * 40 + 4 * hh;
    f32x16 s = fzero();
#pragma unroll
    for (int ks = 0; ks < 4; ++ks) s = MFMA(*(const bf16x8*)(kt + ks * 16), qf[ks], s);
    float tmax = -INFINITY;
#pragma unroll
    for (int i = 0; i < 16; ++i) {
      const int dj = ipos - (k0 + crow(i, hh));
      const bool ok = !local || (dj <= 128 && dj >= -128);
      s[i] = ok ? s[i] : -INFINITY;
      tmax = fmaxf(tmax, s[i]);
    }
    tmax = fmaxf(tmax, __shfl_xor(tmax, 32));
    const float mn = fmaxf(m, tmax), corr = __expf(m - mn);
    m = mn; l *= corr;
#pragma unroll
    for (int i = 0; i < 16; ++i) { o0[i] *= corr; o1[i] *= corr; }
#pragma unroll
    for (int i = 0; i < 16; ++i) { s[i] = __expf(s[i] - mn); l += s[i]; }
    const bf16x8 pf0 = pack8(s[0], s[1], s[2], s[3], s[4], s[5], s[6], s[7]);
    const bf16x8 pf1 = pack8(s[8], s[9], s[10], s[11], s[12], s[13], s[14], s[15]);
    o0 = MFMA(ldfrag2(vt, vt + 8), pf0, o0);
    o1 = MFMA(ldfrag2(vt + 32 * 40, vt + 32 * 40 + 8), pf0, o1);
    o0 = MFMA(ldfrag2(vt + 16, vt + 24), pf1, o0);
    o1 = MFMA(ldfrag2(vt + 32 * 40 + 16, vt + 32 * 40 + 24), pf1, o1);
    if (tile + 1 < ntile) { *(uint4*)(sKt + (cur ^ 1) * 32 * 72 + skoff) = gk; *(uint4*)(sVt + (cur ^ 1) * 64 * 40 + svoff) = gv; }
    __syncthreads();
  }
#undef ATT_LOAD
  l += __shfl_xor(l, 32);
  const float inv = 1.f / l;
  bf16_t* dst = MIX + qrow * 1024 + 512 + hq * 64;
#pragma unroll
  for (int q4 = 0; q4 < 4; ++q4) {
    const int d = 8 * q4 + 4 * hh;
    uint2 u;
    u.x = pack2(o0[4 * q4] * inv, o0[4 * q4 + 1] * inv); u.y = pack2(o0[4 * q4 + 2] * inv, o0[4 * q4 + 3] * inv);
    *(uint2*)(dst + d) = u;
    u.x = pack2(o1[4 * q4] * inv, o1[4 * q4 + 1] * inv); u.y = pack2(o1[4 * q4 + 2] * inv, o1[4 * q4 + 3] * inv);
    *(uint2*)(dst + 32 + d) = u;
  }
}

DI void mlstm_local_item(const Params& p, int item, char* smem) {
  float* gs = (float*)smem;
  float* wv = gs + 512;
  float* msc = wv + 256;
  int t_ = tid();
  asm volatile("" : "+v"(t_));
  const int t = t_, lane = t & 63, w = t >> 6, wm = w >> 1, wn = w & 1, r = lane & 31, hh = lane >> 5;
  const int bh = item / NSTEP, nc = item % NSTEP, b = bh >> 2, h = bh & 3;
  const int sc = nc < 2 ? 128 + b * 2 + nc : b * 64 + (nc - 2);
  const int row0 = sc * 128;
  const float* GL = (const float*)(p.ws + O_GL);
  const bf16_t* KT = (const bf16_t*)(p.ws + O_KT) + (size_t)(sc * 4 + h) * 16384;
  const bf16_t* VT = (const bf16_t*)(p.ws + O_VT) + (size_t)(sc * 4 + h) * 16384;
  char* sK = smem + 8192;
  char* sV = sK + 32768;
#pragma unroll
  for (int i = 0; i < 8; ++i) {
    const int q = t + 256 * i, row = q >> 4, cc = q & 15;
    const int so = row * 256 + ((cc ^ (row & 15)) << 4);
    *(uint4*)(sK + so) = *(const uint4*)(KT + row * 128 + cc * 8);
    *(uint4*)(sV + so) = *(const uint4*)(VT + row * 128 + cc * 8);
  }
  for (int i = t; i < 512; i += 256) { const int ty = i >> 7, s = i & 127; gs[i] = GL[(size_t)(row0 + s) * 16 + ty * 4 + h]; }
  __syncthreads();
  {
    const int dir = t >> 7, s = t & 127;
    float wval, tot = 0.f;
    if (dir == 0) {
      float bsum = 0.f;
      for (int j = 0; j < 128; ++j) { const float f = gs[128 + j]; tot += f; if (j <= s) bsum += f; }
      wval = tot - bsum + gs[s];
    } else {
      float pre = 0.f;
      for (int j = 0; j < 128; ++j) { const float f = gs[384 + j]; tot += f; if (j < s) pre += f; }
      wval = pre + gs[256 + s];
    }
    wv[dir * 128 + s] = wval;
    if (s == 0) msc[dir] = tot;
  }
  __syncthreads();
  {
    const int dir = t >> 7, s = t & 127;
    float mx = -INFINITY;
    for (int j = 0; j < 128; ++j) mx = fmaxf(mx, wv[dir * 128 + j]);
    const float wval = wv[dir * 128 + s];
    __syncthreads();
    wv[dir * 128 + s] = expf(wval - mx);
    if (s == 0) msc[2 + dir] = mx;
  }
  __syncthreads();
  float* DC = (float*)(p.ws + O_DC);
#pragma unroll 1
  for (int d = 0; d < 2; ++d) {
    f32x16 acc[2][2];
#pragma unroll
    for (int i = 0; i < 2; ++i)
#pragma unroll
      for (int j = 0; j < 2; ++j) acc[i][j] = fzero();
#pragma unroll 2
    for (int ks = 0; ks < 8; ++ks) {
      const int xo = ((ks * 2 + hh) ^ (r & 15)) << 4;
      const bf16x8 ra0 = *(const bf16x8*)(sV + (wm * 64 + r) * 256 + xo);
      const bf16x8 ra1 = *(const bf16x8*)(sV + (wm * 64 + 32 + r) * 256 + xo);
      const bf16x8 b0 = *(const bf16x8*)(sK + (wn * 64 + r) * 256 + xo);
      const bf16x8 b1 = *(const bf16x8*)(sK + (wn * 64 + 32 + r) * 256 + xo);
      const float* ww = wv + d * 128 + ks * 16 + hh * 8;
      const bf16x8 a0 = pack8(bf2f((bf16_t)ra0[0]) * ww[0], bf2f((bf16_t)ra0[1]) * ww[1], bf2f((bf16_t)ra0[2]) * ww[2], bf2f((bf16_t)ra0[3]) * ww[3],
                              bf2f((bf16_t)ra0[4]) * ww[4], bf2f((bf16_t)ra0[5]) * ww[5], bf2f((bf16_t)ra0[6]) * ww[6], bf2f((bf16_t)ra0[7]) * ww[7]);
      const bf16x8 a1 = pack8(bf2f((bf16_t)ra1[0]) * ww[0], bf2f((bf16_t)ra1[1]) * ww[1], bf2f((bf16_t)ra1[2]) * ww[2], bf2f((bf16_t)ra1[3]) * ww[3],
                              bf2f((bf16_t)ra1[4]) * ww[4], bf2f((bf16_t)ra1[5]) * ww[5], bf2f((bf16_t)ra1[6]) * ww[6], bf2f((bf16_t)ra1[7]) * ww[7]);
      acc[0][0] = MFMA(a0, b0, acc[0][0]);
      acc[0][1] = MFMA(a0, b1, acc[0][1]);
      acc[1][0] = MFMA(a1, b0, acc[1][0]);
      acc[1][1] = MFMA(a1, b1, acc[1][1]);
    }
    float* dst = DC + ((size_t)(bh * 2 + d) * NSTEP + nc) * 16384;
#pragma unroll
    for (int mi = 0; mi < 2; ++mi)
#pragma unroll
      for (int ni = 0; ni < 2; ++ni)
#pragma unroll
        for (int i = 0; i < 16; ++i)
          dst[(wm * 64 + mi * 32 + crow(i, hh)) * 128 + wn * 64 + ni * 32 + r] = acc[mi][ni][i];
  }
  {
    const int dir = t >> 7, k = t & 127;
    float s = 0.f;
    for (int s8 = 0; s8 < 16; ++s8) {
      const bf16x8 v = *(const bf16x8*)(sK + k * 256 + ((s8 ^ (k & 15)) << 4));
#pragma unroll
      for (int e = 0; e < 8; ++e) s += wv[dir * 128 + s8 * 8 + e] * bf2f((bf16_t)v[e]);
    }
    ((float*)(p.ws + O_DN))[((size_t)(bh * 2 + dir) * NSTEP + nc) * 128 + k] = s;
    if (k == 0) {
      ((float*)(p.ws + O_GSC))[(bh * 2 + dir) * NSTEP + nc] = msc[dir];
      ((float*)(p.ws + O_MLOC))[(bh * 2 + dir) * NSTEP + nc] = msc[2 + dir];
    }
  }
  __syncthreads();
}

DI int chain_nc(int dir, int i) { return dir == 0 ? i : (i < 2 ? 1 - i : 67 - i); }
template <int DIR>
DI void scan_chain_elems(const float* __restrict__ DCc, bf16_t* __restrict__ CSTc, const float* fa, const float* fb, int e, int epos) {
  float C = 0.f;
#pragma unroll
  for (int blk = 0; blk < 3; ++blk) {
    float v[22];
#pragma unroll
    for (int j = 0; j < 22; ++j) {
      const int i = blk * 22 + j;
      const int nc = DIR == 0 ? i : (i < 2 ? 1 - i : 67 - i);
      v[j] = DCc[(size_t)nc * 16384 + e];
    }
#pragma unroll
    for (int j = 0; j < 22; ++j) {
      const int i = blk * 22 + j;
      const int nc = DIR == 0 ? i : (i < 2 ? 1 - i : 67 - i);
      if (i >= 2) CSTc[(size_t)(nc - 2) * 16384 + epos] = f2bf(C);
      C = fa[i] * C + fb[i] * v[j];
    }
  }
}
DI void phase_scan(const Params& p, char* smem) {
  float* fa = (float*)smem;
  float* fb = fa + 66;
  const float* GSC = (const float*)(p.ws + O_GSC); const float* MLOC = (const float*)(p.ws + O_MLOC);
  const float* DC = (const float*)(p.ws + O_DC); const float* DN = (const float*)(p.ws + O_DN);
  bf16_t* CST = (bf16_t*)(p.ws + O_CST); float* NST = (float*)(p.ws + O_NST); float* MST = (float*)(p.ws + O_MST);
  const int t = tid();
  for (int item = blockIdx.x; item < 16 * 64 + 16; item += gridDim.x) {
    const int chain = item < 1024 ? (item >> 6) : (item - 1024), dir = chain & 1;
    __syncthreads();
    if (t < NSTEP) { const int nc = chain_nc(dir, t); fa[t] = GSC[chain * NSTEP + nc]; fb[t] = MLOC[chain * NSTEP + nc]; }
    __syncthreads();
    if (t == 0) {
      float m = 0.f;
      for (int i = 0; i < NSTEP; ++i) {
        if (i >= 2 && item >= 1024) MST[chain * 64 + chain_nc(dir, i) - 2] = m;
        const float g = fa[i], ml = fb[i];
        const float mn = fmaxf(g + m, ml);
        fa[i] = __expf(g + m - mn); fb[i] = __expf(ml - mn);
        m = mn;
      }
    }
    __syncthreads();
    if (item < 1024) {
      const int e = (item & 63) * 256 + t;
      const int ev = e >> 7, ek = e & 127;
      const int epos = ((((ev >> 5) * 8 + (ek >> 4)) * 64) + ((ek >> 3) & 1) * 32 + (ev & 31)) * 8 + (ek & 7);
      const float* DCc = DC + (size_t)chain * NSTEP * 16384;
      bf16_t* CSTc = CST + (size_t)chain * 64 * 16384;
      if (dir == 0) scan_chain_elems<0>(DCc, CSTc, fa, fb, e, epos);
      else scan_chain_elems<1>(DCc, CSTc, fa, fb, e, epos);
    } else if (t < 128) {
      const int k = t;
      float n = 0.f;
      for (int i = 0; i < NSTEP; ++i) {
        const int nc = chain_nc(dir, i);
        if (i >= 2) NST[((size_t)chain * 64 + (nc - 2)) * 128 + k] = n;
        n = fa[i] * n + fb[i] * DN[((size_t)chain * NSTEP + nc) * 128 + k];
      }
    }
  }
}

DI void mlstm_out_item(const Params& p, int item, char* smem) {
  float* gs = (float*)smem;
  float* bb = gs + 512;
  float* lib = bb + 256;
  float* mrow = lib + 256;
  float* aT = mrow + 256;
  float* nq = aT + 256;
  float* nst = nq + 256;
  char* sK = smem + 8192;
  char* sV = sK + 32768;
  int t_ = tid();
  asm volatile("" : "+v"(t_));
  const int t = t_, lane = t & 63, w = t >> 6, r = lane & 31, hh = lane >> 5;
  const int bh = item >> 6, c = item & 63, b = bh >> 2, h = bh & 3;
  const int sc = b * 64 + c, row0 = sc * 128;
  const float* GL = (const float*)(p.ws + O_GL);
  const bf16_t* Qc = (const bf16_t*)(p.ws + O_QC); const bf16_t* Kc = (const bf16_t*)(p.ws + O_KC);
  const bf16_t* VT = (const bf16_t*)(p.ws + O_VT) + (size_t)(sc * 4 + h) * 16384;
  const bf16_t* P = (const bf16_t*)(p.ws + O_P);
  const float* MST = (const float*)(p.ws + O_MST);
  bf16_t* MIX = (bf16_t*)(p.ws + O_HA);
#pragma unroll
  for (int i = 0; i < 8; ++i) {
    const int q = t + 256 * i, row = q >> 4, cc = q & 15;
    const int so = row * 256 + ((cc ^ (row & 15)) << 4);
    *(uint4*)(sK + so) = *(const uint4*)(Kc + (size_t)(row0 + row) * 512 + h * 128 + cc * 8);
    *(uint4*)(sV + so) = *(const uint4*)(VT + row * 128 + cc * 8);
  }
  for (int i = t; i < 512; i += 256) { const int ty = i >> 7, s = i & 127; gs[i] = GL[(size_t)(row0 + s) * 16 + ty * 4 + h]; }
  {
    const int dir = t >> 7, k = t & 127;
    nst[t] = ((const float*)(p.ws + O_NST))[((size_t)(bh * 2 + dir) * 64 + c) * 128 + k];
  }
  __syncthreads();
  {
    const int dir = t >> 7, s = t & 127;
    float bsum = 0.f;
    if (dir == 0) { for (int j = 0; j <= s; ++j) bsum += gs[128 + j]; }
    else { for (int j = s; j < 128; ++j) bsum += gs[384 + j]; }
    bb[t] = bsum;
    lib[t] = gs[dir * 256 + s] - bsum;
    const bf16_t* qr = Qc + (size_t)(row0 + s) * 512 + h * 128;
    float acc = 0.f;
    for (int k8 = 0; k8 < 16; ++k8) {
      const bf16x8 v = ldfrag(qr + k8 * 8);
#pragma unroll
      for (int e = 0; e < 8; ++e) acc += nst[dir * 128 + k8 * 8 + e] * bf2f((bf16_t)v[e]);
    }
    nq[t] = acc;
  }
  __syncthreads();
  {
    const int dir = t >> 7, s = t & 127;
    float pm = -INFINITY;
    if (dir == 0) { for (int j = 0; j <= s; ++j) pm = fmaxf(pm, lib[j]); }
    else { for (int j = s; j < 128; ++j) pm = fmaxf(pm, lib[128 + j]); }
    const float m_in = MST[(bh * 2 + dir) * 64 + c];
    const float mr = bb[t] + fmaxf(m_in, pm);
    mrow[t] = mr;
    aT[t] = expf(bb[t] + m_in - mr);
  }
  __syncthreads();
  const int tl = w * 32 + r;
  const bf16_t* qrow = Qc + (size_t)(row0 + tl) * 512 + h * 128 + hh * 8;
  bf16x8 qf[8];
#pragma unroll
  for (int ks = 0; ks < 8; ++ks) qf[ks] = ldfrag(qrow + ks * 16);
  const int swz = r & 15;
  const char* kp[8]; const char* vp[16];
#pragma unroll
  for (int ks = 0; ks < 8; ++ks) kp[ks] = sK + r * 256 + (((ks * 2 + hh) ^ swz) << 4);
#pragma unroll
  for (int cc = 0; cc < 16; ++cc) vp[cc] = sV + r * 256 + 8 * hh + ((cc ^ swz) << 4);
  float* Hb = (float*)(p.ws + O_DC) + (size_t)item * 16384 + tl;
  float* Hbh = Hb + 4 * hh * 128;
  f32x16 outa[4];
#define MLSTM_DIR(DIR)                                                                                                   \
  {                                                                                                                      \
    const bf16_t* CSTl = (const bf16_t*)(p.ws + O_CST) + ((size_t)(bh * 2 + DIR) * 64 + c) * 16384 + lane * 8;           \
    const float bbt = bb[DIR * 128 + tl], mrt = mrow[DIR * 128 + tl], at = aT[DIR * 128 + tl];                            \
    float dsum = 0.f;                                                                                                    \
    const float* libp = lib + DIR * 128 + 4 * hh;                                                                        \
    const int tb = tl - 4 * hh;                                                                                          \
    bf16x8 pf[8];                                                                                                        \
    _Pragma("unroll") for (int half = 0; half < 2; ++half) {                                                             \
      f32x16 st[2];                                                                                                      \
      st[0] = fzero(); st[1] = fzero();                                                                                  \
      _Pragma("unroll") for (int ks = 0; ks < 8; ++ks) {                                                                 \
        _Pragma("unroll") for (int r2 = 0; r2 < 2; ++r2)                                                                 \
          st[r2] = MFMA(*(const bf16x8*)(kp[ks] + (half * 2 + r2) * 8192), qf[ks], st[r2]);                              \
      }                                                                                                                  \
      _Pragma("unroll") for (int r2 = 0; r2 < 2; ++r2) {                                                                 \
        const int rb = half * 2 + r2;                                                                                    \
        _Pragma("unroll") for (int i = 0; i < 16; ++i) {                                                                 \
          const int sc_ = rb * 32 + (i & 3) + 8 * (i >> 2);                                           \
          const int diff = DIR == 0 ? (tb - sc_) : (sc_ - tb);                                                           \
          const float msk = (float)((unsigned)(~diff) >> 31);                                                            \
          const float v = st[r2][i] * __expf(fminf(bbt + libp[sc_] - mrt, 0.f)) * msk;                                    \
          st[r2][i] = v; dsum += v;                                                                                      \
        }                                                                                                                \
        pf[rb * 2] = pack8(st[r2][0], st[r2][1], st[r2][2], st[r2][3], st[r2][4], st[r2][5], st[r2][6], st[r2][7]);      \
        pf[rb * 2 + 1] = pack8(st[r2][8], st[r2][9], st[r2][10], st[r2][11], st[r2][12], st[r2][13], st[r2][14], st[r2][15]); \
      }                                                                                                                  \
      __builtin_amdgcn_sched_barrier(0);                                                                                 \
    }                                                                                                                    \
    dsum += __shfl_xor(dsum, 32);                                                                                        \
    const float den = dsum + at * nq[DIR * 128 + tl];                                                                    \
    const float dinv = 1.f / fmaxf(fabsf(den), expf(-mrt));                                                              \
    _Pragma("unroll") for (int half = 0; half < 2; ++half) {                                                             \
      f32x16 ha[2];                                                                                                      \
      ha[0] = fzero(); ha[1] = fzero();                                                                                  \
      _Pragma("unroll") for (int ks = 0; ks < 8; ++ks) {                                                                 \
        _Pragma("unroll") for (int r2 = 0; r2 < 2; ++r2)                                                                 \
          ha[r2] = MFMA(ldfrag(CSTl + ((half * 2 + r2) * 8 + ks) * 512), qf[ks], ha[r2]);                                \
        if (ks == 3) __builtin_amdgcn_sched_barrier(0);                                                                  \
      }                                                                                                                  \
      _Pragma("unroll") for (int r2 = 0; r2 < 2; ++r2)                                                                   \
        _Pragma("unroll") for (int i = 0; i < 16; ++i) ha[r2][i] *= at;                                                  \
      __builtin_amdgcn_sched_barrier(0);                                                                                 \
      _Pragma("unroll") for (int kk = 0; kk < 8; ++kk) {                                                                 \
        _Pragma("unroll") for (int r2 = 0; r2 < 2; ++r2) {                                                               \
          const s16x4 lo = *(const s16x4*)(vp[2 * kk] + (half * 2 + r2) * 8192);                                         \
          const s16x4 hi = *(const s16x4*)(vp[2 * kk + 1] + (half * 2 + r2) * 8192);                                     \
          ha[r2] = MFMA(__builtin_shufflevector(lo, hi, 0, 1, 2, 3, 4, 5, 6, 7), pf[kk], ha[r2]);                        \
        }                                                                                                                \
      }                                                                                                                  \
      _Pragma("unroll") for (int r2 = 0; r2 < 2; ++r2)                                                                   \
        _Pragma("unroll") for (int i = 0; i < 16; ++i) {                                                                 \
          float* hp = Hbh + ((half * 2 + r2) * 32 + (i & 3) + 8 * (i >> 2)) * 128;                                       \
          if (DIR == 0) *hp = ha[r2][i] * dinv;                                                                          \
          else outa[half * 2 + r2][i] = *hp + ha[r2][i] * dinv;                                                          \
        }                                                                                                                \
      __builtin_amdgcn_sched_barrier(0);                                                                                 \
    }                                                                                                                    \
  }
  MLSTM_DIR(0)
  MLSTM_DIR(1)
#undef MLSTM_DIR
  float ss = 0.f;
#pragma unroll
  for (int rb = 0; rb < 4; ++rb)
#pragma unroll
    for (int i = 0; i < 16; ++i) ss += outa[rb][i] * outa[rb][i];
  ss += __shfl_xor(ss, 32);
  const float rn = rsqrtf(ss * (1.f / 128.f) + EPS);
  const size_t row = (size_t)row0 + tl;
#pragma unroll
  for (int rb = 0; rb < 4; ++rb)
#pragma unroll
    for (int q4 = 0; q4 < 4; ++q4) {
      const int v = rb * 32 + 8 * q4 + 4 * hh;
      const s16x4 ov = *(const s16x4*)(P + row * PLD + 1536 + h * 128 + v);
      const float4 hg = *(const float4*)(p.ab_head_g + h * 128 + v);
      const float y0 = outa[rb][4 * q4] * rn * hg.x * sigmf(bf2f((bf16_t)ov[0]));
      const float y1 = outa[rb][4 * q4 + 1] * rn * hg.y * sigmf(bf2f((bf16_t)ov[1]));
      const float y2 = outa[rb][4 * q4 + 2] * rn * hg.z * sigmf(bf2f((bf16_t)ov[2]));
      const float y3 = outa[rb][4 * q4 + 3] * rn * hg.w * sigmf(bf2f((bf16_t)ov[3]));
      uint2 u; u.x = pack2(y0, y1); u.y = pack2(y2, y3);
      *(uint2*)(MIX + row * 1024 + h * 128 + v) = u;
    }
  __syncthreads();
}

DI void phase_topk(const Params& p, char* smem) {
  unsigned* vals = (unsigned*)smem;
  unsigned* hist = vals + 8448;
  unsigned* cntg = hist + 256;
  unsigned* cnte = cntg + 256;
  unsigned* misc = cnte + 256;
  const float* AFF = (const float*)(p.ws + O_AFF);
  int* IDX = (int*)(p.ws + O_IDX); float* GATE = (float*)(p.ws + O_GATE); int* INV = (int*)(p.ws + O_INV);
  const int t = tid();
  for (int item = blockIdx.x; item < 32; item += gridDim.x) {
    const float* a = AFF + (size_t)item * 8192;
    for (int i = t; i < 8192; i += 256) vals[i + (i >> 5)] = __float_as_uint(a[i]);
    unsigned prefix = 0, remaining = 1024;
    for (int pass = 0; pass < 4; ++pass) {
      const int shift = 24 - 8 * pass;
      hist[t] = 0;
      __syncthreads();
      const unsigned mask = pass == 0 ? 0u : (0xFFFFFFFFu << (shift + 8));
      for (int i = t; i < 8192; i += 256) {
        const unsigned u = vals[i + (i >> 5)];
        if ((u & mask) == (prefix & mask)) atomicAdd(&hist[(u >> shift) & 255], 1u);
      }
      __syncthreads();
      {
        unsigned above = 0;
        for (int bin = t + 1; bin < 256; ++bin) above += hist[bin];
        const unsigned mineh = hist[t];
        if (above < remaining && above + mineh >= remaining) {
          misc[0] = prefix | ((unsigned)t << shift);
          misc[1] = remaining - above;
        }
      }
      __syncthreads();
      prefix = misc[0]; remaining = misc[1];
      __syncthreads();
    }
    const unsigned T = prefix, need_eq = remaining;
    unsigned cg_ = 0, ce = 0;
    for (int j = 0; j < 32; ++j) {
      const int n = t * 32 + j;
      const unsigned u = vals[n + (n >> 5)];
      cg_ += u > T; ce += u == T;
    }
    cntg[t] = cg_; cnte[t] = ce;
    __syncthreads();
    unsigned pg = 0, pe = 0;
    for (int j = 0; j < t; ++j) { pg += cntg[j]; pe += cnte[j]; }
    for (int j = 0; j < 32; ++j) {
      const int n = t * 32 + j;
      const unsigned u = vals[n + (n >> 5)];
      if (u > T) { IDX[item * 1024 + pg] = n; GATE[item * 1024 + pg] = __uint_as_float(u); INV[((size_t)(item >> 4) * 8192 + n) * 16 + (item & 15)] = (int)pg + 1; ++pg; }
      else if (u == T) {
        if (pe < need_eq) { const unsigned slot = 1024 - need_eq + pe; IDX[item * 1024 + slot] = n; GATE[item * 1024 + slot] = __uint_as_float(u); INV[((size_t)(item >> 4) * 8192 + n) * 16 + (item & 15)] = (int)slot + 1; }
        ++pe;
      }
    }
    __syncthreads();
  }
}

DI void phase_stats(const Params& p, char* smem) {
  float* red = (float*)smem;
  const bf16_t* GVT = (const bf16_t*)(p.ws + O_GVT);
  float* PART = (float*)(p.ws + O_STATS);
  const int t = tid(), qq = t & 31, cg_ = t >> 5;
  for (int item = blockIdx.x; item < 1024; item += gridDim.x) {
    const int chunk = item >> 3, cgrp = item & 7;
    const bf16_t* base = GVT + ((size_t)chunk * 2048 + cgrp * 256) * 128 + qq * 4;
    float s[4] = {0.f, 0.f, 0.f, 0.f}, s2[4] = {0.f, 0.f, 0.f, 0.f};
#pragma unroll 8
    for (int c = cg_; c < 256; c += 8) {
      const s16x4 v = *(const s16x4*)(base + (size_t)c * 128);
#pragma unroll
      for (int e = 0; e < 4; ++e) { const float f = bf2f((bf16_t)v[e]); s[e] += f; s2[e] += f * f; }
    }
#pragma unroll
    for (int e = 0; e < 4; ++e) { red[(cg_ * 128 + qq * 4 + e) * 2] = s[e]; red[(cg_ * 128 + qq * 4 + e) * 2 + 1] = s2[e]; }
    __syncthreads();
    if (t < 128) {
      float a = 0.f, b2 = 0.f;
      for (int g = 0; g < 8; ++g) { a += red[(g * 128 + t) * 2]; b2 += red[(g * 128 + t) * 2 + 1]; }
      PART[((size_t)item * 128 + t) * 2] = a;
      PART[((size_t)item * 128 + t) * 2 + 1] = b2;
    }
    __syncthreads();
  }
}
DI void phase_spatial(const Params& p, char* smem) {
  float* smu = (float*)smem;
  float* srs = smu + 128;
  const bf16_t* GVT = (const bf16_t*)(p.ws + O_GVT); const bf16_t* U = (const bf16_t*)(p.ws + O_U);
  const float* PART = (const float*)(p.ws + O_STATS);
  bf16_t* UV = (bf16_t*)(p.ws + O_UV);
  for (int item = blockIdx.x; item < 1024; item += gridDim.x) {
    int t_ = tid();
    const int t = t_, lane = t & 63, w = t >> 6, r = lane & 31, hh = lane >> 5;
    const int chunk = item >> 3, g = item & 7;
    if (t < 128) {
      float a = 0.f, b2 = 0.f;
#pragma unroll
      for (int j = 0; j < 8; ++j) { a += PART[((size_t)(chunk * 8 + j) * 128 + t) * 2]; b2 += PART[((size_t)(chunk * 8 + j) * 128 + t) * 2 + 1]; }
      const float mu = a * (1.f / 2048.f);
      const float var = fmaxf(b2 * (1.f / 2048.f) - mu * mu, 0.f);
      smu[t] = mu; srs[t] = rsqrtf(var + EPS);
    }
    __syncthreads();
    const float* Ws = p.gm_w_s + (size_t)g * 16384;
    f32x16 acc[2][4];
#pragma unroll
    for (int i = 0; i < 4; ++i) { acc[0][i] = fzero(); acc[1][i] = fzero(); }
    const int cA = g * 256 + w * 64 + r, cB = cA + 32;
    const float lgA = p.gm_ln_g[cA], lbA = p.gm_ln_b[cA], lgB = p.gm_ln_g[cB], lbB = p.gm_ln_b[cB];
    const bf16_t* vA = GVT + ((size_t)chunk * 2048 + cA) * 128 + hh * 8;
    const bf16_t* vB = GVT + ((size_t)chunk * 2048 + cB) * 128 + hh * 8;
    for (int ks = 0; ks < 8; ++ks) {
      const bf16x8 ra = ldfrag(vA + ks * 16), rbv = ldfrag(vB + ks * 16);
      const float* mu = smu + ks * 16 + hh * 8; const float* rs = srs + ks * 16 + hh * 8;
      const bf16x8 aA = pack8((bf2f((bf16_t)ra[0]) - mu[0]) * rs[0] * lgA + lbA, (bf2f((bf16_t)ra[1]) - mu[1]) * rs[1] * lgA + lbA,
                              (bf2f((bf16_t)ra[2]) - mu[2]) * rs[2] * lgA + lbA, (bf2f((bf16_t)ra[3]) - mu[3]) * rs[3] * lgA + lbA,
                              (bf2f((bf16_t)ra[4]) - mu[4]) * rs[4] * lgA + lbA, (bf2f((bf16_t)ra[5]) - mu[5]) * rs[5] * lgA + lbA,
                              (bf2f((bf16_t)ra[6]) - mu[6]) * rs[6] * lgA + lbA, (bf2f((bf16_t)ra[7]) - mu[7]) * rs[7] * lgA + lbA);
      const bf16x8 aB = pack8((bf2f((bf16_t)rbv[0]) - mu[0]) * rs[0] * lgB + lbB, (bf2f((bf16_t)rbv[1]) - mu[1]) * rs[1] * lgB + lbB,
                              (bf2f((bf16_t)rbv[2]) - mu[2]) * rs[2] * lgB + lbB, (bf2f((bf16_t)rbv[3]) - mu[3]) * rs[3] * lgB + lbB,
                              (bf2f((bf16_t)rbv[4]) - mu[4]) * rs[4] * lgB + lbB, (bf2f((bf16_t)rbv[5]) - mu[5]) * rs[5] * lgB + lbB,
                              (bf2f((bf16_t)rbv[6]) - mu[6]) * rs[6] * lgB + lbB, (bf2f((bf16_t)rbv[7]) - mu[7]) * rs[7] * lgB + lbB);
#pragma unroll
      for (int pb = 0; pb < 4; ++pb) {
        const float* wp = Ws + (pb * 32 + r) * 128 + ks * 16 + hh * 8;
        const float4 w0 = *(const float4*)wp, w1 = *(const float4*)(wp + 4);
        const bf16x8 bw = pack8(w0.x, w0.y, w0.z, w0.w, w1.x, w1.y, w1.z, w1.w);
        acc[0][pb] = MFMA(aA, bw, acc[0][pb]);
        acc[1][pb] = MFMA(aB, bw, acc[1][pb]);
      }
    }
#pragma unroll
    for (int pb = 0; pb < 4; ++pb) {
      const int pp = pb * 32 + r;
      const float bs = p.gm_b_s[g * 128 + pp];
      const size_t rowo = ((size_t)chunk * 128 + pp) * 2048 + g * 256 + w * 64 + 4 * hh;
#pragma unroll
      for (int cb = 0; cb < 2; ++cb)
#pragma unroll
        for (int q4 = 0; q4 < 4; ++q4) {
          const size_t o = rowo + cb * 32 + 8 * q4;
          const s16x4 uu = *(const s16x4*)(U + o);
          uint2 st;
          st.x = pack2(bf2f((bf16_t)uu[0]) * (acc[cb][pb][4 * q4] + bs), bf2f((bf16_t)uu[1]) * (acc[cb][pb][4 * q4 + 1] + bs));
          st.y = pack2(bf2f((bf16_t)uu[2]) * (acc[cb][pb][4 * q4 + 2] + bs), bf2f((bf16_t)uu[3]) * (acc[cb][pb][4 * q4 + 3] + bs));
          *(uint2*)(UV + o) = st;
        }
    }
    __syncthreads();
  }
}

struct EpiBf16 {
  bf16_t* dst; int ld;
  DI void operator()(f32x16 (&acc)[4][2], int mb, int nb, int r, int hh) const {
#pragma unroll
    for (int mi = 0; mi < 4; ++mi)
#pragma unroll
      for (int ni = 0; ni < 2; ++ni)
#pragma unroll
        for (int i = 0; i < 16; ++i)
          dst[(size_t)(mb + mi * 32 + crow(i, hh)) * ld + nb + ni * 32 + r] = f2bf(acc[mi][ni][i]);
  }
};
struct EpiRes {
  float* out; const float* base; const float* gate;
  DI void operator()(f32x16 (&acc)[4][2], int mb, int nb, int r, int hh) const {
#pragma unroll
    for (int ni = 0; ni < 2; ++ni) {
      const int n = nb + ni * 32 + r;
      const float gt = gate[n];
#pragma unroll
      for (int mi = 0; mi < 4; ++mi) {
        const unsigned o0 = (unsigned)(mb + mi * 32 + 4 * hh) * 1024u + (unsigned)n;
#pragma unroll
        for (int q4 = 0; q4 < 4; ++q4) {
          const float b0 = base[o0 + (8 * q4 + 0) * 1024], b1 = base[o0 + (8 * q4 + 1) * 1024], b2 = base[o0 + (8 * q4 + 2) * 1024], b3 = base[o0 + (8 * q4 + 3) * 1024];
          out[o0 + (8 * q4 + 0) * 1024] = b0 + gt * acc[mi][ni][4 * q4];
          out[o0 + (8 * q4 + 1) * 1024] = b1 + gt * acc[mi][ni][4 * q4 + 1];
          out[o0 + (8 * q4 + 2) * 1024] = b2 + gt * acc[mi][ni][4 * q4 + 2];
          out[o0 + (8 * q4 + 3) * 1024] = b3 + gt * acc[mi][ni][4 * q4 + 3];
          __builtin_amdgcn_sched_barrier(0);
        }
      }
    }
  }
};
struct EpiGelu {
  bf16_t* U; bf16_t* GVT; int m0, n0;
  DI void operator()(f32x16 (&acc)[4][2], int mb, int nb, int r, int hh) const {
    if (n0 < 2048) {
#pragma unroll
      for (int mi = 0; mi < 4; ++mi)
#pragma unroll
        for (int ni = 0; ni < 2; ++ni)
#pragma unroll
          for (int i = 0; i < 16; ++i)
            U[(size_t)(m0 + mb + mi * 32 + crow(i, hh)) * 2048 + n0 + nb + ni * 32 + r] = f2bf(geluf(acc[mi][ni][i]));
    } else {
#pragma unroll
      for (int mi = 0; mi < 4; ++mi) {
        const int mrow = m0 + mb + mi * 32;
        const int chunk = mrow >> 7, q0 = mrow & 127;
#pragma unroll
        for (int ni = 0; ni < 2; ++ni) {
          const int cc = n0 - 2048 + nb + ni * 32 + r;
          bf16_t* d = GVT + ((size_t)chunk * 2048 + cc) * 128 + q0 + 4 * hh;
#pragma unroll
          for (int q4 = 0; q4 < 4; ++q4) {
            uint2 u;
            u.x = pack2(geluf(acc[mi][ni][4 * q4]), geluf(acc[mi][ni][4 * q4 + 1]));
            u.y = pack2(geluf(acc[mi][ni][4 * q4 + 2]), geluf(acc[mi][ni][4 * q4 + 3]));
            *(uint2*)(d + 8 * q4) = u;
          }
        }
      }
    }
  }
};
struct EpiSwiglu {
  bf16_t* hid;
  DI void operator()(f32x16 (&acc)[4][2], int mb, int nb, int r, int hh) const {
    const int f = (nb >> 1) + r;
#pragma unroll
    for (int mi = 0; mi < 4; ++mi)
#pragma unroll
      for (int i = 0; i < 16; ++i) {
        const float gv = acc[mi][0][i], uv = acc[mi][1][i];
        hid[(size_t)(mb + mi * 32 + crow(i, hh)) * 1024 + f] = f2bf(siluf(gv) * uv);
      }
  }
};
DI void phase_moe1(const Params& p, char* smem) {
  const bf16_t* HA = (const bf16_t*)(p.ws + O_HA); const bf16_t* WGU = (const bf16_t*)(p.ws + O_MGU);
  const int* IDX = (const int*)(p.ws + O_IDX); bf16_t* HID = (bf16_t*)(p.ws + O_HID);
  const int t = tid(), lrow = t >> 3, lcol = (t & 7) * 8;
  for (TileWalk tw(128 * 16, smem); tw.valid(); tw.next()) {
    int mg, nt; tw.get(8, 8, 2, mg, nt);
    const int e = mg >> 3, b = (mg >> 2) & 1, mt = mg & 3, be = b * 16 + e;
    unsigned aoff[8];
#pragma unroll
    for (int i = 0; i < 8; ++i) aoff[i] = (unsigned)IDX[be * 1024 + mt * 256 + lrow + 32 * i] * 1024u + (unsigned)lcol;
    gemm_tile<false>(HA + (size_t)b * 8192 * 1024, aoff, WGU + ((size_t)e * 2048 + nt * 128) * 1024, (unsigned)lrow * 1024u + (unsigned)lcol, 1024, smem,
              EpiSwiglu{HID + ((size_t)be * 1024 + mt * 256) * 1024 + nt * 64});
  }
}
DI void phase_moe2(const Params& p, int layer, char* smem) {
  const bf16_t* HID = (const bf16_t*)(p.ws + O_HID); const bf16_t* WD = (const bf16_t*)(p.ws + O_MD);
  const int t = tid(), lrow = t >> 3, lcol = (t & 7) * 8;
  for (TileWalk tw(128 * 8, smem); tw.valid(); tw.next()) {
    int mg, nt; tw.get(8, 8, 1, mg, nt);
    const int e = mg >> 3, b = (mg >> 2) & 1, mt = mg & 3, be = b * 16 + e;
    unsigned aoff[8];
#pragma unroll
    for (int i = 0; i < 8; ++i) aoff[i] = (unsigned)(lrow + 32 * i) * 1024u + (unsigned)lcol;
    gemm_tile<true>(HID + ((size_t)be * 1024 + mt * 256) * 1024, aoff, WD + ((size_t)e * 1024 + nt * 128) * 1024, (unsigned)lrow * 1024u + (unsigned)lcol, 1024, smem,
              EpiBf16{(bf16_t*)(p.ws + O_YE) + ((size_t)be * 1024 + mt * 256) * 1024 + nt * 128, 1024});
  }
}

DI void phase_final(const Params& p) {
  const int t = tid(), lane = t & 63, w = t >> 6;
  for (int row = blockIdx.x * 4 + w; row < NTOK; row += gridDim.x * 4) {
    float* src = p.out + (size_t)row * 1024;
    float4 xv[4]; float ss = 0.f;
#pragma unroll
    for (int i = 0; i < 4; ++i) xv[i] = *(const float4*)(src + (i * 64 + lane) * 4);
    {
      float4 ca[4];
      moe_combine_row(p, row, lane, ca);
      const float* g2 = (const float*)(p.ws + O_MODV) + (1 * 3 + (row >> 13)) * 6144 + 5 * 1024;
#pragma unroll
      for (int i = 0; i < 4; ++i) {
        const float4 gg = *(const float4*)(g2 + (i * 64 + lane) * 4);
        xv[i].x += gg.x * ca[i].x; xv[i].y += gg.y * ca[i].y; xv[i].z += gg.z * ca[i].z; xv[i].w += gg.w * ca[i].w;
      }
    }
#pragma unroll
    for (int i = 0; i < 4; ++i) ss += xv[i].x * xv[i].x + xv[i].y * xv[i].y + xv[i].z * xv[i].z + xv[i].w * xv[i].w;
    ss = wsum(ss);
    const float rstd = rsqrtf(ss * (1.f / 1024.f) + EPS);
#pragma unroll
    for (int i = 0; i < 4; ++i) {
      const int col = (i * 64 + lane) * 4;
      const float4 g4 = *(const float4*)(p.final_norm_g + col);
      float4 y; y.x = xv[i].x * rstd * g4.x; y.y = xv[i].y * rstd * g4.y; y.z = xv[i].z * rstd * g4.z; y.w = xv[i].w * rstd * g4.w;
      *(float4*)(src + col) = y;
    }
  }
}

constexpr int NPHASE = 22;
DI void run_phase(const Params& p, int ph, char* smem) {
  const float* modv = (const float*)(p.ws + O_MODV);
  switch (ph) {
#if !defined(ONLY) || ONLY == 0
    case 0:
      phase_adaln(p, smem);
      __syncthreads();
      tconv(p.ab_w_in, 2832, 2832, 1024, 1, 0, (bf16_t*)(p.ws + O_WIN), 0, 1, smem);
      tconv(p.ab_w_out, 1024, 1024, 1024, 1, 0, (bf16_t*)(p.ws + O_WOUT), 0, 0, smem);
      tconv(p.gm_w_in, 4096, 4096, 1024, 1, 0, (bf16_t*)(p.ws + O_GMIN), 0, 0, smem);
      tconv(p.gm_w_out, 1024, 1024, 2048, 1, 0, (bf16_t*)(p.ws + O_GMOUT), 0, 0, smem);
      tconv_moe(p, 0, smem);
      break;
#endif
#if !defined(ONLY) || ONLY == 1
    case 1: phase_modulate<1, false>(p, 0, 0, smem); break;
#endif
#if !defined(ONLY) || ONLY == 2
    case 2:
      gemm_dense((const bf16_t*)(p.ws + O_HA), (const bf16_t*)(p.ws + O_WIN), NROW, PLD, 1024, 6, 11, smem,
                 [&](int m0, int n0) { return EpiBf16{(bf16_t*)(p.ws + O_P) + (size_t)m0 * PLD + n0, PLD}; });
      break;
#endif
#if !defined(ONLY) || ONLY == 3
    case 3: phase_prep2(p, smem); break;
#endif
#if !defined(ONLY) || ONLY == 4
    case 4:
      for (int item = blockIdx.x; item < 1024 + 8 * NSTEP; item += gridDim.x) {
        if (item < 1024) attn_item(p, item, smem); else mlstm_local_item(p, item - 1024, smem);
      }
      break;
#endif
#if !defined(ONLY) || ONLY == 5
    case 5: phase_scan(p, smem); break;
#endif
#if !defined(ONLY) || ONLY == 6
    case 6:
      for (int item = blockIdx.x; item < 512; item += gridDim.x) mlstm_out_item(p, item, smem);
      break;
#endif
#if !defined(ONLY) || ONLY == 7
    case 7:
      gemm_dense((const bf16_t*)(p.ws + O_HA), (const bf16_t*)(p.ws + O_WOUT), NTOK, 1024, 1024, 8, 8, smem,
                 [&](int m0, int n0) {
                   return EpiRes{p.out + (size_t)m0 * 1024 + n0, p.x + (size_t)m0 * 1024 + n0, modv + (0 * 3 + (m0 >> 13)) * 6144 + 2 * 1024 + n0};
                 });
      break;
#endif
#if !defined(ONLY) || ONLY == 8
    case 8: phase_modulate<2, false>(p, 0, 1, smem); break;
#endif
#if !defined(ONLY) || ONLY == 9
    case 9: phase_topk(p, smem); break;
#endif
#if !defined(ONLY) || ONLY == 10
    case 10: phase_moe1(p, smem); break;
#endif
#if !defined(ONLY) || ONLY == 11
    case 11: phase_moe2(p, 0, smem); break;
#endif
#if !defined(ONLY) || ONLY == 12
    case 12:
      phase_modulate<0, true>(p, 1, 0, smem);
      __syncthreads();
      tconv_moe(p, 1, smem);
      break;
#endif
#if !defined(ONLY) || ONLY == 13
    case 13:
      gemm_dense((const bf16_t*)(p.ws + O_HA), (const bf16_t*)(p.ws + O_GMIN), NTOK, 4096, 1024, 8, 8, smem,
                 [&](int m0, int n0) { return EpiGelu{(bf16_t*)(p.ws + O_U), (bf16_t*)(p.ws + O_GVT), m0, n0}; });
      break;
#endif
#if !defined(ONLY) || ONLY == 14
    case 14: phase_stats(p, smem); break;
#endif
#if !defined(ONLY) || ONLY == 15
    case 15: phase_spatial(p, smem); break;
#endif
#if !defined(ONLY) || ONLY == 16
    case 16:
      gemm_dense((const bf16_t*)(p.ws + O_UV), (const bf16_t*)(p.ws + O_GMOUT), NTOK, 1024, 2048, 8, 8, smem,
                 [&](int m0, int n0) {
                   return EpiRes{p.out + (size_t)m0 * 1024 + n0, p.out + (size_t)m0 * 1024 + n0, modv + (1 * 3 + (m0 >> 13)) * 6144 + 2 * 1024 + n0};
                 });
      break;
#endif
#if !defined(ONLY) || ONLY == 17
    case 17: phase_modulate<2, false>(p, 1, 1, smem); break;
#endif
#if !defined(ONLY) || ONLY == 18
    case 18: phase_topk(p, smem); break;
#endif
#if !defined(ONLY) || ONLY == 19
    case 19: phase_moe1(p, smem); break;
#endif
#if !defined(ONLY) || ONLY == 20
    case 20: phase_moe2(p, 1, smem); break;
#endif
#if !defined(ONLY) || ONLY == 21
    case 21: phase_final(p); break;
#endif
    default: break;
  }
}

#define XB_TMO      128
#define XB_XCNT(j)  (256  + 64 * (j))
#define XB_XSUB(j)  (1280 + 64 * (j))
#define XB_XGEN(j)  (2304 + 64 * (j))
#define XB_TOP      3328
#define XB_TOPGEN   3392
#define XCD_BAR_WORDS 3456
#define XB_SPIN_CAP (1u << 18)
#define LAS __attribute__((address_space(3)))
DI unsigned xb_ld(unsigned* p) { return __hip_atomic_load(p, __ATOMIC_RELAXED, __HIP_MEMORY_SCOPE_AGENT); }
DI unsigned xb_add(unsigned* p, unsigned v) { return __hip_atomic_fetch_add(p, v, __ATOMIC_RELAXED, __HIP_MEMORY_SCOPE_AGENT); }
DI unsigned xb_xcc_id() { return (unsigned)__builtin_amdgcn_s_getreg((3 << 11) | 20) & 0xFu; }
#define XB_SPIN(cond, bar) do { unsigned _sp = 0; while (cond) { __builtin_amdgcn_s_sleep(1); \
    if ((++_sp & 255u) == 0u) { if (xb_ld(&(bar)[XB_TMO])) break; if (_sp > XB_SPIN_CAP) { atomicAdd(&(bar)[XB_TMO], 1u); break; } } } } while (0)
struct XcdBarrier { unsigned* bar; unsigned x; volatile LAS unsigned* st; };
DI XcdBarrier xcd_barrier_post(unsigned* bar, volatile LAS unsigned* st) {
  XcdBarrier b; b.bar = bar; b.x = xb_xcc_id(); b.st = st;
  if (threadIdx.x == 0) st[3] = xb_add(&bar[XB_XCNT(b.x)], 1u);
  return b;
}
DI void xcd_barrier_complete(unsigned* bar, unsigned x, unsigned& nloc, unsigned& nx, unsigned& sbefore) {
  const unsigned G = gridDim.x * gridDim.y * gridDim.z;
  unsigned sum, cnt, mine, sp = 0u, sb = 0u;
  for (;;) {
    sum = 0u; cnt = 0u; mine = 0u; sb = 0u;
#pragma unroll
    for (unsigned j = 0; j < 16; ++j) { const unsigned c = xb_ld(&bar[XB_XCNT(j)]); sum += c; cnt += (c > 0u) ? 1u : 0u; mine = (j == x) ? c : mine; sb += (j < x) ? c : 0u; }
    if (sum == G) break;
    __builtin_amdgcn_s_sleep(1);
    if ((++sp & 255u) == 0u) { if (xb_ld(&bar[XB_TMO])) break; if (sp > XB_SPIN_CAP) { atomicAdd(&bar[XB_TMO], 1u); break; } }
  }
  nloc = mine > 0u ? mine : 1u; nx = cnt > 0u ? cnt : 1u; sbefore = sb;
}
DI void xcd_barrier(const XcdBarrier& b) {
  asm volatile("s_waitcnt vmcnt(0)" ::: "memory");
  __syncthreads();
  if (threadIdx.x == 0) {
    unsigned* bar = b.bar;
    __builtin_amdgcn_s_waitcnt(0);
    unsigned nloc = b.st[0], nx = b.st[1];
    if (nloc == 0u) { unsigned sbf; xcd_barrier_complete(bar, b.x, nloc, nx, sbf); b.st[0] = nloc; b.st[1] = nx; b.st[2] = sbf; }
    const unsigned old = xb_add(&bar[XB_XSUB(b.x)], 1u);
    const unsigned gen = old / nloc;
    if (old + 1u == (gen + 1u) * nloc) {
      __builtin_amdgcn_fence(__ATOMIC_RELEASE, "agent");
      asm volatile("s_waitcnt vmcnt(0)" ::: "memory");
      const unsigned og = xb_add(&bar[XB_TOP], 1u);
      const unsigned tg = og / nx;
      if (og + 1u == (tg + 1u) * nx) xb_add(&bar[XB_TOPGEN], 1u);
      else XB_SPIN(xb_ld(&bar[XB_TOPGEN]) == tg, bar);
      __builtin_amdgcn_fence(__ATOMIC_ACQUIRE, "agent");
      xb_add(&bar[XB_XGEN(b.x)], 1u);
      asm volatile("s_waitcnt vmcnt(0)" ::: "memory");
    } else {
      XB_SPIN(xb_ld(&bar[XB_XGEN(b.x)]) == gen, bar);
      __builtin_amdgcn_fence(__ATOMIC_ACQUIRE, "agent");
      asm volatile("s_waitcnt vmcnt(0)" ::: "memory");
    }
  }
  __syncthreads();
}

DI Params kargs() {
  Params P{};
#if defined(__HIP_DEVICE_COMPILE__)
  typedef const unsigned long long __attribute__((address_space(4))) CU;
  CU* q = (CU*)__builtin_amdgcn_kernarg_segment_ptr();
  asm volatile("" : "+s"(q));
#define GP(T, i) ((T*)(T __attribute__((address_space(1)))*)(q[i]))
  P.x = GP(const float, 0);
  P.c = GP(const float, 1);
  P.ctx = GP(const float, 2);
  P.c_ctx = GP(const float, 3);
  P.w_mod = GP(const float, 4);
  P.b_mod = GP(const float, 5);
  P.norm_mix_g = GP(const float, 6);
  P.norm_ffn_g = GP(const float, 7);
  P.final_norm_g = GP(const float, 8);
  P.ab_w_in = GP(const float, 9);
  P.ab_conv_w = GP(const float, 10);
  P.ab_gate_b = GP(const float, 11);
  P.ab_head_g = GP(const float, 12);
  P.ab_sink = GP(const float, 13);
  P.ab_w_out = GP(const float, 14);
  P.gm_w_in = GP(const float, 15);
  P.gm_ln_g = GP(const float, 16);
  P.gm_ln_b = GP(const float, 17);
  P.gm_w_s = GP(const float, 18);
  P.gm_b_s = GP(const float, 19);
  P.gm_w_out = GP(const float, 20);
  P.moe_w_router = GP(const float, 21);
  P.moe_w_gate = GP(const float, 22);
  P.moe_w_up = GP(const float, 23);
  P.moe_w_down = GP(const float, 24);
  P.out = GP(float, 25);
  P.ws = GP(char, 26);
#undef GP
#endif
  return P;
}
#if COOP
#ifndef REPEAT_MASK
#define REPEAT_MASK 0
#endif
__global__ void __launch_bounds__(256, 2) mega(Params p_unused) {
  __shared__ __attribute__((aligned(16))) char smem[73728 + 16];
  unsigned* xbw = (unsigned*)(smem + 73728);
  cg::grid_group grid = cg::this_grid();
  if (threadIdx.x < 4) xbw[threadIdx.x] = 0u;
  __syncthreads();
  XcdBarrier xb;
  { const Params pp = kargs(); xb = xcd_barrier_post((unsigned*)(pp.ws + O_BAR), (volatile LAS unsigned*)xbw); }
#define PHX(n) { const Params pp = kargs(); run_phase(pp, n, smem); } xcd_barrier(xb); \
  if ((REPEAT_MASK >> n) & 1) { { const Params pp = kargs(); run_phase(pp, n, smem); } xcd_barrier(xb); }
  { const Params pp = kargs(); run_phase(pp, 0, smem); }
  if (p_unused.ws == nullptr) grid.sync();
  xcd_barrier(xb);
  PHX(1) PHX(2) PHX(3) PHX(4) PHX(5) PHX(6) PHX(7) PHX(8) PHX(9) PHX(10)
  PHX(11) PHX(12) PHX(13) PHX(14) PHX(15) PHX(16) PHX(17) PHX(18) PHX(19) PHX(20)
  { const Params pp = kargs(); run_phase(pp, 21, smem); }
}
#else
__global__ void __launch_bounds__(256, 2) mega(Params p, int ph) {
  __shared__ __attribute__((aligned(16))) char smem[73728];
  run_phase(p, ph, smem);
}
#endif

extern "C" void kernel_launch(void* const* d_in, const int* in_sizes, int n_in, void* d_out, int out_size, void* d_ws,
                              size_t ws_size, hipStream_t stream) {
  (void)in_sizes; (void)n_in; (void)out_size;
  if (ws_size < WS_NEED) { fprintf(stderr, "workspace too small: %zu < %zu\n", ws_size, (size_t)WS_NEED); return; }
  static int grid_blocks = 0;
  if (!grid_blocks) {
    int dev = 0, cus = 0, per_cu = 0;
    hipGetDevice(&dev);
    hipDeviceGetAttribute(&cus, hipDeviceAttributeMultiprocessorCount, dev);
    hipOccupancyMaxActiveBlocksPerMultiprocessor(&per_cu, mega, 256, 0);
    if (per_cu < 1) per_cu = 1;
    if (per_cu > 2) per_cu = 2;
    grid_blocks = cus * per_cu;
  }
  Params p{};
  const float** f = (const float**)&p;
  for (int i = 0; i < 25; ++i) f[i] = (const float*)d_in[i];
  p.out = (float*)d_out;
  p.ws = (char*)d_ws;
#if COOP
  hipMemsetAsync((char*)d_ws + O_BAR, 0, XCD_BAR_WORDS * 4, stream);
  void* args[] = {&p};
  hipError_t e = hipLaunchCooperativeKernel((void*)mega, dim3(grid_blocks), dim3(256), args, 0, stream);
  if (e != hipSuccess) fprintf(stderr, "cooperative launch failed: %s (grid %d)\n", hipGetErrorString(e), grid_blocks);
#else
  for (int ph = 0; ph < NPHASE; ++ph) hipLaunchKernelGGL(mega, dim3(grid_blocks), dim3(256), 0, stream, p, ph);
#endif
}
```

```cpp
#include <hip/hip_runtime.h>
#include <hip/hip_cooperative_groups.h>
#include <cstdio>
namespace cg = cooperative_groups;

#define DI __device__ __forceinline__
typedef unsigned short bf16_t;
using bf16x8 = __attribute__((ext_vector_type(8))) short;
using s16x4 = __attribute__((ext_vector_type(4))) short;
using f32x16 = __attribute__((ext_vector_type(16))) float;
#define MFMA(a, b, c) __builtin_amdgcn_mfma_f32_32x32x16_bf16((a), (b), (c), 0, 0, 0)

#ifndef COOP
#define COOP 1
#endif

constexpr int DM = 1024, NBAT = 2, SEQ = 8192, NTOK = NBAT * SEQ, CTXL = 256, NROW = NTOK + NBAT * CTXL;
constexpr int PLD = 2816;
constexpr int NSTEP = 66;
constexpr float EPS = 1e-6f;

constexpr size_t al256(size_t x) { return (x + 255) & ~(size_t)255; }
constexpr size_t O_BAR = 0;
constexpr size_t O_WIN = 16384;
constexpr size_t O_WOUT = O_WIN + al256((size_t)PLD * 1024 * 2);
constexpr size_t O_GMIN = O_WOUT + al256((size_t)1024 * 1024 * 2);
constexpr size_t O_GMOUT = O_GMIN + al256((size_t)4096 * 1024 * 2);
constexpr size_t O_MGU = O_GMOUT + al256((size_t)1024 * 2048 * 2);
constexpr size_t O_MD = O_MGU + al256((size_t)16 * 2048 * 1024 * 2);
constexpr size_t O_MODV = O_MD + al256((size_t)16 * 1024 * 1024 * 2);
constexpr size_t O_HA = O_MODV + al256((size_t)2 * 3 * 6144 * 4);
constexpr size_t O_GL = O_HA + al256((size_t)NROW * 1024 * 2);
constexpr size_t O_AFF = O_GL + al256((size_t)NROW * 16 * 4);
constexpr size_t O_IDX = O_AFF + al256((size_t)32 * 8192 * 4);
constexpr size_t O_GATE = O_IDX + al256((size_t)32 * 1024 * 4);
constexpr size_t O_STATS = O_GATE + al256((size_t)32 * 1024 * 4);
constexpr size_t O_GSC = O_STATS + al256((size_t)NTOK * 16 * 4);
constexpr size_t O_MLOC = O_GSC + al256((size_t)16 * NSTEP * 4);
constexpr size_t O_DN = O_MLOC + al256((size_t)16 * NSTEP * 4);
constexpr size_t O_NST = O_DN + al256((size_t)16 * NSTEP * 128 * 4);
constexpr size_t O_MST = O_NST + al256((size_t)16 * 64 * 128 * 4);
constexpr size_t O_INV = O_MST + al256((size_t)16 * 64 * 4);
constexpr size_t O_R12 = O_INV + al256((size_t)NTOK * 16 * 4);
constexpr size_t O_P = O_R12;
constexpr size_t O_QC = O_P + al256((size_t)NROW * PLD * 2);
constexpr size_t O_KC = O_QC + al256((size_t)NTOK * 512 * 2);
constexpr size_t O_KT = O_KC + al256((size_t)NTOK * 512 * 2);
constexpr size_t O_VT = O_KT + al256((size_t)132 * 4 * 128 * 128 * 2);
constexpr size_t O_RQ = O_VT + al256((size_t)132 * 4 * 128 * 128 * 2);
constexpr size_t O_RK = O_RQ + al256((size_t)NTOK * 512 * 2);
constexpr size_t O_AVTX = O_RK + al256((size_t)NROW * 128 * 2);
constexpr size_t O_AVTC = O_AVTX + al256((size_t)4 * 64 * 8192 * 2);
constexpr size_t O_R12_END = O_AVTC + al256((size_t)4 * 64 * 256 * 2);
constexpr size_t O_HID = O_R12;
constexpr size_t O_U = O_R12;
constexpr size_t O_GVT = O_U + al256((size_t)NTOK * 2048 * 2);
static_assert(O_GVT + (size_t)NTOK * 2048 * 2 <= O_R12_END, "R12 too small");
constexpr size_t O_DC = O_R12_END;
constexpr size_t O_CST = O_DC + al256((size_t)16 * NSTEP * 16384 * 4);
constexpr size_t O_UV = O_DC;
constexpr size_t O_YE = O_DC;
constexpr size_t WS_NEED = O_CST + al256((size_t)16 * 64 * 16384 * 2);

struct Params {
  const float *x, *c, *ctx, *c_ctx, *w_mod, *b_mod, *norm_mix_g, *norm_ffn_g, *final_norm_g;
  const float *ab_w_in, *ab_conv_w, *ab_gate_b, *ab_head_g, *ab_sink, *ab_w_out;
  const float *gm_w_in, *gm_ln_g, *gm_ln_b, *gm_w_s, *gm_b_s, *gm_w_out;
  const float *moe_w_router, *moe_w_gate, *moe_w_up, *moe_w_down;
  float* out;
  char* ws;
};

DI bf16_t f2bf(float x) { unsigned u = __float_as_uint(x); u += 0x7fffu + ((u >> 16) & 1u); return (bf16_t)(u >> 16); }
DI float bf2f(bf16_t b) { return __uint_as_float(((unsigned)b) << 16); }
DI unsigned pack2(float a, float b) { return (unsigned)f2bf(a) | ((unsigned)f2bf(b) << 16); }
DI bf16x8 pack8(float a0, float a1, float a2, float a3, float a4, float a5, float a6, float a7) {
  uint4 u; u.x = pack2(a0, a1); u.y = pack2(a2, a3); u.z = pack2(a4, a5); u.w = pack2(a6, a7);
  return __builtin_bit_cast(bf16x8, u);
}
DI bf16x8 ldfrag(const bf16_t* p) { return *(const bf16x8*)p; }
DI bf16x8 ldfrag2(const bf16_t* p0, const bf16_t* p1) {
  s16x4 lo = *(const s16x4*)p0, hi = *(const s16x4*)p1;
  return __builtin_shufflevector(lo, hi, 0, 1, 2, 3, 4, 5, 6, 7);
}
DI int crow(int i, int hh) { return (i & 3) + 8 * (i >> 2) + 4 * hh; }
DI float siluf(float x) { return x / (1.f + __expf(-x)); }
DI float sigmf(float x) { return 1.f / (1.f + __expf(-x)); }
DI float logsigf(float x) { return fminf(x, 0.f) - log1pf(expf(-fabsf(x))); }
DI float geluf(float x) {
  const float u2 = 1.5957691216057308f * (x + 0.044715f * x * x * x);
  return x / (1.f + __expf(-u2));
}
DI float wsum(float v) {
#pragma unroll
  for (int o = 32; o > 0; o >>= 1) v += __shfl_xor(v, o);
  return v;
}
DI int tid() { int t = threadIdx.x; asm volatile("" : "+v"(t)); return t; }
DI f32x16 fzero() { f32x16 z; for (int i = 0; i < 16; ++i) z[i] = 0.f; return z; }

DI int tmap(int kind, int n) {
  if (kind == 0) return n;
  if (kind == 1) return n < 2048 ? n : (n < 2064 ? -1 : n - 16);
  int r = (n >> 6) * 128 + ((n >> 5) & 1) * 64 + (n & 31);
  return kind == 2 ? r : r + 32;
}
DI void tconv(const float* __restrict__ src, int ldn, int ncols, int K, int nmat, size_t sstride,
              bf16_t* __restrict__ dst, size_t dstride, int kind, char* smem) {
  float* sm = (float*)smem;
  const int t = tid();
  const int ntn = (ncols + 63) >> 6, ntk = K >> 6, per = ntn * ntk, total = per * nmat;
  const int c4 = t & 15, rr = t >> 4;
  float4 v0, v1, v2, v3;
#define TC_LOAD(tile_) { const int mat_ = (tile_) / per, tt_ = (tile_) % per; const int k0_ = (tt_ / ntn) * 64, n_ = (tt_ % ntn) * 64 + c4 * 4; \
    const float* s_ = src + (size_t)mat_ * sstride + (size_t)(k0_ + rr) * ldn + n_; \
    if (n_ < ncols) { v0 = *(const float4*)(s_); v1 = *(const float4*)(s_ + (size_t)16 * ldn); v2 = *(const float4*)(s_ + (size_t)32 * ldn); v3 = *(const float4*)(s_ + (size_t)48 * ldn); } \
    else { v0 = v1 = v2 = v3 = make_float4(0.f, 0.f, 0.f, 0.f); } }
  int tile = blockIdx.x;
  if (tile < total) TC_LOAD(tile)
  for (; tile < total; tile += gridDim.x) {
    const int mat = tile / per, tt = tile % per;
    const int k0 = (tt / ntn) * 64, n0 = (tt % ntn) * 64;
    bf16_t* d = dst + (size_t)mat * dstride;
    {
      float* q = sm + rr * 65 + c4 * 4;
      q[0] = v0.x; q[1] = v0.y; q[2] = v0.z; q[3] = v0.w;
      q[16 * 65 + 0] = v1.x; q[16 * 65 + 1] = v1.y; q[16 * 65 + 2] = v1.z; q[16 * 65 + 3] = v1.w;
      q[32 * 65 + 0] = v2.x; q[32 * 65 + 1] = v2.y; q[32 * 65 + 2] = v2.z; q[32 * 65 + 3] = v2.w;
      q[48 * 65 + 0] = v3.x; q[48 * 65 + 1] = v3.y; q[48 * 65 + 2] = v3.z; q[48 * 65 + 3] = v3.w;
    }
    if (tile + (int)gridDim.x < total) TC_LOAD(tile + (int)gridDim.x)
    __syncthreads();
    const int nl = t >> 2, kq = t & 3, n = n0 + nl;
    if (n < ncols) {
      const int row = tmap(kind, n);
      if (row >= 0) {
        uint4 o0, o1;
        const float* q = sm + (kq * 16) * 65 + nl;
        o0.x = pack2(q[0 * 65], q[1 * 65]); o0.y = pack2(q[2 * 65], q[3 * 65]); o0.z = pack2(q[4 * 65], q[5 * 65]); o0.w = pack2(q[6 * 65], q[7 * 65]);
        o1.x = pack2(q[8 * 65], q[9 * 65]); o1.y = pack2(q[10 * 65], q[11 * 65]); o1.z = pack2(q[12 * 65], q[13 * 65]); o1.w = pack2(q[14 * 65], q[15 * 65]);
        uint4* dp = (uint4*)(d + (size_t)row * K + k0 + kq * 16);
        dp[0] = o0; dp[1] = o1;
      }
    }
    __syncthreads();
  }
#undef TC_LOAD
}
DI void tconv_moe(const Params& p, int layer, char* smem) {
  const size_t wo = (size_t)layer * 16 * 1024 * 1024;
  tconv(p.moe_w_gate + wo, 1024, 1024, 1024, 16, (size_t)1024 * 1024, (bf16_t*)(p.ws + O_MGU), (size_t)2048 * 1024, 2, smem);
  tconv(p.moe_w_up + wo, 1024, 1024, 1024, 16, (size_t)1024 * 1024, (bf16_t*)(p.ws + O_MGU), (size_t)2048 * 1024, 3, smem);
  tconv(p.moe_w_down + wo, 1024, 1024, 1024, 16, (size_t)1024 * 1024, (bf16_t*)(p.ws + O_MD), (size_t)1024 * 1024, 0, smem);
}

DI void phase_adaln(const Params& p, char* smem) {
  float* sv = (float*)smem;
  float* red = sv + 3 * 1024;
  float* modv = (float*)(p.ws + O_MODV);
  const int t = tid();
  if (blockIdx.x >= 192) return;
  for (int i = t; i < 3 * 1024; i += 256) {
    const int v = i >> 10, k = i & 1023;
    const float cv = v < 2 ? p.c[v * 1024 + k] : p.c_ctx[k];
    sv[i] = siluf(cv);
  }
  __syncthreads();
  for (int item = blockIdx.x; item < 192; item += gridDim.x) {
    const int l = item / 96, cb = item % 96;
    const int cq = t & 15, kg = t >> 4;
    const float* w = p.w_mod + (size_t)l * 1024 * 6144 + cb * 64 + cq * 4;
    float a0[4] = {0.f, 0.f, 0.f, 0.f}, a1[4] = {0.f, 0.f, 0.f, 0.f}, a2[4] = {0.f, 0.f, 0.f, 0.f};
    for (int i = 0; i < 64; ++i) {
      const int k = kg + 16 * i;
      const float4 wv = *(const float4*)(w + (size_t)k * 6144);
      const float s0 = sv[k], s1 = sv[1024 + k], s2 = sv[2048 + k];
      a0[0] += s0 * wv.x; a0[1] += s0 * wv.y; a0[2] += s0 * wv.z; a0[3] += s0 * wv.w;
      a1[0] += s1 * wv.x; a1[1] += s1 * wv.y; a1[2] += s1 * wv.z; a1[3] += s1 * wv.w;
      a2[0] += s2 * wv.x; a2[1] += s2 * wv.y; a2[2] += s2 * wv.z; a2[3] += s2 * wv.w;
    }
#pragma unroll
    for (int j = 0; j < 4; ++j) {
      red[(kg * 3 + 0) * 64 + cq * 4 + j] = a0[j];
      red[(kg * 3 + 1) * 64 + cq * 4 + j] = a1[j];
      red[(kg * 3 + 2) * 64 + cq * 4 + j] = a2[j];
    }
    __syncthreads();
    if (t < 192) {
      const int v = t >> 6, col = t & 63;
      float s = 0.f;
      for (int g = 0; g < 16; ++g) s += red[(g * 3 + v) * 64 + col];
      const int cc = cb * 64 + col;
      modv[(l * 3 + v) * 6144 + cc] = s + p.b_mod[l * 6144 + cc];
    }
    __syncthreads();
  }
}

DI void moe_combine_row(const Params& p, int row, int lane, float4 (&acc)[4]) {
  const int* INV = (const int*)(p.ws + O_INV); const float* GATE = (const float*)(p.ws + O_GATE);
  const bf16_t* YE = (const bf16_t*)(p.ws + O_YE);
  const int b = row >> 13;
  const int myslot = INV[(size_t)row * 16 + (lane & 15)];
#pragma unroll
  for (int i = 0; i < 4; ++i) acc[i] = make_float4(0.f, 0.f, 0.f, 0.f);
#pragma unroll 1
  for (int e = 0; e < 16; ++e) {
    const int slot = __builtin_amdgcn_readlane(myslot, e);
    if (slot != 0) {
      const int be = b * 16 + e;
      const float g = GATE[be * 1024 + slot - 1];
      const bf16_t* yr = YE + ((size_t)be * 1024 + slot - 1) * 1024;
#pragma unroll
      for (int i = 0; i < 4; ++i) {
        const s16x4 v = *(const s16x4*)(yr + (i * 64 + lane) * 4);
        acc[i].x += g * bf2f((bf16_t)v[0]); acc[i].y += g * bf2f((bf16_t)v[1]); acc[i].z += g * bf2f((bf16_t)v[2]); acc[i].w += g * bf2f((bf16_t)v[3]);
      }
    }
  }
}

template <int MODE, bool COMB>
DI void phase_modulate(const Params& p, int layer, int which, char* smem) {
  float* wt = (float*)smem;
  const int t = tid(), lane = t & 63, w = t >> 6;
  const float* modv = (const float*)(p.ws + O_MODV);
  bf16_t* HA = (bf16_t*)(p.ws + O_HA);
  if (MODE != 0) {
    const float* W = MODE == 1 ? p.ab_w_in + 2048 : p.moe_w_router + (size_t)layer * 1024 * 16;
    const int ld = MODE == 1 ? 2832 : 16;
    for (int i = t; i < 4096; i += 256) {
      const int k = i >> 2, e4 = i & 3;
      const float4 v = *(const float4*)(W + (size_t)k * ld + e4 * 4);
      wt[(e4 * 4 + 0) * 1024 + k] = v.x; wt[(e4 * 4 + 1) * 1024 + k] = v.y; wt[(e4 * 4 + 2) * 1024 + k] = v.z; wt[(e4 * 4 + 3) * 1024 + k] = v.w;
    }
    __syncthreads();
  }
  const float* gn = (which == 0 ? p.norm_mix_g : p.norm_ffn_g) + layer * 1024;
  const int nrows = MODE == 1 ? NROW : NTOK;
  const int rstride = gridDim.x * 4;
  float4 nx[4];
#define MOD_SRC(row_) (MODE == 1 ? ((row_) < NTOK ? p.x + (size_t)(row_) * 1024 : p.ctx + (size_t)((row_) - NTOK) * 1024) : p.out + (size_t)(row_) * 1024)
  {
    const int row0_ = blockIdx.x * 4 + w;
    if (row0_ < nrows) {
      const float* s0_ = MOD_SRC(row0_);
#pragma unroll
      for (int i = 0; i < 4; ++i) nx[i] = *(const float4*)(s0_ + (i * 64 + lane) * 4);
    }
  }
  for (int row = blockIdx.x * 4 + w; row < nrows; row += rstride) {
    const int v = (MODE == 1 && row >= NTOK) ? 2 : (row >> 13);
    const float* sh = modv + (layer * 3 + v) * 6144 + (which ? 3 : 0) * 1024;
    const float* sc = sh + 1024;
    float4 xv[4];
    float ss = 0.f;
#pragma unroll
    for (int i = 0; i < 4; ++i) xv[i] = nx[i];
    if (row + rstride < nrows) {
      const float* s1_ = MOD_SRC(row + rstride);
#pragma unroll
      for (int i = 0; i < 4; ++i) nx[i] = *(const float4*)(s1_ + (i * 64 + lane) * 4);
    }
    if (COMB) {
      float4 ca[4];
      moe_combine_row(p, row, lane, ca);
      const float* g2 = modv + ((layer - 1) * 3 + v) * 6144 + 5 * 1024;
#pragma unroll
      for (int i = 0; i < 4; ++i) {
        const float4 gg = *(const float4*)(g2 + (i * 64 + lane) * 4);
        xv[i].x += gg.x * ca[i].x; xv[i].y += gg.y * ca[i].y; xv[i].z += gg.z * ca[i].z; xv[i].w += gg.w * ca[i].w;
        *(float4*)(p.out + (size_t)row * 1024 + (i * 64 + lane) * 4) = xv[i];
      }
    }
#pragma unroll
    for (int i = 0; i < 4; ++i) ss += xv[i].x * xv[i].x + xv[i].y * xv[i].y + xv[i].z * xv[i].z + xv[i].w * xv[i].w;
    ss = wsum(ss);
    const float rstd = rsqrtf(ss * (1.f / 1024.f) + EPS);
    float4 yv[4];
#pragma unroll
    for (int i = 0; i < 4; ++i) {
      const int col = (i * 64 + lane) * 4;
      const float4 g4 = *(const float4*)(gn + col), s4 = *(const float4*)(sh + col), c4 = *(const float4*)(sc + col);
      float4 y;
      y.x = xv[i].x * rstd * g4.x * (1.f + c4.x) + s4.x;
      y.y = xv[i].y * rstd * g4.y * (1.f + c4.y) + s4.y;
      y.z = xv[i].z * rstd * g4.z * (1.f + c4.z) + s4.z;
      y.w = xv[i].w * rstd * g4.w * (1.f + c4.w) + s4.w;
      yv[i] = y;
      uint2 o; o.x = pack2(y.x, y.y); o.y = pack2(y.z, y.w);
      *(uint2*)(HA + (size_t)row * 1024 + col) = o;
    }
    if (MODE != 0) {
      float mine = 0.f;
#pragma unroll 1
      for (int e4 = 0; e4 < 16; e4 += 4) {
        float pe0 = 0.f, pe1 = 0.f, pe2 = 0.f, pe3 = 0.f;
#pragma unroll
        for (int i = 0; i < 4; ++i) {
          const float* wp = wt + e4 * 1024 + (i * 64 + lane) * 4;
          const float4 wa = *(const float4*)(wp), wb = *(const float4*)(wp + 1024), wc = *(const float4*)(wp + 2048), wd = *(const float4*)(wp + 3072);
          pe0 += yv[i].x * wa.x + yv[i].y * wa.y + yv[i].z * wa.z + yv[i].w * wa.w;
          pe1 += yv[i].x * wb.x + yv[i].y * wb.y + yv[i].z * wb.z + yv[i].w * wb.w;
          pe2 += yv[i].x * wc.x + yv[i].y * wc.y + yv[i].z * wc.z + yv[i].w * wc.w;
          pe3 += yv[i].x * wd.x + yv[i].y * wd.y + yv[i].z * wd.z + yv[i].w * wd.w;
        }
#pragma unroll
        for (int o = 32; o > 0; o >>= 1) {
          const float q0 = __shfl_xor(pe0, o), q1 = __shfl_xor(pe1, o), q2 = __shfl_xor(pe2, o), q3 = __shfl_xor(pe3, o);
          pe0 += q0; pe1 += q1; pe2 += q2; pe3 += q3;
        }
        const int el = (lane & 15) - e4;
        mine = el == 0 ? pe0 : (el == 1 ? pe1 : (el == 2 ? pe2 : (el == 3 ? pe3 : mine)));
      }
      const int e = lane & 15;
      if (MODE == 1) {
        float val = mine + p.ab_gate_b[e];
        if (((e >> 2) & 1) == 1) val = logsigf(val);
        if (lane < 16) ((float*)(p.ws + O_GL))[(size_t)row * 16 + lane] = val;
      } else {
        float mx = mine;
#pragma unroll
        for (int o = 8; o > 0; o >>= 1) mx = fmaxf(mx, __shfl_xor(mx, o));
        const float ex = expf(mine - mx);
        float sum = ex;
#pragma unroll
        for (int o = 8; o > 0; o >>= 1) sum += __shfl_xor(sum, o);
        if (lane < 16) ((float*)(p.ws + O_AFF))[((size_t)(row >> 13) * 16 + lane) * 8192 + (row & 8191)] = ex / sum;
        if (lane < 16) ((int*)(p.ws + O_INV))[(size_t)row * 16 + lane] = 0;
      }
    }
  }
}

template <bool DENSEA, class Epi>
DI void gemm_tile(const bf16_t* Abase, const unsigned (&aoff)[8], const bf16_t* Bbase, unsigned boff, int K, char* smem, Epi&& epi) {
  bf16_t* sA = (bf16_t*)smem;
  bf16_t* sB = sA + 256 * 72;
  const int t = tid(), lane = t & 63, w = t >> 6, wm = w >> 1, wn = w & 1, r = lane & 31, hh = lane >> 5;
  const int lrow = t >> 3, lcol = (t & 7) * 8;
  const unsigned bst = 32u * (unsigned)K;
  f32x16 acc[4][2];
#pragma unroll
  for (int i = 0; i < 4; ++i) { acc[i][0] = fzero(); acc[i][1] = fzero(); }
  uint4 A0, A1, A2, A3, A4, A5, A6, A7, B0, B1, B2, B3;
#define GLOADT(kn_) { \
    const bf16_t* Ak_ = Abase + (kn_); const bf16_t* Bk_ = Bbase + (kn_);     \
    if (DENSEA) { \
      A0 = *(const uint4*)(Ak_ + aoff[0]); A1 = *(const uint4*)((Ak_ + bst) + aoff[0]); A2 = *(const uint4*)((Ak_ + 2 * bst) + aoff[0]); A3 = *(const uint4*)((Ak_ + 3 * bst) + aoff[0]); \
      A4 = *(const uint4*)((Ak_ + 4 * bst) + aoff[0]); A5 = *(const uint4*)((Ak_ + 5 * bst) + aoff[0]); A6 = *(const uint4*)((Ak_ + 6 * bst) + aoff[0]); A7 = *(const uint4*)((Ak_ + 7 * bst) + aoff[0]); \
    } else { \
      A0 = *(const uint4*)(Ak_ + aoff[0]); A1 = *(const uint4*)(Ak_ + aoff[1]); A2 = *(const uint4*)(Ak_ + aoff[2]); A3 = *(const uint4*)(Ak_ + aoff[3]); \
      A4 = *(const uint4*)(Ak_ + aoff[4]); A5 = *(const uint4*)(Ak_ + aoff[5]); A6 = *(const uint4*)(Ak_ + aoff[6]); A7 = *(const uint4*)(Ak_ + aoff[7]); \
    } \
    B0 = *(const uint4*)(Bk_ + boff); B1 = *(const uint4*)((Bk_ + bst) + boff); B2 = *(const uint4*)((Bk_ + 2 * bst) + boff); B3 = *(const uint4*)((Bk_ + 3 * bst) + boff); }
  GLOADT(0)
  const int so = lrow * 72 + lcol;
  const bf16_t* cA = sA + (wm * 128 + r) * 72 + hh * 8;
  const bf16_t* cB = sB + (wn * 64 + r) * 72 + hh * 8;
  const int KT = K >> 6;
  for (int kt = 0; kt < KT; ++kt) {
    __syncthreads();
    *(uint4*)(sA + so) = A0; *(uint4*)(sA + so + 32 * 72) = A1; *(uint4*)(sA + so + 64 * 72) = A2; *(uint4*)(sA + so + 96 * 72) = A3;
    *(uint4*)(sA + so + 128 * 72) = A4; *(uint4*)(sA + so + 160 * 72) = A5; *(uint4*)(sA + so + 192 * 72) = A6; *(uint4*)(sA + so + 224 * 72) = A7;
    *(uint4*)(sB + so) = B0; *(uint4*)(sB + so + 32 * 72) = B1; *(uint4*)(sB + so + 64 * 72) = B2; *(uint4*)(sB + so + 96 * 72) = B3;
    __syncthreads();
    { const int kn = (kt + 1 < KT ? kt + 1 : kt) * 64; GLOADT(kn) }
    __builtin_amdgcn_sched_barrier(0);
    __builtin_amdgcn_s_setprio(1);
#pragma unroll
    for (int ks = 0; ks < 4; ++ks) {
      const bf16x8 b0 = *(const bf16x8*)(cB + ks * 16), b1 = *(const bf16x8*)(cB + 32 * 72 + ks * 16);
#pragma unroll
      for (int mi = 0; mi < 4; ++mi) {
        const bf16x8 a = *(const bf16x8*)(cA + mi * 32 * 72 + ks * 16);
        acc[mi][0] = MFMA(a, b0, acc[mi][0]);
        acc[mi][1] = MFMA(a, b1, acc[mi][1]);
      }
      if (ks == 1) __builtin_amdgcn_sched_barrier(0);
    }
    __builtin_amdgcn_s_setprio(0);
    __builtin_amdgcn_sched_barrier(0);
  }
#undef GLOADT
  epi(acc, wm * 128, wn * 64, r, hh);
}

struct TileWalk {
  int L, Lend, nl;
  DI TileWalk(int T, const char* smem) {
    const volatile unsigned* xw = (const volatile unsigned*)(smem + 73728);
    const int nloc = (int)xw[0], sb = (int)xw[2], rk = (int)xw[3];
    int G = (int)gridDim.x;
    asm volatile("" : "+s"(G));
    nl = nloc;
    L = (T * sb) / G + rk; Lend = (T * (sb + nloc)) / G;
  }
  DI bool valid() const { return L < Lend; }
  DI void next() { L += nl; }
  DI void get(int SM, int SN, int nsn, int& mt, int& nt) const {
    const int s = L / (SM * SN), wi = L % (SM * SN);
    mt = (s / nsn) * SM + wi / SN; nt = (s % nsn) * SN + wi % SN;
  }
};

template <class MakeEpi>
DI void gemm_dense(const bf16_t* A, const bf16_t* Bt, int M, int N, int K, int SM, int SN, char* smem, MakeEpi&& mk) {
  const int t = tid(), lrow = t >> 3, lcol = (t & 7) * 8;
  const int ntn = N >> 7, ntm = M >> 8;
  for (TileWalk tw(ntn * ntm, smem); tw.valid(); tw.next()) {
    int mt, nt; tw.get(SM, SN, ntn / SN, mt, nt);
    unsigned aoff[8];
#pragma unroll
    for (int i = 0; i < 8; ++i) aoff[i] = (unsigned)(lrow + 32 * i) * (unsigned)K + (unsigned)lcol;
    gemm_tile<true>(A + (size_t)mt * 256 * K, aoff, Bt + (size_t)(nt * 128) * K, (unsigned)lrow * (unsigned)K + (unsigned)lcol, K, smem, mk(mt * 256, nt * 128));
  }
}

DI void phase_prep2(const Params& p, char* smem) {
  bf16_t* T = (bf16_t*)smem;
  const bf16_t* P = (const bf16_t*)(p.ws + O_P);
  bf16_t* Qc = (bf16_t*)(p.ws + O_QC); bf16_t* Kc = (bf16_t*)(p.ws + O_KC);
  bf16_t* KT = (bf16_t*)(p.ws + O_KT); bf16_t* VT = (bf16_t*)(p.ws + O_VT);
  bf16_t* RQ = (bf16_t*)(p.ws + O_RQ); bf16_t* RK = (bf16_t*)(p.ws + O_RK);
  bf16_t* AVTX = (bf16_t*)(p.ws + O_AVTX); bf16_t* AVTC = (bf16_t*)(p.ws + O_AVTC);
  const int t = tid();
  for (int item = blockIdx.x; item < 132 * 6; item += gridDim.x) {
    const int sc = item / 6, part = item % 6;
    const bool isx = sc < 128;
    const int row0 = sc * 128;
    const int seq_lo = isx ? (sc >> 6) * 8192 : NTOK + ((sc - 128) >> 1) * 256;
    const int seq_hi = seq_lo + (isx ? 8192 : 256);
    if (part < 4) {
      const int h = part;
      const int col8 = t & 15, rsub = t >> 4;
      for (int pass = 0; pass < 3; ++pass) {
        if (pass == 2 && !isx) break;
        const int pcol = (pass == 0 ? 512 : (pass == 1 ? 1024 : 0)) + h * 128 + col8 * 8;
        float cw[5][8];
        if (pass != 1) {
#pragma unroll
          for (int j = 0; j < 5; ++j)
#pragma unroll
            for (int e = 0; e < 8; ++e) cw[j][e] = p.ab_conv_w[j * 1024 + (pass == 0 ? 512 : 0) + h * 128 + col8 * 8 + e];
        }
        for (int i = 0; i < 8; ++i) {
          const int rl = rsub + 16 * i, row = row0 + rl;
          uint4 o;
          if (pass == 1) {
            o = *(const uint4*)(P + (size_t)row * PLD + pcol);
          } else {
            float a[8];
#pragma unroll
            for (int e = 0; e < 8; ++e) a[e] = 0.f;
#pragma unroll
            for (int j = 0; j < 5; ++j) {
              const int rr = row + j - 2;
              if (rr >= seq_lo && rr < seq_hi) {
                const bf16x8 v = *(const bf16x8*)(P + (size_t)rr * PLD + pcol);
#pragma unroll
                for (int e = 0; e < 8; ++e) a[e] += cw[j][e] * bf2f((bf16_t)v[e]);
              }
            }
            const float scl = pass == 0 ? 0.08838834764831845f : 1.f;
#pragma unroll
            for (int e = 0; e < 8; ++e) a[e] = siluf(a[e]) * scl;
            o.x = pack2(a[0], a[1]); o.y = pack2(a[2], a[3]); o.z = pack2(a[4], a[5]); o.w = pack2(a[6], a[7]);
            if (isx) *(uint4*)((pass == 0 ? Kc : Qc) + (size_t)row * 512 + h * 128 + col8 * 8) = o;
          }
          if (pass < 2) *(uint4*)(T + rl * 136 + col8 * 8) = o;
        }
        if (pass < 2) {
          __syncthreads();
          bf16_t* dstT = (pass == 0 ? KT : VT) + (size_t)(sc * 4 + h) * 16384;
          const int d = t & 127, shf = t >> 7;
#pragma unroll
          for (int s8 = 0; s8 < 8; ++s8) {
            const bf16_t* q = T + (shf * 64 + s8 * 8) * 136 + d;
            uint4 o;
            o.x = (unsigned)q[0] | ((unsigned)q[136] << 16); o.y = (unsigned)q[2 * 136] | ((unsigned)q[3 * 136] << 16);
            o.z = (unsigned)q[4 * 136] | ((unsigned)q[5 * 136] << 16); o.w = (unsigned)q[6 * 136] | ((unsigned)q[7 * 136] << 16);
            *(uint4*)(dstT + d * 128 + shf * 64 + s8 * 8) = o;
          }
          __syncthreads();
        }
      }
    } else if (part == 4) {
      if (!isx) continue;
      for (int idx = t; idx < 512; idx += 256) {
        const int rl = idx >> 2, dc = idx & 3, row = row0 + rl, pos = row - seq_lo;
        const float rp = (float)(pos >> 6), cp = (float)(pos & 63);
        float cs[8], sn[8];
#pragma unroll
        for (int e = 0; e < 8; ++e) {
          const int a = dc * 8 + e;
          const float inv = powf(10000.f, -(float)(a & 15) / 16.f);
          const float ang = (a < 16 ? rp : cp) * inv;
          cs[e] = cosf(ang); sn[e] = sinf(ang);
        }
        for (int hq = 0; hq < 8; ++hq) {
          const bf16x8 x1 = *(const bf16x8*)(P + (size_t)row * PLD + 2048 + hq * 64 + dc * 8);
          const bf16x8 x2 = *(const bf16x8*)(P + (size_t)row * PLD + 2048 + hq * 64 + 32 + dc * 8);
          float o1[8], o2[8];
#pragma unroll
          for (int e = 0; e < 8; ++e) {
            const float a = bf2f((bf16_t)x1[e]), b = bf2f((bf16_t)x2[e]);
            o1[e] = (a * cs[e] - b * sn[e]) * 0.125f; o2[e] = (b * cs[e] + a * sn[e]) * 0.125f;
          }
          uint4 u1, u2;
          u1.x = pack2(o1[0], o1[1]); u1.y = pack2(o1[2], o1[3]); u1.z = pack2(o1[4], o1[5]); u1.w = pack2(o1[6], o1[7]);
          u2.x = pack2(o2[0], o2[1]); u2.y = pack2(o2[2], o2[3]); u2.z = pack2(o2[4], o2[5]); u2.w = pack2(o2[6], o2[7]);
          *(uint4*)(RQ + (size_t)row * 512 + hq * 64 + dc * 8) = u1;
          *(uint4*)(RQ + (size_t)row * 512 + hq * 64 + 32 + dc * 8) = u2;
        }
      }
    } else {
      for (int idx = t; idx < 512; idx += 256) {
        const int rl = idx >> 2, dc = idx & 3, row = row0 + rl, pos = row - seq_lo;
        const float rp = (float)(pos >> 6), cp = (float)(pos & 63);
        float cs[8], sn[8];
#pragma unroll
        for (int e = 0; e < 8; ++e) {
          const int a = dc * 8 + e;
          const float inv = powf(10000.f, -(float)(a & 15) / 16.f);
          const float ang = (a < 16 ? rp : cp) * inv;
          cs[e] = isx ? cosf(ang) : 1.f; sn[e] = isx ? sinf(ang) : 0.f;
        }
        for (int g = 0; g < 2; ++g) {
          const bf16x8 x1 = *(const bf16x8*)(P + (size_t)row * PLD + 2560 + g * 64 + dc * 8);
          const bf16x8 x2 = *(const bf16x8*)(P + (size_t)row * PLD + 2560 + g * 64 + 32 + dc * 8);
          float o1[8], o2[8];
#pragma unroll
          for (int e = 0; e < 8; ++e) {
            const float a = bf2f((bf16_t)x1[e]), b = bf2f((bf16_t)x2[e]);
            o1[e] = a * cs[e] - b * sn[e]; o2[e] = b * cs[e] + a * sn[e];
          }
          uint4 u1, u2;
          u1.x = pack2(o1[0], o1[1]); u1.y = pack2(o1[2], o1[3]); u1.z = pack2(o1[4], o1[5]); u1.w = pack2(o1[6], o1[7]);
          u2.x = pack2(o2[0], o2[1]); u2.y = pack2(o2[2], o2[3]); u2.z = pack2(o2[4], o2[5]); u2.w = pack2(o2[6], o2[7]);
          *(uint4*)(RK + (size_t)row * 128 + g * 64 + dc * 8) = u1;
          *(uint4*)(RK + (size_t)row * 128 + g * 64 + 32 + dc * 8) = u2;
        }
      }
      {
        const int col8 = t & 15, rsub = t >> 4;
        for (int i = 0; i < 8; ++i) {
          const int rl = rsub + 16 * i;
          *(uint4*)(T + rl * 136 + col8 * 8) = *(const uint4*)(P + (size_t)(row0 + rl) * PLD + 2688 + col8 * 8);
        }
        __syncthreads();
        const int d = t & 127, shf = t >> 7;
        const int b = isx ? (sc >> 6) : ((sc - 128) >> 1);
        const int pos0 = row0 - seq_lo;
        bf16_t* dst = isx ? AVTX + ((size_t)(b * 2 + (d >> 6)) * 64 + (d & 63)) * 8192 + pos0
                          : AVTC + ((size_t)(b * 2 + (d >> 6)) * 64 + (d & 63)) * 256 + pos0;
#pragma unroll
        for (int s8 = 0; s8 < 8; ++s8) {
          const bf16_t* q = T + (shf * 64 + s8 * 8) * 136 + d;
          uint4 o;
          o.x = (unsigned)q[0] | ((unsigned)q[136] << 16); o.y = (unsigned)q[2 * 136] | ((unsigned)q[3 * 136] << 16);
          o.z = (unsigned)q[4 * 136] | ((unsigned)q[5 * 136] << 16); o.w = (unsigned)q[6 * 136] | ((unsigned)q[7 * 136] << 16);
          *(uint4*)(dst + shf * 64 + s8 * 8) = o;
        }
        __syncthreads();
      }
    }
  }
}

DI void attn_item(const Params& p, int item, char* smem) {
  const int g = item & 1, qb = (item >> 1) & 255, b = item >> 9;
  int t_ = tid();
  asm volatile("" : "+v"(t_));
  const int t = t_, lane = t & 63, w = t >> 6, r = lane & 31, hh = lane >> 5;
  const int hq = g * 4 + w, q0 = qb * 32;
  const bf16_t* RQ = (const bf16_t*)(p.ws + O_RQ); const bf16_t* RK = (const bf16_t*)(p.ws + O_RK);
  const bf16_t* AVTX = (const bf16_t*)(p.ws + O_AVTX); const bf16_t* AVTC = (const bf16_t*)(p.ws + O_AVTC);
  bf16_t* MIX = (bf16_t*)(p.ws + O_HA);
  const size_t qrow = (size_t)b * 8192 + q0 + r;
  bf16x8 qf[4];
#pragma unroll
  for (int ks = 0; ks < 4; ++ks) qf[ks] = ldfrag(RQ + qrow * 512 + hq * 64 + ks * 16 + hh * 8);
  float m = p.ab_sink[hq], l = hh == 0 ? 1.f : 0.f;
  f32x16 o0 = fzero(), o1 = fzero();
  const int ipos = q0 + r;
  const int lo = q0 - 128 < 0 ? 0 : q0 - 128, hi = q0 + 128 > 8192 - 32 ? 8192 - 32 : q0 + 128;
  const int nloc = ((hi - lo) >> 5) + 1, ntile = nloc + 8;
  bf16_t* sKt = (bf16_t*)smem;
  bf16_t* sVt = sKt + 2 * 32 * 72;
  const bf16_t* kloc = RK + (size_t)(b * 8192) * 128 + g * 64 + (t >> 3) * 128 + (t & 7) * 8;
  const bf16_t* kctx = RK + (size_t)(NTOK + b * 256) * 128 + g * 64 + (t >> 3) * 128 + (t & 7) * 8;
  const bf16_t* vloc = AVTX + (size_t)((b * 2 + g) * 64 + (t >> 2)) * 8192 + (t & 3) * 8;
  const bf16_t* vctx = AVTC + (size_t)((b * 2 + g) * 64 + (t >> 2)) * 256 + (t & 3) * 8;
  const int skoff = (t >> 3) * 72 + (t & 7) * 8, svoff = (t >> 2) * 40 + (t & 3) * 8;
  uint4 gk, gv;
#define ATT_LOAD(j_) { const bool loc_ = (j_) < nloc; const int k0_ = loc_ ? lo + (j_) * 32 : ((j_) - nloc) * 32; \
    gk = *(const uint4*)((loc_ ? kloc : kctx) + (size_t)k0_ * 128); gv = *(const uint4*)((loc_ ? vloc : vctx) + k0_); }
  ATT_LOAD(0)
  __syncthreads();
  *(uint4*)(sKt + skoff) = gk; *(uint4*)(sVt + svoff) = gv;
  __syncthreads();
#pragma unroll 1
  for (int tile = 0; tile < ntile; ++tile) {
    const int cur = tile & 1;
    if (tile + 1 < ntile) ATT_LOAD(tile + 1)
    const bool local = tile < nloc;
    const int k0 = local ? lo + tile * 32 : (tile - nloc) * 32;
    const bf16_t* kt = sKt + cur * 32 * 72 + r * 72 + hh * 8;
    const bf16_t* vt = sVt + cur * 64 * 40 + r * 40 + 4 * hh;
    f32x16 s = fzero();
#pragma unroll
    for (int ks = 0; ks < 4; ++ks) s = MFMA(*(const bf16x8*)(kt + ks * 16), qf[ks], s);
    float tmax = -INFINITY;
#pragma unroll
    for (int i = 0; i < 16; ++i) {
      const int dj = ipos - (k0 + crow(i, hh));
      const bool ok = !local || (dj <= 128 && dj >= -128);
      s[i] = ok ? s[i] : -INFINITY;
      tmax = fmaxf(tmax, s[i]);
    }
    tmax = fmaxf(tmax, __shfl_xor(tmax, 32));
    const float mn = fmaxf(m, tmax), corr = __expf(m - mn);
    m = mn; l *= corr;
#pragma unroll
    for (int i = 0; i < 16; ++i) { o0[i] *= corr; o1[i] *= corr; }
#pragma unroll
    for (int i = 0; i < 16; ++i) { s[i] = __expf(s[i] - mn); l += s[i]; }
    const bf16x8 pf0 = pack8(s[0], s[1], s[2], s[3], s[4], s[5], s[6], s[7]);
    const bf16x8 pf1 = pack8(s[8], s[9], s[10], s[11], s[12], s[13], s[14], s[15]);
    o0 = MFMA(ldfrag2(vt, vt + 8), pf0, o0);
    o1 = MFMA(ldfrag2(vt + 32 * 40, vt + 32 * 40 + 8), pf0, o1);
    o0 = MFMA(ldfrag2(vt + 16, vt + 24), pf1, o0);
    o1 = MFMA(ldfrag2(vt + 32 * 40 + 16, vt + 32 * 40 + 24), pf1, o1);
    if (tile + 1 < ntile) { *(uint4*)(sKt + (cur ^ 1) * 32 * 72 + skoff) = gk; *(uint4*)(sVt + (cur ^ 1) * 64 * 40 + svoff) = gv; }
    __syncthreads();
  }
#undef ATT_LOAD
  l += __shfl_xor(l, 32);
  const float inv = 1.f / l;
  bf16_t* dst = MIX + qrow * 1024 + 512 + hq * 64;
#pragma unroll
  for (int q4 = 0; q4 < 4; ++q4) {
    const int d = 8 * q4 + 4 * hh;
    uint2 u;
    u.x = pack2(o0[4 * q4] * inv, o0[4 * q4 + 1] * inv); u.y = pack2(o0[4 * q4 + 2] * inv, o0[4 * q4 + 3] * inv);
    *(uint2*)(dst + d) = u;
    u.x = pack2(o1[4 * q4] * inv, o1[4 * q4 + 1] * inv); u.y = pack2(o1[4 * q4 + 2] * inv, o1[4 * q4 + 3] * inv);
    *(uint2*)(dst + 32 + d) = u;
  }
}

DI void mlstm_local_item(const Params& p, int item, char* smem) {
  float* gs = (float*)smem;
  float* wv = gs + 512;
  float* msc = wv + 256;
  int t_ = tid();
  asm volatile("" : "+v"(t_));
  const int t = t_, lane = t & 63, w = t >> 6, wm = w >> 1, wn = w & 1, r = lane & 31, hh = lane >> 5;
  const int bh = item / NSTEP, nc = item % NSTEP, b = bh >> 2, h = bh & 3;
  const int sc = nc < 2 ? 128 + b * 2 + nc : b * 64 + (nc - 2);
  const int row0 = sc * 128;
  const float* GL = (const float*)(p.ws + O_GL);
  const bf16_t* KT = (const bf16_t*)(p.ws + O_KT) + (size_t)(sc * 4 + h) * 16384;
  const bf16_t* VT = (const bf16_t*)(p.ws + O_VT) + (size_t)(sc * 4 + h) * 16384;
  char* sK = smem + 8192;
  char* sV = sK + 32768;
#pragma unroll
  for (int i = 0; i < 8; ++i) {
    const int q = t + 256 * i, row = q >> 4, cc = q & 15;
    const int so = row * 256 + ((cc ^ (row & 15)) << 4);
    *(uint4*)(sK + so) = *(const uint4*)(KT + row * 128 + cc * 8);
    *(uint4*)(sV + so) = *(const uint4*)(VT + row * 128 + cc * 8);
  }
  for (int i = t; i < 512; i += 256) { const int ty = i >> 7, s = i & 127; gs[i] = GL[(size_t)(row0 + s) * 16 + ty * 4 + h]; }
  __syncthreads();
  {
    const int dir = t >> 7, s = t & 127;
    float wval, tot = 0.f;
    if (dir == 0) {
      float bsum = 0.f;
      for (int j = 0; j < 128; ++j) { const float f = gs[128 + j]; tot += f; if (j <= s) bsum += f; }
      wval = tot - bsum + gs[s];
    } else {
      float pre = 0.f;
      for (int j = 0; j < 128; ++j) { const float f = gs[384 + j]; tot += f; if (j < s) pre += f; }
      wval = pre + gs[256 + s];
    }
    wv[dir * 128 + s] = wval;
    if (s == 0) msc[dir] = tot;
  }
  __syncthreads();
  {
    const int dir = t >> 7, s = t & 127;
    float mx = -INFINITY;
    for (int j = 0; j < 128; ++j) mx = fmaxf(mx, wv[dir * 128 + j]);
    const float wval = wv[dir * 128 + s];
    __syncthreads();
    wv[dir * 128 + s] = expf(wval - mx);
    if (s == 0) msc[2 + dir] = mx;
  }
  __syncthreads();
  bf16_t* DC = (bf16_t*)(p.ws + O_DC);
#pragma unroll 1
  for (int d = 0; d < 2; ++d) {
    f32x16 acc[2][2];
#pragma unroll
    for (int i = 0; i < 2; ++i)
#pragma unroll
      for (int j = 0; j < 2; ++j) acc[i][j] = fzero();
#pragma unroll 2
    for (int ks = 0; ks < 8; ++ks) {
      const int xo = ((ks * 2 + hh) ^ (r & 15)) << 4;
      const bf16x8 ra0 = *(const bf16x8*)(sV + (wm * 64 + r) * 256 + xo);
      const bf16x8 ra1 = *(const bf16x8*)(sV + (wm * 64 + 32 + r) * 256 + xo);
      const bf16x8 b0 = *(const bf16x8*)(sK + (wn * 64 + r) * 256 + xo);
      const bf16x8 b1 = *(const bf16x8*)(sK + (wn * 64 + 32 + r) * 256 + xo);
      const float* ww = wv + d * 128 + ks * 16 + hh * 8;
      const bf16x8 a0 = pack8(bf2f((bf16_t)ra0[0]) * ww[0], bf2f((bf16_t)ra0[1]) * ww[1], bf2f((bf16_t)ra0[2]) * ww[2], bf2f((bf16_t)ra0[3]) * ww[3],
                              bf2f((bf16_t)ra0[4]) * ww[4], bf2f((bf16_t)ra0[5]) * ww[5], bf2f((bf16_t)ra0[6]) * ww[6], bf2f((bf16_t)ra0[7]) * ww[7]);
      const bf16x8 a1 = pack8(bf2f((bf16_t)ra1[0]) * ww[0], bf2f((bf16_t)ra1[1]) * ww[1], bf2f((bf16_t)ra1[2]) * ww[2], bf2f((bf16_t)ra1[3]) * ww[3],
                              bf2f((bf16_t)ra1[4]) * ww[4], bf2f((bf16_t)ra1[5]) * ww[5], bf2f((bf16_t)ra1[6]) * ww[6], bf2f((bf16_t)ra1[7]) * ww[7]);
      acc[0][0] = MFMA(a0, b0, acc[0][0]);
      acc[0][1] = MFMA(a0, b1, acc[0][1]);
      acc[1][0] = MFMA(a1, b0, acc[1][0]);
      acc[1][1] = MFMA(a1, b1, acc[1][1]);
    }
    bf16_t* dst = DC + ((size_t)(bh * 2 + d) * NSTEP + nc) * 16384;
#pragma unroll
    for (int mi = 0; mi < 2; ++mi)
#pragma unroll
      for (int ni = 0; ni < 2; ++ni)
#pragma unroll
        for (int i = 0; i < 16; ++i)
          dst[(wm * 64 + mi * 32 + crow(i, hh)) * 128 + wn * 64 + ni * 32 + r] = f2bf(acc[mi][ni][i]);
  }
  {
    const int dir = t >> 7, k = t & 127;
    float s = 0.f;
    for (int s8 = 0; s8 < 16; ++s8) {
      const bf16x8 v = *(const bf16x8*)(sK + k * 256 + ((s8 ^ (k & 15)) << 4));
#pragma unroll
      for (int e = 0; e < 8; ++e) s += wv[dir * 128 + s8 * 8 + e] * bf2f((bf16_t)v[e]);
    }
    ((float*)(p.ws + O_DN))[((size_t)(bh * 2 + dir) * NSTEP + nc) * 128 + k] = s;
    if (k == 0) {
      ((float*)(p.ws + O_GSC))[(bh * 2 + dir) * NSTEP + nc] = msc[dir];
      ((float*)(p.ws + O_MLOC))[(bh * 2 + dir) * NSTEP + nc] = msc[2 + dir];
    }
  }
  __syncthreads();
}

DI int chain_nc(int dir, int i) { return dir == 0 ? i : (i < 2 ? 1 - i : 67 - i); }
template <int DIR>
DI void scan_chain_elems(const bf16_t* __restrict__ DCc, bf16_t* __restrict__ CSTc, const float* fa, const float* fb, int e, int epos) {
  float C = 0.f;
#pragma unroll
  for (int blk = 0; blk < 3; ++blk) {
    float v[22];
#pragma unroll
    for (int j = 0; j < 22; ++j) {
      const int i = blk * 22 + j;
      const int nc = DIR == 0 ? i : (i < 2 ? 1 - i : 67 - i);
      v[j] = bf2f(DCc[(size_t)nc * 16384 + e]);
    }
#pragma unroll
    for (int j = 0; j < 22; ++j) {
      const int i = blk * 22 + j;
      const int nc = DIR == 0 ? i : (i < 2 ? 1 - i : 67 - i);
      if (i >= 2) CSTc[(size_t)(nc - 2) * 16384 + epos] = f2bf(C);
      C = fa[i] * C + fb[i] * v[j];
    }
  }
}
DI void phase_scan(const Params& p, char* smem) {
  float* fa = (float*)smem;
  float* fb = fa + 66;
  const float* GSC = (const float*)(p.ws + O_GSC); const float* MLOC = (const float*)(p.ws + O_MLOC);
  const bf16_t* DC = (const bf16_t*)(p.ws + O_DC); const float* DN = (const float*)(p.ws + O_DN);
  bf16_t* CST = (bf16_t*)(p.ws + O_CST); float* NST = (float*)(p.ws + O_NST); float* MST = (float*)(p.ws + O_MST);
  const int t = tid();
  for (int item = blockIdx.x; item < 16 * 64 + 16; item += gridDim.x) {
    const int chain = item < 1024 ? (item >> 6) : (item - 1024), dir = chain & 1;
    __syncthreads();
    if (t < NSTEP) { const int nc = chain_nc(dir, t); fa[t] = GSC[chain * NSTEP + nc]; fb[t] = MLOC[chain * NSTEP + nc]; }
    __syncthreads();
    if (t == 0) {
      float m = 0.f;
      for (int i = 0; i < NSTEP; ++i) {
        if (i >= 2 && item >= 1024) MST[chain * 64 + chain_nc(dir, i) - 2] = m;
        const float g = fa[i], ml = fb[i];
        const float mn = fmaxf(g + m, ml);
        fa[i] = __expf(g + m - mn); fb[i] = __expf(ml - mn);
        m = mn;
      }
    }
    __syncthreads();
    if (item < 1024) {
      const int e = (item & 63) * 256 + t;
      const int ev = e >> 7, ek = e & 127;
      const int epos = ((((ev >> 5) * 8 + (ek >> 4)) * 64) + ((ek >> 3) & 1) * 32 + (ev & 31)) * 8 + (ek & 7);
      const bf16_t* DCc = DC + (size_t)chain * NSTEP * 16384;
      bf16_t* CSTc = CST + (size_t)chain * 64 * 16384;
      if (dir == 0) scan_chain_elems<0>(DCc, CSTc, fa, fb, e, epos);
      else scan_chain_elems<1>(DCc, CSTc, fa, fb, e, epos);
    } else if (t < 128) {
      const int k = t;
      float n = 0.f;
      for (int i = 0; i < NSTEP; ++i) {
        const int nc = chain_nc(dir, i);
        if (i >= 2) NST[((size_t)chain * 64 + (nc - 2)) * 128 + k] = n;
        n = fa[i] * n + fb[i] * DN[((size_t)chain * NSTEP + nc) * 128 + k];
      }
    }
  }
}

DI void mlstm_out_item(const Params& p, int item, char* smem) {
  float* gs = (float*)smem;
  float* bb = gs + 512;
  float* lib = bb + 256;
  float* mrow = lib + 256;
  float* aT = mrow + 256;
  float* nq = aT + 256;
  float* nst = nq + 256;
  char* sK = smem + 8192;
  char* sV = sK + 32768;
  int t_ = tid();
  asm volatile("" : "+v"(t_));
  const int t = t_, lane = t & 63, w = t >> 6, r = lane & 31, hh = lane >> 5;
  const int bh = item >> 6, c = item & 63, b = bh >> 2, h = bh & 3;
  const int sc = b * 64 + c, row0 = sc * 128;
  const float* GL = (const float*)(p.ws + O_GL);
  const bf16_t* Qc = (const bf16_t*)(p.ws + O_QC); const bf16_t* Kc = (const bf16_t*)(p.ws + O_KC);
  const bf16_t* VT = (const bf16_t*)(p.ws + O_VT) + (size_t)(sc * 4 + h) * 16384;
  const bf16_t* P = (const bf16_t*)(p.ws + O_P);
  const float* MST = (const float*)(p.ws + O_MST);
  bf16_t* MIX = (bf16_t*)(p.ws + O_HA);
#pragma unroll
  for (int i = 0; i < 8; ++i) {
    const int q = t + 256 * i, row = q >> 4, cc = q & 15;
    const int so = row * 256 + ((cc ^ (row & 15)) << 4);
    *(uint4*)(sK + so) = *(const uint4*)(Kc + (size_t)(row0 + row) * 512 + h * 128 + cc * 8);
    *(uint4*)(sV + so) = *(const uint4*)(VT + row * 128 + cc * 8);
  }
  for (int i = t; i < 512; i += 256) { const int ty = i >> 7, s = i & 127; gs[i] = GL[(size_t)(row0 + s) * 16 + ty * 4 + h]; }
  {
    const int dir = t >> 7, k = t & 127;
    nst[t] = ((const float*)(p.ws + O_NST))[((size_t)(bh * 2 + dir) * 64 + c) * 128 + k];
  }
  __syncthreads();
  {
    const int dir = t >> 7, s = t & 127;
    float bsum = 0.f;
    if (dir == 0) { for (int j = 0; j <= s; ++j) bsum += gs[128 + j]; }
    else { for (int j = s; j < 128; ++j) bsum += gs[384 + j]; }
    bb[t] = bsum;
    lib[t] = gs[dir * 256 + s] - bsum;
    const bf16_t* qr = Qc + (size_t)(row0 + s) * 512 + h * 128;
    float acc = 0.f;
    for (int k8 = 0; k8 < 16; ++k8) {
      const bf16x8 v = ldfrag(qr + k8 * 8);
#pragma unroll
      for (int e = 0; e < 8; ++e) acc += nst[dir * 128 + k8 * 8 + e] * bf2f((bf16_t)v[e]);
    }
    nq[t] = acc;
  }
  __syncthreads();
  {
    const int dir = t >> 7, s = t & 127;
    float pm = -INFINITY;
    if (dir == 0) { for (int j = 0; j <= s; ++j) pm = fmaxf(pm, lib[j]); }
    else { for (int j = s; j < 128; ++j) pm = fmaxf(pm, lib[128 + j]); }
    const float m_in = MST[(bh * 2 + dir) * 64 + c];
    const float mr = bb[t] + fmaxf(m_in, pm);
    mrow[t] = mr;
    aT[t] = expf(bb[t] + m_in - mr);
  }
  __syncthreads();
  const int tl = w * 32 + r;
  const bf16_t* qrow = Qc + (size_t)(row0 + tl) * 512 + h * 128 + hh * 8;
  bf16x8 qf[8];
#pragma unroll
  for (int ks = 0; ks < 8; ++ks) qf[ks] = ldfrag(qrow + ks * 16);
  const int swz = r & 15;
  const char* kp[8]; const char* vp[16];
#pragma unroll
  for (int ks = 0; ks < 8; ++ks) kp[ks] = sK + r * 256 + (((ks * 2 + hh) ^ swz) << 4);
#pragma unroll
  for (int cc = 0; cc < 16; ++cc) vp[cc] = sV + r * 256 + 8 * hh + ((cc ^ swz) << 4);
  float* Hb = (float*)(p.ws + O_DC) + (size_t)item * 16384 + tl;
  float* Hbh = Hb + 4 * hh * 128;
  f32x16 outa[4];
#define MLSTM_DIR(DIR)                                                                                                   \
  {                                                                                                                      \
    const bf16_t* CSTl = (const bf16_t*)(p.ws + O_CST) + ((size_t)(bh * 2 + DIR) * 64 + c) * 16384 + lane * 8;           \
    const float bbt = bb[DIR * 128 + tl], mrt = mrow[DIR * 128 + tl], at = aT[DIR * 128 + tl];                            \
    float dsum = 0.f;                                                                                                    \
    const float* libp = lib + DIR * 128 + 4 * hh;                                                                        \
    const int tb = tl - 4 * hh;                                                                                          \
    bf16x8 pf[8];                                                                                                        \
    _Pragma("unroll") for (int half = 0; half < 2; ++half) {                                                             \
      f32x16 st[2];                                                                                                      \
      st[0] = fzero(); st[1] = fzero();                                                                                  \
      _Pragma("unroll") for (int ks = 0; ks < 8; ++ks) {                                                                 \
        _Pragma("unroll") for (int r2 = 0; r2 < 2; ++r2)                                                                 \
          st[r2] = MFMA(*(const bf16x8*)(kp[ks] + (half * 2 + r2) * 8192), qf[ks], st[r2]);                              \
      }                                                                                                                  \
      _Pragma("unroll") for (int r2 = 0; r2 < 2; ++r2) {                                                                 \
        const int rb = half * 2 + r2;                                                                                    \
        _Pragma("unroll") for (int i = 0; i < 16; ++i) {                                                                 \
          const int sc_ = rb * 32 + (i & 3) + 8 * (i >> 2);                                           \
          const int diff = DIR == 0 ? (tb - sc_) : (sc_ - tb);                                                           \
          const float msk = (float)((unsigned)(~diff) >> 31);                                                            \
          const float v = st[r2][i] * __expf(fminf(bbt + libp[sc_] - mrt, 0.f)) * msk;                                    \
          st[r2][i] = v; dsum += v;                                                                                      \
        }                                                                                                                \
        pf[rb * 2] = pack8(st[r2][0], st[r2][1], st[r2][2], st[r2][3], st[r2][4], st[r2][5], st[r2][6], st[r2][7]);      \
        pf[rb * 2 + 1] = pack8(st[r2][8], st[r2][9], st[r2][10], st[r2][11], st[r2][12], st[r2][13], st[r2][14], st[r2][15]); \
      }                                                                                                                  \
      __builtin_amdgcn_sched_barrier(0);                                                                                 \
    }                                                                                                                    \
    dsum += __shfl_xor(dsum, 32);                                                                                        \
    const float den = dsum + at * nq[DIR * 128 + tl];                                                                    \
    const float dinv = 1.f / fmaxf(fabsf(den), expf(-mrt));                                                              \
    _Pragma("unroll") for (int half = 0; half < 2; ++half) {                                                             \
      f32x16 ha[2];                                                                                                      \
      ha[0] = fzero(); ha[1] = fzero();                                                                                  \
      _Pragma("unroll") for (int ks = 0; ks < 8; ++ks) {                                                                 \
        _Pragma("unroll") for (int r2 = 0; r2 < 2; ++r2)                                                                 \
          ha[r2] = MFMA(ldfrag(CSTl + ((half * 2 + r2) * 8 + ks) * 512), qf[ks], ha[r2]);                                \
        if (ks == 3) __builtin_amdgcn_sched_barrier(0);                                                                  \
      }                                                                                                                  \
      _Pragma("unroll") for (int r2 = 0; r2 < 2; ++r2)                                                                   \
        _Pragma("unroll") for (int i = 0; i < 16; ++i) ha[r2][i] *= at;                                                  \
      __builtin_amdgcn_sched_barrier(0);                                                                                 \
      _Pragma("unroll") for (int kk = 0; kk < 8; ++kk) {                                                                 \
        _Pragma("unroll") for (int r2 = 0; r2 < 2; ++r2) {                                                               \
          const s16x4 lo = *(const s16x4*)(vp[2 * kk] + (half * 2 + r2) * 8192);                                         \
          const s16x4 hi = *(const s16x4*)(vp[2 * kk + 1] + (half * 2 + r2) * 8192);                                     \
          ha[r2] = MFMA(__builtin_shufflevector(lo, hi, 0, 1, 2, 3, 4, 5, 6, 7), pf[kk], ha[r2]);                        \
        }                                                                                                                \
      }                                                                                                                  \
      _Pragma("unroll") for (int r2 = 0; r2 < 2; ++r2)                                                                   \
        _Pragma("unroll") for (int i = 0; i < 16; ++i) {                                                                 \
          float* hp = Hbh + ((half * 2 + r2) * 32 + (i & 3) + 8 * (i >> 2)) * 128;                                       \
          if (DIR == 0) *hp = ha[r2][i] * dinv;                                                                          \
          else outa[half * 2 + r2][i] = *hp + ha[r2][i] * dinv;                                                          \
        }                                                                                                                \
      __builtin_amdgcn_sched_barrier(0);                                                                                 \
    }                                                                                                                    \
  }
  MLSTM_DIR(0)
  MLSTM_DIR(1)
#undef MLSTM_DIR
  float ss = 0.f;
#pragma unroll
  for (int rb = 0; rb < 4; ++rb)
#pragma unroll
    for (int i = 0; i < 16; ++i) ss += outa[rb][i] * outa[rb][i];
  ss += __shfl_xor(ss, 32);
  const float rn = rsqrtf(ss * (1.f / 128.f) + EPS);
  const size_t row = (size_t)row0 + tl;
#pragma unroll
  for (int rb = 0; rb < 4; ++rb)
#pragma unroll
    for (int q4 = 0; q4 < 4; ++q4) {
      const int v = rb * 32 + 8 * q4 + 4 * hh;
      const s16x4 ov = *(const s16x4*)(P + row * PLD + 1536 + h * 128 + v);
      const float4 hg = *(const float4*)(p.ab_head_g + h * 128 + v);
      const float y0 = outa[rb][4 * q4] * rn * hg.x * sigmf(bf2f((bf16_t)ov[0]));
      const float y1 = outa[rb][4 * q4 + 1] * rn * hg.y * sigmf(bf2f((bf16_t)ov[1]));
      const float y2 = outa[rb][4 * q4 + 2] * rn * hg.z * sigmf(bf2f((bf16_t)ov[2]));
      const float y3 = outa[rb][4 * q4 + 3] * rn * hg.w * sigmf(bf2f((bf16_t)ov[3]));
      uint2 u; u.x = pack2(y0, y1); u.y = pack2(y2, y3);
      *(uint2*)(MIX + row * 1024 + h * 128 + v) = u;
    }
  __syncthreads();
}

DI void phase_topk(const Params& p, char* smem) {
  unsigned* vals = (unsigned*)smem;
  unsigned* hist = vals + 8448;
  unsigned* cntg = hist + 256;
  unsigned* cnte = cntg + 256;
  unsigned* misc = cnte + 256;
  const float* AFF = (const float*)(p.ws + O_AFF);
  int* IDX = (int*)(p.ws + O_IDX); float* GATE = (float*)(p.ws + O_GATE); int* INV = (int*)(p.ws + O_INV);
  const int t = tid();
  for (int item = blockIdx.x; item < 32; item += gridDim.x) {
    const float* a = AFF + (size_t)item * 8192;
    for (int i = t; i < 8192; i += 256) vals[i + (i >> 5)] = __float_as_uint(a[i]);
    unsigned prefix = 0, remaining = 1024;
    for (int pass = 0; pass < 4; ++pass) {
      const int shift = 24 - 8 * pass;
      hist[t] = 0;
      __syncthreads();
      const unsigned mask = pass == 0 ? 0u : (0xFFFFFFFFu << (shift + 8));
      for (int i = t; i < 8192; i += 256) {
        const unsigned u = vals[i + (i >> 5)];
        if ((u & mask) == (prefix & mask)) atomicAdd(&hist[(u >> shift) & 255], 1u);
      }
      __syncthreads();
      {
        unsigned above = 0;
        for (int bin = t + 1; bin < 256; ++bin) above += hist[bin];
        const unsigned mineh = hist[t];
        if (above < remaining && above + mineh >= remaining) {
          misc[0] = prefix | ((unsigned)t << shift);
          misc[1] = remaining - above;
        }
      }
      __syncthreads();
      prefix = misc[0]; remaining = misc[1];
      __syncthreads();
    }
    const unsigned T = prefix, need_eq = remaining;
    unsigned cg_ = 0, ce = 0;
    for (int j = 0; j < 32; ++j) {
      const int n = t * 32 + j;
      const unsigned u = vals[n + (n >> 5)];
      cg_ += u > T; ce += u == T;
    }
    cntg[t] = cg_; cnte[t] = ce;
    __syncthreads();
    unsigned pg = 0, pe = 0;
    for (int j = 0; j < t; ++j) { pg += cntg[j]; pe += cnte[j]; }
    for (int j = 0; j < 32; ++j) {
      const int n = t * 32 + j;
      const unsigned u = vals[n + (n >> 5)];
      if (u > T) { IDX[item * 1024 + pg] = n; GATE[item * 1024 + pg] = __uint_as_float(u); INV[((size_t)(item >> 4) * 8192 + n) * 16 + (item & 15)] = (int)pg + 1; ++pg; }
      else if (u == T) {
        if (pe < need_eq) { const unsigned slot = 1024 - need_eq + pe; IDX[item * 1024 + slot] = n; GATE[item * 1024 + slot] = __uint_as_float(u); INV[((size_t)(item >> 4) * 8192 + n) * 16 + (item & 15)] = (int)slot + 1; }
        ++pe;
      }
    }
    __syncthreads();
  }
}

DI void phase_stats(const Params& p, char* smem) {
  float* red = (float*)smem;
  const bf16_t* GVT = (const bf16_t*)(p.ws + O_GVT);
  float* PART = (float*)(p.ws + O_STATS);
  const int t = tid(), qq = t & 31, cg_ = t >> 5;
  for (int item = blockIdx.x; item < 1024; item += gridDim.x) {
    const int chunk = item >> 3, cgrp = item & 7;
    const bf16_t* base = GVT + ((size_t)chunk * 2048 + cgrp * 256) * 128 + qq * 4;
    float s[4] = {0.f, 0.f, 0.f, 0.f}, s2[4] = {0.f, 0.f, 0.f, 0.f};
#pragma unroll 8
    for (int c = cg_; c < 256; c += 8) {
      const s16x4 v = *(const s16x4*)(base + (size_t)c * 128);
#pragma unroll
      for (int e = 0; e < 4; ++e) { const float f = bf2f((bf16_t)v[e]); s[e] += f; s2[e] += f * f; }
    }
#pragma unroll
    for (int e = 0; e < 4; ++e) { red[(cg_ * 128 + qq * 4 + e) * 2] = s[e]; red[(cg_ * 128 + qq * 4 + e) * 2 + 1] = s2[e]; }
    __syncthreads();
    if (t < 128) {
      float a = 0.f, b2 = 0.f;
      for (int g = 0; g < 8; ++g) { a += red[(g * 128 + t) * 2]; b2 += red[(g * 128 + t) * 2 + 1]; }
      PART[((size_t)item * 128 + t) * 2] = a;
      PART[((size_t)item * 128 + t) * 2 + 1] = b2;
    }
    __syncthreads();
  }
}
DI void phase_spatial(const Params& p, char* smem) {
  float* smu = (float*)smem;
  float* srs = smu + 128;
  const bf16_t* GVT = (const bf16_t*)(p.ws + O_GVT); const bf16_t* U = (const bf16_t*)(p.ws + O_U);
  const float* PART = (const float*)(p.ws + O_STATS);
  bf16_t* UV = (bf16_t*)(p.ws + O_UV);
  char* sW = smem + 1024;
  int g_staged = -1;
  for (int item = blockIdx.x; item < 1024; item += gridDim.x) {
    int t_ = tid();
    const int t = t_, lane = t & 63, w = t >> 6, r = lane & 31, hh = lane >> 5;
    const int chunk = item >> 3, g = item & 7;
    if (t < 128) {
      float a = 0.f, b2 = 0.f;
#pragma unroll
      for (int j = 0; j < 8; ++j) { a += PART[((size_t)(chunk * 8 + j) * 128 + t) * 2]; b2 += PART[((size_t)(chunk * 8 + j) * 128 + t) * 2 + 1]; }
      const float mu = a * (1.f / 2048.f);
      const float var = fmaxf(b2 * (1.f / 2048.f) - mu * mu, 0.f);
      smu[t] = mu; srs[t] = rsqrtf(var + EPS);
    }
    if (g != g_staged) {
      const float* Wg = p.gm_w_s + (size_t)g * 16384;
#pragma unroll
      for (int i = 0; i < 8; ++i) {
        const int q = t + 256 * i, row = q >> 4, cc = q & 15;
        const float4 w0 = *(const float4*)(Wg + row * 128 + cc * 8), w1 = *(const float4*)(Wg + row * 128 + cc * 8 + 4);
        uint4 o; o.x = pack2(w0.x, w0.y); o.y = pack2(w0.z, w0.w); o.z = pack2(w1.x, w1.y); o.w = pack2(w1.z, w1.w);
        *(uint4*)(sW + row * 256 + ((cc ^ (row & 15)) << 4)) = o;
      }
      g_staged = g;
    }
    __syncthreads();
    f32x16 acc[2][4];
#pragma unroll
    for (int i = 0; i < 4; ++i) { acc[0][i] = fzero(); acc[1][i] = fzero(); }
    const int cA = g * 256 + w * 64 + r, cB = cA + 32;
    const float lgA = p.gm_ln_g[cA], lbA = p.gm_ln_b[cA], lgB = p.gm_ln_g[cB], lbB = p.gm_ln_b[cB];
    const bf16_t* vA = GVT + ((size_t)chunk * 2048 + cA) * 128 + hh * 8;
    const bf16_t* vB = GVT + ((size_t)chunk * 2048 + cB) * 128 + hh * 8;
    for (int ks = 0; ks < 8; ++ks) {
      const bf16x8 ra = ldfrag(vA + ks * 16), rbv = ldfrag(vB + ks * 16);
      const float* mu = smu + ks * 16 + hh * 8; const float* rs = srs + ks * 16 + hh * 8;
      const bf16x8 aA = pack8((bf2f((bf16_t)ra[0]) - mu[0]) * rs[0] * lgA + lbA, (bf2f((bf16_t)ra[1]) - mu[1]) * rs[1] * lgA + lbA,
                              (bf2f((bf16_t)ra[2]) - mu[2]) * rs[2] * lgA + lbA, (bf2f((bf16_t)ra[3]) - mu[3]) * rs[3] * lgA + lbA,
                              (bf2f((bf16_t)ra[4]) - mu[4]) * rs[4] * lgA + lbA, (bf2f((bf16_t)ra[5]) - mu[5]) * rs[5] * lgA + lbA,
                              (bf2f((bf16_t)ra[6]) - mu[6]) * rs[6] * lgA + lbA, (bf2f((bf16_t)ra[7]) - mu[7]) * rs[7] * lgA + lbA);
      const bf16x8 aB = pack8((bf2f((bf16_t)rbv[0]) - mu[0]) * rs[0] * lgB + lbB, (bf2f((bf16_t)rbv[1]) - mu[1]) * rs[1] * lgB + lbB,
                              (bf2f((bf16_t)rbv[2]) - mu[2]) * rs[2] * lgB + lbB, (bf2f((bf16_t)rbv[3]) - mu[3]) * rs[3] * lgB + lbB,
                              (bf2f((bf16_t)rbv[4]) - mu[4]) * rs[4] * lgB + lbB, (bf2f((bf16_t)rbv[5]) - mu[5]) * rs[5] * lgB + lbB,
                              (bf2f((bf16_t)rbv[6]) - mu[6]) * rs[6] * lgB + lbB, (bf2f((bf16_t)rbv[7]) - mu[7]) * rs[7] * lgB + lbB);
#pragma unroll
      for (int pb = 0; pb < 4; ++pb) {
        const bf16x8 bw = *(const bf16x8*)(sW + (pb * 32 + r) * 256 + (((ks * 2 + hh) ^ (r & 15)) << 4));
        acc[0][pb] = MFMA(aA, bw, acc[0][pb]);
        acc[1][pb] = MFMA(aB, bw, acc[1][pb]);
      }
    }
#pragma unroll
    for (int pb = 0; pb < 4; ++pb) {
      const int pp = pb * 32 + r;
      const float bs = p.gm_b_s[g * 128 + pp];
      const size_t rowo = ((size_t)chunk * 128 + pp) * 2048 + g * 256 + w * 64 + 4 * hh;
#pragma unroll
      for (int cb = 0; cb < 2; ++cb)
#pragma unroll
        for (int q4 = 0; q4 < 4; ++q4) {
          const size_t o = rowo + cb * 32 + 8 * q4;
          const s16x4 uu = *(const s16x4*)(U + o);
          uint2 st;
          st.x = pack2(bf2f((bf16_t)uu[0]) * (acc[cb][pb][4 * q4] + bs), bf2f((bf16_t)uu[1]) * (acc[cb][pb][4 * q4 + 1] + bs));
          st.y = pack2(bf2f((bf16_t)uu[2]) * (acc[cb][pb][4 * q4 + 2] + bs), bf2f((bf16_t)uu[3]) * (acc[cb][pb][4 * q4 + 3] + bs));
          *(uint2*)(UV + o) = st;
        }
    }
    __syncthreads();
  }
}

struct EpiBf16 {
  bf16_t* dst; int ld;
  DI void operator()(f32x16 (&acc)[4][2], int mb, int nb, int r, int hh) const {
#pragma unroll
    for (int mi = 0; mi < 4; ++mi)
#pragma unroll
      for (int ni = 0; ni < 2; ++ni)
#pragma unroll
        for (int i = 0; i < 16; ++i)
          dst[(size_t)(mb + mi * 32 + crow(i, hh)) * ld + nb + ni * 32 + r] = f2bf(acc[mi][ni][i]);
  }
};
struct EpiRes {
  float* out; const float* base; const float* gate;
  DI void operator()(f32x16 (&acc)[4][2], int mb, int nb, int r, int hh) const {
#pragma unroll
    for (int ni = 0; ni < 2; ++ni) {
      const int n = nb + ni * 32 + r;
      const float gt = gate[n];
#pragma unroll
      for (int mi = 0; mi < 4; ++mi) {
        const unsigned o0 = (unsigned)(mb + mi * 32 + 4 * hh) * 1024u + (unsigned)n;
#pragma unroll
        for (int q4 = 0; q4 < 4; ++q4) {
          const float b0 = base[o0 + (8 * q4 + 0) * 1024], b1 = base[o0 + (8 * q4 + 1) * 1024], b2 = base[o0 + (8 * q4 + 2) * 1024], b3 = base[o0 + (8 * q4 + 3) * 1024];
          out[o0 + (8 * q4 + 0) * 1024] = b0 + gt * acc[mi][ni][4 * q4];
          out[o0 + (8 * q4 + 1) * 1024] = b1 + gt * acc[mi][ni][4 * q4 + 1];
          out[o0 + (8 * q4 + 2) * 1024] = b2 + gt * acc[mi][ni][4 * q4 + 2];
          out[o0 + (8 * q4 + 3) * 1024] = b3 + gt * acc[mi][ni][4 * q4 + 3];
          __builtin_amdgcn_sched_barrier(0);
        }
      }
    }
  }
};
struct EpiGelu {
  bf16_t* U; bf16_t* GVT; int m0, n0;
  DI void operator()(f32x16 (&acc)[4][2], int mb, int nb, int r, int hh) const {
    if (n0 < 2048) {
#pragma unroll
      for (int mi = 0; mi < 4; ++mi)
#pragma unroll
        for (int ni = 0; ni < 2; ++ni)
#pragma unroll
          for (int i = 0; i < 16; ++i)
            U[(size_t)(m0 + mb + mi * 32 + crow(i, hh)) * 2048 + n0 + nb + ni * 32 + r] = f2bf(geluf(acc[mi][ni][i]));
    } else {
#pragma unroll
      for (int mi = 0; mi < 4; ++mi) {
        const int mrow = m0 + mb + mi * 32;
        const int chunk = mrow >> 7, q0 = mrow & 127;
#pragma unroll
        for (int ni = 0; ni < 2; ++ni) {
          const int cc = n0 - 2048 + nb + ni * 32 + r;
          bf16_t* d = GVT + ((size_t)chunk * 2048 + cc) * 128 + q0 + 4 * hh;
#pragma unroll
          for (int q4 = 0; q4 < 4; ++q4) {
            uint2 u;
            u.x = pack2(geluf(acc[mi][ni][4 * q4]), geluf(acc[mi][ni][4 * q4 + 1]));
            u.y = pack2(geluf(acc[mi][ni][4 * q4 + 2]), geluf(acc[mi][ni][4 * q4 + 3]));
            *(uint2*)(d + 8 * q4) = u;
          }
        }
      }
    }
  }
};
struct EpiSwiglu {
  bf16_t* hid;
  DI void operator()(f32x16 (&acc)[4][2], int mb, int nb, int r, int hh) const {
    const int f = (nb >> 1) + r;
#pragma unroll
    for (int mi = 0; mi < 4; ++mi)
#pragma unroll
      for (int i = 0; i < 16; ++i) {
        const float gv = acc[mi][0][i], uv = acc[mi][1][i];
        hid[(size_t)(mb + mi * 32 + crow(i, hh)) * 1024 + f] = f2bf(siluf(gv) * uv);
      }
  }
};
DI void phase_moe1(const Params& p, char* smem) {
  const bf16_t* HA = (const bf16_t*)(p.ws + O_HA); const bf16_t* WGU = (const bf16_t*)(p.ws + O_MGU);
  const int* IDX = (const int*)(p.ws + O_IDX); bf16_t* HID = (bf16_t*)(p.ws + O_HID);
  const int t = tid(), lrow = t >> 3, lcol = (t & 7) * 8;
  for (TileWalk tw(128 * 16, smem); tw.valid(); tw.next()) {
    int mg, nt; tw.get(8, 8, 2, mg, nt);
    const int e = mg >> 3, b = (mg >> 2) & 1, mt = mg & 3, be = b * 16 + e;
    unsigned aoff[8];
#pragma unroll
    for (int i = 0; i < 8; ++i) aoff[i] = (unsigned)IDX[be * 1024 + mt * 256 + lrow + 32 * i] * 1024u + (unsigned)lcol;
    gemm_tile<false>(HA + (size_t)b * 8192 * 1024, aoff, WGU + ((size_t)e * 2048 + nt * 128) * 1024, (unsigned)lrow * 1024u + (unsigned)lcol, 1024, smem,
              EpiSwiglu{HID + ((size_t)be * 1024 + mt * 256) * 1024 + nt * 64});
  }
}
DI void phase_moe2(const Params& p, int layer, char* smem) {
  const bf16_t* HID = (const bf16_t*)(p.ws + O_HID); const bf16_t* WD = (const bf16_t*)(p.ws + O_MD);
  const int t = tid(), lrow = t >> 3, lcol = (t & 7) * 8;
  for (TileWalk tw(128 * 8, smem); tw.valid(); tw.next()) {
    int mg, nt; tw.get(8, 8, 1, mg, nt);
    const int e = mg >> 3, b = (mg >> 2) & 1, mt = mg & 3, be = b * 16 + e;
    unsigned aoff[8];
#pragma unroll
    for (int i = 0; i < 8; ++i) aoff[i] = (unsigned)(lrow + 32 * i) * 1024u + (unsigned)lcol;
    gemm_tile<true>(HID + ((size_t)be * 1024 + mt * 256) * 1024, aoff, WD + ((size_t)e * 1024 + nt * 128) * 1024, (unsigned)lrow * 1024u + (unsigned)lcol, 1024, smem,
              EpiBf16{(bf16_t*)(p.ws + O_YE) + ((size_t)be * 1024 + mt * 256) * 1024 + nt * 128, 1024});
  }
}

DI void phase_final(const Params& p) {
  const int t = tid(), lane = t & 63, w = t >> 6;
  for (int row = blockIdx.x * 4 + w; row < NTOK; row += gridDim.x * 4) {
    float* src = p.out + (size_t)row * 1024;
    float4 xv[4]; float ss = 0.f;
#pragma unroll
    for (int i = 0; i < 4; ++i) xv[i] = *(const float4*)(src + (i * 64 + lane) * 4);
    {
      float4 ca[4];
      moe_combine_row(p, row, lane, ca);
      const float* g2 = (const float*)(p.ws + O_MODV) + (1 * 3 + (row >> 13)) * 6144 + 5 * 1024;
#pragma unroll
      for (int i = 0; i < 4; ++i) {
        const float4 gg = *(const float4*)(g2 + (i * 64 + lane) * 4);
        xv[i].x += gg.x * ca[i].x; xv[i].y += gg.y * ca[i].y; xv[i].z += gg.z * ca[i].z; xv[i].w += gg.w * ca[i].w;
      }
    }
#pragma unroll
    for (int i = 0; i < 4; ++i) ss += xv[i].x * xv[i].x + xv[i].y * xv[i].y + xv[i].z * xv[i].z + xv[i].w * xv[i].w;
    ss = wsum(ss);
    const float rstd = rsqrtf(ss * (1.f / 1024.f) + EPS);
#pragma unroll
    for (int i = 0; i < 4; ++i) {
      const int col = (i * 64 + lane) * 4;
      const float4 g4 = *(const float4*)(p.final_norm_g + col);
      float4 y; y.x = xv[i].x * rstd * g4.x; y.y = xv[i].y * rstd * g4.y; y.z = xv[i].z * rstd * g4.z; y.w = xv[i].w * rstd * g4.w;
      *(float4*)(src + col) = y;
    }
  }
}

constexpr int NPHASE = 22;
DI void run_phase(const Params& p, int ph, char* smem) {
  const float* modv = (const float*)(p.ws + O_MODV);
  switch (ph) {
#if !defined(ONLY) || ONLY == 0
    case 0:
      phase_adaln(p, smem);
      __syncthreads();
      tconv(p.ab_w_in, 2832, 2832, 1024, 1, 0, (bf16_t*)(p.ws + O_WIN), 0, 1, smem);
      tconv(p.ab_w_out, 1024, 1024, 1024, 1, 0, (bf16_t*)(p.ws + O_WOUT), 0, 0, smem);
      tconv(p.gm_w_in, 4096, 4096, 1024, 1, 0, (bf16_t*)(p.ws + O_GMIN), 0, 0, smem);
      tconv(p.gm_w_out, 1024, 1024, 2048, 1, 0, (bf16_t*)(p.ws + O_GMOUT), 0, 0, smem);
      tconv_moe(p, 0, smem);
      break;
#endif
#if !defined(ONLY) || ONLY == 1
    case 1: phase_modulate<1, false>(p, 0, 0, smem); break;
#endif
#if !defined(ONLY) || ONLY == 2
    case 2:
      gemm_dense((const bf16_t*)(p.ws + O_HA), (const bf16_t*)(p.ws + O_WIN), NROW, PLD, 1024, 6, 11, smem,
                 [&](int m0, int n0) { return EpiBf16{(bf16_t*)(p.ws + O_P) + (size_t)m0 * PLD + n0, PLD}; });
      break;
#endif
#if !defined(ONLY) || ONLY == 3
    case 3: phase_prep2(p, smem); break;
#endif
#if !defined(ONLY) || ONLY == 4
    case 4:
      for (int item = blockIdx.x; item < 1024 + 8 * NSTEP; item += gridDim.x) {
        if (item < 1024) attn_item(p, item, smem); else mlstm_local_item(p, item - 1024, smem);
      }
      break;
#endif
#if !defined(ONLY) || ONLY == 5
    case 5: phase_scan(p, smem); break;
#endif
#if !defined(ONLY) || ONLY == 6
    case 6:
      for (int item = blockIdx.x; item < 512; item += gridDim.x) mlstm_out_item(p, item, smem);
      break;
#endif
#if !defined(ONLY) || ONLY == 7
    case 7:
      gemm_dense((const bf16_t*)(p.ws + O_HA), (const bf16_t*)(p.ws + O_WOUT), NTOK, 1024, 1024, 8, 8, smem,
                 [&](int m0, int n0) {
                   return EpiRes{p.out + (size_t)m0 * 1024 + n0, p.x + (size_t)m0 * 1024 + n0, modv + (0 * 3 + (m0 >> 13)) * 6144 + 2 * 1024 + n0};
                 });
      break;
#endif
#if !defined(ONLY) || ONLY == 8
    case 8: phase_modulate<2, false>(p, 0, 1, smem); break;
#endif
#if !defined(ONLY) || ONLY == 9
    case 9: phase_topk(p, smem); break;
#endif
#if !defined(ONLY) || ONLY == 10
    case 10: phase_moe1(p, smem); break;
#endif
#if !defined(ONLY) || ONLY == 11
    case 11: phase_moe2(p, 0, smem); break;
#endif
#if !defined(ONLY) || ONLY == 12
    case 12:
      phase_modulate<0, true>(p, 1, 0, smem);
      __syncthreads();
      tconv_moe(p, 1, smem);
      break;
#endif
#if !defined(ONLY) || ONLY == 13
    case 13:
      gemm_dense((const bf16_t*)(p.ws + O_HA), (const bf16_t*)(p.ws + O_GMIN), NTOK, 4096, 1024, 8, 8, smem,
                 [&](int m0, int n0) { return EpiGelu{(bf16_t*)(p.ws + O_U), (bf16_t*)(p.ws + O_GVT), m0, n0}; });
      break;
#endif
#if !defined(ONLY) || ONLY == 14
    case 14: phase_stats(p, smem); break;
#endif
#if !defined(ONLY) || ONLY == 15
    case 15: phase_spatial(p, smem); break;
#endif
#if !defined(ONLY) || ONLY == 16
    case 16:
      gemm_dense((const bf16_t*)(p.ws + O_UV), (const bf16_t*)(p.ws + O_GMOUT), NTOK, 1024, 2048, 8, 8, smem,
                 [&](int m0, int n0) {
                   return EpiRes{p.out + (size_t)m0 * 1024 + n0, p.out + (size_t)m0 * 1024 + n0, modv + (1 * 3 + (m0 >> 13)) * 6144 + 2 * 1024 + n0};
                 });
      break;
#endif
#if !defined(ONLY) || ONLY == 17
    case 17: phase_modulate<2, false>(p, 1, 1, smem); break;
#endif
#if !defined(ONLY) || ONLY == 18
    case 18: phase_topk(p, smem); break;
#endif
#if !defined(ONLY) || ONLY == 19
    case 19: phase_moe1(p, smem); break;
#endif
#if !defined(ONLY) || ONLY == 20
    case 20: phase_moe2(p, 1, smem); break;
#endif
#if !defined(ONLY) || ONLY == 21
    case 21: phase_final(p); break;
#endif
    default: break;
  }
}

#define XB_TMO      128
#define XB_XCNT(j)  (256  + 64 * (j))
#define XB_XSUB(j)  (1280 + 64 * (j))
#define XB_XGEN(j)  (2304 + 64 * (j))
#define XB_TOP      3328
#define XB_TOPGEN   3392
#define XCD_BAR_WORDS 3456
#define XB_SPIN_CAP (1u << 18)
#define LAS __attribute__((address_space(3)))
DI unsigned xb_ld(unsigned* p) { return __hip_atomic_load(p, __ATOMIC_RELAXED, __HIP_MEMORY_SCOPE_AGENT); }
DI unsigned xb_add(unsigned* p, unsigned v) { return __hip_atomic_fetch_add(p, v, __ATOMIC_RELAXED, __HIP_MEMORY_SCOPE_AGENT); }
DI unsigned xb_xcc_id() { return (unsigned)__builtin_amdgcn_s_getreg((3 << 11) | 20) & 0xFu; }
#define XB_SPIN(cond, bar) do { unsigned _sp = 0; while (cond) { __builtin_amdgcn_s_sleep(1); \
    if ((++_sp & 255u) == 0u) { if (xb_ld(&(bar)[XB_TMO])) break; if (_sp > XB_SPIN_CAP) { atomicAdd(&(bar)[XB_TMO], 1u); break; } } } } while (0)
struct XcdBarrier { unsigned* bar; unsigned x; volatile LAS unsigned* st; };
DI XcdBarrier xcd_barrier_post(unsigned* bar, volatile LAS unsigned* st) {
  XcdBarrier b; b.bar = bar; b.x = xb_xcc_id(); b.st = st;
  if (threadIdx.x == 0) st[3] = xb_add(&bar[XB_XCNT(b.x)], 1u);
  return b;
}
DI void xcd_barrier_complete(unsigned* bar, unsigned x, unsigned& nloc, unsigned& nx, unsigned& sbefore) {
  const unsigned G = gridDim.x * gridDim.y * gridDim.z;
  unsigned sum, cnt, mine, sp = 0u, sb = 0u;
  for (;;) {
    sum = 0u; cnt = 0u; mine = 0u; sb = 0u;
#pragma unroll
    for (unsigned j = 0; j < 16; ++j) { const unsigned c = xb_ld(&bar[XB_XCNT(j)]); sum += c; cnt += (c > 0u) ? 1u : 0u; mine = (j == x) ? c : mine; sb += (j < x) ? c : 0u; }
    if (sum == G) break;
    __builtin_amdgcn_s_sleep(1);
    if ((++sp & 255u) == 0u) { if (xb_ld(&bar[XB_TMO])) break; if (sp > XB_SPIN_CAP) { atomicAdd(&bar[XB_TMO], 1u); break; } }
  }
  nloc = mine > 0u ? mine : 1u; nx = cnt > 0u ? cnt : 1u; sbefore = sb;
}
DI void xcd_barrier(const XcdBarrier& b) {
  asm volatile("s_waitcnt vmcnt(0)" ::: "memory");
  __syncthreads();
  if (threadIdx.x == 0) {
    unsigned* bar = b.bar;
    __builtin_amdgcn_s_waitcnt(0);
    unsigned nloc = b.st[0], nx = b.st[1];
    if (nloc == 0u) { unsigned sbf; xcd_barrier_complete(bar, b.x, nloc, nx, sbf); b.st[0] = nloc; b.st[1] = nx; b.st[2] = sbf; }
    const unsigned old = xb_add(&bar[XB_XSUB(b.x)], 1u);
    const unsigned gen = old / nloc;
    if (old + 1u == (gen + 1u) * nloc) {
      __builtin_amdgcn_fence(__ATOMIC_RELEASE, "agent");
      asm volatile("s_waitcnt vmcnt(0)" ::: "memory");
      const unsigned og = xb_add(&bar[XB_TOP], 1u);
      const unsigned tg = og / nx;
      if (og + 1u == (tg + 1u) * nx) xb_add(&bar[XB_TOPGEN], 1u);
      else XB_SPIN(xb_ld(&bar[XB_TOPGEN]) == tg, bar);
      __builtin_amdgcn_fence(__ATOMIC_ACQUIRE, "agent");
      xb_add(&bar[XB_XGEN(b.x)], 1u);
      asm volatile("s_waitcnt vmcnt(0)" ::: "memory");
    } else {
      XB_SPIN(xb_ld(&bar[XB_XGEN(b.x)]) == gen, bar);
      __builtin_amdgcn_fence(__ATOMIC_ACQUIRE, "agent");
      asm volatile("s_waitcnt vmcnt(0)" ::: "memory");
    }
  }
  __syncthreads();
}

DI Params kargs() {
  Params P{};
#if defined(__HIP_DEVICE_COMPILE__)
  typedef const unsigned long long __attribute__((address_space(4))) CU;
  CU* q = (CU*)__builtin_amdgcn_kernarg_segment_ptr();
  asm volatile("" : "+s"(q));
#define GP(T, i) ((T*)(T __attribute__((address_space(1)))*)(q[i]))
  P.x = GP(const float, 0);
  P.c = GP(const float, 1);
  P.ctx = GP(const float, 2);
  P.c_ctx = GP(const float, 3);
  P.w_mod = GP(const float, 4);
  P.b_mod = GP(const float, 5);
  P.norm_mix_g = GP(const float, 6);
  P.norm_ffn_g = GP(const float, 7);
  P.final_norm_g = GP(const float, 8);
  P.ab_w_in = GP(const float, 9);
  P.ab_conv_w = GP(const float, 10);
  P.ab_gate_b = GP(const float, 11);
  P.ab_head_g = GP(const float, 12);
  P.ab_sink = GP(const float, 13);
  P.ab_w_out = GP(const float, 14);
  P.gm_w_in = GP(const float, 15);
  P.gm_ln_g = GP(const float, 16);
  P.gm_ln_b = GP(const float, 17);
  P.gm_w_s = GP(const float, 18);
  P.gm_b_s = GP(const float, 19);
  P.gm_w_out = GP(const float, 20);
  P.moe_w_router = GP(const float, 21);
  P.moe_w_gate = GP(const float, 22);
  P.moe_w_up = GP(const float, 23);
  P.moe_w_down = GP(const float, 24);
  P.out = GP(float, 25);
  P.ws = GP(char, 26);
#undef GP
#endif
  return P;
}
#if COOP
#ifndef REPEAT_MASK
#define REPEAT_MASK 0
#endif
__global__ void __launch_bounds__(256, 2) mega(Params p_unused) {
  __shared__ __attribute__((aligned(16))) char smem[73728 + 16];
  unsigned* xbw = (unsigned*)(smem + 73728);
  cg::grid_group grid = cg::this_grid();
  if (threadIdx.x < 4) xbw[threadIdx.x] = 0u;
  __syncthreads();
  XcdBarrier xb;
  { const Params pp = kargs(); xb = xcd_barrier_post((unsigned*)(pp.ws + O_BAR), (volatile LAS unsigned*)xbw); }
#define PHX(n) { const Params pp = kargs(); run_phase(pp, n, smem); } xcd_barrier(xb); \
  if ((REPEAT_MASK >> n) & 1) { { const Params pp = kargs(); run_phase(pp, n, smem); } xcd_barrier(xb); }
  { const Params pp = kargs(); run_phase(pp, 0, smem); }
  if (p_unused.ws == nullptr) grid.sync();
  xcd_barrier(xb);
  PHX(1) PHX(2) PHX(3) PHX(4) PHX(5) PHX(6) PHX(7) PHX(8) PHX(9) PHX(10)
  PHX(11) PHX(12) PHX(13) PHX(14) PHX(15) PHX(16) PHX(17) PHX(18) PHX(19) PHX(20)
  { const Params pp = kargs(); run_phase(pp, 21, smem); }
}
#else
__global__ void __launch_bounds__(256, 2) mega(Params p, int ph) {
  __shared__ __attribute__((aligned(16))) char smem[73728];
  run_phase(p, ph, smem);
}
#endif

extern "C" void kernel_launch(void* const* d_in, const int* in_sizes, int n_in, void* d_out, int out_size, void* d_ws,
                              size_t ws_size, hipStream_t stream) {
  (void)in_sizes; (void)n_in; (void)out_size;
  if (ws_size < WS_NEED) { fprintf(stderr, "workspace too small: %zu < %zu\n", ws_size, (size_t)WS_NEED); return; }
  static int grid_blocks = 0;
  if (!grid_blocks) {
    int dev = 0, cus = 0, per_cu = 0;
    hipGetDevice(&dev);
    hipDeviceGetAttribute(&cus, hipDeviceAttributeMultiprocessorCount, dev);
    hipOccupancyMaxActiveBlocksPerMultiprocessor(&per_cu, mega, 256, 0);
    if (per_cu < 1) per_cu = 1;
    if (per_cu > 2) per_cu = 2;
    grid_blocks = cus * per_cu;
  }
  Params p{};
  const float** f = (const float**)&p;
  for (int i = 0; i < 25; ++i) f[i] = (const float*)d_in[i];
  p.out = (float*)d_out;
  p.ws = (char*)d_ws;
#if COOP
  hipMemsetAsync((char*)d_ws + O_BAR, 0, XCD_BAR_WORDS * 4, stream);
  void* args[] = {&p};
  hipError_t e = hipLaunchCooperativeKernel((void*)mega, dim3(grid_blocks), dim3(256), args, 0, stream);
  if (e != hipSuccess) fprintf(stderr, "cooperative launch failed: %s (grid %d)\n", hipGetErrorString(e), grid_blocks);
#else
  for (int ph = 0; ph < NPHASE; ++ph) hipLaunchKernelGGL(mega, dim3(grid_blocks), dim3(256), 0, stream, p, ph);
#endif
}
```

```cpp
#include <hip/hip_runtime.h>
#include <hip/hip_cooperative_groups.h>
#include <cstdio>
namespace cg = cooperative_groups;

#define DI __device__ __forceinline__
typedef unsigned short bf16_t;
using bf16x8 = __attribute__((ext_vector_type(8))) short;
using s16x4 = __attribute__((ext_vector_type(4))) short;
using f32x16 = __attribute__((ext_vector_type(16))) float;
#define MFMA(a, b, c) __builtin_amdgcn_mfma_f32_32x32x16_bf16((a), (b), (c), 0, 0, 0)

#ifndef COOP
#define COOP 1
#endif

constexpr int DM = 1024, NBAT = 2, SEQ = 8192, NTOK = NBAT * SEQ, CTXL = 256, NROW = NTOK + NBAT * CTXL;
constexpr int PLD = 2816;
constexpr int NSTEP = 66;
constexpr float EPS = 1e-6f;

constexpr size_t al256(size_t x) { return (x + 255) & ~(size_t)255; }
constexpr size_t O_BAR = 0;
constexpr size_t O_WIN = 16384;
constexpr size_t O_WOUT = O_WIN + al256((size_t)PLD * 1024 * 2);
constexpr size_t O_GMIN = O_WOUT + al256((size_t)1024 * 1024 * 2);
constexpr size_t O_GMOUT = O_GMIN + al256((size_t)4096 * 1024 * 2);
constexpr size_t O_MGU = O_GMOUT + al256((size_t)1024 * 2048 * 2);
constexpr size_t O_MD = O_MGU + al256((size_t)16 * 2048 * 1024 * 2);
constexpr size_t O_MODV = O_MD + al256((size_t)16 * 1024 * 1024 * 2);
constexpr size_t O_HA = O_MODV + al256((size_t)2 * 3 * 6144 * 4);
constexpr size_t O_GL = O_HA + al256((size_t)NROW * 1024 * 2);
constexpr size_t O_AFF = O_GL + al256((size_t)NROW * 16 * 4);
constexpr size_t O_IDX = O_AFF + al256((size_t)32 * 8192 * 4);
constexpr size_t O_GATE = O_IDX + al256((size_t)32 * 1024 * 4);
constexpr size_t O_STATS = O_GATE + al256((size_t)32 * 1024 * 4);
constexpr size_t O_GSC = O_STATS + al256((size_t)NTOK * 16 * 4);
constexpr size_t O_MLOC = O_GSC + al256((size_t)16 * NSTEP * 4);
constexpr size_t O_DN = O_MLOC + al256((size_t)16 * NSTEP * 4);
constexpr size_t O_NST = O_DN + al256((size_t)16 * NSTEP * 128 * 4);
constexpr size_t O_MST = O_NST + al256((size_t)16 * 64 * 128 * 4);
constexpr size_t O_INV = O_MST + al256((size_t)16 * 64 * 4);
constexpr size_t O_R12 = O_INV + al256((size_t)NTOK * 16 * 4);
constexpr size_t O_P = O_R12;
constexpr size_t O_QC = O_P + al256((size_t)NROW * PLD * 2);
constexpr size_t O_KC = O_QC + al256((size_t)NTOK * 512 * 2);
constexpr size_t O_KT = O_KC + al256((size_t)NTOK * 512 * 2);
constexpr size_t O_VT = O_KT + al256((size_t)132 * 4 * 128 * 128 * 2);
constexpr size_t O_RQ = O_VT + al256((size_t)132 * 4 * 128 * 128 * 2);
constexpr size_t O_RK = O_RQ + al256((size_t)NTOK * 512 * 2);
constexpr size_t O_AVTX = O_RK + al256((size_t)NROW * 128 * 2);
constexpr size_t O_AVTC = O_AVTX + al256((size_t)4 * 64 * 8192 * 2);
constexpr size_t O_R12_END = O_AVTC + al256((size_t)4 * 64 * 256 * 2);
constexpr size_t O_HID = O_R12;
constexpr size_t O_U = O_R12;
constexpr size_t O_GVT = O_U + al256((size_t)NTOK * 2048 * 2);
static_assert(O_GVT + (size_t)NTOK * 2048 * 2 <= O_R12_END, "R12 too small");
constexpr size_t O_DC = O_R12_END;
constexpr size_t O_CST = O_DC + al256((size_t)16 * NSTEP * 16384 * 4);
constexpr size_t O_UV = O_DC;
constexpr size_t O_YE = O_DC;
constexpr size_t WS_NEED = O_CST + al256((size_t)16 * 64 * 16384 * 2);

struct Params {
  const float *x, *c, *ctx, *c_ctx, *w_mod, *b_mod, *norm_mix_g, *norm_ffn_g, *final_norm_g;
  const float *ab_w_in, *ab_conv_w, *ab_gate_b, *ab_head_g, *ab_sink, *ab_w_out;
  const float *gm_w_in, *gm_ln_g, *gm_ln_b, *gm_w_s, *gm_b_s, *gm_w_out;
  const float *moe_w_router, *moe_w_gate, *moe_w_up, *moe_w_down;
  float* out;
  char* ws;
};

DI bf16_t f2bf(float x) { unsigned u = __float_as_uint(x); u += 0x7fffu + ((u >> 16) & 1u); return (bf16_t)(u >> 16); }
DI float bf2f(bf16_t b) { return __uint_as_float(((unsigned)b) << 16); }
DI unsigned pack2(float a, float b) { return (unsigned)f2bf(a) | ((unsigned)f2bf(b) << 16); }
DI bf16x8 pack8(float a0, float a1, float a2, float a3, float a4, float a5, float a6, float a7) {
  uint4 u; u.x = pack2(a0, a1); u.y = pack2(a2, a3); u.z = pack2(a4, a5); u.w = pack2(a6, a7);
  return __builtin_bit_cast(bf16x8, u);
}
DI bf16x8 ldfrag(const bf16_t* p) { return *(const bf16x8*)p; }
DI bf16x8 ldfrag2(const bf16_t* p0, const bf16_t* p1) {
  s16x4 lo = *(const s16x4*)p0, hi = *(const s16x4*)p1;
  return __builtin_shufflevector(lo, hi, 0, 1, 2, 3, 4, 5, 6, 7);
}
DI int crow(int i, int hh) { return (i & 3) + 8 * (i >> 2) + 4 * hh; }
DI float siluf(float x) { return x / (1.f + __expf(-x)); }
DI float sigmf(float x) { return 1.f / (1.f + __expf(-x)); }
DI float logsigf(float x) { return fminf(x, 0.f) - log1pf(expf(-fabsf(x))); }
DI float geluf(float x) {
  const float u2 = 1.5957691216057308f * (x + 0.044715f * x * x * x);
  return x / (1.f + __expf(-u2));
}
DI float wsum(float v) {
#pragma unroll
  for (int o = 32; o > 0; o >>= 1) v += __shfl_xor(v, o);
  return v;
}
DI int tid() { int t = threadIdx.x; asm volatile("" : "+v"(t)); return t; }
DI f32x16 fzero() { f32x16 z; for (int i = 0; i < 16; ++i) z[i] = 0.f; return z; }

DI int tmap(int kind, int n) {
  if (kind == 0) return n;
  if (kind == 1) return n < 2048 ? n : (n < 2064 ? -1 : n - 16);
  int r = (n >> 6) * 128 + ((n >> 5) & 1) * 64 + (n & 31);
  return kind == 2 ? r : r + 32;
}
DI void tconv(const float* __restrict__ src, int ldn, int ncols, int K, int nmat, size_t sstride,
              bf16_t* __restrict__ dst, size_t dstride, int kind, char* smem) {
  float* sm = (float*)smem;
  const int t = tid();
  const int ntn = (ncols + 63) >> 6, ntk = K >> 6, per = ntn * ntk, total = per * nmat;
  const int c4 = t & 15, rr = t >> 4;
  float4 v0, v1, v2, v3;
#define TC_LOAD(tile_) { const int mat_ = (tile_) / per, tt_ = (tile_) % per; const int k0_ = (tt_ / ntn) * 64, n_ = (tt_ % ntn) * 64 + c4 * 4; \
    const float* s_ = src + (size_t)mat_ * sstride + (size_t)(k0_ + rr) * ldn + n_; \
    if (n_ < ncols) { v0 = *(const float4*)(s_); v1 = *(const float4*)(s_ + (size_t)16 * ldn); v2 = *(const float4*)(s_ + (size_t)32 * ldn); v3 = *(const float4*)(s_ + (size_t)48 * ldn); } \
    else { v0 = v1 = v2 = v3 = make_float4(0.f, 0.f, 0.f, 0.f); } }
  int tile = blockIdx.x;
  if (tile < total) TC_LOAD(tile)
  for (; tile < total; tile += gridDim.x) {
    const int mat = tile / per, tt = tile % per;
    const int k0 = (tt / ntn) * 64, n0 = (tt % ntn) * 64;
    bf16_t* d = dst + (size_t)mat * dstride;
    {
      float* q = sm + rr * 65 + c4 * 4;
      q[0] = v0.x; q[1] = v0.y; q[2] = v0.z; q[3] = v0.w;
      q[16 * 65 + 0] = v1.x; q[16 * 65 + 1] = v1.y; q[16 * 65 + 2] = v1.z; q[16 * 65 + 3] = v1.w;
      q[32 * 65 + 0] = v2.x; q[32 * 65 + 1] = v2.y; q[32 * 65 + 2] = v2.z; q[32 * 65 + 3] = v2.w;
      q[48 * 65 + 0] = v3.x; q[48 * 65 + 1] = v3.y; q[48 * 65 + 2] = v3.z; q[48 * 65 + 3] = v3.w;
    }
    if (tile + (int)gridDim.x < total) TC_LOAD(tile + (int)gridDim.x)
    __syncthreads();
    const int nl = t >> 2, kq = t & 3, n = n0 + nl;
    if (n < ncols) {
      const int row = tmap(kind, n);
      if (row >= 0) {
        uint4 o0, o1;
        const float* q = sm + (kq * 16) * 65 + nl;
        o0.x = pack2(q[0 * 65], q[1 * 65]); o0.y = pack2(q[2 * 65], q[3 * 65]); o0.z = pack2(q[4 * 65], q[5 * 65]); o0.w = pack2(q[6 * 65], q[7 * 65]);
        o1.x = pack2(q[8 * 65], q[9 * 65]); o1.y = pack2(q[10 * 65], q[11 * 65]); o1.z = pack2(q[12 * 65], q[13 * 65]); o1.w = pack2(q[14 * 65], q[15 * 65]);
        uint4* dp = (uint4*)(d + (size_t)row * K + k0 + kq * 16);
        dp[0] = o0; dp[1] = o1;
      }
    }
    __syncthreads();
  }
#undef TC_LOAD
}
DI void tconv_moe(const Params& p, int layer, char* smem) {
  const size_t wo = (size_t)layer * 16 * 1024 * 1024;
  tconv(p.moe_w_gate + wo, 1024, 1024, 1024, 16, (size_t)1024 * 1024, (bf16_t*)(p.ws + O_MGU), (size_t)2048 * 1024, 2, smem);
  tconv(p.moe_w_up + wo, 1024, 1024, 1024, 16, (size_t)1024 * 1024, (bf16_t*)(p.ws + O_MGU), (size_t)2048 * 1024, 3, smem);
  tconv(p.moe_w_down + wo, 1024, 1024, 1024, 16, (size_t)1024 * 1024, (bf16_t*)(p.ws + O_MD), (size_t)1024 * 1024, 0, smem);
}

DI void phase_adaln(const Params& p, char* smem) {
  float* sv = (float*)smem;
  float* red = sv + 3 * 1024;
  float* modv = (float*)(p.ws + O_MODV);
  const int t = tid();
  if (blockIdx.x >= 192) return;
  for (int i = t; i < 3 * 1024; i += 256) {
    const int v = i >> 10, k = i & 1023;
    const float cv = v < 2 ? p.c[v * 1024 + k] : p.c_ctx[k];
    sv[i] = siluf(cv);
  }
  __syncthreads();
  for (int item = blockIdx.x; item < 192; item += gridDim.x) {
    const int l = item / 96, cb = item % 96;
    const int cq = t & 15, kg = t >> 4;
    const float* w = p.w_mod + (size_t)l * 1024 * 6144 + cb * 64 + cq * 4;
    float a0[4] = {0.f, 0.f, 0.f, 0.f}, a1[4] = {0.f, 0.f, 0.f, 0.f}, a2[4] = {0.f, 0.f, 0.f, 0.f};
    for (int i = 0; i < 64; ++i) {
      const int k = kg + 16 * i;
      const float4 wv = *(const float4*)(w + (size_t)k * 6144);
      const float s0 = sv[k], s1 = sv[1024 + k], s2 = sv[2048 + k];
      a0[0] += s0 * wv.x; a0[1] += s0 * wv.y; a0[2] += s0 * wv.z; a0[3] += s0 * wv.w;
      a1[0] += s1 * wv.x; a1[1] += s1 * wv.y; a1[2] += s1 * wv.z; a1[3] += s1 * wv.w;
      a2[0] += s2 * wv.x; a2[1] += s2 * wv.y; a2[2] += s2 * wv.z; a2[3] += s2 * wv.w;
    }
#pragma unroll
    for (int j = 0; j < 4; ++j) {
      red[(kg * 3 + 0) * 64 + cq * 4 + j] = a0[j];
      red[(kg * 3 + 1) * 64 + cq * 4 + j] = a1[j];
      red[(kg * 3 + 2) * 64 + cq * 4 + j] = a2[j];
    }
    __syncthreads();
    if (t < 192) {
      const int v = t >> 6, col = t & 63;
      float s = 0.f;
      for (int g = 0; g < 16; ++g) s += red[(g * 3 + v) * 64 + col];
      const int cc = cb * 64 + col;
      modv[(l * 3 + v) * 6144 + cc] = s + p.b_mod[l * 6144 + cc];
    }
    __syncthreads();
  }
}

DI void moe_combine_row(const Params& p, int row, int lane, float4 (&acc)[4]) {
  const int* INV = (const int*)(p.ws + O_INV); const float* GATE = (const float*)(p.ws + O_GATE);
  const bf16_t* YE = (const bf16_t*)(p.ws + O_YE);
  const int b = row >> 13;
  const int myslot = INV[(size_t)row * 16 + (lane & 15)];
#pragma unroll
  for (int i = 0; i < 4; ++i) acc[i] = make_float4(0.f, 0.f, 0.f, 0.f);
#pragma unroll 1
  for (int e = 0; e < 16; ++e) {
    const int slot = __builtin_amdgcn_readlane(myslot, e);
    if (slot != 0) {
      const int be = b * 16 + e;
      const float g = GATE[be * 1024 + slot - 1];
      const bf16_t* yr = YE + ((size_t)be * 1024 + slot - 1) * 1024;
#pragma unroll
      for (int i = 0; i < 4; ++i) {
        const s16x4 v = *(const s16x4*)(yr + (i * 64 + lane) * 4);
        acc[i].x += g * bf2f((bf16_t)v[0]); acc[i].y += g * bf2f((bf16_t)v[1]); acc[i].z += g * bf2f((bf16_t)v[2]); acc[i].w += g * bf2f((bf16_t)v[3]);
      }
    }
  }
}

template <int MODE, bool COMB>
DI void phase_modulate(const Params& p, int layer, int which, char* smem) {
  float* wt = (float*)smem;
  const int t = tid(), lane = t & 63, w = t >> 6;
  const float* modv = (const float*)(p.ws + O_MODV);
  bf16_t* HA = (bf16_t*)(p.ws + O_HA);
  if (MODE != 0) {
    const float* W = MODE == 1 ? p.ab_w_in + 2048 : p.moe_w_router + (size_t)layer * 1024 * 16;
    const int ld = MODE == 1 ? 2832 : 16;
    for (int i = t; i < 4096; i += 256) {
      const int k = i >> 2, e4 = i & 3;
      const float4 v = *(const float4*)(W + (size_t)k * ld + e4 * 4);
      wt[(e4 * 4 + 0) * 1024 + k] = v.x; wt[(e4 * 4 + 1) * 1024 + k] = v.y; wt[(e4 * 4 + 2) * 1024 + k] = v.z; wt[(e4 * 4 + 3) * 1024 + k] = v.w;
    }
    __syncthreads();
  }
  const float* gn = (which == 0 ? p.norm_mix_g : p.norm_ffn_g) + layer * 1024;
  const int nrows = MODE == 1 ? NROW : NTOK;
  const int rstride = gridDim.x * 4;
  float4 nx[4];
#define MOD_SRC(row_) (MODE == 1 ? ((row_) < NTOK ? p.x + (size_t)(row_) * 1024 : p.ctx + (size_t)((row_) - NTOK) * 1024) : p.out + (size_t)(row_) * 1024)
  {
    const int row0_ = blockIdx.x * 4 + w;
    if (row0_ < nrows) {
      const float* s0_ = MOD_SRC(row0_);
#pragma unroll
      for (int i = 0; i < 4; ++i) nx[i] = *(const float4*)(s0_ + (i * 64 + lane) * 4);
    }
  }
  for (int row = blockIdx.x * 4 + w; row < nrows; row += rstride) {
    const int v = (MODE == 1 && row >= NTOK) ? 2 : (row >> 13);
    const float* sh = modv + (layer * 3 + v) * 6144 + (which ? 3 : 0) * 1024;
    const float* sc = sh + 1024;
    float4 xv[4];
    float ss = 0.f;
#pragma unroll
    for (int i = 0; i < 4; ++i) xv[i] = nx[i];
    if (row + rstride < nrows) {
      const float* s1_ = MOD_SRC(row + rstride);
#pragma unroll
      for (int i = 0; i < 4; ++i) nx[i] = *(const float4*)(s1_ + (i * 64 + lane) * 4);
    }
    if (COMB) {
      float4 ca[4];
      moe_combine_row(p, row, lane, ca);
      const float* g2 = modv + ((layer - 1) * 3 + v) * 6144 + 5 * 1024;
#pragma unroll
      for (int i = 0; i < 4; ++i) {
        const float4 gg = *(const float4*)(g2 + (i * 64 + lane) * 4);
        xv[i].x += gg.x * ca[i].x; xv[i].y += gg.y * ca[i].y; xv[i].z += gg.z * ca[i].z; xv[i].w += gg.w * ca[i].w;
        *(float4*)(p.out + (size_t)row * 1024 + (i * 64 + lane) * 4) = xv[i];
      }
    }
#pragma unroll
    for (int i = 0; i < 4; ++i) ss += xv[i].x * xv[i].x + xv[i].y * xv[i].y + xv[i].z * xv[i].z + xv[i].w * xv[i].w;
    ss = wsum(ss);
    const float rstd = rsqrtf(ss * (1.f / 1024.f) + EPS);
    float4 yv[4];
#pragma unroll
    for (int i = 0; i < 4; ++i) {
      const int col = (i * 64 + lane) * 4;
      const float4 g4 = *(const float4*)(gn + col), s4 = *(const float4*)(sh + col), c4 = *(const float4*)(sc + col);
      float4 y;
      y.x = xv[i].x * rstd * g4.x * (1.f + c4.x) + s4.x;
      y.y = xv[i].y * rstd * g4.y * (1.f + c4.y) + s4.y;
      y.z = xv[i].z * rstd * g4.z * (1.f + c4.z) + s4.z;
      y.w = xv[i].w * rstd * g4.w * (1.f + c4.w) + s4.w;
      yv[i] = y;
      uint2 o; o.x = pack2(y.x, y.y); o.y = pack2(y.z, y.w);
      *(uint2*)(HA + (size_t)row * 1024 + col) = o;
    }
    if (MODE != 0) {
      float mine = 0.f;
#pragma unroll 1
      for (int e4 = 0; e4 < 16; e4 += 4) {
        float pe0 = 0.f, pe1 = 0.f, pe2 = 0.f, pe3 = 0.f;
#pragma unroll
        for (int i = 0; i < 4; ++i) {
          const float* wp = wt + e4 * 1024 + (i * 64 + lane) * 4;
          const float4 wa = *(const float4*)(wp), wb = *(const float4*)(wp + 1024), wc = *(const float4*)(wp + 2048), wd = *(const float4*)(wp + 3072);
          pe0 += yv[i].x * wa.x + yv[i].y * wa.y + yv[i].z * wa.z + yv[i].w * wa.w;
          pe1 += yv[i].x * wb.x + yv[i].y * wb.y + yv[i].z * wb.z + yv[i].w * wb.w;
          pe2 += yv[i].x * wc.x + yv[i].y * wc.y + yv[i].z * wc.z + yv[i].w * wc.w;
          pe3 += yv[i].x * wd.x + yv[i].y * wd.y + yv[i].z * wd.z + yv[i].w * wd.w;
        }
#pragma unroll
        for (int o = 32; o > 0; o >>= 1) {
          const float q0 = __shfl_xor(pe0, o), q1 = __shfl_xor(pe1, o), q2 = __shfl_xor(pe2, o), q3 = __shfl_xor(pe3, o);
          pe0 += q0; pe1 += q1; pe2 += q2; pe3 += q3;
        }
        const int el = (lane & 15) - e4;
        mine = el == 0 ? pe0 : (el == 1 ? pe1 : (el == 2 ? pe2 : (el == 3 ? pe3 : mine)));
      }
      const int e = lane & 15;
      if (MODE == 1) {
        float val = mine + p.ab_gate_b[e];
        if (((e >> 2) & 1) == 1) val = logsigf(val);
        if (lane < 16) ((float*)(p.ws + O_GL))[(size_t)row * 16 + lane] = val;
      } else {
        float mx = mine;
#pragma unroll
        for (int o = 8; o > 0; o >>= 1) mx = fmaxf(mx, __shfl_xor(mx, o));
        const float ex = expf(mine - mx);
        float sum = ex;
#pragma unroll
        for (int o = 8; o > 0; o >>= 1) sum += __shfl_xor(sum, o);
        if (lane < 16) ((float*)(p.ws + O_AFF))[((size_t)(row >> 13) * 16 + lane) * 8192 + (row & 8191)] = ex / sum;
        if (lane < 16) ((int*)(p.ws + O_INV))[(size_t)row * 16 + lane] = 0;
      }
    }
  }
}

template <bool DENSEA, class Epi>
DI void gemm_tile(const bf16_t* Abase, const unsigned (&aoff)[8], const bf16_t* Bbase, unsigned boff, int K, char* smem, Epi&& epi) {
  bf16_t* sA = (bf16_t*)smem;
  bf16_t* sB = sA + 256 * 72;
  const int t = tid(), lane = t & 63, w = t >> 6, wm = w >> 1, wn = w & 1, r = lane & 31, hh = lane >> 5;
  const int lrow = t >> 3, lcol = (t & 7) * 8;
  const unsigned bst = 32u * (unsigned)K;
  f32x16 acc[4][2];
#pragma unroll
  for (int i = 0; i < 4; ++i) { acc[i][0] = fzero(); acc[i][1] = fzero(); }
  uint4 A0, A1, A2, A3, A4, A5, A6, A7, B0, B1, B2, B3;
#define GLOADT(kn_) { \
    const bf16_t* Ak_ = Abase + (kn_); const bf16_t* Bk_ = Bbase + (kn_);     \
    if (DENSEA) { \
      A0 = *(const uint4*)(Ak_ + aoff[0]); A1 = *(const uint4*)((Ak_ + bst) + aoff[0]); A2 = *(const uint4*)((Ak_ + 2 * bst) + aoff[0]); A3 = *(const uint4*)((Ak_ + 3 * bst) + aoff[0]); \
      A4 = *(const uint4*)((Ak_ + 4 * bst) + aoff[0]); A5 = *(const uint4*)((Ak_ + 5 * bst) + aoff[0]); A6 = *(const uint4*)((Ak_ + 6 * bst) + aoff[0]); A7 = *(const uint4*)((Ak_ + 7 * bst) + aoff[0]); \
    } else { \
      A0 = *(const uint4*)(Ak_ + aoff[0]); A1 = *(const uint4*)(Ak_ + aoff[1]); A2 = *(const uint4*)(Ak_ + aoff[2]); A3 = *(const uint4*)(Ak_ + aoff[3]); \
      A4 = *(const uint4*)(Ak_ + aoff[4]); A5 = *(const uint4*)(Ak_ + aoff[5]); A6 = *(const uint4*)(Ak_ + aoff[6]); A7 = *(const uint4*)(Ak_ + aoff[7]); \
    } \
    B0 = *(const uint4*)(Bk_ + boff); B1 = *(const uint4*)((Bk_ + bst) + boff); B2 = *(const uint4*)((Bk_ + 2 * bst) + boff); B3 = *(const uint4*)((Bk_ + 3 * bst) + boff); }
  GLOADT(0)
  const int so = lrow * 72 + lcol;
  const bf16_t* cA = sA + (wm * 128 + r) * 72 + hh * 8;
  const bf16_t* cB = sB + (wn * 64 + r) * 72 + hh * 8;
  const int KT = K >> 6;
  for (int kt = 0; kt < KT; ++kt) {
    __syncthreads();
    *(uint4*)(sA + so) = A0; *(uint4*)(sA + so + 32 * 72) = A1; *(uint4*)(sA + so + 64 * 72) = A2; *(uint4*)(sA + so + 96 * 72) = A3;
    *(uint4*)(sA + so + 128 * 72) = A4; *(uint4*)(sA + so + 160 * 72) = A5; *(uint4*)(sA + so + 192 * 72) = A6; *(uint4*)(sA + so + 224 * 72) = A7;
    *(uint4*)(sB + so) = B0; *(uint4*)(sB + so + 32 * 72) = B1; *(uint4*)(sB + so + 64 * 72) = B2; *(uint4*)(sB + so + 96 * 72) = B3;
    __syncthreads();
    { const int kn = (kt + 1 < KT ? kt + 1 : kt) * 64; GLOADT(kn) }
    __builtin_amdgcn_sched_barrier(0);
    __builtin_amdgcn_s_setprio(1);
#pragma unroll
    for (int ks = 0; ks < 4; ++ks) {
      const bf16x8 b0 = *(const bf16x8*)(cB + ks * 16), b1 = *(const bf16x8*)(cB + 32 * 72 + ks * 16);
#pragma unroll
      for (int mi = 0; mi < 4; ++mi) {
        const bf16x8 a = *(const bf16x8*)(cA + mi * 32 * 72 + ks * 16);
        acc[mi][0] = MFMA(a, b0, acc[mi][0]);
        acc[mi][1] = MFMA(a, b1, acc[mi][1]);
      }
      if (ks == 1) __builtin_amdgcn_sched_barrier(0);
    }
    __builtin_amdgcn_s_setprio(0);
    __builtin_amdgcn_sched_barrier(0);
  }
#undef GLOADT
  epi(acc, wm * 128, wn * 64, r, hh);
}

struct TileWalk {
  int L, Lend, nl;
  DI TileWalk(int T, const char* smem) {
    const volatile unsigned* xw = (const volatile unsigned*)(smem + 73728);
    const int nloc = (int)xw[0], sb = (int)xw[2], rk = (int)xw[3];
    int G = (int)gridDim.x;
    asm volatile("" : "+s"(G));
    nl = nloc;
    L = (T * sb) / G + rk; Lend = (T * (sb + nloc)) / G;
  }
  DI bool valid() const { return L < Lend; }
  DI void next() { L += nl; }
  DI void get(int SM, int SN, int nsn, int& mt, int& nt) const {
    const int s = L / (SM * SN), wi = L % (SM * SN);
    mt = (s / nsn) * SM + wi / SN; nt = (s % nsn) * SN + wi % SN;
  }
};

template <class MakeEpi>
DI void gemm_dense(const bf16_t* A, const bf16_t* Bt, int M, int N, int K, int SM, int SN, char* smem, MakeEpi&& mk) {
  const int t = tid(), lrow = t >> 3, lcol = (t & 7) * 8;
  const int ntn = N >> 7, ntm = M >> 8;
  for (TileWalk tw(ntn * ntm, smem); tw.valid(); tw.next()) {
    int mt, nt; tw.get(SM, SN, ntn / SN, mt, nt);
    unsigned aoff[8];
#pragma unroll
    for (int i = 0; i < 8; ++i) aoff[i] = (unsigned)(lrow + 32 * i) * (unsigned)K + (unsigned)lcol;
    gemm_tile<true>(A + (size_t)mt * 256 * K, aoff, Bt + (size_t)(nt * 128) * K, (unsigned)lrow * (unsigned)K + (unsigned)lcol, K, smem, mk(mt * 256, nt * 128));
  }
}

DI void phase_prep2(const Params& p, char* smem) {
  bf16_t* T = (bf16_t*)smem;
  const bf16_t* P = (const bf16_t*)(p.ws + O_P);
  bf16_t* Qc = (bf16_t*)(p.ws + O_QC); bf16_t* Kc = (bf16_t*)(p.ws + O_KC);
  bf16_t* KT = (bf16_t*)(p.ws + O_KT); bf16_t* VT = (bf16_t*)(p.ws + O_VT);
  bf16_t* RQ = (bf16_t*)(p.ws + O_RQ); bf16_t* RK = (bf16_t*)(p.ws + O_RK);
  bf16_t* AVTX = (bf16_t*)(p.ws + O_AVTX); bf16_t* AVTC = (bf16_t*)(p.ws + O_AVTC);
  const int t = tid();
  for (int item = blockIdx.x; item < 132 * 6; item += gridDim.x) {
    const int sc = item / 6, part = item % 6;
    const bool isx = sc < 128;
    const int row0 = sc * 128;
    const int seq_lo = isx ? (sc >> 6) * 8192 : NTOK + ((sc - 128) >> 1) * 256;
    const int seq_hi = seq_lo + (isx ? 8192 : 256);
    if (part < 4) {
      const int h = part;
      const int col8 = t & 15, rsub = t >> 4;
      for (int pass = 0; pass < 3; ++pass) {
        if (pass == 2 && !isx) break;
        const int pcol = (pass == 0 ? 512 : (pass == 1 ? 1024 : 0)) + h * 128 + col8 * 8;
        float cw[5][8];
        if (pass != 1) {
#pragma unroll
          for (int j = 0; j < 5; ++j)
#pragma unroll
            for (int e = 0; e < 8; ++e) cw[j][e] = p.ab_conv_w[j * 1024 + (pass == 0 ? 512 : 0) + h * 128 + col8 * 8 + e];
        }
        for (int i = 0; i < 8; ++i) {
          const int rl = rsub + 16 * i, row = row0 + rl;
          uint4 o;
          if (pass == 1) {
            o = *(const uint4*)(P + (size_t)row * PLD + pcol);
          } else {
            float a[8];
#pragma unroll
            for (int e = 0; e < 8; ++e) a[e] = 0.f;
#pragma unroll
            for (int j = 0; j < 5; ++j) {
              const int rr = row + j - 2;
              if (rr >= seq_lo && rr < seq_hi) {
                const bf16x8 v = *(const bf16x8*)(P + (size_t)rr * PLD + pcol);
#pragma unroll
                for (int e = 0; e < 8; ++e) a[e] += cw[j][e] * bf2f((bf16_t)v[e]);
              }
            }
            const float scl = pass == 0 ? 0.08838834764831845f : 1.f;
#pragma unroll
            for (int e = 0; e < 8; ++e) a[e] = siluf(a[e]) * scl;
            o.x = pack2(a[0], a[1]); o.y = pack2(a[2], a[3]); o.z = pack2(a[4], a[5]); o.w = pack2(a[6], a[7]);
            if (isx) *(uint4*)((pass == 0 ? Kc : Qc) + (size_t)row * 512 + h * 128 + col8 * 8) = o;
          }
          if (pass < 2) *(uint4*)(T + rl * 136 + col8 * 8) = o;
        }
        if (pass < 2) {
          __syncthreads();
          bf16_t* dstT = (pass == 0 ? KT : VT) + (size_t)(sc * 4 + h) * 16384;
          const int d = t & 127, shf = t >> 7;
#pragma unroll
          for (int s8 = 0; s8 < 8; ++s8) {
            const bf16_t* q = T + (shf * 64 + s8 * 8) * 136 + d;
            uint4 o;
            o.x = (unsigned)q[0] | ((unsigned)q[136] << 16); o.y = (unsigned)q[2 * 136] | ((unsigned)q[3 * 136] << 16);
            o.z = (unsigned)q[4 * 136] | ((unsigned)q[5 * 136] << 16); o.w = (unsigned)q[6 * 136] | ((unsigned)q[7 * 136] << 16);
            *(uint4*)(dstT + d * 128 + shf * 64 + s8 * 8) = o;
          }
          __syncthreads();
        }
      }
    } else if (part == 4) {
      if (!isx) continue;
      for (int idx = t; idx < 512; idx += 256) {
        const int rl = idx >> 2, dc = idx & 3, row = row0 + rl, pos = row - seq_lo;
        const float rp = (float)(pos >> 6), cp = (float)(pos & 63);
        float cs[8], sn[8];
#pragma unroll
        for (int e = 0; e < 8; ++e) {
          const int a = dc * 8 + e;
          const float inv = powf(10000.f, -(float)(a & 15) / 16.f);
          const float ang = (a < 16 ? rp : cp) * inv;
          cs[e] = cosf(ang); sn[e] = sinf(ang);
        }
        for (int hq = 0; hq < 8; ++hq) {
          const bf16x8 x1 = *(const bf16x8*)(P + (size_t)row * PLD + 2048 + hq * 64 + dc * 8);
          const bf16x8 x2 = *(const bf16x8*)(P + (size_t)row * PLD + 2048 + hq * 64 + 32 + dc * 8);
          float o1[8], o2[8];
#pragma unroll
          for (int e = 0; e < 8; ++e) {
            const float a = bf2f((bf16_t)x1[e]), b = bf2f((bf16_t)x2[e]);
            o1[e] = (a * cs[e] - b * sn[e]) * 0.125f; o2[e] = (b * cs[e] + a * sn[e]) * 0.125f;
          }
          uint4 u1, u2;
          u1.x = pack2(o1[0], o1[1]); u1.y = pack2(o1[2], o1[3]); u1.z = pack2(o1[4], o1[5]); u1.w = pack2(o1[6], o1[7]);
          u2.x = pack2(o2[0], o2[1]); u2.y = pack2(o2[2], o2[3]); u2.z = pack2(o2[4], o2[5]); u2.w = pack2(o2[6], o2[7]);
          *(uint4*)(RQ + (size_t)row * 512 + hq * 64 + dc * 8) = u1;
          *(uint4*)(RQ + (size_t)row * 512 + hq * 64 + 32 + dc * 8) = u2;
        }
      }
    } else {
      for (int idx = t; idx < 512; idx += 256) {
        const int rl = idx >> 2, dc = idx & 3, row = row0 + rl, pos = row - seq_lo;
        const float rp = (float)(pos >> 6), cp = (float)(pos & 63);
        float cs[8], sn[8];
#pragma unroll
        for (int e = 0; e < 8; ++e) {
          const int a = dc * 8 + e;
          const float inv = powf(10000.f, -(float)(a & 15) / 16.f);
          const float ang = (a < 16 ? rp : cp) * inv;
          cs[e] = isx ? cosf(ang) : 1.f; sn[e] = isx ? sinf(ang) : 0.f;
        }
        for (int g = 0; g < 2; ++g) {
          const bf16x8 x1 = *(const bf16x8*)(P + (size_t)row * PLD + 2560 + g * 64 + dc * 8);
          const bf16x8 x2 = *(const bf16x8*)(P + (size_t)row * PLD + 2560 + g * 64 + 32 + dc * 8);
          float o1[8], o2[8];
#pragma unroll
          for (int e = 0; e < 8; ++e) {
            const float a = bf2f((bf16_t)x1[e]), b = bf2f((bf16_t)x2[e]);
            o1[e] = a * cs[e] - b * sn[e]; o2[e] = b * cs[e] + a * sn[e];
          }
          uint4 u1, u2;
          u1.x = pack2(o1[0], o1[1]); u1.y = pack2(o1[2], o1[3]); u1.z = pack2(o1[4], o1[5]); u1.w = pack2(o1[6], o1[7]);
          u2.x = pack2(o2[0], o2[1]); u2.y = pack2(o2[2], o2[3]); u2.z = pack2(o2[4], o2[5]); u2.w = pack2(o2[6], o2[7]);
          *(uint4*)(RK + (size_t)row * 128 + g * 64 + dc * 8) = u1;
          *(uint4*)(RK + (size_t)row * 128 + g * 64 + 32 + dc * 8) = u2;
        }
      }
      {
        const int col8 = t & 15, rsub = t >> 4;
        for (int i = 0; i < 8; ++i) {
          const int rl = rsub + 16 * i;
          *(uint4*)(T + rl * 136 + col8 * 8) = *(const uint4*)(P + (size_t)(row0 + rl) * PLD + 2688 + col8 * 8);
        }
        __syncthreads();
        const int d = t & 127, shf = t >> 7;
        const int b = isx ? (sc >> 6) : ((sc - 128) >> 1);
        const int pos0 = row0 - seq_lo;
        bf16_t* dst = isx ? AVTX + ((size_t)(b * 2 + (d >> 6)) * 64 + (d & 63)) * 8192 + pos0
                          : AVTC + ((size_t)(b * 2 + (d >> 6)) * 64 + (d & 63)) * 256 + pos0;
#pragma unroll
        for (int s8 = 0; s8 < 8; ++s8) {
          const bf16_t* q = T + (shf * 64 + s8 * 8) * 136 + d;
          uint4 o;
          o.x = (unsigned)q[0] | ((unsigned)q[136] << 16); o.y = (unsigned)q[2 * 136] | ((unsigned)q[3 * 136] << 16);
          o.z = (unsigned)q[4 * 136] | ((unsigned)q[5 * 136] << 16); o.w = (unsigned)q[6 * 136] | ((unsigned)q[7 * 136] << 16);
          *(uint4*)(dst + shf * 64 + s8 * 8) = o;
        }
        __syncthreads();
      }
    }
  }
}

DI void attn_item(const Params& p, int item, char* smem) {
  const int g = item & 1, qb = (item >> 1) & 255, b = item >> 9;
  int t_ = tid();
  asm volatile("" : "+v"(t_));
  const int t = t_, lane = t & 63, w = t >> 6, r = lane & 31, hh = lane >> 5;
  const int hq = g * 4 + w, q0 = qb * 32;
  const bf16_t* RQ = (const bf16_t*)(p.ws + O_RQ); const bf16_t* RK = (const bf16_t*)(p.ws + O_RK);
  const bf16_t* AVTX = (const bf16_t*)(p.ws + O_AVTX); const bf16_t* AVTC = (const bf16_t*)(p.ws + O_AVTC);
  bf16_t* MIX = (bf16_t*)(p.ws + O_HA);
  const size_t qrow = (size_t)b * 8192 + q0 + r;
  bf16x8 qf[4];
#pragma unroll
  for (int ks = 0; ks < 4; ++ks) qf[ks] = ldfrag(RQ + qrow * 512 + hq * 64 + ks * 16 + hh * 8);
  float m = p.ab_sink[hq], l = hh == 0 ? 1.f : 0.f;
  f32x16 o0 = fzero(), o1 = fzero();
  const int ipos = q0 + r;
  const int lo = q0 - 128 < 0 ? 0 : q0 - 128, hi = q0 + 128 > 8192 - 32 ? 8192 - 32 : q0 + 128;
  const int nloc = ((hi - lo) >> 5) + 1, ntile = nloc + 8;
  bf16_t* sKt = (bf16_t*)smem;
  bf16_t* sVt = sKt + 2 * 32 * 72;
  const bf16_t* kloc = RK + (size_t)(b * 8192) * 128 + g * 64 + (t >> 3) * 128 + (t & 7) * 8;
  const bf16_t* kctx = RK + (size_t)(NTOK + b * 256) * 128 + g * 64 + (t >> 3) * 128 + (t & 7) * 8;
  const bf16_t* vloc = AVTX + (size_t)((b * 2 + g) * 64 + (t >> 2)) * 8192 + (t & 3) * 8;
  const bf16_t* vctx = AVTC + (size_t)((b * 2 + g) * 64 + (t >> 2)) * 256 + (t & 3) * 8;
  const int skoff = (t >> 3) * 72 + (t & 7) * 8, svoff = (t >> 2) * 40 + (t & 3) * 8;
  uint4 gk, gv;
#define ATT_LOAD(j_) { const bool loc_ = (j_) < nloc; const int k0_ = loc_ ? lo + (j_) * 32 : ((j_) - nloc) * 32; \
    gk = *(const uint4*)((loc_ ? kloc : kctx) + (size_t)k0_ * 128); gv = *(const uint4*)((loc_ ? vloc : vctx) + k0_); }
  ATT_LOAD(0)
  __syncthreads();
  *(uint4*)(sKt + skoff) = gk; *(uint4*)(sVt + svoff) = gv;
  __syncthreads();
#pragma unroll 1
  for (int tile = 0; tile < ntile; ++tile) {
    const int cur = tile & 1;
    if (tile + 1 < ntile) ATT_LOAD(tile + 1)
    const bool local = tile < nloc;
    const int k0 = local ? lo + tile * 32 : (tile - nloc) * 32;
    const bf16_t* kt = sKt + cur * 32 * 72 + r * 72 + hh * 8;
    const bf16_t* vt = sVt + cur * 64 * 40 + r * 40 + 4 * hh;
    f32x16 s = fzero();
#pragma unroll
    for (int ks = 0; ks < 4; ++ks) s = MFMA(*(const bf16x8*)(kt + ks * 16), qf[ks], s);
    float tmax = -INFINITY;
#pragma unroll
    for (int i = 0; i < 16; ++i) {
      const int dj = ipos - (k0 + crow(i, hh));
      const bool ok = !local || (dj <= 128 && dj >= -128);
      s[i] = ok ? s[i] : -INFINITY;
      tmax = fmaxf(tmax, s[i]);
    }
    tmax = fmaxf(tmax, __shfl_xor(tmax, 32));
    const float mn = fmaxf(m, tmax), corr = __expf(m - mn);
    m = mn; l *= corr;
#pragma unroll
    for (int i = 0; i < 16; ++i) { o0[i] *= corr; o1[i] *= corr; }
#pragma unroll
    for (int i = 0; i < 16; ++i) { s[i] = __expf(s[i] - mn); l += s[i]; }
    const bf16x8 pf0 = pack8(s[0], s[1], s[2], s[3], s[4], s[5], s[6], s[7]);
    const bf16x8 pf1 = pack8(s[8], s[9], s[10], s[11], s[12], s[13], s[14], s[15]);
    o0 = MFMA(ldfrag2(vt, vt + 8), pf0, o0);
    o1 = MFMA(ldfrag2(vt + 32 * 40, vt + 32 * 40 + 8), pf0, o1);
    o0 = MFMA(ldfrag2(vt + 16, vt + 24), pf1, o0);
    o1 = MFMA(ldfrag2(vt + 32 * 40 + 16, vt + 32 * 40 + 24), pf1, o1);
    if (tile + 1 < ntile) { *(uint4*)(sKt + (cur ^ 1) * 32 * 72 + skoff) = gk; *(uint4*)(sVt + (cur ^ 1) * 64 * 40 + svoff) = gv; }
    __syncthreads();
  }
#undef ATT_LOAD
  l += __shfl_xor(l, 32);
  const float inv = 1.f / l;
  bf16_t* dst = MIX + qrow * 1024 + 512 + hq * 64;
#pragma unroll
  for (int q4 = 0; q4 < 4; ++q4) {
    const int d = 8 * q4 + 4 * hh;
    uint2 u;
    u.x = pack2(o0[4 * q4] * inv, o0[4 * q4 + 1] * inv); u.y = pack2(o0[4 * q4 + 2] * inv, o0[4 * q4 + 3] * inv);
    *(uint2*)(dst + d) = u;
    u.x = pack2(o1[4 * q4] * inv, o1[4 * q4 + 1] * inv); u.y = pack2(o1[4 * q4 + 2] * inv, o1[4 * q4 + 3] * inv);
    *(uint2*)(dst + 32 + d) = u;
  }
}

DI void mlstm_local_item(const Params& p, int item, char* smem) {
  float* gs = (float*)smem;
  float* wv = gs + 512;
  float* msc = wv + 256;
  int t_ = tid();
  asm volatile("" : "+v"(t_));
  const int t = t_, lane = t & 63, w = t >> 6, wm = w >> 1, wn = w & 1, r = lane & 31, hh = lane >> 5;
  const int bh = item / NSTEP, nc = item % NSTEP, b = bh >> 2, h = bh & 3;
  const int sc = nc < 2 ? 128 + b * 2 + nc : b * 64 + (nc - 2);
  const int row0 = sc * 128;
  const float* GL = (const float*)(p.ws + O_GL);
  const bf16_t* KT = (const bf16_t*)(p.ws + O_KT) + (size_t)(sc * 4 + h) * 16384;
  const bf16_t* VT = (const bf16_t*)(p.ws + O_VT) + (size_t)(sc * 4 + h) * 16384;
  char* sK = smem + 8192;
  char* sV = sK + 32768;
#pragma unroll
  for (int i = 0; i < 8; ++i) {
    const int q = t + 256 * i, row = q >> 4, cc = q & 15;
    const int so = row * 256 + ((cc ^ (row & 15)) << 4);
    *(uint4*)(sK + so) = *(const uint4*)(KT + row * 128 + cc * 8);
    *(uint4*)(sV + so) = *(const uint4*)(VT + row * 128 + cc * 8);
  }
  for (int i = t; i < 512; i += 256) { const int ty = i >> 7, s = i & 127; gs[i] = GL[(size_t)(row0 + s) * 16 + ty * 4 + h]; }
  __syncthreads();
  {
    const int dir = t >> 7, s = t & 127;
    float wval, tot = 0.f;
    if (dir == 0) {
      float bsum = 0.f;
      for (int j = 0; j < 128; ++j) { const float f = gs[128 + j]; tot += f; if (j <= s) bsum += f; }
      wval = tot - bsum + gs[s];
    } else {
      float pre = 0.f;
      for (int j = 0; j < 128; ++j) { const float f = gs[384 + j]; tot += f; if (j < s) pre += f; }
      wval = pre + gs[256 + s];
    }
    wv[dir * 128 + s] = wval;
    if (s == 0) msc[dir] = tot;
  }
  __syncthreads();
  {
    const int dir = t >> 7, s = t & 127;
    float mx = -INFINITY;
    for (int j = 0; j < 128; ++j) mx = fmaxf(mx, wv[dir * 128 + j]);
    const float wval = wv[dir * 128 + s];
    __syncthreads();
    wv[dir * 128 + s] = expf(wval - mx);
    if (s == 0) msc[2 + dir] = mx;
  }
  __syncthreads();
  bf16_t* DC = (bf16_t*)(p.ws + O_DC);
#pragma unroll 1
  for (int d = 0; d < 2; ++d) {
    f32x16 acc[2][2];
#pragma unroll
    for (int i = 0; i < 2; ++i)
#pragma unroll
      for (int j = 0; j < 2; ++j) acc[i][j] = fzero();
#pragma unroll 2
    for (int ks = 0; ks < 8; ++ks) {
      const int xo = ((ks * 2 + hh) ^ (r & 15)) << 4;
      const bf16x8 ra0 = *(const bf16x8*)(sV + (wm * 64 + r) * 256 + xo);
      const bf16x8 ra1 = *(const bf16x8*)(sV + (wm * 64 + 32 + r) * 256 + xo);
      const bf16x8 b0 = *(const bf16x8*)(sK + (wn * 64 + r) * 256 + xo);
      const bf16x8 b1 = *(const bf16x8*)(sK + (wn * 64 + 32 + r) * 256 + xo);
      const float* ww = wv + d * 128 + ks * 16 + hh * 8;
      const bf16x8 a0 = pack8(bf2f((bf16_t)ra0[0]) * ww[0], bf2f((bf16_t)ra0[1]) * ww[1], bf2f((bf16_t)ra0[2]) * ww[2], bf2f((bf16_t)ra0[3]) * ww[3],
                              bf2f((bf16_t)ra0[4]) * ww[4], bf2f((bf16_t)ra0[5]) * ww[5], bf2f((bf16_t)ra0[6]) * ww[6], bf2f((bf16_t)ra0[7]) * ww[7]);
      const bf16x8 a1 = pack8(bf2f((bf16_t)ra1[0]) * ww[0], bf2f((bf16_t)ra1[1]) * ww[1], bf2f((bf16_t)ra1[2]) * ww[2], bf2f((bf16_t)ra1[3]) * ww[3],
                              bf2f((bf16_t)ra1[4]) * ww[4], bf2f((bf16_t)ra1[5]) * ww[5], bf2f((bf16_t)ra1[6]) * ww[6], bf2f((bf16_t)ra1[7]) * ww[7]);
      acc[0][0] = MFMA(a0, b0, acc[0][0]);
      acc[0][1] = MFMA(a0, b1, acc[0][1]);
      acc[1][0] = MFMA(a1, b0, acc[1][0]);
      acc[1][1] = MFMA(a1, b1, acc[1][1]);
    }
    bf16_t* dst = DC + ((size_t)(bh * 2 + d) * NSTEP + nc) * 16384;
#pragma unroll
    for (int mi = 0; mi < 2; ++mi)
#pragma unroll
      for (int ni = 0; ni < 2; ++ni)
#pragma unroll
        for (int i = 0; i < 16; ++i)
          dst[(wm * 64 + mi * 32 + crow(i, hh)) * 128 + wn * 64 + ni * 32 + r] = f2bf(acc[mi][ni][i]);
  }
  {
    const int dir = t >> 7, k = t & 127;
    float s = 0.f;
    for (int s8 = 0; s8 < 16; ++s8) {
      const bf16x8 v = *(const bf16x8*)(sK + k * 256 + ((s8 ^ (k & 15)) << 4));
#pragma unroll
      for (int e = 0; e < 8; ++e) s += wv[dir * 128 + s8 * 8 + e] * bf2f((bf16_t)v[e]);
    }
    ((float*)(p.ws + O_DN))[((size_t)(bh * 2 + dir) * NSTEP + nc) * 128 + k] = s;
    if (k == 0) {
      ((float*)(p.ws + O_GSC))[(bh * 2 + dir) * NSTEP + nc] = msc[dir];
      ((float*)(p.ws + O_MLOC))[(bh * 2 + dir) * NSTEP + nc] = msc[2 + dir];
    }
  }
  __syncthreads();
}

DI int chain_nc(int dir, int i) { return dir == 0 ? i : (i < 2 ? 1 - i : 67 - i); }
template <int DIR>
DI void scan_chain_elems(const bf16_t* __restrict__ DCc, bf16_t* __restrict__ CSTc, const float* fa, const float* fb, int e, int epos) {
  float C = 0.f;
#pragma unroll
  for (int blk = 0; blk < 3; ++blk) {
    float v[22];
#pragma unroll
    for (int j = 0; j < 22; ++j) {
      const int i = blk * 22 + j;
      const int nc = DIR == 0 ? i : (i < 2 ? 1 - i : 67 - i);
      v[j] = bf2f(DCc[(size_t)nc * 16384 + e]);
    }
#pragma unroll
    for (int j = 0; j < 22; ++j) {
      const int i = blk * 22 + j;
      const int nc = DIR == 0 ? i : (i < 2 ? 1 - i : 67 - i);
      if (i >= 2) CSTc[(size_t)(nc - 2) * 16384 + epos] = f2bf(C);
      C = fa[i] * C + fb[i] * v[j];
    }
  }
}
DI void phase_scan(const Params& p, char* smem) {
  float* fa = (float*)smem;
  float* fb = fa + 66;
  const float* GSC = (const float*)(p.ws + O_GSC); const float* MLOC = (const float*)(p.ws + O_MLOC);
  const bf16_t* DC = (const bf16_t*)(p.ws + O_DC); const float* DN = (const float*)(p.ws + O_DN);
  bf16_t* CST = (bf16_t*)(p.ws + O_CST); float* NST = (float*)(p.ws + O_NST); float* MST = (float*)(p.ws + O_MST);
  const int t = tid();
  for (int item = blockIdx.x; item < 16 * 64 + 16; item += gridDim.x) {
    const int chain = item < 1024 ? (item >> 6) : (item - 1024), dir = chain & 1;
    __syncthreads();
    if (t < NSTEP) { const int nc = chain_nc(dir, t); fa[t] = GSC[chain * NSTEP + nc]; fb[t] = MLOC[chain * NSTEP + nc]; }
    __syncthreads();
    if (t == 0) {
      float m = 0.f;
      for (int i = 0; i < NSTEP; ++i) {
        if (i >= 2 && item >= 1024) MST[chain * 64 + chain_nc(dir, i) - 2] = m;
        const float g = fa[i], ml = fb[i];
        const float mn = fmaxf(g + m, ml);
        fa[i] = __expf(g + m - mn); fb[i] = __expf(ml - mn);
        m = mn;
      }
    }
    __syncthreads();
    if (item < 1024) {
      const int e = (item & 63) * 256 + t;
      const int ev = e >> 7, ek = e & 127;
      const int epos = ((((ev >> 5) * 8 + (ek >> 4)) * 64) + ((ek >> 3) & 1) * 32 + (ev & 31)) * 8 + (ek & 7);
      const bf16_t* DCc = DC + (size_t)chain * NSTEP * 16384;
      bf16_t* CSTc = CST + (size_t)chain * 64 * 16384;
      if (dir == 0) scan_chain_elems<0>(DCc, CSTc, fa, fb, e, epos);
      else scan_chain_elems<1>(DCc, CSTc, fa, fb, e, epos);
    } else if (t < 128) {
      const int k = t;
      float n = 0.f;
      for (int i = 0; i < NSTEP; ++i) {
        const int nc = chain_nc(dir, i);
        if (i >= 2) NST[((size_t)chain * 64 + (nc - 2)) * 128 + k] = n;
        n = fa[i] * n + fb[i] * DN[((size_t)chain * NSTEP + nc) * 128 + k];
      }
    }
  }
}

DI void mlstm_out_item(const Params& p, int item, char* smem) {
  float* gs = (float*)smem;
  float* bb = gs + 512;
  float* lib = bb + 256;
  float* mrow = lib + 256;
  float* aT = mrow + 256;
  float* nq = aT + 256;
  float* nst = nq + 256;
  char* sK = smem + 8192;
  char* sV = sK + 32768;
  int t_ = tid();
  asm volatile("" : "+v"(t_));
  const int t = t_, lane = t & 63, w = t >> 6, r = lane & 31, hh = lane >> 5;
  const int bh = item >> 6, c = item & 63, b = bh >> 2, h = bh & 3;
  const int sc = b * 64 + c, row0 = sc * 128;
  const float* GL = (const float*)(p.ws + O_GL);
  const bf16_t* Qc = (const bf16_t*)(p.ws + O_QC); const bf16_t* Kc = (const bf16_t*)(p.ws + O_KC);
  const bf16_t* VT = (const bf16_t*)(p.ws + O_VT) + (size_t)(sc * 4 + h) * 16384;
  const bf16_t* P = (const bf16_t*)(p.ws + O_P);
  const float* MST = (const float*)(p.ws + O_MST);
  bf16_t* MIX = (bf16_t*)(p.ws + O_HA);
#pragma unroll
  for (int i = 0; i < 8; ++i) {
    const int q = t + 256 * i, row = q >> 4, cc = q & 15;
    const int so = row * 256 + ((cc ^ (row & 15)) << 4);
    *(uint4*)(sK + so) = *(const uint4*)(Kc + (size_t)(row0 + row) * 512 + h * 128 + cc * 8);
    *(uint4*)(sV + so) = *(const uint4*)(VT + row * 128 + cc * 8);
  }
  for (int i = t; i < 512; i += 256) { const int ty = i >> 7, s = i & 127; gs[i] = GL[(size_t)(row0 + s) * 16 + ty * 4 + h]; }
  {
    const int dir = t >> 7, k = t & 127;
    nst[t] = ((const float*)(p.ws + O_NST))[((size_t)(bh * 2 + dir) * 64 + c) * 128 + k];
  }
  __syncthreads();
  {
    const int dir = t >> 7, s = t & 127;
    float bsum = 0.f;
    if (dir == 0) { for (int j = 0; j <= s; ++j) bsum += gs[128 + j]; }
    else { for (int j = s; j < 128; ++j) bsum += gs[384 + j]; }
    bb[t] = bsum;
    lib[t] = gs[dir * 256 + s] - bsum;
    const bf16_t* qr = Qc + (size_t)(row0 + s) * 512 + h * 128;
    float acc = 0.f;
    for (int k8 = 0; k8 < 16; ++k8) {
      const bf16x8 v = ldfrag(qr + k8 * 8);
#pragma unroll
      for (int e = 0; e < 8; ++e) acc += nst[dir * 128 + k8 * 8 + e] * bf2f((bf16_t)v[e]);
    }
    nq[t] = acc;
  }
  __syncthreads();
  {
    const int dir = t >> 7, s = t & 127;
    float pm = -INFINITY;
    if (dir == 0) { for (int j = 0; j <= s; ++j) pm = fmaxf(pm, lib[j]); }
    else { for (int j = s; j < 128; ++j) pm = fmaxf(pm, lib[128 + j]); }
    const float m_in = MST[(bh * 2 + dir) * 64 + c];
    const float mr = bb[t] + fmaxf(m_in, pm);
    mrow[t] = mr;
    aT[t] = expf(bb[t] + m_in - mr);
  }
  __syncthreads();
  const int tl = w * 32 + r;
  const bf16_t* qrow = Qc + (size_t)(row0 + tl) * 512 + h * 128 + hh * 8;
  bf16x8 qf[8];
#pragma unroll
  for (int ks = 0; ks < 8; ++ks) qf[ks] = ldfrag(qrow + ks * 16);
  const int swz = r & 15;
  const char* kp[8]; const char* vp[16];
#pragma unroll
  for (int ks = 0; ks < 8; ++ks) kp[ks] = sK + r * 256 + (((ks * 2 + hh) ^ swz) << 4);
#pragma unroll
  for (int cc = 0; cc < 16; ++cc) vp[cc] = sV + r * 256 + 8 * hh + ((cc ^ swz) << 4);
  float* Hb = (float*)(p.ws + O_DC) + (size_t)item * 16384 + tl;
  float* Hbh = Hb + 4 * hh * 128;
  f32x16 outa[4];
#define MLSTM_DIR(DIR)                                                                                                   \
  {                                                                                                                      \
    const bf16_t* CSTl = (const bf16_t*)(p.ws + O_CST) + ((size_t)(bh * 2 + DIR) * 64 + c) * 16384 + lane * 8;           \
    const float bbt = bb[DIR * 128 + tl], mrt = mrow[DIR * 128 + tl], at = aT[DIR * 128 + tl];                            \
    float dsum = 0.f;                                                                                                    \
    const float* libp = lib + DIR * 128 + 4 * hh;                                                                        \
    const int tb = tl - 4 * hh;                                                                                          \
    bf16x8 pf[8];                                                                                                        \
    _Pragma("unroll") for (int half = 0; half < 2; ++half) {                                                             \
      f32x16 st[2];                                                                                                      \
      st[0] = fzero(); st[1] = fzero();                                                                                  \
      _Pragma("unroll") for (int ks = 0; ks < 8; ++ks) {                                                                 \
        _Pragma("unroll") for (int r2 = 0; r2 < 2; ++r2)                                                                 \
          st[r2] = MFMA(*(const bf16x8*)(kp[ks] + (half * 2 + r2) * 8192), qf[ks], st[r2]);                              \
      }                                                                                                                  \
      _Pragma("unroll") for (int r2 = 0; r2 < 2; ++r2) {                                                                 \
        const int rb = half * 2 + r2;                                                                                    \
        _Pragma("unroll") for (int i = 0; i < 16; ++i) {                                                                 \
          const int sc_ = rb * 32 + (i & 3) + 8 * (i >> 2);                                           \
          const int diff = DIR == 0 ? (tb - sc_) : (sc_ - tb);                                                           \
          const float msk = (float)((unsigned)(~diff) >> 31);                                                            \
          const float v = st[r2][i] * __expf(fminf(bbt + libp[sc_] - mrt, 0.f)) * msk;                                    \
          st[r2][i] = v; dsum += v;                                                                                      \
        }                                                                                                                \
        pf[rb * 2] = pack8(st[r2][0], st[r2][1], st[r2][2], st[r2][3], st[r2][4], st[r2][5], st[r2][6], st[r2][7]);      \
        pf[rb * 2 + 1] = pack8(st[r2][8], st[r2][9], st[r2][10], st[r2][11], st[r2][12], st[r2][13], st[r2][14], st[r2][15]); \
      }                                                                                                                  \
      __builtin_amdgcn_sched_barrier(0);                                                                                 \
    }                                                                                                                    \
    dsum += __shfl_xor(dsum, 32);                                                                                        \
    const float den = dsum + at * nq[DIR * 128 + tl];                                                                    \
    const float dinv = 1.f / fmaxf(fabsf(den), expf(-mrt));                                                              \
    _Pragma("unroll") for (int half = 0; half < 2; ++half) {                                                             \
      f32x16 ha[2];                                                                                                      \
      ha[0] = fzero(); ha[1] = fzero();                                                                                  \
      _Pragma("unroll") for (int ks = 0; ks < 8; ++ks) {                                                                 \
        _Pragma("unroll") for (int r2 = 0; r2 < 2; ++r2)                                                                 \
          ha[r2] = MFMA(ldfrag(CSTl + ((half * 2 + r2) * 8 + ks) * 512), qf[ks], ha[r2]);                                \
        if (ks == 3) __builtin_amdgcn_sched_barrier(0);                                                                  \
      }                                                                                                                  \
      _Pragma("unroll") for (int r2 = 0; r2 < 2; ++r2)                                                                   \
        _Pragma("unroll") for (int i = 0; i < 16; ++i) ha[r2][i] *= at;                                                  \
      __builtin_amdgcn_sched_barrier(0);                                                                                 \
      _Pragma("unroll") for (int kk = 0; kk < 8; ++kk) {                                                                 \
        _Pragma("unroll") for (int r2 = 0; r2 < 2; ++r2) {                                                               \
          const s16x4 lo = *(const s16x4*)(vp[2 * kk] + (half * 2 + r2) * 8192);                                         \
          const s16x4 hi = *(const s16x4*)(vp[2 * kk + 1] + (half * 2 + r2) * 8192);                                     \
          ha[r2] = MFMA(__builtin_shufflevector(lo, hi, 0, 1, 2, 3, 4, 5, 6, 7), pf[kk], ha[r2]);                        \
        }                                                                                                                \
      }                                                                                                                  \
      _Pragma("unroll") for (int r2 = 0; r2 < 2; ++r2)                                                                   \
        _Pragma("unroll") for (int i = 0; i < 16; ++i) {                                                                 \
          float* hp = Hbh + ((half * 2 + r2) * 32 + (i & 3) + 8 * (i >> 2)) * 128;                                       \
          if (DIR == 0) *hp = ha[r2][i] * dinv;                                                                          \
          else outa[half * 2 + r2][i] = *hp + ha[r2][i] * dinv;                                                          \
        }                                                                                                                \
      __builtin_amdgcn_sched_barrier(0);                                                                                 \
    }                                                                                                                    \
  }
  MLSTM_DIR(0)
  MLSTM_DIR(1)
#undef MLSTM_DIR
  float ss = 0.f;
#pragma unroll
  for (int rb = 0; rb < 4; ++rb)
#pragma unroll
    for (int i = 0; i < 16; ++i) ss += outa[rb][i] * outa[rb][i];
  ss += __shfl_xor(ss, 32);
  const float rn = rsqrtf(ss * (1.f / 128.f) + EPS);
  const size_t row = (size_t)row0 + tl;
#pragma unroll
  for (int rb = 0; rb < 4; ++rb)
#pragma unroll
    for (int q4 = 0; q4 < 4; ++q4) {
      const int v = rb * 32 + 8 * q4 + 4 * hh;
      const s16x4 ov = *(const s16x4*)(P + row * PLD + 1536 + h * 128 + v);
      const float4 hg = *(const float4*)(p.ab_head_g + h * 128 + v);
      const float y0 = outa[rb][4 * q4] * rn * hg.x * sigmf(bf2f((bf16_t)ov[0]));
      const float y1 = outa[rb][4 * q4 + 1] * rn * hg.y * sigmf(bf2f((bf16_t)ov[1]));
      const float y2 = outa[rb][4 * q4 + 2] * rn * hg.z * sigmf(bf2f((bf16_t)ov[2]));
      const float y3 = outa[rb][4 * q4 + 3] * rn * hg.w * sigmf(bf2f((bf16_t)ov[3]));
      uint2 u; u.x = pack2(y0, y1); u.y = pack2(y2, y3);
      *(uint2*)(MIX + row * 1024 + h * 128 + v) = u;
    }
  __syncthreads();
}

DI void phase_topk(const Params& p, char* smem) {
  unsigned* vals = (unsigned*)smem;
  unsigned* hist = vals + 8448;
  unsigned* cntg = hist + 256;
  unsigned* cnte = cntg + 256;
  unsigned* misc = cnte + 256;
  const float* AFF = (const float*)(p.ws + O_AFF);
  int* IDX = (int*)(p.ws + O_IDX); float* GATE = (float*)(p.ws + O_GATE); int* INV = (int*)(p.ws + O_INV);
  const int t = tid();
  for (int item = blockIdx.x; item < 32; item += gridDim.x) {
    const float* a = AFF + (size_t)item * 8192;
    for (int i = t; i < 8192; i += 256) vals[i + (i >> 5)] = __float_as_uint(a[i]);
    unsigned prefix = 0, remaining = 1024;
    for (int pass = 0; pass < 4; ++pass) {
      const int shift = 24 - 8 * pass;
      hist[t] = 0;
      __syncthreads();
      const unsigned mask = pass == 0 ? 0u : (0xFFFFFFFFu << (shift + 8));
      for (int i = t; i < 8192; i += 256) {
        const unsigned u = vals[i + (i >> 5)];
        if ((u & mask) == (prefix & mask)) atomicAdd(&hist[(u >> shift) & 255], 1u);
      }
      __syncthreads();
      {
        unsigned above = 0;
        for (int bin = t + 1; bin < 256; ++bin) above += hist[bin];
        const unsigned mineh = hist[t];
        if (above < remaining && above + mineh >= remaining) {
          misc[0] = prefix | ((unsigned)t << shift);
          misc[1] = remaining - above;
        }
      }
      __syncthreads();
      prefix = misc[0]; remaining = misc[1];
      __syncthreads();
    }
    const unsigned T = prefix, need_eq = remaining;
    unsigned cg_ = 0, ce = 0;
    for (int j = 0; j < 32; ++j) {
      const int n = t * 32 + j;
      const unsigned u = vals[n + (n >> 5)];
      cg_ += u > T; ce += u == T;
    }
    cntg[t] = cg_; cnte[t] = ce;
    __syncthreads();
    unsigned pg = 0, pe = 0;
    for (int j = 0; j < t; ++j) { pg += cntg[j]; pe += cnte[j]; }
    for (int j = 0; j < 32; ++j) {
      const int n = t * 32 + j;
      const unsigned u = vals[n + (n >> 5)];
      if (u > T) { IDX[item * 1024 + pg] = n; GATE[item * 1024 + pg] = __uint_as_float(u); INV[((size_t)(item >> 4) * 8192 + n) * 16 + (item & 15)] = (int)pg + 1; ++pg; }
      else if (u == T) {
        if (pe < need_eq) { const unsigned slot = 1024 - need_eq + pe; IDX[item * 1024 + slot] = n; GATE[item * 1024 + slot] = __uint_as_float(u); INV[((size_t)(item >> 4) * 8192 + n) * 16 + (item & 15)] = (int)slot + 1; }
        ++pe;
      }
    }
    __syncthreads();
  }
}

DI void phase_stats(const Params& p, char* smem) {
  float* red = (float*)smem;
  const bf16_t* GVT = (const bf16_t*)(p.ws + O_GVT);
  float* PART = (float*)(p.ws + O_STATS);
  const int t = tid(), qq = t & 31, cg_ = t >> 5;
  for (int item = blockIdx.x; item < 1024; item += gridDim.x) {
    const int chunk = item >> 3, cgrp = item & 7;
    const bf16_t* base = GVT + ((size_t)chunk * 2048 + cgrp * 256) * 128 + qq * 4;
    float s[4] = {0.f, 0.f, 0.f, 0.f}, s2[4] = {0.f, 0.f, 0.f, 0.f};
#pragma unroll 8
    for (int c = cg_; c < 256; c += 8) {
      const s16x4 v = *(const s16x4*)(base + (size_t)c * 128);
#pragma unroll
      for (int e = 0; e < 4; ++e) { const float f = bf2f((bf16_t)v[e]); s[e] += f; s2[e] += f * f; }
    }
#pragma unroll
    for (int e = 0; e < 4; ++e) { red[(cg_ * 128 + qq * 4 + e) * 2] = s[e]; red[(cg_ * 128 + qq * 4 + e) * 2 + 1] = s2[e]; }
    __syncthreads();
    if (t < 128) {
      float a = 0.f, b2 = 0.f;
      for (int g = 0; g < 8; ++g) { a += red[(g * 128 + t) * 2]; b2 += red[(g * 128 + t) * 2 + 1]; }
      PART[((size_t)item * 128 + t) * 2] = a;
      PART[((size_t)item * 128 + t) * 2 + 1] = b2;
    }
    __syncthreads();
  }
}
DI void phase_spatial(const Params& p, char* smem) {
  float* smu = (float*)smem;
  float* srs = smu + 128;
  const bf16_t* GVT = (const bf16_t*)(p.ws + O_GVT); const bf16_t* U = (const bf16_t*)(p.ws + O_U);
  const float* PART = (const float*)(p.ws + O_STATS);
  bf16_t* UV = (bf16_t*)(p.ws + O_UV);
  char* sW = smem + 1024;
  int g_staged = -1;
  for (int item = blockIdx.x; item < 1024; item += gridDim.x) {
    int t_ = tid();
    const int t = t_, lane = t & 63, w = t >> 6, r = lane & 31, hh = lane >> 5;
    const int chunk = item >> 3, g = item & 7;
    if (t < 128) {
      float a = 0.f, b2 = 0.f;
#pragma unroll
      for (int j = 0; j < 8; ++j) { a += PART[((size_t)(chunk * 8 + j) * 128 + t) * 2]; b2 += PART[((size_t)(chunk * 8 + j) * 128 + t) * 2 + 1]; }
      const float mu = a * (1.f / 2048.f);
      const float var = fmaxf(b2 * (1.f / 2048.f) - mu * mu, 0.f);
      smu[t] = mu; srs[t] = rsqrtf(var + EPS);
    }
    if (g != g_staged) {
      const float* Wg = p.gm_w_s + (size_t)g * 16384;
#pragma unroll
      for (int i = 0; i < 8; ++i) {
        const int q = t + 256 * i, row = q >> 4, cc = q & 15;
        const float4 w0 = *(const float4*)(Wg + row * 128 + cc * 8), w1 = *(const float4*)(Wg + row * 128 + cc * 8 + 4);
        uint4 o; o.x = pack2(w0.x, w0.y); o.y = pack2(w0.z, w0.w); o.z = pack2(w1.x, w1.y); o.w = pack2(w1.z, w1.w);
        *(uint4*)(sW + row * 256 + ((cc ^ (row & 15)) << 4)) = o;
      }
      g_staged = g;
    }
    __syncthreads();
    f32x16 acc[2][4];
#pragma unroll
    for (int i = 0; i < 4; ++i) { acc[0][i] = fzero(); acc[1][i] = fzero(); }
    const int cA = g * 256 + w * 64 + r, cB = cA + 32;
    const float lgA = p.gm_ln_g[cA], lbA = p.gm_ln_b[cA], lgB = p.gm_ln_g[cB], lbB = p.gm_ln_b[cB];
    const bf16_t* vA = GVT + ((size_t)chunk * 2048 + cA) * 128 + hh * 8;
    const bf16_t* vB = GVT + ((size_t)chunk * 2048 + cB) * 128 + hh * 8;
    for (int ks = 0; ks < 8; ++ks) {
      const bf16x8 ra = ldfrag(vA + ks * 16), rbv = ldfrag(vB + ks * 16);
      const float* mu = smu + ks * 16 + hh * 8; const float* rs = srs + ks * 16 + hh * 8;
      const bf16x8 aA = pack8((bf2f((bf16_t)ra[0]) - mu[0]) * rs[0] * lgA + lbA, (bf2f((bf16_t)ra[1]) - mu[1]) * rs[1] * lgA + lbA,
                              (bf2f((bf16_t)ra[2]) - mu[2]) * rs[2] * lgA + lbA, (bf2f((bf16_t)ra[3]) - mu[3]) * rs[3] * lgA + lbA,
                              (bf2f((bf16_t)ra[4]) - mu[4]) * rs[4] * lgA + lbA, (bf2f((bf16_t)ra[5]) - mu[5]) * rs[5] * lgA + lbA,
                              (bf2f((bf16_t)ra[6]) - mu[6]) * rs[6] * lgA + lbA, (bf2f((bf16_t)ra[7]) - mu[7]) * rs[7] * lgA + lbA);
      const bf16x8 aB = pack8((bf2f((bf16_t)rbv[0]) - mu[0]) * rs[0] * lgB + lbB, (bf2f((bf16_t)rbv[1]) - mu[1]) * rs[1] * lgB + lbB,
                              (bf2f((bf16_t)rbv[2]) - mu[2]) * rs[2] * lgB + lbB, (bf2f((bf16_t)rbv[3]) - mu[3]) * rs[3] * lgB + lbB,
                              (bf2f((bf16_t)rbv[4]) - mu[4]) * rs[4] * lgB + lbB, (bf2f((bf16_t)rbv[5]) - mu[5]) * rs[5] * lgB + lbB,
                              (bf2f((bf16_t)rbv[6]) - mu[6]) * rs[6] * lgB + lbB, (bf2f((bf16_t)rbv[7]) - mu[7]) * rs[7] * lgB + lbB);
#pragma unroll
      for (int pb = 0; pb < 4; ++pb) {
        const bf16x8 bw = *(const bf16x8*)(sW + (pb * 32 + r) * 256 + (((ks * 2 + hh) ^ (r & 15)) << 4));
        acc[0][pb] = MFMA(aA, bw, acc[0][pb]);
        acc[1][pb] = MFMA(aB, bw, acc[1][pb]);
      }
    }
#pragma unroll
    for (int pb = 0; pb < 4; ++pb) {
      const int pp = pb * 32 + r;
      const float bs = p.gm_b_s[g * 128 + pp];
      const size_t rowo = ((size_t)chunk * 128 + pp) * 2048 + g * 256 + w * 64 + 4 * hh;
#pragma unroll
      for (int cb = 0; cb < 2; ++cb)
#pragma unroll
        for (int q4 = 0; q4 < 4; ++q4) {
          const size_t o = rowo + cb * 32 + 8 * q4;
          const s16x4 uu = *(const s16x4*)(U + o);
          uint2 st;
          st.x = pack2(bf2f((bf16_t)uu[0]) * (acc[cb][pb][4 * q4] + bs), bf2f((bf16_t)uu[1]) * (acc[cb][pb][4 * q4 + 1] + bs));
          st.y = pack2(bf2f((bf16_t)uu[2]) * (acc[cb][pb][4 * q4 + 2] + bs), bf2f((bf16_t)uu[3]) * (acc[cb][pb][4 * q4 + 3] + bs));
          *(uint2*)(UV + o) = st;
        }
    }
    __syncthreads();
  }
}

struct EpiBf16 {
  bf16_t* dst; int ld;
  DI void operator()(f32x16 (&acc)[4][2], int mb, int nb, int r, int hh) const {
#pragma unroll
    for (int mi = 0; mi < 4; ++mi)
#pragma unroll
      for (int ni = 0; ni < 2; ++ni)
#pragma unroll
        for (int i = 0; i < 16; ++i)
          dst[(size_t)(mb + mi * 32 + crow(i, hh)) * ld + nb + ni * 32 + r] = f2bf(acc[mi][ni][i]);
  }
};
struct EpiRes {
  float* out; const float* base; const float* gate;
  DI void operator()(f32x16 (&acc)[4][2], int mb, int nb, int r, int hh) const {
#pragma unroll
    for (int ni = 0; ni < 2; ++ni) {
      const int n = nb + ni * 32 + r;
      const float gt = gate[n];
#pragma unroll
      for (int mi = 0; mi < 4; ++mi) {
        const unsigned o0 = (unsigned)(mb + mi * 32 + 4 * hh) * 1024u + (unsigned)n;
#pragma unroll
        for (int q4 = 0; q4 < 4; ++q4) {
          const float b0 = base[o0 + (8 * q4 + 0) * 1024], b1 = base[o0 + (8 * q4 + 1) * 1024], b2 = base[o0 + (8 * q4 + 2) * 1024], b3 = base[o0 + (8 * q4 + 3) * 1024];
          out[o0 + (8 * q4 + 0) * 1024] = b0 + gt * acc[mi][ni][4 * q4];
          out[o0 + (8 * q4 + 1) * 1024] = b1 + gt * acc[mi][ni][4 * q4 + 1];
          out[o0 + (8 * q4 + 2) * 1024] = b2 + gt * acc[mi][ni][4 * q4 + 2];
          out[o0 + (8 * q4 + 3) * 1024] = b3 + gt * acc[mi][ni][4 * q4 + 3];
          __builtin_amdgcn_sched_barrier(0);
        }
      }
    }
  }
};
struct EpiGelu {
  bf16_t* U; bf16_t* GVT; int m0, n0;
  DI void operator()(f32x16 (&acc)[4][2], int mb, int nb, int r, int hh) const {
    if (n0 < 2048) {
#pragma unroll
      for (int mi = 0; mi < 4; ++mi)
#pragma unroll
        for (int ni = 0; ni < 2; ++ni)
#pragma unroll
          for (int i = 0; i < 16; ++i)
            U[(size_t)(m0 + mb + mi * 32 + crow(i, hh)) * 2048 + n0 + nb + ni * 32 + r] = f2bf(geluf(acc[mi][ni][i]));
    } else {
#pragma unroll
      for (int mi = 0; mi < 4; ++mi) {
        const int mrow = m0 + mb + mi * 32;
        const int chunk = mrow >> 7, q0 = mrow & 127;
#pragma unroll
        for (int ni = 0; ni < 2; ++ni) {
          const int cc = n0 - 2048 + nb + ni * 32 + r;
          bf16_t* d = GVT + ((size_t)chunk * 2048 + cc) * 128 + q0 + 4 * hh;
#pragma unroll
          for (int q4 = 0; q4 < 4; ++q4) {
            uint2 u;
            u.x = pack2(geluf(acc[mi][ni][4 * q4]), geluf(acc[mi][ni][4 * q4 + 1]));
            u.y = pack2(geluf(acc[mi][ni][4 * q4 + 2]), geluf(acc[mi][ni][4 * q4 + 3]));
            *(uint2*)(d + 8 * q4) = u;
          }
        }
      }
    }
  }
};
struct EpiSwiglu {
  bf16_t* hid;
  DI void operator()(f32x16 (&acc)[4][2], int mb, int nb, int r, int hh) const {
    const int f = (nb >> 1) + r;
#pragma unroll
    for (int mi = 0; mi < 4; ++mi)
#pragma unroll
      for (int i = 0; i < 16; ++i) {
        const float gv = acc[mi][0][i], uv = acc[mi][1][i];
        hid[(size_t)(mb + mi * 32 + crow(i, hh)) * 1024 + f] = f2bf(siluf(gv) * uv);
      }
  }
};
DI void phase_moe1(const Params& p, char* smem) {
  const bf16_t* HA = (const bf16_t*)(p.ws + O_HA); const bf16_t* WGU = (const bf16_t*)(p.ws + O_MGU);
  const int* IDX = (const int*)(p.ws + O_IDX); bf16_t* HID = (bf16_t*)(p.ws + O_HID);
  const int t = tid(), lrow = t >> 3, lcol = (t & 7) * 8;
  for (TileWalk tw(128 * 16, smem); tw.valid(); tw.next()) {
    int mg, nt; tw.get(8, 8, 2, mg, nt);
    const int e = mg >> 3, b = (mg >> 2) & 1, mt = mg & 3, be = b * 16 + e;
    unsigned aoff[8];
#pragma unroll
    for (int i = 0; i < 8; ++i) aoff[i] = (unsigned)IDX[be * 1024 + mt * 256 + lrow + 32 * i] * 1024u + (unsigned)lcol;
    gemm_tile<false>(HA + (size_t)b * 8192 * 1024, aoff, WGU + ((size_t)e * 2048 + nt * 128) * 1024, (unsigned)lrow * 1024u + (unsigned)lcol, 1024, smem,
              EpiSwiglu{HID + ((size_t)be * 1024 + mt * 256) * 1024 + nt * 64});
  }
}
DI void phase_moe2(const Params& p, int layer, char* smem) {
  const bf16_t* HID = (const bf16_t*)(p.ws + O_HID); const bf16_t* WD = (const bf16_t*)(p.ws + O_MD);
  const int t = tid(), lrow = t >> 3, lcol = (t & 7) * 8;
  for (TileWalk tw(128 * 8, smem); tw.valid(); tw.next()) {
    int mg, nt; tw.get(8, 8, 1, mg, nt);
    const int e = mg >> 3, b = (mg >> 2) & 1, mt = mg & 3, be = b * 16 + e;
    unsigned aoff[8];
#pragma unroll
    for (int i = 0; i < 8; ++i) aoff[i] = (unsigned)(lrow + 32 * i) * 1024u + (unsigned)lcol;
    gemm_tile<true>(HID + ((size_t)be * 1024 + mt * 256) * 1024, aoff, WD + ((size_t)e * 1024 + nt * 128) * 1024, (unsigned)lrow * 1024u + (unsigned)lcol, 1024, smem,
              EpiBf16{(bf16_t*)(p.ws + O_YE) + ((size_t)be * 1024 + mt * 256) * 1024 + nt * 128, 1024});
  }
}

DI void phase_final(const Params& p) {
  const int t = tid(), lane = t & 63, w = t >> 6;
  for (int row = blockIdx.x * 4 + w; row < NTOK; row += gridDim.x * 4) {
    float* src = p.out + (size_t)row * 1024;
    float4 xv[4]; float ss = 0.f;
#pragma unroll
    for (int i = 0; i < 4; ++i) xv[i] = *(const float4*)(src + (i * 64 + lane) * 4);
    {
      float4 ca[4];
      moe_combine_row(p, row, lane, ca);
      const float* g2 = (const float*)(p.ws + O_MODV) + (1 * 3 + (row >> 13)) * 6144 + 5 * 1024;
#pragma unroll
      for (int i = 0; i < 4; ++i) {
        const float4 gg = *(const float4*)(g2 + (i * 64 + lane) * 4);
        xv[i].x += gg.x * ca[i].x; xv[i].y += gg.y * ca[i].y; xv[i].z += gg.z * ca[i].z; xv[i].w += gg.w * ca[i].w;
      }
    }
#pragma unroll
    for (int i = 0; i < 4; ++i) ss += xv[i].x * xv[i].x + xv[i].y * xv[i].y + xv[i].z * xv[i].z + xv[i].w * xv[i].w;
    ss = wsum(ss);
    const float rstd = rsqrtf(ss * (1.f / 1024.f) + EPS);
#pragma unroll
    for (int i = 0; i < 4; ++i) {
      const int col = (i * 64 + lane) * 4;
      const float4 g4 = *(const float4*)(p.final_norm_g + col);
      float4 y; y.x = xv[i].x * rstd * g4.x; y.y = xv[i].y * rstd * g4.y; y.z = xv[i].z * rstd * g4.z; y.w = xv[i].w * rstd * g4.w;
      *(float4*)(src + col) = y;
    }
  }
}

constexpr int NPHASE = 22;
DI void run_phase(const Params& p, int ph, char* smem) {
  const float* modv = (const float*)(p.ws + O_MODV);
  switch (ph) {
#if !defined(ONLY) || ONLY == 0
    case 0:
      phase_adaln(p, smem);
      __syncthreads();
      tconv(p.ab_w_in, 2832, 2832, 1024, 1, 0, (bf16_t*)(p.ws + O_WIN), 0, 1, smem);
      tconv(p.ab_w_out, 1024, 1024, 1024, 1, 0, (bf16_t*)(p.ws + O_WOUT), 0, 0, smem);
      tconv(p.gm_w_in, 4096, 4096, 1024, 1, 0, (bf16_t*)(p.ws + O_GMIN), 0, 0, smem);
      tconv(p.gm_w_out, 1024, 1024, 2048, 1, 0, (bf16_t*)(p.ws + O_GMOUT), 0, 0, smem);
      break;
#endif
#if !defined(ONLY) || ONLY == 1
    case 1: phase_modulate<1, false>(p, 0, 0, smem); break;
#endif
#if !defined(ONLY) || ONLY == 2
    case 2:
      gemm_dense((const bf16_t*)(p.ws + O_HA), (const bf16_t*)(p.ws + O_WIN), NROW, PLD, 1024, 6, 11, smem,
                 [&](int m0, int n0) { return EpiBf16{(bf16_t*)(p.ws + O_P) + (size_t)m0 * PLD + n0, PLD}; });
      break;
#endif
#if !defined(ONLY) || ONLY == 3
    case 3: phase_prep2(p, smem); break;
#endif
#if !defined(ONLY) || ONLY == 4
    case 4:
      for (int item = blockIdx.x; item < 1024 + 8 * NSTEP; item += gridDim.x) {
        if (item < 1024) attn_item(p, item, smem); else mlstm_local_item(p, item - 1024, smem);
      }
      break;
#endif
#if !defined(ONLY) || ONLY == 5
    case 5: phase_scan(p, smem); break;
#endif
#if !defined(ONLY) || ONLY == 6
    case 6:
      for (int item = blockIdx.x; item < 512; item += gridDim.x) mlstm_out_item(p, item, smem);
      break;
#endif
#if !defined(ONLY) || ONLY == 7
    case 7:
#pragma unroll 1
      for (int step = 0; step < 2; ++step) {
        if (((step ^ (int)blockIdx.x) & 1) == 0) {
          gemm_dense((const bf16_t*)(p.ws + O_HA), (const bf16_t*)(p.ws + O_WOUT), NTOK, 1024, 1024, 8, 8, smem,
                     [&](int m0, int n0) {
                       return EpiRes{p.out + (size_t)m0 * 1024 + n0, p.x + (size_t)m0 * 1024 + n0, modv + (0 * 3 + (m0 >> 13)) * 6144 + 2 * 1024 + n0};
                     });
        } else {
          tconv_moe(p, 0, smem);
        }
        __syncthreads();
      }
      break;
#endif
#if !defined(ONLY) || ONLY == 8
    case 8: phase_modulate<2, false>(p, 0, 1, smem); break;
#endif
#if !defined(ONLY) || ONLY == 9
    case 9: phase_topk(p, smem); break;
#endif
#if !defined(ONLY) || ONLY == 10
    case 10: phase_moe1(p, smem); break;
#endif
#if !defined(ONLY) || ONLY == 11
    case 11: phase_moe2(p, 0, smem); break;
#endif
#if !defined(ONLY) || ONLY == 12
    case 12:
      phase_modulate<0, true>(p, 1, 0, smem);
      break;
#endif
#if !defined(ONLY) || ONLY == 13
    case 13:
      gemm_dense((const bf16_t*)(p.ws + O_HA), (const bf16_t*)(p.ws + O_GMIN), NTOK, 4096, 1024, 8, 8, smem,
                 [&](int m0, int n0) { return EpiGelu{(bf16_t*)(p.ws + O_U), (bf16_t*)(p.ws + O_GVT), m0, n0}; });
      break;
#endif
#if !defined(ONLY) || ONLY == 14
    case 14: phase_stats(p, smem); break;
#endif
#if !defined(ONLY) || ONLY == 15
    case 15: phase_spatial(p, smem); break;
#endif
#if !defined(ONLY) || ONLY == 16
    case 16:
#pragma unroll 1
      for (int step = 0; step < 2; ++step) {
        if (((step ^ (int)blockIdx.x) & 1) == 0) {
          gemm_dense((const bf16_t*)(p.ws + O_UV), (const bf16_t*)(p.ws + O_GMOUT), NTOK, 1024, 2048, 8, 8, smem,
                     [&](int m0, int n0) {
                       return EpiRes{p.out + (size_t)m0 * 1024 + n0, p.out + (size_t)m0 * 1024 + n0, modv + (1 * 3 + (m0 >> 13)) * 6144 + 2 * 1024 + n0};
                     });
        } else {
          tconv_moe(p, 1, smem);
        }
        __syncthreads();
      }
      break;
#endif
#if !defined(ONLY) || ONLY == 17
    case 17: phase_modulate<2, false>(p, 1, 1, smem); break;
#endif
#if !defined(ONLY) || ONLY == 18
    case 18: phase_topk(p, smem); break;
#endif
#if !defined(ONLY) || ONLY == 19
    case 19: phase_moe1(p, smem); break;
#endif
#if !defined(ONLY) || ONLY == 20
    case 20: phase_moe2(p, 1, smem); break;
#endif
#if !defined(ONLY) || ONLY == 21
    case 21: phase_final(p); break;
#endif
    default: break;
  }
}

#define XB_TMO      128
#define XB_XCNT(j)  (256  + 64 * (j))
#define XB_XSUB(j)  (1280 + 64 * (j))
#define XB_XGEN(j)  (2304 + 64 * (j))
#define XB_TOP      3328
#define XB_TOPGEN   3392
#define XCD_BAR_WORDS 3456
#define XB_SPIN_CAP (1u << 18)
#define LAS __attribute__((address_space(3)))
DI unsigned xb_ld(unsigned* p) { return __hip_atomic_load(p, __ATOMIC_RELAXED, __HIP_MEMORY_SCOPE_AGENT); }
DI unsigned xb_add(unsigned* p, unsigned v) { return __hip_atomic_fetch_add(p, v, __ATOMIC_RELAXED, __HIP_MEMORY_SCOPE_AGENT); }
DI unsigned xb_xcc_id() { return (unsigned)__builtin_amdgcn_s_getreg((3 << 11) | 20) & 0xFu; }
#define XB_SPIN(cond, bar) do { unsigned _sp = 0; while (cond) { __builtin_amdgcn_s_sleep(1); \
    if ((++_sp & 255u) == 0u) { if (xb_ld(&(bar)[XB_TMO])) break; if (_sp > XB_SPIN_CAP) { atomicAdd(&(bar)[XB_TMO], 1u); break; } } } } while (0)
struct XcdBarrier { unsigned* bar; unsigned x; volatile LAS unsigned* st; };
DI XcdBarrier xcd_barrier_post(unsigned* bar, volatile LAS unsigned* st) {
  XcdBarrier b; b.bar = bar; b.x = xb_xcc_id(); b.st = st;
  if (threadIdx.x == 0) st[3] = xb_add(&bar[XB_XCNT(b.x)], 1u);
  return b;
}
DI void xcd_barrier_complete(unsigned* bar, unsigned x, unsigned& nloc, unsigned& nx, unsigned& sbefore) {
  const unsigned G = gridDim.x * gridDim.y * gridDim.z;
  unsigned sum, cnt, mine, sp = 0u, sb = 0u;
  for (;;) {
    sum = 0u; cnt = 0u; mine = 0u; sb = 0u;
#pragma unroll
    for (unsigned j = 0; j < 16; ++j) { const unsigned c = xb_ld(&bar[XB_XCNT(j)]); sum += c; cnt += (c > 0u) ? 1u : 0u; mine = (j == x) ? c : mine; sb += (j < x) ? c : 0u; }
    if (sum == G) break;
    __builtin_amdgcn_s_sleep(1);
    if ((++sp & 255u) == 0u) { if (xb_ld(&bar[XB_TMO])) break; if (sp > XB_SPIN_CAP) { atomicAdd(&bar[XB_TMO], 1u); break; } }
  }
  nloc = mine > 0u ? mine : 1u; nx = cnt > 0u ? cnt : 1u; sbefore = sb;
}
DI void xcd_barrier(const XcdBarrier& b) {
  asm volatile("s_waitcnt vmcnt(0)" ::: "memory");
  __syncthreads();
  if (threadIdx.x == 0) {
    unsigned* bar = b.bar;
    __builtin_amdgcn_s_waitcnt(0);
    unsigned nloc = b.st[0], nx = b.st[1];
    if (nloc == 0u) { unsigned sbf; xcd_barrier_complete(bar, b.x, nloc, nx, sbf); b.st[0] = nloc; b.st[1] = nx; b.st[2] = sbf; }
    const unsigned old = xb_add(&bar[XB_XSUB(b.x)], 1u);
    const unsigned gen = old / nloc;
    if (old + 1u == (gen + 1u) * nloc) {
      __builtin_amdgcn_fence(__ATOMIC_RELEASE, "agent");
      asm volatile("s_waitcnt vmcnt(0)" ::: "memory");
      const unsigned og = xb_add(&bar[XB_TOP], 1u);
      const unsigned tg = og / nx;
      if (og + 1u == (tg + 1u) * nx) xb_add(&bar[XB_TOPGEN], 1u);
      else XB_SPIN(xb_ld(&bar[XB_TOPGEN]) == tg, bar);
      __builtin_amdgcn_fence(__ATOMIC_ACQUIRE, "agent");
      xb_add(&bar[XB_XGEN(b.x)], 1u);
      asm volatile("s_waitcnt vmcnt(0)" ::: "memory");
    } else {
      XB_SPIN(xb_ld(&bar[XB_XGEN(b.x)]) == gen, bar);
      __builtin_amdgcn_fence(__ATOMIC_ACQUIRE, "agent");
      asm volatile("s_waitcnt vmcnt(0)" ::: "memory");
    }
  }
  __syncthreads();
}

DI Params kargs() {
  Params P{};
#if defined(__HIP_DEVICE_COMPILE__)
  typedef const unsigned long long __attribute__((address_space(4))) CU;
  CU* q = (CU*)__builtin_amdgcn_kernarg_segment_ptr();
  asm volatile("" : "+s"(q));
#define GP(T, i) ((T*)(T __attribute__((address_space(1)))*)(q[i]))
  P.x = GP(const float, 0);
  P.c = GP(const float, 1);
  P.ctx = GP(const float, 2);
  P.c_ctx = GP(const float, 3);
  P.w_mod = GP(const float, 4);
  P.b_mod = GP(const float, 5);
  P.norm_mix_g = GP(const float, 6);
  P.norm_ffn_g = GP(const float, 7);
  P.final_norm_g = GP(const float, 8);
  P.ab_w_in = GP(const float, 9);
  P.ab_conv_w = GP(const float, 10);
  P.ab_gate_b = GP(const float, 11);
  P.ab_head_g = GP(const float, 12);
  P.ab_sink = GP(const float, 13);
  P.ab_w_out = GP(const float, 14);
  P.gm_w_in = GP(const float, 15);
  P.gm_ln_g = GP(const float, 16);
  P.gm_ln_b = GP(const float, 17);
  P.gm_w_s = GP(const float, 18);
  P.gm_b_s = GP(const float, 19);
  P.gm_w_out = GP(const float, 20);
  P.moe_w_router = GP(const float, 21);
  P.moe_w_gate = GP(const float, 22);
  P.moe_w_up = GP(const float, 23);
  P.moe_w_down = GP(const float, 24);
  P.out = GP(float, 25);
  P.ws = GP(char, 26);
#undef GP
#endif
  return P;
}
#if COOP
#ifndef REPEAT_MASK
#define REPEAT_MASK 0
#endif
__global__ void __launch_bounds__(256, 2) mega(Params p_unused) {
  __shared__ __attribute__((aligned(16))) char smem[73728 + 16];
  unsigned* xbw = (unsigned*)(smem + 73728);
  cg::grid_group grid = cg::this_grid();
  if (threadIdx.x < 4) xbw[threadIdx.x] = 0u;
  __syncthreads();
  XcdBarrier xb;
  { const Params pp = kargs(); xb = xcd_barrier_post((unsigned*)(pp.ws + O_BAR), (volatile LAS unsigned*)xbw); }
#define PHX(n) { const Params pp = kargs(); run_phase(pp, n, smem); } xcd_barrier(xb); \
  if ((REPEAT_MASK >> n) & 1) { { const Params pp = kargs(); run_phase(pp, n, smem); } xcd_barrier(xb); }
  { const Params pp = kargs(); run_phase(pp, 0, smem); }
  if (p_unused.ws == nullptr) grid.sync();
  xcd_barrier(xb);
  PHX(1) PHX(2) PHX(3) PHX(4) PHX(5) PHX(6) PHX(7) PHX(8) PHX(9) PHX(10)
  PHX(11) PHX(12) PHX(13) PHX(14) PHX(15) PHX(16) PHX(17) PHX(18) PHX(19) PHX(20)
  { const Params pp = kargs(); run_phase(pp, 21, smem); }
}
#else
__global__ void __launch_bounds__(256, 2) mega(Params p, int ph) {
  __shared__ __attribute__((aligned(16))) char smem[73728];
  run_phase(p, ph, smem);
}
#endif

extern "C" void kernel_launch(void* const* d_in, const int* in_sizes, int n_in, void* d_out, int out_size, void* d_ws,
                              size_t ws_size, hipStream_t stream) {
  (void)in_sizes; (void)n_in; (void)out_size;
  if (ws_size < WS_NEED) { fprintf(stderr, "workspace too small: %zu < %zu\n", ws_size, (size_t)WS_NEED); return; }
  static int grid_blocks = 0;
  if (!grid_blocks) {
    int dev = 0, cus = 0, per_cu = 0;
    hipGetDevice(&dev);
    hipDeviceGetAttribute(&cus, hipDeviceAttributeMultiprocessorCount, dev);
    hipOccupancyMaxActiveBlocksPerMultiprocessor(&per_cu, mega, 256, 0);
    if (per_cu < 1) per_cu = 1;
    if (per_cu > 2) per_cu = 2;
    grid_blocks = cus * per_cu;
  }
  Params p{};
  const float** f = (const float**)&p;
  for (int i = 0; i < 25; ++i) f[i] = (const float*)d_in[i];
  p.out = (float*)d_out;
  p.ws = (char*)d_ws;
#if COOP
  hipMemsetAsync((char*)d_ws + O_BAR, 0, XCD_BAR_WORDS * 4, stream);
  void* args[] = {&p};
  hipError_t e = hipLaunchCooperativeKernel((void*)mega, dim3(grid_blocks), dim3(256), args, 0, stream);
  if (e != hipSuccess) fprintf(stderr, "cooperative launch failed: %s (grid %d)\n", hipGetErrorString(e), grid_blocks);
#else
  for (int ph = 0; ph < NPHASE; ++ph) hipLaunchKernelGGL(mega, dim3(grid_blocks), dim3(256), 0, stream, p, ph);
#endif
}
```

```cpp
#include <hip/hip_runtime.h>
#include <hip/hip_cooperative_groups.h>
#include <cstdio>
namespace cg = cooperative_groups;

#define DI __device__ __forceinline__
typedef unsigned short bf16_t;
using bf16x8 = __attribute__((ext_vector_type(8))) short;
using s16x4 = __attribute__((ext_vector_type(4))) short;
using f32x16 = __attribute__((ext_vector_type(16))) float;
#define MFMA(a, b, c) __builtin_amdgcn_mfma_f32_32x32x16_bf16((a), (b), (c), 0, 0, 0)

#ifndef COOP
#define COOP 1
#endif

constexpr int DM = 1024, NBAT = 2, SEQ = 8192, NTOK = NBAT * SEQ, CTXL = 256, NROW = NTOK + NBAT * CTXL;
constexpr int PLD = 2816;
constexpr int NSTEP = 66;
constexpr float EPS = 1e-6f;

constexpr size_t al256(size_t x) { return (x + 255) & ~(size_t)255; }
constexpr size_t O_BAR = 0;
constexpr size_t O_WIN = 16384;
constexpr size_t O_WOUT = O_WIN + al256((size_t)PLD * 1024 * 2);
constexpr size_t O_GMIN = O_WOUT + al256((size_t)1024 * 1024 * 2);
constexpr size_t O_GMOUT = O_GMIN + al256((size_t)4096 * 1024 * 2);
constexpr size_t O_MGU = O_GMOUT + al256((size_t)1024 * 2048 * 2);
constexpr size_t O_MD = O_MGU + al256((size_t)16 * 2048 * 1024 * 2);
constexpr size_t O_MODV = O_MD + al256((size_t)16 * 1024 * 1024 * 2);
constexpr size_t O_HA = O_MODV + al256((size_t)2 * 3 * 6144 * 4);
constexpr size_t O_GL = O_HA + al256((size_t)NROW * 1024 * 2);
constexpr size_t O_AFF = O_GL + al256((size_t)NROW * 16 * 4);
constexpr size_t O_IDX = O_AFF + al256((size_t)32 * 8192 * 4);
constexpr size_t O_GATE = O_IDX + al256((size_t)32 * 1024 * 4);
constexpr size_t O_STATS = O_GATE + al256((size_t)32 * 1024 * 4);
constexpr size_t O_GSC = O_STATS + al256((size_t)NTOK * 16 * 4);
constexpr size_t O_MLOC = O_GSC + al256((size_t)16 * NSTEP * 4);
constexpr size_t O_DN = O_MLOC + al256((size_t)16 * NSTEP * 4);
constexpr size_t O_NST = O_DN + al256((size_t)16 * NSTEP * 128 * 4);
constexpr size_t O_MST = O_NST + al256((size_t)16 * 64 * 128 * 4);
constexpr size_t O_INV = O_MST + al256((size_t)16 * 64 * 4);
constexpr size_t O_R12 = O_INV + al256((size_t)NTOK * 16 * 4);
constexpr size_t O_P = O_R12;
constexpr size_t O_QC = O_P + al256((size_t)NROW * PLD * 2);
constexpr size_t O_KC = O_QC + al256((size_t)NTOK * 512 * 2);
constexpr size_t O_KT = O_KC + al256((size_t)NTOK * 512 * 2);
constexpr size_t O_VT = O_KT + al256((size_t)132 * 4 * 128 * 128 * 2);
constexpr size_t O_RQ = O_VT + al256((size_t)132 * 4 * 128 * 128 * 2);
constexpr size_t O_RK = O_RQ + al256((size_t)NTOK * 512 * 2);
constexpr size_t O_AVTX = O_RK + al256((size_t)NROW * 128 * 2);
constexpr size_t O_AVTC = O_AVTX + al256((size_t)4 * 64 * 8192 * 2);
constexpr size_t O_R12_END = O_AVTC + al256((size_t)4 * 64 * 256 * 2);
constexpr size_t O_HID = O_R12;
constexpr size_t O_U = O_R12;
constexpr size_t O_GVT = O_U + al256((size_t)NTOK * 2048 * 2);
static_assert(O_GVT + (size_t)NTOK * 2048 * 2 <= O_R12_END, "R12 too small");
constexpr size_t O_DC = O_R12_END;
constexpr size_t O_CST = O_DC + al256((size_t)16 * NSTEP * 16384 * 4);
constexpr size_t O_UV = O_DC;
constexpr size_t O_YE = O_DC;
constexpr size_t WS_NEED = O_CST + al256((size_t)16 * 64 * 16384 * 2);

struct Params {
  const float *x, *c, *ctx, *c_ctx, *w_mod, *b_mod, *norm_mix_g, *norm_ffn_g, *final_norm_g;
  const float *ab_w_in, *ab_conv_w, *ab_gate_b, *ab_head_g, *ab_sink, *ab_w_out;
  const float *gm_w_in, *gm_ln_g, *gm_ln_b, *gm_w_s, *gm_b_s, *gm_w_out;
  const float *moe_w_router, *moe_w_gate, *moe_w_up, *moe_w_down;
  float* out;
  char* ws;
};

DI bf16_t f2bf(float x) { unsigned u = __float_as_uint(x); u += 0x7fffu + ((u >> 16) & 1u); return (bf16_t)(u >> 16); }
DI float bf2f(bf16_t b) { return __uint_as_float(((unsigned)b) << 16); }
DI unsigned pack2(float a, float b) { return (unsigned)f2bf(a) | ((unsigned)f2bf(b) << 16); }
DI bf16x8 pack8(float a0, float a1, float a2, float a3, float a4, float a5, float a6, float a7) {
  uint4 u; u.x = pack2(a0, a1); u.y = pack2(a2, a3); u.z = pack2(a4, a5); u.w = pack2(a6, a7);
  return __builtin_bit_cast(bf16x8, u);
}
DI bf16x8 ldfrag(const bf16_t* p) { return *(const bf16x8*)p; }
DI bf16x8 ldfrag2(const bf16_t* p0, const bf16_t* p1) {
  s16x4 lo = *(const s16x4*)p0, hi = *(const s16x4*)p1;
  return __builtin_shufflevector(lo, hi, 0, 1, 2, 3, 4, 5, 6, 7);
}
DI int crow(int i, int hh) { return (i & 3) + 8 * (i >> 2) + 4 * hh; }
DI float siluf(float x) { return x / (1.f + __expf(-x)); }
DI float sigmf(float x) { return 1.f / (1.f + __expf(-x)); }
DI float logsigf(float x) { return fminf(x, 0.f) - log1pf(expf(-fabsf(x))); }
DI float geluf(float x) {
  const float u2 = 1.5957691216057308f * (x + 0.044715f * x * x * x);
  return x / (1.f + __expf(-u2));
}
DI float wsum(float v) {
#pragma unroll
  for (int o = 32; o > 0; o >>= 1) v += __shfl_xor(v, o);
  return v;
}
DI int tid() { int t = threadIdx.x; asm volatile("" : "+v"(t)); return t; }
DI f32x16 fzero() { f32x16 z; for (int i = 0; i < 16; ++i) z[i] = 0.f; return z; }

DI int tmap(int kind, int n) {
  if (kind == 0) return n;
  if (kind == 1) return n < 2048 ? n : (n < 2064 ? -1 : n - 16);
  int r = (n >> 6) * 128 + ((n >> 5) & 1) * 64 + (n & 31);
  return kind == 2 ? r : r + 32;
}
DI void tconv(const float* __restrict__ src, int ldn, int ncols, int K, int nmat, size_t sstride,
              bf16_t* __restrict__ dst, size_t dstride, int kind, char* smem) {
  float* sm = (float*)smem;
  const int t = tid();
  const int ntn = (ncols + 63) >> 6, ntk = K >> 6, per = ntn * ntk, total = per * nmat;
  const int c4 = t & 15, rr = t >> 4;
  float4 v0, v1, v2, v3;
#define TC_LOAD(tile_) { const int mat_ = (tile_) / per, tt_ = (tile_) % per; const int k0_ = (tt_ / ntn) * 64, n_ = (tt_ % ntn) * 64 + c4 * 4; \
    const float* s_ = src + (size_t)mat_ * sstride + (size_t)(k0_ + rr) * ldn + n_; \
    if (n_ < ncols) { v0 = *(const float4*)(s_); v1 = *(const float4*)(s_ + (size_t)16 * ldn); v2 = *(const float4*)(s_ + (size_t)32 * ldn); v3 = *(const float4*)(s_ + (size_t)48 * ldn); } \
    else { v0 = v1 = v2 = v3 = make_float4(0.f, 0.f, 0.f, 0.f); } }
  int tile = blockIdx.x;
  if (tile < total) TC_LOAD(tile)
  for (; tile < total; tile += gridDim.x) {
    const int mat = tile / per, tt = tile % per;
    const int k0 = (tt / ntn) * 64, n0 = (tt % ntn) * 64;
    bf16_t* d = dst + (size_t)mat * dstride;
    {
      float* q = sm + rr * 65 + c4 * 4;
      q[0] = v0.x; q[1] = v0.y; q[2] = v0.z; q[3] = v0.w;
      q[16 * 65 + 0] = v1.x; q[16 * 65 + 1] = v1.y; q[16 * 65 + 2] = v1.z; q[16 * 65 + 3] = v1.w;
      q[32 * 65 + 0] = v2.x; q[32 * 65 + 1] = v2.y; q[32 * 65 + 2] = v2.z; q[32 * 65 + 3] = v2.w;
      q[48 * 65 + 0] = v3.x; q[48 * 65 + 1] = v3.y; q[48 * 65 + 2] = v3.z; q[48 * 65 + 3] = v3.w;
    }
    if (tile + (int)gridDim.x < total) TC_LOAD(tile + (int)gridDim.x)
    __syncthreads();
    const int nl = t >> 2, kq = t & 3, n = n0 + nl;
    if (n < ncols) {
      const int row = tmap(kind, n);
      if (row >= 0) {
        uint4 o0, o1;
        const float* q = sm + (kq * 16) * 65 + nl;
        o0.x = pack2(q[0 * 65], q[1 * 65]); o0.y = pack2(q[2 * 65], q[3 * 65]); o0.z = pack2(q[4 * 65], q[5 * 65]); o0.w = pack2(q[6 * 65], q[7 * 65]);
        o1.x = pack2(q[8 * 65], q[9 * 65]); o1.y = pack2(q[10 * 65], q[11 * 65]); o1.z = pack2(q[12 * 65], q[13 * 65]); o1.w = pack2(q[14 * 65], q[15 * 65]);
        uint4* dp = (uint4*)(d + (size_t)row * K + k0 + kq * 16);
        dp[0] = o0; dp[1] = o1;
      }
    }
    __syncthreads();
  }
#undef TC_LOAD
}
DI void tconv_moe(const Params& p, int layer, char* smem) {
  const size_t wo = (size_t)layer * 16 * 1024 * 1024;
  tconv(p.moe_w_gate + wo, 1024, 1024, 1024, 16, (size_t)1024 * 1024, (bf16_t*)(p.ws + O_MGU), (size_t)2048 * 1024, 2, smem);
  tconv(p.moe_w_up + wo, 1024, 1024, 1024, 16, (size_t)1024 * 1024, (bf16_t*)(p.ws + O_MGU), (size_t)2048 * 1024, 3, smem);
  tconv(p.moe_w_down + wo, 1024, 1024, 1024, 16, (size_t)1024 * 1024, (bf16_t*)(p.ws + O_MD), (size_t)1024 * 1024, 0, smem);
}

DI void phase_adaln(const Params& p, char* smem) {
  float* sv = (float*)smem;
  float* red = sv + 3 * 1024;
  float* modv = (float*)(p.ws + O_MODV);
  const int t = tid();
  if (blockIdx.x >= 192) return;
  for (int i = t; i < 3 * 1024; i += 256) {
    const int v = i >> 10, k = i & 1023;
    const float cv = v < 2 ? p.c[v * 1024 + k] : p.c_ctx[k];
    sv[i] = siluf(cv);
  }
  __syncthreads();
  for (int item = blockIdx.x; item < 192; item += gridDim.x) {
    const int l = item / 96, cb = item % 96;
    const int cq = t & 15, kg = t >> 4;
    const float* w = p.w_mod + (size_t)l * 1024 * 6144 + cb * 64 + cq * 4;
    float a0[4] = {0.f, 0.f, 0.f, 0.f}, a1[4] = {0.f, 0.f, 0.f, 0.f}, a2[4] = {0.f, 0.f, 0.f, 0.f};
    for (int i = 0; i < 64; ++i) {
      const int k = kg + 16 * i;
      const float4 wv = *(const float4*)(w + (size_t)k * 6144);
      const float s0 = sv[k], s1 = sv[1024 + k], s2 = sv[2048 + k];
      a0[0] += s0 * wv.x; a0[1] += s0 * wv.y; a0[2] += s0 * wv.z; a0[3] += s0 * wv.w;
      a1[0] += s1 * wv.x; a1[1] += s1 * wv.y; a1[2] += s1 * wv.z; a1[3] += s1 * wv.w;
      a2[0] += s2 * wv.x; a2[1] += s2 * wv.y; a2[2] += s2 * wv.z; a2[3] += s2 * wv.w;
    }
#pragma unroll
    for (int j = 0; j < 4; ++j) {
      red[(kg * 3 + 0) * 64 + cq * 4 + j] = a0[j];
      red[(kg * 3 + 1) * 64 + cq * 4 + j] = a1[j];
      red[(kg * 3 + 2) * 64 + cq * 4 + j] = a2[j];
    }
    __syncthreads();
    if (t < 192) {
      const int v = t >> 6, col = t & 63;
      float s = 0.f;
      for (int g = 0; g < 16; ++g) s += red[(g * 3 + v) * 64 + col];
      const int cc = cb * 64 + col;
      modv[(l * 3 + v) * 6144 + cc] = s + p.b_mod[l * 6144 + cc];
    }
    __syncthreads();
  }
}

DI void moe_combine_row(const Params& p, int row, int lane, float4 (&acc)[4]) {
  const int* INV = (const int*)(p.ws + O_INV); const float* GATE = (const float*)(p.ws + O_GATE);
  const bf16_t* YE = (const bf16_t*)(p.ws + O_YE);
  const int b = row >> 13;
  const int myslot = INV[(size_t)row * 16 + (lane & 15)];
#pragma unroll
  for (int i = 0; i < 4; ++i) acc[i] = make_float4(0.f, 0.f, 0.f, 0.f);
#pragma unroll 1
  for (int e = 0; e < 16; ++e) {
    const int slot = __builtin_amdgcn_readlane(myslot, e);
    if (slot != 0) {
      const int be = b * 16 + e;
      const float g = GATE[be * 1024 + slot - 1];
      const bf16_t* yr = YE + ((size_t)be * 1024 + slot - 1) * 1024;
#pragma unroll
      for (int i = 0; i < 4; ++i) {
        const s16x4 v = *(const s16x4*)(yr + (i * 64 + lane) * 4);
        acc[i].x += g * bf2f((bf16_t)v[0]); acc[i].y += g * bf2f((bf16_t)v[1]); acc[i].z += g * bf2f((bf16_t)v[2]); acc[i].w += g * bf2f((bf16_t)v[3]);
      }
    }
  }
}

template <int MODE, bool COMB>
DI void phase_modulate(const Params& p, int layer, int which, char* smem) {
  float* wt = (float*)smem;
  const int t = tid(), lane = t & 63, w = t >> 6;
  const float* modv = (const float*)(p.ws + O_MODV);
  bf16_t* HA = (bf16_t*)(p.ws + O_HA);
  if (MODE != 0) {
    const float* W = MODE == 1 ? p.ab_w_in + 2048 : p.moe_w_router + (size_t)layer * 1024 * 16;
    const int ld = MODE == 1 ? 2832 : 16;
    for (int i = t; i < 4096; i += 256) {
      const int k = i >> 2, e4 = i & 3;
      const float4 v = *(const float4*)(W + (size_t)k * ld + e4 * 4);
      wt[(e4 * 4 + 0) * 1024 + k] = v.x; wt[(e4 * 4 + 1) * 1024 + k] = v.y; wt[(e4 * 4 + 2) * 1024 + k] = v.z; wt[(e4 * 4 + 3) * 1024 + k] = v.w;
    }
    __syncthreads();
  }
  const float* gn = (which == 0 ? p.norm_mix_g : p.norm_ffn_g) + layer * 1024;
  const int nrows = MODE == 1 ? NROW : NTOK;
  const int rstride = gridDim.x * 4;
  float4 nx[4];
#define MOD_SRC(row_) (MODE == 1 ? ((row_) < NTOK ? p.x + (size_t)(row_) * 1024 : p.ctx + (size_t)((row_) - NTOK) * 1024) : p.out + (size_t)(row_) * 1024)
  {
    const int row0_ = blockIdx.x * 4 + w;
    if (row0_ < nrows) {
      const float* s0_ = MOD_SRC(row0_);
#pragma unroll
      for (int i = 0; i < 4; ++i) nx[i] = *(const float4*)(s0_ + (i * 64 + lane) * 4);
    }
  }
  for (int row = blockIdx.x * 4 + w; row < nrows; row += rstride) {
    const int v = (MODE == 1 && row >= NTOK) ? 2 : (row >> 13);
    const float* sh = modv + (layer * 3 + v) * 6144 + (which ? 3 : 0) * 1024;
    const float* sc = sh + 1024;
    float4 xv[4];
    float ss = 0.f;
#pragma unroll
    for (int i = 0; i < 4; ++i) xv[i] = nx[i];
    if (row + rstride < nrows) {
      const float* s1_ = MOD_SRC(row + rstride);
#pragma unroll
      for (int i = 0; i < 4; ++i) nx[i] = *(const float4*)(s1_ + (i * 64 + lane) * 4);
    }
    if (COMB) {
      float4 ca[4];
      moe_combine_row(p, row, lane, ca);
      const float* g2 = modv + ((layer - 1) * 3 + v) * 6144 + 5 * 1024;
#pragma unroll
      for (int i = 0; i < 4; ++i) {
        const float4 gg = *(const float4*)(g2 + (i * 64 + lane) * 4);
        xv[i].x += gg.x * ca[i].x; xv[i].y += gg.y * ca[i].y; xv[i].z += gg.z * ca[i].z; xv[i].w += gg.w * ca[i].w;
        *(float4*)(p.out + (size_t)row * 1024 + (i * 64 + lane) * 4) = xv[i];
      }
    }
#pragma unroll
    for (int i = 0; i < 4; ++i) ss += xv[i].x * xv[i].x + xv[i].y * xv[i].y + xv[i].z * xv[i].z + xv[i].w * xv[i].w;
    ss = wsum(ss);
    const float rstd = rsqrtf(ss * (1.f / 1024.f) + EPS);
    float4 yv[4];
#pragma unroll
    for (int i = 0; i < 4; ++i) {
      const int col = (i * 64 + lane) * 4;
      const float4 g4 = *(const float4*)(gn + col), s4 = *(const float4*)(sh + col), c4 = *(const float4*)(sc + col);
      float4 y;
      y.x = xv[i].x * rstd * g4.x * (1.f + c4.x) + s4.x;
      y.y = xv[i].y * rstd * g4.y * (1.f + c4.y) + s4.y;
      y.z = xv[i].z * rstd * g4.z * (1.f + c4.z) + s4.z;
      y.w = xv[i].w * rstd * g4.w * (1.f + c4.w) + s4.w;
      yv[i] = y;
      uint2 o; o.x = pack2(y.x, y.y); o.y = pack2(y.z, y.w);
      *(uint2*)(HA + (size_t)row * 1024 + col) = o;
    }
    if (MODE != 0) {
      float mine = 0.f;
#pragma unroll 1
      for (int e4 = 0; e4 < 16; e4 += 4) {
        float pe0 = 0.f, pe1 = 0.f, pe2 = 0.f, pe3 = 0.f;
#pragma unroll
        for (int i = 0; i < 4; ++i) {
          const float* wp = wt + e4 * 1024 + (i * 64 + lane) * 4;
          const float4 wa = *(const float4*)(wp), wb = *(const float4*)(wp + 1024), wc = *(const float4*)(wp + 2048), wd = *(const float4*)(wp + 3072);
          pe0 += yv[i].x * wa.x + yv[i].y * wa.y + yv[i].z * wa.z + yv[i].w * wa.w;
          pe1 += yv[i].x * wb.x + yv[i].y * wb.y + yv[i].z * wb.z + yv[i].w * wb.w;
          pe2 += yv[i].x * wc.x + yv[i].y * wc.y + yv[i].z * wc.z + yv[i].w * wc.w;
          pe3 += yv[i].x * wd.x + yv[i].y * wd.y + yv[i].z * wd.z + yv[i].w * wd.w;
        }
#pragma unroll
        for (int o = 32; o > 0; o >>= 1) {
          const float q0 = __shfl_xor(pe0, o), q1 = __shfl_xor(pe1, o), q2 = __shfl_xor(pe2, o), q3 = __shfl_xor(pe3, o);
          pe0 += q0; pe1 += q1; pe2 += q2; pe3 += q3;
        }
        const int el = (lane & 15) - e4;
        mine = el == 0 ? pe0 : (el == 1 ? pe1 : (el == 2 ? pe2 : (el == 3 ? pe3 : mine)));
      }
      const int e = lane & 15;
      if (MODE == 1) {
        float val = mine + p.ab_gate_b[e];
        if (((e >> 2) & 1) == 1) val = logsigf(val);
        if (lane < 16) ((float*)(p.ws + O_GL))[(size_t)row * 16 + lane] = val;
      } else {
        float mx = mine;
#pragma unroll
        for (int o = 8; o > 0; o >>= 1) mx = fmaxf(mx, __shfl_xor(mx, o));
        const float ex = expf(mine - mx);
        float sum = ex;
#pragma unroll
        for (int o = 8; o > 0; o >>= 1) sum += __shfl_xor(sum, o);
        if (lane < 16) ((float*)(p.ws + O_AFF))[((size_t)(row >> 13) * 16 + lane) * 8192 + (row & 8191)] = ex / sum;
        if (lane < 16) ((int*)(p.ws + O_INV))[(size_t)row * 16 + lane] = 0;
      }
    }
  }
}

template <bool DENSEA, class Epi>
DI void gemm_tile(const bf16_t* Abase, const unsigned (&aoff)[8], const bf16_t* Bbase, unsigned boff, int K, char* smem, Epi&& epi) {
  bf16_t* sA = (bf16_t*)smem;
  bf16_t* sB = sA + 256 * 72;
  const int t = tid(), lane = t & 63, w = t >> 6, wm = w >> 1, wn = w & 1, r = lane & 31, hh = lane >> 5;
  const int lrow = t >> 3, lcol = (t & 7) * 8;
  const unsigned bst = 32u * (unsigned)K;
  f32x16 acc[4][2];
#pragma unroll
  for (int i = 0; i < 4; ++i) { acc[i][0] = fzero(); acc[i][1] = fzero(); }
  uint4 A0, A1, A2, A3, A4, A5, A6, A7, B0, B1, B2, B3;
#define GLOADT(kn_) { \
    const bf16_t* Ak_ = Abase + (kn_); const bf16_t* Bk_ = Bbase + (kn_);     \
    if (DENSEA) { \
      A0 = *(const uint4*)(Ak_ + aoff[0]); A1 = *(const uint4*)((Ak_ + bst) + aoff[0]); A2 = *(const uint4*)((Ak_ + 2 * bst) + aoff[0]); A3 = *(const uint4*)((Ak_ + 3 * bst) + aoff[0]); \
      A4 = *(const uint4*)((Ak_ + 4 * bst) + aoff[0]); A5 = *(const uint4*)((Ak_ + 5 * bst) + aoff[0]); A6 = *(const uint4*)((Ak_ + 6 * bst) + aoff[0]); A7 = *(const uint4*)((Ak_ + 7 * bst) + aoff[0]); \
    } else { \
      A0 = *(const uint4*)(Ak_ + aoff[0]); A1 = *(const uint4*)(Ak_ + aoff[1]); A2 = *(const uint4*)(Ak_ + aoff[2]); A3 = *(const uint4*)(Ak_ + aoff[3]); \
      A4 = *(const uint4*)(Ak_ + aoff[4]); A5 = *(const uint4*)(Ak_ + aoff[5]); A6 = *(const uint4*)(Ak_ + aoff[6]); A7 = *(const uint4*)(Ak_ + aoff[7]); \
    } \
    B0 = *(const uint4*)(Bk_ + boff); B1 = *(const uint4*)((Bk_ + bst) + boff); B2 = *(const uint4*)((Bk_ + 2 * bst) + boff); B3 = *(const uint4*)((Bk_ + 3 * bst) + boff); }
  GLOADT(0)
  const int so = lrow * 72 + lcol;
  const bf16_t* cA = sA + (wm * 128 + r) * 72 + hh * 8;
  const bf16_t* cB = sB + (wn * 64 + r) * 72 + hh * 8;
  const int KT = K >> 6;
  for (int kt = 0; kt < KT; ++kt) {
    __syncthreads();
    *(uint4*)(sA + so) = A0; *(uint4*)(sA + so + 32 * 72) = A1; *(uint4*)(sA + so + 64 * 72) = A2; *(uint4*)(sA + so + 96 * 72) = A3;
    *(uint4*)(sA + so + 128 * 72) = A4; *(uint4*)(sA + so + 160 * 72) = A5; *(uint4*)(sA + so + 192 * 72) = A6; *(uint4*)(sA + so + 224 * 72) = A7;
    *(uint4*)(sB + so) = B0; *(uint4*)(sB + so + 32 * 72) = B1; *(uint4*)(sB + so + 64 * 72) = B2; *(uint4*)(sB + so + 96 * 72) = B3;
    { const int kn = (kt + 1 < KT ? kt + 1 : kt) * 64; GLOADT(kn) }
    __builtin_amdgcn_sched_barrier(0);
    __syncthreads();
    __builtin_amdgcn_sched_barrier(0);
    __builtin_amdgcn_s_setprio(1);
#pragma unroll
    for (int ks = 0; ks < 4; ++ks) {
      const bf16x8 b0 = *(const bf16x8*)(cB + ks * 16), b1 = *(const bf16x8*)(cB + 32 * 72 + ks * 16);
#pragma unroll
      for (int mi = 0; mi < 4; ++mi) {
        const bf16x8 a = *(const bf16x8*)(cA + mi * 32 * 72 + ks * 16);
        acc[mi][0] = MFMA(a, b0, acc[mi][0]);
        acc[mi][1] = MFMA(a, b1, acc[mi][1]);
      }
      if (ks == 1) __builtin_amdgcn_sched_barrier(0);
    }
    __builtin_amdgcn_s_setprio(0);
    __builtin_amdgcn_sched_barrier(0);
  }
#undef GLOADT
  epi(acc, wm * 128, wn * 64, r, hh);
}

struct TileWalk {
  int L, Lend, nl;
  DI TileWalk(int T, const char* smem) {
    const volatile unsigned* xw = (const volatile unsigned*)(smem + 73728);
    const int nloc = (int)xw[0], sb = (int)xw[2], rk = (int)xw[3];
    int G = (int)gridDim.x;
    asm volatile("" : "+s"(G));
    nl = nloc;
    L = (T * sb) / G + rk; Lend = (T * (sb + nloc)) / G;
  }
  DI bool valid() const { return L < Lend; }
  DI void next() { L += nl; }
  DI void get(int SM, int SN, int nsn, int& mt, int& nt) const {
    const int s = L / (SM * SN), wi = L % (SM * SN);
    mt = (s / nsn) * SM + wi / SN; nt = (s % nsn) * SN + wi % SN;
  }
};

template <class MakeEpi>
DI void gemm_dense(const bf16_t* A, const bf16_t* Bt, int M, int N, int K, int SM, int SN, char* smem, MakeEpi&& mk) {
  const int t = tid(), lrow = t >> 3, lcol = (t & 7) * 8;
  const int ntn = N >> 7, ntm = M >> 8;
  for (TileWalk tw(ntn * ntm, smem); tw.valid(); tw.next()) {
    int mt, nt; tw.get(SM, SN, ntn / SN, mt, nt);
    unsigned aoff[8];
#pragma unroll
    for (int i = 0; i < 8; ++i) aoff[i] = (unsigned)(lrow + 32 * i) * (unsigned)K + (unsigned)lcol;
    gemm_tile<true>(A + (size_t)mt * 256 * K, aoff, Bt + (size_t)(nt * 128) * K, (unsigned)lrow * (unsigned)K + (unsigned)lcol, K, smem, mk(mt * 256, nt * 128));
  }
}

DI void phase_prep2(const Params& p, char* smem) {
  bf16_t* T = (bf16_t*)smem;
  const bf16_t* P = (const bf16_t*)(p.ws + O_P);
  bf16_t* Qc = (bf16_t*)(p.ws + O_QC); bf16_t* Kc = (bf16_t*)(p.ws + O_KC);
  bf16_t* KT = (bf16_t*)(p.ws + O_KT); bf16_t* VT = (bf16_t*)(p.ws + O_VT);
  bf16_t* RQ = (bf16_t*)(p.ws + O_RQ); bf16_t* RK = (bf16_t*)(p.ws + O_RK);
  bf16_t* AVTX = (bf16_t*)(p.ws + O_AVTX); bf16_t* AVTC = (bf16_t*)(p.ws + O_AVTC);
  const int t = tid();
  for (int item = blockIdx.x; item < 132 * 6; item += gridDim.x) {
    const int sc = item / 6, part = item % 6;
    const bool isx = sc < 128;
    const int row0 = sc * 128;
    const int seq_lo = isx ? (sc >> 6) * 8192 : NTOK + ((sc - 128) >> 1) * 256;
    const int seq_hi = seq_lo + (isx ? 8192 : 256);
    if (part < 4) {
      const int h = part;
      const int col8 = t & 15, rsub = t >> 4;
      for (int pass = 0; pass < 3; ++pass) {
        if (pass == 2 && !isx) break;
        const int pcol = (pass == 0 ? 512 : (pass == 1 ? 1024 : 0)) + h * 128 + col8 * 8;
        float cw[5][8];
        if (pass != 1) {
#pragma unroll
          for (int j = 0; j < 5; ++j)
#pragma unroll
            for (int e = 0; e < 8; ++e) cw[j][e] = p.ab_conv_w[j * 1024 + (pass == 0 ? 512 : 0) + h * 128 + col8 * 8 + e];
        }
        for (int i = 0; i < 8; ++i) {
          const int rl = rsub + 16 * i, row = row0 + rl;
          uint4 o;
          if (pass == 1) {
            o = *(const uint4*)(P + (size_t)row * PLD + pcol);
          } else {
            float a[8];
#pragma unroll
            for (int e = 0; e < 8; ++e) a[e] = 0.f;
#pragma unroll
            for (int j = 0; j < 5; ++j) {
              const int rr = row + j - 2;
              if (rr >= seq_lo && rr < seq_hi) {
                const bf16x8 v = *(const bf16x8*)(P + (size_t)rr * PLD + pcol);
#pragma unroll
                for (int e = 0; e < 8; ++e) a[e] += cw[j][e] * bf2f((bf16_t)v[e]);
              }
            }
            const float scl = pass == 0 ? 0.08838834764831845f : 1.f;
#pragma unroll
            for (int e = 0; e < 8; ++e) a[e] = siluf(a[e]) * scl;
            o.x = pack2(a[0], a[1]); o.y = pack2(a[2], a[3]); o.z = pack2(a[4], a[5]); o.w = pack2(a[6], a[7]);
            if (isx) *(uint4*)((pass == 0 ? Kc : Qc) + (size_t)row * 512 + h * 128 + col8 * 8) = o;
          }
          if (pass < 2) *(uint4*)(T + rl * 136 + col8 * 8) = o;
        }
        if (pass < 2) {
          __syncthreads();
          bf16_t* dstT = (pass == 0 ? KT : VT) + (size_t)(sc * 4 + h) * 16384;
          const int d = t & 127, shf = t >> 7;
#pragma unroll
          for (int s8 = 0; s8 < 8; ++s8) {
            const bf16_t* q = T + (shf * 64 + s8 * 8) * 136 + d;
            uint4 o;
            o.x = (unsigned)q[0] | ((unsigned)q[136] << 16); o.y = (unsigned)q[2 * 136] | ((unsigned)q[3 * 136] << 16);
            o.z = (unsigned)q[4 * 136] | ((unsigned)q[5 * 136] << 16); o.w = (unsigned)q[6 * 136] | ((unsigned)q[7 * 136] << 16);
            *(uint4*)(dstT + d * 128 + shf * 64 + s8 * 8) = o;
          }
          __syncthreads();
        }
      }
    } else if (part == 4) {
      if (!isx) continue;
      for (int idx = t; idx < 512; idx += 256) {
        const int rl = idx >> 2, dc = idx & 3, row = row0 + rl, pos = row - seq_lo;
        const float rp = (float)(pos >> 6), cp = (float)(pos & 63);
        float cs[8], sn[8];
#pragma unroll
        for (int e = 0; e < 8; ++e) {
          const int a = dc * 8 + e;
          const float inv = powf(10000.f, -(float)(a & 15) / 16.f);
          const float ang = (a < 16 ? rp : cp) * inv;
          cs[e] = cosf(ang); sn[e] = sinf(ang);
        }
        for (int hq = 0; hq < 8; ++hq) {
          const bf16x8 x1 = *(const bf16x8*)(P + (size_t)row * PLD + 2048 + hq * 64 + dc * 8);
          const bf16x8 x2 = *(const bf16x8*)(P + (size_t)row * PLD + 2048 + hq * 64 + 32 + dc * 8);
          float o1[8], o2[8];
#pragma unroll
          for (int e = 0; e < 8; ++e) {
            const float a = bf2f((bf16_t)x1[e]), b = bf2f((bf16_t)x2[e]);
            o1[e] = (a * cs[e] - b * sn[e]) * 0.125f; o2[e] = (b * cs[e] + a * sn[e]) * 0.125f;
          }
          uint4 u1, u2;
          u1.x = pack2(o1[0], o1[1]); u1.y = pack2(o1[2], o1[3]); u1.z = pack2(o1[4], o1[5]); u1.w = pack2(o1[6], o1[7]);
          u2.x = pack2(o2[0], o2[1]); u2.y = pack2(o2[2], o2[3]); u2.z = pack2(o2[4], o2[5]); u2.w = pack2(o2[6], o2[7]);
          *(uint4*)(RQ + (size_t)row * 512 + hq * 64 + dc * 8) = u1;
          *(uint4*)(RQ + (size_t)row * 512 + hq * 64 + 32 + dc * 8) = u2;
        }
      }
    } else {
      for (int idx = t; idx < 512; idx += 256) {
        const int rl = idx >> 2, dc = idx & 3, row = row0 + rl, pos = row - seq_lo;
        const float rp = (float)(pos >> 6), cp = (float)(pos & 63);
        float cs[8], sn[8];
#pragma unroll
        for (int e = 0; e < 8; ++e) {
          const int a = dc * 8 + e;
          const float inv = powf(10000.f, -(float)(a & 15) / 16.f);
          const float ang = (a < 16 ? rp : cp) * inv;
          cs[e] = isx ? cosf(ang) : 1.f; sn[e] = isx ? sinf(ang) : 0.f;
        }
        for (int g = 0; g < 2; ++g) {
          const bf16x8 x1 = *(const bf16x8*)(P + (size_t)row * PLD + 2560 + g * 64 + dc * 8);
          const bf16x8 x2 = *(const bf16x8*)(P + (size_t)row * PLD + 2560 + g * 64 + 32 + dc * 8);
          float o1[8], o2[8];
#pragma unroll
          for (int e = 0; e < 8; ++e) {
            const float a = bf2f((bf16_t)x1[e]), b = bf2f((bf16_t)x2[e]);
            o1[e] = a * cs[e] - b * sn[e]; o2[e] = b * cs[e] + a * sn[e];
          }
          uint4 u1, u2;
          u1.x = pack2(o1[0], o1[1]); u1.y = pack2(o1[2], o1[3]); u1.z = pack2(o1[4], o1[5]); u1.w = pack2(o1[6], o1[7]);
          u2.x = pack2(o2[0], o2[1]); u2.y = pack2(o2[2], o2[3]); u2.z = pack2(o2[4], o2[5]); u2.w = pack2(o2[6], o2[7]);
          *(uint4*)(RK + (size_t)row * 128 + g * 64 + dc * 8) = u1;
          *(uint4*)(RK + (size_t)row * 128 + g * 64 + 32 + dc * 8) = u2;
        }
      }
      {
        const int col8 = t & 15, rsub = t >> 4;
        for (int i = 0; i < 8; ++i) {
          const int rl = rsub + 16 * i;
          *(uint4*)(T + rl * 136 + col8 * 8) = *(const uint4*)(P + (size_t)(row0 + rl) * PLD + 2688 + col8 * 8);
        }
        __syncthreads();
        const int d = t & 127, shf = t >> 7;
        const int b = isx ? (sc >> 6) : ((sc - 128) >> 1);
        const int pos0 = row0 - seq_lo;
        bf16_t* dst = isx ? AVTX + ((size_t)(b * 2 + (d >> 6)) * 64 + (d & 63)) * 8192 + pos0
                          : AVTC + ((size_t)(b * 2 + (d >> 6)) * 64 + (d & 63)) * 256 + pos0;
#pragma unroll
        for (int s8 = 0; s8 < 8; ++s8) {
          const bf16_t* q = T + (shf * 64 + s8 * 8) * 136 + d;
          uint4 o;
          o.x = (unsigned)q[0] | ((unsigned)q[136] << 16); o.y = (unsigned)q[2 * 136] | ((unsigned)q[3 * 136] << 16);
          o.z = (unsigned)q[4 * 136] | ((unsigned)q[5 * 136] << 16); o.w = (unsigned)q[6 * 136] | ((unsigned)q[7 * 136] << 16);
          *(uint4*)(dst + shf * 64 + s8 * 8) = o;
        }
        __syncthreads();
      }
    }
  }
}

DI void attn_item(const Params& p, int item, char* smem) {
  const int g = item & 1, qb = (item >> 1) & 255, b = item >> 9;
  int t_ = tid();
  asm volatile("" : "+v"(t_));
  const int t = t_, lane = t & 63, w = t >> 6, r = lane & 31, hh = lane >> 5;
  const int hq = g * 4 + w, q0 = qb * 32;
  const bf16_t* RQ = (const bf16_t*)(p.ws + O_RQ); const bf16_t* RK = (const bf16_t*)(p.ws + O_RK);
  const bf16_t* AVTX = (const bf16_t*)(p.ws + O_AVTX); const bf16_t* AVTC = (const bf16_t*)(p.ws + O_AVTC);
  bf16_t* MIX = (bf16_t*)(p.ws + O_HA);
  const size_t qrow = (size_t)b * 8192 + q0 + r;
  bf16x8 qf[4];
#pragma unroll
  for (int ks = 0; ks < 4; ++ks) qf[ks] = ldfrag(RQ + qrow * 512 + hq * 64 + ks * 16 + hh * 8);
  float m = p.ab_sink[hq], l = hh == 0 ? 1.f : 0.f;
  f32x16 o0 = fzero(), o1 = fzero();
  const int ipos = q0 + r;
  const int lo = q0 - 128 < 0 ? 0 : q0 - 128, hi = q0 + 128 > 8192 - 32 ? 8192 - 32 : q0 + 128;
  const int nloc = ((hi - lo) >> 5) + 1, ntile = nloc + 8;
  bf16_t* sKt = (bf16_t*)smem;
  bf16_t* sVt = sKt + 2 * 32 * 72;
  const bf16_t* kloc = RK + (size_t)(b * 8192) * 128 + g * 64 + (t >> 3) * 128 + (t & 7) * 8;
  const bf16_t* kctx = RK + (size_t)(NTOK + b * 256) * 128 + g * 64 + (t >> 3) * 128 + (t & 7) * 8;
  const bf16_t* vloc = AVTX + (size_t)((b * 2 + g) * 64 + (t >> 2)) * 8192 + (t & 3) * 8;
  const bf16_t* vctx = AVTC + (size_t)((b * 2 + g) * 64 + (t >> 2)) * 256 + (t & 3) * 8;
  const int skoff = (t >> 3) * 72 + (t & 7) * 8, svoff = (t >> 2) * 40 + (t & 3) * 8;
  uint4 gk, gv;
#define ATT_LOAD(j_) { const bool loc_ = (j_) < nloc; const int k0_ = loc_ ? lo + (j_) * 32 : ((j_) - nloc) * 32; \
    gk = *(const uint4*)((loc_ ? kloc : kctx) + (size_t)k0_ * 128); gv = *(const uint4*)((loc_ ? vloc : vctx) + k0_); }
  ATT_LOAD(0)
  __syncthreads();
  *(uint4*)(sKt + skoff) = gk; *(uint4*)(sVt + svoff) = gv;
  __syncthreads();
#pragma unroll 1
  for (int tile = 0; tile < ntile; ++tile) {
    const int cur = tile & 1;
    if (tile + 1 < ntile) ATT_LOAD(tile + 1)
    const bool local = tile < nloc;
    const int k0 = local ? lo + tile * 32 : (tile - nloc) * 32;
    const bf16_t* kt = sKt + cur * 32 * 72 + r * 72 + hh * 8;
    const bf16_t* vt = sVt + cur * 64 * 40 + r * 40 + 4 * hh;
    f32x16 s = fzero();
#pragma unroll
    for (int ks = 0; ks < 4; ++ks) s = MFMA(*(const bf16x8*)(kt + ks * 16), qf[ks], s);
    float tmax = -INFINITY;
#pragma unroll
    for (int i = 0; i < 16; ++i) {
      const int dj = ipos - (k0 + crow(i, hh));
      const bool ok = !local || (dj <= 128 && dj >= -128);
      s[i] = ok ? s[i] : -INFINITY;
      tmax = fmaxf(tmax, s[i]);
    }
    tmax = fmaxf(tmax, __shfl_xor(tmax, 32));
    const float mn = fmaxf(m, tmax), corr = __expf(m - mn);
    m = mn; l *= corr;
#pragma unroll
    for (int i = 0; i < 16; ++i) { o0[i] *= corr; o1[i] *= corr; }
#pragma unroll
    for (int i = 0; i < 16; ++i) { s[i] = __expf(s[i] - mn); l += s[i]; }
    const bf16x8 pf0 = pack8(s[0], s[1], s[2], s[3], s[4], s[5], s[6], s[7]);
    const bf16x8 pf1 = pack8(s[8], s[9], s[10], s[11], s[12], s[13], s[14], s[15]);
    o0 = MFMA(ldfrag2(vt, vt + 8), pf0, o0);
    o1 = MFMA(ldfrag2(vt + 32 * 40, vt + 32 * 40 + 8), pf0, o1);
    o0 = MFMA(ldfrag2(vt + 16, vt + 24), pf1, o0);
    o1 = MFMA(ldfrag2(vt + 32 * 40 + 16, vt + 32 * 40 + 24), pf1, o1);
    if (tile + 1 < ntile) { *(uint4*)(sKt + (cur ^ 1) * 32 * 72 + skoff) = gk; *(uint4*)(sVt + (cur ^ 1) * 64 * 40 + svoff) = gv; }
    __syncthreads();
  }
#undef ATT_LOAD
  l += __shfl_xor(l, 32);
  const float inv = 1.f / l;
  bf16_t* dst = MIX + qrow * 1024 + 512 + hq * 64;
#pragma unroll
  for (int q4 = 0; q4 < 4; ++q4) {
    const int d = 8 * q4 + 4 * hh;
    uint2 u;
    u.x = pack2(o0[4 * q4] * inv, o0[4 * q4 + 1] * inv); u.y = pack2(o0[4 * q4 + 2] * inv, o0[4 * q4 + 3] * inv);
    *(uint2*)(dst + d) = u;
    u.x = pack2(o1[4 * q4] * inv, o1[4 * q4 + 1] * inv); u.y = pack2(o1[4 * q4 + 2] * inv, o1[4 * q4 + 3] * inv);
    *(uint2*)(dst + 32 + d) = u;
  }
}

DI void mlstm_local_item(const Params& p, int item, char* smem) {
  float* gs = (float*)smem;
  float* wv = gs + 512;
  float* msc = wv + 256;
  int t_ = tid();
  asm volatile("" : "+v"(t_));
  const int t = t_, lane = t & 63, w = t >> 6, wm = w >> 1, wn = w & 1, r = lane & 31, hh = lane >> 5;
  const int bh = item / NSTEP, nc = item % NSTEP, b = bh >> 2, h = bh & 3;
  const int sc = nc < 2 ? 128 + b * 2 + nc : b * 64 + (nc - 2);
  const int row0 = sc * 128;
  const float* GL = (const float*)(p.ws + O_GL);
  const bf16_t* KT = (const bf16_t*)(p.ws + O_KT) + (size_t)(sc * 4 + h) * 16384;
  const bf16_t* VT = (const bf16_t*)(p.ws + O_VT) + (size_t)(sc * 4 + h) * 16384;
  char* sK = smem + 8192;
  char* sV = sK + 32768;
#pragma unroll
  for (int i = 0; i < 8; ++i) {
    const int q = t + 256 * i, row = q >> 4, cc = q & 15;
    const int so = row * 256 + ((cc ^ (row & 15)) << 4);
    *(uint4*)(sK + so) = *(const uint4*)(KT + row * 128 + cc * 8);
    *(uint4*)(sV + so) = *(const uint4*)(VT + row * 128 + cc * 8);
  }
  for (int i = t; i < 512; i += 256) { const int ty = i >> 7, s = i & 127; gs[i] = GL[(size_t)(row0 + s) * 16 + ty * 4 + h]; }
  __syncthreads();
  {
    const int dir = t >> 7, s = t & 127;
    float wval, tot = 0.f;
    if (dir == 0) {
      float bsum = 0.f;
      for (int j = 0; j < 128; ++j) { const float f = gs[128 + j]; tot += f; if (j <= s) bsum += f; }
      wval = tot - bsum + gs[s];
    } else {
      float pre = 0.f;
      for (int j = 0; j < 128; ++j) { const float f = gs[384 + j]; tot += f; if (j < s) pre += f; }
      wval = pre + gs[256 + s];
    }
    wv[dir * 128 + s] = wval;
    if (s == 0) msc[dir] = tot;
  }
  __syncthreads();
  {
    const int dir = t >> 7, s = t & 127;
    float mx = -INFINITY;
    for (int j = 0; j < 128; ++j) mx = fmaxf(mx, wv[dir * 128 + j]);
    const float wval = wv[dir * 128 + s];
    __syncthreads();
    wv[dir * 128 + s] = expf(wval - mx);
    if (s == 0) msc[2 + dir] = mx;
  }
  __syncthreads();
  bf16_t* DC = (bf16_t*)(p.ws + O_DC);
#pragma unroll 1
  for (int d = 0; d < 2; ++d) {
    f32x16 acc[2][2];
#pragma unroll
    for (int i = 0; i < 2; ++i)
#pragma unroll
      for (int j = 0; j < 2; ++j) acc[i][j] = fzero();
#pragma unroll 2
    for (int ks = 0; ks < 8; ++ks) {
      const int xo = ((ks * 2 + hh) ^ (r & 15)) << 4;
      const bf16x8 ra0 = *(const bf16x8*)(sV + (wm * 64 + r) * 256 + xo);
      const bf16x8 ra1 = *(const bf16x8*)(sV + (wm * 64 + 32 + r) * 256 + xo);
      const bf16x8 b0 = *(const bf16x8*)(sK + (wn * 64 + r) * 256 + xo);
      const bf16x8 b1 = *(const bf16x8*)(sK + (wn * 64 + 32 + r) * 256 + xo);
      const float* ww = wv + d * 128 + ks * 16 + hh * 8;
      const bf16x8 a0 = pack8(bf2f((bf16_t)ra0[0]) * ww[0], bf2f((bf16_t)ra0[1]) * ww[1], bf2f((bf16_t)ra0[2]) * ww[2], bf2f((bf16_t)ra0[3]) * ww[3],
                              bf2f((bf16_t)ra0[4]) * ww[4], bf2f((bf16_t)ra0[5]) * ww[5], bf2f((bf16_t)ra0[6]) * ww[6], bf2f((bf16_t)ra0[7]) * ww[7]);
      const bf16x8 a1 = pack8(bf2f((bf16_t)ra1[0]) * ww[0], bf2f((bf16_t)ra1[1]) * ww[1], bf2f((bf16_t)ra1[2]) * ww[2], bf2f((bf16_t)ra1[3]) * ww[3],
                              bf2f((bf16_t)ra1[4]) * ww[4], bf2f((bf16_t)ra1[5]) * ww[5], bf2f((bf16_t)ra1[6]) * ww[6], bf2f((bf16_t)ra1[7]) * ww[7]);
      acc[0][0] = MFMA(a0, b0, acc[0][0]);
      acc[0][1] = MFMA(a0, b1, acc[0][1]);
      acc[1][0] = MFMA(a1, b0, acc[1][0]);
      acc[1][1] = MFMA(a1, b1, acc[1][1]);
    }
    bf16_t* dst = DC + ((size_t)(bh * 2 + d) * NSTEP + nc) * 16384;
#pragma unroll
    for (int mi = 0; mi < 2; ++mi)
#pragma unroll
      for (int ni = 0; ni < 2; ++ni)
#pragma unroll
        for (int i = 0; i < 16; ++i)
          dst[(wm * 64 + mi * 32 + crow(i, hh)) * 128 + wn * 64 + ni * 32 + r] = f2bf(acc[mi][ni][i]);
  }
  {
    const int dir = t >> 7, k = t & 127;
    float s = 0.f;
    for (int s8 = 0; s8 < 16; ++s8) {
      const bf16x8 v = *(const bf16x8*)(sK + k * 256 + ((s8 ^ (k & 15)) << 4));
#pragma unroll
      for (int e = 0; e < 8; ++e) s += wv[dir * 128 + s8 * 8 + e] * bf2f((bf16_t)v[e]);
    }
    ((float*)(p.ws + O_DN))[((size_t)(bh * 2 + dir) * NSTEP + nc) * 128 + k] = s;
    if (k == 0) {
      ((float*)(p.ws + O_GSC))[(bh * 2 + dir) * NSTEP + nc] = msc[dir];
      ((float*)(p.ws + O_MLOC))[(bh * 2 + dir) * NSTEP + nc] = msc[2 + dir];
    }
  }
  __syncthreads();
}

DI int chain_nc(int dir, int i) { return dir == 0 ? i : (i < 2 ? 1 - i : 67 - i); }
template <int DIR>
DI void scan_chain_elems(const bf16_t* __restrict__ DCc, bf16_t* __restrict__ CSTc, const float* fa, const float* fb, int e, int epos) {
  float C = 0.f;
#pragma unroll
  for (int blk = 0; blk < 3; ++blk) {
    float v[22];
#pragma unroll
    for (int j = 0; j < 22; ++j) {
      const int i = blk * 22 + j;
      const int nc = DIR == 0 ? i : (i < 2 ? 1 - i : 67 - i);
      v[j] = bf2f(DCc[(size_t)nc * 16384 + e]);
    }
#pragma unroll
    for (int j = 0; j < 22; ++j) {
      const int i = blk * 22 + j;
      const int nc = DIR == 0 ? i : (i < 2 ? 1 - i : 67 - i);
      if (i >= 2) CSTc[(size_t)(nc - 2) * 16384 + epos] = f2bf(C);
      C = fa[i] * C + fb[i] * v[j];
    }
  }
}
DI void phase_scan(const Params& p, char* smem) {
  float* fa = (float*)smem;
  float* fb = fa + 66;
  const float* GSC = (const float*)(p.ws + O_GSC); const float* MLOC = (const float*)(p.ws + O_MLOC);
  const bf16_t* DC = (const bf16_t*)(p.ws + O_DC); const float* DN = (const float*)(p.ws + O_DN);
  bf16_t* CST = (bf16_t*)(p.ws + O_CST); float* NST = (float*)(p.ws + O_NST); float* MST = (float*)(p.ws + O_MST);
  const int t = tid();
  for (int item = blockIdx.x; item < 16 * 64 + 16; item += gridDim.x) {
    const int chain = item < 1024 ? (item >> 6) : (item - 1024), dir = chain & 1;
    __syncthreads();
    if (t < NSTEP) { const int nc = chain_nc(dir, t); fa[t] = GSC[chain * NSTEP + nc]; fb[t] = MLOC[chain * NSTEP + nc]; }
    __syncthreads();
    if (t == 0) {
      float m = 0.f;
      for (int i = 0; i < NSTEP; ++i) {
        if (i >= 2 && item >= 1024) MST[chain * 64 + chain_nc(dir, i) - 2] = m;
        const float g = fa[i], ml = fb[i];
        const float mn = fmaxf(g + m, ml);
        fa[i] = __expf(g + m - mn); fb[i] = __expf(ml - mn);
        m = mn;
      }
    }
    __syncthreads();
    if (item < 1024) {
      const int e = (item & 63) * 256 + t;
      const int ev = e >> 7, ek = e & 127;
      const int epos = ((((ev >> 5) * 8 + (ek >> 4)) * 64) + ((ek >> 3) & 1) * 32 + (ev & 31)) * 8 + (ek & 7);
      const bf16_t* DCc = DC + (size_t)chain * NSTEP * 16384;
      bf16_t* CSTc = CST + (size_t)chain * 64 * 16384;
      if (dir == 0) scan_chain_elems<0>(DCc, CSTc, fa, fb, e, epos);
      else scan_chain_elems<1>(DCc, CSTc, fa, fb, e, epos);
    } else if (t < 128) {
      const int k = t;
      float n = 0.f;
      for (int i = 0; i < NSTEP; ++i) {
        const int nc = chain_nc(dir, i);
        if (i >= 2) NST[((size_t)chain * 64 + (nc - 2)) * 128 + k] = n;
        n = fa[i] * n + fb[i] * DN[((size_t)chain * NSTEP + nc) * 128 + k];
      }
    }
  }
}

DI void mlstm_out_item(const Params& p, int item, char* smem) {
  float* gs = (float*)smem;
  float* bb = gs + 512;
  float* lib = bb + 256;
  float* mrow = lib + 256;
  float* aT = mrow + 256;
  float* nq = aT + 256;
  float* nst = nq + 256;
  char* sK = smem + 8192;
  char* sV = sK + 32768;
  int t_ = tid();
  asm volatile("" : "+v"(t_));
  const int t = t_, lane = t & 63, w = t >> 6, r = lane & 31, hh = lane >> 5;
  const int bh = item >> 6, c = item & 63, b = bh >> 2, h = bh & 3;
  const int sc = b * 64 + c, row0 = sc * 128;
  const float* GL = (const float*)(p.ws + O_GL);
  const bf16_t* Qc = (const bf16_t*)(p.ws + O_QC); const bf16_t* Kc = (const bf16_t*)(p.ws + O_KC);
  const bf16_t* VT = (const bf16_t*)(p.ws + O_VT) + (size_t)(sc * 4 + h) * 16384;
  const bf16_t* P = (const bf16_t*)(p.ws + O_P);
  const float* MST = (const float*)(p.ws + O_MST);
  bf16_t* MIX = (bf16_t*)(p.ws + O_HA);
#pragma unroll
  for (int i = 0; i < 8; ++i) {
    const int q = t + 256 * i, row = q >> 4, cc = q & 15;
    const int so = row * 256 + ((cc ^ (row & 15)) << 4);
    *(uint4*)(sK + so) = *(const uint4*)(Kc + (size_t)(row0 + row) * 512 + h * 128 + cc * 8);
    *(uint4*)(sV + so) = *(const uint4*)(VT + row * 128 + cc * 8);
  }
  for (int i = t; i < 512; i += 256) { const int ty = i >> 7, s = i & 127; gs[i] = GL[(size_t)(row0 + s) * 16 + ty * 4 + h]; }
  {
    const int dir = t >> 7, k = t & 127;
    nst[t] = ((const float*)(p.ws + O_NST))[((size_t)(bh * 2 + dir) * 64 + c) * 128 + k];
  }
  __syncthreads();
  {
    const int dir = t >> 7, s = t & 127;
    float bsum = 0.f;
    if (dir == 0) { for (int j = 0; j <= s; ++j) bsum += gs[128 + j]; }
    else { for (int j = s; j < 128; ++j) bsum += gs[384 + j]; }
    bb[t] = bsum;
    lib[t] = gs[dir * 256 + s] - bsum;
    const bf16_t* qr = Qc + (size_t)(row0 + s) * 512 + h * 128;
    float acc = 0.f;
    for (int k8 = 0; k8 < 16; ++k8) {
      const bf16x8 v = ldfrag(qr + k8 * 8);
#pragma unroll
      for (int e = 0; e < 8; ++e) acc += nst[dir * 128 + k8 * 8 + e] * bf2f((bf16_t)v[e]);
    }
    nq[t] = acc;
  }
  __syncthreads();
  {
    const int dir = t >> 7, s = t & 127;
    float pm = -INFINITY;
    if (dir == 0) { for (int j = 0; j <= s; ++j) pm = fmaxf(pm, lib[j]); }
    else { for (int j = s; j < 128; ++j) pm = fmaxf(pm, lib[128 + j]); }
    const float m_in = MST[(bh * 2 + dir) * 64 + c];
    const float mr = bb[t] + fmaxf(m_in, pm);
    mrow[t] = mr;
    aT[t] = expf(bb[t] + m_in - mr);
  }
  __syncthreads();
  const int tl = w * 32 + r;
  const bf16_t* qrow = Qc + (size_t)(row0 + tl) * 512 + h * 128 + hh * 8;
  bf16x8 qf[8];
#pragma unroll
  for (int ks = 0; ks < 8; ++ks) qf[ks] = ldfrag(qrow + ks * 16);
  const int swz = r & 15;
  const char* kp[8]; const char* vp[16];
#pragma unroll
  for (int ks = 0; ks < 8; ++ks) kp[ks] = sK + r * 256 + (((ks * 2 + hh) ^ swz) << 4);
#pragma unroll
  for (int cc = 0; cc < 16; ++cc) vp[cc] = sV + r * 256 + 8 * hh + ((cc ^ swz) << 4);
  float* Hb = (float*)(p.ws + O_DC) + (size_t)item * 16384 + tl;
  float* Hbh = Hb + 4 * hh * 128;
  f32x16 outa[4];
#define MLSTM_DIR(DIR)                                                                                                   \
  {                                                                                                                      \
    const bf16_t* CSTl = (const bf16_t*)(p.ws + O_CST) + ((size_t)(bh * 2 + DIR) * 64 + c) * 16384 + lane * 8;           \
    const float bbt = bb[DIR * 128 + tl], mrt = mrow[DIR * 128 + tl], at = aT[DIR * 128 + tl];                            \
    float dsum = 0.f;                                                                                                    \
    const float* libp = lib + DIR * 128 + 4 * hh;                                                                        \
    const int tb = tl - 4 * hh;                                                                                          \
    bf16x8 pf[8];                                                                                                        \
    _Pragma("unroll") for (int half = 0; half < 2; ++half) {                                                             \
      f32x16 st[2];                                                                                                      \
      st[0] = fzero(); st[1] = fzero();                                                                                  \
      _Pragma("unroll") for (int ks = 0; ks < 8; ++ks) {                                                                 \
        _Pragma("unroll") for (int r2 = 0; r2 < 2; ++r2)                                                                 \
          st[r2] = MFMA(*(const bf16x8*)(kp[ks] + (half * 2 + r2) * 8192), qf[ks], st[r2]);                              \
      }                                                                                                                  \
      _Pragma("unroll") for (int r2 = 0; r2 < 2; ++r2) {                                                                 \
        const int rb = half * 2 + r2;                                                                                    \
        _Pragma("unroll") for (int i = 0; i < 16; ++i) {                                                                 \
          const int sc_ = rb * 32 + (i & 3) + 8 * (i >> 2);                                           \
          const int diff = DIR == 0 ? (tb - sc_) : (sc_ - tb);                                                           \
          const float msk = (float)((unsigned)(~diff) >> 31);                                                            \
          const float v = st[r2][i] * __expf(fminf(bbt + libp[sc_] - mrt, 0.f)) * msk;                                    \
          st[r2][i] = v; dsum += v;                                                                                      \
        }                                                                                                                \
        pf[rb * 2] = pack8(st[r2][0], st[r2][1], st[r2][2], st[r2][3], st[r2][4], st[r2][5], st[r2][6], st[r2][7]);      \
        pf[rb * 2 + 1] = pack8(st[r2][8], st[r2][9], st[r2][10], st[r2][11], st[r2][12], st[r2][13], st[r2][14], st[r2][15]); \
      }                                                                                                                  \
      __builtin_amdgcn_sched_barrier(0);                                                                                 \
    }                                                                                                                    \
    dsum += __shfl_xor(dsum, 32);                                                                                        \
    const float den = dsum + at * nq[DIR * 128 + tl];                                                                    \
    const float dinv = 1.f / fmaxf(fabsf(den), expf(-mrt));                                                              \
    _Pragma("unroll") for (int half = 0; half < 2; ++half) {                                                             \
      f32x16 ha[2];                                                                                                      \
      ha[0] = fzero(); ha[1] = fzero();                                                                                  \
      _Pragma("unroll") for (int ks = 0; ks < 8; ++ks) {                                                                 \
        _Pragma("unroll") for (int r2 = 0; r2 < 2; ++r2)                                                                 \
          ha[r2] = MFMA(ldfrag(CSTl + ((half * 2 + r2) * 8 + ks) * 512), qf[ks], ha[r2]);                                \
        if (ks == 3) __builtin_amdgcn_sched_barrier(0);                                                                  \
      }                                                                                                                  \
      _Pragma("unroll") for (int r2 = 0; r2 < 2; ++r2)                                                                   \
        _Pragma("unroll") for (int i = 0; i < 16; ++i) ha[r2][i] *= at;                                                  \
      __builtin_amdgcn_sched_barrier(0);                                                                                 \
      _Pragma("unroll") for (int kk = 0; kk < 8; ++kk) {                                                                 \
        _Pragma("unroll") for (int r2 = 0; r2 < 2; ++r2) {                                                               \
          const s16x4 lo = *(const s16x4*)(vp[2 * kk] + (half * 2 + r2) * 8192);                                         \
          const s16x4 hi = *(const s16x4*)(vp[2 * kk + 1] + (half * 2 + r2) * 8192);                                     \
          ha[r2] = MFMA(__builtin_shufflevector(lo, hi, 0, 1, 2, 3, 4, 5, 6, 7), pf[kk], ha[r2]);                        \
        }                                                                                                                \
      }                                                                                                                  \
      _Pragma("unroll") for (int r2 = 0; r2 < 2; ++r2)                                                                   \
        _Pragma("unroll") for (int i = 0; i < 16; ++i) {                                                                 \
          float* hp = Hbh + ((half * 2 + r2) * 32 + (i & 3) + 8 * (i >> 2)) * 128;                                       \
          if (DIR == 0) *hp = ha[r2][i] * dinv;                                                                          \
          else outa[half * 2 + r2][i] = *hp + ha[r2][i] * dinv;                                                          \
        }                                                                                                                \
      __builtin_amdgcn_sched_barrier(0);                                                                                 \
    }                                                                                                                    \
  }
  MLSTM_DIR(0)
  MLSTM_DIR(1)
#undef MLSTM_DIR
  float ss = 0.f;
#pragma unroll
  for (int rb = 0; rb < 4; ++rb)
#pragma unroll
    for (int i = 0; i < 16; ++i) ss += outa[rb][i] * outa[rb][i];
  ss += __shfl_xor(ss, 32);
  const float rn = rsqrtf(ss * (1.f / 128.f) + EPS);
  const size_t row = (size_t)row0 + tl;
#pragma unroll
  for (int rb = 0; rb < 4; ++rb)
#pragma unroll
    for (int q4 = 0; q4 < 4; ++q4) {
      const int v = rb * 32 + 8 * q4 + 4 * hh;
      const s16x4 ov = *(const s16x4*)(P + row * PLD + 1536 + h * 128 + v);
      const float4 hg = *(const float4*)(p.ab_head_g + h * 128 + v);
      const float y0 = outa[rb][4 * q4] * rn * hg.x * sigmf(bf2f((bf16_t)ov[0]));
      const float y1 = outa[rb][4 * q4 + 1] * rn * hg.y * sigmf(bf2f((bf16_t)ov[1]));
      const float y2 = outa[rb][4 * q4 + 2] * rn * hg.z * sigmf(bf2f((bf16_t)ov[2]));
      const float y3 = outa[rb][4 * q4 + 3] * rn * hg.w * sigmf(bf2f((bf16_t)ov[3]));
      uint2 u; u.x = pack2(y0, y1); u.y = pack2(y2, y3);
      *(uint2*)(MIX + row * 1024 + h * 128 + v) = u;
    }
  __syncthreads();
}

DI void phase_topk(const Params& p, char* smem) {
  unsigned* vals = (unsigned*)smem;
  unsigned* hist = vals + 8448;
  unsigned* cntg = hist + 256;
  unsigned* cnte = cntg + 256;
  unsigned* misc = cnte + 256;
  const float* AFF = (const float*)(p.ws + O_AFF);
  int* IDX = (int*)(p.ws + O_IDX); float* GATE = (float*)(p.ws + O_GATE); int* INV = (int*)(p.ws + O_INV);
  const int t = tid();
  for (int item = blockIdx.x; item < 32; item += gridDim.x) {
    const float* a = AFF + (size_t)item * 8192;
    for (int i = t; i < 8192; i += 256) vals[i + (i >> 5)] = __float_as_uint(a[i]);
    unsigned prefix = 0, remaining = 1024;
    for (int pass = 0; pass < 4; ++pass) {
      const int shift = 24 - 8 * pass;
      hist[t] = 0;
      __syncthreads();
      const unsigned mask = pass == 0 ? 0u : (0xFFFFFFFFu << (shift + 8));
      for (int i = t; i < 8192; i += 256) {
        const unsigned u = vals[i + (i >> 5)];
        if ((u & mask) == (prefix & mask)) atomicAdd(&hist[(u >> shift) & 255], 1u);
      }
      __syncthreads();
      {
        unsigned above = 0;
        for (int bin = t + 1; bin < 256; ++bin) above += hist[bin];
        const unsigned mineh = hist[t];
        if (above < remaining && above + mineh >= remaining) {
          misc[0] = prefix | ((unsigned)t << shift);
          misc[1] = remaining - above;
        }
      }
      __syncthreads();
      prefix = misc[0]; remaining = misc[1];
      __syncthreads();
    }
    const unsigned T = prefix, need_eq = remaining;
    unsigned cg_ = 0, ce = 0;
    for (int j = 0; j < 32; ++j) {
      const int n = t * 32 + j;
      const unsigned u = vals[n + (n >> 5)];
      cg_ += u > T; ce += u == T;
    }
    cntg[t] = cg_; cnte[t] = ce;
    __syncthreads();
    unsigned pg = 0, pe = 0;
    for (int j = 0; j < t; ++j) { pg += cntg[j]; pe += cnte[j]; }
    for (int j = 0; j < 32; ++j) {
      const int n = t * 32 + j;
      const unsigned u = vals[n + (n >> 5)];
      if (u > T) { IDX[item * 1024 + pg] = n; GATE[item * 1024 + pg] = __uint_as_float(u); INV[((size_t)(item >> 4) * 8192 + n) * 16 + (item & 15)] = (int)pg + 1; ++pg; }
      else if (u == T) {
        if (pe < need_eq) { const unsigned slot = 1024 - need_eq + pe; IDX[item * 1024 + slot] = n; GATE[item * 1024 + slot] = __uint_as_float(u); INV[((size_t)(item >> 4) * 8192 + n) * 16 + (item & 15)] = (int)slot + 1; }
        ++pe;
      }
    }
    __syncthreads();
  }
}

DI void phase_stats(const Params& p, char* smem) {
  float* red = (float*)smem;
  const bf16_t* GVT = (const bf16_t*)(p.ws + O_GVT);
  float* PART = (float*)(p.ws + O_STATS);
  const int t = tid(), qq = t & 31, cg_ = t >> 5;
  for (int item = blockIdx.x; item < 1024; item += gridDim.x) {
    const int chunk = item >> 3, cgrp = item & 7;
    const bf16_t* base = GVT + ((size_t)chunk * 2048 + cgrp * 256) * 128 + qq * 4;
    float s[4] = {0.f, 0.f, 0.f, 0.f}, s2[4] = {0.f, 0.f, 0.f, 0.f};
#pragma unroll 8
    for (int c = cg_; c < 256; c += 8) {
      const s16x4 v = *(const s16x4*)(base + (size_t)c * 128);
#pragma unroll
      for (int e = 0; e < 4; ++e) { const float f = bf2f((bf16_t)v[e]); s[e] += f; s2[e] += f * f; }
    }
#pragma unroll
    for (int e = 0; e < 4; ++e) { red[(cg_ * 128 + qq * 4 + e) * 2] = s[e]; red[(cg_ * 128 + qq * 4 + e) * 2 + 1] = s2[e]; }
    __syncthreads();
    if (t < 128) {
      float a = 0.f, b2 = 0.f;
      for (int g = 0; g < 8; ++g) { a += red[(g * 128 + t) * 2]; b2 += red[(g * 128 + t) * 2 + 1]; }
      PART[((size_t)item * 128 + t) * 2] = a;
      PART[((size_t)item * 128 + t) * 2 + 1] = b2;
    }
    __syncthreads();
  }
}
DI void phase_spatial(const Params& p, char* smem) {
  float* smu = (float*)smem;
  float* srs = smu + 128;
  const bf16_t* GVT = (const bf16_t*)(p.ws + O_GVT); const bf16_t* U = (const bf16_t*)(p.ws + O_U);
  const float* PART = (const float*)(p.ws + O_STATS);
  bf16_t* UV = (bf16_t*)(p.ws + O_UV);
  char* sW = smem + 1024;
  int g_staged = -1;
  for (int item = blockIdx.x; item < 1024; item += gridDim.x) {
    int t_ = tid();
    const int t = t_, lane = t & 63, w = t >> 6, r = lane & 31, hh = lane >> 5;
    const int chunk = item >> 3, g = item & 7;
    if (t < 128) {
      float a = 0.f, b2 = 0.f;
#pragma unroll
      for (int j = 0; j < 8; ++j) { a += PART[((size_t)(chunk * 8 + j) * 128 + t) * 2]; b2 += PART[((size_t)(chunk * 8 + j) * 128 + t) * 2 + 1]; }
      const float mu = a * (1.f / 2048.f);
      const float var = fmaxf(b2 * (1.f / 2048.f) - mu * mu, 0.f);
      smu[t] = mu; srs[t] = rsqrtf(var + EPS);
    }
    if (g != g_staged) {
      const float* Wg = p.gm_w_s + (size_t)g * 16384;
#pragma unroll
      for (int i = 0; i < 8; ++i) {
        const int q = t + 256 * i, row = q >> 4, cc = q & 15;
        const float4 w0 = *(const float4*)(Wg + row * 128 + cc * 8), w1 = *(const float4*)(Wg + row * 128 + cc * 8 + 4);
        uint4 o; o.x = pack2(w0.x, w0.y); o.y = pack2(w0.z, w0.w); o.z = pack2(w1.x, w1.y); o.w = pack2(w1.z, w1.w);
        *(uint4*)(sW + row * 256 + ((cc ^ (row & 15)) << 4)) = o;
      }
      g_staged = g;
    }
    __syncthreads();
    f32x16 acc[2][4];
#pragma unroll
    for (int i = 0; i < 4; ++i) { acc[0][i] = fzero(); acc[1][i] = fzero(); }
    const int cA = g * 256 + w * 64 + r, cB = cA + 32;
    const float lgA = p.gm_ln_g[cA], lbA = p.gm_ln_b[cA], lgB = p.gm_ln_g[cB], lbB = p.gm_ln_b[cB];
    const bf16_t* vA = GVT + ((size_t)chunk * 2048 + cA) * 128 + hh * 8;
    const bf16_t* vB = GVT + ((size_t)chunk * 2048 + cB) * 128 + hh * 8;
    for (int ks = 0; ks < 8; ++ks) {
      const bf16x8 ra = ldfrag(vA + ks * 16), rbv = ldfrag(vB + ks * 16);
      const float* mu = smu + ks * 16 + hh * 8; const float* rs = srs + ks * 16 + hh * 8;
      const bf16x8 aA = pack8((bf2f((bf16_t)ra[0]) - mu[0]) * rs[0] * lgA + lbA, (bf2f((bf16_t)ra[1]) - mu[1]) * rs[1] * lgA + lbA,
                              (bf2f((bf16_t)ra[2]) - mu[2]) * rs[2] * lgA + lbA, (bf2f((bf16_t)ra[3]) - mu[3]) * rs[3] * lgA + lbA,
                              (bf2f((bf16_t)ra[4]) - mu[4]) * rs[4] * lgA + lbA, (bf2f((bf16_t)ra[5]) - mu[5]) * rs[5] * lgA + lbA,
                              (bf2f((bf16_t)ra[6]) - mu[6]) * rs[6] * lgA + lbA, (bf2f((bf16_t)ra[7]) - mu[7]) * rs[7] * lgA + lbA);
      const bf16x8 aB = pack8((bf2f((bf16_t)rbv[0]) - mu[0]) * rs[0] * lgB + lbB, (bf2f((bf16_t)rbv[1]) - mu[1]) * rs[1] * lgB + lbB,
                              (bf2f((bf16_t)rbv[2]) - mu[2]) * rs[2] * lgB + lbB, (bf2f((bf16_t)rbv[3]) - mu[3]) * rs[3] * lgB + lbB,
                              (bf2f((bf16_t)rbv[4]) - mu[4]) * rs[4] * lgB + lbB, (bf2f((bf16_t)rbv[5]) - mu[5]) * rs[5] * lgB + lbB,
                              (bf2f((bf16_t)rbv[6]) - mu[6]) * rs[6] * lgB + lbB, (bf2f((bf16_t)rbv[7]) - mu[7]) * rs[7] * lgB + lbB);
#pragma unroll
      for (int pb = 0; pb < 4; ++pb) {
        const bf16x8 bw = *(const bf16x8*)(sW + (pb * 32 + r) * 256 + (((ks * 2 + hh) ^ (r & 15)) << 4));
        acc[0][pb] = MFMA(aA, bw, acc[0][pb]);
        acc[1][pb] = MFMA(aB, bw, acc[1][pb]);
      }
    }
#pragma unroll
    for (int pb = 0; pb < 4; ++pb) {
      const int pp = pb * 32 + r;
      const float bs = p.gm_b_s[g * 128 + pp];
      const size_t rowo = ((size_t)chunk * 128 + pp) * 2048 + g * 256 + w * 64 + 4 * hh;
#pragma unroll
      for (int cb = 0; cb < 2; ++cb)
#pragma unroll
        for (int q4 = 0; q4 < 4; ++q4) {
          const size_t o = rowo + cb * 32 + 8 * q4;
          const s16x4 uu = *(const s16x4*)(U + o);
          uint2 st;
          st.x = pack2(bf2f((bf16_t)uu[0]) * (acc[cb][pb][4 * q4] + bs), bf2f((bf16_t)uu[1]) * (acc[cb][pb][4 * q4 + 1] + bs));
          st.y = pack2(bf2f((bf16_t)uu[2]) * (acc[cb][pb][4 * q4 + 2] + bs), bf2f((bf16_t)uu[3]) * (acc[cb][pb][4 * q4 + 3] + bs));
          *(uint2*)(UV + o) = st;
        }
    }
    __syncthreads();
  }
}

struct EpiBf16 {
  bf16_t* dst; int ld;
  DI void operator()(f32x16 (&acc)[4][2], int mb, int nb, int r, int hh) const {
#pragma unroll
    for (int mi = 0; mi < 4; ++mi)
#pragma unroll
      for (int ni = 0; ni < 2; ++ni)
#pragma unroll
        for (int i = 0; i < 16; ++i)
          dst[(size_t)(mb + mi * 32 + crow(i, hh)) * ld + nb + ni * 32 + r] = f2bf(acc[mi][ni][i]);
  }
};
struct EpiRes {
  float* out; const float* base; const float* gate;
  DI void operator()(f32x16 (&acc)[4][2], int mb, int nb, int r, int hh) const {
#pragma unroll
    for (int ni = 0; ni < 2; ++ni) {
      const int n = nb + ni * 32 + r;
      const float gt = gate[n];
#pragma unroll
      for (int mi = 0; mi < 4; ++mi) {
        const unsigned o0 = (unsigned)(mb + mi * 32 + 4 * hh) * 1024u + (unsigned)n;
#pragma unroll
        for (int q4 = 0; q4 < 4; ++q4) {
          const float b0 = base[o0 + (8 * q4 + 0) * 1024], b1 = base[o0 + (8 * q4 + 1) * 1024], b2 = base[o0 + (8 * q4 + 2) * 1024], b3 = base[o0 + (8 * q4 + 3) * 1024];
          out[o0 + (8 * q4 + 0) * 1024] = b0 + gt * acc[mi][ni][4 * q4];
          out[o0 + (8 * q4 + 1) * 1024] = b1 + gt * acc[mi][ni][4 * q4 + 1];
          out[o0 + (8 * q4 + 2) * 1024] = b2 + gt * acc[mi][ni][4 * q4 + 2];
          out[o0 + (8 * q4 + 3) * 1024] = b3 + gt * acc[mi][ni][4 * q4 + 3];
          __builtin_amdgcn_sched_barrier(0);
        }
      }
    }
  }
};
struct EpiGelu {
  bf16_t* U; bf16_t* GVT; int m0, n0;
  DI void operator()(f32x16 (&acc)[4][2], int mb, int nb, int r, int hh) const {
    if (n0 < 2048) {
#pragma unroll
      for (int mi = 0; mi < 4; ++mi)
#pragma unroll
        for (int ni = 0; ni < 2; ++ni)
#pragma unroll
          for (int i = 0; i < 16; ++i)
            U[(size_t)(m0 + mb + mi * 32 + crow(i, hh)) * 2048 + n0 + nb + ni * 32 + r] = f2bf(geluf(acc[mi][ni][i]));
    } else {
#pragma unroll
      for (int mi = 0; mi < 4; ++mi) {
        const int mrow = m0 + mb + mi * 32;
        const int chunk = mrow >> 7, q0 = mrow & 127;
#pragma unroll
        for (int ni = 0; ni < 2; ++ni) {
          const int cc = n0 - 2048 + nb + ni * 32 + r;
          bf16_t* d = GVT + ((size_t)chunk * 2048 + cc) * 128 + q0 + 4 * hh;
#pragma unroll
          for (int q4 = 0; q4 < 4; ++q4) {
            uint2 u;
            u.x = pack2(geluf(acc[mi][ni][4 * q4]), geluf(acc[mi][ni][4 * q4 + 1]));
            u.y = pack2(geluf(acc[mi][ni][4 * q4 + 2]), geluf(acc[mi][ni][4 * q4 + 3]));
            *(uint2*)(d + 8 * q4) = u;
          }
        }
      }
    }
  }
};
struct EpiSwiglu {
  bf16_t* hid;
  DI void operator()(f32x16 (&acc)[4][2], int mb, int nb, int r, int hh) const {
    const int f = (nb >> 1) + r;
#pragma unroll
    for (int mi = 0; mi < 4; ++mi)
#pragma unroll
      for (int i = 0; i < 16; ++i) {
        const float gv = acc[mi][0][i], uv = acc[mi][1][i];
        hid[(size_t)(mb + mi * 32 + crow(i, hh)) * 1024 + f] = f2bf(siluf(gv) * uv);
      }
  }
};
DI void phase_moe1(const Params& p, char* smem) {
  const bf16_t* HA = (const bf16_t*)(p.ws + O_HA); const bf16_t* WGU = (const bf16_t*)(p.ws + O_MGU);
  const int* IDX = (const int*)(p.ws + O_IDX); bf16_t* HID = (bf16_t*)(p.ws + O_HID);
  const int t = tid(), lrow = t >> 3, lcol = (t & 7) * 8;
  for (TileWalk tw(128 * 16, smem); tw.valid(); tw.next()) {
    int mg, nt; tw.get(8, 8, 2, mg, nt);
    const int e = mg >> 3, b = (mg >> 2) & 1, mt = mg & 3, be = b * 16 + e;
    unsigned aoff[8];
#pragma unroll
    for (int i = 0; i < 8; ++i) aoff[i] = (unsigned)IDX[be * 1024 + mt * 256 + lrow + 32 * i] * 1024u + (unsigned)lcol;
    gemm_tile<false>(HA + (size_t)b * 8192 * 1024, aoff, WGU + ((size_t)e * 2048 + nt * 128) * 1024, (unsigned)lrow * 1024u + (unsigned)lcol, 1024, smem,
              EpiSwiglu{HID + ((size_t)be * 1024 + mt * 256) * 1024 + nt * 64});
  }
}
DI void phase_moe2(const Params& p, int layer, char* smem) {
  const bf16_t* HID = (const bf16_t*)(p.ws + O_HID); const bf16_t* WD = (const bf16_t*)(p.ws + O_MD);
  const int t = tid(), lrow = t >> 3, lcol = (t & 7) * 8;
  for (TileWalk tw(128 * 8, smem); tw.valid(); tw.next()) {
    int mg, nt; tw.get(8, 8, 1, mg, nt);
    const int e = mg >> 3, b = (mg >> 2) & 1, mt = mg & 3, be = b * 16 + e;
    unsigned aoff[8];
#pragma unroll
    for (int i = 0; i < 8; ++i) aoff[i] = (unsigned)(lrow + 32 * i) * 1024u + (unsigned)lcol;
    gemm_tile<true>(HID + ((size_t)be * 1024 + mt * 256) * 1024, aoff, WD + ((size_t)e * 1024 + nt * 128) * 1024, (unsigned)lrow * 1024u + (unsigned)lcol, 1024, smem,
              EpiBf16{(bf16_t*)(p.ws + O_YE) + ((size_t)be * 1024 + mt * 256) * 1024 + nt * 128, 1024});
  }
}

DI void phase_final(const Params& p) {
  const int t = tid(), lane = t & 63, w = t >> 6;
  for (int row = blockIdx.x * 4 + w; row < NTOK; row += gridDim.x * 4) {
    float* src = p.out + (size_t)row * 1024;
    float4 xv[4]; float ss = 0.f;
#pragma unroll
    for (int i = 0; i < 4; ++i) xv[i] = *(const float4*)(src + (i * 64 + lane) * 4);
    {
      float4 ca[4];
      moe_combine_row(p, row, lane, ca);
      const float* g2 = (const float*)(p.ws + O_MODV) + (1 * 3 + (row >> 13)) * 6144 + 5 * 1024;
#pragma unroll
      for (int i = 0; i < 4; ++i) {
        const float4 gg = *(const float4*)(g2 + (i * 64 + lane) * 4);
        xv[i].x += gg.x * ca[i].x; xv[i].y += gg.y * ca[i].y; xv[i].z += gg.z * ca[i].z; xv[i].w += gg.w * ca[i].w;
      }
    }
#pragma unroll
    for (int i = 0; i < 4; ++i) ss += xv[i].x * xv[i].x + xv[i].y * xv[i].y + xv[i].z * xv[i].z + xv[i].w * xv[i].w;
    ss = wsum(ss);
    const float rstd = rsqrtf(ss * (1.f / 1024.f) + EPS);
#pragma unroll
    for (int i = 0; i < 4; ++i) {
      const int col = (i * 64 + lane) * 4;
      const float4 g4 = *(const float4*)(p.final_norm_g + col);
      float4 y; y.x = xv[i].x * rstd * g4.x; y.y = xv[i].y * rstd * g4.y; y.z = xv[i].z * rstd * g4.z; y.w = xv[i].w * rstd * g4.w;
      *(float4*)(src + col) = y;
    }
  }
}

constexpr int NPHASE = 22;
DI void run_phase(const Params& p, int ph, char* smem) {
  const float* modv = (const float*)(p.ws + O_MODV);
  switch (ph) {
#if !defined(ONLY) || ONLY == 0
    case 0:
      phase_adaln(p, smem);
      __syncthreads();
      tconv(p.ab_w_in, 2832, 2832, 1024, 1, 0, (bf16_t*)(p.ws + O_WIN), 0, 1, smem);
      tconv(p.ab_w_out, 1024, 1024, 1024, 1, 0, (bf16_t*)(p.ws + O_WOUT), 0, 0, smem);
      tconv(p.gm_w_in, 4096, 4096, 1024, 1, 0, (bf16_t*)(p.ws + O_GMIN), 0, 0, smem);
      tconv(p.gm_w_out, 1024, 1024, 2048, 1, 0, (bf16_t*)(p.ws + O_GMOUT), 0, 0, smem);
      break;
#endif
#if !defined(ONLY) || ONLY == 1
    case 1: phase_modulate<1, false>(p, 0, 0, smem); break;
#endif
#if !defined(ONLY) || ONLY == 2
    case 2:
      gemm_dense((const bf16_t*)(p.ws + O_HA), (const bf16_t*)(p.ws + O_WIN), NROW, PLD, 1024, 6, 11, smem,
                 [&](int m0, int n0) { return EpiBf16{(bf16_t*)(p.ws + O_P) + (size_t)m0 * PLD + n0, PLD}; });
      break;
#endif
#if !defined(ONLY) || ONLY == 3
    case 3: phase_prep2(p, smem); break;
#endif
#if !defined(ONLY) || ONLY == 4
    case 4:
      for (int item = blockIdx.x; item < 1024 + 8 * NSTEP; item += gridDim.x) {
        if (item < 1024) attn_item(p, item, smem); else mlstm_local_item(p, item - 1024, smem);
      }
      break;
#endif
#if !defined(ONLY) || ONLY == 5
    case 5: phase_scan(p, smem); break;
#endif
#if !defined(ONLY) || ONLY == 6
    case 6:
      for (int item = blockIdx.x; item < 512; item += gridDim.x) mlstm_out_item(p, item, smem);
      break;
#endif
#if !defined(ONLY) || ONLY == 7
    case 7:
#pragma unroll 1
      for (int step = 0; step < 2; ++step) {
        if (((step ^ (int)blockIdx.x) & 1) == 0) {
          gemm_dense((const bf16_t*)(p.ws + O_HA), (const bf16_t*)(p.ws + O_WOUT), NTOK, 1024, 1024, 8, 8, smem,
                     [&](int m0, int n0) {
                       return EpiRes{p.out + (size_t)m0 * 1024 + n0, p.x + (size_t)m0 * 1024 + n0, modv + (0 * 3 + (m0 >> 13)) * 6144 + 2 * 1024 + n0};
                     });
        } else {
          tconv_moe(p, 0, smem);
        }
        __syncthreads();
      }
      break;
#endif
#if !defined(ONLY) || ONLY == 8
    case 8: phase_modulate<2, false>(p, 0, 1, smem); break;
#endif
#if !defined(ONLY) || ONLY == 9
    case 9: phase_topk(p, smem); break;
#endif
#if !defined(ONLY) || ONLY == 10
    case 10: phase_moe1(p, smem); break;
#endif
#if !defined(ONLY) || ONLY == 11
    case 11: phase_moe2(p, 0, smem); break;
#endif
#if !defined(ONLY) || ONLY == 12
    case 12:
      phase_modulate<0, true>(p, 1, 0, smem);
      break;
#endif
#if !defined(ONLY) || ONLY == 13
    case 13:
      gemm_dense((const bf16_t*)(p.ws + O_HA), (const bf16_t*)(p.ws + O_GMIN), NTOK, 4096, 1024, 8, 8, smem,
                 [&](int m0, int n0) { return EpiGelu{(bf16_t*)(p.ws + O_U), (bf16_t*)(p.ws + O_GVT), m0, n0}; });
      break;
#endif
#if !defined(ONLY) || ONLY == 14
    case 14: phase_stats(p, smem); break;
#endif
#if !defined(ONLY) || ONLY == 15
    case 15: phase_spatial(p, smem); break;
#endif
#if !defined(ONLY) || ONLY == 16
    case 16:
#pragma unroll 1
      for (int step = 0; step < 2; ++step) {
        if (((step ^ (int)blockIdx.x) & 1) == 0) {
          gemm_dense((const bf16_t*)(p.ws + O_UV), (const bf16_t*)(p.ws + O_GMOUT), NTOK, 1024, 2048, 8, 8, smem,
                     [&](int m0, int n0) {
                       return EpiRes{p.out + (size_t)m0 * 1024 + n0, p.out + (size_t)m0 * 1024 + n0, modv + (1 * 3 + (m0 >> 13)) * 6144 + 2 * 1024 + n0};
                     });
        } else {
          tconv_moe(p, 1, smem);
        }
        __syncthreads();
      }
      break;
#endif
#if !defined(ONLY) || ONLY == 17
    case 17: phase_modulate<2, false>(p, 1, 1, smem); break;
#endif
#if !defined(ONLY) || ONLY == 18
    case 18: phase_topk(p, smem); break;
#endif
#if !defined(ONLY) || ONLY == 19
    case 19: phase_moe1(p, smem); break;
#endif
#if !defined(ONLY) || ONLY == 20
    case 20: phase_moe2(p, 1, smem); break;
#endif
#if !defined(ONLY) || ONLY == 21
    case 21: phase_final(p); break;
#endif
    default: break;
  }
}

#define XB_TMO      128
#define XB_XCNT(j)  (256  + 64 * (j))
#define XB_XSUB(j)  (1280 + 64 * (j))
#define XB_XGEN(j)  (2304 + 64 * (j))
#define XB_TOP      3328
#define XB_TOPGEN   3392
#define XCD_BAR_WORDS 3456
#define XB_SPIN_CAP (1u << 18)
#define LAS __attribute__((address_space(3)))
DI unsigned xb_ld(unsigned* p) { return __hip_atomic_load(p, __ATOMIC_RELAXED, __HIP_MEMORY_SCOPE_AGENT); }
DI unsigned xb_add(unsigned* p, unsigned v) { return __hip_atomic_fetch_add(p, v, __ATOMIC_RELAXED, __HIP_MEMORY_SCOPE_AGENT); }
DI unsigned xb_xcc_id() { return (unsigned)__builtin_amdgcn_s_getreg((3 << 11) | 20) & 0xFu; }
#define XB_SPIN(cond, bar) do { unsigned _sp = 0; while (cond) { __builtin_amdgcn_s_sleep(1); \
    if ((++_sp & 255u) == 0u) { if (xb_ld(&(bar)[XB_TMO])) break; if (_sp > XB_SPIN_CAP) { atomicAdd(&(bar)[XB_TMO], 1u); break; } } } } while (0)
struct XcdBarrier { unsigned* bar; unsigned x; volatile LAS unsigned* st; };
DI XcdBarrier xcd_barrier_post(unsigned* bar, volatile LAS unsigned* st) {
  XcdBarrier b; b.bar = bar; b.x = xb_xcc_id(); b.st = st;
  if (threadIdx.x == 0) st[3] = xb_add(&bar[XB_XCNT(b.x)], 1u);
  return b;
}
DI void xcd_barrier_complete(unsigned* bar, unsigned x, unsigned& nloc, unsigned& nx, unsigned& sbefore) {
  const unsigned G = gridDim.x * gridDim.y * gridDim.z;
  unsigned sum, cnt, mine, sp = 0u, sb = 0u;
  for (;;) {
    sum = 0u; cnt = 0u; mine = 0u; sb = 0u;
#pragma unroll
    for (unsigned j = 0; j < 16; ++j) { const unsigned c = xb_ld(&bar[XB_XCNT(j)]); sum += c; cnt += (c > 0u) ? 1u : 0u; mine = (j == x) ? c : mine; sb += (j < x) ? c : 0u; }
    if (sum == G) break;
    __builtin_amdgcn_s_sleep(1);
    if ((++sp & 255u) == 0u) { if (xb_ld(&bar[XB_TMO])) break; if (sp > XB_SPIN_CAP) { atomicAdd(&bar[XB_TMO], 1u); break; } }
  }
  nloc = mine > 0u ? mine : 1u; nx = cnt > 0u ? cnt : 1u; sbefore = sb;
}
DI void xcd_barrier(const XcdBarrier& b) {
  asm volatile("s_waitcnt vmcnt(0)" ::: "memory");
  __syncthreads();
  if (threadIdx.x == 0) {
    unsigned* bar = b.bar;
    __builtin_amdgcn_s_waitcnt(0);
    unsigned nloc = b.st[0], nx = b.st[1];
    if (nloc == 0u) { unsigned sbf; xcd_barrier_complete(bar, b.x, nloc, nx, sbf); b.st[0] = nloc; b.st[1] = nx; b.st[2] = sbf; }
    const unsigned old = xb_add(&bar[XB_XSUB(b.x)], 1u);
    const unsigned gen = old / nloc;
    if (old + 1u == (gen + 1u) * nloc) {
      __builtin_amdgcn_fence(__ATOMIC_RELEASE, "agent");
      asm volatile("s_waitcnt vmcnt(0)" ::: "memory");
      const unsigned og = xb_add(&bar[XB_TOP], 1u);
      const unsigned tg = og / nx;
      if (og + 1u == (tg + 1u) * nx) xb_add(&bar[XB_TOPGEN], 1u);
      else XB_SPIN(xb_ld(&bar[XB_TOPGEN]) == tg, bar);
      __builtin_amdgcn_fence(__ATOMIC_ACQUIRE, "agent");
      xb_add(&bar[XB_XGEN(b.x)], 1u);
      asm volatile("s_waitcnt vmcnt(0)" ::: "memory");
    } else {
      XB_SPIN(xb_ld(&bar[XB_XGEN(b.x)]) == gen, bar);
      __builtin_amdgcn_fence(__ATOMIC_ACQUIRE, "agent");
      asm volatile("s_waitcnt vmcnt(0)" ::: "memory");
    }
  }
  __syncthreads();
}

DI Params kargs() {
  Params P{};
#if defined(__HIP_DEVICE_COMPILE__)
  typedef const unsigned long long __attribute__((address_space(4))) CU;
  CU* q = (CU*)__builtin_amdgcn_kernarg_segment_ptr();
  asm volatile("" : "+s"(q));
#define GP(T, i) ((T*)(T __attribute__((address_space(1)))*)(q[i]))
  P.x = GP(const float, 0);
  P.c = GP(const float, 1);
  P.ctx = GP(const float, 2);
  P.c_ctx = GP(const float, 3);
  P.w_mod = GP(const float, 4);
  P.b_mod = GP(const float, 5);
  P.norm_mix_g = GP(const float, 6);
  P.norm_ffn_g = GP(const float, 7);
  P.final_norm_g = GP(const float, 8);
  P.ab_w_in = GP(const float, 9);
  P.ab_conv_w = GP(const float, 10);
  P.ab_gate_b = GP(const float, 11);
  P.ab_head_g = GP(const float, 12);
  P.ab_sink = GP(const float, 13);
  P.ab_w_out = GP(const float, 14);
  P.gm_w_in = GP(const float, 15);
  P.gm_ln_g = GP(const float, 16);
  P.gm_ln_b = GP(const float, 17);
  P.gm_w_s = GP(const float, 18);
  P.gm_b_s = GP(const float, 19);
  P.gm_w_out = GP(const float, 20);
  P.moe_w_router = GP(const float, 21);
  P.moe_w_gate = GP(const float, 22);
  P.moe_w_up = GP(const float, 23);
  P.moe_w_down = GP(const float, 24);
  P.out = GP(float, 25);
  P.ws = GP(char, 26);
#undef GP
#endif
  return P;
}
#if COOP
#ifndef REPEAT_MASK
#define REPEAT_MASK 0
#endif
__global__ void __launch_bounds__(256, 2) mega(Params p_unused) {
  __shared__ __attribute__((aligned(16))) char smem[73728 + 16];
  unsigned* xbw = (unsigned*)(smem + 73728);
  cg::grid_group grid = cg::this_grid();
  if (threadIdx.x < 4) xbw[threadIdx.x] = 0u;
  __syncthreads();
  XcdBarrier xb;
  { const Params pp = kargs(); xb = xcd_barrier_post((unsigned*)(pp.ws + O_BAR), (volatile LAS unsigned*)xbw); }
#define PHX(n) { const Params pp = kargs(); run_phase(pp, n, smem); } xcd_barrier(xb); \
  if ((REPEAT_MASK >> n) & 1) { { const Params pp = kargs(); run_phase(pp, n, smem); } xcd_barrier(xb); }
  { const Params pp = kargs(); run_phase(pp, 0, smem); }
  if (p_unused.ws == nullptr) grid.sync();
  xcd_barrier(xb);
  PHX(1) PHX(2) PHX(3) PHX(4) PHX(5) PHX(6) PHX(7) PHX(8) PHX(9) PHX(10)
  PHX(11) PHX(12) PHX(13) PHX(14) PHX(15) PHX(16) PHX(17) PHX(18) PHX(19) PHX(20)
  { const Params pp = kargs(); run_phase(pp, 21, smem); }
}
#else
__global__ void __launch_bounds__(256, 2) mega(Params p, int ph) {
  __shared__ __attribute__((aligned(16))) char smem[73728];
  run_phase(p, ph, smem);
}
#endif

extern "C" void kernel_launch(void* const* d_in, const int* in_sizes, int n_in, void* d_out, int out_size, void* d_ws,
                              size_t ws_size, hipStream_t stream) {
  (void)in_sizes; (void)n_in; (void)out_size;
  if (ws_size < WS_NEED) { fprintf(stderr, "workspace too small: %zu < %zu\n", ws_size, (size_t)WS_NEED); return; }
  static int grid_blocks = 0;
  if (!grid_blocks) {
    int dev = 0, cus = 0, per_cu = 0;
    hipGetDevice(&dev);
    hipDeviceGetAttribute(&cus, hipDeviceAttributeMultiprocessorCount, dev);
    hipOccupancyMaxActiveBlocksPerMultiprocessor(&per_cu, mega, 256, 0);
    if (per_cu < 1) per_cu = 1;
    if (per_cu > 2) per_cu = 2;
    grid_blocks = cus * per_cu;
  }
  Params p{};
  const float** f = (const float**)&p;
  for (int i = 0; i < 25; ++i) f[i] = (const float*)d_in[i];
  p.out = (float*)d_out;
  p.ws = (char*)d_ws;
#if COOP
  hipMemsetAsync((char*)d_ws + O_BAR, 0, XCD_BAR_WORDS * 4, stream);
  void* args[] = {&p};
  hipError_t e = hipLaunchCooperativeKernel((void*)mega, dim3(grid_blocks), dim3(256), args, 0, stream);
  if (e != hipSuccess) fprintf(stderr, "cooperative launch failed: %s (grid %d)\n", hipGetErrorString(e), grid_blocks);
#else
  for (int ph = 0; ph < NPHASE; ++ph) hipLaunchKernelGGL(mega, dim3(grid_blocks), dim3(256), 0, stream, p, ph);
#endif
}
```

```cpp
#include <hip/hip_runtime.h>
#include <hip/hip_cooperative_groups.h>
#include <cstdio>
namespace cg = cooperative_groups;

#define DI __device__ __forceinline__
typedef unsigned short bf16_t;
using bf16x8 = __attribute__((ext_vector_type(8))) short;
using s16x4 = __attribute__((ext_vector_type(4))) short;
using f32x16 = __attribute__((ext_vector_type(16))) float;
#define MFMA(a, b, c) __builtin_amdgcn_mfma_f32_32x32x16_bf16((a), (b), (c), 0, 0, 0)

#ifndef COOP
#define COOP 1
#endif

constexpr int DM = 1024, NBAT = 2, SEQ = 8192, NTOK = NBAT * SEQ, CTXL = 256, NROW = NTOK + NBAT * CTXL;
constexpr int PLD = 2816;
constexpr int NSTEP = 66;
constexpr float EPS = 1e-6f;

constexpr size_t al256(size_t x) { return (x + 255) & ~(size_t)255; }
constexpr size_t O_BAR = 0;
constexpr size_t O_WIN = 16384;
constexpr size_t O_WOUT = O_WIN + al256((size_t)PLD * 1024 * 2);
constexpr size_t O_GMIN = O_WOUT + al256((size_t)1024 * 1024 * 2);
constexpr size_t O_GMOUT = O_GMIN + al256((size_t)4096 * 1024 * 2);
constexpr size_t O_MGU = O_GMOUT + al256((size_t)1024 * 2048 * 2);
constexpr size_t O_MD = O_MGU + al256((size_t)16 * 2048 * 1024 * 2);
constexpr size_t O_MODV = O_MD + al256((size_t)16 * 1024 * 1024 * 2);
constexpr size_t O_HA = O_MODV + al256((size_t)2 * 3 * 6144 * 4);
constexpr size_t O_GL = O_HA + al256((size_t)NROW * 1024 * 2);
constexpr size_t O_AFF = O_GL + al256((size_t)NROW * 16 * 4);
constexpr size_t O_IDX = O_AFF + al256((size_t)32 * 8192 * 4);
constexpr size_t O_GATE = O_IDX + al256((size_t)32 * 1024 * 4);
constexpr size_t O_STATS = O_GATE + al256((size_t)32 * 1024 * 4);
constexpr size_t O_GSC = O_STATS + al256((size_t)NTOK * 16 * 4);
constexpr size_t O_MLOC = O_GSC + al256((size_t)16 * NSTEP * 4);
constexpr size_t O_DN = O_MLOC + al256((size_t)16 * NSTEP * 4);
constexpr size_t O_NST = O_DN + al256((size_t)16 * NSTEP * 128 * 4);
constexpr size_t O_MST = O_NST + al256((size_t)16 * 64 * 128 * 4);
constexpr size_t O_INV = O_MST + al256((size_t)16 * 64 * 4);
constexpr size_t O_R12 = O_INV + al256((size_t)NTOK * 16 * 4);
constexpr size_t O_P = O_R12;
constexpr size_t O_QC = O_P + al256((size_t)NROW * PLD * 2);
constexpr size_t O_KC = O_QC + al256((size_t)NTOK * 512 * 2);
constexpr size_t O_KT = O_KC + al256((size_t)NTOK * 512 * 2);
constexpr size_t O_VT = O_KT + al256((size_t)132 * 4 * 128 * 128 * 2);
constexpr size_t O_RQ = O_VT + al256((size_t)132 * 4 * 128 * 128 * 2);
constexpr size_t O_RK = O_RQ + al256((size_t)NTOK * 512 * 2);
constexpr size_t O_AVTX = O_RK + al256((size_t)NROW * 128 * 2);
constexpr size_t O_AVTC = O_AVTX + al256((size_t)4 * 64 * 8192 * 2);
constexpr size_t O_R12_END = O_AVTC + al256((size_t)4 * 64 * 256 * 2);
constexpr size_t O_HID = O_R12;
constexpr size_t O_U = O_R12;
constexpr size_t O_GVT = O_U + al256((size_t)NTOK * 2048 * 2);
static_assert(O_GVT + (size_t)NTOK * 2048 * 2 <= O_R12_END, "R12 too small");
constexpr size_t O_DC = O_R12_END;
constexpr size_t O_CST = O_DC + al256((size_t)16 * NSTEP * 16384 * 4);
constexpr size_t O_UV = O_DC;
constexpr size_t O_YE = O_DC;
constexpr size_t WS_NEED = O_CST + al256((size_t)16 * 64 * 16384 * 2);

struct Params {
  const float *x, *c, *ctx, *c_ctx, *w_mod, *b_mod, *norm_mix_g, *norm_ffn_g, *final_norm_g;
  const float *ab_w_in, *ab_conv_w, *ab_gate_b, *ab_head_g, *ab_sink, *ab_w_out;
  const float *gm_w_in, *gm_ln_g, *gm_ln_b, *gm_w_s, *gm_b_s, *gm_w_out;
  const float *moe_w_router, *moe_w_gate, *moe_w_up, *moe_w_down;
  float* out;
  char* ws;
};

DI bf16_t f2bf(float x) { unsigned u = __float_as_uint(x); u += 0x7fffu + ((u >> 16) & 1u); return (bf16_t)(u >> 16); }
DI float bf2f(bf16_t b) { return __uint_as_float(((unsigned)b) << 16); }
DI unsigned pack2(float a, float b) { return (unsigned)f2bf(a) | ((unsigned)f2bf(b) << 16); }
DI bf16x8 pack8(float a0, float a1, float a2, float a3, float a4, float a5, float a6, float a7) {
  uint4 u; u.x = pack2(a0, a1); u.y = pack2(a2, a3); u.z = pack2(a4, a5); u.w = pack2(a6, a7);
  return __builtin_bit_cast(bf16x8, u);
}
DI bf16x8 ldfrag(const bf16_t* p) { return *(const bf16x8*)p; }
DI bf16x8 ldfrag2(const bf16_t* p0, const bf16_t* p1) {
  s16x4 lo = *(const s16x4*)p0, hi = *(const s16x4*)p1;
  return __builtin_shufflevector(lo, hi, 0, 1, 2, 3, 4, 5, 6, 7);
}
DI int crow(int i, int hh) { return (i & 3) + 8 * (i >> 2) + 4 * hh; }
DI float siluf(float x) { return x / (1.f + __expf(-x)); }
DI float sigmf(float x) { return 1.f / (1.f + __expf(-x)); }
DI float logsigf(float x) { return fminf(x, 0.f) - log1pf(expf(-fabsf(x))); }
DI float geluf(float x) {
  const float u2 = 1.5957691216057308f * (x + 0.044715f * x * x * x);
  return x / (1.f + __expf(-u2));
}
DI float wsum(float v) {
#pragma unroll
  for (int o = 32; o > 0; o >>= 1) v += __shfl_xor(v, o);
  return v;
}
DI int tid() { int t = threadIdx.x; asm volatile("" : "+v"(t)); return t; }
DI f32x16 fzero() { f32x16 z; for (int i = 0; i < 16; ++i) z[i] = 0.f; return z; }

DI int tmap(int kind, int n) {
  if (kind == 0) return n;
  if (kind == 1) return n < 2048 ? n : (n < 2064 ? -1 : n - 16);
  int r = (n >> 6) * 128 + ((n >> 5) & 1) * 64 + (n & 31);
  return kind == 2 ? r : r + 32;
}
DI void tconv(const float* __restrict__ src, int ldn, int ncols, int K, int nmat, size_t sstride,
              bf16_t* __restrict__ dst, size_t dstride, int kind, char* smem) {
  float* sm = (float*)smem;
  const int t = tid();
  const int ntn = (ncols + 63) >> 6, ntk = K >> 6, per = ntn * ntk, total = per * nmat;
  const int c4 = t & 15, rr = t >> 4;
  float4 v0, v1, v2, v3;
#define TC_LOAD(tile_) { const int mat_ = (tile_) / per, tt_ = (tile_) % per; const int k0_ = (tt_ / ntn) * 64, n_ = (tt_ % ntn) * 64 + c4 * 4; \
    const float* s_ = src + (size_t)mat_ * sstride + (size_t)(k0_ + rr) * ldn + n_; \
    if (n_ < ncols) { v0 = *(const float4*)(s_); v1 = *(const float4*)(s_ + (size_t)16 * ldn); v2 = *(const float4*)(s_ + (size_t)32 * ldn); v3 = *(const float4*)(s_ + (size_t)48 * ldn); } \
    else { v0 = v1 = v2 = v3 = make_float4(0.f, 0.f, 0.f, 0.f); } }
  int tile = blockIdx.x;
  if (tile < total) TC_LOAD(tile)
  for (; tile < total; tile += gridDim.x) {
    const int mat = tile / per, tt = tile % per;
    const int k0 = (tt / ntn) * 64, n0 = (tt % ntn) * 64;
    bf16_t* d = dst + (size_t)mat * dstride;
    {
      float* q = sm + rr * 65 + c4 * 4;
      q[0] = v0.x; q[1] = v0.y; q[2] = v0.z; q[3] = v0.w;
      q[16 * 65 + 0] = v1.x; q[16 * 65 + 1] = v1.y; q[16 * 65 + 2] = v1.z; q[16 * 65 + 3] = v1.w;
      q[32 * 65 + 0] = v2.x; q[32 * 65 + 1] = v2.y; q[32 * 65 + 2] = v2.z; q[32 * 65 + 3] = v2.w;
      q[48 * 65 + 0] = v3.x; q[48 * 65 + 1] = v3.y; q[48 * 65 + 2] = v3.z; q[48 * 65 + 3] = v3.w;
    }
    if (tile + (int)gridDim.x < total) TC_LOAD(tile + (int)gridDim.x)
    __syncthreads();
    const int nl = t >> 2, kq = t & 3, n = n0 + nl;
    if (n < ncols) {
      const int row = tmap(kind, n);
      if (row >= 0) {
        uint4 o0, o1;
        const float* q = sm + (kq * 16) * 65 + nl;
        o0.x = pack2(q[0 * 65], q[1 * 65]); o0.y = pack2(q[2 * 65], q[3 * 65]); o0.z = pack2(q[4 * 65], q[5 * 65]); o0.w = pack2(q[6 * 65], q[7 * 65]);
        o1.x = pack2(q[8 * 65], q[9 * 65]); o1.y = pack2(q[10 * 65], q[11 * 65]); o1.z = pack2(q[12 * 65], q[13 * 65]); o1.w = pack2(q[14 * 65], q[15 * 65]);
        uint4* dp = (uint4*)(d + (size_t)row * K + k0 + kq * 16);
        dp[0] = o0; dp[1] = o1;
      }
    }
    __syncthreads();
  }
#undef TC_LOAD
}
DI void tconv_moe(const Params& p, int layer, char* smem) {
  const size_t wo = (size_t)layer * 16 * 1024 * 1024;
  tconv(p.moe_w_gate + wo, 1024, 1024, 1024, 16, (size_t)1024 * 1024, (bf16_t*)(p.ws + O_MGU), (size_t)2048 * 1024, 2, smem);
  tconv(p.moe_w_up + wo, 1024, 1024, 1024, 16, (size_t)1024 * 1024, (bf16_t*)(p.ws + O_MGU), (size_t)2048 * 1024, 3, smem);
  tconv(p.moe_w_down + wo, 1024, 1024, 1024, 16, (size_t)1024 * 1024, (bf16_t*)(p.ws + O_MD), (size_t)1024 * 1024, 0, smem);
}

DI void phase_adaln(const Params& p, char* smem) {
  float* sv = (float*)smem;
  float* red = sv + 3 * 1024;
  float* modv = (float*)(p.ws + O_MODV);
  const int t = tid();
  if (blockIdx.x >= 192) return;
  for (int i = t; i < 3 * 1024; i += 256) {
    const int v = i >> 10, k = i & 1023;
    const float cv = v < 2 ? p.c[v * 1024 + k] : p.c_ctx[k];
    sv[i] = siluf(cv);
  }
  __syncthreads();
  for (int item = blockIdx.x; item < 192; item += gridDim.x) {
    const int l = item / 96, cb = item % 96;
    const int cq = t & 15, kg = t >> 4;
    const float* w = p.w_mod + (size_t)l * 1024 * 6144 + cb * 64 + cq * 4;
    float a0[4] = {0.f, 0.f, 0.f, 0.f}, a1[4] = {0.f, 0.f, 0.f, 0.f}, a2[4] = {0.f, 0.f, 0.f, 0.f};
    for (int i = 0; i < 64; ++i) {
      const int k = kg + 16 * i;
      const float4 wv = *(const float4*)(w + (size_t)k * 6144);
      const float s0 = sv[k], s1 = sv[1024 + k], s2 = sv[2048 + k];
      a0[0] += s0 * wv.x; a0[1] += s0 * wv.y; a0[2] += s0 * wv.z; a0[3] += s0 * wv.w;
      a1[0] += s1 * wv.x; a1[1] += s1 * wv.y; a1[2] += s1 * wv.z; a1[3] += s1 * wv.w;
      a2[0] += s2 * wv.x; a2[1] += s2 * wv.y; a2[2] += s2 * wv.z; a2[3] += s2 * wv.w;
    }
#pragma unroll
    for (int j = 0; j < 4; ++j) {
      red[(kg * 3 + 0) * 64 + cq * 4 + j] = a0[j];
      red[(kg * 3 + 1) * 64 + cq * 4 + j] = a1[j];
      red[(kg * 3 + 2) * 64 + cq * 4 + j] = a2[j];
    }
    __syncthreads();
    if (t < 192) {
      const int v = t >> 6, col = t & 63;
      float s = 0.f;
      for (int g = 0; g < 16; ++g) s += red[(g * 3 + v) * 64 + col];
      const int cc = cb * 64 + col;
      modv[(l * 3 + v) * 6144 + cc] = s + p.b_mod[l * 6144 + cc];
    }
    __syncthreads();
  }
}

DI void moe_combine_row(const Params& p, int row, int lane, float4 (&acc)[4]) {
  const int* INV = (const int*)(p.ws + O_INV); const float* GATE = (const float*)(p.ws + O_GATE);
  const bf16_t* YE = (const bf16_t*)(p.ws + O_YE);
  const int b = row >> 13;
  const int myslot = INV[(size_t)row * 16 + (lane & 15)];
#pragma unroll
  for (int i = 0; i < 4; ++i) acc[i] = make_float4(0.f, 0.f, 0.f, 0.f);
#pragma unroll 1
  for (int e = 0; e < 16; ++e) {
    const int slot = __builtin_amdgcn_readlane(myslot, e);
    if (slot != 0) {
      const int be = b * 16 + e;
      const float g = GATE[be * 1024 + slot - 1];
      const bf16_t* yr = YE + ((size_t)be * 1024 + slot - 1) * 1024;
#pragma unroll
      for (int i = 0; i < 4; ++i) {
        const s16x4 v = *(const s16x4*)(yr + (i * 64 + lane) * 4);
        acc[i].x += g * bf2f((bf16_t)v[0]); acc[i].y += g * bf2f((bf16_t)v[1]); acc[i].z += g * bf2f((bf16_t)v[2]); acc[i].w += g * bf2f((bf16_t)v[3]);
      }
    }
  }
}

template <int MODE, bool COMB>
DI void phase_modulate(const Params& p, int layer, int which, char* smem) {
  float* wt = (float*)smem;
  const int t = tid(), lane = t & 63, w = t >> 6;
  const float* modv = (const float*)(p.ws + O_MODV);
  bf16_t* HA = (bf16_t*)(p.ws + O_HA);
  if (MODE != 0) {
    const float* W = MODE == 1 ? p.ab_w_in + 2048 : p.moe_w_router + (size_t)layer * 1024 * 16;
    const int ld = MODE == 1 ? 2832 : 16;
    for (int i = t; i < 4096; i += 256) {
      const int k = i >> 2, e4 = i & 3;
      const float4 v = *(const float4*)(W + (size_t)k * ld + e4 * 4);
      wt[(e4 * 4 + 0) * 1024 + k] = v.x; wt[(e4 * 4 + 1) * 1024 + k] = v.y; wt[(e4 * 4 + 2) * 1024 + k] = v.z; wt[(e4 * 4 + 3) * 1024 + k] = v.w;
    }
    __syncthreads();
  }
  const float* gn = (which == 0 ? p.norm_mix_g : p.norm_ffn_g) + layer * 1024;
  const int nrows = MODE == 1 ? NROW : NTOK;
  const int rstride = gridDim.x * 4;
  float4 nx[4];
#define MOD_SRC(row_) (MODE == 1 ? ((row_) < NTOK ? p.x + (size_t)(row_) * 1024 : p.ctx + (size_t)((row_) - NTOK) * 1024) : p.out + (size_t)(row_) * 1024)
  {
    const int row0_ = blockIdx.x * 4 + w;
    if (row0_ < nrows) {
      const float* s0_ = MOD_SRC(row0_);
#pragma unroll
      for (int i = 0; i < 4; ++i) nx[i] = *(const float4*)(s0_ + (i * 64 + lane) * 4);
    }
  }
  for (int row = blockIdx.x * 4 + w; row < nrows; row += rstride) {
    const int v = (MODE == 1 && row >= NTOK) ? 2 : (row >> 13);
    const float* sh = modv + (layer * 3 + v) * 6144 + (which ? 3 : 0) * 1024;
    const float* sc = sh + 1024;
    float4 xv[4];
    float ss = 0.f;
#pragma unroll
    for (int i = 0; i < 4; ++i) xv[i] = nx[i];
    if (row + rstride < nrows) {
      const float* s1_ = MOD_SRC(row + rstride);
#pragma unroll
      for (int i = 0; i < 4; ++i) nx[i] = *(const float4*)(s1_ + (i * 64 + lane) * 4);
    }
    if (COMB) {
      float4 ca[4];
      moe_combine_row(p, row, lane, ca);
      const float* g2 = modv + ((layer - 1) * 3 + v) * 6144 + 5 * 1024;
#pragma unroll
      for (int i = 0; i < 4; ++i) {
        const float4 gg = *(const float4*)(g2 + (i * 64 + lane) * 4);
        xv[i].x += gg.x * ca[i].x; xv[i].y += gg.y * ca[i].y; xv[i].z += gg.z * ca[i].z; xv[i].w += gg.w * ca[i].w;
        *(float4*)(p.out + (size_t)row * 1024 + (i * 64 + lane) * 4) = xv[i];
      }
    }
#pragma unroll
    for (int i = 0; i < 4; ++i) ss += xv[i].x * xv[i].x + xv[i].y * xv[i].y + xv[i].z * xv[i].z + xv[i].w * xv[i].w;
    ss = wsum(ss);
    const float rstd = rsqrtf(ss * (1.f / 1024.f) + EPS);
    float4 yv[4];
#pragma unroll
    for (int i = 0; i < 4; ++i) {
      const int col = (i * 64 + lane) * 4;
      const float4 g4 = *(const float4*)(gn + col), s4 = *(const float4*)(sh + col), c4 = *(const float4*)(sc + col);
      float4 y;
      y.x = xv[i].x * rstd * g4.x * (1.f + c4.x) + s4.x;
      y.y = xv[i].y * rstd * g4.y * (1.f + c4.y) + s4.y;
      y.z = xv[i].z * rstd * g4.z * (1.f + c4.z) + s4.z;
      y.w = xv[i].w * rstd * g4.w * (1.f + c4.w) + s4.w;
      yv[i] = y;
      uint2 o; o.x = pack2(y.x, y.y); o.y = pack2(y.z, y.w);
      *(uint2*)(HA + (size_t)row * 1024 + col) = o;
    }
    if (MODE != 0) {
      float mine = 0.f;
#pragma unroll 1
      for (int e4 = 0; e4 < 16; e4 += 4) {
        float pe0 = 0.f, pe1 = 0.f, pe2 = 0.f, pe3 = 0.f;
#pragma unroll
        for (int i = 0; i < 4; ++i) {
          const float* wp = wt + e4 * 1024 + (i * 64 + lane) * 4;
          const float4 wa = *(const float4*)(wp), wb = *(const float4*)(wp + 1024), wc = *(const float4*)(wp + 2048), wd = *(const float4*)(wp + 3072);
          pe0 += yv[i].x * wa.x + yv[i].y * wa.y + yv[i].z * wa.z + yv[i].w * wa.w;
          pe1 += yv[i].x * wb.x + yv[i].y * wb.y + yv[i].z * wb.z + yv[i].w * wb.w;
          pe2 += yv[i].x * wc.x + yv[i].y * wc.y + yv[i].z * wc.z + yv[i].w * wc.w;
          pe3 += yv[i].x * wd.x + yv[i].y * wd.y + yv[i].z * wd.z + yv[i].w * wd.w;
        }
#pragma unroll
        for (int o = 32; o > 0; o >>= 1) {
          const float q0 = __shfl_xor(pe0, o), q1 = __shfl_xor(pe1, o), q2 = __shfl_xor(pe2, o), q3 = __shfl_xor(pe3, o);
          pe0 += q0; pe1 += q1; pe2 += q2; pe3 += q3;
        }
        const int el = (lane & 15) - e4;
        mine = el == 0 ? pe0 : (el == 1 ? pe1 : (el == 2 ? pe2 : (el == 3 ? pe3 : mine)));
      }
      const int e = lane & 15;
      if (MODE == 1) {
        float val = mine + p.ab_gate_b[e];
        if (((e >> 2) & 1) == 1) val = logsigf(val);
        if (lane < 16) ((float*)(p.ws + O_GL))[(size_t)row * 16 + lane] = val;
      } else {
        float mx = mine;
#pragma unroll
        for (int o = 8; o > 0; o >>= 1) mx = fmaxf(mx, __shfl_xor(mx, o));
        const float ex = expf(mine - mx);
        float sum = ex;
#pragma unroll
        for (int o = 8; o > 0; o >>= 1) sum += __shfl_xor(sum, o);
        if (lane < 16) ((float*)(p.ws + O_AFF))[((size_t)(row >> 13) * 16 + lane) * 8192 + (row & 8191)] = ex / sum;
        if (lane < 16) ((int*)(p.ws + O_INV))[(size_t)row * 16 + lane] = 0;
      }
    }
  }
}

template <bool DENSEA, class Epi>
DI void gemm_tile(const bf16_t* Abase, const unsigned (&aoff)[8], const bf16_t* Bbase, unsigned boff, int K, char* smem, Epi&& epi) {
  bf16_t* sA = (bf16_t*)smem;
  bf16_t* sB = sA + 256 * 72;
  const int t = tid(), lane = t & 63, w = t >> 6, wm = w >> 1, wn = w & 1, r = lane & 31, hh = lane >> 5;
  const int lrow = t >> 3, lcol = (t & 7) * 8;
  const unsigned bst = 32u * (unsigned)K;
  f32x16 acc[4][2];
#pragma unroll
  for (int i = 0; i < 4; ++i) { acc[i][0] = fzero(); acc[i][1] = fzero(); }
  uint4 A0, A1, A2, A3, A4, A5, A6, A7, B0, B1, B2, B3;
#define GLOADT(kn_) { \
    const bf16_t* Ak_ = Abase + (kn_); const bf16_t* Bk_ = Bbase + (kn_);     \
    if (DENSEA) { \
      A0 = *(const uint4*)(Ak_ + aoff[0]); A1 = *(const uint4*)((Ak_ + bst) + aoff[0]); A2 = *(const uint4*)((Ak_ + 2 * bst) + aoff[0]); A3 = *(const uint4*)((Ak_ + 3 * bst) + aoff[0]); \
      A4 = *(const uint4*)((Ak_ + 4 * bst) + aoff[0]); A5 = *(const uint4*)((Ak_ + 5 * bst) + aoff[0]); A6 = *(const uint4*)((Ak_ + 6 * bst) + aoff[0]); A7 = *(const uint4*)((Ak_ + 7 * bst) + aoff[0]); \
    } else { \
      A0 = *(const uint4*)(Ak_ + aoff[0]); A1 = *(const uint4*)(Ak_ + aoff[1]); A2 = *(const uint4*)(Ak_ + aoff[2]); A3 = *(const uint4*)(Ak_ + aoff[3]); \
      A4 = *(const uint4*)(Ak_ + aoff[4]); A5 = *(const uint4*)(Ak_ + aoff[5]); A6 = *(const uint4*)(Ak_ + aoff[6]); A7 = *(const uint4*)(Ak_ + aoff[7]); \
    } \
    B0 = *(const uint4*)(Bk_ + boff); B1 = *(const uint4*)((Bk_ + bst) + boff); B2 = *(const uint4*)((Bk_ + 2 * bst) + boff); B3 = *(const uint4*)((Bk_ + 3 * bst) + boff); }
  GLOADT(0)
  const int so = lrow * 72 + lcol;
  const bf16_t* cA = sA + (wm * 128 + r) * 72 + hh * 8;
  const bf16_t* cB = sB + (wn * 64 + r) * 72 + hh * 8;
  const int KT = K >> 6;
  for (int kt = 0; kt < KT; ++kt) {
    __syncthreads();
    *(uint4*)(sA + so) = A0; *(uint4*)(sA + so + 32 * 72) = A1; *(uint4*)(sA + so + 64 * 72) = A2; *(uint4*)(sA + so + 96 * 72) = A3;
    *(uint4*)(sA + so + 128 * 72) = A4; *(uint4*)(sA + so + 160 * 72) = A5; *(uint4*)(sA + so + 192 * 72) = A6; *(uint4*)(sA + so + 224 * 72) = A7;
    *(uint4*)(sB + so) = B0; *(uint4*)(sB + so + 32 * 72) = B1; *(uint4*)(sB + so + 64 * 72) = B2; *(uint4*)(sB + so + 96 * 72) = B3;
    { const int kn = (kt + 1 < KT ? kt + 1 : kt) * 64; GLOADT(kn) }
    __builtin_amdgcn_sched_barrier(0);
    __syncthreads();
    __builtin_amdgcn_sched_barrier(0);
    __builtin_amdgcn_s_setprio(1);
    __builtin_amdgcn_iglp_opt(0);
#pragma unroll
    for (int ks = 0; ks < 4; ++ks) {
      const bf16x8 b0 = *(const bf16x8*)(cB + ks * 16), b1 = *(const bf16x8*)(cB + 32 * 72 + ks * 16);
#pragma unroll
      for (int mi = 0; mi < 4; ++mi) {
        const bf16x8 a = *(const bf16x8*)(cA + mi * 32 * 72 + ks * 16);
        acc[mi][0] = MFMA(a, b0, acc[mi][0]);
        acc[mi][1] = MFMA(a, b1, acc[mi][1]);
      }
      if (ks == 1) { __builtin_amdgcn_sched_barrier(0); __builtin_amdgcn_iglp_opt(0); }
    }
    __builtin_amdgcn_s_setprio(0);
    __builtin_amdgcn_sched_barrier(0);
  }
#undef GLOADT
  epi(acc, wm * 128, wn * 64, r, hh);
}

struct TileWalk {
  int L, Lend, nl;
  DI TileWalk(int T, const char* smem) {
    const volatile unsigned* xw = (const volatile unsigned*)(smem + 73728);
    const int nloc = (int)xw[0], sb = (int)xw[2], rk = (int)xw[3];
    int G = (int)gridDim.x;
    asm volatile("" : "+s"(G));
    nl = nloc;
    L = (T * sb) / G + rk; Lend = (T * (sb + nloc)) / G;
  }
  DI bool valid() const { return L < Lend; }
  DI void next() { L += nl; }
  DI void get(int SM, int SN, int nsn, int& mt, int& nt) const {
    const int s = L / (SM * SN), wi = L % (SM * SN);
    mt = (s / nsn) * SM + wi / SN; nt = (s % nsn) * SN + wi % SN;
  }
};

template <class MakeEpi>
DI void gemm_dense(const bf16_t* A, const bf16_t* Bt, int M, int N, int K, int SM, int SN, char* smem, MakeEpi&& mk) {
  const int t = tid(), lrow = t >> 3, lcol = (t & 7) * 8;
  const int ntn = N >> 7, ntm = M >> 8;
  for (TileWalk tw(ntn * ntm, smem); tw.valid(); tw.next()) {
    int mt, nt; tw.get(SM, SN, ntn / SN, mt, nt);
    unsigned aoff[8];
#pragma unroll
    for (int i = 0; i < 8; ++i) aoff[i] = (unsigned)(lrow + 32 * i) * (unsigned)K + (unsigned)lcol;
    gemm_tile<true>(A + (size_t)mt * 256 * K, aoff, Bt + (size_t)(nt * 128) * K, (unsigned)lrow * (unsigned)K + (unsigned)lcol, K, smem, mk(mt * 256, nt * 128));
  }
}

DI void phase_prep2(const Params& p, char* smem) {
  bf16_t* T = (bf16_t*)smem;
  const bf16_t* P = (const bf16_t*)(p.ws + O_P);
  bf16_t* Qc = (bf16_t*)(p.ws + O_QC); bf16_t* Kc = (bf16_t*)(p.ws + O_KC);
  bf16_t* KT = (bf16_t*)(p.ws + O_KT); bf16_t* VT = (bf16_t*)(p.ws + O_VT);
  bf16_t* RQ = (bf16_t*)(p.ws + O_RQ); bf16_t* RK = (bf16_t*)(p.ws + O_RK);
  bf16_t* AVTX = (bf16_t*)(p.ws + O_AVTX); bf16_t* AVTC = (bf16_t*)(p.ws + O_AVTC);
  const int t = tid();
  for (int item = blockIdx.x; item < 132 * 6; item += gridDim.x) {
    const int sc = item / 6, part = item % 6;
    const bool isx = sc < 128;
    const int row0 = sc * 128;
    const int seq_lo = isx ? (sc >> 6) * 8192 : NTOK + ((sc - 128) >> 1) * 256;
    const int seq_hi = seq_lo + (isx ? 8192 : 256);
    if (part < 4) {
      const int h = part;
      const int col8 = t & 15, rsub = t >> 4;
      for (int pass = 0; pass < 3; ++pass) {
        if (pass == 2 && !isx) break;
        const int pcol = (pass == 0 ? 512 : (pass == 1 ? 1024 : 0)) + h * 128 + col8 * 8;
        float cw[5][8];
        if (pass != 1) {
#pragma unroll
          for (int j = 0; j < 5; ++j)
#pragma unroll
            for (int e = 0; e < 8; ++e) cw[j][e] = p.ab_conv_w[j * 1024 + (pass == 0 ? 512 : 0) + h * 128 + col8 * 8 + e];
        }
        for (int i = 0; i < 8; ++i) {
          const int rl = rsub + 16 * i, row = row0 + rl;
          uint4 o;
          if (pass == 1) {
            o = *(const uint4*)(P + (size_t)row * PLD + pcol);
          } else {
            float a[8];
#pragma unroll
            for (int e = 0; e < 8; ++e) a[e] = 0.f;
#pragma unroll
            for (int j = 0; j < 5; ++j) {
              const int rr = row + j - 2;
              if (rr >= seq_lo && rr < seq_hi) {
                const bf16x8 v = *(const bf16x8*)(P + (size_t)rr * PLD + pcol);
#pragma unroll
                for (int e = 0; e < 8; ++e) a[e] += cw[j][e] * bf2f((bf16_t)v[e]);
              }
            }
            const float scl = pass == 0 ? 0.08838834764831845f : 1.f;
#pragma unroll
            for (int e = 0; e < 8; ++e) a[e] = siluf(a[e]) * scl;
            o.x = pack2(a[0], a[1]); o.y = pack2(a[2], a[3]); o.z = pack2(a[4], a[5]); o.w = pack2(a[6], a[7]);
            if (isx) *(uint4*)((pass == 0 ? Kc : Qc) + (size_t)row * 512 + h * 128 + col8 * 8) = o;
          }
          if (pass < 2) *(uint4*)(T + rl * 136 + col8 * 8) = o;
        }
        if (pass < 2) {
          __syncthreads();
          bf16_t* dstT = (pass == 0 ? KT : VT) + (size_t)(sc * 4 + h) * 16384;
          const int d = t & 127, shf = t >> 7;
#pragma unroll
          for (int s8 = 0; s8 < 8; ++s8) {
            const bf16_t* q = T + (shf * 64 + s8 * 8) * 136 + d;
            uint4 o;
            o.x = (unsigned)q[0] | ((unsigned)q[136] << 16); o.y = (unsigned)q[2 * 136] | ((unsigned)q[3 * 136] << 16);
            o.z = (unsigned)q[4 * 136] | ((unsigned)q[5 * 136] << 16); o.w = (unsigned)q[6 * 136] | ((unsigned)q[7 * 136] << 16);
            *(uint4*)(dstT + d * 128 + shf * 64 + s8 * 8) = o;
          }
          __syncthreads();
        }
      }
    } else if (part == 4) {
      if (!isx) continue;
      for (int idx = t; idx < 512; idx += 256) {
        const int rl = idx >> 2, dc = idx & 3, row = row0 + rl, pos = row - seq_lo;
        const float rp = (float)(pos >> 6), cp = (float)(pos & 63);
        float cs[8], sn[8];
#pragma unroll
        for (int e = 0; e < 8; ++e) {
          const int a = dc * 8 + e;
          const float inv = powf(10000.f, -(float)(a & 15) / 16.f);
          const float ang = (a < 16 ? rp : cp) * inv;
          cs[e] = cosf(ang); sn[e] = sinf(ang);
        }
        for (int hq = 0; hq < 8; ++hq) {
          const bf16x8 x1 = *(const bf16x8*)(P + (size_t)row * PLD + 2048 + hq * 64 + dc * 8);
          const bf16x8 x2 = *(const bf16x8*)(P + (size_t)row * PLD + 2048 + hq * 64 + 32 + dc * 8);
          float o1[8], o2[8];
#pragma unroll
          for (int e = 0; e < 8; ++e) {
            const float a = bf2f((bf16_t)x1[e]), b = bf2f((bf16_t)x2[e]);
            o1[e] = (a * cs[e] - b * sn[e]) * 0.125f; o2[e] = (b * cs[e] + a * sn[e]) * 0.125f;
          }
          uint4 u1, u2;
          u1.x = pack2(o1[0], o1[1]); u1.y = pack2(o1[2], o1[3]); u1.z = pack2(o1[4], o1[5]); u1.w = pack2(o1[6], o1[7]);
          u2.x = pack2(o2[0], o2[1]); u2.y = pack2(o2[2], o2[3]); u2.z = pack2(o2[4], o2[5]); u2.w = pack2(o2[6], o2[7]);
          *(uint4*)(RQ + (size_t)row * 512 + hq * 64 + dc * 8) = u1;
          *(uint4*)(RQ + (size_t)row * 512 + hq * 64 + 32 + dc * 8) = u2;
        }
      }
    } else {
      for (int idx = t; idx < 512; idx += 256) {
        const int rl = idx >> 2, dc = idx & 3, row = row0 + rl, pos = row - seq_lo;
        const float rp = (float)(pos >> 6), cp = (float)(pos & 63);
        float cs[8], sn[8];
#pragma unroll
        for (int e = 0; e < 8; ++e) {
          const int a = dc * 8 + e;
          const float inv = powf(10000.f, -(float)(a & 15) / 16.f);
          const float ang = (a < 16 ? rp : cp) * inv;
          cs[e] = isx ? cosf(ang) : 1.f; sn[e] = isx ? sinf(ang) : 0.f;
        }
        for (int g = 0; g < 2; ++g) {
          const bf16x8 x1 = *(const bf16x8*)(P + (size_t)row * PLD + 2560 + g * 64 + dc * 8);
          const bf16x8 x2 = *(const bf16x8*)(P + (size_t)row * PLD + 2560 + g * 64 + 32 + dc * 8);
          float o1[8], o2[8];
#pragma unroll
          for (int e = 0; e < 8; ++e) {
            const float a = bf2f((bf16_t)x1[e]), b = bf2f((bf16_t)x2[e]);
            o1[e] = a * cs[e] - b * sn[e]; o2[e] = b * cs[e] + a * sn[e];
          }
          uint4 u1, u2;
          u1.x = pack2(o1[0], o1[1]); u1.y = pack2(o1[2], o1[3]); u1.z = pack2(o1[4], o1[5]); u1.w = pack2(o1[6], o1[7]);
          u2.x = pack2(o2[0], o2[1]); u2.y = pack2(o2[2], o2[3]); u2.z = pack2(o2[4], o2[5]); u2.w = pack2(o2[6], o2[7]);
          *(uint4*)(RK + (size_t)row * 128 + g * 64 + dc * 8) = u1;
          *(uint4*)(RK + (size_t)row * 128 + g * 64 + 32 + dc * 8) = u2;
        }
      }
      {
        const int col8 = t & 15, rsub = t >> 4;
        for (int i = 0; i < 8; ++i) {
          const int rl = rsub + 16 * i;
          *(uint4*)(T + rl * 136 + col8 * 8) = *(const uint4*)(P + (size_t)(row0 + rl) * PLD + 2688 + col8 * 8);
        }
        __syncthreads();
        const int d = t & 127, shf = t >> 7;
        const int b = isx ? (sc >> 6) : ((sc - 128) >> 1);
        const int pos0 = row0 - seq_lo;
        bf16_t* dst = isx ? AVTX + ((size_t)(b * 2 + (d >> 6)) * 64 + (d & 63)) * 8192 + pos0
                          : AVTC + ((size_t)(b * 2 + (d >> 6)) * 64 + (d & 63)) * 256 + pos0;
#pragma unroll
        for (int s8 = 0; s8 < 8; ++s8) {
          const bf16_t* q = T + (shf * 64 + s8 * 8) * 136 + d;
          uint4 o;
          o.x = (unsigned)q[0] | ((unsigned)q[136] << 16); o.y = (unsigned)q[2 * 136] | ((unsigned)q[3 * 136] << 16);
          o.z = (unsigned)q[4 * 136] | ((unsigned)q[5 * 136] << 16); o.w = (unsigned)q[6 * 136] | ((unsigned)q[7 * 136] << 16);
          *(uint4*)(dst + shf * 64 + s8 * 8) = o;
        }
        __syncthreads();
      }
    }
  }
}

DI void attn_item(const Params& p, int item, char* smem) {
  const int g = item & 1, qb = (item >> 1) & 255, b = item >> 9;
  int t_ = tid();
  asm volatile("" : "+v"(t_));
  const int t = t_, lane = t & 63, w = t >> 6, r = lane & 31, hh = lane >> 5;
  const int hq = g * 4 + w, q0 = qb * 32;
  const bf16_t* RQ = (const bf16_t*)(p.ws + O_RQ); const bf16_t* RK = (const bf16_t*)(p.ws + O_RK);
  const bf16_t* AVTX = (const bf16_t*)(p.ws + O_AVTX); const bf16_t* AVTC = (const bf16_t*)(p.ws + O_AVTC);
  bf16_t* MIX = (bf16_t*)(p.ws + O_HA);
  const size_t qrow = (size_t)b * 8192 + q0 + r;
  bf16x8 qf[4];
#pragma unroll
  for (int ks = 0; ks < 4; ++ks) qf[ks] = ldfrag(RQ + qrow * 512 + hq * 64 + ks * 16 + hh * 8);
  float m = p.ab_sink[hq], l = hh == 0 ? 1.f : 0.f;
  f32x16 o0 = fzero(), o1 = fzero();
  const int ipos = q0 + r;
  const int lo = q0 - 128 < 0 ? 0 : q0 - 128, hi = q0 + 128 > 8192 - 32 ? 8192 - 32 : q0 + 128;
  const int nloc = ((hi - lo) >> 5) + 1, ntile = nloc + 8;
  bf16_t* sKt = (bf16_t*)smem;
  bf16_t* sVt = sKt + 2 * 32 * 72;
  const bf16_t* kloc = RK + (size_t)(b * 8192) * 128 + g * 64 + (t >> 3) * 128 + (t & 7) * 8;
  const bf16_t* kctx = RK + (size_t)(NTOK + b * 256) * 128 + g * 64 + (t >> 3) * 128 + (t & 7) * 8;
  const bf16_t* vloc = AVTX + (size_t)((b * 2 + g) * 64 + (t >> 2)) * 8192 + (t & 3) * 8;
  const bf16_t* vctx = AVTC + (size_t)((b * 2 + g) * 64 + (t >> 2)) * 256 + (t & 3) * 8;
  const int skoff = (t >> 3) * 72 + (t & 7) * 8, svoff = (t >> 2) * 40 + (t & 3) * 8;
  uint4 gk, gv;
#define ATT_LOAD(j_) { const bool loc_ = (j_) < nloc; const int k0_ = loc_ ? lo + (j_) * 32 : ((j_) - nloc) * 32; \
    gk = *(const uint4*)((loc_ ? kloc : kctx) + (size_t)k0_ * 128); gv = *(const uint4*)((loc_ ? vloc : vctx) + k0_); }
  ATT_LOAD(0)
  __syncthreads();
  *(uint4*)(sKt + skoff) = gk; *(uint4*)(sVt + svoff) = gv;
  __syncthreads();
#pragma unroll 1
  for (int tile = 0; tile < ntile; ++tile) {
    const int cur = tile & 1;
    if (tile + 1 < ntile) ATT_LOAD(tile + 1)
    const bool local = tile < nloc;
    const int k0 = local ? lo + tile * 32 : (tile - nloc) * 32;
    const bf16_t* kt = sKt + cur * 32 * 72 + r * 72 + hh * 8;
    const bf16_t* vt = sVt + cur * 64 * 40 + r * 40 + 4 * hh;
    f32x16 s = fzero();
#pragma unroll
    for (int ks = 0; ks < 4; ++ks) s = MFMA(*(const bf16x8*)(kt + ks * 16), qf[ks], s);
    float tmax = -INFINITY;
#pragma unroll
    for (int i = 0; i < 16; ++i) {
      const int dj = ipos - (k0 + crow(i, hh));
      const bool ok = !local || (dj <= 128 && dj >= -128);
      s[i] = ok ? s[i] : -INFINITY;
      tmax = fmaxf(tmax, s[i]);
    }
    tmax = fmaxf(tmax, __shfl_xor(tmax, 32));
    const float mn = fmaxf(m, tmax), corr = __expf(m - mn);
    m = mn; l *= corr;
#pragma unroll
    for (int i = 0; i < 16; ++i) { o0[i] *= corr; o1[i] *= corr; }
#pragma unroll
    for (int i = 0; i < 16; ++i) { s[i] = __expf(s[i] - mn); l += s[i]; }
    const bf16x8 pf0 = pack8(s[0], s[1], s[2], s[3], s[4], s[5], s[6], s[7]);
    const bf16x8 pf1 = pack8(s[8], s[9], s[10], s[11], s[12], s[13], s[14], s[15]);
    o0 = MFMA(ldfrag2(vt, vt + 8), pf0, o0);
    o1 = MFMA(ldfrag2(vt + 32 * 40, vt + 32 * 40 + 8), pf0, o1);
    o0 = MFMA(ldfrag2(vt + 16, vt + 24), pf1, o0);
    o1 = MFMA(ldfrag2(vt + 32 * 40 + 16, vt + 32 * 40 + 24), pf1, o1);
    if (tile + 1 < ntile) { *(uint4*)(sKt + (cur ^ 1) * 32 * 72 + skoff) = gk; *(uint4*)(sVt + (cur ^ 1) * 64 * 40 + svoff) = gv; }
    __syncthreads();
  }
#undef ATT_LOAD
  l += __shfl_xor(l, 32);
  const float inv = 1.f / l;
  bf16_t* dst = MIX + qrow * 1024 + 512 + hq * 64;
#pragma unroll
  for (int q4 = 0; q4 < 4; ++q4) {
    const int d = 8 * q4 + 4 * hh;
    uint2 u;
    u.x = pack2(o0[4 * q4] * inv, o0[4 * q4 + 1] * inv); u.y = pack2(o0[4 * q4 + 2] * inv, o0[4 * q4 + 3] * inv);
    *(uint2*)(dst + d) = u;
    u.x = pack2(o1[4 * q4] * inv, o1[4 * q4 + 1] * inv); u.y = pack2(o1[4 * q4 + 2] * inv, o1[4 * q4 + 3] * inv);
    *(uint2*)(dst + 32 + d) = u;
  }
}

DI void mlstm_local_item(const Params& p, int item, char* smem) {
  float* gs = (float*)smem;
  float* wv = gs + 512;
  float* msc = wv + 256;
  int t_ = tid();
  asm volatile("" : "+v"(t_));
  const int t = t_, lane = t & 63, w = t >> 6, wm = w >> 1, wn = w & 1, r = lane & 31, hh = lane >> 5;
  const int bh = item / NSTEP, nc = item % NSTEP, b = bh >> 2, h = bh & 3;
  const int sc = nc < 2 ? 128 + b * 2 + nc : b * 64 + (nc - 2);
  const int row0 = sc * 128;
  const float* GL = (const float*)(p.ws + O_GL);
  const bf16_t* KT = (const bf16_t*)(p.ws + O_KT) + (size_t)(sc * 4 + h) * 16384;
  const bf16_t* VT = (const bf16_t*)(p.ws + O_VT) + (size_t)(sc * 4 + h) * 16384;
  char* sK = smem + 8192;
  char* sV = sK + 32768;
#pragma unroll
  for (int i = 0; i < 8; ++i) {
    const int q = t + 256 * i, row = q >> 4, cc = q & 15;
    const int so = row * 256 + ((cc ^ (row & 15)) << 4);
    *(uint4*)(sK + so) = *(const uint4*)(KT + row * 128 + cc * 8);
    *(uint4*)(sV + so) = *(const uint4*)(VT + row * 128 + cc * 8);
  }
  for (int i = t; i < 512; i += 256) { const int ty = i >> 7, s = i & 127; gs[i] = GL[(size_t)(row0 + s) * 16 + ty * 4 + h]; }
  __syncthreads();
  {
    const int dir = t >> 7, s = t & 127;
    float wval, tot = 0.f;
    if (dir == 0) {
      float bsum = 0.f;
      for (int j = 0; j < 128; ++j) { const float f = gs[128 + j]; tot += f; if (j <= s) bsum += f; }
      wval = tot - bsum + gs[s];
    } else {
      float pre = 0.f;
      for (int j = 0; j < 128; ++j) { const float f = gs[384 + j]; tot += f; if (j < s) pre += f; }
      wval = pre + gs[256 + s];
    }
    wv[dir * 128 + s] = wval;
    if (s == 0) msc[dir] = tot;
  }
  __syncthreads();
  {
    const int dir = t >> 7, s = t & 127;
    float mx = -INFINITY;
    for (int j = 0; j < 128; ++j) mx = fmaxf(mx, wv[dir * 128 + j]);
    const float wval = wv[dir * 128 + s];
    __syncthreads();
    wv[dir * 128 + s] = expf(wval - mx);
    if (s == 0) msc[2 + dir] = mx;
  }
  __syncthreads();
  bf16_t* DC = (bf16_t*)(p.ws + O_DC);
#pragma unroll 1
  for (int d = 0; d < 2; ++d) {
    f32x16 acc[2][2];
#pragma unroll
    for (int i = 0; i < 2; ++i)
#pragma unroll
      for (int j = 0; j < 2; ++j) acc[i][j] = fzero();
#pragma unroll 2
    for (int ks = 0; ks < 8; ++ks) {
      const int xo = ((ks * 2 + hh) ^ (r & 15)) << 4;
      const bf16x8 ra0 = *(const bf16x8*)(sV + (wm * 64 + r) * 256 + xo);
      const bf16x8 ra1 = *(const bf16x8*)(sV + (wm * 64 + 32 + r) * 256 + xo);
      const bf16x8 b0 = *(const bf16x8*)(sK + (wn * 64 + r) * 256 + xo);
      const bf16x8 b1 = *(const bf16x8*)(sK + (wn * 64 + 32 + r) * 256 + xo);
      const float* ww = wv + d * 128 + ks * 16 + hh * 8;
      const bf16x8 a0 = pack8(bf2f((bf16_t)ra0[0]) * ww[0], bf2f((bf16_t)ra0[1]) * ww[1], bf2f((bf16_t)ra0[2]) * ww[2], bf2f((bf16_t)ra0[3]) * ww[3],
                              bf2f((bf16_t)ra0[4]) * ww[4], bf2f((bf16_t)ra0[5]) * ww[5], bf2f((bf16_t)ra0[6]) * ww[6], bf2f((bf16_t)ra0[7]) * ww[7]);
      const bf16x8 a1 = pack8(bf2f((bf16_t)ra1[0]) * ww[0], bf2f((bf16_t)ra1[1]) * ww[1], bf2f((bf16_t)ra1[2]) * ww[2], bf2f((bf16_t)ra1[3]) * ww[3],
                              bf2f((bf16_t)ra1[4]) * ww[4], bf2f((bf16_t)ra1[5]) * ww[5], bf2f((bf16_t)ra1[6]) * ww[6], bf2f((bf16_t)ra1[7]) * ww[7]);
      acc[0][0] = MFMA(a0, b0, acc[0][0]);
      acc[0][1] = MFMA(a0, b1, acc[0][1]);
      acc[1][0] = MFMA(a1, b0, acc[1][0]);
      acc[1][1] = MFMA(a1, b1, acc[1][1]);
    }
    bf16_t* dst = DC + ((size_t)(bh * 2 + d) * NSTEP + nc) * 16384;
#pragma unroll
    for (int mi = 0; mi < 2; ++mi)
#pragma unroll
      for (int ni = 0; ni < 2; ++ni)
#pragma unroll
        for (int i = 0; i < 16; ++i)
          dst[(wm * 64 + mi * 32 + crow(i, hh)) * 128 + wn * 64 + ni * 32 + r] = f2bf(acc[mi][ni][i]);
  }
  {
    const int dir = t >> 7, k = t & 127;
    float s = 0.f;
    for (int s8 = 0; s8 < 16; ++s8) {
      const bf16x8 v = *(const bf16x8*)(sK + k * 256 + ((s8 ^ (k & 15)) << 4));
#pragma unroll
      for (int e = 0; e < 8; ++e) s += wv[dir * 128 + s8 * 8 + e] * bf2f((bf16_t)v[e]);
    }
    ((float*)(p.ws + O_DN))[((size_t)(bh * 2 + dir) * NSTEP + nc) * 128 + k] = s;
    if (k == 0) {
      ((float*)(p.ws + O_GSC))[(bh * 2 + dir) * NSTEP + nc] = msc[dir];
      ((float*)(p.ws + O_MLOC))[(bh * 2 + dir) * NSTEP + nc] = msc[2 + dir];
    }
  }
  __syncthreads();
}

DI int chain_nc(int dir, int i) { return dir == 0 ? i : (i < 2 ? 1 - i : 67 - i); }
template <int DIR>
DI void scan_chain_elems(const bf16_t* __restrict__ DCc, bf16_t* __restrict__ CSTc, const float* fa, const float* fb, int e, int epos) {
  float C = 0.f;
#pragma unroll
  for (int blk = 0; blk < 3; ++blk) {
    float v[22];
#pragma unroll
    for (int j = 0; j < 22; ++j) {
      const int i = blk * 22 + j;
      const int nc = DIR == 0 ? i : (i < 2 ? 1 - i : 67 - i);
      v[j] = bf2f(DCc[(size_t)nc * 16384 + e]);
    }
#pragma unroll
    for (int j = 0; j < 22; ++j) {
      const int i = blk * 22 + j;
      const int nc = DIR == 0 ? i : (i < 2 ? 1 - i : 67 - i);
      if (i >= 2) CSTc[(size_t)(nc - 2) * 16384 + epos] = f2bf(C);
      C = fa[i] * C + fb[i] * v[j];
    }
  }
}
DI void phase_scan(const Params& p, char* smem) {
  float* fa = (float*)smem;
  float* fb = fa + 66;
  const float* GSC = (const float*)(p.ws + O_GSC); const float* MLOC = (const float*)(p.ws + O_MLOC);
  const bf16_t* DC = (const bf16_t*)(p.ws + O_DC); const float* DN = (const float*)(p.ws + O_DN);
  bf16_t* CST = (bf16_t*)(p.ws + O_CST); float* NST = (float*)(p.ws + O_NST); float* MST = (float*)(p.ws + O_MST);
  const int t = tid();
  for (int item = blockIdx.x; item < 16 * 64 + 16; item += gridDim.x) {
    const int chain = item < 1024 ? (item >> 6) : (item - 1024), dir = chain & 1;
    __syncthreads();
    if (t < NSTEP) { const int nc = chain_nc(dir, t); fa[t] = GSC[chain * NSTEP + nc]; fb[t] = MLOC[chain * NSTEP + nc]; }
    __syncthreads();
    if (t == 0) {
      float m = 0.f;
      for (int i = 0; i < NSTEP; ++i) {
        if (i >= 2 && item >= 1024) MST[chain * 64 + chain_nc(dir, i) - 2] = m;
        const float g = fa[i], ml = fb[i];
        const float mn = fmaxf(g + m, ml);
        fa[i] = __expf(g + m - mn); fb[i] = __expf(ml - mn);
        m = mn;
      }
    }
    __syncthreads();
    if (item < 1024) {
      const int e = (item & 63) * 256 + t;
      const int ev = e >> 7, ek = e & 127;
      const int epos = ((((ev >> 5) * 8 + (ek >> 4)) * 64) + ((ek >> 3) & 1) * 32 + (ev & 31)) * 8 + (ek & 7);
      const bf16_t* DCc = DC + (size_t)chain * NSTEP * 16384;
      bf16_t* CSTc = CST + (size_t)chain * 64 * 16384;
      if (dir == 0) scan_chain_elems<0>(DCc, CSTc, fa, fb, e, epos);
      else scan_chain_elems<1>(DCc, CSTc, fa, fb, e, epos);
    } else if (t < 128) {
      const int k = t;
      float n = 0.f;
      for (int i = 0; i < NSTEP; ++i) {
        const int nc = chain_nc(dir, i);
        if (i >= 2) NST[((size_t)chain * 64 + (nc - 2)) * 128 + k] = n;
        n = fa[i] * n + fb[i] * DN[((size_t)chain * NSTEP + nc) * 128 + k];
      }
    }
  }
}

DI void mlstm_out_item(const Params& p, int item, char* smem) {
  float* gs = (float*)smem;
  float* bb = gs + 512;
  float* lib = bb + 256;
  float* mrow = lib + 256;
  float* aT = mrow + 256;
  float* nq = aT + 256;
  float* nst = nq + 256;
  char* sK = smem + 8192;
  char* sV = sK + 32768;
  int t_ = tid();
  asm volatile("" : "+v"(t_));
  const int t = t_, lane = t & 63, w = t >> 6, r = lane & 31, hh = lane >> 5;
  const int bh = item >> 6, c = item & 63, b = bh >> 2, h = bh & 3;
  const int sc = b * 64 + c, row0 = sc * 128;
  const float* GL = (const float*)(p.ws + O_GL);
  const bf16_t* Qc = (const bf16_t*)(p.ws + O_QC); const bf16_t* Kc = (const bf16_t*)(p.ws + O_KC);
  const bf16_t* VT = (const bf16_t*)(p.ws + O_VT) + (size_t)(sc * 4 + h) * 16384;
  const bf16_t* P = (const bf16_t*)(p.ws + O_P);
  const float* MST = (const float*)(p.ws + O_MST);
  bf16_t* MIX = (bf16_t*)(p.ws + O_HA);
#pragma unroll
  for (int i = 0; i < 8; ++i) {
    const int q = t + 256 * i, row = q >> 4, cc = q & 15;
    const int so = row * 256 + ((cc ^ (row & 15)) << 4);
    *(uint4*)(sK + so) = *(const uint4*)(Kc + (size_t)(row0 + row) * 512 + h * 128 + cc * 8);
    *(uint4*)(sV + so) = *(const uint4*)(VT + row * 128 + cc * 8);
  }
  for (int i = t; i < 512; i += 256) { const int ty = i >> 7, s = i & 127; gs[i] = GL[(size_t)(row0 + s) * 16 + ty * 4 + h]; }
  {
    const int dir = t >> 7, k = t & 127;
    nst[t] = ((const float*)(p.ws + O_NST))[((size_t)(bh * 2 + dir) * 64 + c) * 128 + k];
  }
  __syncthreads();
  {
    const int dir = t >> 7, s = t & 127;
    float bsum = 0.f;
    if (dir == 0) { for (int j = 0; j <= s; ++j) bsum += gs[128 + j]; }
    else { for (int j = s; j < 128; ++j) bsum += gs[384 + j]; }
    bb[t] = bsum;
    lib[t] = gs[dir * 256 + s] - bsum;
    const bf16_t* qr = Qc + (size_t)(row0 + s) * 512 + h * 128;
    float acc = 0.f;
    for (int k8 = 0; k8 < 16; ++k8) {
      const bf16x8 v = ldfrag(qr + k8 * 8);
#pragma unroll
      for (int e = 0; e < 8; ++e) acc += nst[dir * 128 + k8 * 8 + e] * bf2f((bf16_t)v[e]);
    }
    nq[t] = acc;
  }
  __syncthreads();
  {
    const int dir = t >> 7, s = t & 127;
    float pm = -INFINITY;
    if (dir == 0) { for (int j = 0; j <= s; ++j) pm = fmaxf(pm, lib[j]); }
    else { for (int j = s; j < 128; ++j) pm = fmaxf(pm, lib[128 + j]); }
    const float m_in = MST[(bh * 2 + dir) * 64 + c];
    const float mr = bb[t] + fmaxf(m_in, pm);
    mrow[t] = mr;
    aT[t] = expf(bb[t] + m_in - mr);
  }
  __syncthreads();
  const int tl = w * 32 + r;
  const bf16_t* qrow = Qc + (size_t)(row0 + tl) * 512 + h * 128 + hh * 8;
  bf16x8 qf[8];
#pragma unroll
  for (int ks = 0; ks < 8; ++ks) qf[ks] = ldfrag(qrow + ks * 16);
  const int swz = r & 15;
  const char* kp[8]; const char* vp[16];
#pragma unroll
  for (int ks = 0; ks < 8; ++ks) kp[ks] = sK + r * 256 + (((ks * 2 + hh) ^ swz) << 4);
#pragma unroll
  for (int cc = 0; cc < 16; ++cc) vp[cc] = sV + r * 256 + 8 * hh + ((cc ^ swz) << 4);
  float* Hb = (float*)(p.ws + O_DC) + (size_t)item * 16384 + tl;
  float* Hbh = Hb + 4 * hh * 128;
  f32x16 outa[4];
#define MLSTM_DIR(DIR)                                                                                                   \
  {                                                                                                                      \
    const bf16_t* CSTl = (const bf16_t*)(p.ws + O_CST) + ((size_t)(bh * 2 + DIR) * 64 + c) * 16384 + lane * 8;           \
    const float bbt = bb[DIR * 128 + tl], mrt = mrow[DIR * 128 + tl], at = aT[DIR * 128 + tl];                            \
    float dsum = 0.f;                                                                                                    \
    const float* libp = lib + DIR * 128 + 4 * hh;                                                                        \
    const int tb = tl - 4 * hh;                                                                                          \
    bf16x8 pf[8];                                                                                                        \
    _Pragma("unroll") for (int half = 0; half < 2; ++half) {                                                             \
      f32x16 st[2];                                                                                                      \
      st[0] = fzero(); st[1] = fzero();                                                                                  \
      _Pragma("unroll") for (int ks = 0; ks < 8; ++ks) {                                                                 \
        _Pragma("unroll") for (int r2 = 0; r2 < 2; ++r2)                                                                 \
          st[r2] = MFMA(*(const bf16x8*)(kp[ks] + (half * 2 + r2) * 8192), qf[ks], st[r2]);                              \
      }                                                                                                                  \
      _Pragma("unroll") for (int r2 = 0; r2 < 2; ++r2) {                                                                 \
        const int rb = half * 2 + r2;                                                                                    \
        _Pragma("unroll") for (int i = 0; i < 16; ++i) {                                                                 \
          const int sc_ = rb * 32 + (i & 3) + 8 * (i >> 2);                                           \
          const int diff = DIR == 0 ? (tb - sc_) : (sc_ - tb);                                                           \
          const float msk = (float)((unsigned)(~diff) >> 31);                                                            \
          const float v = st[r2][i] * __expf(fminf(bbt + libp[sc_] - mrt, 0.f)) * msk;                                    \
          st[r2][i] = v; dsum += v;                                                                                      \
        }                                                                                                                \
        pf[rb * 2] = pack8(st[r2][0], st[r2][1], st[r2][2], st[r2][3], st[r2][4], st[r2][5], st[r2][6], st[r2][7]);      \
        pf[rb * 2 + 1] = pack8(st[r2][8], st[r2][9], st[r2][10], st[r2][11], st[r2][12], st[r2][13], st[r2][14], st[r2][15]); \
      }                                                                                                                  \
      __builtin_amdgcn_sched_barrier(0);                                                                                 \
    }                                                                                                                    \
    dsum += __shfl_xor(dsum, 32);                                                                                        \
    const float den = dsum + at * nq[DIR * 128 + tl];                                                                    \
    const float dinv = 1.f / fmaxf(fabsf(den), expf(-mrt));                                                              \
    _Pragma("unroll") for (int half = 0; half < 2; ++half) {                                                             \
      f32x16 ha[2];                                                                                                      \
      ha[0] = fzero(); ha[1] = fzero();                                                                                  \
      _Pragma("unroll") for (int ks = 0; ks < 8; ++ks) {                                                                 \
        _Pragma("unroll") for (int r2 = 0; r2 < 2; ++r2)                                                                 \
          ha[r2] = MFMA(ldfrag(CSTl + ((half * 2 + r2) * 8 + ks) * 512), qf[ks], ha[r2]);                                \
        if (ks == 3) __builtin_amdgcn_sched_barrier(0);                                                                  \
      }                                                                                                                  \
      _Pragma("unroll") for (int r2 = 0; r2 < 2; ++r2)                                                                   \
        _Pragma("unroll") for (int i = 0; i < 16; ++i) ha[r2][i] *= at;                                                  \
      __builtin_amdgcn_sched_barrier(0);                                                                                 \
      _Pragma("unroll") for (int kk = 0; kk < 8; ++kk) {                                                                 \
        _Pragma("unroll") for (int r2 = 0; r2 < 2; ++r2) {                                                               \
          const s16x4 lo = *(const s16x4*)(vp[2 * kk] + (half * 2 + r2) * 8192);                                         \
          const s16x4 hi = *(const s16x4*)(vp[2 * kk + 1] + (half * 2 + r2) * 8192);                                     \
          ha[r2] = MFMA(__builtin_shufflevector(lo, hi, 0, 1, 2, 3, 4, 5, 6, 7), pf[kk], ha[r2]);                        \
        }                                                                                                                \
      }                                                                                                                  \
      _Pragma("unroll") for (int r2 = 0; r2 < 2; ++r2)                                                                   \
        _Pragma("unroll") for (int i = 0; i < 16; ++i) {                                                                 \
          float* hp = Hbh + ((half * 2 + r2) * 32 + (i & 3) + 8 * (i >> 2)) * 128;                                       \
          if (DIR == 0) *hp = ha[r2][i] * dinv;                                                                          \
          else outa[half * 2 + r2][i] = *hp + ha[r2][i] * dinv;                                                          \
        }                                                                                                                \
      __builtin_amdgcn_sched_barrier(0);                                                                                 \
    }                                                                                                                    \
  }
  MLSTM_DIR(0)
  MLSTM_DIR(1)
#undef MLSTM_DIR
  float ss = 0.f;
#pragma unroll
  for (int rb = 0; rb < 4; ++rb)
#pragma unroll
    for (int i = 0; i < 16; ++i) ss += outa[rb][i] * outa[rb][i];
  ss += __shfl_xor(ss, 32);
  const float rn = rsqrtf(ss * (1.f / 128.f) + EPS);
  const size_t row = (size_t)row0 + tl;
#pragma unroll
  for (int rb = 0; rb < 4; ++rb)
#pragma unroll
    for (int q4 = 0; q4 < 4; ++q4) {
      const int v = rb * 32 + 8 * q4 + 4 * hh;
      const s16x4 ov = *(const s16x4*)(P + row * PLD + 1536 + h * 128 + v);
      const float4 hg = *(const float4*)(p.ab_head_g + h * 128 + v);
      const float y0 = outa[rb][4 * q4] * rn * hg.x * sigmf(bf2f((bf16_t)ov[0]));
      const float y1 = outa[rb][4 * q4 + 1] * rn * hg.y * sigmf(bf2f((bf16_t)ov[1]));
      const float y2 = outa[rb][4 * q4 + 2] * rn * hg.z * sigmf(bf2f((bf16_t)ov[2]));
      const float y3 = outa[rb][4 * q4 + 3] * rn * hg.w * sigmf(bf2f((bf16_t)ov[3]));
      uint2 u; u.x = pack2(y0, y1); u.y = pack2(y2, y3);
      *(uint2*)(MIX + row * 1024 + h * 128 + v) = u;
    }
  __syncthreads();
}

DI void phase_topk(const Params& p, char* smem) {
  unsigned* vals = (unsigned*)smem;
  unsigned* hist = vals + 8448;
  unsigned* cntg = hist + 256;
  unsigned* cnte = cntg + 256;
  unsigned* misc = cnte + 256;
  const float* AFF = (const float*)(p.ws + O_AFF);
  int* IDX = (int*)(p.ws + O_IDX); float* GATE = (float*)(p.ws + O_GATE); int* INV = (int*)(p.ws + O_INV);
  const int t = tid();
  for (int item = blockIdx.x; item < 32; item += gridDim.x) {
    const float* a = AFF + (size_t)item * 8192;
    for (int i = t; i < 8192; i += 256) vals[i + (i >> 5)] = __float_as_uint(a[i]);
    unsigned prefix = 0, remaining = 1024;
    for (int pass = 0; pass < 4; ++pass) {
      const int shift = 24 - 8 * pass;
      hist[t] = 0;
      __syncthreads();
      const unsigned mask = pass == 0 ? 0u : (0xFFFFFFFFu << (shift + 8));
      for (int i = t; i < 8192; i += 256) {
        const unsigned u = vals[i + (i >> 5)];
        if ((u & mask) == (prefix & mask)) atomicAdd(&hist[(u >> shift) & 255], 1u);
      }
      __syncthreads();
      {
        unsigned above = 0;
        for (int bin = t + 1; bin < 256; ++bin) above += hist[bin];
        const unsigned mineh = hist[t];
        if (above < remaining && above + mineh >= remaining) {
          misc[0] = prefix | ((unsigned)t << shift);
          misc[1] = remaining - above;
        }
      }
      __syncthreads();
      prefix = misc[0]; remaining = misc[1];
      __syncthreads();
    }
    const unsigned T = prefix, need_eq = remaining;
    unsigned cg_ = 0, ce = 0;
    for (int j = 0; j < 32; ++j) {
      const int n = t * 32 + j;
      const unsigned u = vals[n + (n >> 5)];
      cg_ += u > T; ce += u == T;
    }
    cntg[t] = cg_; cnte[t] = ce;
    __syncthreads();
    unsigned pg = 0, pe = 0;
    for (int j = 0; j < t; ++j) { pg += cntg[j]; pe += cnte[j]; }
    for (int j = 0; j < 32; ++j) {
      const int n = t * 32 + j;
      const unsigned u = vals[n + (n >> 5)];
      if (u > T) { IDX[item * 1024 + pg] = n; GATE[item * 1024 + pg] = __uint_as_float(u); INV[((size_t)(item >> 4) * 8192 + n) * 16 + (item & 15)] = (int)pg + 1; ++pg; }
      else if (u == T) {
        if (pe < need_eq) { const unsigned slot = 1024 - need_eq + pe; IDX[item * 1024 + slot] = n; GATE[item * 1024 + slot] = __uint_as_float(u); INV[((size_t)(item >> 4) * 8192 + n) * 16 + (item & 15)] = (int)slot + 1; }
        ++pe;
      }
    }
    __syncthreads();
  }
}

DI void phase_stats(const Params& p, char* smem) {
  float* red = (float*)smem;
  const bf16_t* GVT = (const bf16_t*)(p.ws + O_GVT);
  float* PART = (float*)(p.ws + O_STATS);
  const int t = tid(), qq = t & 31, cg_ = t >> 5;
  for (int item = blockIdx.x; item < 1024; item += gridDim.x) {
    const int chunk = item >> 3, cgrp = item & 7;
    const bf16_t* base = GVT + ((size_t)chunk * 2048 + cgrp * 256) * 128 + qq * 4;
    float s[4] = {0.f, 0.f, 0.f, 0.f}, s2[4] = {0.f, 0.f, 0.f, 0.f};
#pragma unroll 8
    for (int c = cg_; c < 256; c += 8) {
      const s16x4 v = *(const s16x4*)(base + (size_t)c * 128);
#pragma unroll
      for (int e = 0; e < 4; ++e) { const float f = bf2f((bf16_t)v[e]); s[e] += f; s2[e] += f * f; }
    }
#pragma unroll
    for (int e = 0; e < 4; ++e) { red[(cg_ * 128 + qq * 4 + e) * 2] = s[e]; red[(cg_ * 128 + qq * 4 + e) * 2 + 1] = s2[e]; }
    __syncthreads();
    if (t < 128) {
      float a = 0.f, b2 = 0.f;
      for (int g = 0; g < 8; ++g) { a += red[(g * 128 + t) * 2]; b2 += red[(g * 128 + t) * 2 + 1]; }
      PART[((size_t)item * 128 + t) * 2] = a;
      PART[((size_t)item * 128 + t) * 2 + 1] = b2;
    }
    __syncthreads();
  }
}
DI void phase_spatial(const Params& p, char* smem) {
  float* smu = (float*)smem;
  float* srs = smu + 128;
  const bf16_t* GVT = (const bf16_t*)(p.ws + O_GVT); const bf16_t* U = (const bf16_t*)(p.ws + O_U);
  const float* PART = (const float*)(p.ws + O_STATS);
  bf16_t* UV = (bf16_t*)(p.ws + O_UV);
  char* sW = smem + 1024;
  int g_staged = -1;
  for (int item = blockIdx.x; item < 1024; item += gridDim.x) {
    int t_ = tid();
    const int t = t_, lane = t & 63, w = t >> 6, r = lane & 31, hh = lane >> 5;
    const int chunk = item >> 3, g = item & 7;
    if (t < 128) {
      float a = 0.f, b2 = 0.f;
#pragma unroll
      for (int j = 0; j < 8; ++j) { a += PART[((size_t)(chunk * 8 + j) * 128 + t) * 2]; b2 += PART[((size_t)(chunk * 8 + j) * 128 + t) * 2 + 1]; }
      const float mu = a * (1.f / 2048.f);
      const float var = fmaxf(b2 * (1.f / 2048.f) - mu * mu, 0.f);
      smu[t] = mu; srs[t] = rsqrtf(var + EPS);
    }
    if (g != g_staged) {
      const float* Wg = p.gm_w_s + (size_t)g * 16384;
#pragma unroll
      for (int i = 0; i < 8; ++i) {
        const int q = t + 256 * i, row = q >> 4, cc = q & 15;
        const float4 w0 = *(const float4*)(Wg + row * 128 + cc * 8), w1 = *(const float4*)(Wg + row * 128 + cc * 8 + 4);
        uint4 o; o.x = pack2(w0.x, w0.y); o.y = pack2(w0.z, w0.w); o.z = pack2(w1.x, w1.y); o.w = pack2(w1.z, w1.w);
        *(uint4*)(sW + row * 256 + ((cc ^ (row & 15)) << 4)) = o;
      }
      g_staged = g;
    }
    __syncthreads();
    f32x16 acc[2][4];
#pragma unroll
    for (int i = 0; i < 4; ++i) { acc[0][i] = fzero(); acc[1][i] = fzero(); }
    const int cA = g * 256 + w * 64 + r, cB = cA + 32;
    const float lgA = p.gm_ln_g[cA], lbA = p.gm_ln_b[cA], lgB = p.gm_ln_g[cB], lbB = p.gm_ln_b[cB];
    const bf16_t* vA = GVT + ((size_t)chunk * 2048 + cA) * 128 + hh * 8;
    const bf16_t* vB = GVT + ((size_t)chunk * 2048 + cB) * 128 + hh * 8;
    for (int ks = 0; ks < 8; ++ks) {
      const bf16x8 ra = ldfrag(vA + ks * 16), rbv = ldfrag(vB + ks * 16);
      const float* mu = smu + ks * 16 + hh * 8; const float* rs = srs + ks * 16 + hh * 8;
      const bf16x8 aA = pack8((bf2f((bf16_t)ra[0]) - mu[0]) * rs[0] * lgA + lbA, (bf2f((bf16_t)ra[1]) - mu[1]) * rs[1] * lgA + lbA,
                              (bf2f((bf16_t)ra[2]) - mu[2]) * rs[2] * lgA + lbA, (bf2f((bf16_t)ra[3]) - mu[3]) * rs[3] * lgA + lbA,
                              (bf2f((bf16_t)ra[4]) - mu[4]) * rs[4] * lgA + lbA, (bf2f((bf16_t)ra[5]) - mu[5]) * rs[5] * lgA + lbA,
                              (bf2f((bf16_t)ra[6]) - mu[6]) * rs[6] * lgA + lbA, (bf2f((bf16_t)ra[7]) - mu[7]) * rs[7] * lgA + lbA);
      const bf16x8 aB = pack8((bf2f((bf16_t)rbv[0]) - mu[0]) * rs[0] * lgB + lbB, (bf2f((bf16_t)rbv[1]) - mu[1]) * rs[1] * lgB + lbB,
                              (bf2f((bf16_t)rbv[2]) - mu[2]) * rs[2] * lgB + lbB, (bf2f((bf16_t)rbv[3]) - mu[3]) * rs[3] * lgB + lbB,
                              (bf2f((bf16_t)rbv[4]) - mu[4]) * rs[4] * lgB + lbB, (bf2f((bf16_t)rbv[5]) - mu[5]) * rs[5] * lgB + lbB,
                              (bf2f((bf16_t)rbv[6]) - mu[6]) * rs[6] * lgB + lbB, (bf2f((bf16_t)rbv[7]) - mu[7]) * rs[7] * lgB + lbB);
#pragma unroll
      for (int pb = 0; pb < 4; ++pb) {
        const bf16x8 bw = *(const bf16x8*)(sW + (pb * 32 + r) * 256 + (((ks * 2 + hh) ^ (r & 15)) << 4));
        acc[0][pb] = MFMA(aA, bw, acc[0][pb]);
        acc[1][pb] = MFMA(aB, bw, acc[1][pb]);
      }
    }
#pragma unroll
    for (int pb = 0; pb < 4; ++pb) {
      const int pp = pb * 32 + r;
      const float bs = p.gm_b_s[g * 128 + pp];
      const size_t rowo = ((size_t)chunk * 128 + pp) * 2048 + g * 256 + w * 64 + 4 * hh;
#pragma unroll
      for (int cb = 0; cb < 2; ++cb)
#pragma unroll
        for (int q4 = 0; q4 < 4; ++q4) {
          const size_t o = rowo + cb * 32 + 8 * q4;
          const s16x4 uu = *(const s16x4*)(U + o);
          uint2 st;
          st.x = pack2(bf2f((bf16_t)uu[0]) * (acc[cb][pb][4 * q4] + bs), bf2f((bf16_t)uu[1]) * (acc[cb][pb][4 * q4 + 1] + bs));
          st.y = pack2(bf2f((bf16_t)uu[2]) * (acc[cb][pb][4 * q4 + 2] + bs), bf2f((bf16_t)uu[3]) * (acc[cb][pb][4 * q4 + 3] + bs));
          *(uint2*)(UV + o) = st;
        }
    }
    __syncthreads();
  }
}

struct EpiBf16 {
  bf16_t* dst; int ld;
  DI void operator()(f32x16 (&acc)[4][2], int mb, int nb, int r, int hh) const {
#pragma unroll
    for (int mi = 0; mi < 4; ++mi)
#pragma unroll
      for (int ni = 0; ni < 2; ++ni)
#pragma unroll
        for (int i = 0; i < 16; ++i)
          dst[(size_t)(mb + mi * 32 + crow(i, hh)) * ld + nb + ni * 32 + r] = f2bf(acc[mi][ni][i]);
  }
};
struct EpiRes {
  float* out; const float* base; const float* gate;
  DI void operator()(f32x16 (&acc)[4][2], int mb, int nb, int r, int hh) const {
#pragma unroll
    for (int ni = 0; ni < 2; ++ni) {
      const int n = nb + ni * 32 + r;
      const float gt = gate[n];
#pragma unroll
      for (int mi = 0; mi < 4; ++mi) {
        const unsigned o0 = (unsigned)(mb + mi * 32 + 4 * hh) * 1024u + (unsigned)n;
#pragma unroll
        for (int q4 = 0; q4 < 4; ++q4) {
          const float b0 = base[o0 + (8 * q4 + 0) * 1024], b1 = base[o0 + (8 * q4 + 1) * 1024], b2 = base[o0 + (8 * q4 + 2) * 1024], b3 = base[o0 + (8 * q4 + 3) * 1024];
          out[o0 + (8 * q4 + 0) * 1024] = b0 + gt * acc[mi][ni][4 * q4];
          out[o0 + (8 * q4 + 1) * 1024] = b1 + gt * acc[mi][ni][4 * q4 + 1];
          out[o0 + (8 * q4 + 2) * 1024] = b2 + gt * acc[mi][ni][4 * q4 + 2];
          out[o0 + (8 * q4 + 3) * 1024] = b3 + gt * acc[mi][ni][4 * q4 + 3];
          __builtin_amdgcn_sched_barrier(0);
        }
      }
    }
  }
};
struct EpiGelu {
  bf16_t* U; bf16_t* GVT; int m0, n0;
  DI void operator()(f32x16 (&acc)[4][2], int mb, int nb, int r, int hh) const {
    if (n0 < 2048) {
#pragma unroll
      for (int mi = 0; mi < 4; ++mi)
#pragma unroll
        for (int ni = 0; ni < 2; ++ni)
#pragma unroll
          for (int i = 0; i < 16; ++i)
            U[(size_t)(m0 + mb + mi * 32 + crow(i, hh)) * 2048 + n0 + nb + ni * 32 + r] = f2bf(geluf(acc[mi][ni][i]));
    } else {
#pragma unroll
      for (int mi = 0; mi < 4; ++mi) {
        const int mrow = m0 + mb + mi * 32;
        const int chunk = mrow >> 7, q0 = mrow & 127;
#pragma unroll
        for (int ni = 0; ni < 2; ++ni) {
          const int cc = n0 - 2048 + nb + ni * 32 + r;
          bf16_t* d = GVT + ((size_t)chunk * 2048 + cc) * 128 + q0 + 4 * hh;
#pragma unroll
          for (int q4 = 0; q4 < 4; ++q4) {
            uint2 u;
            u.x = pack2(geluf(acc[mi][ni][4 * q4]), geluf(acc[mi][ni][4 * q4 + 1]));
            u.y = pack2(geluf(acc[mi][ni][4 * q4 + 2]), geluf(acc[mi][ni][4 * q4 + 3]));
            *(uint2*)(d + 8 * q4) = u;
          }
        }
      }
    }
  }
};
struct EpiSwiglu {
  bf16_t* hid;
  DI void operator()(f32x16 (&acc)[4][2], int mb, int nb, int r, int hh) const {
    const int f = (nb >> 1) + r;
#pragma unroll
    for (int mi = 0; mi < 4; ++mi)
#pragma unroll
      for (int i = 0; i < 16; ++i) {
        const float gv = acc[mi][0][i], uv = acc[mi][1][i];
        hid[(size_t)(mb + mi * 32 + crow(i, hh)) * 1024 + f] = f2bf(siluf(gv) * uv);
      }
  }
};
DI void phase_moe1(const Params& p, char* smem) {
  const bf16_t* HA = (const bf16_t*)(p.ws + O_HA); const bf16_t* WGU = (const bf16_t*)(p.ws + O_MGU);
  const int* IDX = (const int*)(p.ws + O_IDX); bf16_t* HID = (bf16_t*)(p.ws + O_HID);
  const int t = tid(), lrow = t >> 3, lcol = (t & 7) * 8;
  for (TileWalk tw(128 * 16, smem); tw.valid(); tw.next()) {
    int mg, nt; tw.get(8, 8, 2, mg, nt);
    const int e = mg >> 3, b = (mg >> 2) & 1, mt = mg & 3, be = b * 16 + e;
    unsigned aoff[8];
#pragma unroll
    for (int i = 0; i < 8; ++i) aoff[i] = (unsigned)IDX[be * 1024 + mt * 256 + lrow + 32 * i] * 1024u + (unsigned)lcol;
    gemm_tile<false>(HA + (size_t)b * 8192 * 1024, aoff, WGU + ((size_t)e * 2048 + nt * 128) * 1024, (unsigned)lrow * 1024u + (unsigned)lcol, 1024, smem,
              EpiSwiglu{HID + ((size_t)be * 1024 + mt * 256) * 1024 + nt * 64});
  }
}
DI void phase_moe2(const Params& p, int layer, char* smem) {
  const bf16_t* HID = (const bf16_t*)(p.ws + O_HID); const bf16_t* WD = (const bf16_t*)(p.ws + O_MD);
  const int t = tid(), lrow = t >> 3, lcol = (t & 7) * 8;
  for (TileWalk tw(128 * 8, smem); tw.valid(); tw.next()) {
    int mg, nt; tw.get(8, 8, 1, mg, nt);
    const int e = mg >> 3, b = (mg >> 2) & 1, mt = mg & 3, be = b * 16 + e;
    unsigned aoff[8];
#pragma unroll
    for (int i = 0; i < 8; ++i) aoff[i] = (unsigned)(lrow + 32 * i) * 1024u + (unsigned)lcol;
    gemm_tile<true>(HID + ((size_t)be * 1024 + mt * 256) * 1024, aoff, WD + ((size_t)e * 1024 + nt * 128) * 1024, (unsigned)lrow * 1024u + (unsigned)lcol, 1024, smem,
              EpiBf16{(bf16_t*)(p.ws + O_YE) + ((size_t)be * 1024 + mt * 256) * 1024 + nt * 128, 1024});
  }
}

DI void phase_final(const Params& p) {
  const int t = tid(), lane = t & 63, w = t >> 6;
  for (int row = blockIdx.x * 4 + w; row < NTOK; row += gridDim.x * 4) {
    float* src = p.out + (size_t)row * 1024;
    float4 xv[4]; float ss = 0.f;
#pragma unroll
    for (int i = 0; i < 4; ++i) xv[i] = *(const float4*)(src + (i * 64 + lane) * 4);
    {
      float4 ca[4];
      moe_combine_row(p, row, lane, ca);
      const float* g2 = (const float*)(p.ws + O_MODV) + (1 * 3 + (row >> 13)) * 6144 + 5 * 1024;
#pragma unroll
      for (int i = 0; i < 4; ++i) {
        const float4 gg = *(const float4*)(g2 + (i * 64 + lane) * 4);
        xv[i].x += gg.x * ca[i].x; xv[i].y += gg.y * ca[i].y; xv[i].z += gg.z * ca[i].z; xv[i].w += gg.w * ca[i].w;
      }
    }
#pragma unroll
    for (int i = 0; i < 4; ++i) ss += xv[i].x * xv[i].x + xv[i].y * xv[i].y + xv[i].z * xv[i].z + xv[i].w * xv[i].w;
    ss = wsum(ss);
    const float rstd = rsqrtf(ss * (1.f / 1024.f) + EPS);
#pragma unroll
    for (int i = 0; i < 4; ++i) {
      const int col = (i * 64 + lane) * 4;
      const float4 g4 = *(const float4*)(p.final_norm_g + col);
      float4 y; y.x = xv[i].x * rstd * g4.x; y.y = xv[i].y * rstd * g4.y; y.z = xv[i].z * rstd * g4.z; y.w = xv[i].w * rstd * g4.w;
      *(float4*)(src + col) = y;
    }
  }
}

constexpr int NPHASE = 22;
DI void run_phase(const Params& p, int ph, char* smem) {
  const float* modv = (const float*)(p.ws + O_MODV);
  switch (ph) {
#if !defined(ONLY) || ONLY == 0
    case 0:
      phase_adaln(p, smem);
      __syncthreads();
      tconv(p.ab_w_in, 2832, 2832, 1024, 1, 0, (bf16_t*)(p.ws + O_WIN), 0, 1, smem);
      tconv(p.ab_w_out, 1024, 1024, 1024, 1, 0, (bf16_t*)(p.ws + O_WOUT), 0, 0, smem);
      tconv(p.gm_w_in, 4096, 4096, 1024, 1, 0, (bf16_t*)(p.ws + O_GMIN), 0, 0, smem);
      tconv(p.gm_w_out, 1024, 1024, 2048, 1, 0, (bf16_t*)(p.ws + O_GMOUT), 0, 0, smem);
      break;
#endif
#if !defined(ONLY) || ONLY == 1
    case 1: phase_modulate<1, false>(p, 0, 0, smem); break;
#endif
#if !defined(ONLY) || ONLY == 2
    case 2:
      gemm_dense((const bf16_t*)(p.ws + O_HA), (const bf16_t*)(p.ws + O_WIN), NROW, PLD, 1024, 6, 11, smem,
                 [&](int m0, int n0) { return EpiBf16{(bf16_t*)(p.ws + O_P) + (size_t)m0 * PLD + n0, PLD}; });
      break;
#endif
#if !defined(ONLY) || ONLY == 3
    case 3: phase_prep2(p, smem); break;
#endif
#if !defined(ONLY) || ONLY == 4
    case 4:
      for (int item = blockIdx.x; item < 1024 + 8 * NSTEP; item += gridDim.x) {
        if (item < 1024) attn_item(p, item, smem); else mlstm_local_item(p, item - 1024, smem);
      }
      break;
#endif
#if !defined(ONLY) || ONLY == 5
    case 5: phase_scan(p, smem); break;
#endif
#if !defined(ONLY) || ONLY == 6
    case 6:
      for (int item = blockIdx.x; item < 512; item += gridDim.x) mlstm_out_item(p, item, smem);
      break;
#endif
#if !defined(ONLY) || ONLY == 7
    case 7:
#pragma unroll 1
      for (int step = 0; step < 2; ++step) {
        if (((step ^ (int)blockIdx.x) & 1) == 0) {
          gemm_dense((const bf16_t*)(p.ws + O_HA), (const bf16_t*)(p.ws + O_WOUT), NTOK, 1024, 1024, 8, 8, smem,
                     [&](int m0, int n0) {
                       return EpiRes{p.out + (size_t)m0 * 1024 + n0, p.x + (size_t)m0 * 1024 + n0, modv + (0 * 3 + (m0 >> 13)) * 6144 + 2 * 1024 + n0};
                     });
        } else {
          tconv_moe(p, 0, smem);
        }
        __syncthreads();
      }
      break;
#endif
#if !defined(ONLY) || ONLY == 8
    case 8: phase_modulate<2, false>(p, 0, 1, smem); break;
#endif
#if !defined(ONLY) || ONLY == 9
    case 9: phase_topk(p, smem); break;
#endif
#if !defined(ONLY) || ONLY == 10
    case 10: phase_moe1(p, smem); break;
#endif
#if !defined(ONLY) || ONLY == 11
    case 11: phase_moe2(p, 0, smem); break;
#endif
#if !defined(ONLY) || ONLY == 12
    case 12:
      phase_modulate<0, true>(p, 1, 0, smem);
      break;
#endif
#if !defined(ONLY) || ONLY == 13
    case 13:
      gemm_dense((const bf16_t*)(p.ws + O_HA), (const bf16_t*)(p.ws + O_GMIN), NTOK, 4096, 1024, 8, 8, smem,
                 [&](int m0, int n0) { return EpiGelu{(bf16_t*)(p.ws + O_U), (bf16_t*)(p.ws + O_GVT), m0, n0}; });
      break;
#endif
#if !defined(ONLY) || ONLY == 14
    case 14: phase_stats(p, smem); break;
#endif
#if !defined(ONLY) || ONLY == 15
    case 15: phase_spatial(p, smem); break;
#endif
#if !defined(ONLY) || ONLY == 16
    case 16:
#pragma unroll 1
      for (int step = 0; step < 2; ++step) {
        if (((step ^ (int)blockIdx.x) & 1) == 0) {
          gemm_dense((const bf16_t*)(p.ws + O_UV), (const bf16_t*)(p.ws + O_GMOUT), NTOK, 1024, 2048, 8, 8, smem,
                     [&](int m0, int n0) {
                       return EpiRes{p.out + (size_t)m0 * 1024 + n0, p.out + (size_t)m0 * 1024 + n0, modv + (1 * 3 + (m0 >> 13)) * 6144 + 2 * 1024 + n0};
                     });
        } else {
          tconv_moe(p, 1, smem);
        }
        __syncthreads();
      }
      break;
#endif
#if !defined(ONLY) || ONLY == 17
    case 17: phase_modulate<2, false>(p, 1, 1, smem); break;
#endif
#if !defined(ONLY) || ONLY == 18
    case 18: phase_topk(p, smem); break;
#endif
#if !defined(ONLY) || ONLY == 19
    case 19: phase_moe1(p, smem); break;
#endif
#if !defined(ONLY) || ONLY == 20
    case 20: phase_moe2(p, 1, smem); break;
#endif
#if !defined(ONLY) || ONLY == 21
    case 21: phase_final(p); break;
#endif
    default: break;
  }
}

#define XB_TMO      128
#define XB_XCNT(j)  (256  + 64 * (j))
#define XB_XSUB(j)  (1280 + 64 * (j))
#define XB_XGEN(j)  (2304 + 64 * (j))
#define XB_TOP      3328
#define XB_TOPGEN   3392
#define XCD_BAR_WORDS 3456
#define XB_SPIN_CAP (1u << 18)
#define LAS __attribute__((address_space(3)))
DI unsigned xb_ld(unsigned* p) { return __hip_atomic_load(p, __ATOMIC_RELAXED, __HIP_MEMORY_SCOPE_AGENT); }
DI unsigned xb_add(unsigned* p, unsigned v) { return __hip_atomic_fetch_add(p, v, __ATOMIC_RELAXED, __HIP_MEMORY_SCOPE_AGENT); }
DI unsigned xb_xcc_id() { return (unsigned)__builtin_amdgcn_s_getreg((3 << 11) | 20) & 0xFu; }
#define XB_SPIN(cond, bar) do { unsigned _sp = 0; while (cond) { __builtin_amdgcn_s_sleep(1); \
    if ((++_sp & 255u) == 0u) { if (xb_ld(&(bar)[XB_TMO])) break; if (_sp > XB_SPIN_CAP) { atomicAdd(&(bar)[XB_TMO], 1u); break; } } } } while (0)
struct XcdBarrier { unsigned* bar; unsigned x; volatile LAS unsigned* st; };
DI XcdBarrier xcd_barrier_post(unsigned* bar, volatile LAS unsigned* st) {
  XcdBarrier b; b.bar = bar; b.x = xb_xcc_id(); b.st = st;
  if (threadIdx.x == 0) st[3] = xb_add(&bar[XB_XCNT(b.x)], 1u);
  return b;
}
DI void xcd_barrier_complete(unsigned* bar, unsigned x, unsigned& nloc, unsigned& nx, unsigned& sbefore) {
  const unsigned G = gridDim.x * gridDim.y * gridDim.z;
  unsigned sum, cnt, mine, sp = 0u, sb = 0u;
  for (;;) {
    sum = 0u; cnt = 0u; mine = 0u; sb = 0u;
#pragma unroll
    for (unsigned j = 0; j < 16; ++j) { const unsigned c = xb_ld(&bar[XB_XCNT(j)]); sum += c; cnt += (c > 0u) ? 1u : 0u; mine = (j == x) ? c : mine; sb += (j < x) ? c : 0u; }
    if (sum == G) break;
    __builtin_amdgcn_s_sleep(1);
    if ((++sp & 255u) == 0u) { if (xb_ld(&bar[XB_TMO])) break; if (sp > XB_SPIN_CAP) { atomicAdd(&bar[XB_TMO], 1u); break; } }
  }
  nloc = mine > 0u ? mine : 1u; nx = cnt > 0u ? cnt : 1u; sbefore = sb;
}
DI void xcd_barrier(const XcdBarrier& b) {
  asm volatile("s_waitcnt vmcnt(0)" ::: "memory");
  __syncthreads();
  if (threadIdx.x == 0) {
    unsigned* bar = b.bar;
    __builtin_amdgcn_s_waitcnt(0);
    unsigned nloc = b.st[0], nx = b.st[1];
    if (nloc == 0u) { unsigned sbf; xcd_barrier_complete(bar, b.x, nloc, nx, sbf); b.st[0] = nloc; b.st[1] = nx; b.st[2] = sbf; }
    const unsigned old = xb_add(&bar[XB_XSUB(b.x)], 1u);
    const unsigned gen = old / nloc;
    if (old + 1u == (gen + 1u) * nloc) {
      __builtin_amdgcn_fence(__ATOMIC_RELEASE, "agent");
      asm volatile("s_waitcnt vmcnt(0)" ::: "memory");
      const unsigned og = xb_add(&bar[XB_TOP], 1u);
      const unsigned tg = og / nx;
      if (og + 1u == (tg + 1u) * nx) xb_add(&bar[XB_TOPGEN], 1u);
      else XB_SPIN(xb_ld(&bar[XB_TOPGEN]) == tg, bar);
      __builtin_amdgcn_fence(__ATOMIC_ACQUIRE, "agent");
      xb_add(&bar[XB_XGEN(b.x)], 1u);
      asm volatile("s_waitcnt vmcnt(0)" ::: "memory");
    } else {
      XB_SPIN(xb_ld(&bar[XB_XGEN(b.x)]) == gen, bar);
      __builtin_amdgcn_fence(__ATOMIC_ACQUIRE, "agent");
      asm volatile("s_waitcnt vmcnt(0)" ::: "memory");
    }
  }
  __syncthreads();
}

DI Params kargs() {
  Params P{};
#if defined(__HIP_DEVICE_COMPILE__)
  typedef const unsigned long long __attribute__((address_space(4))) CU;
  CU* q = (CU*)__builtin_amdgcn_kernarg_segment_ptr();
  asm volatile("" : "+s"(q));
#define GP(T, i) ((T*)(T __attribute__((address_space(1)))*)(q[i]))
  P.x = GP(const float, 0);
  P.c = GP(const float, 1);
  P.ctx = GP(const float, 2);
  P.c_ctx = GP(const float, 3);
  P.w_mod = GP(const float, 4);
  P.b_mod = GP(const float, 5);
  P.norm_mix_g = GP(const float, 6);
  P.norm_ffn_g = GP(const float, 7);
  P.final_norm_g = GP(const float, 8);
  P.ab_w_in = GP(const float, 9);
  P.ab_conv_w = GP(const float, 10);
  P.ab_gate_b = GP(const float, 11);
  P.ab_head_g = GP(const float, 12);
  P.ab_sink = GP(const float, 13);
  P.ab_w_out = GP(const float, 14);
  P.gm_w_in = GP(const float, 15);
  P.gm_ln_g = GP(const float, 16);
  P.gm_ln_b = GP(const float, 17);
  P.gm_w_s = GP(const float, 18);
  P.gm_b_s = GP(const float, 19);
  P.gm_w_out = GP(const float, 20);
  P.moe_w_router = GP(const float, 21);
  P.moe_w_gate = GP(const float, 22);
  P.moe_w_up = GP(const float, 23);
  P.moe_w_down = GP(const float, 24);
  P.out = GP(float, 25);
  P.ws = GP(char, 26);
#undef GP
#endif
  return P;
}
#if COOP
#ifndef REPEAT_MASK
#define REPEAT_MASK 0
#endif
__global__ void __launch_bounds__(256, 2) mega(Params p_unused) {
  __shared__ __attribute__((aligned(16))) char smem[73728 + 16];
  unsigned* xbw = (unsigned*)(smem + 73728);
  cg::grid_group grid = cg::this_grid();
  if (threadIdx.x < 4) xbw[threadIdx.x] = 0u;
  __syncthreads();
  XcdBarrier xb;
  { const Params pp = kargs(); xb = xcd_barrier_post((unsigned*)(pp.ws + O_BAR), (volatile LAS unsigned*)xbw); }
#define PHX(n) { const Params pp = kargs(); run_phase(pp, n, smem); } xcd_barrier(xb); \
  if ((REPEAT_MASK >> n) & 1) { { const Params pp = kargs(); run_phase(pp, n, smem); } xcd_barrier(xb); }
  { const Params pp = kargs(); run_phase(pp, 0, smem); }
  if (p_unused.ws == nullptr) grid.sync();
  xcd_barrier(xb);
  PHX(1) PHX(2) PHX(3) PHX(4) PHX(5) PHX(6) PHX(7) PHX(8) PHX(9) PHX(10)
  PHX(11) PHX(12) PHX(13) PHX(14) PHX(15) PHX(16) PHX(17) PHX(18) PHX(19) PHX(20)
  { const Params pp = kargs(); run_phase(pp, 21, smem); }
}
#else
__global__ void __launch_bounds__(256, 2) mega(Params p, int ph) {
  __shared__ __attribute__((aligned(16))) char smem[73728];
  run_phase(p, ph, smem);
}
#endif

extern "C" void kernel_launch(void* const* d_in, const int* in_sizes, int n_in, void* d_out, int out_size, void* d_ws,
                              size_t ws_size, hipStream_t stream) {
  (void)in_sizes; (void)n_in; (void)out_size;
  if (ws_size < WS_NEED) { fprintf(stderr, "workspace too small: %zu < %zu\n", ws_size, (size_t)WS_NEED); return; }
  static int grid_blocks = 0;
  if (!grid_blocks) {
    int dev = 0, cus = 0, per_cu = 0;
    hipGetDevice(&dev);
    hipDeviceGetAttribute(&cus, hipDeviceAttributeMultiprocessorCount, dev);
    hipOccupancyMaxActiveBlocksPerMultiprocessor(&per_cu, mega, 256, 0);
    if (per_cu < 1) per_cu = 1;
    if (per_cu > 2) per_cu = 2;
    grid_blocks = cus * per_cu;
  }
  Params p{};
  const float** f = (const float**)&p;
  for (int i = 0; i < 25; ++i) f[i] = (const float*)d_in[i];
  p.out = (float*)d_out;
  p.ws = (char*)d_ws;
#if COOP
  hipMemsetAsync((char*)d_ws + O_BAR, 0, XCD_BAR_WORDS * 4, stream);
  void* args[] = {&p};
  hipError_t e = hipLaunchCooperativeKernel((void*)mega, dim3(grid_blocks), dim3(256), args, 0, stream);
  if (e != hipSuccess) fprintf(stderr, "cooperative launch failed: %s (grid %d)\n", hipGetErrorString(e), grid_blocks);
#else
  for (int ph = 0; ph < NPHASE; ++ph) hipLaunchKernelGGL(mega, dim3(grid_blocks), dim3(256), 0, stream, p, ph);
#endif
}
```

```cpp
#include <hip/hip_runtime.h>
#include <hip/hip_cooperative_groups.h>
#include <cstdio>
namespace cg = cooperative_groups;

#define DI __device__ __forceinline__
typedef unsigned short bf16_t;
using bf16x8 = __attribute__((ext_vector_type(8))) short;
using s16x4 = __attribute__((ext_vector_type(4))) short;
using f32x16 = __attribute__((ext_vector_type(16))) float;
#define MFMA(a, b, c) __builtin_amdgcn_mfma_f32_32x32x16_bf16((a), (b), (c), 0, 0, 0)

#ifndef COOP
#define COOP 1
#endif

constexpr int DM = 1024, NBAT = 2, SEQ = 8192, NTOK = NBAT * SEQ, CTXL = 256, NROW = NTOK + NBAT * CTXL;
constexpr int PLD = 2816;
constexpr int NSTEP = 66;
constexpr float EPS = 1e-6f;

constexpr size_t al256(size_t x) { return (x + 255) & ~(size_t)255; }
constexpr size_t O_BAR = 0;
constexpr size_t O_WIN = 16384;
constexpr size_t O_WOUT = O_WIN + al256((size_t)PLD * 1024 * 2);
constexpr size_t O_GMIN = O_WOUT + al256((size_t)1024 * 1024 * 2);
constexpr size_t O_GMOUT = O_GMIN + al256((size_t)4096 * 1024 * 2);
constexpr size_t O_MGU = O_GMOUT + al256((size_t)1024 * 2048 * 2);
constexpr size_t O_MD = O_MGU + al256((size_t)16 * 2048 * 1024 * 2);
constexpr size_t O_MODV = O_MD + al256((size_t)16 * 1024 * 1024 * 2);
constexpr size_t O_HA = O_MODV + al256((size_t)2 * 3 * 6144 * 4);
constexpr size_t O_GL = O_HA + al256((size_t)NROW * 1024 * 2);
constexpr size_t O_AFF = O_GL + al256((size_t)NROW * 16 * 4);
constexpr size_t O_IDX = O_AFF + al256((size_t)32 * 8192 * 4);
constexpr size_t O_GATE = O_IDX + al256((size_t)32 * 1024 * 4);
constexpr size_t O_STATS = O_GATE + al256((size_t)32 * 1024 * 4);
constexpr size_t O_GSC = O_STATS + al256((size_t)NTOK * 16 * 4);
constexpr size_t O_MLOC = O_GSC + al256((size_t)16 * NSTEP * 4);
constexpr size_t O_DN = O_MLOC + al256((size_t)16 * NSTEP * 4);
constexpr size_t O_NST = O_DN + al256((size_t)16 * NSTEP * 128 * 4);
constexpr size_t O_MST = O_NST + al256((size_t)16 * 64 * 128 * 4);
constexpr size_t O_INV = O_MST + al256((size_t)16 * 64 * 4);
constexpr size_t O_R12 = O_INV + al256((size_t)NTOK * 16 * 4);
constexpr size_t O_P = O_R12;
constexpr size_t O_QC = O_P + al256((size_t)NROW * PLD * 2);
constexpr size_t O_KC = O_QC + al256((size_t)NTOK * 512 * 2);
constexpr size_t O_KT = O_KC + al256((size_t)NTOK * 512 * 2);
constexpr size_t O_VT = O_KT + al256((size_t)132 * 4 * 128 * 128 * 2);
constexpr size_t O_RQ = O_VT + al256((size_t)132 * 4 * 128 * 128 * 2);
constexpr size_t O_RK = O_RQ + al256((size_t)NTOK * 512 * 2);
constexpr size_t O_AVTX = O_RK + al256((size_t)NROW * 128 * 2);
constexpr size_t O_AVTC = O_AVTX + al256((size_t)4 * 64 * 8192 * 2);
constexpr size_t O_R12_END = O_AVTC + al256((size_t)4 * 64 * 256 * 2);
constexpr size_t O_HID = O_R12;
constexpr size_t O_U = O_R12;
constexpr size_t O_GVT = O_U + al256((size_t)NTOK * 2048 * 2);
static_assert(O_GVT + (size_t)NTOK * 2048 * 2 <= O_R12_END, "R12 too small");
constexpr size_t O_DC = O_R12_END;
constexpr size_t O_CST = O_DC + al256((size_t)16 * NSTEP * 16384 * 4);
constexpr size_t O_UV = O_DC;
constexpr size_t O_YE = O_DC;
constexpr size_t WS_NEED = O_CST + al256((size_t)16 * 64 * 16384 * 2);

struct Params {
  const float *x, *c, *ctx, *c_ctx, *w_mod, *b_mod, *norm_mix_g, *norm_ffn_g, *final_norm_g;
  const float *ab_w_in, *ab_conv_w, *ab_gate_b, *ab_head_g, *ab_sink, *ab_w_out;
  const float *gm_w_in, *gm_ln_g, *gm_ln_b, *gm_w_s, *gm_b_s, *gm_w_out;
  const float *moe_w_router, *moe_w_gate, *moe_w_up, *moe_w_down;
  float* out;
  char* ws;
};

DI bf16_t f2bf(float x) { unsigned u = __float_as_uint(x); u += 0x7fffu + ((u >> 16) & 1u); return (bf16_t)(u >> 16); }
DI float bf2f(bf16_t b) { return __uint_as_float(((unsigned)b) << 16); }
DI unsigned pack2(float a, float b) { return (unsigned)f2bf(a) | ((unsigned)f2bf(b) << 16); }
DI bf16x8 pack8(float a0, float a1, float a2, float a3, float a4, float a5, float a6, float a7) {
  uint4 u; u.x = pack2(a0, a1); u.y = pack2(a2, a3); u.z = pack2(a4, a5); u.w = pack2(a6, a7);
  return __builtin_bit_cast(bf16x8, u);
}
DI bf16x8 ldfrag(const bf16_t* p) { return *(const bf16x8*)p; }
DI bf16x8 ldfrag2(const bf16_t* p0, const bf16_t* p1) {
  s16x4 lo = *(const s16x4*)p0, hi = *(const s16x4*)p1;
  return __builtin_shufflevector(lo, hi, 0, 1, 2, 3, 4, 5, 6, 7);
}
DI int crow(int i, int hh) { return (i & 3) + 8 * (i >> 2) + 4 * hh; }
DI float siluf(float x) { return x / (1.f + __expf(-x)); }
DI float sigmf(float x) { return 1.f / (1.f + __expf(-x)); }
DI float logsigf(float x) { return fminf(x, 0.f) - log1pf(expf(-fabsf(x))); }
DI float geluf(float x) {
  const float u2 = 1.5957691216057308f * (x + 0.044715f * x * x * x);
  return x / (1.f + __expf(-u2));
}
DI float wsum(float v) {
#pragma unroll
  for (int o = 32; o > 0; o >>= 1) v += __shfl_xor(v, o);
  return v;
}
DI int tid() { int t = threadIdx.x; asm volatile("" : "+v"(t)); return t; }
DI f32x16 fzero() { f32x16 z; for (int i = 0; i < 16; ++i) z[i] = 0.f; return z; }

DI int tmap(int kind, int n) {
  if (kind == 0) return n;
  if (kind == 1) return n < 2048 ? n : (n < 2064 ? -1 : n - 16);
  int r = (n >> 6) * 128 + ((n >> 5) & 1) * 64 + (n & 31);
  return kind == 2 ? r : r + 32;
}
DI void tconv(const float* __restrict__ src, int ldn, int ncols, int K, int nmat, size_t sstride,
              bf16_t* __restrict__ dst, size_t dstride, int kind, char* smem) {
  float* sm = (float*)smem;
  const int t = tid();
  const int ntn = (ncols + 63) >> 6, ntk = K >> 6, per = ntn * ntk, total = per * nmat;
  const int c4 = t & 15, rr = t >> 4;
  float4 v0, v1, v2, v3;
#define TC_LOAD(tile_) { const int mat_ = (tile_) / per, tt_ = (tile_) % per; const int k0_ = (tt_ / ntn) * 64, n_ = (tt_ % ntn) * 64 + c4 * 4; \
    const float* s_ = src + (size_t)mat_ * sstride + (size_t)(k0_ + rr) * ldn + n_; \
    if (n_ < ncols) { v0 = *(const float4*)(s_); v1 = *(const float4*)(s_ + (size_t)16 * ldn); v2 = *(const float4*)(s_ + (size_t)32 * ldn); v3 = *(const float4*)(s_ + (size_t)48 * ldn); } \
    else { v0 = v1 = v2 = v3 = make_float4(0.f, 0.f, 0.f, 0.f); } }
  int tile = blockIdx.x;
  if (tile < total) TC_LOAD(tile)
  for (; tile < total; tile += gridDim.x) {
    const int mat = tile / per, tt = tile % per;
    const int k0 = (tt / ntn) * 64, n0 = (tt % ntn) * 64;
    bf16_t* d = dst + (size_t)mat * dstride;
    {
      float* q = sm + rr * 65 + c4 * 4;
      q[0] = v0.x; q[1] = v0.y; q[2] = v0.z; q[3] = v0.w;
      q[16 * 65 + 0] = v1.x; q[16 * 65 + 1] = v1.y; q[16 * 65 + 2] = v1.z; q[16 * 65 + 3] = v1.w;
      q[32 * 65 + 0] = v2.x; q[32 * 65 + 1] = v2.y; q[32 * 65 + 2] = v2.z; q[32 * 65 + 3] = v2.w;
      q[48 * 65 + 0] = v3.x; q[48 * 65 + 1] = v3.y; q[48 * 65 + 2] = v3.z; q[48 * 65 + 3] = v3.w;
    }
    if (tile + (int)gridDim.x < total) TC_LOAD(tile + (int)gridDim.x)
    __syncthreads();
    const int nl = t >> 2, kq = t & 3, n = n0 + nl;
    if (n < ncols) {
      const int row = tmap(kind, n);
      if (row >= 0) {
        uint4 o0, o1;
        const float* q = sm + (kq * 16) * 65 + nl;
        o0.x = pack2(q[0 * 65], q[1 * 65]); o0.y = pack2(q[2 * 65], q[3 * 65]); o0.z = pack2(q[4 * 65], q[5 * 65]); o0.w = pack2(q[6 * 65], q[7 * 65]);
        o1.x = pack2(q[8 * 65], q[9 * 65]); o1.y = pack2(q[10 * 65], q[11 * 65]); o1.z = pack2(q[12 * 65], q[13 * 65]); o1.w = pack2(q[14 * 65], q[15 * 65]);
        uint4* dp = (uint4*)(d + (size_t)row * K + k0 + kq * 16);
        dp[0] = o0; dp[1] = o1;
      }
    }
    __syncthreads();
  }
#undef TC_LOAD
}
DI void tconv_moe(const Params& p, int layer, char* smem) {
  const size_t wo = (size_t)layer * 16 * 1024 * 1024;
  tconv(p.moe_w_gate + wo, 1024, 1024, 1024, 16, (size_t)1024 * 1024, (bf16_t*)(p.ws + O_MGU), (size_t)2048 * 1024, 2, smem);
  tconv(p.moe_w_up + wo, 1024, 1024, 1024, 16, (size_t)1024 * 1024, (bf16_t*)(p.ws + O_MGU), (size_t)2048 * 1024, 3, smem);
  tconv(p.moe_w_down + wo, 1024, 1024, 1024, 16, (size_t)1024 * 1024, (bf16_t*)(p.ws + O_MD), (size_t)1024 * 1024, 0, smem);
}

DI void phase_adaln(const Params& p, char* smem) {
  float* sv = (float*)smem;
  float* red = sv + 3 * 1024;
  float* modv = (float*)(p.ws + O_MODV);
  const int t = tid();
  if (blockIdx.x >= 192) return;
  for (int i = t; i < 3 * 1024; i += 256) {
    const int v = i >> 10, k = i & 1023;
    const float cv = v < 2 ? p.c[v * 1024 + k] : p.c_ctx[k];
    sv[i] = siluf(cv);
  }
  __syncthreads();
  for (int item = blockIdx.x; item < 192; item += gridDim.x) {
    const int l = item / 96, cb = item % 96;
    const int cq = t & 15, kg = t >> 4;
    const float* w = p.w_mod + (size_t)l * 1024 * 6144 + cb * 64 + cq * 4;
    float a0[4] = {0.f, 0.f, 0.f, 0.f}, a1[4] = {0.f, 0.f, 0.f, 0.f}, a2[4] = {0.f, 0.f, 0.f, 0.f};
    for (int i = 0; i < 64; ++i) {
      const int k = kg + 16 * i;
      const float4 wv = *(const float4*)(w + (size_t)k * 6144);
      const float s0 = sv[k], s1 = sv[1024 + k], s2 = sv[2048 + k];
      a0[0] += s0 * wv.x; a0[1] += s0 * wv.y; a0[2] += s0 * wv.z; a0[3] += s0 * wv.w;
      a1[0] += s1 * wv.x; a1[1] += s1 * wv.y; a1[2] += s1 * wv.z; a1[3] += s1 * wv.w;
      a2[0] += s2 * wv.x; a2[1] += s2 * wv.y; a2[2] += s2 * wv.z; a2[3] += s2 * wv.w;
    }
#pragma unroll
    for (int j = 0; j < 4; ++j) {
      red[(kg * 3 + 0) * 64 + cq * 4 + j] = a0[j];
      red[(kg * 3 + 1) * 64 + cq * 4 + j] = a1[j];
      red[(kg * 3 + 2) * 64 + cq * 4 + j] = a2[j];
    }
    __syncthreads();
    if (t < 192) {
      const int v = t >> 6, col = t & 63;
      float s = 0.f;
      for (int g = 0; g < 16; ++g) s += red[(g * 3 + v) * 64 + col];
      const int cc = cb * 64 + col;
      modv[(l * 3 + v) * 6144 + cc] = s + p.b_mod[l * 6144 + cc];
    }
    __syncthreads();
  }
}

DI void moe_combine_row(const Params& p, int row, int lane, float4 (&acc)[4]) {
  const int* INV = (const int*)(p.ws + O_INV); const float* GATE = (const float*)(p.ws + O_GATE);
  const bf16_t* YE = (const bf16_t*)(p.ws + O_YE);
  const int b = row >> 13;
  const int myslot = INV[(size_t)row * 16 + (lane & 15)];
#pragma unroll
  for (int i = 0; i < 4; ++i) acc[i] = make_float4(0.f, 0.f, 0.f, 0.f);
#pragma unroll 1
  for (int e = 0; e < 16; ++e) {
    const int slot = __builtin_amdgcn_readlane(myslot, e);
    if (slot != 0) {
      const int be = b * 16 + e;
      const float g = GATE[be * 1024 + slot - 1];
      const bf16_t* yr = YE + ((size_t)be * 1024 + slot - 1) * 1024;
#pragma unroll
      for (int i = 0; i < 4; ++i) {
        const s16x4 v = *(const s16x4*)(yr + (i * 64 + lane) * 4);
        acc[i].x += g * bf2f((bf16_t)v[0]); acc[i].y += g * bf2f((bf16_t)v[1]); acc[i].z += g * bf2f((bf16_t)v[2]); acc[i].w += g * bf2f((bf16_t)v[3]);
      }
    }
  }
}

template <int MODE, bool COMB>
DI void phase_modulate(const Params& p, int layer, int which, char* smem) {
  float* wt = (float*)smem;
  const int t = tid(), lane = t & 63, w = t >> 6;
  const float* modv = (const float*)(p.ws + O_MODV);
  bf16_t* HA = (bf16_t*)(p.ws + O_HA);
  if (MODE != 0) {
    const float* W = MODE == 1 ? p.ab_w_in + 2048 : p.moe_w_router + (size_t)layer * 1024 * 16;
    const int ld = MODE == 1 ? 2832 : 16;
    for (int i = t; i < 4096; i += 256) {
      const int k = i >> 2, e4 = i & 3;
      const float4 v = *(const float4*)(W + (size_t)k * ld + e4 * 4);
      wt[(e4 * 4 + 0) * 1024 + k] = v.x; wt[(e4 * 4 + 1) * 1024 + k] = v.y; wt[(e4 * 4 + 2) * 1024 + k] = v.z; wt[(e4 * 4 + 3) * 1024 + k] = v.w;
    }
    __syncthreads();
  }
  const float* gn = (which == 0 ? p.norm_mix_g : p.norm_ffn_g) + layer * 1024;
  const int nrows = MODE == 1 ? NROW : NTOK;
  const int rstride = gridDim.x * 4;
  float4 nx[4];
#define MOD_SRC(row_) (MODE == 1 ? ((row_) < NTOK ? p.x + (size_t)(row_) * 1024 : p.ctx + (size_t)((row_) - NTOK) * 1024) : p.out + (size_t)(row_) * 1024)
  {
    const int row0_ = blockIdx.x * 4 + w;
    if (row0_ < nrows) {
      const float* s0_ = MOD_SRC(row0_);
#pragma unroll
      for (int i = 0; i < 4; ++i) nx[i] = *(const float4*)(s0_ + (i * 64 + lane) * 4);
    }
  }
  for (int row = blockIdx.x * 4 + w; row < nrows; row += rstride) {
    const int v = (MODE == 1 && row >= NTOK) ? 2 : (row >> 13);
    const float* sh = modv + (layer * 3 + v) * 6144 + (which ? 3 : 0) * 1024;
    const float* sc = sh + 1024;
    float4 xv[4];
    float ss = 0.f;
#pragma unroll
    for (int i = 0; i < 4; ++i) xv[i] = nx[i];
    if (row + rstride < nrows) {
      const float* s1_ = MOD_SRC(row + rstride);
#pragma unroll
      for (int i = 0; i < 4; ++i) nx[i] = *(const float4*)(s1_ + (i * 64 + lane) * 4);
    }
    if (COMB) {
      float4 ca[4];
      moe_combine_row(p, row, lane, ca);
      const float* g2 = modv + ((layer - 1) * 3 + v) * 6144 + 5 * 1024;
#pragma unroll
      for (int i = 0; i < 4; ++i) {
        const float4 gg = *(const float4*)(g2 + (i * 64 + lane) * 4);
        xv[i].x += gg.x * ca[i].x; xv[i].y += gg.y * ca[i].y; xv[i].z += gg.z * ca[i].z; xv[i].w += gg.w * ca[i].w;
        *(float4*)(p.out + (size_t)row * 1024 + (i * 64 + lane) * 4) = xv[i];
      }
    }
#pragma unroll
    for (int i = 0; i < 4; ++i) ss += xv[i].x * xv[i].x + xv[i].y * xv[i].y + xv[i].z * xv[i].z + xv[i].w * xv[i].w;
    ss = wsum(ss);
    const float rstd = rsqrtf(ss * (1.f / 1024.f) + EPS);
    float4 yv[4];
#pragma unroll
    for (int i = 0; i < 4; ++i) {
      const int col = (i * 64 + lane) * 4;
      const float4 g4 = *(const float4*)(gn + col), s4 = *(const float4*)(sh + col), c4 = *(const float4*)(sc + col);
      float4 y;
      y.x = xv[i].x * rstd * g4.x * (1.f + c4.x) + s4.x;
      y.y = xv[i].y * rstd * g4.y * (1.f + c4.y) + s4.y;
      y.z = xv[i].z * rstd * g4.z * (1.f + c4.z) + s4.z;
      y.w = xv[i].w * rstd * g4.w * (1.f + c4.w) + s4.w;
      yv[i] = y;
      uint2 o; o.x = pack2(y.x, y.y); o.y = pack2(y.z, y.w);
      *(uint2*)(HA + (size_t)row * 1024 + col) = o;
    }
    if (MODE != 0) {
      float mine = 0.f;
#pragma unroll 1
      for (int e4 = 0; e4 < 16; e4 += 4) {
        float pe0 = 0.f, pe1 = 0.f, pe2 = 0.f, pe3 = 0.f;
#pragma unroll
        for (int i = 0; i < 4; ++i) {
          const float* wp = wt + e4 * 1024 + (i * 64 + lane) * 4;
          const float4 wa = *(const float4*)(wp), wb = *(const float4*)(wp + 1024), wc = *(const float4*)(wp + 2048), wd = *(const float4*)(wp + 3072);
          pe0 += yv[i].x * wa.x + yv[i].y * wa.y + yv[i].z * wa.z + yv[i].w * wa.w;
          pe1 += yv[i].x * wb.x + yv[i].y * wb.y + yv[i].z * wb.z + yv[i].w * wb.w;
          pe2 += yv[i].x * wc.x + yv[i].y * wc.y + yv[i].z * wc.z + yv[i].w * wc.w;
          pe3 += yv[i].x * wd.x + yv[i].y * wd.y + yv[i].z * wd.z + yv[i].w * wd.w;
        }
#pragma unroll
        for (int o = 32; o > 0; o >>= 1) {
          const float q0 = __shfl_xor(pe0, o), q1 = __shfl_xor(pe1, o), q2 = __shfl_xor(pe2, o), q3 = __shfl_xor(pe3, o);
          pe0 += q0; pe1 += q1; pe2 += q2; pe3 += q3;
        }
        const int el = (lane & 15) - e4;
        mine = el == 0 ? pe0 : (el == 1 ? pe1 : (el == 2 ? pe2 : (el == 3 ? pe3 : mine)));
      }
      const int e = lane & 15;
      if (MODE == 1) {
        float val = mine + p.ab_gate_b[e];
        if (((e >> 2) & 1) == 1) val = logsigf(val);
        if (lane < 16) ((float*)(p.ws + O_GL))[(size_t)row * 16 + lane] = val;
      } else {
        float mx = mine;
#pragma unroll
        for (int o = 8; o > 0; o >>= 1) mx = fmaxf(mx, __shfl_xor(mx, o));
        const float ex = expf(mine - mx);
        float sum = ex;
#pragma unroll
        for (int o = 8; o > 0; o >>= 1) sum += __shfl_xor(sum, o);
        if (lane < 16) ((float*)(p.ws + O_AFF))[((size_t)(row >> 13) * 16 + lane) * 8192 + (row & 8191)] = ex / sum;
        if (lane < 16) ((int*)(p.ws + O_INV))[(size_t)row * 16 + lane] = 0;
      }
    }
  }
}

template <bool DENSEA, class Epi>
DI void gemm_tile(const bf16_t* Abase, const unsigned (&aoff)[8], const bf16_t* Bbase, unsigned boff, int K, char* smem, Epi&& epi) {
  bf16_t* sA = (bf16_t*)smem;
  bf16_t* sB = sA + 256 * 72;
  const int t = tid(), lane = t & 63, w = t >> 6, wm = w >> 1, wn = w & 1, r = lane & 31, hh = lane >> 5;
  const int lrow = t >> 3, lcol = (t & 7) * 8;
  const unsigned bst = 32u * (unsigned)K;
  f32x16 acc[4][2];
#pragma unroll
  for (int i = 0; i < 4; ++i) { acc[i][0] = fzero(); acc[i][1] = fzero(); }
  uint4 A0, A1, A2, A3, A4, A5, A6, A7, B0, B1, B2, B3;
#define GLOADT(kn_) { \
    const bf16_t* Ak_ = Abase + (kn_); const bf16_t* Bk_ = Bbase + (kn_);     \
    if (DENSEA) { \
      A0 = *(const uint4*)(Ak_ + aoff[0]); A1 = *(const uint4*)((Ak_ + bst) + aoff[0]); A2 = *(const uint4*)((Ak_ + 2 * bst) + aoff[0]); A3 = *(const uint4*)((Ak_ + 3 * bst) + aoff[0]); \
      A4 = *(const uint4*)((Ak_ + 4 * bst) + aoff[0]); A5 = *(const uint4*)((Ak_ + 5 * bst) + aoff[0]); A6 = *(const uint4*)((Ak_ + 6 * bst) + aoff[0]); A7 = *(const uint4*)((Ak_ + 7 * bst) + aoff[0]); \
    } else { \
      A0 = *(const uint4*)(Ak_ + aoff[0]); A1 = *(const uint4*)(Ak_ + aoff[1]); A2 = *(const uint4*)(Ak_ + aoff[2]); A3 = *(const uint4*)(Ak_ + aoff[3]); \
      A4 = *(const uint4*)(Ak_ + aoff[4]); A5 = *(const uint4*)(Ak_ + aoff[5]); A6 = *(const uint4*)(Ak_ + aoff[6]); A7 = *(const uint4*)(Ak_ + aoff[7]); \
    } \
    B0 = *(const uint4*)(Bk_ + boff); B1 = *(const uint4*)((Bk_ + bst) + boff); B2 = *(const uint4*)((Bk_ + 2 * bst) + boff); B3 = *(const uint4*)((Bk_ + 3 * bst) + boff); }
  GLOADT(0)
  const int so = lrow * 72 + lcol;
  const bf16_t* cA = sA + (wm * 128 + r) * 72 + hh * 8;
  const bf16_t* cB = sB + (wn * 64 + r) * 72 + hh * 8;
  const int KT = K >> 6;
  for (int kt = 0; kt < KT; ++kt) {
    __syncthreads();
    *(uint4*)(sA + so) = A0; *(uint4*)(sA + so + 32 * 72) = A1; *(uint4*)(sA + so + 64 * 72) = A2; *(uint4*)(sA + so + 96 * 72) = A3;
    *(uint4*)(sA + so + 128 * 72) = A4; *(uint4*)(sA + so + 160 * 72) = A5; *(uint4*)(sA + so + 192 * 72) = A6; *(uint4*)(sA + so + 224 * 72) = A7;
    *(uint4*)(sB + so) = B0; *(uint4*)(sB + so + 32 * 72) = B1; *(uint4*)(sB + so + 64 * 72) = B2; *(uint4*)(sB + so + 96 * 72) = B3;
    { const int kn = (kt + 1 < KT ? kt + 1 : kt) * 64; GLOADT(kn) }
    __builtin_amdgcn_sched_barrier(0);
    __syncthreads();
    __builtin_amdgcn_sched_barrier(0);
    __builtin_amdgcn_s_setprio(1);
    __builtin_amdgcn_iglp_opt(1);
#pragma unroll
    for (int ks = 0; ks < 4; ++ks) {
      const bf16x8 b0 = *(const bf16x8*)(cB + ks * 16), b1 = *(const bf16x8*)(cB + 32 * 72 + ks * 16);
#pragma unroll
      for (int mi = 0; mi < 4; ++mi) {
        const bf16x8 a = *(const bf16x8*)(cA + mi * 32 * 72 + ks * 16);
        acc[mi][0] = MFMA(a, b0, acc[mi][0]);
        acc[mi][1] = MFMA(a, b1, acc[mi][1]);
      }
      if (ks == 1) { __builtin_amdgcn_sched_barrier(0); __builtin_amdgcn_iglp_opt(1); }
    }
    __builtin_amdgcn_s_setprio(0);
    __builtin_amdgcn_sched_barrier(0);
  }
#undef GLOADT
  epi(acc, wm * 128, wn * 64, r, hh);
}

struct TileWalk {
  int L, Lend, nl;
  DI TileWalk(int T, const char* smem) {
    const volatile unsigned* xw = (const volatile unsigned*)(smem + 73728);
    const int nloc = (int)xw[0], sb = (int)xw[2], rk = (int)xw[3];
    int G = (int)gridDim.x;
    asm volatile("" : "+s"(G));
    nl = nloc;
    L = (T * sb) / G + rk; Lend = (T * (sb + nloc)) / G;
  }
  DI bool valid() const { return L < Lend; }
  DI void next() { L += nl; }
  DI void get(int SM, int SN, int nsn, int& mt, int& nt) const {
    const int s = L / (SM * SN), wi = L % (SM * SN);
    mt = (s / nsn) * SM + wi / SN; nt = (s % nsn) * SN + wi % SN;
  }
};

template <class MakeEpi>
DI void gemm_dense(const bf16_t* A, const bf16_t* Bt, int M, int N, int K, int SM, int SN, char* smem, MakeEpi&& mk) {
  const int t = tid(), lrow = t >> 3, lcol = (t & 7) * 8;
  const int ntn = N >> 7, ntm = M >> 8;
  for (TileWalk tw(ntn * ntm, smem); tw.valid(); tw.next()) {
    int mt, nt; tw.get(SM, SN, ntn / SN, mt, nt);
    unsigned aoff[8];
#pragma unroll
    for (int i = 0; i < 8; ++i) aoff[i] = (unsigned)(lrow + 32 * i) * (unsigned)K + (unsigned)lcol;
    gemm_tile<true>(A + (size_t)mt * 256 * K, aoff, Bt + (size_t)(nt * 128) * K, (unsigned)lrow * (unsigned)K + (unsigned)lcol, K, smem, mk(mt * 256, nt * 128));
  }
}

DI void phase_prep2(const Params& p, char* smem) {
  bf16_t* T = (bf16_t*)smem;
  const bf16_t* P = (const bf16_t*)(p.ws + O_P);
  bf16_t* Qc = (bf16_t*)(p.ws + O_QC); bf16_t* Kc = (bf16_t*)(p.ws + O_KC);
  bf16_t* KT = (bf16_t*)(p.ws + O_KT); bf16_t* VT = (bf16_t*)(p.ws + O_VT);
  bf16_t* RQ = (bf16_t*)(p.ws + O_RQ); bf16_t* RK = (bf16_t*)(p.ws + O_RK);
  bf16_t* AVTX = (bf16_t*)(p.ws + O_AVTX); bf16_t* AVTC = (bf16_t*)(p.ws + O_AVTC);
  const int t = tid();
  for (int item = blockIdx.x; item < 132 * 6; item += gridDim.x) {
    const int sc = item / 6, part = item % 6;
    const bool isx = sc < 128;
    const int row0 = sc * 128;
    const int seq_lo = isx ? (sc >> 6) * 8192 : NTOK + ((sc - 128) >> 1) * 256;
    const int seq_hi = seq_lo + (isx ? 8192 : 256);
    if (part < 4) {
      const int h = part;
      const int col8 = t & 15, rsub = t >> 4;
      for (int pass = 0; pass < 3; ++pass) {
        if (pass == 2 && !isx) break;
        const int pcol = (pass == 0 ? 512 : (pass == 1 ? 1024 : 0)) + h * 128 + col8 * 8;
        float cw[5][8];
        if (pass != 1) {
#pragma unroll
          for (int j = 0; j < 5; ++j)
#pragma unroll
            for (int e = 0; e < 8; ++e) cw[j][e] = p.ab_conv_w[j * 1024 + (pass == 0 ? 512 : 0) + h * 128 + col8 * 8 + e];
        }
        for (int i = 0; i < 8; ++i) {
          const int rl = rsub + 16 * i, row = row0 + rl;
          uint4 o;
          if (pass == 1) {
            o = *(const uint4*)(P + (size_t)row * PLD + pcol);
          } else {
            float a[8];
#pragma unroll
            for (int e = 0; e < 8; ++e) a[e] = 0.f;
#pragma unroll
            for (int j = 0; j < 5; ++j) {
              const int rr = row + j - 2;
              if (rr >= seq_lo && rr < seq_hi) {
                const bf16x8 v = *(const bf16x8*)(P + (size_t)rr * PLD + pcol);
#pragma unroll
                for (int e = 0; e < 8; ++e) a[e] += cw[j][e] * bf2f((bf16_t)v[e]);
              }
            }
            const float scl = pass == 0 ? 0.08838834764831845f : 1.f;
#pragma unroll
            for (int e = 0; e < 8; ++e) a[e] = siluf(a[e]) * scl;
            o.x = pack2(a[0], a[1]); o.y = pack2(a[2], a[3]); o.z = pack2(a[4], a[5]); o.w = pack2(a[6], a[7]);
            if (isx) *(uint4*)((pass == 0 ? Kc : Qc) + (size_t)row * 512 + h * 128 + col8 * 8) = o;
          }
          if (pass < 2) *(uint4*)(T + rl * 136 + col8 * 8) = o;
        }
        if (pass < 2) {
          __syncthreads();
          bf16_t* dstT = (pass == 0 ? KT : VT) + (size_t)(sc * 4 + h) * 16384;
          const int d = t & 127, shf = t >> 7;
#pragma unroll
          for (int s8 = 0; s8 < 8; ++s8) {
            const bf16_t* q = T + (shf * 64 + s8 * 8) * 136 + d;
            uint4 o;
            o.x = (unsigned)q[0] | ((unsigned)q[136] << 16); o.y = (unsigned)q[2 * 136] | ((unsigned)q[3 * 136] << 16);
            o.z = (unsigned)q[4 * 136] | ((unsigned)q[5 * 136] << 16); o.w = (unsigned)q[6 * 136] | ((unsigned)q[7 * 136] << 16);
            *(uint4*)(dstT + d * 128 + shf * 64 + s8 * 8) = o;
          }
          __syncthreads();
        }
      }
    } else if (part == 4) {
      if (!isx) continue;
      for (int idx = t; idx < 512; idx += 256) {
        const int rl = idx >> 2, dc = idx & 3, row = row0 + rl, pos = row - seq_lo;
        const float rp = (float)(pos >> 6), cp = (float)(pos & 63);
        float cs[8], sn[8];
#pragma unroll
        for (int e = 0; e < 8; ++e) {
          const int a = dc * 8 + e;
          const float inv = powf(10000.f, -(float)(a & 15) / 16.f);
          const float ang = (a < 16 ? rp : cp) * inv;
          cs[e] = cosf(ang); sn[e] = sinf(ang);
        }
        for (int hq = 0; hq < 8; ++hq) {
          const bf16x8 x1 = *(const bf16x8*)(P + (size_t)row * PLD + 2048 + hq * 64 + dc * 8);
          const bf16x8 x2 = *(const bf16x8*)(P + (size_t)row * PLD + 2048 + hq * 64 + 32 + dc * 8);
          float o1[8], o2[8];
#pragma unroll
          for (int e = 0; e < 8; ++e) {
            const float a = bf2f((bf16_t)x1[e]), b = bf2f((bf16_t)x2[e]);
            o1[e] = (a * cs[e] - b * sn[e]) * 0.125f; o2[e] = (b * cs[e] + a * sn[e]) * 0.125f;
          }
          uint4 u1, u2;
          u1.x = pack2(o1[0], o1[1]); u1.y = pack2(o1[2], o1[3]); u1.z = pack2(o1[4], o1[5]); u1.w = pack2(o1[6], o1[7]);
          u2.x = pack2(o2[0], o2[1]); u2.y = pack2(o2[2], o2[3]); u2.z = pack2(o2[4], o2[5]); u2.w = pack2(o2[6], o2[7]);
          *(uint4*)(RQ + (size_t)row * 512 + hq * 64 + dc * 8) = u1;
          *(uint4*)(RQ + (size_t)row * 512 + hq * 64 + 32 + dc * 8) = u2;
        }
      }
    } else {
      for (int idx = t; idx < 512; idx += 256) {
        const int rl = idx >> 2, dc = idx & 3, row = row0 + rl, pos = row - seq_lo;
        const float rp = (float)(pos >> 6), cp = (float)(pos & 63);
        float cs[8], sn[8];
#pragma unroll
        for (int e = 0; e < 8; ++e) {
          const int a = dc * 8 + e;
          const float inv = powf(10000.f, -(float)(a & 15) / 16.f);
          const float ang = (a < 16 ? rp : cp) * inv;
          cs[e] = isx ? cosf(ang) : 1.f; sn[e] = isx ? sinf(ang) : 0.f;
        }
        for (int g = 0; g < 2; ++g) {
          const bf16x8 x1 = *(const bf16x8*)(P + (size_t)row * PLD + 2560 + g * 64 + dc * 8);
          const bf16x8 x2 = *(const bf16x8*)(P + (size_t)row * PLD + 2560 + g * 64 + 32 + dc * 8);
          float o1[8], o2[8];
#pragma unroll
          for (int e = 0; e < 8; ++e) {
            const float a = bf2f((bf16_t)x1[e]), b = bf2f((bf16_t)x2[e]);
            o1[e] = a * cs[e] - b * sn[e]; o2[e] = b * cs[e] + a * sn[e];
          }
          uint4 u1, u2;
          u1.x = pack2(o1[0], o1[1]); u1.y = pack2(o1[2], o1[3]); u1.z = pack2(o1[4], o1[5]); u1.w = pack2(o1[6], o1[7]);
          u2.x = pack2(o2[0], o2[1]); u2.y = pack2(o2[2], o2[3]); u2.z = pack2(o2[4], o2[5]); u2.w = pack2(o2[6], o2[7]);
          *(uint4*)(RK + (size_t)row * 128 + g * 64 + dc * 8) = u1;
          *(uint4*)(RK + (size_t)row * 128 + g * 64 + 32 + dc * 8) = u2;
        }
      }
      {
        const int col8 = t & 15, rsub = t >> 4;
        for (int i = 0; i < 8; ++i) {
          const int rl = rsub + 16 * i;
          *(uint4*)(T + rl * 136 + col8 * 8) = *(const uint4*)(P + (size_t)(row0 + rl) * PLD + 2688 + col8 * 8);
        }
        __syncthreads();
        const int d = t & 127, shf = t >> 7;
        const int b = isx ? (sc >> 6) : ((sc - 128) >> 1);
        const int pos0 = row0 - seq_lo;
        bf16_t* dst = isx ? AVTX + ((size_t)(b * 2 + (d >> 6)) * 64 + (d & 63)) * 8192 + pos0
                          : AVTC + ((size_t)(b * 2 + (d >> 6)) * 64 + (d & 63)) * 256 + pos0;
#pragma unroll
        for (int s8 = 0; s8 < 8; ++s8) {
          const bf16_t* q = T + (shf * 64 + s8 * 8) * 136 + d;
          uint4 o;
          o.x = (unsigned)q[0] | ((unsigned)q[136] << 16); o.y = (unsigned)q[2 * 136] | ((unsigned)q[3 * 136] << 16);
          o.z = (unsigned)q[4 * 136] | ((unsigned)q[5 * 136] << 16); o.w = (unsigned)q[6 * 136] | ((unsigned)q[7 * 136] << 16);
          *(uint4*)(dst + shf * 64 + s8 * 8) = o;
        }
        __syncthreads();
      }
    }
  }
}

DI void attn_item(const Params& p, int item, char* smem) {
  const int g = item & 1, qb = (item >> 1) & 255, b = item >> 9;
  int t_ = tid();
  asm volatile("" : "+v"(t_));
  const int t = t_, lane = t & 63, w = t >> 6, r = lane & 31, hh = lane >> 5;
  const int hq = g * 4 + w, q0 = qb * 32;
  const bf16_t* RQ = (const bf16_t*)(p.ws + O_RQ); const bf16_t* RK = (const bf16_t*)(p.ws + O_RK);
  const bf16_t* AVTX = (const bf16_t*)(p.ws + O_AVTX); const bf16_t* AVTC = (const bf16_t*)(p.ws + O_AVTC);
  bf16_t* MIX = (bf16_t*)(p.ws + O_HA);
  const size_t qrow = (size_t)b * 8192 + q0 + r;
  bf16x8 qf[4];
#pragma unroll
  for (int ks = 0; ks < 4; ++ks) qf[ks] = ldfrag(RQ + qrow * 512 + hq * 64 + ks * 16 + hh * 8);
  float m = p.ab_sink[hq], l = hh == 0 ? 1.f : 0.f;
  f32x16 o0 = fzero(), o1 = fzero();
  const int ipos = q0 + r;
  const int lo = q0 - 128 < 0 ? 0 : q0 - 128, hi = q0 + 128 > 8192 - 32 ? 8192 - 32 : q0 + 128;
  const int nloc = ((hi - lo) >> 5) + 1, ntile = nloc + 8;
  bf16_t* sKt = (bf16_t*)smem;
  bf16_t* sVt = sKt + 2 * 32 * 72;
  const bf16_t* kloc = RK + (size_t)(b * 8192) * 128 + g * 64 + (t >> 3) * 128 + (t & 7) * 8;
  const bf16_t* kctx = RK + (size_t)(NTOK + b * 256) * 128 + g * 64 + (t >> 3) * 128 + (t & 7) * 8;
  const bf16_t* vloc = AVTX + (size_t)((b * 2 + g) * 64 + (t >> 2)) * 8192 + (t & 3) * 8;
  const bf16_t* vctx = AVTC + (size_t)((b * 2 + g) * 64 + (t >> 2)) * 256 + (t & 3) * 8;
  const int skoff = (t >> 3) * 72 + (t & 7) * 8, svoff = (t >> 2) * 40 + (t & 3) * 8;
  uint4 gk, gv;
#define ATT_LOAD(j_) { const bool loc_ = (j_) < nloc; const int k0_ = loc_ ? lo + (j_) * 32 : ((j_) - nloc) * 32; \
    gk = *(const uint4*)((loc_ ? kloc : kctx) + (size_t)k0_ * 128); gv = *(const uint4*)((loc_ ? vloc : vctx) + k0_); }
  ATT_LOAD(0)
  __syncthreads();
  *(uint4*)(sKt + skoff) = gk; *(uint4*)(sVt + svoff) = gv;
  __syncthreads();
#pragma unroll 1
  for (int tile = 0; tile < ntile; ++tile) {
    const int cur = tile & 1;
    if (tile + 1 < ntile) ATT_LOAD(tile + 1)
    const bool local = tile < nloc;
    const int k0 = local ? lo + tile * 32 : (tile - nloc) * 32;
    const bf16_t* kt = sKt + cur * 32 * 72 + r * 72 + hh * 8;
    const bf16_t* vt = sVt + cur * 64 * 40 + r * 40 + 4 * hh;
    f32x16 s = fzero();
#pragma unroll
    for (int ks = 0; ks < 4; ++ks) s = MFMA(*(const bf16x8*)(kt + ks * 16), qf[ks], s);
    float tmax = -INFINITY;
#pragma unroll
    for (int i = 0; i < 16; ++i) {
      const int dj = ipos - (k0 + crow(i, hh));
      const bool ok = !local || (dj <= 128 && dj >= -128);
      s[i] = ok ? s[i] : -INFINITY;
      tmax = fmaxf(tmax, s[i]);
    }
    tmax = fmaxf(tmax, __shfl_xor(tmax, 32));
    const float mn = fmaxf(m, tmax), corr = __expf(m - mn);
    m = mn; l *= corr;
#pragma unroll
    for (int i = 0; i < 16; ++i) { o0[i] *= corr; o1[i] *= corr; }
#pragma unroll
    for (int i = 0; i < 16; ++i) { s[i] = __expf(s[i] - mn); l += s[i]; }
    const bf16x8 pf0 = pack8(s[0], s[1], s[2], s[3], s[4], s[5], s[6], s[7]);
    const bf16x8 pf1 = pack8(s[8], s[9], s[10], s[11], s[12], s[13], s[14], s[15]);
    o0 = MFMA(ldfrag2(vt, vt + 8), pf0, o0);
    o1 = MFMA(ldfrag2(vt + 32 * 40, vt + 32 * 40 + 8), pf0, o1);
    o0 = MFMA(ldfrag2(vt + 16, vt + 24), pf1, o0);
    o1 = MFMA(ldfrag2(vt + 32 * 40 + 16, vt + 32 * 40 + 24), pf1, o1);
    if (tile + 1 < ntile) { *(uint4*)(sKt + (cur ^ 1) * 32 * 72 + skoff) = gk; *(uint4*)(sVt + (cur ^ 1) * 64 * 40 + svoff) = gv; }
    __syncthreads();
  }
#undef ATT_LOAD
  l += __shfl_xor(l, 32);
  const float inv = 1.f / l;
  bf16_t* dst = MIX + qrow * 1024 + 512 + hq * 64;
#pragma unroll
  for (int q4 = 0; q4 < 4; ++q4) {
    const int d = 8 * q4 + 4 * hh;
    uint2 u;
    u.x = pack2(o0[4 * q4] * inv, o0[4 * q4 + 1] * inv); u.y = pack2(o0[4 * q4 + 2] * inv, o0[4 * q4 + 3] * inv);
    *(uint2*)(dst + d) = u;
    u.x = pack2(o1[4 * q4] * inv, o1[4 * q4 + 1] * inv); u.y = pack2(o1[4 * q4 + 2] * inv, o1[4 * q4 + 3] * inv);
    *(uint2*)(dst + 32 + d) = u;
  }
}

DI void mlstm_local_item(const Params& p, int item, char* smem) {
  float* gs = (float*)smem;
  float* wv = gs + 512;
  float* msc = wv + 256;
  int t_ = tid();
  asm volatile("" : "+v"(t_));
  const int t = t_, lane = t & 63, w = t >> 6, wm = w >> 1, wn = w & 1, r = lane & 31, hh = lane >> 5;
  const int bh = item / NSTEP, nc = item % NSTEP, b = bh >> 2, h = bh & 3;
  const int sc = nc < 2 ? 128 + b * 2 + nc : b * 64 + (nc - 2);
  const int row0 = sc * 128;
  const float* GL = (const float*)(p.ws + O_GL);
  const bf16_t* KT = (const bf16_t*)(p.ws + O_KT) + (size_t)(sc * 4 + h) * 16384;
  const bf16_t* VT = (const bf16_t*)(p.ws + O_VT) + (size_t)(sc * 4 + h) * 16384;
  char* sK = smem + 8192;
  char* sV = sK + 32768;
#pragma unroll
  for (int i = 0; i < 8; ++i) {
    const int q = t + 256 * i, row = q >> 4, cc = q & 15;
    const int so = row * 256 + ((cc ^ (row & 15)) << 4);
    *(uint4*)(sK + so) = *(const uint4*)(KT + row * 128 + cc * 8);
    *(uint4*)(sV + so) = *(const uint4*)(VT + row * 128 + cc * 8);
  }
  for (int i = t; i < 512; i += 256) { const int ty = i >> 7, s = i & 127; gs[i] = GL[(size_t)(row0 + s) * 16 + ty * 4 + h]; }
  __syncthreads();
  {
    const int dir = t >> 7, s = t & 127;
    float wval, tot = 0.f;
    if (dir == 0) {
      float bsum = 0.f;
      for (int j = 0; j < 128; ++j) { const float f = gs[128 + j]; tot += f; if (j <= s) bsum += f; }
      wval = tot - bsum + gs[s];
    } else {
      float pre = 0.f;
      for (int j = 0; j < 128; ++j) { const float f = gs[384 + j]; tot += f; if (j < s) pre += f; }
      wval = pre + gs[256 + s];
    }
    wv[dir * 128 + s] = wval;
    if (s == 0) msc[dir] = tot;
  }
  __syncthreads();
  {
    const int dir = t >> 7, s = t & 127;
    float mx = -INFINITY;
    for (int j = 0; j < 128; ++j) mx = fmaxf(mx, wv[dir * 128 + j]);
    const float wval = wv[dir * 128 + s];
    __syncthreads();
    wv[dir * 128 + s] = expf(wval - mx);
    if (s == 0) msc[2 + dir] = mx;
  }
  __syncthreads();
  bf16_t* DC = (bf16_t*)(p.ws + O_DC);
#pragma unroll 1
  for (int d = 0; d < 2; ++d) {
    f32x16 acc[2][2];
#pragma unroll
    for (int i = 0; i < 2; ++i)
#pragma unroll
      for (int j = 0; j < 2; ++j) acc[i][j] = fzero();
#pragma unroll 2
    for (int ks = 0; ks < 8; ++ks) {
      const int xo = ((ks * 2 + hh) ^ (r & 15)) << 4;
      const bf16x8 ra0 = *(const bf16x8*)(sV + (wm * 64 + r) * 256 + xo);
      const bf16x8 ra1 = *(const bf16x8*)(sV + (wm * 64 + 32 + r) * 256 + xo);
      const bf16x8 b0 = *(const bf16x8*)(sK + (wn * 64 + r) * 256 + xo);
      const bf16x8 b1 = *(const bf16x8*)(sK + (wn * 64 + 32 + r) * 256 + xo);
      const float* ww = wv + d * 128 + ks * 16 + hh * 8;
      const bf16x8 a0 = pack8(bf2f((bf16_t)ra0[0]) * ww[0], bf2f((bf16_t)ra0[1]) * ww[1], bf2f((bf16_t)ra0[2]) * ww[2], bf2f((bf16_t)ra0[3]) * ww[3],
                              bf2f((bf16_t)ra0[4]) * ww[4], bf2f((bf16_t)ra0[5]) * ww[5], bf2f((bf16_t)ra0[6]) * ww[6], bf2f((bf16_t)ra0[7]) * ww[7]);
      const bf16x8 a1 = pack8(bf2f((bf16_t)ra1[0]) * ww[0], bf2f((bf16_t)ra1[1]) * ww[1], bf2f((bf16_t)ra1[2]) * ww[2], bf2f((bf16_t)ra1[3]) * ww[3],
                              bf2f((bf16_t)ra1[4]) * ww[4], bf2f((bf16_t)ra1[5]) * ww[5], bf2f((bf16_t)ra1[6]) * ww[6], bf2f((bf16_t)ra1[7]) * ww[7]);
      acc[0][0] = MFMA(a0, b0, acc[0][0]);
      acc[0][1] = MFMA(a0, b1, acc[0][1]);
      acc[1][0] = MFMA(a1, b0, acc[1][0]);
      acc[1][1] = MFMA(a1, b1, acc[1][1]);
    }
    bf16_t* dst = DC + ((size_t)(bh * 2 + d) * NSTEP + nc) * 16384;
#pragma unroll
    for (int mi = 0; mi < 2; ++mi)
#pragma unroll
      for (int ni = 0; ni < 2; ++ni)
#pragma unroll
        for (int i = 0; i < 16; ++i)
          dst[(wm * 64 + mi * 32 + crow(i, hh)) * 128 + wn * 64 + ni * 32 + r] = f2bf(acc[mi][ni][i]);
  }
  {
    const int dir = t >> 7, k = t & 127;
    float s = 0.f;
    for (int s8 = 0; s8 < 16; ++s8) {
      const bf16x8 v = *(const bf16x8*)(sK + k * 256 + ((s8 ^ (k & 15)) << 4));
#pragma unroll
      for (int e = 0; e < 8; ++e) s += wv[dir * 128 + s8 * 8 + e] * bf2f((bf16_t)v[e]);
    }
    ((float*)(p.ws + O_DN))[((size_t)(bh * 2 + dir) * NSTEP + nc) * 128 + k] = s;
    if (k == 0) {
      ((float*)(p.ws + O_GSC))[(bh * 2 + dir) * NSTEP + nc] = msc[dir];
      ((float*)(p.ws + O_MLOC))[(bh * 2 + dir) * NSTEP + nc] = msc[2 + dir];
    }
  }
  __syncthreads();
}

DI int chain_nc(int dir, int i) { return dir == 0 ? i : (i < 2 ? 1 - i : 67 - i); }
template <int DIR>
DI void scan_chain_elems(const bf16_t* __restrict__ DCc, bf16_t* __restrict__ CSTc, const float* fa, const float* fb, int e, int epos) {
  float C = 0.f;
#pragma unroll
  for (int blk = 0; blk < 3; ++blk) {
    float v[22];
#pragma unroll
    for (int j = 0; j < 22; ++j) {
      const int i = blk * 22 + j;
      const int nc = DIR == 0 ? i : (i < 2 ? 1 - i : 67 - i);
      v[j] = bf2f(DCc[(size_t)nc * 16384 + e]);
    }
#pragma unroll
    for (int j = 0; j < 22; ++j) {
      const int i = blk * 22 + j;
      const int nc = DIR == 0 ? i : (i < 2 ? 1 - i : 67 - i);
      if (i >= 2) CSTc[(size_t)(nc - 2) * 16384 + epos] = f2bf(C);
      C = fa[i] * C + fb[i] * v[j];
    }
  }
}
DI void phase_scan(const Params& p, char* smem) {
  float* fa = (float*)smem;
  float* fb = fa + 66;
  const float* GSC = (const float*)(p.ws + O_GSC); const float* MLOC = (const float*)(p.ws + O_MLOC);
  const bf16_t* DC = (const bf16_t*)(p.ws + O_DC); const float* DN = (const float*)(p.ws + O_DN);
  bf16_t* CST = (bf16_t*)(p.ws + O_CST); float* NST = (float*)(p.ws + O_NST); float* MST = (float*)(p.ws + O_MST);
  const int t = tid();
  for (int item = blockIdx.x; item < 16 * 64 + 16; item += gridDim.x) {
    const int chain = item < 1024 ? (item >> 6) : (item - 1024), dir = chain & 1;
    __syncthreads();
    if (t < NSTEP) { const int nc = chain_nc(dir, t); fa[t] = GSC[chain * NSTEP + nc]; fb[t] = MLOC[chain * NSTEP + nc]; }
    __syncthreads();
    if (t == 0) {
      float m = 0.f;
      for (int i = 0; i < NSTEP; ++i) {
        if (i >= 2 && item >= 1024) MST[chain * 64 + chain_nc(dir, i) - 2] = m;
        const float g = fa[i], ml = fb[i];
        const float mn = fmaxf(g + m, ml);
        fa[i] = __expf(g + m - mn); fb[i] = __expf(ml - mn);
        m = mn;
      }
    }
    __syncthreads();
    if (item < 1024) {
      const int e = (item & 63) * 256 + t;
      const int ev = e >> 7, ek = e & 127;
      const int epos = ((((ev >> 5) * 8 + (ek >> 4)) * 64) + ((ek >> 3) & 1) * 32 + (ev & 31)) * 8 + (ek & 7);
      const bf16_t* DCc = DC + (size_t)chain * NSTEP * 16384;
      bf16_t* CSTc = CST + (size_t)chain * 64 * 16384;
      if (dir == 0) scan_chain_elems<0>(DCc, CSTc, fa, fb, e, epos);
      else scan_chain_elems<1>(DCc, CSTc, fa, fb, e, epos);
    } else if (t < 128) {
      const int k = t;
      float n = 0.f;
      for (int i = 0; i < NSTEP; ++i) {
        const int nc = chain_nc(dir, i);
        if (i >= 2) NST[((size_t)chain * 64 + (nc - 2)) * 128 + k] = n;
        n = fa[i] * n + fb[i] * DN[((size_t)chain * NSTEP + nc) * 128 + k];
      }
    }
  }
}

DI void mlstm_out_item(const Params& p, int item, char* smem) {
  float* gs = (float*)smem;
  float* bb = gs + 512;
  float* lib = bb + 256;
  float* mrow = lib + 256;
  float* aT = mrow + 256;
  float* nq = aT + 256;
  float* nst = nq + 256;
  char* sK = smem + 8192;
  char* sV = sK + 32768;
  int t_ = tid();
  asm volatile("" : "+v"(t_));
  const int t = t_, lane = t & 63, w = t >> 6, r = lane & 31, hh = lane >> 5;
  const int bh = item >> 6, c = item & 63, b = bh >> 2, h = bh & 3;
  const int sc = b * 64 + c, row0 = sc * 128;
  const float* GL = (const float*)(p.ws + O_GL);
  const bf16_t* Qc = (const bf16_t*)(p.ws + O_QC); const bf16_t* Kc = (const bf16_t*)(p.ws + O_KC);
  const bf16_t* VT = (const bf16_t*)(p.ws + O_VT) + (size_t)(sc * 4 + h) * 16384;
  const bf16_t* P = (const bf16_t*)(p.ws + O_P);
  const float* MST = (const float*)(p.ws + O_MST);
  bf16_t* MIX = (bf16_t*)(p.ws + O_HA);
#pragma unroll
  for (int i = 0; i < 8; ++i) {
    const int q = t + 256 * i, row = q >> 4, cc = q & 15;
    const int so = row * 256 + ((cc ^ (row & 15)) << 4);
    *(uint4*)(sK + so) = *(const uint4*)(Kc + (size_t)(row0 + row) * 512 + h * 128 + cc * 8);
    *(uint4*)(sV + so) = *(const uint4*)(VT + row * 128 + cc * 8);
  }
  for (int i = t; i < 512; i += 256) { const int ty = i >> 7, s = i & 127; gs[i] = GL[(size_t)(row0 + s) * 16 + ty * 4 + h]; }
  {
    const int dir = t >> 7, k = t & 127;
    nst[t] = ((const float*)(p.ws + O_NST))[((size_t)(bh * 2 + dir) * 64 + c) * 128 + k];
  }
  __syncthreads();
  {
    const int dir = t >> 7, s = t & 127;
    float bsum = 0.f;
    if (dir == 0) { for (int j = 0; j <= s; ++j) bsum += gs[128 + j]; }
    else { for (int j = s; j < 128; ++j) bsum += gs[384 + j]; }
    bb[t] = bsum;
    lib[t] = gs[dir * 256 + s] - bsum;
    const bf16_t* qr = Qc + (size_t)(row0 + s) * 512 + h * 128;
    float acc = 0.f;
    for (int k8 = 0; k8 < 16; ++k8) {
      const bf16x8 v = ldfrag(qr + k8 * 8);
#pragma unroll
      for (int e = 0; e < 8; ++e) acc += nst[dir * 128 + k8 * 8 + e] * bf2f((bf16_t)v[e]);
    }
    nq[t] = acc;
  }
  __syncthreads();
  {
    const int dir = t >> 7, s = t & 127;
    float pm = -INFINITY;
    if (dir == 0) { for (int j = 0; j <= s; ++j) pm = fmaxf(pm, lib[j]); }
    else { for (int j = s; j < 128; ++j) pm = fmaxf(pm, lib[128 + j]); }
    const float m_in = MST[(bh * 2 + dir) * 64 + c];
    const float mr = bb[t] + fmaxf(m_in, pm);
    mrow[t] = mr;
    aT[t] = expf(bb[t] + m_in - mr);
  }
  __syncthreads();
  const int tl = w * 32 + r;
  const bf16_t* qrow = Qc + (size_t)(row0 + tl) * 512 + h * 128 + hh * 8;
  bf16x8 qf[8];
#pragma unroll
  for (int ks = 0; ks < 8; ++ks) qf[ks] = ldfrag(qrow + ks * 16);
  const int swz = r & 15;
  const char* kp[8]; const char* vp[16];
#pragma unroll
  for (int ks = 0; ks < 8; ++ks) kp[ks] = sK + r * 256 + (((ks * 2 + hh) ^ swz) << 4);
#pragma unroll
  for (int cc = 0; cc < 16; ++cc) vp[cc] = sV + r * 256 + 8 * hh + ((cc ^ swz) << 4);
  float* Hb = (float*)(p.ws + O_DC) + (size_t)item * 16384 + tl;
  float* Hbh = Hb + 4 * hh * 128;
  f32x16 outa[4];
#define MLSTM_DIR(DIR)                                                                                                   \
  {                                                                                                                      \
    const bf16_t* CSTl = (const bf16_t*)(p.ws + O_CST) + ((size_t)(bh * 2 + DIR) * 64 + c) * 16384 + lane * 8;           \
    const float bbt = bb[DIR * 128 + tl], mrt = mrow[DIR * 128 + tl], at = aT[DIR * 128 + tl];                            \
    float dsum = 0.f;                                                                                                    \
    const float* libp = lib + DIR * 128 + 4 * hh;                                                                        \
    const int tb = tl - 4 * hh;                                                                                          \
    bf16x8 pf[8];                                                                                                        \
    _Pragma("unroll") for (int half = 0; half < 2; ++half) {                                                             \
      f32x16 st[2];                                                                                                      \
      st[0] = fzero(); st[1] = fzero();                                                                                  \
      _Pragma("unroll") for (int ks = 0; ks < 8; ++ks) {                                                                 \
        _Pragma("unroll") for (int r2 = 0; r2 < 2; ++r2)                                                                 \
          st[r2] = MFMA(*(const bf16x8*)(kp[ks] + (half * 2 + r2) * 8192), qf[ks], st[r2]);                              \
      }                                                                                                                  \
      _Pragma("unroll") for (int r2 = 0; r2 < 2; ++r2) {                                                                 \
        const int rb = half * 2 + r2;                                                                                    \
        _Pragma("unroll") for (int i = 0; i < 16; ++i) {                                                                 \
          const int sc_ = rb * 32 + (i & 3) + 8 * (i >> 2);                                           \
          const int diff = DIR == 0 ? (tb - sc_) : (sc_ - tb);                                                           \
          const float msk = (float)((unsigned)(~diff) >> 31);                                                            \
          const float v = st[r2][i] * __expf(fminf(bbt + libp[sc_] - mrt, 0.f)) * msk;                                    \
          st[r2][i] = v; dsum += v;                                                                                      \
        }                                                                                                                \
        pf[rb * 2] = pack8(st[r2][0], st[r2][1], st[r2][2], st[r2][3], st[r2][4], st[r2][5], st[r2][6], st[r2][7]);      \
        pf[rb * 2 + 1] = pack8(st[r2][8], st[r2][9], st[r2][10], st[r2][11], st[r2][12], st[r2][13], st[r2][14], st[r2][15]); \
      }                                                                                                                  \
      __builtin_amdgcn_sched_barrier(0);                                                                                 \
    }                                                                                                                    \
    dsum += __shfl_xor(dsum, 32);                                                                                        \
    const float den = dsum + at * nq[DIR * 128 + tl];                                                                    \
    const float dinv = 1.f / fmaxf(fabsf(den), expf(-mrt));                                                              \
    _Pragma("unroll") for (int half = 0; half < 2; ++half) {                                                             \
      f32x16 ha[2];                                                                                                      \
      ha[0] = fzero(); ha[1] = fzero();                                                                                  \
      _Pragma("unroll") for (int ks = 0; ks < 8; ++ks) {                                                                 \
        _Pragma("unroll") for (int r2 = 0; r2 < 2; ++r2)                                                                 \
          ha[r2] = MFMA(ldfrag(CSTl + ((half * 2 + r2) * 8 + ks) * 512), qf[ks], ha[r2]);                                \
        if (ks == 3) __builtin_amdgcn_sched_barrier(0);                                                                  \
      }                                                                                                                  \
      _Pragma("unroll") for (int r2 = 0; r2 < 2; ++r2)                                                                   \
        _Pragma("unroll") for (int i = 0; i < 16; ++i) ha[r2][i] *= at;                                                  \
      __builtin_amdgcn_sched_barrier(0);                                                                                 \
      _Pragma("unroll") for (int kk = 0; kk < 8; ++kk) {                                                                 \
        _Pragma("unroll") for (int r2 = 0; r2 < 2; ++r2) {                                                               \
          const s16x4 lo = *(const s16x4*)(vp[2 * kk] + (half * 2 + r2) * 8192);                                         \
          const s16x4 hi = *(const s16x4*)(vp[2 * kk + 1] + (half * 2 + r2) * 8192);                                     \
          ha[r2] = MFMA(__builtin_shufflevector(lo, hi, 0, 1, 2, 3, 4, 5, 6, 7), pf[kk], ha[r2]);                        \
        }                                                                                                                \
      }                                                                                                                  \
      _Pragma("unroll") for (int r2 = 0; r2 < 2; ++r2)                                                                   \
        _Pragma("unroll") for (int i = 0; i < 16; ++i) {                                                                 \
          float* hp = Hbh + ((half * 2 + r2) * 32 + (i & 3) + 8 * (i >> 2)) * 128;                                       \
          if (DIR == 0) *hp = ha[r2][i] * dinv;                                                                          \
          else outa[half * 2 + r2][i] = *hp + ha[r2][i] * dinv;                                                          \
        }                                                                                                                \
      __builtin_amdgcn_sched_barrier(0);                                                                                 \
    }                                                                                                                    \
  }
  MLSTM_DIR(0)
  MLSTM_DIR(1)
#undef MLSTM_DIR
  float ss = 0.f;
#pragma unroll
  for (int rb = 0; rb < 4; ++rb)
#pragma unroll
    for (int i = 0; i < 16; ++i) ss += outa[rb][i] * outa[rb][i];
  ss += __shfl_xor(ss, 32);
  const float rn = rsqrtf(ss * (1.f / 128.f) + EPS);
  const size_t row = (size_t)row0 + tl;
#pragma unroll
  for (int rb = 0; rb < 4; ++rb)
#pragma unroll
    for (int q4 = 0; q4 < 4; ++q4) {
      const int v = rb * 32 + 8 * q4 + 4 * hh;
      const s16x4 ov = *(const s16x4*)(P + row * PLD + 1536 + h * 128 + v);
      const float4 hg = *(const float4*)(p.ab_head_g + h * 128 + v);
      const float y0 = outa[rb][4 * q4] * rn * hg.x * sigmf(bf2f((bf16_t)ov[0]));
      const float y1 = outa[rb][4 * q4 + 1] * rn * hg.y * sigmf(bf2f((bf16_t)ov[1]));
      const float y2 = outa[rb][4 * q4 + 2] * rn * hg.z * sigmf(bf2f((bf16_t)ov[2]));
      const float y3 = outa[rb][4 * q4 + 3] * rn * hg.w * sigmf(bf2f((bf16_t)ov[3]));
      uint2 u; u.x = pack2(y0, y1); u.y = pack2(y2, y3);
      *(uint2*)(MIX + row * 1024 + h * 128 + v) = u;
    }
  __syncthreads();
}

DI void phase_topk(const Params& p, char* smem) {
  unsigned* vals = (unsigned*)smem;
  unsigned* hist = vals + 8448;
  unsigned* cntg = hist + 256;
  unsigned* cnte = cntg + 256;
  unsigned* misc = cnte + 256;
  const float* AFF = (const float*)(p.ws + O_AFF);
  int* IDX = (int*)(p.ws + O_IDX); float* GATE = (float*)(p.ws + O_GATE); int* INV = (int*)(p.ws + O_INV);
  const int t = tid();
  for (int item = blockIdx.x; item < 32; item += gridDim.x) {
    const float* a = AFF + (size_t)item * 8192;
    for (int i = t; i < 8192; i += 256) vals[i + (i >> 5)] = __float_as_uint(a[i]);
    unsigned prefix = 0, remaining = 1024;
    for (int pass = 0; pass < 4; ++pass) {
      const int shift = 24 - 8 * pass;
      hist[t] = 0;
      __syncthreads();
      const unsigned mask = pass == 0 ? 0u : (0xFFFFFFFFu << (shift + 8));
      for (int i = t; i < 8192; i += 256) {
        const unsigned u = vals[i + (i >> 5)];
        if ((u & mask) == (prefix & mask)) atomicAdd(&hist[(u >> shift) & 255], 1u);
      }
      __syncthreads();
      {
        unsigned above = 0;
        for (int bin = t + 1; bin < 256; ++bin) above += hist[bin];
        const unsigned mineh = hist[t];
        if (above < remaining && above + mineh >= remaining) {
          misc[0] = prefix | ((unsigned)t << shift);
          misc[1] = remaining - above;
        }
      }
      __syncthreads();
      prefix = misc[0]; remaining = misc[1];
      __syncthreads();
    }
    const unsigned T = prefix, need_eq = remaining;
    unsigned cg_ = 0, ce = 0;
    for (int j = 0; j < 32; ++j) {
      const int n = t * 32 + j;
      const unsigned u = vals[n + (n >> 5)];
      cg_ += u > T; ce += u == T;
    }
    cntg[t] = cg_; cnte[t] = ce;
    __syncthreads();
    unsigned pg = 0, pe = 0;
    for (int j = 0; j < t; ++j) { pg += cntg[j]; pe += cnte[j]; }
    for (int j = 0; j < 32; ++j) {
      const int n = t * 32 + j;
      const unsigned u = vals[n + (n >> 5)];
      if (u > T) { IDX[item * 1024 + pg] = n; GATE[item * 1024 + pg] = __uint_as_float(u); INV[((size_t)(item >> 4) * 8192 + n) * 16 + (item & 15)] = (int)pg + 1; ++pg; }
      else if (u == T) {
        if (pe < need_eq) { const unsigned slot = 1024 - need_eq + pe; IDX[item * 1024 + slot] = n; GATE[item * 1024 + slot] = __uint_as_float(u); INV[((size_t)(item >> 4) * 8192 + n) * 16 + (item & 15)] = (int)slot + 1; }
        ++pe;
      }
    }
    __syncthreads();
  }
}

DI void phase_stats(const Params& p, char* smem) {
  float* red = (float*)smem;
  const bf16_t* GVT = (const bf16_t*)(p.ws + O_GVT);
  float* PART = (float*)(p.ws + O_STATS);
  const int t = tid(), qq = t & 31, cg_ = t >> 5;
  for (int item = blockIdx.x; item < 1024; item += gridDim.x) {
    const int chunk = item >> 3, cgrp = item & 7;
    const bf16_t* base = GVT + ((size_t)chunk * 2048 + cgrp * 256) * 128 + qq * 4;
    float s[4] = {0.f, 0.f, 0.f, 0.f}, s2[4] = {0.f, 0.f, 0.f, 0.f};
#pragma unroll 8
    for (int c = cg_; c < 256; c += 8) {
      const s16x4 v = *(const s16x4*)(base + (size_t)c * 128);
#pragma unroll
      for (int e = 0; e < 4; ++e) { const float f = bf2f((bf16_t)v[e]); s[e] += f; s2[e] += f * f; }
    }
#pragma unroll
    for (int e = 0; e < 4; ++e) { red[(cg_ * 128 + qq * 4 + e) * 2] = s[e]; red[(cg_ * 128 + qq * 4 + e) * 2 + 1] = s2[e]; }
    __syncthreads();
    if (t < 128) {
      float a = 0.f, b2 = 0.f;
      for (int g = 0; g < 8; ++g) { a += red[(g * 128 + t) * 2]; b2 += red[(g * 128 + t) * 2 + 1]; }
      PART[((size_t)item * 128 + t) * 2] = a;
      PART[((size_t)item * 128 + t) * 2 + 1] = b2;
    }
    __syncthreads();
  }
}
DI void phase_spatial(const Params& p, char* smem) {
  float* smu = (float*)smem;
  float* srs = smu + 128;
  const bf16_t* GVT = (const bf16_t*)(p.ws + O_GVT); const bf16_t* U = (const bf16_t*)(p.ws + O_U);
  const float* PART = (const float*)(p.ws + O_STATS);
  bf16_t* UV = (bf16_t*)(p.ws + O_UV);
  char* sW = smem + 1024;
  int g_staged = -1;
  for (int item = blockIdx.x; item < 1024; item += gridDim.x) {
    int t_ = tid();
    const int t = t_, lane = t & 63, w = t >> 6, r = lane & 31, hh = lane >> 5;
    const int chunk = item >> 3, g = item & 7;
    if (t < 128) {
      float a = 0.f, b2 = 0.f;
#pragma unroll
      for (int j = 0; j < 8; ++j) { a += PART[((size_t)(chunk * 8 + j) * 128 + t) * 2]; b2 += PART[((size_t)(chunk * 8 + j) * 128 + t) * 2 + 1]; }
      const float mu = a * (1.f / 2048.f);
      const float var = fmaxf(b2 * (1.f / 2048.f) - mu * mu, 0.f);
      smu[t] = mu; srs[t] = rsqrtf(var + EPS);
    }
    if (g != g_staged) {
      const float* Wg = p.gm_w_s + (size_t)g * 16384;
#pragma unroll
      for (int i = 0; i < 8; ++i) {
        const int q = t + 256 * i, row = q >> 4, cc = q & 15;
        const float4 w0 = *(const float4*)(Wg + row * 128 + cc * 8), w1 = *(const float4*)(Wg + row * 128 + cc * 8 + 4);
        uint4 o; o.x = pack2(w0.x, w0.y); o.y = pack2(w0.z, w0.w); o.z = pack2(w1.x, w1.y); o.w = pack2(w1.z, w1.w);
        *(uint4*)(sW + row * 256 + ((cc ^ (row & 15)) << 4)) = o;
      }
      g_staged = g;
    }
    __syncthreads();
    f32x16 acc[2][4];
#pragma unroll
    for (int i = 0; i < 4; ++i) { acc[0][i] = fzero(); acc[1][i] = fzero(); }
    const int cA = g * 256 + w * 64 + r, cB = cA + 32;
    const float lgA = p.gm_ln_g[cA], lbA = p.gm_ln_b[cA], lgB = p.gm_ln_g[cB], lbB = p.gm_ln_b[cB];
    const bf16_t* vA = GVT + ((size_t)chunk * 2048 + cA) * 128 + hh * 8;
    const bf16_t* vB = GVT + ((size_t)chunk * 2048 + cB) * 128 + hh * 8;
    for (int ks = 0; ks < 8; ++ks) {
      const bf16x8 ra = ldfrag(vA + ks * 16), rbv = ldfrag(vB + ks * 16);
      const float* mu = smu + ks * 16 + hh * 8; const float* rs = srs + ks * 16 + hh * 8;
      const bf16x8 aA = pack8((bf2f((bf16_t)ra[0]) - mu[0]) * rs[0] * lgA + lbA, (bf2f((bf16_t)ra[1]) - mu[1]) * rs[1] * lgA + lbA,
                              (bf2f((bf16_t)ra[2]) - mu[2]) * rs[2] * lgA + lbA, (bf2f((bf16_t)ra[3]) - mu[3]) * rs[3] * lgA + lbA,
                              (bf2f((bf16_t)ra[4]) - mu[4]) * rs[4] * lgA + lbA, (bf2f((bf16_t)ra[5]) - mu[5]) * rs[5] * lgA + lbA,
                              (bf2f((bf16_t)ra[6]) - mu[6]) * rs[6] * lgA + lbA, (bf2f((bf16_t)ra[7]) - mu[7]) * rs[7] * lgA + lbA);
      const bf16x8 aB = pack8((bf2f((bf16_t)rbv[0]) - mu[0]) * rs[0] * lgB + lbB, (bf2f((bf16_t)rbv[1]) - mu[1]) * rs[1] * lgB + lbB,
                              (bf2f((bf16_t)rbv[2]) - mu[2]) * rs[2] * lgB + lbB, (bf2f((bf16_t)rbv[3]) - mu[3]) * rs[3] * lgB + lbB,
                              (bf2f((bf16_t)rbv[4]) - mu[4]) * rs[4] * lgB + lbB, (bf2f((bf16_t)rbv[5]) - mu[5]) * rs[5] * lgB + lbB,
                              (bf2f((bf16_t)rbv[6]) - mu[6]) * rs[6] * lgB + lbB, (bf2f((bf16_t)rbv[7]) - mu[7]) * rs[7] * lgB + lbB);
#pragma unroll
      for (int pb = 0; pb < 4; ++pb) {
        const bf16x8 bw = *(const bf16x8*)(sW + (pb * 32 + r) * 256 + (((ks * 2 + hh) ^ (r & 15)) << 4));
        acc[0][pb] = MFMA(aA, bw, acc[0][pb]);
        acc[1][pb] = MFMA(aB, bw, acc[1][pb]);
      }
    }
#pragma unroll
    for (int pb = 0; pb < 4; ++pb) {
      const int pp = pb * 32 + r;
      const float bs = p.gm_b_s[g * 128 + pp];
      const size_t rowo = ((size_t)chunk * 128 + pp) * 2048 + g * 256 + w * 64 + 4 * hh;
#pragma unroll
      for (int cb = 0; cb < 2; ++cb)
#pragma unroll
        for (int q4 = 0; q4 < 4; ++q4) {
          const size_t o = rowo + cb * 32 + 8 * q4;
          const s16x4 uu = *(const s16x4*)(U + o);
          uint2 st;
          st.x = pack2(bf2f((bf16_t)uu[0]) * (acc[cb][pb][4 * q4] + bs), bf2f((bf16_t)uu[1]) * (acc[cb][pb][4 * q4 + 1] + bs));
          st.y = pack2(bf2f((bf16_t)uu[2]) * (acc[cb][pb][4 * q4 + 2] + bs), bf2f((bf16_t)uu[3]) * (acc[cb][pb][4 * q4 + 3] + bs));
          *(uint2*)(UV + o) = st;
        }
    }
    __syncthreads();
  }
}

struct EpiBf16 {
  bf16_t* dst; int ld;
  DI void operator()(f32x16 (&acc)[4][2], int mb, int nb, int r, int hh) const {
#pragma unroll
    for (int mi = 0; mi < 4; ++mi)
#pragma unroll
      for (int ni = 0; ni < 2; ++ni)
#pragma unroll
        for (int i = 0; i < 16; ++i)
          dst[(size_t)(mb + mi * 32 + crow(i, hh)) * ld + nb + ni * 32 + r] = f2bf(acc[mi][ni][i]);
  }
};
struct EpiRes {
  float* out; const float* base; const float* gate;
  DI void operator()(f32x16 (&acc)[4][2], int mb, int nb, int r, int hh) const {
#pragma unroll
    for (int ni = 0; ni < 2; ++ni) {
      const int n = nb + ni * 32 + r;
      const float gt = gate[n];
#pragma unroll
      for (int mi = 0; mi < 4; ++mi) {
        const unsigned o0 = (unsigned)(mb + mi * 32 + 4 * hh) * 1024u + (unsigned)n;
#pragma unroll
        for (int q4 = 0; q4 < 4; ++q4) {
          const float b0 = base[o0 + (8 * q4 + 0) * 1024], b1 = base[o0 + (8 * q4 + 1) * 1024], b2 = base[o0 + (8 * q4 + 2) * 1024], b3 = base[o0 + (8 * q4 + 3) * 1024];
          out[o0 + (8 * q4 + 0) * 1024] = b0 + gt * acc[mi][ni][4 * q4];
          out[o0 + (8 * q4 + 1) * 1024] = b1 + gt * acc[mi][ni][4 * q4 + 1];
          out[o0 + (8 * q4 + 2) * 1024] = b2 + gt * acc[mi][ni][4 * q4 + 2];
          out[o0 + (8 * q4 + 3) * 1024] = b3 + gt * acc[mi][ni][4 * q4 + 3];
          __builtin_amdgcn_sched_barrier(0);
        }
      }
    }
  }
};
struct EpiGelu {
  bf16_t* U; bf16_t* GVT; int m0, n0;
  DI void operator()(f32x16 (&acc)[4][2], int mb, int nb, int r, int hh) const {
    if (n0 < 2048) {
#pragma unroll
      for (int mi = 0; mi < 4; ++mi)
#pragma unroll
        for (int ni = 0; ni < 2; ++ni)
#pragma unroll
          for (int i = 0; i < 16; ++i)
            U[(size_t)(m0 + mb + mi * 32 + crow(i, hh)) * 2048 + n0 + nb + ni * 32 + r] = f2bf(geluf(acc[mi][ni][i]));
    } else {
#pragma unroll
      for (int mi = 0; mi < 4; ++mi) {
        const int mrow = m0 + mb + mi * 32;
        const int chunk = mrow >> 7, q0 = mrow & 127;
#pragma unroll
        for (int ni = 0; ni < 2; ++ni) {
          const int cc = n0 - 2048 + nb + ni * 32 + r;
          bf16_t* d = GVT + ((size_t)chunk * 2048 + cc) * 128 + q0 + 4 * hh;
#pragma unroll
          for (int q4 = 0; q4 < 4; ++q4) {
            uint2 u;
            u.x = pack2(geluf(acc[mi][ni][4 * q4]), geluf(acc[mi][ni][4 * q4 + 1]));
            u.y = pack2(geluf(acc[mi][ni][4 * q4 + 2]), geluf(acc[mi][ni][4 * q4 + 3]));
            *(uint2*)(d + 8 * q4) = u;
          }
        }
      }
    }
  }
};
struct EpiSwiglu {
  bf16_t* hid;
  DI void operator()(f32x16 (&acc)[4][2], int mb, int nb, int r, int hh) const {
    const int f = (nb >> 1) + r;
#pragma unroll
    for (int mi = 0; mi < 4; ++mi)
#pragma unroll
      for (int i = 0; i < 16; ++i) {
        const float gv = acc[mi][0][i], uv = acc[mi][1][i];
        hid[(size_t)(mb + mi * 32 + crow(i, hh)) * 1024 + f] = f2bf(siluf(gv) * uv);
      }
  }
};
DI void phase_moe1(const Params& p, char* smem) {
  const bf16_t* HA = (const bf16_t*)(p.ws + O_HA); const bf16_t* WGU = (const bf16_t*)(p.ws + O_MGU);
  const int* IDX = (const int*)(p.ws + O_IDX); bf16_t* HID = (bf16_t*)(p.ws + O_HID);
  const int t = tid(), lrow = t >> 3, lcol = (t & 7) * 8;
  for (TileWalk tw(128 * 16, smem); tw.valid(); tw.next()) {
    int mg, nt; tw.get(8, 8, 2, mg, nt);
    const int e = mg >> 3, b = (mg >> 2) & 1, mt = mg & 3, be = b * 16 + e;
    unsigned aoff[8];
#pragma unroll
    for (int i = 0; i < 8; ++i) aoff[i] = (unsigned)IDX[be * 1024 + mt * 256 + lrow + 32 * i] * 1024u + (unsigned)lcol;
    gemm_tile<false>(HA + (size_t)b * 8192 * 1024, aoff, WGU + ((size_t)e * 2048 + nt * 128) * 1024, (unsigned)lrow * 1024u + (unsigned)lcol, 1024, smem,
              EpiSwiglu{HID + ((size_t)be * 1024 + mt * 256) * 1024 + nt * 64});
  }
}
DI void phase_moe2(const Params& p, int layer, char* smem) {
  const bf16_t* HID = (const bf16_t*)(p.ws + O_HID); const bf16_t* WD = (const bf16_t*)(p.ws + O_MD);
  const int t = tid(), lrow = t >> 3, lcol = (t & 7) * 8;
  for (TileWalk tw(128 * 8, smem); tw.valid(); tw.next()) {
    int mg, nt; tw.get(8, 8, 1, mg, nt);
    const int e = mg >> 3, b = (mg >> 2) & 1, mt = mg & 3, be = b * 16 + e;
    unsigned aoff[8];
#pragma unroll
    for (int i = 0; i < 8; ++i) aoff[i] = (unsigned)(lrow + 32 * i) * 1024u + (unsigned)lcol;
    gemm_tile<true>(HID + ((size_t)be * 1024 + mt * 256) * 1024, aoff, WD + ((size_t)e * 1024 + nt * 128) * 1024, (unsigned)lrow * 1024u + (unsigned)lcol, 1024, smem,
              EpiBf16{(bf16_t*)(p.ws + O_YE) + ((size_t)be * 1024 + mt * 256) * 1024 + nt * 128, 1024});
  }
}

DI void phase_final(const Params& p) {
  const int t = tid(), lane = t & 63, w = t >> 6;
  for (int row = blockIdx.x * 4 + w; row < NTOK; row += gridDim.x * 4) {
    float* src = p.out + (size_t)row * 1024;
    float4 xv[4]; float ss = 0.f;
#pragma unroll
    for (int i = 0; i < 4; ++i) xv[i] = *(const float4*)(src + (i * 64 + lane) * 4);
    {
      float4 ca[4];
      moe_combine_row(p, row, lane, ca);
      const float* g2 = (const float*)(p.ws + O_MODV) + (1 * 3 + (row >> 13)) * 6144 + 5 * 1024;
#pragma unroll
      for (int i = 0; i < 4; ++i) {
        const float4 gg = *(const float4*)(g2 + (i * 64 + lane) * 4);
        xv[i].x += gg.x * ca[i].x; xv[i].y += gg.y * ca[i].y; xv[i].z += gg.z * ca[i].z; xv[i].w += gg.w * ca[i].w;
      }
    }
#pragma unroll
    for (int i = 0; i < 4; ++i) ss += xv[i].x * xv[i].x + xv[i].y * xv[i].y + xv[i].z * xv[i].z + xv[i].w * xv[i].w;
    ss = wsum(ss);
    const float rstd = rsqrtf(ss * (1.f / 1024.f) + EPS);
#pragma unroll
    for (int i = 0; i < 4; ++i) {
      const int col = (i * 64 + lane) * 4;
      const float4 g4 = *(const float4*)(p.final_norm_g + col);
      float4 y; y.x = xv[i].x * rstd * g4.x; y.y = xv[i].y * rstd * g4.y; y.z = xv[i].z * rstd * g4.z; y.w = xv[i].w * rstd * g4.w;
      *(float4*)(src + col) = y;
    }
  }
}

constexpr int NPHASE = 22;
DI void run_phase(const Params& p, int ph, char* smem) {
  const float* modv = (const float*)(p.ws + O_MODV);
  switch (ph) {
#if !defined(ONLY) || ONLY == 0
    case 0:
      phase_adaln(p, smem);
      __syncthreads();
      tconv(p.ab_w_in, 2832, 2832, 1024, 1, 0, (bf16_t*)(p.ws + O_WIN), 0, 1, smem);
      tconv(p.ab_w_out, 1024, 1024, 1024, 1, 0, (bf16_t*)(p.ws + O_WOUT), 0, 0, smem);
      tconv(p.gm_w_in, 4096, 4096, 1024, 1, 0, (bf16_t*)(p.ws + O_GMIN), 0, 0, smem);
      tconv(p.gm_w_out, 1024, 1024, 2048, 1, 0, (bf16_t*)(p.ws + O_GMOUT), 0, 0, smem);
      break;
#endif
#if !defined(ONLY) || ONLY == 1
    case 1: phase_modulate<1, false>(p, 0, 0, smem); break;
#endif
#if !defined(ONLY) || ONLY == 2
    case 2:
      gemm_dense((const bf16_t*)(p.ws + O_HA), (const bf16_t*)(p.ws + O_WIN), NROW, PLD, 1024, 6, 11, smem,
                 [&](int m0, int n0) { return EpiBf16{(bf16_t*)(p.ws + O_P) + (size_t)m0 * PLD + n0, PLD}; });
      break;
#endif
#if !defined(ONLY) || ONLY == 3
    case 3: phase_prep2(p, smem); break;
#endif
#if !defined(ONLY) || ONLY == 4
    case 4:
      for (int item = blockIdx.x; item < 1024 + 8 * NSTEP; item += gridDim.x) {
        if (item < 1024) attn_item(p, item, smem); else mlstm_local_item(p, item - 1024, smem);
      }
      break;
#endif
#if !defined(ONLY) || ONLY == 5
    case 5: phase_scan(p, smem); break;
#endif
#if !defined(ONLY) || ONLY == 6
    case 6:
      for (int item = blockIdx.x; item < 512; item += gridDim.x) mlstm_out_item(p, item, smem);
      break;
#endif
#if !defined(ONLY) || ONLY == 7
    case 7:
#pragma unroll 1
      for (int step = 0; step < 2; ++step) {
        if (((step ^ (int)blockIdx.x) & 1) == 0) {
          gemm_dense((const bf16_t*)(p.ws + O_HA), (const bf16_t*)(p.ws + O_WOUT), NTOK, 1024, 1024, 8, 8, smem,
                     [&](int m0, int n0) {
                       return EpiRes{p.out + (size_t)m0 * 1024 + n0, p.x + (size_t)m0 * 1024 + n0, modv + (0 * 3 + (m0 >> 13)) * 6144 + 2 * 1024 + n0};
                     });
        } else {
          tconv_moe(p, 0, smem);
        }
        __syncthreads();
      }
      break;
#endif
#if !defined(ONLY) || ONLY == 8
    case 8: phase_modulate<2, false>(p, 0, 1, smem); break;
#endif
#if !defined(ONLY) || ONLY == 9
    case 9: phase_topk(p, smem); break;
#endif
#if !defined(ONLY) || ONLY == 10
    case 10: phase_moe1(p, smem); break;
#endif
#if !defined(ONLY) || ONLY == 11
    case 11: phase_moe2(p, 0, smem); break;
#endif
#if !defined(ONLY) || ONLY == 12
    case 12:
      phase_modulate<0, true>(p, 1, 0, smem);
      break;
#endif
#if !defined(ONLY) || ONLY == 13
    case 13:
      gemm_dense((const bf16_t*)(p.ws + O_HA), (const bf16_t*)(p.ws + O_GMIN), NTOK, 4096, 1024, 8, 8, smem,
                 [&](int m0, int n0) { return EpiGelu{(bf16_t*)(p.ws + O_U), (bf16_t*)(p.ws + O_GVT), m0, n0}; });
      break;
#endif
#if !defined(ONLY) || ONLY == 14
    case 14: phase_stats(p, smem); break;
#endif
#if !defined(ONLY) || ONLY == 15
    case 15: phase_spatial(p, smem); break;
#endif
#if !defined(ONLY) || ONLY == 16
    case 16:
#pragma unroll 1
      for (int step = 0; step < 2; ++step) {
        if (((step ^ (int)blockIdx.x) & 1) == 0) {
          gemm_dense((const bf16_t*)(p.ws + O_UV), (const bf16_t*)(p.ws + O_GMOUT), NTOK, 1024, 2048, 8, 8, smem,
                     [&](int m0, int n0) {
                       return EpiRes{p.out + (size_t)m0 * 1024 + n0, p.out + (size_t)m0 * 1024 + n0, modv + (1 * 3 + (m0 >> 13)) * 6144 + 2 * 1024 + n0};
                     });
        } else {
          tconv_moe(p, 1, smem);
        }
        __syncthreads();
      }
      break;
#endif
#if !defined(ONLY) || ONLY == 17
    case 17: phase_modulate<2, false>(p, 1, 1, smem); break;
#endif
#if !defined(ONLY) || ONLY == 18
    case 18: phase_topk(p, smem); break;
#endif
#if !defined(ONLY) || ONLY == 19
    case 19: phase_moe1(p, smem); break;
#endif
#if !defined(ONLY) || ONLY == 20
    case 20: phase_moe2(p, 1, smem); break;
#endif
#if !defined(ONLY) || ONLY == 21
    case 21: phase_final(p); break;
#endif
    default: break;
  }
}

#define XB_TMO      128
#define XB_XCNT(j)  (256  + 64 * (j))
#define XB_XSUB(j)  (1280 + 64 * (j))
#define XB_XGEN(j)  (2304 + 64 * (j))
#define XB_TOP      3328
#define XB_TOPGEN   3392
#define XCD_BAR_WORDS 3456
#define XB_SPIN_CAP (1u << 18)
#define LAS __attribute__((address_space(3)))
DI unsigned xb_ld(unsigned* p) { return __hip_atomic_load(p, __ATOMIC_RELAXED, __HIP_MEMORY_SCOPE_AGENT); }
DI unsigned xb_add(unsigned* p, unsigned v) { return __hip_atomic_fetch_add(p, v, __ATOMIC_RELAXED, __HIP_MEMORY_SCOPE_AGENT); }
DI unsigned xb_xcc_id() { return (unsigned)__builtin_amdgcn_s_getreg((3 << 11) | 20) & 0xFu; }
#define XB_SPIN(cond, bar) do { unsigned _sp = 0; while (cond) { __builtin_amdgcn_s_sleep(1); \
    if ((++_sp & 255u) == 0u) { if (xb_ld(&(bar)[XB_TMO])) break; if (_sp > XB_SPIN_CAP) { atomicAdd(&(bar)[XB_TMO], 1u); break; } } } } while (0)
struct XcdBarrier { unsigned* bar; unsigned x; volatile LAS unsigned* st; };
DI XcdBarrier xcd_barrier_post(unsigned* bar, volatile LAS unsigned* st) {
  XcdBarrier b; b.bar = bar; b.x = xb_xcc_id(); b.st = st;
  if (threadIdx.x == 0) st[3] = xb_add(&bar[XB_XCNT(b.x)], 1u);
  return b;
}
DI void xcd_barrier_complete(unsigned* bar, unsigned x, unsigned& nloc, unsigned& nx, unsigned& sbefore) {
  const unsigned G = gridDim.x * gridDim.y * gridDim.z;
  unsigned sum, cnt, mine, sp = 0u, sb = 0u;
  for (;;) {
    sum = 0u; cnt = 0u; mine = 0u; sb = 0u;
#pragma unroll
    for (unsigned j = 0; j < 16; ++j) { const unsigned c = xb_ld(&bar[XB_XCNT(j)]); sum += c; cnt += (c > 0u) ? 1u : 0u; mine = (j == x) ? c : mine; sb += (j < x) ? c : 0u; }
    if (sum == G) break;
    __builtin_amdgcn_s_sleep(1);
    if ((++sp & 255u) == 0u) { if (xb_ld(&bar[XB_TMO])) break; if (sp > XB_SPIN_CAP) { atomicAdd(&bar[XB_TMO], 1u); break; } }
  }
  nloc = mine > 0u ? mine : 1u; nx = cnt > 0u ? cnt : 1u; sbefore = sb;
}
DI void xcd_barrier(const XcdBarrier& b) {
  asm volatile("s_waitcnt vmcnt(0)" ::: "memory");
  __syncthreads();
  if (threadIdx.x == 0) {
    unsigned* bar = b.bar;
    __builtin_amdgcn_s_waitcnt(0);
    unsigned nloc = b.st[0], nx = b.st[1];
    if (nloc == 0u) { unsigned sbf; xcd_barrier_complete(bar, b.x, nloc, nx, sbf); b.st[0] = nloc; b.st[1] = nx; b.st[2] = sbf; }
    const unsigned old = xb_add(&bar[XB_XSUB(b.x)], 1u);
    const unsigned gen = old / nloc;
    if (old + 1u == (gen + 1u) * nloc) {
      __builtin_amdgcn_fence(__ATOMIC_RELEASE, "agent");
      asm volatile("s_waitcnt vmcnt(0)" ::: "memory");
      const unsigned og = xb_add(&bar[XB_TOP], 1u);
      const unsigned tg = og / nx;
      if (og + 1u == (tg + 1u) * nx) xb_add(&bar[XB_TOPGEN], 1u);
      else XB_SPIN(xb_ld(&bar[XB_TOPGEN]) == tg, bar);
      __builtin_amdgcn_fence(__ATOMIC_ACQUIRE, "agent");
      xb_add(&bar[XB_XGEN(b.x)], 1u);
      asm volatile("s_waitcnt vmcnt(0)" ::: "memory");
    } else {
      XB_SPIN(xb_ld(&bar[XB_XGEN(b.x)]) == gen, bar);
      __builtin_amdgcn_fence(__ATOMIC_ACQUIRE, "agent");
      asm volatile("s_waitcnt vmcnt(0)" ::: "memory");
    }
  }
  __syncthreads();
}

DI Params kargs() {
  Params P{};
#if defined(__HIP_DEVICE_COMPILE__)
  typedef const unsigned long long __attribute__((address_space(4))) CU;
  CU* q = (CU*)__builtin_amdgcn_kernarg_segment_ptr();
  asm volatile("" : "+s"(q));
#define GP(T, i) ((T*)(T __attribute__((address_space(1)))*)(q[i]))
  P.x = GP(const float, 0);
  P.c = GP(const float, 1);
  P.ctx = GP(const float, 2);
  P.c_ctx = GP(const float, 3);
  P.w_mod = GP(const float, 4);
  P.b_mod = GP(const float, 5);
  P.norm_mix_g = GP(const float, 6);
  P.norm_ffn_g = GP(const float, 7);
  P.final_norm_g = GP(const float, 8);
  P.ab_w_in = GP(const float, 9);
  P.ab_conv_w = GP(const float, 10);
  P.ab_gate_b = GP(const float, 11);
  P.ab_head_g = GP(const float, 12);
  P.ab_sink = GP(const float, 13);
  P.ab_w_out = GP(const float, 14);
  P.gm_w_in = GP(const float, 15);
  P.gm_ln_g = GP(const float, 16);
  P.gm_ln_b = GP(const float, 17);
  P.gm_w_s = GP(const float, 18);
  P.gm_b_s = GP(const float, 19);
  P.gm_w_out = GP(const float, 20);
  P.moe_w_router = GP(const float, 21);
  P.moe_w_gate = GP(const float, 22);
  P.moe_w_up = GP(const float, 23);
  P.moe_w_down = GP(const float, 24);
  P.out = GP(float, 25);
  P.ws = GP(char, 26);
#undef GP
#endif
  return P;
}
#if COOP
#ifndef REPEAT_MASK
#define REPEAT_MASK 0
#endif
__global__ void __launch_bounds__(256, 2) mega(Params p_unused) {
  __shared__ __attribute__((aligned(16))) char smem[73728 + 16];
  unsigned* xbw = (unsigned*)(smem + 73728);
  cg::grid_group grid = cg::this_grid();
  if (threadIdx.x < 4) xbw[threadIdx.x] = 0u;
  __syncthreads();
  XcdBarrier xb;
  { const Params pp = kargs(); xb = xcd_barrier_post((unsigned*)(pp.ws + O_BAR), (volatile LAS unsigned*)xbw); }
#define PHX(n) { const Params pp = kargs(); run_phase(pp, n, smem); } xcd_barrier(xb); \
  if ((REPEAT_MASK >> n) & 1) { { const Params pp = kargs(); run_phase(pp, n, smem); } xcd_barrier(xb); }
  { const Params pp = kargs(); run_phase(pp, 0, smem); }
  if (p_unused.ws == nullptr) grid.sync();
  xcd_barrier(xb);
  PHX(1) PHX(2) PHX(3) PHX(4) PHX(5) PHX(6) PHX(7) PHX(8) PHX(9) PHX(10)
  PHX(11) PHX(12) PHX(13) PHX(14) PHX(15) PHX(16) PHX(17) PHX(18) PHX(19) PHX(20)
  { const Params pp = kargs(); run_phase(pp, 21, smem); }
}
#else
__global__ void __launch_bounds__(256, 2) mega(Params p, int ph) {
  __shared__ __attribute__((aligned(16))) char smem[73728];
  run_phase(p, ph, smem);
}
#endif

extern "C" void kernel_launch(void* const* d_in, const int* in_sizes, int n_in, void* d_out, int out_size, void* d_ws,
                              size_t ws_size, hipStream_t stream) {
  (void)in_sizes; (void)n_in; (void)out_size;
  if (ws_size < WS_NEED) { fprintf(stderr, "workspace too small: %zu < %zu\n", ws_size, (size_t)WS_NEED); return; }
  static int grid_blocks = 0;
  if (!grid_blocks) {
    int dev = 0, cus = 0, per_cu = 0;
    hipGetDevice(&dev);
    hipDeviceGetAttribute(&cus, hipDeviceAttributeMultiprocessorCount, dev);
    hipOccupancyMaxActiveBlocksPerMultiprocessor(&per_cu, mega, 256, 0);
    if (per_cu < 1) per_cu = 1;
    if (per_cu > 2) per_cu = 2;
    grid_blocks = cus * per_cu;
  }
  Params p{};
  const float** f = (const float**)&p;
  for (int i = 0; i < 25; ++i) f[i] = (const float*)d_in[i];
  p.out = (float*)d_out;
  p.ws = (char*)d_ws;
#if COOP
  hipMemsetAsync((char*)d_ws + O_BAR, 0, XCD_BAR_WORDS * 4, stream);
  void* args[] = {&p};
  hipError_t e = hipLaunchCooperativeKernel((void*)mega, dim3(grid_blocks), dim3(256), args, 0, stream);
  if (e != hipSuccess) fprintf(stderr, "cooperative launch failed: %s (grid %d)\n", hipGetErrorString(e), grid_blocks);
#else
  for (int ph = 0; ph < NPHASE; ++ph) hipLaunchKernelGGL(mega, dim3(grid_blocks), dim3(256), 0, stream, p, ph);
#endif
}
```
